# Optimizing an MI355X kernel written in HIP

```python
import math
import jax, jax.numpy as jnp
from jax import lax
import numpy as np

D_MODEL = 1024
BATCH = 8
SEQ = 2048
DEPTH = 1

CTX_LEN = 256
GRID_W = 64
D_MIX = D_MODEL
MLSTM_W = D_MIX // 2
MLSTM_HEADS = 4
MLSTM_DH = MLSTM_W // MLSTM_HEADS
MLSTM_CHUNK = 128
QK_CONV = 3
POOL_W = D_MIX - MLSTM_W
POOL_WINDOWS = (2, 4, 8, 16)
POOL_G = POOL_W // len(POOL_WINDOWS)
N_GATE = 2 * 2 * MLSTM_HEADS
V_OFF = 2 * MLSTM_W
O_OFF = 3 * MLSTM_W
POOL_OFF = 4 * MLSTM_W
GATE_OFF = POOL_OFF + POOL_W
PROJ_W = GATE_OFF + N_GATE
PEER_HEADS = 8
PEER_NKEYS = 128
PEER_EXPERTS = PEER_NKEYS * PEER_NKEYS
PEER_TOPK = 16
PEER_QDIM = 256
PEER_QHALF = PEER_QDIM // 2
PEER_BLOCK = 128
EPS = 1e-6

kernel_name = 'hybrid_mlstm_pool_peer_dit_layer'


def rmsnorm(x, w):
    xf = x.astype(jnp.float32)
    y = xf * lax.rsqrt(jnp.mean(xf * xf, axis=-1, keepdims=True) + EPS)
    return (y * w.astype(jnp.float32)).astype(x.dtype)


def adaln(cond, w, b):
    m = jax.nn.silu(cond) @ w + b
    return m.reshape(cond.shape[0], 6, 1, D_MODEL)


def modulate(h, shift, scale):
    return h * (1 + scale) + shift


def centred_dwconv(u, w, b):
    T = u.shape[1]
    pad = QK_CONV // 2
    up = jnp.pad(u, ((0, 0), (pad, pad), (0, 0)))
    y = b + up[:, 0:T] * w[0]
    for j in range(1, QK_CONV):
        y = y + up[:, j:j + T] * w[j]
    return y


def mlstm_inputs(proj, conv_w, conv_b, b_gates):
    B, T, _ = proj.shape
    qk = jax.nn.silu(centred_dwconv(proj[..., :V_OFF], conv_w, conv_b))

    def heads(a):
        return a.reshape(B, T, MLSTM_HEADS, MLSTM_DH).transpose(0, 2, 1, 3).astype(jnp.float32)

    q = heads(qk[..., :MLSTM_W])
    k = heads(qk[..., MLSTM_W:]) * (MLSTM_DH ** -0.5)
    v = heads(proj[..., V_OFF:O_OFF])
    o = proj[..., O_OFF:POOL_OFF]
    g = proj[..., GATE_OFF:].reshape(B, T, 2, 2, MLSTM_HEADS) + b_gates
    g = g.astype(jnp.float32).transpose(2, 3, 0, 4, 1)
    return q, k, v, g, o


def zero_state(B):
    f32 = jnp.float32
    return (jnp.zeros((B, MLSTM_HEADS, MLSTM_DH, MLSTM_DH), f32),
            jnp.zeros((B, MLSTM_HEADS, MLSTM_DH), f32),
            jnp.zeros((B, MLSTM_HEADS), f32))


def mlstm_scan(q, k, v, ig, fg, state, return_h):
    B, H, T, dh = q.shape
    L = MLSTM_CHUNK
    nc = T // L

    def chunk(a):
        return jnp.moveaxis(a.reshape(B, H, nc, L, *a.shape[3:]), 2, 0)

    xs = (chunk(q), chunk(k), chunk(v), chunk(ig), chunk(fg))
    tril = jnp.tril(jnp.ones((L, L), dtype=bool))

    def body(carry, inp):
        C, n, m = carry
        qc, kc, vc, ic, fc = inp
        b = jnp.cumsum(jax.nn.log_sigmoid(fc), axis=-1)
        dlog = jnp.where(tril, b[..., :, None] - b[..., None, :] + ic[..., None, :], -jnp.inf)
        inter = b + m[..., None]
        m_t = jnp.maximum(inter, jnp.max(dlog, axis=-1))
        w_intra = jnp.exp(dlog - m_t[..., None])
        w_inter = jnp.exp(inter - m_t)
        s = jnp.einsum('bhtd,bhsd->bhts', qc, kc) * w_intra
        num = jnp.einsum('bhts,bhsd->bhtd', s, vc) + w_inter[..., None] * jnp.einsum('bhvk,bhtk->bhtv', C, qc)
        den = jnp.sum(s, axis=-1) + w_inter * jnp.einsum('bhk,bhtk->bht', n, qc)
        h = num / jnp.maximum(jnp.abs(den), jnp.exp(-m_t))[..., None]
        b_end = b[..., -1]
        wlog = b_end[..., None] - b + ic
        m_new = jnp.maximum(b_end + m, jnp.max(wlog, axis=-1))
        decay = jnp.exp(b_end + m - m_new)
        ws = jnp.exp(wlog - m_new[..., None])
        C_new = decay[..., None, None] * C + jnp.einsum('bhs,bhsv,bhsk->bhvk', ws, vc, kc)
        n_new = decay[..., None] * n + jnp.einsum('bhs,bhsk->bhk', ws, kc)
        return (C_new, n_new, m_new), (h if return_h else None)

    state, hs = lax.scan(body, state, xs)
    if not return_h:
        return None, state
    return jnp.moveaxis(hs, 0, 2).reshape(B, H, T, dh), state


def mlstm_bidir(q, k, v, g, states, return_h):
    def flip(a):
        return jnp.flip(a, axis=2)

    h_f, s_f = mlstm_scan(q, k, v, g[0, 0], g[0, 1], states[0], return_h)
    h_b, s_b = mlstm_scan(flip(q), flip(k), flip(v), flip(g[1, 0]), flip(g[1, 1]), states[1], return_h)
    h = h_f + flip(h_b) if return_h else None
    return h, (s_f, s_b)


def mlstm_out(h, o, head_norm_w):
    B, H, T, dh = h.shape
    mu = jnp.mean(h, axis=-1, keepdims=True)
    var = jnp.mean(jnp.square(h - mu), axis=-1, keepdims=True)
    hn = ((h - mu) * lax.rsqrt(var + EPS)).transpose(0, 2, 1, 3).reshape(B, T, MLSTM_W)
    return (hn * head_norm_w * jax.nn.sigmoid(o.astype(jnp.float32))).astype(o.dtype)


def multiscale_pool(u, pool_w, pool_scale):
    uf = u.astype(jnp.float32)
    n = u.shape[-2]
    S = jnp.pad(jnp.cumsum(uf, axis=-2), [(0, 0)] * (uf.ndim - 2) + [(1, 0), (0, 0)])
    t = jnp.arange(n)
    outs = []
    for gi, w in enumerate(POOL_WINDOWS):
        lo = jnp.clip(t - w // 2, 0, n)
        hi = jnp.clip(t - w // 2 + w, 0, n)
        Sg = S[..., gi * POOL_G:(gi + 1) * POOL_G]
        avg = (jnp.take(Sg, hi, axis=-2) - jnp.take(Sg, lo, axis=-2)) / (hi - lo).astype(jnp.float32)[:, None]
        outs.append(avg - uf[..., gi * POOL_G:(gi + 1) * POOL_G])
    d = jnp.stack(outs, axis=-2)
    y = jnp.einsum('...gi,gio->...go', d, pool_w.astype(jnp.float32)).reshape(*u.shape[:-1], POOL_W)
    return (y * pool_scale).astype(u.dtype)


def peer_ffn(h, wq, keys, U, V):
    shape = h.shape
    xt = h.reshape(-1, D_MODEL)
    T = xt.shape[0]
    q = (xt @ wq).reshape(T, PEER_HEADS, 2, PEER_QHALF)
    s = jnp.einsum('thpd,hpnd->thpn', q, keys)
    sv, si = lax.top_k(s, PEER_TOPK)
    cand = (sv[:, :, 0, :, None] + sv[:, :, 1, None, :]).reshape(T, PEER_HEADS, PEER_TOPK * PEER_TOPK)
    cidx = (si[:, :, 0, :, None] * PEER_NKEYS + si[:, :, 1, None, :]).reshape(T, PEER_HEADS, PEER_TOPK * PEER_TOPK)
    top_s, top_c = lax.top_k(cand, PEER_TOPK)
    eidx = jnp.take_along_axis(cidx, top_c, axis=-1)
    gates = jax.nn.softmax(top_s.astype(jnp.float32), axis=-1).astype(h.dtype)
    nb = T // PEER_BLOCK

    def block(args):
        xb, ib, gb = args
        a = jnp.einsum('thkd,td->thk', U[ib], xb)
        return jnp.einsum('thk,thkd->td', jax.nn.gelu(a, approximate=False) * gb, V[ib])

    y = lax.map(block, (xt.reshape(nb, PEER_BLOCK, D_MODEL),
                        eidx.reshape(nb, PEER_BLOCK, PEER_HEADS, PEER_TOPK),
                        gates.reshape(nb, PEER_BLOCK, PEER_HEADS, PEER_TOPK)))
    return y.reshape(shape)


def setup_inputs(seed: int = 0) -> dict:
    key = jax.random.key(seed)
    ks = jax.random.split(key, 24)
    nrm = jax.random.normal
    f32 = jnp.float32
    gate_base = jnp.stack([jnp.zeros((MLSTM_HEADS,), f32), jnp.linspace(3.0, 6.0, MLSTM_HEADS, dtype=f32)])
    return {
        'x': nrm(ks[0], (BATCH, SEQ, D_MODEL), f32),
        'c': nrm(ks[1], (BATCH, D_MODEL), f32),
        'ctx': nrm(ks[2], (BATCH, CTX_LEN, D_MODEL), f32),
        'c_ctx': nrm(ks[3], (D_MODEL,), f32),
        'w_mod': nrm(ks[4], (DEPTH, D_MODEL, 6 * D_MODEL), f32) * D_MODEL ** -0.5,
        'b_mod': nrm(ks[5], (DEPTH, 6 * D_MODEL), f32) * 0.02,
        'norm1_w': 1.0 + 0.05 * nrm(ks[6], (DEPTH, D_MODEL), f32),
        'w_in': nrm(ks[7], (DEPTH, D_MODEL, PROJ_W), f32) * D_MODEL ** -0.5,
        'conv_w': nrm(ks[8], (DEPTH, QK_CONV, 2 * MLSTM_W), f32) * QK_CONV ** -0.5,
        'conv_b': nrm(ks[9], (DEPTH, 2 * MLSTM_W), f32) * 0.02,
        'b_gates': gate_base[None, None] + 0.1 * nrm(ks[10], (DEPTH, 2, 2, MLSTM_HEADS), f32),
        'head_norm_w': 1.0 + 0.05 * nrm(ks[11], (DEPTH, MLSTM_W), f32),
        'pool_w': nrm(ks[12], (DEPTH, len(POOL_WINDOWS), POOL_G, POOL_G), f32) * POOL_G ** -0.5,
        'pool_scale': 1.0 + 0.1 * nrm(ks[13], (DEPTH, POOL_W), f32),
        'w_out': nrm(ks[14], (DEPTH, D_MIX, D_MODEL), f32) * D_MIX ** -0.5,
        'norm2_w': 1.0 + 0.05 * nrm(ks[15], (DEPTH, D_MODEL), f32),
        'peer_wq': nrm(ks[16], (DEPTH, D_MODEL, PEER_HEADS * PEER_QDIM), f32) * D_MODEL ** -0.5,
        'peer_keys': nrm(ks[17], (DEPTH, PEER_HEADS, 2, PEER_NKEYS, PEER_QHALF), f32) * PEER_QHALF ** -0.5,
        'peer_u': nrm(ks[18], (DEPTH, PEER_EXPERTS, D_MODEL), f32) * D_MODEL ** -0.5,
        'peer_v': nrm(ks[19], (DEPTH, PEER_EXPERTS, D_MODEL), f32) * 0.5,
        'final_norm_w': 1.0 + 0.05 * nrm(ks[20], (D_MODEL,), f32),
    }


def reference(x, c, ctx, c_ctx, w_mod, b_mod, norm1_w, w_in, conv_w, conv_b, b_gates, head_norm_w,
              pool_w, pool_scale, w_out, norm2_w, peer_wq, peer_keys, peer_u, peer_v, final_norm_w):
    B, S, _ = x.shape
    rows = S // GRID_W
    xl, xc = x, ctx
    for l in range(DEPTH):
        last = l == DEPTH - 1
        mod_l = adaln(c, w_mod[l], b_mod[l])
        mod_c = adaln(c_ctx[None], w_mod[l], b_mod[l])
        pl = modulate(rmsnorm(xl, norm1_w[l]), mod_l[:, 0], mod_l[:, 1]) @ w_in[l]
        pc = modulate(rmsnorm(xc, norm1_w[l]), mod_c[:, 0], mod_c[:, 1]) @ w_in[l]
        ql, kl, vl, gl, ol = mlstm_inputs(pl, conv_w[l], conv_b[l], b_gates[l])
        qc, kc, vc, gc, oc = mlstm_inputs(pc, conv_w[l], conv_b[l], b_gates[l])
        hc_m, ctx_states = mlstm_bidir(qc, kc, vc, gc, (zero_state(B), zero_state(B)), not last)
        hl_m, _ = mlstm_bidir(ql, kl, vl, gl, ctx_states, True)
        ml = mlstm_out(hl_m, ol, head_norm_w[l])
        ul = pl[..., POOL_OFF:GATE_OFF].reshape(B, rows, GRID_W, POOL_W)
        pool_l = multiscale_pool(ul, pool_w[l], pool_scale[l]).reshape(B, S, POOL_W)
        xl = xl + mod_l[:, 2] * (jnp.concatenate([ml, pool_l], axis=-1) @ w_out[l])
        h2 = modulate(rmsnorm(xl, norm2_w[l]), mod_l[:, 3], mod_l[:, 4])
        xl = xl + mod_l[:, 5] * peer_ffn(h2, peer_wq[l], peer_keys[l], peer_u[l], peer_v[l])
        if not last:
            mc = mlstm_out(hc_m, oc, head_norm_w[l])
            pool_c = multiscale_pool(pc[..., POOL_OFF:GATE_OFF], pool_w[l], pool_scale[l])
            xc = xc + mod_c[:, 2] * (jnp.concatenate([mc, pool_c], axis=-1) @ w_out[l])
            h2c = modulate(rmsnorm(xc, norm2_w[l]), mod_c[:, 3], mod_c[:, 4])
            xc = xc + mod_c[:, 5] * peer_ffn(h2c, peer_wq[l], peer_keys[l], peer_u[l], peer_v[l])
    return rmsnorm(xl, final_norm_w)
```

```cpp
#include <hip/hip_runtime.h>
#include <hip/hip_cooperative_groups.h>
#include <stdint.h>
#include <stdio.h>
namespace cg = cooperative_groups;

#ifndef PHMASK
#define PHMASK 0x7ff
#endif
#ifndef N_LAUNCHES
#define N_LAUNCHES 0
#endif

typedef unsigned short bf16_t;
typedef short bf16x8 __attribute__((ext_vector_type(8)));
typedef float f32x4 __attribute__((ext_vector_type(4)));
typedef unsigned u32x4 __attribute__((ext_vector_type(4)));
typedef unsigned u32x2 __attribute__((ext_vector_type(2)));

#define NB 8
#define SEQ 2048
#define DM 1024
#define CTXL 256
#define TL 16384
#define TC 2048
#define TR 18432
#define LDP 2576
#define NPADIN 2688
#define NTHR 256
#define NPH 11

#define OFF_MOD    (4096ull)
#define OFF_GATES  (OFF_MOD + 262144ull)
#define OFF_WTIN   (OFF_GATES + 1179648ull)
#define OFF_WTOUT  (OFF_WTIN + 5505024ull)
#define OFF_WTQ    (OFF_WTOUT + 2097152ull)
#define OFF_KEYS   (OFF_WTQ + 4194304ull)
#define OFF_POOLWT (OFF_KEYS + 524288ull)
#define OFF_HN     (OFF_POOLWT + 131072ull)
#define OFF_PL     (OFF_HN + 37748736ull)
#define OFF_D      (OFF_PL + 94961664ull)
#define OFF_ND     (OFF_D + 37748736ull)
#define OFF_SC     (OFF_ND + 589824ull)
#define OFF_CIN    (OFF_SC + 16384ull)
#define OFF_NIN    (OFF_CIN + 33554432ull)
#define OFF_MIN    (OFF_NIN + 524288ull)
#define OFF_EIDX   (OFF_MIN + 8192ull)
#define OFF_GATE   (OFF_EIDX + 8388608ull)
#define WS_END     (OFF_GATE + 8388608ull)

struct P {
  const float *x, *c, *ctx, *c_ctx, *w_mod, *b_mod, *norm1_w, *w_in, *conv_w, *conv_b, *b_gates, *head_norm_w,
      *pool_w, *pool_scale, *w_out, *norm2_w, *wq, *keys, *U, *V, *final_norm_w;
  float* out;
  float* mod;
  float* gates;
  bf16_t* wt_in;
  bf16_t* wt_out;
  bf16_t* wt_q;
  bf16_t* keys_bf;
  bf16_t* hn;
  bf16_t* pl;
  bf16_t* Dst;
  float* ND;
  float* SC;
  bf16_t* CIN;
  float* NIN;
  float* MIN_;
  int* eidx;
  float* gate;
  int ph_lo, ph_hi;
};

__device__ __forceinline__ bf16_t f2bf(float f) {
  unsigned u = __float_as_uint(f);
  u += 0x7fffu + ((u >> 16) & 1u);
  return (bf16_t)(u >> 16);
}
__device__ __forceinline__ float bf2f(bf16_t h) { return __uint_as_float(((unsigned)h) << 16); }
__device__ __forceinline__ float wave_sum(float v) {
#pragma unroll
  for (int o = 32; o > 0; o >>= 1) v += __shfl_xor(v, o);
  return v;
}
__device__ __forceinline__ float silu_f(float v) { return v / (1.f + __expf(-v)); }
__device__ __forceinline__ float logsig_f(float v) { return fminf(v, 0.f) - log1pf(__expf(-fabsf(v))); }

__device__ __forceinline__ void ph0_prep(const P& p, int bid, int nb, char* smem) {
  float* sm = (float*)smem;
  const int tid = threadIdx.x;
  const int N_MOD = 24, N_TIN = 16 * 42, N_TOUT = 256, N_TQ = 16 * 32, N_POOL = 16, N_KEYS = 64;
  const int total = N_MOD + N_TIN + N_TOUT + N_TQ + N_POOL + N_KEYS;
  for (int it = bid; it < total; it += nb) {
    int r = it;
    if (r < N_MOD) {
      for (int i = tid; i < 9 * 1024; i += NTHR) {
        int rr = i >> 10, k = i & 1023;
        float v = rr < 8 ? p.c[rr * 1024 + k] : p.c_ctx[k];
        sm[i] = silu_f(v);
      }
      __syncthreads();
      int n = r * 256 + tid;
      float acc[9];
#pragma unroll
      for (int q = 0; q < 9; ++q) acc[q] = p.b_mod[n];
#pragma unroll 4
      for (int k = 0; k < 1024; ++k) {
        float w = p.w_mod[(size_t)k * 6144 + n];
#pragma unroll
        for (int q = 0; q < 9; ++q) acc[q] += sm[q * 1024 + k] * w;
      }
#pragma unroll
      for (int q = 0; q < 9; ++q) p.mod[q * 6144 + n] = acc[q];
      __syncthreads();
      continue;
    }
    r -= N_MOD;
    const float* src = nullptr; bf16_t* dst = nullptr; int K = 1024, N = 0, ntn = 0;
    bool is_t = false;
    if (r < N_TIN) { src = p.w_in; dst = p.wt_in; N = 2576; ntn = 42; is_t = true; }
    else { r -= N_TIN;
      if (r < N_TOUT) { src = p.w_out; dst = p.wt_out; N = 1024; ntn = 16; is_t = true; }
      else { r -= N_TOUT;
        if (r < N_TQ) { src = p.wq; dst = p.wt_q; N = 2048; ntn = 32; is_t = true; }
        else { r -= N_TQ;
          if (r < N_POOL) { int g = r >> 2; r &= 3; src = p.pool_w + g * 16384; dst = (bf16_t*)((char*)p.keys_bf + 524288) + g * 16384; K = 128; N = 128; ntn = 2; is_t = true; }
          else { r -= N_POOL; }
        }
      }
    }
    if (is_t) {
      int kt = r / ntn, nt = r % ntn, k0 = kt * 64, n0 = nt * 64;
      int cc = tid & 63;
      for (int rr = tid >> 6; rr < 64; rr += 4) {
        int n = n0 + cc;
        sm[rr * 65 + cc] = n < N ? src[(size_t)(k0 + rr) * N + n] : 0.f;
      }
      __syncthreads();
      for (int rr = tid >> 6; rr < 64; rr += 4) dst[(size_t)(n0 + rr) * K + k0 + cc] = f2bf(sm[cc * 65 + rr]);
      __syncthreads();
    } else {
      for (int i = tid; i < 4096; i += NTHR) p.keys_bf[r * 4096 + i] = f2bf(p.keys[r * 4096 + i]);
    }
  }
}

template <int WHICH>
__device__ __forceinline__ void ph_norm_rows(const P& p, int bid, int nb) {
  const int wave = threadIdx.x >> 6, lane = threadIdx.x & 63;
  const int nrows = WHICH == 0 ? TR : TL;
  for (int row = bid * 4 + wave; row < nrows; row += nb * 4) {
    const float* src = WHICH == 0 ? (row < TL ? p.x + (size_t)row * 1024 : p.ctx + (size_t)(row - TL) * 1024) : p.out + (size_t)row * 1024;
    const int mr = row < TL ? row / SEQ : 8;
    float4 v[4];
    float ss = 0.f;
#pragma unroll
    for (int j = 0; j < 4; ++j) {
      v[j] = ((const float4*)src)[j * 64 + lane];
      ss += v[j].x * v[j].x + v[j].y * v[j].y + v[j].z * v[j].z + v[j].w * v[j].w;
    }
    ss = wave_sum(ss);
    const float rstd = rsqrtf(ss * (1.f / 1024.f) + 1e-6f);
    const float* nw = WHICH == 0 ? p.norm1_w : p.norm2_w;
    const float* sh = p.mod + mr * 6144 + (WHICH == 0 ? 0 : 3) * 1024;
    const float* sc = sh + 1024;
#pragma unroll
    for (int j = 0; j < 4; ++j) {
      const int col = j * 256 + lane * 4;
      float4 w4 = *(const float4*)(nw + col), s4 = *(const float4*)(sh + col), c4 = *(const float4*)(sc + col);
      float y0 = v[j].x * rstd * w4.x * (1.f + c4.x) + s4.x;
      float y1 = v[j].y * rstd * w4.y * (1.f + c4.y) + s4.y;
      float y2 = v[j].z * rstd * w4.z * (1.f + c4.z) + s4.z;
      float y3 = v[j].w * rstd * w4.w * (1.f + c4.w) + s4.w;
      uint2 o;
      o.x = (unsigned)f2bf(y0) | ((unsigned)f2bf(y1) << 16);
      o.y = (unsigned)f2bf(y2) | ((unsigned)f2bf(y3) << 16);
      *(uint2*)(p.hn + (size_t)row * 1024 + col) = o;
    }
  }
}

#define GBK 64
#define GLD 72
template <int EPI>
__device__ __forceinline__ void gemm_tile(const P& p, const bf16_t* A, int lda, const bf16_t* Bt, int m0, int n0, bf16_t* sA, bf16_t* sB) {
  const int tid = threadIdx.x, lane = tid & 63, wave = tid >> 6;
  const int wm = wave >> 1, wn = wave & 1;
  const int lr = lane & 15, lq = lane >> 4;
  f32x4 acc[4][4];
#pragma unroll
  for (int i = 0; i < 4; ++i)
#pragma unroll
    for (int j = 0; j < 4; ++j) acc[i][j] = (f32x4){0.f, 0.f, 0.f, 0.f};
  const int sr = tid >> 3, scol = (tid & 7) * 8;
  u32x4 ra[4], rb[4];
  const bf16_t* Ap = A + (size_t)(m0 + sr) * lda + scol;
  const bf16_t* Bp = Bt + (size_t)(n0 + sr) * 1024 + scol;
#pragma unroll
  for (int i = 0; i < 4; ++i) {
    ra[i] = *(const u32x4*)(Ap + (size_t)(i * 32) * lda);
    rb[i] = *(const u32x4*)(Bp + (size_t)(i * 32) * 1024);
  }
  for (int kt = 0; kt < 1024 / GBK; ++kt) {
    __syncthreads();
#pragma unroll
    for (int i = 0; i < 4; ++i) {
      *(u32x4*)(sA + (sr + i * 32) * GLD + scol) = ra[i];
      *(u32x4*)(sB + (sr + i * 32) * GLD + scol) = rb[i];
    }
    __syncthreads();
    {
      const int k0 = (kt + 1 < 1024 / GBK ? kt + 1 : kt) * GBK;
#pragma unroll
      for (int i = 0; i < 4; ++i) {
        ra[i] = *(const u32x4*)(Ap + (size_t)(i * 32) * lda + k0);
        rb[i] = *(const u32x4*)(Bp + (size_t)(i * 32) * 1024 + k0);
      }
    }
#pragma unroll
    for (int ks = 0; ks < 2; ++ks) {
      bf16x8 af[4], bfr[4];
#pragma unroll
      for (int i = 0; i < 4; ++i) {
        af[i] = *(const bf16x8*)(sA + (wm * 64 + i * 16 + lr) * GLD + ks * 32 + lq * 8);
        bfr[i] = *(const bf16x8*)(sB + (wn * 64 + i * 16 + lr) * GLD + ks * 32 + lq * 8);
      }
#pragma unroll
      for (int i = 0; i < 4; ++i)
#pragma unroll
        for (int j = 0; j < 4; ++j) acc[i][j] = __builtin_amdgcn_mfma_f32_16x16x32_bf16(af[i], bfr[j], acc[i][j], 0, 0, 0);
    }
  }
#pragma unroll
  for (int i = 0; i < 4; ++i)
#pragma unroll
    for (int j = 0; j < 4; ++j)
#pragma unroll
      for (int e = 0; e < 4; ++e) {
        const int row = m0 + wm * 64 + i * 16 + lq * 4 + e;
        const int col = n0 + wn * 64 + j * 16 + lr;
        const float v = acc[i][j][e];
        if (EPI == 0) {
          if (col < 2560) p.pl[(size_t)row * LDP + col] = f2bf(v);
          else if (col < 2576) p.gates[(size_t)row * 16 + (col - 2560)] = v;
        } else if (EPI == 1) {
          const int b = row / SEQ;
          p.out[(size_t)row * 1024 + col] = p.x[(size_t)row * 1024 + col] + p.mod[b * 6144 + 2 * 1024 + col] * v;
        } else {
          p.pl[(size_t)row * 2048 + col] = f2bf(v);
        }
      }
}

template <int EPI>
__device__ __forceinline__ void ph_gemm(const P& p, int bid, int nb, char* smem) {
  bf16_t* sA = (bf16_t*)smem;
  bf16_t* sB = sA + 128 * GLD;
  const int ntn = EPI == 0 ? 21 : (EPI == 1 ? 8 : 16);
  const int ntm = EPI == 0 ? 144 : 128;
  const bf16_t* A = EPI == 0 ? p.hn : (EPI == 1 ? p.pl + 1536 : p.hn);
  const int lda = EPI == 1 ? LDP : 1024;
  const bf16_t* Bt = EPI == 0 ? p.wt_in : (EPI == 1 ? p.wt_out : p.wt_q);
  for (int t = bid; t < ntm * ntn; t += nb) {
    const int tm = t / ntn, tn = t % ntn;
    if (EPI == 0 && tm >= 128 && tn >= 12 && tn < 20) continue;
    gemm_tile<EPI>(p, A, lda, Bt, tm * 128, tn * 128, sA, sB);
  }
}

struct UnitInfo { int isctx, b, c, h, T, seqrow0, row0; };
__device__ __forceinline__ UnitInfo decode_unit(int u) {
  UnitInfo r;
  if (u < 512) { r.isctx = 0; r.b = u >> 6; r.c = (u >> 2) & 15; r.h = u & 3; r.T = SEQ; r.seqrow0 = r.b * SEQ; }
  else { int uu = u - 512; r.isctx = 1; r.b = uu >> 3; r.c = (uu >> 2) & 1; r.h = uu & 3; r.T = CTXL; r.seqrow0 = TL + r.b * CTXL; }
  r.row0 = r.seqrow0 + r.c * 128;
  return r;
}
__device__ __forceinline__ float qk_act(const P& p, int seqrow0, int T, int t, int col) {
  const bf16_t* base = p.pl + (size_t)(seqrow0 + t) * LDP + col;
  float r0 = t > 0 ? bf2f(base[-LDP]) : 0.f;
  float r1 = bf2f(base[0]);
  float r2 = t + 1 < T ? bf2f(base[LDP]) : 0.f;
  float y = p.conv_b[col] + r0 * p.conv_w[col] + r1 * p.conv_w[1024 + col] + r2 * p.conv_w[2048 + col];
  return silu_f(y);
}

__device__ __forceinline__ void ph3_chunk_local(const P& p, int bid, int nb, char* smem) {
  bf16_t* kb = (bf16_t*)smem;
  bf16_t* vb = kb + 16384;
  float* fa = (float*)(vb + 16384);
  float *igf = fa, *lff = fa + 128, *igb = fa + 256, *lfb = fa + 384, *ef = fa + 512, *eb = fa + 640, *scal = fa + 768;
  const int tid = threadIdx.x;
  for (int u = bid; u < 576; u += nb) {
    const UnitInfo ui = decode_unit(u);
    const int h = ui.h;
    if (tid < 128) {
      const float* g = p.gates + (size_t)(ui.row0 + tid) * 16;
      igf[tid] = g[h] + p.b_gates[h];
      lff[tid] = logsig_f(g[4 + h] + p.b_gates[4 + h]);
      igb[tid] = g[8 + h] + p.b_gates[8 + h];
      lfb[tid] = logsig_f(g[12 + h] + p.b_gates[12 + h]);
    }
    for (int idx = tid; idx < 16384; idx += NTHR) {
      const int t = idx >> 7, d = idx & 127;
      const float y = qk_act(p, ui.seqrow0, ui.T, ui.c * 128 + t, 512 + h * 128 + d) * 0.08838834764831845f;
      kb[idx] = f2bf(y);
      vb[idx] = p.pl[(size_t)(ui.row0 + t) * LDP + 1024 + h * 128 + d];
    }
    __syncthreads();
    if (tid == 0) {
      float b = 0.f, G = -3.0e38f;
      for (int t = 0; t < 128; ++t) { b += lff[t]; float g = igf[t] - b; ef[t] = g; G = fmaxf(G, g); }
      scal[0] = G; scal[1] = b;
    } else if (tid == 64) {
      float b = 0.f, G = -3.0e38f;
      for (int t = 127; t >= 0; --t) { b += lfb[t]; float g = igb[t] - b; eb[t] = g; G = fmaxf(G, g); }
      scal[2] = G; scal[3] = b;
    }
    __syncthreads();
    if (tid < 128) { ef[tid] = __expf(ef[tid] - scal[0]); }
    else { eb[tid - 128] = __expf(eb[tid - 128] - scal[2]); }
    __syncthreads();
#pragma unroll 1
    for (int dir = 0; dir < 2; ++dir) {
      const int tv = tid >> 4, tk = tid & 15;
      const float* ee = dir ? eb : ef;
      float af[8][8];
#pragma unroll
      for (int i = 0; i < 8; ++i)
#pragma unroll
        for (int j = 0; j < 8; ++j) af[i][j] = 0.f;
      for (int t = 0; t < 128; ++t) {
        float vv[8], kk[8];
        const uint4 v4 = *(const uint4*)(vb + t * 128 + tv * 8);
        const uint4 k4 = *(const uint4*)(kb + t * 128 + tk * 8);
        const unsigned vw[4] = {v4.x, v4.y, v4.z, v4.w}, kw[4] = {k4.x, k4.y, k4.z, k4.w};
#pragma unroll
        for (int i = 0; i < 4; ++i) {
          vv[2 * i] = __uint_as_float(vw[i] << 16); vv[2 * i + 1] = __uint_as_float(vw[i] & 0xffff0000u);
          kk[2 * i] = __uint_as_float(kw[i] << 16); kk[2 * i + 1] = __uint_as_float(kw[i] & 0xffff0000u);
        }
        const float e1 = ee[t];
#pragma unroll
        for (int i = 0; i < 8; ++i) {
          const float a1 = e1 * vv[i];
#pragma unroll
          for (int j = 0; j < 8; ++j) af[i][j] += a1 * kk[j];
        }
      }
      bf16_t* Df = p.Dst + (size_t)(u * 2 + dir) * 16384;
#pragma unroll
      for (int i = 0; i < 8; ++i) {
        uint4 o1;
        o1.x = (unsigned)f2bf(af[i][0]) | ((unsigned)f2bf(af[i][1]) << 16);
        o1.y = (unsigned)f2bf(af[i][2]) | ((unsigned)f2bf(af[i][3]) << 16);
        o1.z = (unsigned)f2bf(af[i][4]) | ((unsigned)f2bf(af[i][5]) << 16);
        o1.w = (unsigned)f2bf(af[i][6]) | ((unsigned)f2bf(af[i][7]) << 16);
        *(uint4*)(Df + (tv * 8 + i) * 128 + tk * 8) = o1;
      }
    }
    {
      const int dir = tid >> 7, k = tid & 127;
      const float* e = dir ? eb : ef;
      float s = 0.f;
      for (int t = 0; t < 128; ++t) s += e[t] * bf2f(kb[t * 128 + k]);
      p.ND[(size_t)(u * 2 + dir) * 128 + k] = s;
    }
    if (tid < 4) p.SC[(size_t)u * 4 + tid] = scal[tid];
    __syncthreads();
  }
}

__device__ __forceinline__ void ph4_scan(const P& p, int bid, int nb) {
  const int tid = threadIdx.x;
  for (int it = bid; it < 1024; it += nb) {
    const int combo = it >> 4, vblk = it & 15;
    const int b = combo >> 3, h = (combo >> 1) & 3, dir = combo & 1;
    const int v = vblk * 8 + (tid >> 5), k0 = (tid & 31) * 4;
    float C0 = 0.f, C1 = 0.f, C2 = 0.f, C3 = 0.f, nacc = 0.f, m = 0.f;
    for (int i = 0; i < 18; ++i) {
      int u;
      if (i < 2) { const int cc = dir == 0 ? i : 1 - i; u = 512 + b * 8 + cc * 4 + h; }
      else {
        const int lc = i - 2, c = dir == 0 ? lc : 15 - lc;
        u = b * 64 + c * 4 + h;
        const size_t ci = (size_t)u * 2 + dir;
        uint2 o;
        o.x = (unsigned)f2bf(C0) | ((unsigned)f2bf(C1) << 16);
        o.y = (unsigned)f2bf(C2) | ((unsigned)f2bf(C3) << 16);
        *(uint2*)(p.CIN + ci * 16384 + v * 128 + k0) = o;
        if (vblk == 0 && tid < 128) p.NIN[ci * 128 + tid] = nacc;
        if (vblk == 0 && tid == 0) p.MIN_[ci] = m;
      }
      const size_t di = (size_t)u * 2 + dir;
      const float G = p.SC[di * 2 + 0], bend = p.SC[di * 2 + 1];
      const float Mx = fmaxf(m, G);
      const float dec = __expf(m - Mx), inj = __expf(G - Mx);
      const uint2 d2 = *(const uint2*)(p.Dst + di * 16384 + v * 128 + k0);
      C0 = dec * C0 + inj * __uint_as_float(d2.x << 16);
      C1 = dec * C1 + inj * __uint_as_float(d2.x & 0xffff0000u);
      C2 = dec * C2 + inj * __uint_as_float(d2.y << 16);
      C3 = dec * C3 + inj * __uint_as_float(d2.y & 0xffff0000u);
      if (vblk == 0 && tid < 128) nacc = dec * nacc + inj * p.ND[di * 128 + tid];
      m = bend + Mx;
    }
  }
}

__device__ __forceinline__ void ph5_mlstm_out(const P& p, int bid, int nb, char* smem) {
  bf16_t* kb = (bf16_t*)smem;
  float* qb = (float*)(kb + 128 * 130);
  float* Pf = qb + 2048;
  float* Pb = Pf + 2048;
  float* fa = Pb + 2048;
  float *igf = fa, *lff = fa + 128, *igb = fa + 256, *lfb = fa + 384, *gf = fa + 512, *gb = fa + 640, *bfw = fa + 768, *bbw = fa + 896,
        *pmf = fa + 1024, *pmb = fa + 1152, *den = fa + 1280  ;
  float* hs = Pf;
  hs = fa + 1344;
  const int tid = threadIdx.x;
  for (int it = bid; it < 4096 + 1024; it += nb) {
    if (it < 4096) {
      const int u = it >> 3, qs = it & 7;
      const UnitInfo ui = decode_unit(u);
      const int h = ui.h;
      if (tid < 128) {
        const float* g = p.gates + (size_t)(ui.row0 + tid) * 16;
        igf[tid] = g[h] + p.b_gates[h];
        lff[tid] = logsig_f(g[4 + h] + p.b_gates[4 + h]);
        igb[tid] = g[8 + h] + p.b_gates[8 + h];
        lfb[tid] = logsig_f(g[12 + h] + p.b_gates[12 + h]);
      }
      for (int idx = tid; idx < 16384; idx += NTHR) {
        const int t = idx >> 7, d = idx & 127;
        kb[t * 130 + d] = f2bf(qk_act(p, ui.seqrow0, ui.T, ui.c * 128 + t, 512 + h * 128 + d) * 0.08838834764831845f);
      }
      for (int idx = tid; idx < 2048; idx += NTHR) {
        const int tq = idx >> 7, d = idx & 127;
        qb[idx] = bf2f(f2bf(qk_act(p, ui.seqrow0, ui.T, ui.c * 128 + qs * 16 + tq, h * 128 + d)));
      }
      __syncthreads();
      if (tid == 0) {
        float b = 0.f, pm = -3.0e38f;
        for (int t = 0; t < 128; ++t) { b += lff[t]; bfw[t] = b; float g = igf[t] - b; gf[t] = g; pm = fmaxf(pm, g); pmf[t] = pm; }
      } else if (tid == 64) {
        float b = 0.f, pm = -3.0e38f;
        for (int t = 127; t >= 0; --t) { b += lfb[t]; bbw[t] = b; float g = igb[t] - b; gb[t] = g; pm = fmaxf(pm, g); pmb[t] = pm; }
      }
      __syncthreads();
      const size_t cif = (size_t)u * 2, cib = (size_t)u * 2 + 1;
      const float minf_ = p.MIN_[cif], minb_ = p.MIN_[cib];
      for (int idx = tid; idx < 2048; idx += NTHR) {
        const int tq = idx >> 7, s = idx & 127, t = qs * 16 + tq;
        float sv = 0.f;
        for (int d = 0; d < 128; ++d) sv += qb[tq * 128 + d] * bf2f(kb[s * 130 + d]);
        const float Mf = fmaxf(minf_, pmf[t]), Mb = fmaxf(minb_, pmb[t]);
        Pf[idx] = s <= t ? sv * __expf(gf[s] - Mf) : 0.f;
        Pb[idx] = s >= t ? sv * __expf(gb[s] - Mb) : 0.f;
      }
      __syncthreads();
      if (tid < 32) {
        const int dir = tid >> 4, tq = tid & 15, t = qs * 16 + tq;
        const float* Pp = dir ? Pb : Pf;
        float s1 = 0.f, s2 = 0.f;
        for (int s = 0; s < 128; ++s) s1 += Pp[tq * 128 + s];
        const float* nin = p.NIN + (dir ? cib : cif) * 128;
        for (int k = 0; k < 128; ++k) s2 += nin[k] * qb[tq * 128 + k];
        const float mi = dir ? minb_ : minf_;
        const float M = fmaxf(mi, dir ? pmb[t] : pmf[t]);
        const float dd = s1 + __expf(mi - M) * s2;
        const float mt = (dir ? bbw[t] : bfw[t]) + M;
        den[dir * 16 + tq] = fmaxf(fabsf(dd), __expf(-mt));
      }
      __syncthreads();
      {
        const int v = tid & 127, tg = tid >> 7;
        float nf[8], nbk[8], cf[8], cb[8];
#pragma unroll
        for (int i = 0; i < 8; ++i) { nf[i] = 0.f; nbk[i] = 0.f; cf[i] = 0.f; cb[i] = 0.f; }
        for (int s = 0; s < 128; ++s) {
          const float vv = bf2f(p.pl[(size_t)(ui.row0 + s) * LDP + 1024 + h * 128 + v]);
#pragma unroll
          for (int i = 0; i < 8; ++i) { nf[i] += Pf[(tg * 8 + i) * 128 + s] * vv; nbk[i] += Pb[(tg * 8 + i) * 128 + s] * vv; }
        }
        const bf16_t* Cf = p.CIN + cif * 16384 + v * 128;
        const bf16_t* Cb = p.CIN + cib * 16384 + v * 128;
        for (int k = 0; k < 128; ++k) {
          const float c1 = bf2f(Cf[k]), c2 = bf2f(Cb[k]);
#pragma unroll
          for (int i = 0; i < 8; ++i) { const float qv = qb[(tg * 8 + i) * 128 + k]; cf[i] += c1 * qv; cb[i] += c2 * qv; }
        }
#pragma unroll
        for (int i = 0; i < 8; ++i) {
          const int tq = tg * 8 + i, t = qs * 16 + tq;
          const float Mf = fmaxf(minf_, pmf[t]), Mb = fmaxf(minb_, pmb[t]);
          const float hf = (nf[i] + __expf(minf_ - Mf) * cf[i]) / den[tq];
          const float hb = (nbk[i] + __expf(minb_ - Mb) * cb[i]) / den[16 + tq];
          hs[tq * 128 + v] = hf + hb;
        }
      }
      __syncthreads();
      {
        const int wave = tid >> 6, lane = tid & 63;
        for (int i = 0; i < 4; ++i) {
          const int tq = wave * 4 + i;
          const float a0 = hs[tq * 128 + lane], a1 = hs[tq * 128 + 64 + lane];
          const float mu = wave_sum(a0 + a1) * (1.f / 128.f);
          const float d0 = a0 - mu, d1 = a1 - mu;
          const float var = wave_sum(d0 * d0 + d1 * d1) * (1.f / 128.f);
          const float rs = rsqrtf(var + 1e-6f);
          bf16_t* op = p.pl + (size_t)(ui.row0 + qs * 16 + tq) * LDP + 1536 + h * 128;
          const float o0 = bf2f(op[lane]), o1 = bf2f(op[64 + lane]);
          op[lane] = f2bf(d0 * rs * p.head_norm_w[h * 128 + lane] / (1.f + __expf(-o0)));
          op[64 + lane] = f2bf(d1 * rs * p.head_norm_w[h * 128 + 64 + lane] / (1.f + __expf(-o1)));
        }
      }
      __syncthreads();
    } else {
      const int pu = it - 4096, grp = pu >> 2, g = pu & 3;
      float* us = (float*)smem;
      float* dd = us + 8192;
      const int w = 2 << g;
      const size_t rbase = (size_t)grp * 64;
      for (int idx = tid; idx < 8192; idx += NTHR) {
        const int t = idx >> 7, i = idx & 127;
        us[idx] = bf2f(p.pl[(rbase + t) * LDP + 2048 + g * 128 + i]);
      }
      __syncthreads();
      for (int idx = tid; idx < 8192; idx += NTHR) {
        const int t = idx >> 7, i = idx & 127;
        int lo = t - w / 2, hi = t - w / 2 + w;
        lo = lo < 0 ? 0 : lo; hi = hi > 64 ? 64 : hi;
        float s = 0.f;
        for (int j = lo; j < hi; ++j) s += us[j * 128 + i];
        dd[idx] = s / (float)(hi - lo) - us[idx];
      }
      __syncthreads();
      {
        const int o = tid & 127, tg = tid >> 7;
        float acc[32];
#pragma unroll
        for (int i = 0; i < 32; ++i) acc[i] = 0.f;
        for (int i = 0; i < 128; ++i) {
          const float wv = p.pool_w[(size_t)(g * 128 + i) * 128 + o];
#pragma unroll
          for (int tt = 0; tt < 32; ++tt) acc[tt] += dd[(tg * 32 + tt) * 128 + i] * wv;
        }
        const float ps = p.pool_scale[g * 128 + o];
#pragma unroll
        for (int tt = 0; tt < 32; ++tt) p.pl[(rbase + tg * 32 + tt) * LDP + 2048 + g * 128 + o] = f2bf(acc[tt] * ps);
      }
      __syncthreads();
    }
  }
}

__device__ __forceinline__ void ph9_topk(const P& p, int bid, int nb, char* smem) {
  float* qs = (float*)smem;
  float* sc = qs + 256;
  float* sv = sc + 256;
  int* si = (int*)(sv + 32);
  const int tid = threadIdx.x, lane = tid & 63, wave = tid >> 6;
  for (int it = bid; it < TL * 8; it += nb) {
    const int tok = it >> 3, h = it & 7;
    qs[tid] = bf2f(p.pl[(size_t)tok * 2048 + h * 256 + tid]);
    __syncthreads();
    {
      const int pp = tid >> 7, n = tid & 127;
      const bf16_t* kr = p.keys_bf + ((size_t)(h * 2 + pp) * 128 + n) * 128;
      const float* qq = qs + pp * 128;
      float s = 0.f;
      for (int d8 = 0; d8 < 16; ++d8) {
        const uint4 k4 = *(const uint4*)(kr + d8 * 8);
        const unsigned kw[4] = {k4.x, k4.y, k4.z, k4.w};
#pragma unroll
        for (int i = 0; i < 4; ++i) s += qq[d8 * 8 + 2 * i] * __uint_as_float(kw[i] << 16) + qq[d8 * 8 + 2 * i + 1] * __uint_as_float(kw[i] & 0xffff0000u);
      }
      sc[tid] = s;
    }
    __syncthreads();
    if (wave < 2) {
      float v0 = sc[wave * 128 + lane], v1 = sc[wave * 128 + 64 + lane];
      for (int r = 0; r < 16; ++r) {
        float bv; int bi;
        if (v0 >= v1) { bv = v0; bi = lane; } else { bv = v1; bi = lane + 64; }
#pragma unroll
        for (int o = 32; o > 0; o >>= 1) {
          const float ov = __shfl_xor(bv, o); const int oi = __shfl_xor(bi, o);
          if (ov > bv || (ov == bv && oi < bi)) { bv = ov; bi = oi; }
        }
        if (lane == 0) { sv[wave * 16 + r] = bv; si[wave * 16 + r] = bi; }
        if (bi == lane) v0 = -3.0e38f;
        if (bi == lane + 64) v1 = -3.0e38f;
      }
    }
    __syncthreads();
    if (wave == 0) {
      float cv[4];
#pragma unroll
      for (int j = 0; j < 4; ++j) { const int c = j * 64 + lane; cv[j] = sv[c >> 4] + sv[16 + (c & 15)]; }
      float myv = 0.f; int myc = 0;
      for (int r = 0; r < 16; ++r) {
        float bv = cv[0]; int bi = lane;
#pragma unroll
        for (int j = 1; j < 4; ++j) if (cv[j] > bv) { bv = cv[j]; bi = j * 64 + lane; }
#pragma unroll
        for (int o = 32; o > 0; o >>= 1) {
          const float ov = __shfl_xor(bv, o); const int oi = __shfl_xor(bi, o);
          if (ov > bv || (ov == bv && oi < bi)) { bv = ov; bi = oi; }
        }
        if (lane == r) { myv = bv; myc = bi; }
#pragma unroll
        for (int j = 0; j < 4; ++j) if (bi == j * 64 + lane) cv[j] = -3.0e38f;
      }
      const float mx = __shfl(myv, 0);
      float e = lane < 16 ? __expf(myv - mx) : 0.f;
      const float tot = wave_sum(e);
      if (lane < 16) {
        p.eidx[(size_t)tok * 128 + h * 16 + lane] = si[myc >> 4] * 128 + si[16 + (myc & 15)];
        p.gate[(size_t)tok * 128 + h * 16 + lane] = e / tot;
      }
    }
    __syncthreads();
  }
}

__device__ __forceinline__ void ph10_gather(const P& p, int bid, int nb) {
  const int wave = threadIdx.x >> 6, lane = threadIdx.x & 63;
  for (int tok = bid * 4 + wave; tok < TL; tok += nb * 4) {
    const int b = tok / SEQ;
    float xv[16], y[16];
#pragma unroll
    for (int j = 0; j < 4; ++j) {
      const uint2 hv = *(const uint2*)(p.hn + (size_t)tok * 1024 + j * 256 + lane * 4);
      xv[j * 4 + 0] = __uint_as_float(hv.x << 16); xv[j * 4 + 1] = __uint_as_float(hv.x & 0xffff0000u);
      xv[j * 4 + 2] = __uint_as_float(hv.y << 16); xv[j * 4 + 3] = __uint_as_float(hv.y & 0xffff0000u);
      y[j * 4 + 0] = 0.f; y[j * 4 + 1] = 0.f; y[j * 4 + 2] = 0.f; y[j * 4 + 3] = 0.f;
    }
    for (int pk = 0; pk < 128; ++pk) {
      const int e = p.eidx[(size_t)tok * 128 + pk];
      const float g = p.gate[(size_t)tok * 128 + pk];
      const float4* ur = (const float4*)(p.U + (size_t)e * 1024);
      float a = 0.f;
#pragma unroll
      for (int j = 0; j < 4; ++j) {
        const float4 uu = ur[j * 64 + lane];
        a += uu.x * xv[j * 4] + uu.y * xv[j * 4 + 1] + uu.z * xv[j * 4 + 2] + uu.w * xv[j * 4 + 3];
      }
      a = wave_sum(a);
      const float w = 0.5f * a * (1.f + erff(a * 0.70710678118654752f)) * g;
      const float4* vr = (const float4*)(p.V + (size_t)e * 1024);
#pragma unroll
      for (int j = 0; j < 4; ++j) {
        const float4 vv = vr[j * 64 + lane];
        y[j * 4] += w * vv.x; y[j * 4 + 1] += w * vv.y; y[j * 4 + 2] += w * vv.z; y[j * 4 + 3] += w * vv.w;
      }
    }
    float* orow = p.out + (size_t)tok * 1024;
    const float* g2 = p.mod + b * 6144 + 5 * 1024;
    float z[16];
    float ss = 0.f;
#pragma unroll
    for (int j = 0; j < 4; ++j) {
      const int col = j * 256 + lane * 4;
      const float4 xl = *(const float4*)(orow + col);
      const float4 gg = *(const float4*)(g2 + col);
      z[j * 4] = xl.x + gg.x * y[j * 4]; z[j * 4 + 1] = xl.y + gg.y * y[j * 4 + 1];
      z[j * 4 + 2] = xl.z + gg.z * y[j * 4 + 2]; z[j * 4 + 3] = xl.w + gg.w * y[j * 4 + 3];
      ss += z[j * 4] * z[j * 4] + z[j * 4 + 1] * z[j * 4 + 1] + z[j * 4 + 2] * z[j * 4 + 2] + z[j * 4 + 3] * z[j * 4 + 3];
    }
    ss = wave_sum(ss);
    const float rstd = rsqrtf(ss * (1.f / 1024.f) + 1e-6f);
#pragma unroll
    for (int j = 0; j < 4; ++j) {
      const int col = j * 256 + lane * 4;
      const float4 fw = *(const float4*)(p.final_norm_w + col);
      float4 o;
      o.x = z[j * 4] * rstd * fw.x; o.y = z[j * 4 + 1] * rstd * fw.y; o.z = z[j * 4 + 2] * rstd * fw.z; o.w = z[j * 4 + 3] * rstd * fw.w;
      *(float4*)(orow + col) = o;
    }
  }
}

__global__ void __launch_bounds__(NTHR, 2) mega(P p) {
  __shared__ __attribute__((aligned(16))) char smem[73728];
  cg::grid_group grid = cg::this_grid();
  const int bid = blockIdx.x, nb = gridDim.x;
#define RUN(k, call) if ((PHMASK & (1 << k)) && p.ph_lo <= k && k < p.ph_hi) { call; if (k + 1 < p.ph_hi) grid.sync(); }
  RUN(0, ph0_prep(p, bid, nb, smem))
  RUN(1, ph_norm_rows<0>(p, bid, nb))
  RUN(2, ph_gemm<0>(p, bid, nb, smem))
  RUN(3, ph3_chunk_local(p, bid, nb, smem))
  RUN(4, ph4_scan(p, bid, nb))
  RUN(5, ph5_mlstm_out(p, bid, nb, smem))
  RUN(6, ph_gemm<1>(p, bid, nb, smem))
  RUN(7, ph_norm_rows<1>(p, bid, nb))
  RUN(8, ph_gemm<2>(p, bid, nb, smem))
  RUN(9, ph9_topk(p, bid, nb, smem))
  RUN(10, ph10_gather(p, bid, nb))
#undef RUN
}

extern "C" void kernel_launch(void* const* d_in, const int* in_sizes, int n_in, void* d_out, int out_size, void* d_ws, size_t ws_size,
                              hipStream_t stream) {
  static int grid_blocks = 0;
  if (!grid_blocks) {
    int dev = 0, cus = 0, per_cu = 0;
    hipGetDevice(&dev);
    hipDeviceGetAttribute(&cus, hipDeviceAttributeMultiprocessorCount, dev);
    hipOccupancyMaxActiveBlocksPerMultiprocessor(&per_cu, (const void*)mega, NTHR, 0);
    if (per_cu > 2) per_cu = 2;
    if (per_cu < 1) per_cu = 1;
    grid_blocks = cus * per_cu;
    if (ws_size < WS_END) fprintf(stderr, "kernel_launch: workspace too small: %zu < %llu\n", ws_size, (unsigned long long)WS_END);
  }
  P p{};
  const float* const* in = (const float* const*)d_in;
  p.x = in[0]; p.c = in[1]; p.ctx = in[2]; p.c_ctx = in[3]; p.w_mod = in[4]; p.b_mod = in[5]; p.norm1_w = in[6]; p.w_in = in[7];
  p.conv_w = in[8]; p.conv_b = in[9]; p.b_gates = in[10]; p.head_norm_w = in[11]; p.pool_w = in[12]; p.pool_scale = in[13];
  p.w_out = in[14]; p.norm2_w = in[15]; p.wq = in[16]; p.keys = in[17]; p.U = in[18]; p.V = in[19]; p.final_norm_w = in[20];
  p.out = (float*)d_out;
  char* ws = (char*)d_ws;
  p.mod = (float*)(ws + OFF_MOD); p.gates = (float*)(ws + OFF_GATES);
  p.wt_in = (bf16_t*)(ws + OFF_WTIN); p.wt_out = (bf16_t*)(ws + OFF_WTOUT); p.wt_q = (bf16_t*)(ws + OFF_WTQ);
  p.keys_bf = (bf16_t*)(ws + OFF_KEYS); p.hn = (bf16_t*)(ws + OFF_HN); p.pl = (bf16_t*)(ws + OFF_PL);
  p.Dst = (bf16_t*)(ws + OFF_D); p.ND = (float*)(ws + OFF_ND); p.SC = (float*)(ws + OFF_SC);
  p.CIN = (bf16_t*)(ws + OFF_CIN); p.NIN = (float*)(ws + OFF_NIN); p.MIN_ = (float*)(ws + OFF_MIN);
  p.eidx = (int*)(ws + OFF_EIDX); p.gate = (float*)(ws + OFF_GATE);
#if N_LAUNCHES == 1
  p.ph_lo = 0; p.ph_hi = NPH;
  void* args[] = {&p};
  hipError_t e = hipLaunchCooperativeKernel((const void*)mega, dim3(grid_blocks), dim3(NTHR), args, 0, stream);
  if (e != hipSuccess) fprintf(stderr, "cooperative launch failed: %s (grid %d)\n", hipGetErrorString(e), grid_blocks);
#else
  for (int ph = 0; ph < NPH; ++ph) {
    p.ph_lo = ph; p.ph_hi = ph + 1;
    void* args[] = {&p};
    hipError_t e = hipLaunchCooperativeKernel((const void*)mega, dim3(grid_blocks), dim3(NTHR), args, 0, stream);
    if (e != hipSuccess) fprintf(stderr, "launch %d failed: %s (grid %d)\n", ph, hipGetErrorString(e), grid_blocks);
  }
#endif
}
```

```cpp
#include <hip/hip_runtime.h>
#include <hip/hip_cooperative_groups.h>
#include <stdint.h>
#include <stdio.h>
namespace cg = cooperative_groups;

#ifndef PHMASK
#define PHMASK 0x7ff
#endif
#ifndef N_LAUNCHES
#define N_LAUNCHES 1
#endif

typedef unsigned short bf16_t;
typedef short bf16x8 __attribute__((ext_vector_type(8)));
typedef float f32x4 __attribute__((ext_vector_type(4)));
typedef unsigned u32x4 __attribute__((ext_vector_type(4)));
typedef unsigned u32x2 __attribute__((ext_vector_type(2)));
typedef __bf16 bf16x2 __attribute__((ext_vector_type(2)));

#define NB 8
#define SEQ 2048
#define DM 1024
#define CTXL 256
#define TL 16384
#define TC 2048
#define TR 18432
#define LDP 2576
#define NPADIN 2688
#define NTHR 256
#define NPH 11

#define OFF_MOD    (4096ull)
#define OFF_GATES  (OFF_MOD + 262144ull)
#define OFF_WTIN   (OFF_GATES + 1179648ull)
#define OFF_WTOUT  (OFF_WTIN + 5505024ull)
#define OFF_WTQ    (OFF_WTOUT + 2097152ull)
#define OFF_KEYS   (OFF_WTQ + 4194304ull)
#define OFF_POOLWT (OFF_KEYS + 524288ull)
#define OFF_HN     (OFF_POOLWT + 131072ull)
#define OFF_PL     (OFF_HN + 37748736ull)
#define OFF_D      (OFF_PL + 94961664ull)
#define OFF_ND     (OFF_D + 37748736ull)
#define OFF_SC     (OFF_ND + 589824ull)
#define OFF_CIN    (OFF_SC + 16384ull)
#define OFF_NIN    (OFF_CIN + 33554432ull)
#define OFF_MIN    (OFF_NIN + 524288ull)
#define OFF_EIDX   (OFF_MIN + 8192ull)
#define OFF_GATE   (OFF_EIDX + 8388608ull)
#define WS_END     (OFF_GATE + 8388608ull)

struct P {
  const float *x, *c, *ctx, *c_ctx, *w_mod, *b_mod, *norm1_w, *w_in, *conv_w, *conv_b, *b_gates, *head_norm_w,
      *pool_w, *pool_scale, *w_out, *norm2_w, *wq, *keys, *U, *V, *final_norm_w;
  float* out;
  float* mod;
  float* gates;
  bf16_t* wt_in;
  bf16_t* wt_out;
  bf16_t* wt_q;
  bf16_t* keys_bf;
  bf16_t* hn;
  bf16_t* pl;
  bf16_t* Dst;
  float* ND;
  float* SC;
  bf16_t* CIN;
  float* NIN;
  float* MIN_;
  bf16_t* Ubf;
  bf16_t* Vbf;
  int* eidx;
  float* gate;
  int ph_lo, ph_hi;
};

__device__ __forceinline__ bf16_t f2bf(float f) {
  unsigned u = __float_as_uint(f);
  u += 0x7fffu + ((u >> 16) & 1u);
  return (bf16_t)(u >> 16);
}
__device__ __forceinline__ float bf2f(bf16_t h) { return __uint_as_float(((unsigned)h) << 16); }
__device__ __forceinline__ float wave_sum(float v) {
#pragma unroll
  for (int o = 32; o > 0; o >>= 1) v += __shfl_xor(v, o);
  return v;
}
__device__ __forceinline__ float silu_f(float v) { return v / (1.f + __expf(-v)); }
__device__ __forceinline__ float logsig_f(float v) { return fminf(v, 0.f) - log1pf(__expf(-fabsf(v))); }

__device__ __forceinline__ void ph0_prep(const P& p, int bid, int nb, char* smem) {
  float* sm = (float*)smem;
  const int tid = threadIdx.x;
  const int N_MOD = 24, N_TIN = 16 * 42, N_TOUT = 256, N_TQ = 16 * 32, N_POOL = 16, N_KEYS = 64;
  const int total = N_MOD + N_TIN + N_TOUT + N_TQ + N_POOL + N_KEYS;
  for (int it = bid; it < total; it += nb) {
    int r = it;
    if (r < N_MOD) {
      for (int i = tid; i < 9 * 1024; i += NTHR) {
        int rr = i >> 10, k = i & 1023;
        float v = rr < 8 ? p.c[rr * 1024 + k] : p.c_ctx[k];
        sm[i] = silu_f(v);
      }
      __syncthreads();
      int n = r * 256 + tid;
      float acc[9];
#pragma unroll
      for (int q = 0; q < 9; ++q) acc[q] = p.b_mod[n];
#pragma unroll 4
      for (int k = 0; k < 1024; ++k) {
        float w = p.w_mod[(size_t)k * 6144 + n];
#pragma unroll
        for (int q = 0; q < 9; ++q) acc[q] += sm[q * 1024 + k] * w;
      }
#pragma unroll
      for (int q = 0; q < 9; ++q) p.mod[q * 6144 + n] = acc[q];
      __syncthreads();
      continue;
    }
    r -= N_MOD;
    const float* src = nullptr; bf16_t* dst = nullptr; int K = 1024, N = 0, ntn = 0;
    bool is_t = false;
    if (r < N_TIN) { src = p.w_in; dst = p.wt_in; N = 2576; ntn = 42; is_t = true; }
    else { r -= N_TIN;
      if (r < N_TOUT) { src = p.w_out; dst = p.wt_out; N = 1024; ntn = 16; is_t = true; }
      else { r -= N_TOUT;
        if (r < N_TQ) { src = p.wq; dst = p.wt_q; N = 2048; ntn = 32; is_t = true; }
        else { r -= N_TQ;
          if (r < N_POOL) { int g = r >> 2; r &= 3; src = p.pool_w + g * 16384; dst = (bf16_t*)((char*)p.keys_bf + 524288) + g * 16384; K = 128; N = 128; ntn = 2; is_t = true; }
          else { r -= N_POOL; }
        }
      }
    }
    if (is_t) {
      int kt = r / ntn, nt = r % ntn, k0 = kt * 64, n0 = nt * 64;
      int cc = tid & 63;
      for (int rr = tid >> 6; rr < 64; rr += 4) {
        int n = n0 + cc;
        sm[rr * 65 + cc] = n < N ? src[(size_t)(k0 + rr) * N + n] : 0.f;
      }
      __syncthreads();
      for (int rr = tid >> 6; rr < 64; rr += 4) dst[(size_t)(n0 + rr) * K + k0 + cc] = f2bf(sm[cc * 65 + rr]);
      __syncthreads();
    } else {
      for (int i = tid; i < 4096; i += NTHR) p.keys_bf[r * 4096 + i] = f2bf(p.keys[r * 4096 + i]);
    }
  }
}

template <int WHICH>
__device__ __forceinline__ void ph_norm_rows(const P& p, int bid, int nb) {
  const int wave = threadIdx.x >> 6, lane = threadIdx.x & 63;
  const int nrows = WHICH == 0 ? TR : TL;
  for (int row = bid * 4 + wave; row < nrows; row += nb * 4) {
    const float* src = WHICH == 0 ? (row < TL ? p.x + (size_t)row * 1024 : p.ctx + (size_t)(row - TL) * 1024) : p.out + (size_t)row * 1024;
    const int mr = row < TL ? row / SEQ : 8;
    float4 v[4];
    float ss = 0.f;
#pragma unroll
    for (int j = 0; j < 4; ++j) {
      v[j] = ((const float4*)src)[j * 64 + lane];
      ss += v[j].x * v[j].x + v[j].y * v[j].y + v[j].z * v[j].z + v[j].w * v[j].w;
    }
    ss = wave_sum(ss);
    const float rstd = rsqrtf(ss * (1.f / 1024.f) + 1e-6f);
    const float* nw = WHICH == 0 ? p.norm1_w : p.norm2_w;
    const float* sh = p.mod + mr * 6144 + (WHICH == 0 ? 0 : 3) * 1024;
    const float* sc = sh + 1024;
#pragma unroll
    for (int j = 0; j < 4; ++j) {
      const int col = j * 256 + lane * 4;
      float4 w4 = *(const float4*)(nw + col), s4 = *(const float4*)(sh + col), c4 = *(const float4*)(sc + col);
      float y0 = v[j].x * rstd * w4.x * (1.f + c4.x) + s4.x;
      float y1 = v[j].y * rstd * w4.y * (1.f + c4.y) + s4.y;
      float y2 = v[j].z * rstd * w4.z * (1.f + c4.z) + s4.z;
      float y3 = v[j].w * rstd * w4.w * (1.f + c4.w) + s4.w;
      uint2 o;
      o.x = (unsigned)f2bf(y0) | ((unsigned)f2bf(y1) << 16);
      o.y = (unsigned)f2bf(y2) | ((unsigned)f2bf(y3) << 16);
      *(uint2*)(p.hn + (size_t)row * 1024 + col) = o;
    }
  }
}

#define GBK 64
#define GLD 72
template <int EPI>
__device__ __forceinline__ void gemm_tile(const P& p, const bf16_t* A, int lda, const bf16_t* Bt, int m0, int n0, bf16_t* sA, bf16_t* sB) {
  const int tid = threadIdx.x, lane = tid & 63, wave = tid >> 6;
  const int wm = wave >> 1, wn = wave & 1;
  const int lr = lane & 15, lq = lane >> 4;
  f32x4 acc[4][4];
#pragma unroll
  for (int i = 0; i < 4; ++i)
#pragma unroll
    for (int j = 0; j < 4; ++j) acc[i][j] = (f32x4){0.f, 0.f, 0.f, 0.f};
  const int sr = tid >> 3, scol = (tid & 7) * 8;
  u32x4 ra[4], rb[4];
  const bf16_t* Ap = A + (size_t)(m0 + sr) * lda + scol;
  const bf16_t* Bp = Bt + (size_t)(n0 + sr) * 1024 + scol;
#pragma unroll
  for (int i = 0; i < 4; ++i) {
    ra[i] = *(const u32x4*)(Ap + (size_t)(i * 32) * lda);
    rb[i] = *(const u32x4*)(Bp + (size_t)(i * 32) * 1024);
  }
  for (int kt = 0; kt < 1024 / GBK; ++kt) {
    __syncthreads();
#pragma unroll
    for (int i = 0; i < 4; ++i) {
      *(u32x4*)(sA + (sr + i * 32) * GLD + scol) = ra[i];
      *(u32x4*)(sB + (sr + i * 32) * GLD + scol) = rb[i];
    }
    __syncthreads();
    {
      const int k0 = (kt + 1 < 1024 / GBK ? kt + 1 : kt) * GBK;
#pragma unroll
      for (int i = 0; i < 4; ++i) {
        ra[i] = *(const u32x4*)(Ap + (size_t)(i * 32) * lda + k0);
        rb[i] = *(const u32x4*)(Bp + (size_t)(i * 32) * 1024 + k0);
      }
    }
#pragma unroll
    for (int ks = 0; ks < 2; ++ks) {
      bf16x8 af[4], bfr[4];
#pragma unroll
      for (int i = 0; i < 4; ++i) {
        af[i] = *(const bf16x8*)(sA + (wm * 64 + i * 16 + lr) * GLD + ks * 32 + lq * 8);
        bfr[i] = *(const bf16x8*)(sB + (wn * 64 + i * 16 + lr) * GLD + ks * 32 + lq * 8);
      }
#pragma unroll
      for (int i = 0; i < 4; ++i)
#pragma unroll
        for (int j = 0; j < 4; ++j) acc[i][j] = __builtin_amdgcn_mfma_f32_16x16x32_bf16(af[i], bfr[j], acc[i][j], 0, 0, 0);
    }
  }
#pragma unroll
  for (int i = 0; i < 4; ++i)
#pragma unroll
    for (int j = 0; j < 4; ++j)
#pragma unroll
      for (int e = 0; e < 4; ++e) {
        const int row = m0 + wm * 64 + i * 16 + lq * 4 + e;
        const int col = n0 + wn * 64 + j * 16 + lr;
        const float v = acc[i][j][e];
        if (EPI == 0) {
          if (col < 2560) p.pl[(size_t)row * LDP + col] = f2bf(v);
          else if (col < 2576) p.gates[(size_t)row * 16 + (col - 2560)] = v;
        } else if (EPI == 1) {
          const int b = row / SEQ;
          p.out[(size_t)row * 1024 + col] = p.x[(size_t)row * 1024 + col] + p.mod[b * 6144 + 2 * 1024 + col] * v;
        } else {
          p.pl[(size_t)row * 2048 + col] = f2bf(v);
        }
      }
}

template <int EPI>
__device__ __forceinline__ void ph_gemm(const P& p, int bid, int nb, char* smem) {
  bf16_t* sA = (bf16_t*)smem;
  bf16_t* sB = sA + 128 * GLD;
  const int ntn = EPI == 0 ? 21 : (EPI == 1 ? 8 : 16);
  const int ntm = EPI == 0 ? 144 : 128;
  const bf16_t* A = EPI == 0 ? p.hn : (EPI == 1 ? p.pl + 1536 : p.hn);
  const int lda = EPI == 1 ? LDP : 1024;
  const bf16_t* Bt = EPI == 0 ? p.wt_in : (EPI == 1 ? p.wt_out : p.wt_q);
  for (int t = bid; t < ntm * ntn; t += nb) {
    const int tm = t / ntn, tn = t % ntn;
    if (EPI == 0 && tm >= 128 && tn >= 12 && tn < 20) continue;
    gemm_tile<EPI>(p, A, lda, Bt, tm * 128, tn * 128, sA, sB);
  }
}

struct UnitInfo { int isctx, b, c, h, T, seqrow0, row0; };
__device__ __forceinline__ UnitInfo decode_unit(int u) {
  UnitInfo r;
  if (u < 512) { r.isctx = 0; r.b = u >> 6; r.c = (u >> 2) & 15; r.h = u & 3; r.T = SEQ; r.seqrow0 = r.b * SEQ; }
  else { int uu = u - 512; r.isctx = 1; r.b = uu >> 3; r.c = (uu >> 2) & 1; r.h = uu & 3; r.T = CTXL; r.seqrow0 = TL + r.b * CTXL; }
  r.row0 = r.seqrow0 + r.c * 128;
  return r;
}
__device__ __forceinline__ float qk_act(const P& p, int seqrow0, int T, int t, int col) {
  const bf16_t* base = p.pl + (size_t)(seqrow0 + t) * LDP + col;
  float r0 = t > 0 ? bf2f(base[-LDP]) : 0.f;
  float r1 = bf2f(base[0]);
  float r2 = t + 1 < T ? bf2f(base[LDP]) : 0.f;
  float y = p.conv_b[col] + r0 * p.conv_w[col] + r1 * p.conv_w[1024 + col] + r2 * p.conv_w[2048 + col];
  return silu_f(y);
}

__device__ __forceinline__ void ph3_chunk_local(const P& p, int bid, int nb, char* smem) {
  bf16_t* kb = (bf16_t*)smem;
  bf16_t* vb = kb + 16384;
  float* fa = (float*)(vb + 16384);
  float *igf = fa, *lff = fa + 128, *igb = fa + 256, *lfb = fa + 384, *ef = fa + 512, *eb = fa + 640, *scal = fa + 768;
  const int tid = threadIdx.x;
  for (int u = bid; u < 576; u += nb) {
    const UnitInfo ui = decode_unit(u);
    const int h = ui.h;
    if (tid < 128) {
      const float* g = p.gates + (size_t)(ui.row0 + tid) * 16;
      igf[tid] = g[h] + p.b_gates[h];
      lff[tid] = logsig_f(g[4 + h] + p.b_gates[4 + h]);
      igb[tid] = g[8 + h] + p.b_gates[8 + h];
      lfb[tid] = logsig_f(g[12 + h] + p.b_gates[12 + h]);
    }
    for (int idx = tid; idx < 16384; idx += NTHR) {
      const int t = idx >> 7, d = idx & 127;
      const float y = qk_act(p, ui.seqrow0, ui.T, ui.c * 128 + t, 512 + h * 128 + d) * 0.08838834764831845f;
      kb[idx] = f2bf(y);
      vb[idx] = p.pl[(size_t)(ui.row0 + t) * LDP + 1024 + h * 128 + d];
    }
    __syncthreads();
    if (tid == 0) {
      float b = 0.f, G = -3.0e38f;
      for (int t = 0; t < 128; ++t) { b += lff[t]; float g = igf[t] - b; ef[t] = g; G = fmaxf(G, g); }
      scal[0] = G; scal[1] = b;
    } else if (tid == 64) {
      float b = 0.f, G = -3.0e38f;
      for (int t = 127; t >= 0; --t) { b += lfb[t]; float g = igb[t] - b; eb[t] = g; G = fmaxf(G, g); }
      scal[2] = G; scal[3] = b;
    }
    __syncthreads();
    if (tid < 128) { ef[tid] = __expf(ef[tid] - scal[0]); }
    else { eb[tid - 128] = __expf(eb[tid - 128] - scal[2]); }
    __syncthreads();
#pragma unroll 1
    for (int dir = 0; dir < 2; ++dir) {
      const int tv = tid >> 4, tk = tid & 15;
      const float* ee = dir ? eb : ef;
      float af[8][8];
#pragma unroll
      for (int i = 0; i < 8; ++i)
#pragma unroll
        for (int j = 0; j < 8; ++j) af[i][j] = 0.f;
      for (int t = 0; t < 128; ++t) {
        float vv[8], kk[8];
        const uint4 v4 = *(const uint4*)(vb + t * 128 + tv * 8);
        const uint4 k4 = *(const uint4*)(kb + t * 128 + tk * 8);
        const unsigned vw[4] = {v4.x, v4.y, v4.z, v4.w}, kw[4] = {k4.x, k4.y, k4.z, k4.w};
#pragma unroll
        for (int i = 0; i < 4; ++i) {
          vv[2 * i] = __uint_as_float(vw[i] << 16); vv[2 * i + 1] = __uint_as_float(vw[i] & 0xffff0000u);
          kk[2 * i] = __uint_as_float(kw[i] << 16); kk[2 * i + 1] = __uint_as_float(kw[i] & 0xffff0000u);
        }
        const float e1 = ee[t];
#pragma unroll
        for (int i = 0; i < 8; ++i) {
          const float a1 = e1 * vv[i];
#pragma unroll
          for (int j = 0; j < 8; ++j) af[i][j] += a1 * kk[j];
        }
      }
      bf16_t* Df = p.Dst + (size_t)(u * 2 + dir) * 16384;
#pragma unroll
      for (int i = 0; i < 8; ++i) {
        uint4 o1;
        o1.x = (unsigned)f2bf(af[i][0]) | ((unsigned)f2bf(af[i][1]) << 16);
        o1.y = (unsigned)f2bf(af[i][2]) | ((unsigned)f2bf(af[i][3]) << 16);
        o1.z = (unsigned)f2bf(af[i][4]) | ((unsigned)f2bf(af[i][5]) << 16);
        o1.w = (unsigned)f2bf(af[i][6]) | ((unsigned)f2bf(af[i][7]) << 16);
        *(uint4*)(Df + (tv * 8 + i) * 128 + tk * 8) = o1;
      }
    }
    {
      const int dir = tid >> 7, k = tid & 127;
      const float* e = dir ? eb : ef;
      float s = 0.f;
      for (int t = 0; t < 128; ++t) s += e[t] * bf2f(kb[t * 128 + k]);
      p.ND[(size_t)(u * 2 + dir) * 128 + k] = s;
    }
    if (tid < 4) p.SC[(size_t)u * 4 + tid] = scal[tid];
    __syncthreads();
  }
}

__device__ __forceinline__ void ph4_scan(const P& p, int bid, int nb) {
  const int tid = threadIdx.x;
  for (int it = bid; it < 1024; it += nb) {
    const int combo = it >> 4, vblk = it & 15;
    const int b = combo >> 3, h = (combo >> 1) & 3, dir = combo & 1;
    const int v = vblk * 8 + (tid >> 5), k0 = (tid & 31) * 4;
    float C0 = 0.f, C1 = 0.f, C2 = 0.f, C3 = 0.f, nacc = 0.f, m = 0.f;
    for (int i = 0; i < 18; ++i) {
      int u;
      if (i < 2) { const int cc = dir == 0 ? i : 1 - i; u = 512 + b * 8 + cc * 4 + h; }
      else {
        const int lc = i - 2, c = dir == 0 ? lc : 15 - lc;
        u = b * 64 + c * 4 + h;
        const size_t ci = (size_t)u * 2 + dir;
        uint2 o;
        o.x = (unsigned)f2bf(C0) | ((unsigned)f2bf(C1) << 16);
        o.y = (unsigned)f2bf(C2) | ((unsigned)f2bf(C3) << 16);
        *(uint2*)(p.CIN + ci * 16384 + v * 128 + k0) = o;
        if (vblk == 0 && tid < 128) p.NIN[ci * 128 + tid] = nacc;
        if (vblk == 0 && tid == 0) p.MIN_[ci] = m;
      }
      const size_t di = (size_t)u * 2 + dir;
      const float G = p.SC[di * 2 + 0], bend = p.SC[di * 2 + 1];
      const float Mx = fmaxf(m, G);
      const float dec = __expf(m - Mx), inj = __expf(G - Mx);
      const uint2 d2 = *(const uint2*)(p.Dst + di * 16384 + v * 128 + k0);
      C0 = dec * C0 + inj * __uint_as_float(d2.x << 16);
      C1 = dec * C1 + inj * __uint_as_float(d2.x & 0xffff0000u);
      C2 = dec * C2 + inj * __uint_as_float(d2.y << 16);
      C3 = dec * C3 + inj * __uint_as_float(d2.y & 0xffff0000u);
      if (vblk == 0 && tid < 128) nacc = dec * nacc + inj * p.ND[di * 128 + tid];
      m = bend + Mx;
    }
  }
}

__device__ __forceinline__ void ph5_mlstm_out(const P& p, int bid, int nb, char* smem) {
  bf16_t* kb = (bf16_t*)smem;
  float* qb = (float*)(kb + 128 * 130);
  float* Pf = qb + 2048;
  float* Pb = Pf + 2048;
  float* fa = Pb + 2048;
  float *igf = fa, *lff = fa + 128, *igb = fa + 256, *lfb = fa + 384, *gf = fa + 512, *gb = fa + 640, *bfw = fa + 768, *bbw = fa + 896,
        *pmf = fa + 1024, *pmb = fa + 1152, *den = fa + 1280  ;
  float* hs = Pf;
  hs = fa + 1344;
  const int tid = threadIdx.x;
  for (int it = bid; it < 4096 + 1024; it += nb) {
    if (it < 4096) {
      const int u = it >> 3, qs = it & 7;
      const UnitInfo ui = decode_unit(u);
      const int h = ui.h;
      if (tid < 128) {
        const float* g = p.gates + (size_t)(ui.row0 + tid) * 16;
        igf[tid] = g[h] + p.b_gates[h];
        lff[tid] = logsig_f(g[4 + h] + p.b_gates[4 + h]);
        igb[tid] = g[8 + h] + p.b_gates[8 + h];
        lfb[tid] = logsig_f(g[12 + h] + p.b_gates[12 + h]);
      }
      for (int idx = tid; idx < 16384; idx += NTHR) {
        const int t = idx >> 7, d = idx & 127;
        kb[t * 130 + d] = f2bf(qk_act(p, ui.seqrow0, ui.T, ui.c * 128 + t, 512 + h * 128 + d) * 0.08838834764831845f);
      }
      for (int idx = tid; idx < 2048; idx += NTHR) {
        const int tq = idx >> 7, d = idx & 127;
        qb[idx] = bf2f(f2bf(qk_act(p, ui.seqrow0, ui.T, ui.c * 128 + qs * 16 + tq, h * 128 + d)));
      }
      __syncthreads();
      if (tid == 0) {
        float b = 0.f, pm = -3.0e38f;
        for (int t = 0; t < 128; ++t) { b += lff[t]; bfw[t] = b; float g = igf[t] - b; gf[t] = g; pm = fmaxf(pm, g); pmf[t] = pm; }
      } else if (tid == 64) {
        float b = 0.f, pm = -3.0e38f;
        for (int t = 127; t >= 0; --t) { b += lfb[t]; bbw[t] = b; float g = igb[t] - b; gb[t] = g; pm = fmaxf(pm, g); pmb[t] = pm; }
      }
      __syncthreads();
      const size_t cif = (size_t)u * 2, cib = (size_t)u * 2 + 1;
      const float minf_ = p.MIN_[cif], minb_ = p.MIN_[cib];
      for (int idx = tid; idx < 2048; idx += NTHR) {
        const int tq = idx >> 7, s = idx & 127, t = qs * 16 + tq;
        float sv = 0.f;
        for (int d = 0; d < 128; ++d) sv += qb[tq * 128 + d] * bf2f(kb[s * 130 + d]);
        const float Mf = fmaxf(minf_, pmf[t]), Mb = fmaxf(minb_, pmb[t]);
        Pf[idx] = s <= t ? sv * __expf(gf[s] - Mf) : 0.f;
        Pb[idx] = s >= t ? sv * __expf(gb[s] - Mb) : 0.f;
      }
      __syncthreads();
      if (tid < 32) {
        const int dir = tid >> 4, tq = tid & 15, t = qs * 16 + tq;
        const float* Pp = dir ? Pb : Pf;
        float s1 = 0.f, s2 = 0.f;
        for (int s = 0; s < 128; ++s) s1 += Pp[tq * 128 + s];
        const float* nin = p.NIN + (dir ? cib : cif) * 128;
        for (int k = 0; k < 128; ++k) s2 += nin[k] * qb[tq * 128 + k];
        const float mi = dir ? minb_ : minf_;
        const float M = fmaxf(mi, dir ? pmb[t] : pmf[t]);
        const float dd = s1 + __expf(mi - M) * s2;
        const float mt = (dir ? bbw[t] : bfw[t]) + M;
        den[dir * 16 + tq] = fmaxf(fabsf(dd), __expf(-mt));
      }
      __syncthreads();
      {
        const int v = tid & 127, tg = tid >> 7;
        float nf[8], nbk[8], cf[8], cb[8];
#pragma unroll
        for (int i = 0; i < 8; ++i) { nf[i] = 0.f; nbk[i] = 0.f; cf[i] = 0.f; cb[i] = 0.f; }
        for (int s = 0; s < 128; ++s) {
          const float vv = bf2f(p.pl[(size_t)(ui.row0 + s) * LDP + 1024 + h * 128 + v]);
#pragma unroll
          for (int i = 0; i < 8; ++i) { nf[i] += Pf[(tg * 8 + i) * 128 + s] * vv; nbk[i] += Pb[(tg * 8 + i) * 128 + s] * vv; }
        }
        const bf16_t* Cf = p.CIN + cif * 16384 + v * 128;
        const bf16_t* Cb = p.CIN + cib * 16384 + v * 128;
        for (int k = 0; k < 128; ++k) {
          const float c1 = bf2f(Cf[k]), c2 = bf2f(Cb[k]);
#pragma unroll
          for (int i = 0; i < 8; ++i) { const float qv = qb[(tg * 8 + i) * 128 + k]; cf[i] += c1 * qv; cb[i] += c2 * qv; }
        }
#pragma unroll
        for (int i = 0; i < 8; ++i) {
          const int tq = tg * 8 + i, t = qs * 16 + tq;
          const float Mf = fmaxf(minf_, pmf[t]), Mb = fmaxf(minb_, pmb[t]);
          const float hf = (nf[i] + __expf(minf_ - Mf) * cf[i]) / den[tq];
          const float hb = (nbk[i] + __expf(minb_ - Mb) * cb[i]) / den[16 + tq];
          hs[tq * 128 + v] = hf + hb;
        }
      }
      __syncthreads();
      {
        const int wave = tid >> 6, lane = tid & 63;
        for (int i = 0; i < 4; ++i) {
          const int tq = wave * 4 + i;
          const float a0 = hs[tq * 128 + lane], a1 = hs[tq * 128 + 64 + lane];
          const float mu = wave_sum(a0 + a1) * (1.f / 128.f);
          const float d0 = a0 - mu, d1 = a1 - mu;
          const float var = wave_sum(d0 * d0 + d1 * d1) * (1.f / 128.f);
          const float rs = rsqrtf(var + 1e-6f);
          bf16_t* op = p.pl + (size_t)(ui.row0 + qs * 16 + tq) * LDP + 1536 + h * 128;
          const float o0 = bf2f(op[lane]), o1 = bf2f(op[64 + lane]);
          op[lane] = f2bf(d0 * rs * p.head_norm_w[h * 128 + lane] / (1.f + __expf(-o0)));
          op[64 + lane] = f2bf(d1 * rs * p.head_norm_w[h * 128 + 64 + lane] / (1.f + __expf(-o1)));
        }
      }
      __syncthreads();
    } else {
      const int pu = it - 4096, grp = pu >> 2, g = pu & 3;
      float* us = (float*)smem;
      float* dd = us + 8192;
      const int w = 2 << g;
      const size_t rbase = (size_t)grp * 64;
      for (int idx = tid; idx < 8192; idx += NTHR) {
        const int t = idx >> 7, i = idx & 127;
        us[idx] = bf2f(p.pl[(rbase + t) * LDP + 2048 + g * 128 + i]);
      }
      __syncthreads();
      for (int idx = tid; idx < 8192; idx += NTHR) {
        const int t = idx >> 7, i = idx & 127;
        int lo = t - w / 2, hi = t - w / 2 + w;
        lo = lo < 0 ? 0 : lo; hi = hi > 64 ? 64 : hi;
        float s = 0.f;
        for (int j = lo; j < hi; ++j) s += us[j * 128 + i];
        dd[idx] = s / (float)(hi - lo) - us[idx];
      }
      __syncthreads();
      {
        const int o = tid & 127, tg = tid >> 7;
        float acc[32];
#pragma unroll
        for (int i = 0; i < 32; ++i) acc[i] = 0.f;
        for (int i = 0; i < 128; ++i) {
          const float wv = p.pool_w[(size_t)(g * 128 + i) * 128 + o];
#pragma unroll
          for (int tt = 0; tt < 32; ++tt) acc[tt] += dd[(tg * 32 + tt) * 128 + i] * wv;
        }
        const float ps = p.pool_scale[g * 128 + o];
#pragma unroll
        for (int tt = 0; tt < 32; ++tt) p.pl[(rbase + tg * 32 + tt) * LDP + 2048 + g * 128 + o] = f2bf(acc[tt] * ps);
      }
      __syncthreads();
    }
  }
}

#define SORT16(X) do { unsigned h_, l_; h_ = X[0] > X[1] ? X[0] : X[1]; l_ = X[0] > X[1] ? X[1] : X[0]; X[0] = h_; X[1] = l_; h_ = X[3] > X[2] ? X[3] : X[2]; l_ = X[3] > X[2] ? X[2] : X[3]; X[3] = h_; X[2] = l_; h_ = X[4] > X[5] ? X[4] : X[5]; l_ = X[4] > X[5] ? X[5] : X[4]; X[4] = h_; X[5] = l_; h_ = X[7] > X[6] ? X[7] : X[6]; l_ = X[7] > X[6] ? X[6] : X[7]; X[7] = h_; X[6] = l_; h_ = X[8] > X[9] ? X[8] : X[9]; l_ = X[8] > X[9] ? X[9] : X[8]; X[8] = h_; X[9] = l_; h_ = X[11] > X[10] ? X[11] : X[10]; l_ = X[11] > X[10] ? X[10] : X[11]; X[11] = h_; X[10] = l_; h_ = X[12] > X[13] ? X[12] : X[13]; l_ = X[12] > X[13] ? X[13] : X[12]; X[12] = h_; X[13] = l_; h_ = X[15] > X[14] ? X[15] : X[14]; l_ = X[15] > X[14] ? X[14] : X[15]; X[15] = h_; X[14] = l_; h_ = X[0] > X[2] ? X[0] : X[2]; l_ = X[0] > X[2] ? X[2] : X[0]; X[0] = h_; X[2] = l_; h_ = X[1] > X[3] ? X[1] : X[3]; l_ = X[1] > X[3] ? X[3] : X[1]; X[1] = h_; X[3] = l_; h_ = X[6] > X[4] ? X[6] : X[4]; l_ = X[6] > X[4] ? X[4] : X[6]; X[6] = h_; X[4] = l_; h_ = X[7] > X[5] ? X[7] : X[5]; l_ = X[7] > X[5] ? X[5] : X[7]; X[7] = h_; X[5] = l_; h_ = X[8] > X[10] ? X[8] : X[10]; l_ = X[8] > X[10] ? X[10] : X[8]; X[8] = h_; X[10] = l_; h_ = X[9] > X[11] ? X[9] : X[11]; l_ = X[9] > X[11] ? X[11] : X[9]; X[9] = h_; X[11] = l_; h_ = X[14] > X[12] ? X[14] : X[12]; l_ = X[14] > X[12] ? X[12] : X[14]; X[14] = h_; X[12] = l_; h_ = X[15] > X[13] ? X[15] : X[13]; l_ = X[15] > X[13] ? X[13] : X[15]; X[15] = h_; X[13] = l_; h_ = X[0] > X[1] ? X[0] : X[1]; l_ = X[0] > X[1] ? X[1] : X[0]; X[0] = h_; X[1] = l_; h_ = X[2] > X[3] ? X[2] : X[3]; l_ = X[2] > X[3] ? X[3] : X[2]; X[2] = h_; X[3] = l_; h_ = X[5] > X[4] ? X[5] : X[4]; l_ = X[5] > X[4] ? X[4] : X[5]; X[5] = h_; X[4] = l_; h_ = X[7] > X[6] ? X[7] : X[6]; l_ = X[7] > X[6] ? X[6] : X[7]; X[7] = h_; X[6] = l_; h_ = X[8] > X[9] ? X[8] : X[9]; l_ = X[8] > X[9] ? X[9] : X[8]; X[8] = h_; X[9] = l_; h_ = X[10] > X[11] ? X[10] : X[11]; l_ = X[10] > X[11] ? X[11] : X[10]; X[10] = h_; X[11] = l_; h_ = X[13] > X[12] ? X[13] : X[12]; l_ = X[13] > X[12] ? X[12] : X[13]; X[13] = h_; X[12] = l_; h_ = X[15] > X[14] ? X[15] : X[14]; l_ = X[15] > X[14] ? X[14] : X[15]; X[15] = h_; X[14] = l_; h_ = X[0] > X[4] ? X[0] : X[4]; l_ = X[0] > X[4] ? X[4] : X[0]; X[0] = h_; X[4] = l_; h_ = X[1] > X[5] ? X[1] : X[5]; l_ = X[1] > X[5] ? X[5] : X[1]; X[1] = h_; X[5] = l_; h_ = X[2] > X[6] ? X[2] : X[6]; l_ = X[2] > X[6] ? X[6] : X[2]; X[2] = h_; X[6] = l_; h_ = X[3] > X[7] ? X[3] : X[7]; l_ = X[3] > X[7] ? X[7] : X[3]; X[3] = h_; X[7] = l_; h_ = X[12] > X[8] ? X[12] : X[8]; l_ = X[12] > X[8] ? X[8] : X[12]; X[12] = h_; X[8] = l_; h_ = X[13] > X[9] ? X[13] : X[9]; l_ = X[13] > X[9] ? X[9] : X[13]; X[13] = h_; X[9] = l_; h_ = X[14] > X[10] ? X[14] : X[10]; l_ = X[14] > X[10] ? X[10] : X[14]; X[14] = h_; X[10] = l_; h_ = X[15] > X[11] ? X[15] : X[11]; l_ = X[15] > X[11] ? X[11] : X[15]; X[15] = h_; X[11] = l_; h_ = X[0] > X[2] ? X[0] : X[2]; l_ = X[0] > X[2] ? X[2] : X[0]; X[0] = h_; X[2] = l_; h_ = X[1] > X[3] ? X[1] : X[3]; l_ = X[1] > X[3] ? X[3] : X[1]; X[1] = h_; X[3] = l_; h_ = X[4] > X[6] ? X[4] : X[6]; l_ = X[4] > X[6] ? X[6] : X[4]; X[4] = h_; X[6] = l_; h_ = X[5] > X[7] ? X[5] : X[7]; l_ = X[5] > X[7] ? X[7] : X[5]; X[5] = h_; X[7] = l_; h_ = X[10] > X[8] ? X[10] : X[8]; l_ = X[10] > X[8] ? X[8] : X[10]; X[10] = h_; X[8] = l_; h_ = X[11] > X[9] ? X[11] : X[9]; l_ = X[11] > X[9] ? X[9] : X[11]; X[11] = h_; X[9] = l_; h_ = X[14] > X[12] ? X[14] : X[12]; l_ = X[14] > X[12] ? X[12] : X[14]; X[14] = h_; X[12] = l_; h_ = X[15] > X[13] ? X[15] : X[13]; l_ = X[15] > X[13] ? X[13] : X[15]; X[15] = h_; X[13] = l_; h_ = X[0] > X[1] ? X[0] : X[1]; l_ = X[0] > X[1] ? X[1] : X[0]; X[0] = h_; X[1] = l_; h_ = X[2] > X[3] ? X[2] : X[3]; l_ = X[2] > X[3] ? X[3] : X[2]; X[2] = h_; X[3] = l_; h_ = X[4] > X[5] ? X[4] : X[5]; l_ = X[4] > X[5] ? X[5] : X[4]; X[4] = h_; X[5] = l_; h_ = X[6] > X[7] ? X[6] : X[7]; l_ = X[6] > X[7] ? X[7] : X[6]; X[6] = h_; X[7] = l_; h_ = X[9] > X[8] ? X[9] : X[8]; l_ = X[9] > X[8] ? X[8] : X[9]; X[9] = h_; X[8] = l_; h_ = X[11] > X[10] ? X[11] : X[10]; l_ = X[11] > X[10] ? X[10] : X[11]; X[11] = h_; X[10] = l_; h_ = X[13] > X[12] ? X[13] : X[12]; l_ = X[13] > X[12] ? X[12] : X[13]; X[13] = h_; X[12] = l_; h_ = X[15] > X[14] ? X[15] : X[14]; l_ = X[15] > X[14] ? X[14] : X[15]; X[15] = h_; X[14] = l_; h_ = X[0] > X[8] ? X[0] : X[8]; l_ = X[0] > X[8] ? X[8] : X[0]; X[0] = h_; X[8] = l_; h_ = X[1] > X[9] ? X[1] : X[9]; l_ = X[1] > X[9] ? X[9] : X[1]; X[1] = h_; X[9] = l_; h_ = X[2] > X[10] ? X[2] : X[10]; l_ = X[2] > X[10] ? X[10] : X[2]; X[2] = h_; X[10] = l_; h_ = X[3] > X[11] ? X[3] : X[11]; l_ = X[3] > X[11] ? X[11] : X[3]; X[3] = h_; X[11] = l_; h_ = X[4] > X[12] ? X[4] : X[12]; l_ = X[4] > X[12] ? X[12] : X[4]; X[4] = h_; X[12] = l_; h_ = X[5] > X[13] ? X[5] : X[13]; l_ = X[5] > X[13] ? X[13] : X[5]; X[5] = h_; X[13] = l_; h_ = X[6] > X[14] ? X[6] : X[14]; l_ = X[6] > X[14] ? X[14] : X[6]; X[6] = h_; X[14] = l_; h_ = X[7] > X[15] ? X[7] : X[15]; l_ = X[7] > X[15] ? X[15] : X[7]; X[7] = h_; X[15] = l_; h_ = X[0] > X[4] ? X[0] : X[4]; l_ = X[0] > X[4] ? X[4] : X[0]; X[0] = h_; X[4] = l_; h_ = X[1] > X[5] ? X[1] : X[5]; l_ = X[1] > X[5] ? X[5] : X[1]; X[1] = h_; X[5] = l_; h_ = X[2] > X[6] ? X[2] : X[6]; l_ = X[2] > X[6] ? X[6] : X[2]; X[2] = h_; X[6] = l_; h_ = X[3] > X[7] ? X[3] : X[7]; l_ = X[3] > X[7] ? X[7] : X[3]; X[3] = h_; X[7] = l_; h_ = X[8] > X[12] ? X[8] : X[12]; l_ = X[8] > X[12] ? X[12] : X[8]; X[8] = h_; X[12] = l_; h_ = X[9] > X[13] ? X[9] : X[13]; l_ = X[9] > X[13] ? X[13] : X[9]; X[9] = h_; X[13] = l_; h_ = X[10] > X[14] ? X[10] : X[14]; l_ = X[10] > X[14] ? X[14] : X[10]; X[10] = h_; X[14] = l_; h_ = X[11] > X[15] ? X[11] : X[15]; l_ = X[11] > X[15] ? X[15] : X[11]; X[11] = h_; X[15] = l_; h_ = X[0] > X[2] ? X[0] : X[2]; l_ = X[0] > X[2] ? X[2] : X[0]; X[0] = h_; X[2] = l_; h_ = X[1] > X[3] ? X[1] : X[3]; l_ = X[1] > X[3] ? X[3] : X[1]; X[1] = h_; X[3] = l_; h_ = X[4] > X[6] ? X[4] : X[6]; l_ = X[4] > X[6] ? X[6] : X[4]; X[4] = h_; X[6] = l_; h_ = X[5] > X[7] ? X[5] : X[7]; l_ = X[5] > X[7] ? X[7] : X[5]; X[5] = h_; X[7] = l_; h_ = X[8] > X[10] ? X[8] : X[10]; l_ = X[8] > X[10] ? X[10] : X[8]; X[8] = h_; X[10] = l_; h_ = X[9] > X[11] ? X[9] : X[11]; l_ = X[9] > X[11] ? X[11] : X[9]; X[9] = h_; X[11] = l_; h_ = X[12] > X[14] ? X[12] : X[14]; l_ = X[12] > X[14] ? X[14] : X[12]; X[12] = h_; X[14] = l_; h_ = X[13] > X[15] ? X[13] : X[15]; l_ = X[13] > X[15] ? X[15] : X[13]; X[13] = h_; X[15] = l_; h_ = X[0] > X[1] ? X[0] : X[1]; l_ = X[0] > X[1] ? X[1] : X[0]; X[0] = h_; X[1] = l_; h_ = X[2] > X[3] ? X[2] : X[3]; l_ = X[2] > X[3] ? X[3] : X[2]; X[2] = h_; X[3] = l_; h_ = X[4] > X[5] ? X[4] : X[5]; l_ = X[4] > X[5] ? X[5] : X[4]; X[4] = h_; X[5] = l_; h_ = X[6] > X[7] ? X[6] : X[7]; l_ = X[6] > X[7] ? X[7] : X[6]; X[6] = h_; X[7] = l_; h_ = X[8] > X[9] ? X[8] : X[9]; l_ = X[8] > X[9] ? X[9] : X[8]; X[8] = h_; X[9] = l_; h_ = X[10] > X[11] ? X[10] : X[11]; l_ = X[10] > X[11] ? X[11] : X[10]; X[10] = h_; X[11] = l_; h_ = X[12] > X[13] ? X[12] : X[13]; l_ = X[12] > X[13] ? X[13] : X[12]; X[12] = h_; X[13] = l_; h_ = X[14] > X[15] ? X[14] : X[15]; l_ = X[14] > X[15] ? X[15] : X[14]; X[14] = h_; X[15] = l_; } while (0)
#define MERGE16(X) do { unsigned h_, l_; h_ = X[0] > X[8] ? X[0] : X[8]; l_ = X[0] > X[8] ? X[8] : X[0]; X[0] = h_; X[8] = l_; h_ = X[1] > X[9] ? X[1] : X[9]; l_ = X[1] > X[9] ? X[9] : X[1]; X[1] = h_; X[9] = l_; h_ = X[2] > X[10] ? X[2] : X[10]; l_ = X[2] > X[10] ? X[10] : X[2]; X[2] = h_; X[10] = l_; h_ = X[3] > X[11] ? X[3] : X[11]; l_ = X[3] > X[11] ? X[11] : X[3]; X[3] = h_; X[11] = l_; h_ = X[4] > X[12] ? X[4] : X[12]; l_ = X[4] > X[12] ? X[12] : X[4]; X[4] = h_; X[12] = l_; h_ = X[5] > X[13] ? X[5] : X[13]; l_ = X[5] > X[13] ? X[13] : X[5]; X[5] = h_; X[13] = l_; h_ = X[6] > X[14] ? X[6] : X[14]; l_ = X[6] > X[14] ? X[14] : X[6]; X[6] = h_; X[14] = l_; h_ = X[7] > X[15] ? X[7] : X[15]; l_ = X[7] > X[15] ? X[15] : X[7]; X[7] = h_; X[15] = l_; h_ = X[0] > X[4] ? X[0] : X[4]; l_ = X[0] > X[4] ? X[4] : X[0]; X[0] = h_; X[4] = l_; h_ = X[1] > X[5] ? X[1] : X[5]; l_ = X[1] > X[5] ? X[5] : X[1]; X[1] = h_; X[5] = l_; h_ = X[2] > X[6] ? X[2] : X[6]; l_ = X[2] > X[6] ? X[6] : X[2]; X[2] = h_; X[6] = l_; h_ = X[3] > X[7] ? X[3] : X[7]; l_ = X[3] > X[7] ? X[7] : X[3]; X[3] = h_; X[7] = l_; h_ = X[8] > X[12] ? X[8] : X[12]; l_ = X[8] > X[12] ? X[12] : X[8]; X[8] = h_; X[12] = l_; h_ = X[9] > X[13] ? X[9] : X[13]; l_ = X[9] > X[13] ? X[13] : X[9]; X[9] = h_; X[13] = l_; h_ = X[10] > X[14] ? X[10] : X[14]; l_ = X[10] > X[14] ? X[14] : X[10]; X[10] = h_; X[14] = l_; h_ = X[11] > X[15] ? X[11] : X[15]; l_ = X[11] > X[15] ? X[15] : X[11]; X[11] = h_; X[15] = l_; h_ = X[0] > X[2] ? X[0] : X[2]; l_ = X[0] > X[2] ? X[2] : X[0]; X[0] = h_; X[2] = l_; h_ = X[1] > X[3] ? X[1] : X[3]; l_ = X[1] > X[3] ? X[3] : X[1]; X[1] = h_; X[3] = l_; h_ = X[4] > X[6] ? X[4] : X[6]; l_ = X[4] > X[6] ? X[6] : X[4]; X[4] = h_; X[6] = l_; h_ = X[5] > X[7] ? X[5] : X[7]; l_ = X[5] > X[7] ? X[7] : X[5]; X[5] = h_; X[7] = l_; h_ = X[8] > X[10] ? X[8] : X[10]; l_ = X[8] > X[10] ? X[10] : X[8]; X[8] = h_; X[10] = l_; h_ = X[9] > X[11] ? X[9] : X[11]; l_ = X[9] > X[11] ? X[11] : X[9]; X[9] = h_; X[11] = l_; h_ = X[12] > X[14] ? X[12] : X[14]; l_ = X[12] > X[14] ? X[14] : X[12]; X[12] = h_; X[14] = l_; h_ = X[13] > X[15] ? X[13] : X[15]; l_ = X[13] > X[15] ? X[15] : X[13]; X[13] = h_; X[15] = l_; h_ = X[0] > X[1] ? X[0] : X[1]; l_ = X[0] > X[1] ? X[1] : X[0]; X[0] = h_; X[1] = l_; h_ = X[2] > X[3] ? X[2] : X[3]; l_ = X[2] > X[3] ? X[3] : X[2]; X[2] = h_; X[3] = l_; h_ = X[4] > X[5] ? X[4] : X[5]; l_ = X[4] > X[5] ? X[5] : X[4]; X[4] = h_; X[5] = l_; h_ = X[6] > X[7] ? X[6] : X[7]; l_ = X[6] > X[7] ? X[7] : X[6]; X[6] = h_; X[7] = l_; h_ = X[8] > X[9] ? X[8] : X[9]; l_ = X[8] > X[9] ? X[9] : X[8]; X[8] = h_; X[9] = l_; h_ = X[10] > X[11] ? X[10] : X[11]; l_ = X[10] > X[11] ? X[11] : X[10]; X[10] = h_; X[11] = l_; h_ = X[12] > X[13] ? X[12] : X[13]; l_ = X[12] > X[13] ? X[13] : X[12]; X[12] = h_; X[13] = l_; h_ = X[14] > X[15] ? X[14] : X[15]; l_ = X[14] > X[15] ? X[15] : X[14]; X[14] = h_; X[15] = l_; } while (0)

__device__ __forceinline__ unsigned f2ord(float f) { const unsigned u = __float_as_uint(f); return (u & 0x80000000u) ? ~u : (u | 0x80000000u); }
__device__ __forceinline__ float ord2f(unsigned o) { return __uint_as_float((o & 0x80000000u) ? (o & 0x7fffffffu) : ~o); }
#define CANDKEY(sum, c) ((f2ord(sum) & ~255u) | (255u - (unsigned)(c)))
__device__ __forceinline__ void xmerge16(unsigned (&X)[16], int mask) {
  unsigned T[16];
#pragma unroll
  for (int i = 0; i < 16; ++i) T[i] = (unsigned)__shfl_xor((int)X[15 - i], mask);
#pragma unroll
  for (int i = 0; i < 16; ++i) X[i] = X[i] > T[i] ? X[i] : T[i];
  MERGE16(X);
}

__device__ __forceinline__ void ph9_topk(const P& p, int bid, int nb, char* smem) {
  const int tid = threadIdx.x, lane = tid & 63, wave = tid >> 6, lr = lane & 15, lq = lane >> 4;
  int* idxs = (int*)smem + wave * 512;
  const int gw = bid * 4 + wave, ngw = nb * 4;
  for (int it = gw; it < 1024 * 8; it += ngw) {
    const int h = it & 7, tile = it >> 3;
    const int tok = tile * 16 + lr;
    unsigned R0[16], R1[16];
#pragma unroll
    for (int pp = 0; pp < 2; ++pp) {
      bf16x8 bq[4];
#pragma unroll
      for (int kk = 0; kk < 4; ++kk) bq[kk] = *(const bf16x8*)(p.pl + (size_t)tok * 2048 + h * 256 + pp * 128 + kk * 32 + lq * 8);
      f32x4 acc[8];
#pragma unroll
      for (int j = 0; j < 8; ++j) acc[j] = (f32x4){0.f, 0.f, 0.f, 0.f};
      const bf16_t* kb = p.keys_bf + (size_t)(h * 2 + pp) * 16384;
#pragma unroll
      for (int j = 0; j < 8; ++j)
#pragma unroll
        for (int kk = 0; kk < 4; ++kk) {
          const bf16x8 a = *(const bf16x8*)(kb + (j * 16 + lr) * 128 + kk * 32 + lq * 8);
          acc[j] = __builtin_amdgcn_mfma_f32_16x16x32_bf16(a, bq[kk], acc[j], 0, 0, 0);
        }
      unsigned X[16], Y[16];
#pragma unroll
      for (int j = 0; j < 4; ++j)
#pragma unroll
        for (int e = 0; e < 4; ++e) {
          X[j * 4 + e] = (f2ord(acc[j][e]) & ~127u) | (127u - (unsigned)(j * 16 + lq * 4 + e));
          Y[j * 4 + e] = (f2ord(acc[4 + j][e]) & ~127u) | (127u - (unsigned)((4 + j) * 16 + lq * 4 + e));
        }
      SORT16(X);
      SORT16(Y);
#pragma unroll
      for (int i = 0; i < 16; ++i) X[i] = X[i] > Y[15 - i] ? X[i] : Y[15 - i];
      MERGE16(X);
      xmerge16(X, 16);
      xmerge16(X, 32);
#pragma unroll
      for (int i = 0; i < 16; ++i) { if (pp == 0) R0[i] = X[i]; else R1[i] = X[i]; }
    }
    if (lq == 0) {
#pragma unroll
      for (int i = 0; i < 16; ++i) { idxs[lr * 32 + i] = 127 - (int)(R0[i] & 127u); idxs[lr * 32 + 16 + i] = 127 - (int)(R1[i] & 127u); }
    }
    float va[16], vb[16];
#pragma unroll
    for (int i = 0; i < 16; ++i) { va[i] = ord2f(R0[i] & ~127u); vb[i] = ord2f(R1[i] & ~127u); }
    unsigned F[16];
  F[0] = lq == 0 ? CANDKEY(va[0] + vb[0], 0) : (lq == 1 ? CANDKEY(va[1] + vb[0], 16) : (lq == 2 ? CANDKEY(va[3] + vb[0], 48) : CANDKEY(va[13] + vb[0], 208)));
  F[1] = lq == 0 ? CANDKEY(va[0] + vb[1], 1) : (lq == 1 ? CANDKEY(va[1] + vb[1], 17) : (lq == 2 ? CANDKEY(va[3] + vb[1], 49) : CANDKEY(va[14] + vb[0], 224)));
  F[2] = lq == 0 ? CANDKEY(va[0] + vb[2], 2) : (lq == 1 ? CANDKEY(va[1] + vb[2], 18) : (lq == 2 ? CANDKEY(va[3] + vb[2], 50) : CANDKEY(va[15] + vb[0], 240)));
  F[3] = lq == 0 ? CANDKEY(va[0] + vb[3], 3) : (lq == 1 ? CANDKEY(va[1] + vb[3], 19) : (lq == 2 ? CANDKEY(va[3] + vb[3], 51) : 0u));
  F[4] = lq == 0 ? CANDKEY(va[0] + vb[4], 4) : (lq == 1 ? CANDKEY(va[1] + vb[4], 20) : (lq == 2 ? CANDKEY(va[4] + vb[0], 64) : 0u));
  F[5] = lq == 0 ? CANDKEY(va[0] + vb[5], 5) : (lq == 1 ? CANDKEY(va[1] + vb[5], 21) : (lq == 2 ? CANDKEY(va[4] + vb[1], 65) : 0u));
  F[6] = lq == 0 ? CANDKEY(va[0] + vb[6], 6) : (lq == 1 ? CANDKEY(va[1] + vb[6], 22) : (lq == 2 ? CANDKEY(va[4] + vb[2], 66) : 0u));
  F[7] = lq == 0 ? CANDKEY(va[0] + vb[7], 7) : (lq == 1 ? CANDKEY(va[1] + vb[7], 23) : (lq == 2 ? CANDKEY(va[6] + vb[0], 96) : 0u));
  F[8] = lq == 0 ? CANDKEY(va[0] + vb[8], 8) : (lq == 1 ? CANDKEY(va[2] + vb[0], 32) : (lq == 2 ? CANDKEY(va[6] + vb[1], 97) : 0u));
  F[9] = lq == 0 ? CANDKEY(va[0] + vb[9], 9) : (lq == 1 ? CANDKEY(va[2] + vb[1], 33) : (lq == 2 ? CANDKEY(va[7] + vb[0], 112) : 0u));
  F[10] = lq == 0 ? CANDKEY(va[0] + vb[10], 10) : (lq == 1 ? CANDKEY(va[2] + vb[2], 34) : (lq == 2 ? CANDKEY(va[7] + vb[1], 113) : 0u));
  F[11] = lq == 0 ? CANDKEY(va[0] + vb[11], 11) : (lq == 1 ? CANDKEY(va[2] + vb[3], 35) : (lq == 2 ? CANDKEY(va[8] + vb[0], 128) : 0u));
  F[12] = lq == 0 ? CANDKEY(va[0] + vb[12], 12) : (lq == 1 ? CANDKEY(va[2] + vb[4], 36) : (lq == 2 ? CANDKEY(va[9] + vb[0], 144) : 0u));
  F[13] = lq == 0 ? CANDKEY(va[0] + vb[13], 13) : (lq == 1 ? CANDKEY(va[5] + vb[0], 80) : (lq == 2 ? CANDKEY(va[10] + vb[0], 160) : 0u));
  F[14] = lq == 0 ? CANDKEY(va[0] + vb[14], 14) : (lq == 1 ? CANDKEY(va[5] + vb[1], 81) : (lq == 2 ? CANDKEY(va[11] + vb[0], 176) : 0u));
  F[15] = lq == 0 ? CANDKEY(va[0] + vb[15], 15) : (lq == 1 ? 0u : (lq == 2 ? CANDKEY(va[12] + vb[0], 192) : 0u));

    SORT16(F);
    xmerge16(F, 16);
    xmerge16(F, 32);
    if (lq == 0) {
      float ev[16];
      const float mx = ord2f(F[0] & ~255u);
      float tot = 0.f;
#pragma unroll
      for (int r = 0; r < 16; ++r) { ev[r] = __expf(ord2f(F[r] & ~255u) - mx); tot += ev[r]; }
      const float inv = 1.f / tot;
      int ei[16];
#pragma unroll
      for (int r = 0; r < 16; ++r) {
        const int c = 255 - (int)(F[r] & 255u);
        ei[r] = idxs[lr * 32 + (c >> 4)] * 128 + idxs[lr * 32 + 16 + (c & 15)];
      }
      int* ep = p.eidx + (size_t)tok * 128 + h * 16;
      float* gp = p.gate + (size_t)tok * 128 + h * 16;
#pragma unroll
      for (int r = 0; r < 4; ++r) {
        *(u32x4*)(ep + r * 4) = (u32x4){(unsigned)ei[r * 4], (unsigned)ei[r * 4 + 1], (unsigned)ei[r * 4 + 2], (unsigned)ei[r * 4 + 3]};
        *(f32x4*)(gp + r * 4) = (f32x4){ev[r * 4] * inv, ev[r * 4 + 1] * inv, ev[r * 4 + 2] * inv, ev[r * 4 + 3] * inv};
      }
    }
  }
}

__device__ __forceinline__ void ph_convert_tables(const P& p, int bid, int nb) {
  const int wave = threadIdx.x >> 6, lane = threadIdx.x & 63;
  for (int row = bid * 4 + wave; row < 32768; row += nb * 4) {
    const float* src = row < 16384 ? p.U + (size_t)row * 1024 : p.V + (size_t)(row - 16384) * 1024;
    bf16_t* dst = row < 16384 ? p.Ubf + (size_t)row * 1024 : p.Vbf + (size_t)(row - 16384) * 1024;
#pragma unroll
    for (int j = 0; j < 4; ++j) {
      const f32x4 v = __builtin_nontemporal_load((const f32x4*)src + j * 64 + lane);
      u32x2 o;
      o.x = (unsigned)f2bf(v.x) | ((unsigned)f2bf(v.y) << 16);
      o.y = (unsigned)f2bf(v.z) | ((unsigned)f2bf(v.w) << 16);
      *(u32x2*)(dst + j * 256 + lane * 4) = o;
    }
  }
}
__device__ __forceinline__ float dot2bf(unsigned a, unsigned b, float c) {
  return __builtin_amdgcn_fdot2_f32_bf16(__builtin_bit_cast(bf16x2, a), __builtin_bit_cast(bf16x2, b), c, false);
}
__device__ __forceinline__ float gelu_exact(float a) { return 0.5f * a * (1.f + erff(a * 0.70710678118654752f)); }

#define G_LOAD(buf, s_) do { const int s__ = (s_); const bf16_t* tab__ = s__ < 16 ? p.Ubf : p.Vbf; const int er__ = (s__ & 8) ? e1 : e0; \
    _Pragma("unroll") for (int k = 0; k < 8; ++k) { const int e__ = __builtin_amdgcn_readlane(er__, (s__ & 7) * 8 + k); \
      const u32x4* r__ = (const u32x4*)(tab__ + (size_t)e__ * 1024) + lane; buf[k][0] = r__[0]; buf[k][1] = r__[64]; } } while (0)
#define G_COMPUTE(buf, s_) do { const int s__ = (s_); \
    if (s__ < 16) { \
      _Pragma("unroll") for (int k = 0; k < 8; ++k) { \
        float d0 = dot2bf(buf[k][0].x, xp0.x, 0.f), d1 = dot2bf(buf[k][0].y, xp0.y, 0.f); \
        d0 = dot2bf(buf[k][0].z, xp0.z, d0); d1 = dot2bf(buf[k][0].w, xp0.w, d1); \
        d0 = dot2bf(buf[k][1].x, xp1.x, d0); d1 = dot2bf(buf[k][1].y, xp1.y, d1); \
        d0 = dot2bf(buf[k][1].z, xp1.z, d0); d1 = dot2bf(buf[k][1].w, xp1.w, d1); \
        const float sm__ = wave_sum(d0 + d1); \
        if (lane == (s__ & 7) * 8 + k) { if (s__ & 8) a1 = sm__; else a0 = sm__; } } \
    } else { \
      if (s__ == 16) { w0 = gelu_exact(a0) * g0; w1 = gelu_exact(a1) * g1; } \
      const int wr__ = __float_as_int((s__ & 8) ? w1 : w0); \
      _Pragma("unroll") for (int k = 0; k < 8; ++k) { \
        const float w__ = __int_as_float(__builtin_amdgcn_readlane(wr__, (s__ & 7) * 8 + k)); \
        _Pragma("unroll") for (int h = 0; h < 2; ++h) { \
          const u32x4 q__ = buf[k][h]; \
          y[h * 8 + 0] += w__ * __uint_as_float(q__.x << 16); y[h * 8 + 1] += w__ * __uint_as_float(q__.x & 0xffff0000u); \
          y[h * 8 + 2] += w__ * __uint_as_float(q__.y << 16); y[h * 8 + 3] += w__ * __uint_as_float(q__.y & 0xffff0000u); \
          y[h * 8 + 4] += w__ * __uint_as_float(q__.z << 16); y[h * 8 + 5] += w__ * __uint_as_float(q__.z & 0xffff0000u); \
          y[h * 8 + 6] += w__ * __uint_as_float(q__.w << 16); y[h * 8 + 7] += w__ * __uint_as_float(q__.w & 0xffff0000u); } } \
    } } while (0)

__device__ __forceinline__ void ph10_gather(const P& p, int bid, int nb) {
  const int wave = __builtin_amdgcn_readfirstlane(threadIdx.x >> 6), lane = threadIdx.x & 63;
  for (int tok = bid * 4 + wave; tok < TL; tok += nb * 4) {
    const int b = tok / SEQ;
    const u32x4 xp0 = *((const u32x4*)(p.hn + (size_t)tok * 1024) + lane);
    const u32x4 xp1 = *((const u32x4*)(p.hn + (size_t)tok * 1024) + 64 + lane);
    const int e0 = p.eidx[(size_t)tok * 128 + lane], e1 = p.eidx[(size_t)tok * 128 + 64 + lane];
    const float g0 = p.gate[(size_t)tok * 128 + lane], g1 = p.gate[(size_t)tok * 128 + 64 + lane];
    float a0 = 0.f, a1 = 0.f, w0 = 0.f, w1 = 0.f;
    float y[16];
#pragma unroll
    for (int i = 0; i < 16; ++i) y[i] = 0.f;
    u32x4 A[8][2], B[8][2];
    G_LOAD(A, 0);
#pragma unroll 1
    for (int s = 0; s < 32; s += 2) {
      G_LOAD(B, s + 1);
      G_COMPUTE(A, s);
      if (s + 2 < 32) G_LOAD(A, s + 2);
      G_COMPUTE(B, s + 1);
    }
    float* orow = p.out + (size_t)tok * 1024;
    const float* g2 = p.mod + b * 6144 + 5 * 1024;
    float z[16];
    float ss = 0.f;
#pragma unroll
    for (int h = 0; h < 2; ++h)
#pragma unroll
      for (int q = 0; q < 2; ++q) {
        const int col = h * 512 + lane * 8 + q * 4;
        const f32x4 xl = *(const f32x4*)(orow + col);
        const f32x4 gg = *(const f32x4*)(g2 + col);
#pragma unroll
        for (int i = 0; i < 4; ++i) { const float zz = xl[i] + gg[i] * y[h * 8 + q * 4 + i]; z[h * 8 + q * 4 + i] = zz; ss += zz * zz; }
      }
    ss = wave_sum(ss);
    const float rstd = rsqrtf(ss * (1.f / 1024.f) + 1e-6f);
#pragma unroll
    for (int h = 0; h < 2; ++h)
#pragma unroll
      for (int q = 0; q < 2; ++q) {
        const int col = h * 512 + lane * 8 + q * 4;
        const f32x4 fw = *(const f32x4*)(p.final_norm_w + col);
        f32x4 o;
#pragma unroll
        for (int i = 0; i < 4; ++i) o[i] = z[h * 8 + q * 4 + i] * rstd * fw[i];
        *(f32x4*)(orow + col) = o;
      }
  }
}

__global__ void __launch_bounds__(NTHR, 2) mega(P p) {
  __shared__ __attribute__((aligned(16))) char smem[73728];
  cg::grid_group grid = cg::this_grid();
  const int bid = blockIdx.x, nb = gridDim.x;
#define RUN(k, call) if ((PHMASK & (1 << k)) && p.ph_lo <= k && k < p.ph_hi) { call; if (k + 1 < p.ph_hi) grid.sync(); }
  RUN(0, ph0_prep(p, bid, nb, smem))
  RUN(1, ph_norm_rows<0>(p, bid, nb))
  RUN(2, ph_gemm<0>(p, bid, nb, smem))
  RUN(3, ph3_chunk_local(p, bid, nb, smem))
  RUN(4, ph4_scan(p, bid, nb))
  RUN(5, ph5_mlstm_out(p, bid, nb, smem))
  RUN(6, (ph_gemm<1>(p, bid, nb, smem), ph_convert_tables(p, bid, nb)))
  RUN(7, ph_norm_rows<1>(p, bid, nb))
  RUN(8, ph_gemm<2>(p, bid, nb, smem))
  RUN(9, ph9_topk(p, bid, nb, smem))
  RUN(10, ph10_gather(p, bid, nb))
#undef RUN
}

extern "C" void kernel_launch(void* const* d_in, const int* in_sizes, int n_in, void* d_out, int out_size, void* d_ws, size_t ws_size,
                              hipStream_t stream) {
  static int grid_blocks = 0;
  if (!grid_blocks) {
    int dev = 0, cus = 0, per_cu = 0;
    hipGetDevice(&dev);
    hipDeviceGetAttribute(&cus, hipDeviceAttributeMultiprocessorCount, dev);
    hipOccupancyMaxActiveBlocksPerMultiprocessor(&per_cu, (const void*)mega, NTHR, 0);
    if (per_cu > 2) per_cu = 2;
    if (per_cu < 1) per_cu = 1;
    grid_blocks = cus * per_cu;
    if (ws_size < WS_END) fprintf(stderr, "kernel_launch: workspace too small: %zu < %llu\n", ws_size, (unsigned long long)WS_END);
  }
  P p{};
  const float* const* in = (const float* const*)d_in;
  p.x = in[0]; p.c = in[1]; p.ctx = in[2]; p.c_ctx = in[3]; p.w_mod = in[4]; p.b_mod = in[5]; p.norm1_w = in[6]; p.w_in = in[7];
  p.conv_w = in[8]; p.conv_b = in[9]; p.b_gates = in[10]; p.head_norm_w = in[11]; p.pool_w = in[12]; p.pool_scale = in[13];
  p.w_out = in[14]; p.norm2_w = in[15]; p.wq = in[16]; p.keys = in[17]; p.U = in[18]; p.V = in[19]; p.final_norm_w = in[20];
  p.out = (float*)d_out;
  char* ws = (char*)d_ws;
  p.mod = (float*)(ws + OFF_MOD); p.gates = (float*)(ws + OFF_GATES);
  p.wt_in = (bf16_t*)(ws + OFF_WTIN); p.wt_out = (bf16_t*)(ws + OFF_WTOUT); p.wt_q = (bf16_t*)(ws + OFF_WTQ);
  p.keys_bf = (bf16_t*)(ws + OFF_KEYS); p.hn = (bf16_t*)(ws + OFF_HN); p.pl = (bf16_t*)(ws + OFF_PL);
  p.Dst = (bf16_t*)(ws + OFF_D); p.ND = (float*)(ws + OFF_ND); p.SC = (float*)(ws + OFF_SC);
  p.CIN = (bf16_t*)(ws + OFF_CIN); p.NIN = (float*)(ws + OFF_NIN); p.MIN_ = (float*)(ws + OFF_MIN);
  p.Ubf = (bf16_t*)(ws + OFF_D); p.Vbf = (bf16_t*)(ws + OFF_D + 33554432ull);
  p.eidx = (int*)(ws + OFF_EIDX); p.gate = (float*)(ws + OFF_GATE);
#if N_LAUNCHES == 1
  p.ph_lo = 0; p.ph_hi = NPH;
  void* args[] = {&p};
  hipError_t e = hipLaunchCooperativeKernel((const void*)mega, dim3(grid_blocks), dim3(NTHR), args, 0, stream);
  if (e != hipSuccess) fprintf(stderr, "cooperative launch failed: %s (grid %d)\n", hipGetErrorString(e), grid_blocks);
#else
  for (int ph = 0; ph < NPH; ++ph) {
    p.ph_lo = ph; p.ph_hi = ph + 1;
    void* args[] = {&p};
    hipError_t e = hipLaunchCooperativeKernel((const void*)mega, dim3(grid_blocks), dim3(NTHR), args, 0, stream);
    if (e != hipSuccess) fprintf(stderr, "launch %d failed: %s (grid %d)\n", ph, hipGetErrorString(e), grid_blocks);
  }
#endif
}
```

```cpp
#include <hip/hip_runtime.h>
#include <hip/hip_cooperative_groups.h>
#include <stdint.h>
#include <stdio.h>
namespace cg = cooperative_groups;

#ifndef PHMASK
#define PHMASK 0x7ff
#endif
#ifndef N_LAUNCHES
#define N_LAUNCHES 1
#endif

typedef unsigned short bf16_t;
typedef short bf16x8 __attribute__((ext_vector_type(8)));
typedef float f32x4 __attribute__((ext_vector_type(4)));
typedef unsigned u32x4 __attribute__((ext_vector_type(4)));
typedef unsigned u32x2 __attribute__((ext_vector_type(2)));
typedef __bf16 bf16x2 __attribute__((ext_vector_type(2)));

#define NB 8
#define SEQ 2048
#define DM 1024
#define CTXL 256
#define TL 16384
#define TC 2048
#define TR 18432
#define LDP 2624
#define NPADIN 2688
#define NTHR 256
#define LDS_HALF 73728
#define NPH 11

#define OFF_MOD    (4096ull)
#define OFF_GATES  (OFF_MOD + 262144ull)
#define OFF_WTIN   (OFF_GATES + 1179648ull)
#define OFF_WTOUT  (OFF_WTIN + 5505024ull)
#define OFF_WTQ    (OFF_WTOUT + 2097152ull)
#define OFF_KEYS   (OFF_WTQ + 4194304ull)
#define OFF_POOLWT (OFF_KEYS + 524288ull)
#define OFF_HN     (OFF_POOLWT + 131072ull)
#define OFF_PL     (OFF_HN + 37748736ull)
#define OFF_D      (OFF_PL + 96731136ull)
#define OFF_ND     (OFF_D + 37748736ull)
#define OFF_SC     (OFF_ND + 589824ull)
#define OFF_CIN    (OFF_SC + 147456ull)
#define OFF_NIN    (OFF_CIN + 33554432ull)
#define OFF_MIN    (OFF_NIN + 524288ull)
#define OFF_EIDX   (OFF_MIN + 131072ull)
#define OFF_GATE   (OFF_EIDX + 8388608ull)
#define WS_END     (OFF_GATE + 8388608ull)

struct P {
  const float *x, *c, *ctx, *c_ctx, *w_mod, *b_mod, *norm1_w, *w_in, *conv_w, *conv_b, *b_gates, *head_norm_w,
      *pool_w, *pool_scale, *w_out, *norm2_w, *wq, *keys, *U, *V, *final_norm_w;
  float* out;
  float* mod;
  float* gates;
  bf16_t* wt_in;
  bf16_t* wt_out;
  bf16_t* wt_q;
  bf16_t* keys_bf;
  bf16_t* hn;
  bf16_t* pl;
  bf16_t* Dst;
  float* ND;
  float* SC;
  bf16_t* CIN;
  float* NIN;
  float* MIN_;
  bf16_t* mix;
  bf16_t* qb;
  bf16_t* Ubf;
  bf16_t* Vbf;
  int* eidx;
  float* gate;
  int ph_lo, ph_hi;
};

__device__ __forceinline__ bf16_t f2bf(float f) { return __builtin_bit_cast(bf16_t, (__bf16)f); }
__device__ __forceinline__ float bf2f(bf16_t h) { return __uint_as_float(((unsigned)h) << 16); }
__device__ __forceinline__ float wave_sum(float v) {
#pragma unroll
  for (int o = 32; o > 0; o >>= 1) v += __shfl_xor(v, o);
  return v;
}
__device__ __forceinline__ float silu_f(float v) { return v / (1.f + __expf(-v)); }
__device__ __forceinline__ float logsig_f(float v) { return fminf(v, 0.f) - log1pf(__expf(-fabsf(v))); }

__device__ __forceinline__ void ph0_prep(const P& p, int bid, int nb, char* smem) {
  float* sm = (float*)smem;
  const int tid = threadIdx.x & 255;
  const int N_MOD = 24, N_TIN = 16 * 42, N_TOUT = 256, N_TQ = 16 * 32, N_POOL = 16;
  const int total = N_MOD + N_TIN + N_TOUT + N_TQ + N_POOL;
  const int trips = (total + nb - 1) / nb;
  for (int k = 0; k < trips; ++k) {
    int r = (bid + k * nb) % total;
    if (r < N_MOD) {
      for (int i = tid; i < 9 * 1024; i += NTHR) {
        int rr = i >> 10, kq = i & 1023;
        float v = rr < 8 ? p.c[rr * 1024 + kq] : p.c_ctx[kq];
        sm[i] = silu_f(v);
      }
      __syncthreads();
      int n = r * 256 + tid;
      float acc[9];
#pragma unroll
      for (int q = 0; q < 9; ++q) acc[q] = p.b_mod[n];
#pragma unroll 4
      for (int kq = 0; kq < 1024; ++kq) {
        float w = p.w_mod[(size_t)kq * 6144 + n];
#pragma unroll
        for (int q = 0; q < 9; ++q) acc[q] += sm[q * 1024 + kq] * w;
      }
#pragma unroll
      for (int q = 0; q < 9; ++q) p.mod[q * 6144 + n] = acc[q];
      __syncthreads();
      continue;
    }
    r -= N_MOD;
    const float* src = nullptr; bf16_t* dst = nullptr; int K = 1024, N = 0, ntn = 0;
    if (r < N_TIN) { src = p.w_in; dst = p.wt_in; N = 2576; ntn = 42; }
    else { r -= N_TIN;
      if (r < N_TOUT) { src = p.w_out; dst = p.wt_out; N = 1024; ntn = 16; }
      else { r -= N_TOUT;
        if (r < N_TQ) { src = p.wq; dst = p.wt_q; N = 2048; ntn = 32; }
        else { r -= N_TQ; int g = r >> 2; r &= 3; src = p.pool_w + g * 16384; dst = (bf16_t*)((char*)p.keys_bf + 524288) + g * 16384; K = 128; N = 128; ntn = 2; }
      }
    }
    {
      int kt = r / ntn, nt = r % ntn, k0 = kt * 64, n0 = nt * 64;
      int cc = tid & 63;
      for (int rr = tid >> 6; rr < 64; rr += 4) {
        int n = n0 + cc;
        sm[rr * 65 + cc] = n < N ? src[(size_t)(k0 + rr) * N + n] : 0.f;
      }
      __syncthreads();
      for (int rr = tid >> 6; rr < 64; rr += 4) dst[(size_t)(n0 + rr) * K + k0 + cc] = f2bf(sm[cc * 65 + rr]);
      __syncthreads();
    }
  }
  for (int i = bid * NTHR + tid; i < 262144; i += nb * NTHR) p.keys_bf[i] = f2bf(p.keys[i]);
}

template <int WHICH>
__device__ __forceinline__ void ph_norm_rows(const P& p, int bid, int nb) {
  const int wave = (threadIdx.x >> 6) & 3, lane = threadIdx.x & 63;
  const int nrows = WHICH == 0 ? TR : TL;
  for (int row = bid * 4 + wave; row < nrows; row += nb * 4) {
    const float* src = WHICH == 0 ? (row < TL ? p.x + (size_t)row * 1024 : p.ctx + (size_t)(row - TL) * 1024) : p.out + (size_t)row * 1024;
    const int mr = row < TL ? row / SEQ : 8;
    float4 v[4];
    float ss = 0.f;
#pragma unroll
    for (int j = 0; j < 4; ++j) {
      v[j] = ((const float4*)src)[j * 64 + lane];
      ss += v[j].x * v[j].x + v[j].y * v[j].y + v[j].z * v[j].z + v[j].w * v[j].w;
    }
    ss = wave_sum(ss);
    const float rstd = rsqrtf(ss * (1.f / 1024.f) + 1e-6f);
    const float* nw = WHICH == 0 ? p.norm1_w : p.norm2_w;
    const float* sh = p.mod + mr * 6144 + (WHICH == 0 ? 0 : 3) * 1024;
    const float* sc = sh + 1024;
#pragma unroll
    for (int j = 0; j < 4; ++j) {
      const int col = j * 256 + lane * 4;
      float4 w4 = *(const float4*)(nw + col), s4 = *(const float4*)(sh + col), c4 = *(const float4*)(sc + col);
      float y0 = v[j].x * rstd * w4.x * (1.f + c4.x) + s4.x;
      float y1 = v[j].y * rstd * w4.y * (1.f + c4.y) + s4.y;
      float y2 = v[j].z * rstd * w4.z * (1.f + c4.z) + s4.z;
      float y3 = v[j].w * rstd * w4.w * (1.f + c4.w) + s4.w;
      uint2 o;
      o.x = (unsigned)f2bf(y0) | ((unsigned)f2bf(y1) << 16);
      o.y = (unsigned)f2bf(y2) | ((unsigned)f2bf(y3) << 16);
      *(uint2*)(p.hn + (size_t)row * 1024 + col) = o;
    }
  }
}

#define GBK 64
#define GLD 72
template <int EPI>
__device__ __forceinline__ void gemm_tile(const P& p, const bf16_t* A, int lda, const bf16_t* Bt, int m0, int n0, bf16_t* sA, bf16_t* sB) {
  const int tid = threadIdx.x & 255, lane = tid & 63, wave = tid >> 6;
  const int wm = wave >> 1, wn = wave & 1;
  const int lr = lane & 15, lq = lane >> 4;
  f32x4 acc[4][4];
#pragma unroll
  for (int i = 0; i < 4; ++i)
#pragma unroll
    for (int j = 0; j < 4; ++j) acc[i][j] = (f32x4){0.f, 0.f, 0.f, 0.f};
  const int sr = tid >> 3, scol = (tid & 7) * 8;
  u32x4 ra[4], rb[4];
  const bf16_t* Ap = A + (size_t)(m0 + sr) * lda + scol;
  const bf16_t* Bp = Bt + (size_t)(n0 + sr) * 1024 + scol;
#pragma unroll
  for (int i = 0; i < 4; ++i) {
    ra[i] = *(const u32x4*)(Ap + (size_t)(i * 32) * lda);
    rb[i] = *(const u32x4*)(Bp + (size_t)(i * 32) * 1024);
  }
  for (int kt = 0; kt < 1024 / GBK; ++kt) {
    __syncthreads();
#pragma unroll
    for (int i = 0; i < 4; ++i) {
      *(u32x4*)(sA + (sr + i * 32) * GLD + scol) = ra[i];
      *(u32x4*)(sB + (sr + i * 32) * GLD + scol) = rb[i];
    }
    __syncthreads();
    {
      const int k0 = (kt + 1 < 1024 / GBK ? kt + 1 : kt) * GBK;
#pragma unroll
      for (int i = 0; i < 4; ++i) {
        ra[i] = *(const u32x4*)(Ap + (size_t)(i * 32) * lda + k0);
        rb[i] = *(const u32x4*)(Bp + (size_t)(i * 32) * 1024 + k0);
      }
    }
#pragma unroll
    for (int ks = 0; ks < 2; ++ks) {
      bf16x8 af[4], bfr[4];
#pragma unroll
      for (int i = 0; i < 4; ++i) {
        af[i] = *(const bf16x8*)(sA + (wm * 64 + i * 16 + lr) * GLD + ks * 32 + lq * 8);
        bfr[i] = *(const bf16x8*)(sB + (wn * 64 + i * 16 + lr) * GLD + ks * 32 + lq * 8);
      }
#pragma unroll
      for (int i = 0; i < 4; ++i)
#pragma unroll
        for (int j = 0; j < 4; ++j) acc[i][j] = __builtin_amdgcn_mfma_f32_16x16x32_bf16(af[i], bfr[j], acc[i][j], 0, 0, 0);
    }
  }
#pragma unroll
  for (int i = 0; i < 4; ++i)
#pragma unroll
    for (int j = 0; j < 4; ++j)
#pragma unroll
      for (int e = 0; e < 4; ++e) {
        const int row = m0 + wm * 64 + i * 16 + lq * 4 + e;
        const int col = n0 + wn * 64 + j * 16 + lr;
        const float v = acc[i][j][e];
        if (EPI == 0) {
          if (col < 2560) p.pl[(size_t)row * LDP + col] = f2bf(v);
          else if (col < 2576) p.gates[(size_t)row * 16 + (col - 2560)] = v;
        } else if (EPI == 1) {
          const int b = row / SEQ;
          p.out[(size_t)row * 1024 + col] = p.x[(size_t)row * 1024 + col] + p.mod[b * 6144 + 2 * 1024 + col] * v;
        } else {
          p.qb[(size_t)row * 2048 + col] = f2bf(v);
        }
      }
}

template <int EPI>
__device__ __forceinline__ void ph_gemm(const P& p, int bid, int nb, char* smem) {
  bf16_t* sA = (bf16_t*)smem;
  bf16_t* sB = sA + 128 * GLD;
  const int ntn = EPI == 0 ? 21 : (EPI == 1 ? 8 : 16);
  const int ntm = EPI == 0 ? 144 : 128;
  const bf16_t* A = EPI == 0 ? p.hn : (EPI == 1 ? p.mix : p.hn);
  const int lda = 1024;
  const bf16_t* Bt = EPI == 0 ? p.wt_in : (EPI == 1 ? p.wt_out : p.wt_q);
  const int nlat = 128 * ntn;
  const int ntiles = EPI == 0 ? nlat + 16 * 13 : ntm * ntn;
  const int trips = (ntiles + nb - 1) / nb;
  for (int k = 0; k < trips; ++k) {
    const int t = (bid + k * nb) % ntiles;
    int tm, tn;
    if (EPI == 0 && t >= nlat) { const int r = t - nlat; tm = 128 + r / 13; tn = r % 13; if (tn == 12) tn = 20; }
    else { tm = t / ntn; tn = t % ntn; }
    gemm_tile<EPI>(p, A, lda, Bt, tm * 128, tn * 128, sA, sB);
  }
}

struct UnitInfo { int isctx, b, c, h, T, seqrow0, row0; };
__device__ __forceinline__ UnitInfo decode_unit(int u) {
  UnitInfo r;
  if (u < 512) { r.isctx = 0; r.b = u >> 6; r.c = (u >> 2) & 15; r.h = u & 3; r.T = SEQ; r.seqrow0 = r.b * SEQ; }
  else { int uu = u - 512; r.isctx = 1; r.b = uu >> 3; r.c = (uu >> 2) & 1; r.h = uu & 3; r.T = CTXL; r.seqrow0 = TL + r.b * CTXL; }
  r.row0 = r.seqrow0 + r.c * 128;
  return r;
}
__device__ __forceinline__ float qk_act(const P& p, int seqrow0, int T, int t, int col) {
  const bf16_t* base = p.pl + (size_t)(seqrow0 + t) * LDP + col;
  float r0 = t > 0 ? bf2f(base[-LDP]) : 0.f;
  float r1 = bf2f(base[0]);
  float r2 = t + 1 < T ? bf2f(base[LDP]) : 0.f;
  float y = p.conv_b[col] + r0 * p.conv_w[col] + r1 * p.conv_w[1024 + col] + r2 * p.conv_w[2048 + col];
  return silu_f(y);
}


typedef short s16x4 __attribute__((ext_vector_type(4)));
#define LDS_AS __attribute__((address_space(3)))
__device__ __forceinline__ s16x4 ds_tr16(const bf16_t* ptr) { return __builtin_amdgcn_ds_read_tr16_b64_v4i16((LDS_AS s16x4*)ptr); }
__device__ __forceinline__ bf16x8 frag_tr(const bf16_t* M, int ld, int s0, int c0, int lr, int lq) {
  const bf16_t* a = M + (s0 + lq * 8 + (lr >> 2)) * ld + c0 + (lr & 3) * 4;
  const s16x4 t0 = ds_tr16(a), t1 = ds_tr16(a + 4 * ld);
  return __builtin_shufflevector(t0, t1, 0, 1, 2, 3, 4, 5, 6, 7);
}
typedef float f32x2 __attribute__((ext_vector_type(2)));
__device__ __forceinline__ unsigned cvt_pk_bf16(float lo, float hi) { const f32x2 v = {lo, hi}; const bf16x2 b = __builtin_convertvector(v, bf16x2); return __builtin_bit_cast(unsigned, b); }
__device__ __forceinline__ float blo(unsigned u) { return __uint_as_float(u << 16); }
__device__ __forceinline__ float bhi(unsigned u) { return __uint_as_float(u & 0xffff0000u); }
#define VLD 136
__device__ __forceinline__ __amdgpu_buffer_rsrc_t mk_rsrc(const void* ptr) { return __builtin_amdgcn_make_buffer_rsrc((void*)ptr, 0, 0x7fffffff, 0x00020000); }
__device__ __forceinline__ bf16x8 bload8(__amdgpu_buffer_rsrc_t r, int voff, int soff) { return __builtin_bit_cast(bf16x8, __builtin_amdgcn_raw_buffer_load_b128(r, voff, soff, 0)); }

__device__ __forceinline__ void ph3_chunk_local(const P& p, int bid, int nb, char* smem) {
  bf16_t* Vs = (bf16_t*)smem;
  bf16_t* Ks = Vs + 128 * VLD;
  float* fa = (float*)(Ks + 128 * VLD);
  float *igf = fa, *lff = fa + 128, *igb = fa + 256, *lfb = fa + 384, *ef = fa + 512, *eb = fa + 640, *scal = fa + 768;
  const int tid = threadIdx.x & 255, lane = tid & 63, wave = tid >> 6, lr = lane & 15, lq = lane >> 4;
  const int trips3 = (576 + nb - 1) / nb;
  for (int k3 = 0; k3 < trips3; ++k3) {
    const int u = (bid + k3 * nb) % 576;
    const UnitInfo ui = decode_unit(u);
    const int h = ui.h;
    if (tid < 128) {
      const float* g = p.gates + (size_t)(ui.row0 + tid) * 16;
      igf[tid] = g[h] + p.b_gates[h];
      lff[tid] = logsig_f(g[4 + h] + p.b_gates[4 + h]);
      igb[tid] = g[8 + h] + p.b_gates[8 + h];
      lfb[tid] = logsig_f(g[12 + h] + p.b_gates[12 + h]);
    }
    {
      const int dch = tid & 15, colq = h * 128 + dch * 8, colk = 512 + colq;
#pragma unroll 1
      for (int which = 0; which < 2; ++which) {
        if (which == 1 && ui.isctx) break;
        const int col = which == 0 ? colk : colq;
        float w0[8], w1[8], w2[8], bb[8];
#pragma unroll
        for (int i = 0; i < 8; ++i) { w0[i] = p.conv_w[col + i]; w1[i] = p.conv_w[1024 + col + i]; w2[i] = p.conv_w[2048 + col + i]; bb[i] = p.conv_b[col + i]; }
        const float scl = which == 0 ? 0.08838834764831845f : 1.f;
#pragma unroll 2
        for (int i = 0; i < 8; ++i) {
          const int t = (tid >> 4) + i * 16, tt = ui.c * 128 + t;
          const bf16_t* base = p.pl + (size_t)(ui.row0 + t) * LDP + col;
          const u32x4 z4 = (u32x4){0u, 0u, 0u, 0u};
          const u32x4 r1 = *(const u32x4*)base;
          const u32x4 r0 = tt > 0 ? *(const u32x4*)(base - LDP) : z4;
          const u32x4 r2 = tt + 1 < ui.T ? *(const u32x4*)(base + LDP) : z4;
          float y[8];
#pragma unroll
          for (int q = 0; q < 4; ++q) {
            y[2 * q] = silu_f(bb[2 * q] + blo(r0[q]) * w0[2 * q] + blo(r1[q]) * w1[2 * q] + blo(r2[q]) * w2[2 * q]) * scl;
            y[2 * q + 1] = silu_f(bb[2 * q + 1] + bhi(r0[q]) * w0[2 * q + 1] + bhi(r1[q]) * w1[2 * q + 1] + bhi(r2[q]) * w2[2 * q + 1]) * scl;
          }
          u32x4 o;
#pragma unroll
          for (int q = 0; q < 4; ++q) o[q] = cvt_pk_bf16(y[2 * q], y[2 * q + 1]);
          if (which == 0) *(u32x4*)(Ks + t * VLD + dch * 8) = o;
          if (!ui.isctx) *(u32x4*)(p.hn + (size_t)(ui.row0 + t) * 1024 + col) = o;
        }
      }
#pragma unroll
      for (int i = 0; i < 8; ++i) {
        const int t = (tid >> 4) + i * 16;
        *(u32x4*)(Vs + t * VLD + dch * 8) = *(const u32x4*)(p.pl + (size_t)(ui.row0 + t) * LDP + 1024 + h * 128 + dch * 8);
      }
    }
    __syncthreads();
    if (tid == 0) {
      float b = 0.f, G = -3.0e38f;
      for (int t = 0; t < 128; ++t) { b += lff[t]; float g = igf[t] - b; ef[t] = g; G = fmaxf(G, g); }
      scal[0] = G; scal[1] = b;
    } else if (tid == 64) {
      float b = 0.f, G = -3.0e38f;
      for (int t = 127; t >= 0; --t) { b += lfb[t]; float g = igb[t] - b; eb[t] = g; G = fmaxf(G, g); }
      scal[2] = G; scal[3] = b;
    }
    __syncthreads();
    if (tid < 128) { ef[tid] = __expf(ef[tid] - scal[0]); }
    else { eb[tid - 128] = __expf(eb[tid - 128] - scal[2]); }
    __syncthreads();
#pragma unroll 1
    for (int dir = 0; dir < 2; ++dir) {
      const float* ee = dir ? eb : ef;
      f32x4 acc[2][8];
#pragma unroll
      for (int m = 0; m < 2; ++m)
#pragma unroll
        for (int j = 0; j < 8; ++j) acc[m][j] = (f32x4){0.f, 0.f, 0.f, 0.f};
#pragma unroll
      for (int kk = 0; kk < 4; ++kk) {
        const f32x4 e0 = *(const f32x4*)(ee + kk * 32 + lq * 8), e1 = *(const f32x4*)(ee + kk * 32 + lq * 8 + 4);
        bf16x8 af[2];
#pragma unroll
        for (int m = 0; m < 2; ++m) {
          const bf16x8 raw = frag_tr(Vs, VLD, kk * 32, wave * 32 + m * 16, lr, lq);
          const u32x4 ru = __builtin_bit_cast(u32x4, raw);
          u32x4 sc;
          sc[0] = cvt_pk_bf16(blo(ru[0]) * e0[0], bhi(ru[0]) * e0[1]);
          sc[1] = cvt_pk_bf16(blo(ru[1]) * e0[2], bhi(ru[1]) * e0[3]);
          sc[2] = cvt_pk_bf16(blo(ru[2]) * e1[0], bhi(ru[2]) * e1[1]);
          sc[3] = cvt_pk_bf16(blo(ru[3]) * e1[2], bhi(ru[3]) * e1[3]);
          af[m] = __builtin_bit_cast(bf16x8, sc);
        }
#pragma unroll
        for (int j = 0; j < 8; ++j) {
          const bf16x8 bfr = frag_tr(Ks, VLD, kk * 32, j * 16, lr, lq);
#pragma unroll
          for (int m = 0; m < 2; ++m) acc[m][j] = __builtin_amdgcn_mfma_f32_16x16x32_bf16(af[m], bfr, acc[m][j], 0, 0, 0);
        }
      }
      bf16_t* Dd = p.Dst + (size_t)(u * 2 + dir) * 16384;
#pragma unroll
      for (int m = 0; m < 2; ++m)
#pragma unroll
        for (int j = 0; j < 8; ++j)
#pragma unroll
          for (int e = 0; e < 4; ++e) Dd[(wave * 32 + m * 16 + lq * 4 + e) * 128 + j * 16 + lr] = f2bf(acc[m][j][e]);
    }
    {
      const int dir = tid >> 7, k = tid & 127;
      const float* e = dir ? eb : ef;
      float sacc = 0.f;
      for (int t = 0; t < 128; ++t) sacc += e[t] * bf2f(Ks[t * VLD + k]);
      p.ND[(size_t)(u * 2 + dir) * 128 + k] = sacc;
    }
    if (tid < 4) p.SC[(size_t)(u * 2 + (tid >> 1)) * 32 + (tid & 1)] = scal[tid];
    __syncthreads();
  }
}

__device__ __forceinline__ void ph4_scan(const P& p, int bid, int nb) {
  const int tid = threadIdx.x & 255;
  for (int it = bid; it < 1024; it += nb) {
    const int combo = it >> 4, vblk = it & 15;
    const int b = combo >> 3, h = (combo >> 1) & 3, dir = combo & 1;
    const int v = vblk * 8 + (tid >> 5), k0 = (tid & 31) * 4;
    float C0 = 0.f, C1 = 0.f, C2 = 0.f, C3 = 0.f, nacc = 0.f, m = 0.f;
    for (int i = 0; i < 18; ++i) {
      int u;
      if (i < 2) { const int cc = dir == 0 ? i : 1 - i; u = 512 + b * 8 + cc * 4 + h; }
      else {
        const int lc = i - 2, c = dir == 0 ? lc : 15 - lc;
        u = b * 64 + c * 4 + h;
        const size_t ci = (size_t)u * 2 + dir;
        uint2 o;
        o.x = (unsigned)f2bf(C0) | ((unsigned)f2bf(C1) << 16);
        o.y = (unsigned)f2bf(C2) | ((unsigned)f2bf(C3) << 16);
        *(uint2*)(p.CIN + ci * 16384 + v * 128 + k0) = o;
        if (vblk == 0 && tid < 128) p.NIN[ci * 128 + tid] = nacc;
        if (vblk == 0 && tid == 0) p.MIN_[ci * 32] = m;
      }
      const size_t di = (size_t)u * 2 + dir;
      const float G = p.SC[di * 32 + 0], bend = p.SC[di * 32 + 1];
      const float Mx = fmaxf(m, G);
      const float dec = __expf(m - Mx), inj = __expf(G - Mx);
      const uint2 d2 = *(const uint2*)(p.Dst + di * 16384 + v * 128 + k0);
      C0 = dec * C0 + inj * __uint_as_float(d2.x << 16);
      C1 = dec * C1 + inj * __uint_as_float(d2.x & 0xffff0000u);
      C2 = dec * C2 + inj * __uint_as_float(d2.y << 16);
      C3 = dec * C3 + inj * __uint_as_float(d2.y & 0xffff0000u);
      if (vblk == 0 && tid < 128) nacc = dec * nacc + inj * p.ND[di * 128 + tid];
      m = bend + Mx;
    }
  }
}

__device__ __forceinline__ void ph5_mlstm_out(const P& p, int bid, int nb, char* smem) {
  bf16_t* Vs = (bf16_t*)smem;
  bf16_t* Pw = Vs + 128 * VLD;
  float* fa = (float*)(Pw + 4 * 16 * VLD);
  float *igf = fa, *lff = fa + 128, *igb = fa + 256, *lfb = fa + 384, *gf = fa + 512, *gb = fa + 640, *bfw = fa + 768, *bbw = fa + 896,
        *pmf = fa + 1024, *pmb = fa + 1152, *nq = fa + 1280  ;
  const int tid = threadIdx.x & 255, lane = tid & 63, wave = tid >> 6, lr = lane & 15, lq = lane >> 4;
  const int trips5 = (1536 + nb - 1) / nb;
  for (int k5 = 0; k5 < trips5; ++k5) {
    const int it = (bid + k5 * nb) % 1536;
    if (it < 512) {
      const int u = it;
      const UnitInfo ui = decode_unit(u);
      const int h = ui.h;
      const size_t cif = (size_t)u * 2, cib = (size_t)u * 2 + 1;
      if (tid < 128) {
        const float* g = p.gates + (size_t)(ui.row0 + tid) * 16;
        igf[tid] = g[h] + p.b_gates[h];
        lff[tid] = logsig_f(g[4 + h] + p.b_gates[4 + h]);
        igb[tid] = g[8 + h] + p.b_gates[8 + h];
        lfb[tid] = logsig_f(g[12 + h] + p.b_gates[12 + h]);
      }
      {
        const int dch = tid & 15;
#pragma unroll
        for (int i = 0; i < 8; ++i) {
          const int t = (tid >> 4) + i * 16;
          *(u32x4*)(Vs + t * VLD + dch * 8) = *(const u32x4*)(p.pl + (size_t)(ui.row0 + t) * LDP + 1024 + h * 128 + dch * 8);
        }
      }
      {
        const int dir = tid >> 7, t = tid & 127;
        const u32x4* qr = (const u32x4*)(p.hn + (size_t)(ui.row0 + t) * 1024 + h * 128);
        const float* nin = p.NIN + (dir ? cib : cif) * 128;
        float sacc = 0.f;
#pragma unroll 4
        for (int c8 = 0; c8 < 16; ++c8) {
          const u32x4 qv = qr[c8];
#pragma unroll
          for (int q = 0; q < 4; ++q) sacc += blo(qv[q]) * nin[c8 * 8 + 2 * q] + bhi(qv[q]) * nin[c8 * 8 + 2 * q + 1];
        }
        nq[dir * 128 + t] = sacc;
      }
      __syncthreads();
      if (tid == 0) {
        float b = 0.f, pm = -3.0e38f;
        for (int t = 0; t < 128; ++t) { b += lff[t]; bfw[t] = b; float g = igf[t] - b; gf[t] = g; pm = fmaxf(pm, g); pmf[t] = pm; }
      } else if (tid == 64) {
        float b = 0.f, pm = -3.0e38f;
        for (int t = 127; t >= 0; --t) { b += lfb[t]; bbw[t] = b; float g = igb[t] - b; gb[t] = g; pm = fmaxf(pm, g); pmb[t] = pm; }
      }
      __syncthreads();
      const float minf_ = p.MIN_[cif * 32], minb_ = p.MIN_[cib * 32];
      bf16_t* Pme = Pw + wave * 16 * VLD;
      const __amdgpu_buffer_rsrc_t r_hn = mk_rsrc(p.hn), r_cin = mk_rsrc(p.CIN);
      const int fvoff = (lr * 1024 + lq * 8) * 2, cvoff = (lr * 128 + lq * 8) * 2;
#pragma unroll 1
      for (int m = 0; m < 2; ++m) {
        const int t0 = wave * 32 + m * 16;
        bf16x8 Qf[4];
#pragma unroll
        for (int kk = 0; kk < 4; ++kk) Qf[kk] = bload8(r_hn, fvoff + kk * 64, ((ui.row0 + t0) * 1024 + h * 128) * 2);
        f32x4 S[8];
#pragma unroll
        for (int j = 0; j < 8; ++j) {
          S[j] = (f32x4){0.f, 0.f, 0.f, 0.f};
#pragma unroll
          for (int kk = 0; kk < 4; ++kk) {
            const bf16x8 kf = bload8(r_hn, fvoff + kk * 64, ((ui.row0 + j * 16) * 1024 + 512 + h * 128) * 2);
            S[j] = __builtin_amdgcn_mfma_f32_16x16x32_bf16(Qf[kk], kf, S[j], 0, 0, 0);
          }
          if (j & 1) __builtin_amdgcn_sched_barrier(0);
        }
        f32x4 hsum[8];
#pragma unroll 1
        for (int dir = 0; dir < 2; ++dir) {
          const float mi = dir ? minb_ : minf_;
          const float* gg = dir ? gb : gf;
          const float* pmx = dir ? pmb : pmf;
          const float* bw = dir ? bbw : bfw;
          float Mrow[4], wi[4];
#pragma unroll
          for (int e = 0; e < 4; ++e) { Mrow[e] = fmaxf(mi, pmx[t0 + lq * 4 + e]); wi[e] = __expf(mi - Mrow[e]); }
          f32x4 acc[8];
#pragma unroll
          for (int jv = 0; jv < 8; ++jv) {
            acc[jv] = (f32x4){0.f, 0.f, 0.f, 0.f};
#pragma unroll
            for (int kk = 0; kk < 4; ++kk) {
              const bf16x8 cf = bload8(r_cin, cvoff + kk * 64, (int)((dir ? cib : cif) * 32768) + jv * 4096);
              acc[jv] = __builtin_amdgcn_mfma_f32_16x16x32_bf16(Qf[kk], cf, acc[jv], 0, 0, 0);
            }
#pragma unroll
            for (int e = 0; e < 4; ++e) acc[jv][e] *= wi[e];
            if (jv & 1) __builtin_amdgcn_sched_barrier(0);
          }
          float rs[4] = {0.f, 0.f, 0.f, 0.f};
#pragma unroll
          for (int j = 0; j < 8; ++j) {
            const int sidx = j * 16 + lr;
            const float gs = gg[sidx];
#pragma unroll
            for (int e = 0; e < 4; ++e) {
              const int t = t0 + lq * 4 + e;
              const bool keep = dir ? (sidx >= t) : (sidx <= t);
              const float pv = keep ? S[j][e] * __expf(gs - Mrow[e]) : 0.f;
              rs[e] += pv;
              Pme[(lq * 4 + e) * VLD + sidx] = f2bf(pv);
            }
          }
          float den[4];
#pragma unroll
          for (int e = 0; e < 4; ++e) {
            float r = rs[e];
            r += __shfl_xor(r, 1); r += __shfl_xor(r, 2); r += __shfl_xor(r, 4); r += __shfl_xor(r, 8);
            const int t = t0 + lq * 4 + e;
            const float dd = r + wi[e] * nq[dir * 128 + t];
            den[e] = fmaxf(fabsf(dd), __expf(-(bw[t] + Mrow[e])));
          }
          __builtin_amdgcn_fence(__ATOMIC_RELEASE, "wavefront");
          __builtin_amdgcn_wave_barrier();
#pragma unroll
          for (int kk = 0; kk < 4; ++kk) {
            const bf16x8 pf = *(const bf16x8*)(Pme + lr * VLD + kk * 32 + lq * 8);
#pragma unroll
            for (int jv = 0; jv < 8; ++jv) {
              const bf16x8 vf = frag_tr(Vs, VLD, kk * 32, jv * 16, lr, lq);
              acc[jv] = __builtin_amdgcn_mfma_f32_16x16x32_bf16(pf, vf, acc[jv], 0, 0, 0);
            }
          }
          __builtin_amdgcn_wave_barrier();
#pragma unroll
          for (int jv = 0; jv < 8; ++jv)
#pragma unroll
            for (int e = 0; e < 4; ++e) {
              const float hv = acc[jv][e] / den[e];
              if (dir == 0) hsum[jv][e] = hv; else hsum[jv][e] += hv;
            }
        }
#pragma unroll
        for (int e = 0; e < 4; ++e) {
          float sm = 0.f;
#pragma unroll
          for (int jv = 0; jv < 8; ++jv) sm += hsum[jv][e];
          sm += __shfl_xor(sm, 1); sm += __shfl_xor(sm, 2); sm += __shfl_xor(sm, 4); sm += __shfl_xor(sm, 8);
          const float mu = sm * (1.f / 128.f);
          float vs = 0.f;
#pragma unroll
          for (int jv = 0; jv < 8; ++jv) { const float d = hsum[jv][e] - mu; vs += d * d; }
          vs += __shfl_xor(vs, 1); vs += __shfl_xor(vs, 2); vs += __shfl_xor(vs, 4); vs += __shfl_xor(vs, 8);
          const float rstd = rsqrtf(vs * (1.f / 128.f) + 1e-6f);
          const bf16_t* op = p.pl + (size_t)(ui.row0 + t0 + lq * 4 + e) * LDP + 1536 + h * 128;
          bf16_t* mp = p.mix + (size_t)(ui.row0 + t0 + lq * 4 + e) * 1024 + h * 128;
#pragma unroll
          for (int jv = 0; jv < 8; ++jv) {
            const int v = jv * 16 + lr;
            const float o = bf2f(op[v]);
            mp[v] = f2bf((hsum[jv][e] - mu) * rstd * p.head_norm_w[h * 128 + v] / (1.f + __expf(-o)));
          }
        }
      }
      __syncthreads();
    } else {
      const int pu = it - 512, grp = pu >> 2, g = pu & 3;
      float* us = (float*)smem;
      float* dd = us + 8192;
      const int w = 2 << g;
      const size_t rbase = (size_t)grp * 64;
      for (int idx = tid; idx < 8192; idx += NTHR) {
        const int t = idx >> 7, i = idx & 127;
        us[idx] = bf2f(p.pl[(rbase + t) * LDP + 2048 + g * 128 + i]);
      }
      __syncthreads();
      for (int idx = tid; idx < 8192; idx += NTHR) {
        const int t = idx >> 7, i = idx & 127;
        int lo = t - w / 2, hi = t - w / 2 + w;
        lo = lo < 0 ? 0 : lo; hi = hi > 64 ? 64 : hi;
        float s = 0.f;
        for (int j = lo; j < hi; ++j) s += us[j * 128 + i];
        dd[idx] = s / (float)(hi - lo) - us[idx];
      }
      __syncthreads();
      {
        const int o = tid & 127, tg = tid >> 7;
        const float ps = p.pool_scale[g * 128 + o];
#pragma unroll 1
        for (int pass = 0; pass < 4; ++pass) {
          float acc[8];
#pragma unroll
          for (int i = 0; i < 8; ++i) acc[i] = 0.f;
          const float* dbase = dd + (tg * 32 + pass * 8) * 128;
#pragma unroll 4
          for (int i = 0; i < 128; ++i) {
            const float wv = p.pool_w[(size_t)(g * 128 + i) * 128 + o];
#pragma unroll
            for (int tt = 0; tt < 8; ++tt) acc[tt] += dbase[tt * 128 + i] * wv;
          }
#pragma unroll
          for (int tt = 0; tt < 8; ++tt) p.mix[(rbase + tg * 32 + pass * 8 + tt) * 1024 + 512 + g * 128 + o] = f2bf(acc[tt] * ps);
        }
      }
      __syncthreads();
    }
  }
}

#define SORT16(X) do { unsigned h_, l_; h_ = X[0] > X[1] ? X[0] : X[1]; l_ = X[0] > X[1] ? X[1] : X[0]; X[0] = h_; X[1] = l_; h_ = X[3] > X[2] ? X[3] : X[2]; l_ = X[3] > X[2] ? X[2] : X[3]; X[3] = h_; X[2] = l_; h_ = X[4] > X[5] ? X[4] : X[5]; l_ = X[4] > X[5] ? X[5] : X[4]; X[4] = h_; X[5] = l_; h_ = X[7] > X[6] ? X[7] : X[6]; l_ = X[7] > X[6] ? X[6] : X[7]; X[7] = h_; X[6] = l_; h_ = X[8] > X[9] ? X[8] : X[9]; l_ = X[8] > X[9] ? X[9] : X[8]; X[8] = h_; X[9] = l_; h_ = X[11] > X[10] ? X[11] : X[10]; l_ = X[11] > X[10] ? X[10] : X[11]; X[11] = h_; X[10] = l_; h_ = X[12] > X[13] ? X[12] : X[13]; l_ = X[12] > X[13] ? X[13] : X[12]; X[12] = h_; X[13] = l_; h_ = X[15] > X[14] ? X[15] : X[14]; l_ = X[15] > X[14] ? X[14] : X[15]; X[15] = h_; X[14] = l_; h_ = X[0] > X[2] ? X[0] : X[2]; l_ = X[0] > X[2] ? X[2] : X[0]; X[0] = h_; X[2] = l_; h_ = X[1] > X[3] ? X[1] : X[3]; l_ = X[1] > X[3] ? X[3] : X[1]; X[1] = h_; X[3] = l_; h_ = X[6] > X[4] ? X[6] : X[4]; l_ = X[6] > X[4] ? X[4] : X[6]; X[6] = h_; X[4] = l_; h_ = X[7] > X[5] ? X[7] : X[5]; l_ = X[7] > X[5] ? X[5] : X[7]; X[7] = h_; X[5] = l_; h_ = X[8] > X[10] ? X[8] : X[10]; l_ = X[8] > X[10] ? X[10] : X[8]; X[8] = h_; X[10] = l_; h_ = X[9] > X[11] ? X[9] : X[11]; l_ = X[9] > X[11] ? X[11] : X[9]; X[9] = h_; X[11] = l_; h_ = X[14] > X[12] ? X[14] : X[12]; l_ = X[14] > X[12] ? X[12] : X[14]; X[14] = h_; X[12] = l_; h_ = X[15] > X[13] ? X[15] : X[13]; l_ = X[15] > X[13] ? X[13] : X[15]; X[15] = h_; X[13] = l_; h_ = X[0] > X[1] ? X[0] : X[1]; l_ = X[0] > X[1] ? X[1] : X[0]; X[0] = h_; X[1] = l_; h_ = X[2] > X[3] ? X[2] : X[3]; l_ = X[2] > X[3] ? X[3] : X[2]; X[2] = h_; X[3] = l_; h_ = X[5] > X[4] ? X[5] : X[4]; l_ = X[5] > X[4] ? X[4] : X[5]; X[5] = h_; X[4] = l_; h_ = X[7] > X[6] ? X[7] : X[6]; l_ = X[7] > X[6] ? X[6] : X[7]; X[7] = h_; X[6] = l_; h_ = X[8] > X[9] ? X[8] : X[9]; l_ = X[8] > X[9] ? X[9] : X[8]; X[8] = h_; X[9] = l_; h_ = X[10] > X[11] ? X[10] : X[11]; l_ = X[10] > X[11] ? X[11] : X[10]; X[10] = h_; X[11] = l_; h_ = X[13] > X[12] ? X[13] : X[12]; l_ = X[13] > X[12] ? X[12] : X[13]; X[13] = h_; X[12] = l_; h_ = X[15] > X[14] ? X[15] : X[14]; l_ = X[15] > X[14] ? X[14] : X[15]; X[15] = h_; X[14] = l_; h_ = X[0] > X[4] ? X[0] : X[4]; l_ = X[0] > X[4] ? X[4] : X[0]; X[0] = h_; X[4] = l_; h_ = X[1] > X[5] ? X[1] : X[5]; l_ = X[1] > X[5] ? X[5] : X[1]; X[1] = h_; X[5] = l_; h_ = X[2] > X[6] ? X[2] : X[6]; l_ = X[2] > X[6] ? X[6] : X[2]; X[2] = h_; X[6] = l_; h_ = X[3] > X[7] ? X[3] : X[7]; l_ = X[3] > X[7] ? X[7] : X[3]; X[3] = h_; X[7] = l_; h_ = X[12] > X[8] ? X[12] : X[8]; l_ = X[12] > X[8] ? X[8] : X[12]; X[12] = h_; X[8] = l_; h_ = X[13] > X[9] ? X[13] : X[9]; l_ = X[13] > X[9] ? X[9] : X[13]; X[13] = h_; X[9] = l_; h_ = X[14] > X[10] ? X[14] : X[10]; l_ = X[14] > X[10] ? X[10] : X[14]; X[14] = h_; X[10] = l_; h_ = X[15] > X[11] ? X[15] : X[11]; l_ = X[15] > X[11] ? X[11] : X[15]; X[15] = h_; X[11] = l_; h_ = X[0] > X[2] ? X[0] : X[2]; l_ = X[0] > X[2] ? X[2] : X[0]; X[0] = h_; X[2] = l_; h_ = X[1] > X[3] ? X[1] : X[3]; l_ = X[1] > X[3] ? X[3] : X[1]; X[1] = h_; X[3] = l_; h_ = X[4] > X[6] ? X[4] : X[6]; l_ = X[4] > X[6] ? X[6] : X[4]; X[4] = h_; X[6] = l_; h_ = X[5] > X[7] ? X[5] : X[7]; l_ = X[5] > X[7] ? X[7] : X[5]; X[5] = h_; X[7] = l_; h_ = X[10] > X[8] ? X[10] : X[8]; l_ = X[10] > X[8] ? X[8] : X[10]; X[10] = h_; X[8] = l_; h_ = X[11] > X[9] ? X[11] : X[9]; l_ = X[11] > X[9] ? X[9] : X[11]; X[11] = h_; X[9] = l_; h_ = X[14] > X[12] ? X[14] : X[12]; l_ = X[14] > X[12] ? X[12] : X[14]; X[14] = h_; X[12] = l_; h_ = X[15] > X[13] ? X[15] : X[13]; l_ = X[15] > X[13] ? X[13] : X[15]; X[15] = h_; X[13] = l_; h_ = X[0] > X[1] ? X[0] : X[1]; l_ = X[0] > X[1] ? X[1] : X[0]; X[0] = h_; X[1] = l_; h_ = X[2] > X[3] ? X[2] : X[3]; l_ = X[2] > X[3] ? X[3] : X[2]; X[2] = h_; X[3] = l_; h_ = X[4] > X[5] ? X[4] : X[5]; l_ = X[4] > X[5] ? X[5] : X[4]; X[4] = h_; X[5] = l_; h_ = X[6] > X[7] ? X[6] : X[7]; l_ = X[6] > X[7] ? X[7] : X[6]; X[6] = h_; X[7] = l_; h_ = X[9] > X[8] ? X[9] : X[8]; l_ = X[9] > X[8] ? X[8] : X[9]; X[9] = h_; X[8] = l_; h_ = X[11] > X[10] ? X[11] : X[10]; l_ = X[11] > X[10] ? X[10] : X[11]; X[11] = h_; X[10] = l_; h_ = X[13] > X[12] ? X[13] : X[12]; l_ = X[13] > X[12] ? X[12] : X[13]; X[13] = h_; X[12] = l_; h_ = X[15] > X[14] ? X[15] : X[14]; l_ = X[15] > X[14] ? X[14] : X[15]; X[15] = h_; X[14] = l_; h_ = X[0] > X[8] ? X[0] : X[8]; l_ = X[0] > X[8] ? X[8] : X[0]; X[0] = h_; X[8] = l_; h_ = X[1] > X[9] ? X[1] : X[9]; l_ = X[1] > X[9] ? X[9] : X[1]; X[1] = h_; X[9] = l_; h_ = X[2] > X[10] ? X[2] : X[10]; l_ = X[2] > X[10] ? X[10] : X[2]; X[2] = h_; X[10] = l_; h_ = X[3] > X[11] ? X[3] : X[11]; l_ = X[3] > X[11] ? X[11] : X[3]; X[3] = h_; X[11] = l_; h_ = X[4] > X[12] ? X[4] : X[12]; l_ = X[4] > X[12] ? X[12] : X[4]; X[4] = h_; X[12] = l_; h_ = X[5] > X[13] ? X[5] : X[13]; l_ = X[5] > X[13] ? X[13] : X[5]; X[5] = h_; X[13] = l_; h_ = X[6] > X[14] ? X[6] : X[14]; l_ = X[6] > X[14] ? X[14] : X[6]; X[6] = h_; X[14] = l_; h_ = X[7] > X[15] ? X[7] : X[15]; l_ = X[7] > X[15] ? X[15] : X[7]; X[7] = h_; X[15] = l_; h_ = X[0] > X[4] ? X[0] : X[4]; l_ = X[0] > X[4] ? X[4] : X[0]; X[0] = h_; X[4] = l_; h_ = X[1] > X[5] ? X[1] : X[5]; l_ = X[1] > X[5] ? X[5] : X[1]; X[1] = h_; X[5] = l_; h_ = X[2] > X[6] ? X[2] : X[6]; l_ = X[2] > X[6] ? X[6] : X[2]; X[2] = h_; X[6] = l_; h_ = X[3] > X[7] ? X[3] : X[7]; l_ = X[3] > X[7] ? X[7] : X[3]; X[3] = h_; X[7] = l_; h_ = X[8] > X[12] ? X[8] : X[12]; l_ = X[8] > X[12] ? X[12] : X[8]; X[8] = h_; X[12] = l_; h_ = X[9] > X[13] ? X[9] : X[13]; l_ = X[9] > X[13] ? X[13] : X[9]; X[9] = h_; X[13] = l_; h_ = X[10] > X[14] ? X[10] : X[14]; l_ = X[10] > X[14] ? X[14] : X[10]; X[10] = h_; X[14] = l_; h_ = X[11] > X[15] ? X[11] : X[15]; l_ = X[11] > X[15] ? X[15] : X[11]; X[11] = h_; X[15] = l_; h_ = X[0] > X[2] ? X[0] : X[2]; l_ = X[0] > X[2] ? X[2] : X[0]; X[0] = h_; X[2] = l_; h_ = X[1] > X[3] ? X[1] : X[3]; l_ = X[1] > X[3] ? X[3] : X[1]; X[1] = h_; X[3] = l_; h_ = X[4] > X[6] ? X[4] : X[6]; l_ = X[4] > X[6] ? X[6] : X[4]; X[4] = h_; X[6] = l_; h_ = X[5] > X[7] ? X[5] : X[7]; l_ = X[5] > X[7] ? X[7] : X[5]; X[5] = h_; X[7] = l_; h_ = X[8] > X[10] ? X[8] : X[10]; l_ = X[8] > X[10] ? X[10] : X[8]; X[8] = h_; X[10] = l_; h_ = X[9] > X[11] ? X[9] : X[11]; l_ = X[9] > X[11] ? X[11] : X[9]; X[9] = h_; X[11] = l_; h_ = X[12] > X[14] ? X[12] : X[14]; l_ = X[12] > X[14] ? X[14] : X[12]; X[12] = h_; X[14] = l_; h_ = X[13] > X[15] ? X[13] : X[15]; l_ = X[13] > X[15] ? X[15] : X[13]; X[13] = h_; X[15] = l_; h_ = X[0] > X[1] ? X[0] : X[1]; l_ = X[0] > X[1] ? X[1] : X[0]; X[0] = h_; X[1] = l_; h_ = X[2] > X[3] ? X[2] : X[3]; l_ = X[2] > X[3] ? X[3] : X[2]; X[2] = h_; X[3] = l_; h_ = X[4] > X[5] ? X[4] : X[5]; l_ = X[4] > X[5] ? X[5] : X[4]; X[4] = h_; X[5] = l_; h_ = X[6] > X[7] ? X[6] : X[7]; l_ = X[6] > X[7] ? X[7] : X[6]; X[6] = h_; X[7] = l_; h_ = X[8] > X[9] ? X[8] : X[9]; l_ = X[8] > X[9] ? X[9] : X[8]; X[8] = h_; X[9] = l_; h_ = X[10] > X[11] ? X[10] : X[11]; l_ = X[10] > X[11] ? X[11] : X[10]; X[10] = h_; X[11] = l_; h_ = X[12] > X[13] ? X[12] : X[13]; l_ = X[12] > X[13] ? X[13] : X[12]; X[12] = h_; X[13] = l_; h_ = X[14] > X[15] ? X[14] : X[15]; l_ = X[14] > X[15] ? X[15] : X[14]; X[14] = h_; X[15] = l_; } while (0)
#define MERGE16(X) do { unsigned h_, l_; h_ = X[0] > X[8] ? X[0] : X[8]; l_ = X[0] > X[8] ? X[8] : X[0]; X[0] = h_; X[8] = l_; h_ = X[1] > X[9] ? X[1] : X[9]; l_ = X[1] > X[9] ? X[9] : X[1]; X[1] = h_; X[9] = l_; h_ = X[2] > X[10] ? X[2] : X[10]; l_ = X[2] > X[10] ? X[10] : X[2]; X[2] = h_; X[10] = l_; h_ = X[3] > X[11] ? X[3] : X[11]; l_ = X[3] > X[11] ? X[11] : X[3]; X[3] = h_; X[11] = l_; h_ = X[4] > X[12] ? X[4] : X[12]; l_ = X[4] > X[12] ? X[12] : X[4]; X[4] = h_; X[12] = l_; h_ = X[5] > X[13] ? X[5] : X[13]; l_ = X[5] > X[13] ? X[13] : X[5]; X[5] = h_; X[13] = l_; h_ = X[6] > X[14] ? X[6] : X[14]; l_ = X[6] > X[14] ? X[14] : X[6]; X[6] = h_; X[14] = l_; h_ = X[7] > X[15] ? X[7] : X[15]; l_ = X[7] > X[15] ? X[15] : X[7]; X[7] = h_; X[15] = l_; h_ = X[0] > X[4] ? X[0] : X[4]; l_ = X[0] > X[4] ? X[4] : X[0]; X[0] = h_; X[4] = l_; h_ = X[1] > X[5] ? X[1] : X[5]; l_ = X[1] > X[5] ? X[5] : X[1]; X[1] = h_; X[5] = l_; h_ = X[2] > X[6] ? X[2] : X[6]; l_ = X[2] > X[6] ? X[6] : X[2]; X[2] = h_; X[6] = l_; h_ = X[3] > X[7] ? X[3] : X[7]; l_ = X[3] > X[7] ? X[7] : X[3]; X[3] = h_; X[7] = l_; h_ = X[8] > X[12] ? X[8] : X[12]; l_ = X[8] > X[12] ? X[12] : X[8]; X[8] = h_; X[12] = l_; h_ = X[9] > X[13] ? X[9] : X[13]; l_ = X[9] > X[13] ? X[13] : X[9]; X[9] = h_; X[13] = l_; h_ = X[10] > X[14] ? X[10] : X[14]; l_ = X[10] > X[14] ? X[14] : X[10]; X[10] = h_; X[14] = l_; h_ = X[11] > X[15] ? X[11] : X[15]; l_ = X[11] > X[15] ? X[15] : X[11]; X[11] = h_; X[15] = l_; h_ = X[0] > X[2] ? X[0] : X[2]; l_ = X[0] > X[2] ? X[2] : X[0]; X[0] = h_; X[2] = l_; h_ = X[1] > X[3] ? X[1] : X[3]; l_ = X[1] > X[3] ? X[3] : X[1]; X[1] = h_; X[3] = l_; h_ = X[4] > X[6] ? X[4] : X[6]; l_ = X[4] > X[6] ? X[6] : X[4]; X[4] = h_; X[6] = l_; h_ = X[5] > X[7] ? X[5] : X[7]; l_ = X[5] > X[7] ? X[7] : X[5]; X[5] = h_; X[7] = l_; h_ = X[8] > X[10] ? X[8] : X[10]; l_ = X[8] > X[10] ? X[10] : X[8]; X[8] = h_; X[10] = l_; h_ = X[9] > X[11] ? X[9] : X[11]; l_ = X[9] > X[11] ? X[11] : X[9]; X[9] = h_; X[11] = l_; h_ = X[12] > X[14] ? X[12] : X[14]; l_ = X[12] > X[14] ? X[14] : X[12]; X[12] = h_; X[14] = l_; h_ = X[13] > X[15] ? X[13] : X[15]; l_ = X[13] > X[15] ? X[15] : X[13]; X[13] = h_; X[15] = l_; h_ = X[0] > X[1] ? X[0] : X[1]; l_ = X[0] > X[1] ? X[1] : X[0]; X[0] = h_; X[1] = l_; h_ = X[2] > X[3] ? X[2] : X[3]; l_ = X[2] > X[3] ? X[3] : X[2]; X[2] = h_; X[3] = l_; h_ = X[4] > X[5] ? X[4] : X[5]; l_ = X[4] > X[5] ? X[5] : X[4]; X[4] = h_; X[5] = l_; h_ = X[6] > X[7] ? X[6] : X[7]; l_ = X[6] > X[7] ? X[7] : X[6]; X[6] = h_; X[7] = l_; h_ = X[8] > X[9] ? X[8] : X[9]; l_ = X[8] > X[9] ? X[9] : X[8]; X[8] = h_; X[9] = l_; h_ = X[10] > X[11] ? X[10] : X[11]; l_ = X[10] > X[11] ? X[11] : X[10]; X[10] = h_; X[11] = l_; h_ = X[12] > X[13] ? X[12] : X[13]; l_ = X[12] > X[13] ? X[13] : X[12]; X[12] = h_; X[13] = l_; h_ = X[14] > X[15] ? X[14] : X[15]; l_ = X[14] > X[15] ? X[15] : X[14]; X[14] = h_; X[15] = l_; } while (0)

__device__ __forceinline__ unsigned f2ord(float f) { const unsigned u = __float_as_uint(f); return (u & 0x80000000u) ? ~u : (u | 0x80000000u); }
__device__ __forceinline__ float ord2f(unsigned o) { return __uint_as_float((o & 0x80000000u) ? (o & 0x7fffffffu) : ~o); }
#define CANDKEY(sum, c) ((f2ord(sum) & ~255u) | (255u - (unsigned)(c)))
__device__ __forceinline__ void xmerge16(unsigned (&X)[16], int mask) {
  unsigned T[16];
#pragma unroll
  for (int i = 0; i < 16; ++i) T[i] = (unsigned)__shfl_xor((int)X[15 - i], mask);
#pragma unroll
  for (int i = 0; i < 16; ++i) X[i] = X[i] > T[i] ? X[i] : T[i];
  MERGE16(X);
}

__device__ __forceinline__ void ph9_topk(const P& p, int bid, int nb, char* smem) {
  const int tid = threadIdx.x & 255, lane = tid & 63, wave = tid >> 6, lr = lane & 15, lq = lane >> 4;
  int* idxs = (int*)smem + wave * 512;
  const int gw = bid * 4 + wave, ngw = nb * 4;
  const __amdgpu_buffer_rsrc_t r_q = mk_rsrc(p.qb), r_k = mk_rsrc(p.keys_bf);
  for (int it = gw; it < 1024 * 8; it += ngw) {
    const int h = it & 7, tile = it >> 3;
    const int tok = tile * 16 + lr;
    unsigned R0[16], R1[16];
#pragma unroll
    for (int pp = 0; pp < 2; ++pp) {
      bf16x8 bq[4];
#pragma unroll
      for (int kk = 0; kk < 4; ++kk) bq[kk] = bload8(r_q, (lr * 2048 + lq * 8) * 2 + kk * 64, (tile * 16 * 2048 + h * 256 + pp * 128) * 2);
      f32x4 acc[8];
#pragma unroll
      for (int j = 0; j < 8; ++j) acc[j] = (f32x4){0.f, 0.f, 0.f, 0.f};
#pragma unroll
      for (int j = 0; j < 8; ++j)
#pragma unroll
        for (int kk = 0; kk < 4; ++kk) {
          const bf16x8 a = bload8(r_k, (lr * 128 + lq * 8) * 2 + kk * 64, ((h * 2 + pp) * 16384 + j * 2048) * 2);
          acc[j] = __builtin_amdgcn_mfma_f32_16x16x32_bf16(a, bq[kk], acc[j], 0, 0, 0);
        }
      unsigned X[16], Y[16];
#pragma unroll
      for (int j = 0; j < 4; ++j)
#pragma unroll
        for (int e = 0; e < 4; ++e) {
          X[j * 4 + e] = (f2ord(acc[j][e]) & ~127u) | (127u - (unsigned)(j * 16 + lq * 4 + e));
          Y[j * 4 + e] = (f2ord(acc[4 + j][e]) & ~127u) | (127u - (unsigned)((4 + j) * 16 + lq * 4 + e));
        }
      SORT16(X);
      SORT16(Y);
#pragma unroll
      for (int i = 0; i < 16; ++i) X[i] = X[i] > Y[15 - i] ? X[i] : Y[15 - i];
      MERGE16(X);
      xmerge16(X, 16);
      xmerge16(X, 32);
#pragma unroll
      for (int i = 0; i < 16; ++i) { if (pp == 0) R0[i] = X[i]; else R1[i] = X[i]; }
    }
    if (lq == 0) {
#pragma unroll
      for (int i = 0; i < 16; ++i) { idxs[lr * 32 + i] = 127 - (int)(R0[i] & 127u); idxs[lr * 32 + 16 + i] = 127 - (int)(R1[i] & 127u); }
    }
    float va[16], vb[16];
#pragma unroll
    for (int i = 0; i < 16; ++i) { va[i] = ord2f(R0[i] & ~127u); vb[i] = ord2f(R1[i] & ~127u); }
    unsigned F[16];
  F[0] = lq == 0 ? CANDKEY(va[0] + vb[0], 0) : (lq == 1 ? CANDKEY(va[1] + vb[0], 16) : (lq == 2 ? CANDKEY(va[3] + vb[0], 48) : CANDKEY(va[13] + vb[0], 208)));
  F[1] = lq == 0 ? CANDKEY(va[0] + vb[1], 1) : (lq == 1 ? CANDKEY(va[1] + vb[1], 17) : (lq == 2 ? CANDKEY(va[3] + vb[1], 49) : CANDKEY(va[14] + vb[0], 224)));
  F[2] = lq == 0 ? CANDKEY(va[0] + vb[2], 2) : (lq == 1 ? CANDKEY(va[1] + vb[2], 18) : (lq == 2 ? CANDKEY(va[3] + vb[2], 50) : CANDKEY(va[15] + vb[0], 240)));
  F[3] = lq == 0 ? CANDKEY(va[0] + vb[3], 3) : (lq == 1 ? CANDKEY(va[1] + vb[3], 19) : (lq == 2 ? CANDKEY(va[3] + vb[3], 51) : 0u));
  F[4] = lq == 0 ? CANDKEY(va[0] + vb[4], 4) : (lq == 1 ? CANDKEY(va[1] + vb[4], 20) : (lq == 2 ? CANDKEY(va[4] + vb[0], 64) : 0u));
  F[5] = lq == 0 ? CANDKEY(va[0] + vb[5], 5) : (lq == 1 ? CANDKEY(va[1] + vb[5], 21) : (lq == 2 ? CANDKEY(va[4] + vb[1], 65) : 0u));
  F[6] = lq == 0 ? CANDKEY(va[0] + vb[6], 6) : (lq == 1 ? CANDKEY(va[1] + vb[6], 22) : (lq == 2 ? CANDKEY(va[4] + vb[2], 66) : 0u));
  F[7] = lq == 0 ? CANDKEY(va[0] + vb[7], 7) : (lq == 1 ? CANDKEY(va[1] + vb[7], 23) : (lq == 2 ? CANDKEY(va[6] + vb[0], 96) : 0u));
  F[8] = lq == 0 ? CANDKEY(va[0] + vb[8], 8) : (lq == 1 ? CANDKEY(va[2] + vb[0], 32) : (lq == 2 ? CANDKEY(va[6] + vb[1], 97) : 0u));
  F[9] = lq == 0 ? CANDKEY(va[0] + vb[9], 9) : (lq == 1 ? CANDKEY(va[2] + vb[1], 33) : (lq == 2 ? CANDKEY(va[7] + vb[0], 112) : 0u));
  F[10] = lq == 0 ? CANDKEY(va[0] + vb[10], 10) : (lq == 1 ? CANDKEY(va[2] + vb[2], 34) : (lq == 2 ? CANDKEY(va[7] + vb[1], 113) : 0u));
  F[11] = lq == 0 ? CANDKEY(va[0] + vb[11], 11) : (lq == 1 ? CANDKEY(va[2] + vb[3], 35) : (lq == 2 ? CANDKEY(va[8] + vb[0], 128) : 0u));
  F[12] = lq == 0 ? CANDKEY(va[0] + vb[12], 12) : (lq == 1 ? CANDKEY(va[2] + vb[4], 36) : (lq == 2 ? CANDKEY(va[9] + vb[0], 144) : 0u));
  F[13] = lq == 0 ? CANDKEY(va[0] + vb[13], 13) : (lq == 1 ? CANDKEY(va[5] + vb[0], 80) : (lq == 2 ? CANDKEY(va[10] + vb[0], 160) : 0u));
  F[14] = lq == 0 ? CANDKEY(va[0] + vb[14], 14) : (lq == 1 ? CANDKEY(va[5] + vb[1], 81) : (lq == 2 ? CANDKEY(va[11] + vb[0], 176) : 0u));
  F[15] = lq == 0 ? CANDKEY(va[0] + vb[15], 15) : (lq == 1 ? 0u : (lq == 2 ? CANDKEY(va[12] + vb[0], 192) : 0u));

    SORT16(F);
    xmerge16(F, 16);
    xmerge16(F, 32);
    if (lq == 0) {
      float ev[16];
      const float mx = ord2f(F[0] & ~255u);
      float tot = 0.f;
#pragma unroll
      for (int r = 0; r < 16; ++r) { ev[r] = __expf(ord2f(F[r] & ~255u) - mx); tot += ev[r]; }
      const float inv = 1.f / tot;
      int ei[16];
#pragma unroll
      for (int r = 0; r < 16; ++r) {
        const int c = 255 - (int)(F[r] & 255u);
        ei[r] = idxs[lr * 32 + (c >> 4)] * 128 + idxs[lr * 32 + 16 + (c & 15)];
      }
      int* ep = p.eidx + (size_t)tok * 128 + h * 16;
      float* gp = p.gate + (size_t)tok * 128 + h * 16;
#pragma unroll
      for (int r = 0; r < 4; ++r) {
        *(u32x4*)(ep + r * 4) = (u32x4){(unsigned)ei[r * 4], (unsigned)ei[r * 4 + 1], (unsigned)ei[r * 4 + 2], (unsigned)ei[r * 4 + 3]};
        *(f32x4*)(gp + r * 4) = (f32x4){ev[r * 4] * inv, ev[r * 4 + 1] * inv, ev[r * 4 + 2] * inv, ev[r * 4 + 3] * inv};
      }
    }
  }
}

__device__ __forceinline__ void ph_convert_tables(const P& p, int bid, int nb) {
  const int wave = (threadIdx.x >> 6) & 3, lane = threadIdx.x & 63;
  for (int row = bid * 4 + wave; row < 32768; row += nb * 4) {
    const float* src = row < 16384 ? p.U + (size_t)row * 1024 : p.V + (size_t)(row - 16384) * 1024;
    bf16_t* dst = row < 16384 ? p.Ubf + (size_t)row * 1024 : p.Vbf + (size_t)(row - 16384) * 1024;
#pragma unroll
    for (int j = 0; j < 4; ++j) {
      const f32x4 v = __builtin_nontemporal_load((const f32x4*)src + j * 64 + lane);
      u32x2 o;
      o.x = (unsigned)f2bf(v.x) | ((unsigned)f2bf(v.y) << 16);
      o.y = (unsigned)f2bf(v.z) | ((unsigned)f2bf(v.w) << 16);
      *(u32x2*)(dst + j * 256 + lane * 4) = o;
    }
  }
}
__device__ __forceinline__ float dot2bf(unsigned a, unsigned b, float c) {
  return __builtin_amdgcn_fdot2_f32_bf16(__builtin_bit_cast(bf16x2, a), __builtin_bit_cast(bf16x2, b), c, false);
}
__device__ __forceinline__ float gelu_exact(float a) { return 0.5f * a * (1.f + erff(a * 0.70710678118654752f)); }

#define G_LOAD(buf, s_) do { const int s__ = (s_); const bf16_t* tab__ = s__ < 32 ? p.Ubf : p.Vbf; const int er__ = (s__ & 16) ? e1 : e0; \
    _Pragma("unroll") for (int k = 0; k < 4; ++k) { const int e__ = __builtin_amdgcn_readlane(er__, (s__ & 15) * 4 + k); \
      const u32x4* r__ = (const u32x4*)(tab__ + (size_t)e__ * 1024) + lane; buf[k][0] = r__[0]; buf[k][1] = r__[64]; } } while (0)
#define G_COMPUTE(buf, s_) do { const int s__ = (s_); \
    if (s__ < 32) { \
      _Pragma("unroll") for (int k = 0; k < 4; ++k) { \
        float d0 = dot2bf(buf[k][0].x, xp0.x, 0.f), d1 = dot2bf(buf[k][0].y, xp0.y, 0.f); \
        d0 = dot2bf(buf[k][0].z, xp0.z, d0); d1 = dot2bf(buf[k][0].w, xp0.w, d1); \
        d0 = dot2bf(buf[k][1].x, xp1.x, d0); d1 = dot2bf(buf[k][1].y, xp1.y, d1); \
        d0 = dot2bf(buf[k][1].z, xp1.z, d0); d1 = dot2bf(buf[k][1].w, xp1.w, d1); \
        const float sm__ = wave_sum(d0 + d1); \
        if (lane == (s__ & 15) * 4 + k) { if (s__ & 16) a1 = sm__; else a0 = sm__; } } \
    } else { \
      if (s__ == 32) { w0 = gelu_exact(a0) * g0; w1 = gelu_exact(a1) * g1; } \
      const int wr__ = __float_as_int((s__ & 16) ? w1 : w0); \
      _Pragma("unroll") for (int k = 0; k < 4; ++k) { \
        const float w__ = __int_as_float(__builtin_amdgcn_readlane(wr__, (s__ & 15) * 4 + k)); \
        _Pragma("unroll") for (int h = 0; h < 2; ++h) { \
          const u32x4 q__ = buf[k][h]; \
          y[h * 8 + 0] += w__ * __uint_as_float(q__.x << 16); y[h * 8 + 1] += w__ * __uint_as_float(q__.x & 0xffff0000u); \
          y[h * 8 + 2] += w__ * __uint_as_float(q__.y << 16); y[h * 8 + 3] += w__ * __uint_as_float(q__.y & 0xffff0000u); \
          y[h * 8 + 4] += w__ * __uint_as_float(q__.z << 16); y[h * 8 + 5] += w__ * __uint_as_float(q__.z & 0xffff0000u); \
          y[h * 8 + 6] += w__ * __uint_as_float(q__.w << 16); y[h * 8 + 7] += w__ * __uint_as_float(q__.w & 0xffff0000u); } } \
    } } while (0)

__device__ __forceinline__ void ph10_gather(const P& p, int bid, int nb) {
  const int wave = __builtin_amdgcn_readfirstlane((threadIdx.x >> 6) & 3), lane = threadIdx.x & 63;
  for (int tok = bid * 4 + wave; tok < TL; tok += nb * 4) {
    const int b = tok / SEQ;
    const u32x4 xp0 = *((const u32x4*)(p.hn + (size_t)tok * 1024) + lane);
    const u32x4 xp1 = *((const u32x4*)(p.hn + (size_t)tok * 1024) + 64 + lane);
    const int e0 = p.eidx[(size_t)tok * 128 + lane], e1 = p.eidx[(size_t)tok * 128 + 64 + lane];
    const float g0 = p.gate[(size_t)tok * 128 + lane], g1 = p.gate[(size_t)tok * 128 + 64 + lane];
    float a0 = 0.f, a1 = 0.f, w0 = 0.f, w1 = 0.f;
    float y[16];
#pragma unroll
    for (int i = 0; i < 16; ++i) y[i] = 0.f;
    u32x4 A[4][2], B[4][2], C[4][2], D[4][2];
    G_LOAD(A, 0); G_LOAD(B, 1); G_LOAD(C, 2);
#pragma unroll 1
    for (int s = 0; s < 64; s += 4) {
      G_LOAD(D, s + 3);
      G_COMPUTE(A, s);
      if (s + 4 < 64) G_LOAD(A, s + 4);
      G_COMPUTE(B, s + 1);
      if (s + 5 < 64) G_LOAD(B, s + 5);
      G_COMPUTE(C, s + 2);
      if (s + 6 < 64) G_LOAD(C, s + 6);
      G_COMPUTE(D, s + 3);
    }
    float* orow = p.out + (size_t)tok * 1024;
    const float* g2 = p.mod + b * 6144 + 5 * 1024;
    float z[16];
    float ss = 0.f;
#pragma unroll
    for (int h = 0; h < 2; ++h)
#pragma unroll
      for (int q = 0; q < 2; ++q) {
        const int col = h * 512 + lane * 8 + q * 4;
        const f32x4 xl = *(const f32x4*)(orow + col);
        const f32x4 gg = *(const f32x4*)(g2 + col);
#pragma unroll
        for (int i = 0; i < 4; ++i) { const float zz = xl[i] + gg[i] * y[h * 8 + q * 4 + i]; z[h * 8 + q * 4 + i] = zz; ss += zz * zz; }
      }
    ss = wave_sum(ss);
    const float rstd = rsqrtf(ss * (1.f / 1024.f) + 1e-6f);
#pragma unroll
    for (int h = 0; h < 2; ++h)
#pragma unroll
      for (int q = 0; q < 2; ++q) {
        const int col = h * 512 + lane * 8 + q * 4;
        const f32x4 fw = *(const f32x4*)(p.final_norm_w + col);
        f32x4 o;
#pragma unroll
        for (int i = 0; i < 4; ++i) o[i] = z[h * 8 + q * 4 + i] * rstd * fw[i];
        *(f32x4*)(orow + col) = o;
      }
  }
}

__global__ void __launch_bounds__(2 * NTHR, 2) mega(P p) {
  __shared__ __attribute__((aligned(16))) char smem_all[2 * LDS_HALF];
  cg::grid_group grid = cg::this_grid();
  const int half = __builtin_amdgcn_readfirstlane(threadIdx.x >> 8);
  char* smem = smem_all + half * LDS_HALF;
  const int bid = blockIdx.x * 2 + half, nb = gridDim.x * 2;
#define RUN(k, call) if ((PHMASK & (1 << k)) && p.ph_lo <= k && k < p.ph_hi) { call; if (k + 1 < p.ph_hi) { asm volatile("s_waitcnt vmcnt(0)" ::: "memory"); grid.sync(); } }
  RUN(0, ph0_prep(p, bid, nb, smem))
  RUN(1, ph_norm_rows<0>(p, bid, nb))
  RUN(2, ph_gemm<0>(p, bid, nb, smem))
  RUN(3, ph3_chunk_local(p, bid, nb, smem))
  RUN(4, ph4_scan(p, bid, nb))
  RUN(5, ph5_mlstm_out(p, bid, nb, smem))
  RUN(6, (ph_gemm<1>(p, bid, nb, smem), ph_convert_tables(p, bid, nb)))
  RUN(7, ph_norm_rows<1>(p, bid, nb))
  RUN(8, ph_gemm<2>(p, bid, nb, smem))
  RUN(9, ph9_topk(p, bid, nb, smem))
  RUN(10, ph10_gather(p, bid, nb))
#undef RUN
}

extern "C" void kernel_launch(void* const* d_in, const int* in_sizes, int n_in, void* d_out, int out_size, void* d_ws, size_t ws_size,
                              hipStream_t stream) {
  static int grid_blocks = 0;
  if (!grid_blocks) {
    int dev = 0, cus = 0, per_cu = 0;
    hipGetDevice(&dev);
    hipDeviceGetAttribute(&cus, hipDeviceAttributeMultiprocessorCount, dev);
    hipOccupancyMaxActiveBlocksPerMultiprocessor(&per_cu, (const void*)mega, 2 * NTHR, 0);
    per_cu = 1;
    grid_blocks = cus * per_cu;
    if (ws_size < WS_END) fprintf(stderr, "kernel_launch: workspace too small: %zu < %llu\n", ws_size, (unsigned long long)WS_END);
  }
  P p{};
  const float* const* in = (const float* const*)d_in;
  p.x = in[0]; p.c = in[1]; p.ctx = in[2]; p.c_ctx = in[3]; p.w_mod = in[4]; p.b_mod = in[5]; p.norm1_w = in[6]; p.w_in = in[7];
  p.conv_w = in[8]; p.conv_b = in[9]; p.b_gates = in[10]; p.head_norm_w = in[11]; p.pool_w = in[12]; p.pool_scale = in[13];
  p.w_out = in[14]; p.norm2_w = in[15]; p.wq = in[16]; p.keys = in[17]; p.U = in[18]; p.V = in[19]; p.final_norm_w = in[20];
  p.out = (float*)d_out;
  char* ws = (char*)d_ws;
  p.mod = (float*)(ws + OFF_MOD); p.gates = (float*)(ws + OFF_GATES);
  p.wt_in = (bf16_t*)(ws + OFF_WTIN); p.wt_out = (bf16_t*)(ws + OFF_WTOUT); p.wt_q = (bf16_t*)(ws + OFF_WTQ);
  p.keys_bf = (bf16_t*)(ws + OFF_KEYS); p.hn = (bf16_t*)(ws + OFF_HN); p.pl = (bf16_t*)(ws + OFF_PL);
  p.Dst = (bf16_t*)(ws + OFF_D); p.ND = (float*)(ws + OFF_ND); p.SC = (float*)(ws + OFF_SC);
  p.CIN = (bf16_t*)(ws + OFF_CIN); p.NIN = (float*)(ws + OFF_NIN); p.MIN_ = (float*)(ws + OFF_MIN);
  p.mix = (bf16_t*)(ws + OFF_D); p.qb = (bf16_t*)(ws + OFF_D);
  p.Ubf = (bf16_t*)(ws + OFF_PL); p.Vbf = (bf16_t*)(ws + OFF_PL + 33554432ull);
  p.eidx = (int*)(ws + OFF_EIDX); p.gate = (float*)(ws + OFF_GATE);
#if N_LAUNCHES == 1
  p.ph_lo = 0; p.ph_hi = NPH;
  void* args[] = {&p};
  hipError_t e = hipLaunchCooperativeKernel((const void*)mega, dim3(grid_blocks), dim3(2 * NTHR), args, 0, stream);
  if (e != hipSuccess) fprintf(stderr, "cooperative launch failed: %s (grid %d)\n", hipGetErrorString(e), grid_blocks);
#else
  for (int ph = 0; ph < NPH; ++ph) {
    p.ph_lo = ph; p.ph_hi = ph + 1;
    void* args[] = {&p};
    hipError_t e = hipLaunchCooperativeKernel((const void*)mega, dim3(grid_blocks), dim3(2 * NTHR), args, 0, stream);
    if (e != hipSuccess) fprintf(stderr, "launch %d failed: %s (grid %d)\n", ph, hipGetErrorString(e), grid_blocks);
  }
#endif
}
```

```cpp
#include <hip/hip_runtime.h>
#include <hip/hip_cooperative_groups.h>
#include <stdint.h>
#include <stdio.h>
namespace cg = cooperative_groups;

#ifndef PHMASK
#define PHMASK 0x7ff
#endif
#ifndef N_LAUNCHES
#define N_LAUNCHES 1
#endif

typedef unsigned short bf16_t;
typedef short bf16x8 __attribute__((ext_vector_type(8)));
typedef float f32x4 __attribute__((ext_vector_type(4)));
typedef unsigned u32x4 __attribute__((ext_vector_type(4)));
typedef float f32x2 __attribute__((ext_vector_type(2)));
typedef unsigned u32x2 __attribute__((ext_vector_type(2)));
typedef __bf16 bf16x2 __attribute__((ext_vector_type(2)));

#define NB 8
#define SEQ 2048
#define DM 1024
#define CTXL 256
#define TL 16384
#define TC 2048
#define TR 18432
#define LDP 2624
#define NPADIN 2688
#define NTHR 256
#define LDS_HALF 73728
#define NPH 11

#define OFF_MOD    (4096ull)
#define OFF_GATES  (OFF_MOD + 262144ull)
#define OFF_WTIN   (OFF_GATES + 1179648ull)
#define OFF_WTOUT  (OFF_WTIN + 5505024ull)
#define OFF_WTQ    (OFF_WTOUT + 2097152ull)
#define OFF_KEYS   (OFF_WTQ + 4194304ull)
#define OFF_POOLWT (OFF_KEYS + 524288ull)
#define OFF_HN     (OFF_POOLWT + 131072ull)
#define OFF_PL     (OFF_HN + 37748736ull)
#define OFF_D      (OFF_PL + 96731136ull)
#define OFF_ND     (OFF_D + 37748736ull)
#define OFF_SC     (OFF_ND + 589824ull)
#define OFF_CIN    (OFF_SC + 147456ull)
#define OFF_NIN    (OFF_CIN + 33554432ull)
#define OFF_MIN    (OFF_NIN + 524288ull)
#define OFF_EIDX   (OFF_MIN + 131072ull)
#define OFF_GATE   (OFF_EIDX + 8388608ull)
#define WS_END     (OFF_GATE + 8388608ull)

struct P {
  const float *x, *c, *ctx, *c_ctx, *w_mod, *b_mod, *norm1_w, *w_in, *conv_w, *conv_b, *b_gates, *head_norm_w,
      *pool_w, *pool_scale, *w_out, *norm2_w, *wq, *keys, *U, *V, *final_norm_w;
  float* out;
  float* mod;
  float* gates;
  bf16_t* wt_in;
  bf16_t* wt_out;
  bf16_t* wt_q;
  bf16_t* keys_bf;
  bf16_t* hn;
  bf16_t* pl;
  bf16_t* Dst;
  float* ND;
  float* SC;
  bf16_t* CIN;
  float* NIN;
  float* MIN_;
  bf16_t* mix;
  bf16_t* qb;
  unsigned char* U8;
  unsigned char* V8;
  int* eidx;
  float* gate;
  int ph_lo, ph_hi;
};

__device__ __forceinline__ bf16_t f2bf(float f) { return __builtin_bit_cast(bf16_t, (__bf16)f); }
__device__ __forceinline__ float bf2f(bf16_t h) { return __uint_as_float(((unsigned)h) << 16); }
__device__ __forceinline__ float wave_sum(float v) {
#pragma unroll
  for (int o = 32; o > 0; o >>= 1) v += __shfl_xor(v, o);
  return v;
}
__device__ __forceinline__ float silu_f(float v) { return v / (1.f + __expf(-v)); }
__device__ __forceinline__ float logsig_f(float v) { return fminf(v, 0.f) - log1pf(__expf(-fabsf(v))); }

__device__ __forceinline__ void ph0_prep(const P& p, int bid, int nb, char* smem) {
  float* sm = (float*)smem;
  const int tid = threadIdx.x & 255;
  const int N_MOD = 24, N_TIN = 16 * 42, N_TOUT = 256, N_TQ = 16 * 32, N_POOL = 16;
  const int total = N_MOD + N_TIN + N_TOUT + N_TQ + N_POOL;
  const int trips = (total + nb - 1) / nb;
  for (int k = 0; k < trips; ++k) {
    int r = (bid + k * nb) % total;
    if (r < N_MOD) {
      for (int i = tid; i < 9 * 1024; i += NTHR) {
        int rr = i >> 10, kq = i & 1023;
        float v = rr < 8 ? p.c[rr * 1024 + kq] : p.c_ctx[kq];
        sm[i] = silu_f(v);
      }
      __syncthreads();
      int n = r * 256 + tid;
      float acc[9];
#pragma unroll
      for (int q = 0; q < 9; ++q) acc[q] = p.b_mod[n];
#pragma unroll 4
      for (int kq = 0; kq < 1024; ++kq) {
        float w = p.w_mod[(size_t)kq * 6144 + n];
#pragma unroll
        for (int q = 0; q < 9; ++q) acc[q] += sm[q * 1024 + kq] * w;
      }
#pragma unroll
      for (int q = 0; q < 9; ++q) p.mod[q * 6144 + n] = acc[q];
      __syncthreads();
      continue;
    }
    r -= N_MOD;
    const float* src = nullptr; bf16_t* dst = nullptr; int K = 1024, N = 0, ntn = 0;
    if (r < N_TIN) { src = p.w_in; dst = p.wt_in; N = 2576; ntn = 42; }
    else { r -= N_TIN;
      if (r < N_TOUT) { src = p.w_out; dst = p.wt_out; N = 1024; ntn = 16; }
      else { r -= N_TOUT;
        if (r < N_TQ) { src = p.wq; dst = p.wt_q; N = 2048; ntn = 32; }
        else { r -= N_TQ; int g = r >> 2; r &= 3; src = p.pool_w + g * 16384; dst = (bf16_t*)((char*)p.keys_bf + 524288) + g * 16384; K = 128; N = 128; ntn = 2; }
      }
    }
    {
      int kt = r / ntn, nt = r % ntn, k0 = kt * 64, n0 = nt * 64;
      int cc = tid & 63;
      for (int rr = tid >> 6; rr < 64; rr += 4) {
        int n = n0 + cc;
        sm[rr * 65 + cc] = n < N ? src[(size_t)(k0 + rr) * N + n] : 0.f;
      }
      __syncthreads();
      for (int rr = tid >> 6; rr < 64; rr += 4) dst[(size_t)(n0 + rr) * K + k0 + cc] = f2bf(sm[cc * 65 + rr]);
      __syncthreads();
    }
  }
  for (int i = bid * NTHR + tid; i < 262144; i += nb * NTHR) p.keys_bf[i] = f2bf(p.keys[i]);
}

template <int WHICH>
__device__ __forceinline__ void ph_norm_rows(const P& p, int bid, int nb) {
  const int wave = (threadIdx.x >> 6) & 3, lane = threadIdx.x & 63;
  const int nrows = WHICH == 0 ? TR : TL;
  for (int row = bid * 4 + wave; row < nrows; row += nb * 4) {
    const float* src = WHICH == 0 ? (row < TL ? p.x + (size_t)row * 1024 : p.ctx + (size_t)(row - TL) * 1024) : p.out + (size_t)row * 1024;
    const int mr = row < TL ? row / SEQ : 8;
    float4 v[4];
    float ss = 0.f;
#pragma unroll
    for (int j = 0; j < 4; ++j) {
      v[j] = ((const float4*)src)[j * 64 + lane];
      ss += v[j].x * v[j].x + v[j].y * v[j].y + v[j].z * v[j].z + v[j].w * v[j].w;
    }
    ss = wave_sum(ss);
    const float rstd = rsqrtf(ss * (1.f / 1024.f) + 1e-6f);
    const float* nw = WHICH == 0 ? p.norm1_w : p.norm2_w;
    const float* sh = p.mod + mr * 6144 + (WHICH == 0 ? 0 : 3) * 1024;
    const float* sc = sh + 1024;
#pragma unroll
    for (int j = 0; j < 4; ++j) {
      const int col = j * 256 + lane * 4;
      float4 w4 = *(const float4*)(nw + col), s4 = *(const float4*)(sh + col), c4 = *(const float4*)(sc + col);
      float y0 = v[j].x * rstd * w4.x * (1.f + c4.x) + s4.x;
      float y1 = v[j].y * rstd * w4.y * (1.f + c4.y) + s4.y;
      float y2 = v[j].z * rstd * w4.z * (1.f + c4.z) + s4.z;
      float y3 = v[j].w * rstd * w4.w * (1.f + c4.w) + s4.w;
      uint2 o;
      o.x = (unsigned)f2bf(y0) | ((unsigned)f2bf(y1) << 16);
      o.y = (unsigned)f2bf(y2) | ((unsigned)f2bf(y3) << 16);
      *(uint2*)(p.hn + (size_t)row * 1024 + col) = o;
    }
  }
}

#define GBK 64
#define GLD 72
template <int EPI>
__device__ __forceinline__ void gemm_tile(const P& p, const bf16_t* A, int lda, const bf16_t* Bt, int m0, int n0, bf16_t* sA, bf16_t* sB) {
  const int tid = threadIdx.x & 255, lane = tid & 63, wave = tid >> 6;
  const int wm = wave >> 1, wn = wave & 1;
  const int lr = lane & 15, lq = lane >> 4;
  f32x4 acc[4][4];
#pragma unroll
  for (int i = 0; i < 4; ++i)
#pragma unroll
    for (int j = 0; j < 4; ++j) acc[i][j] = (f32x4){0.f, 0.f, 0.f, 0.f};
  const int sr = tid >> 3, scol = (tid & 7) * 8;
  u32x4 ra[4], rb[4];
  const bf16_t* Ap = A + (size_t)(m0 + sr) * lda + scol;
  const bf16_t* Bp = Bt + (size_t)(n0 + sr) * 1024 + scol;
#pragma unroll
  for (int i = 0; i < 4; ++i) {
    ra[i] = *(const u32x4*)(Ap + (size_t)(i * 32) * lda);
    rb[i] = *(const u32x4*)(Bp + (size_t)(i * 32) * 1024);
  }
  for (int kt = 0; kt < 1024 / GBK; ++kt) {
    __syncthreads();
#pragma unroll
    for (int i = 0; i < 4; ++i) {
      *(u32x4*)(sA + (sr + i * 32) * GLD + scol) = ra[i];
      *(u32x4*)(sB + (sr + i * 32) * GLD + scol) = rb[i];
    }
    __syncthreads();
    {
      const int k0 = (kt + 1 < 1024 / GBK ? kt + 1 : kt) * GBK;
#pragma unroll
      for (int i = 0; i < 4; ++i) {
        ra[i] = *(const u32x4*)(Ap + (size_t)(i * 32) * lda + k0);
        rb[i] = *(const u32x4*)(Bp + (size_t)(i * 32) * 1024 + k0);
      }
    }
#pragma unroll
    for (int ks = 0; ks < 2; ++ks) {
      bf16x8 af[4], bfr[4];
#pragma unroll
      for (int i = 0; i < 4; ++i) {
        af[i] = *(const bf16x8*)(sA + (wm * 64 + i * 16 + lr) * GLD + ks * 32 + lq * 8);
        bfr[i] = *(const bf16x8*)(sB + (wn * 64 + i * 16 + lr) * GLD + ks * 32 + lq * 8);
      }
#pragma unroll
      for (int i = 0; i < 4; ++i)
#pragma unroll
        for (int j = 0; j < 4; ++j) acc[i][j] = __builtin_amdgcn_mfma_f32_16x16x32_bf16(af[i], bfr[j], acc[i][j], 0, 0, 0);
    }
  }
#pragma unroll
  for (int i = 0; i < 4; ++i)
#pragma unroll
    for (int j = 0; j < 4; ++j)
#pragma unroll
      for (int e = 0; e < 4; ++e) {
        const int row = m0 + wm * 64 + i * 16 + lq * 4 + e;
        const int col = n0 + wn * 64 + j * 16 + lr;
        const float v = acc[i][j][e];
        if (EPI == 0) {
          if (col < 2560) p.pl[(size_t)row * LDP + col] = f2bf(v);
          else if (col < 2576) p.gates[(size_t)row * 16 + (col - 2560)] = v;
        } else if (EPI == 1) {
          const int b = row / SEQ;
          p.out[(size_t)row * 1024 + col] = p.x[(size_t)row * 1024 + col] + p.mod[b * 6144 + 2 * 1024 + col] * v;
        } else {
          p.qb[(size_t)row * 2048 + col] = f2bf(v);
        }
      }
}

template <int EPI>
__device__ __forceinline__ void ph_gemm(const P& p, int bid, int nb, char* smem) {
  bf16_t* sA = (bf16_t*)smem;
  bf16_t* sB = sA + 128 * GLD;
  const int ntn = EPI == 0 ? 21 : (EPI == 1 ? 8 : 16);
  const int ntm = EPI == 0 ? 144 : 128;
  const bf16_t* A = EPI == 0 ? p.hn : (EPI == 1 ? p.mix : p.hn);
  const int lda = 1024;
  const bf16_t* Bt = EPI == 0 ? p.wt_in : (EPI == 1 ? p.wt_out : p.wt_q);
  const int nlat = 128 * ntn;
  const int ntiles = EPI == 0 ? nlat + 16 * 13 : ntm * ntn;
  const int trips = (ntiles + nb - 1) / nb;
  for (int k = 0; k < trips; ++k) {
    const int t = (bid + k * nb) % ntiles;
    int tm, tn;
    if (EPI == 0 && t >= nlat) { const int r = t - nlat; tm = 128 + r / 13; tn = r % 13; if (tn == 12) tn = 20; }
    else { tm = t / ntn; tn = t % ntn; }
    gemm_tile<EPI>(p, A, lda, Bt, tm * 128, tn * 128, sA, sB);
  }
}

struct UnitInfo { int isctx, b, c, h, T, seqrow0, row0; };
__device__ __forceinline__ UnitInfo decode_unit(int u) {
  UnitInfo r;
  if (u < 512) { r.isctx = 0; r.b = u >> 6; r.c = (u >> 2) & 15; r.h = u & 3; r.T = SEQ; r.seqrow0 = r.b * SEQ; }
  else { int uu = u - 512; r.isctx = 1; r.b = uu >> 3; r.c = (uu >> 2) & 1; r.h = uu & 3; r.T = CTXL; r.seqrow0 = TL + r.b * CTXL; }
  r.row0 = r.seqrow0 + r.c * 128;
  return r;
}
__device__ __forceinline__ float qk_act(const P& p, int seqrow0, int T, int t, int col) {
  const bf16_t* base = p.pl + (size_t)(seqrow0 + t) * LDP + col;
  float r0 = t > 0 ? bf2f(base[-LDP]) : 0.f;
  float r1 = bf2f(base[0]);
  float r2 = t + 1 < T ? bf2f(base[LDP]) : 0.f;
  float y = p.conv_b[col] + r0 * p.conv_w[col] + r1 * p.conv_w[1024 + col] + r2 * p.conv_w[2048 + col];
  return silu_f(y);
}


typedef short s16x4 __attribute__((ext_vector_type(4)));
#define LDS_AS __attribute__((address_space(3)))
__device__ __forceinline__ s16x4 ds_tr16(const bf16_t* ptr) { return __builtin_amdgcn_ds_read_tr16_b64_v4i16((LDS_AS s16x4*)ptr); }
__device__ __forceinline__ bf16x8 frag_tr(const bf16_t* M, int ld, int s0, int c0, int lr, int lq) {
  const bf16_t* a = M + (s0 + lq * 8 + (lr >> 2)) * ld + c0 + (lr & 3) * 4;
  const s16x4 t0 = ds_tr16(a), t1 = ds_tr16(a + 4 * ld);
  return __builtin_shufflevector(t0, t1, 0, 1, 2, 3, 4, 5, 6, 7);
}
__device__ __forceinline__ unsigned cvt_pk_bf16(float lo, float hi) { const f32x2 v = {lo, hi}; const bf16x2 b = __builtin_convertvector(v, bf16x2); return __builtin_bit_cast(unsigned, b); }
__device__ __forceinline__ float blo(unsigned u) { return __uint_as_float(u << 16); }
__device__ __forceinline__ float bhi(unsigned u) { return __uint_as_float(u & 0xffff0000u); }
#define VLD 136
__device__ __forceinline__ __amdgpu_buffer_rsrc_t mk_rsrc(const void* ptr) { return __builtin_amdgcn_make_buffer_rsrc((void*)ptr, 0, 0x7fffffff, 0x00020000); }
__device__ __forceinline__ bf16x8 bload8(__amdgpu_buffer_rsrc_t r, int voff, int soff) { return __builtin_bit_cast(bf16x8, __builtin_amdgcn_raw_buffer_load_b128(r, voff, soff, 0)); }

__device__ __forceinline__ void ph3_chunk_local(const P& p, int bid, int nb, char* smem) {
  bf16_t* Vs = (bf16_t*)smem;
  bf16_t* Ks = Vs + 128 * VLD;
  float* fa = (float*)(Ks + 128 * VLD);
  float *igf = fa, *lff = fa + 128, *igb = fa + 256, *lfb = fa + 384, *ef = fa + 512, *eb = fa + 640, *scal = fa + 768;
  const int tid = threadIdx.x & 255, lane = tid & 63, wave = tid >> 6, lr = lane & 15, lq = lane >> 4;
  const int trips3 = (576 + nb - 1) / nb;
  for (int k3 = 0; k3 < trips3; ++k3) {
    const int u = (bid + k3 * nb) % 576;
    const UnitInfo ui = decode_unit(u);
    const int h = ui.h;
    if (tid < 128) {
      const float* g = p.gates + (size_t)(ui.row0 + tid) * 16;
      igf[tid] = g[h] + p.b_gates[h];
      lff[tid] = logsig_f(g[4 + h] + p.b_gates[4 + h]);
      igb[tid] = g[8 + h] + p.b_gates[8 + h];
      lfb[tid] = logsig_f(g[12 + h] + p.b_gates[12 + h]);
    }
    {
      const int dch = tid & 15, colq = h * 128 + dch * 8, colk = 512 + colq;
#pragma unroll 1
      for (int which = 0; which < 2; ++which) {
        if (which == 1 && ui.isctx) break;
        const int col = which == 0 ? colk : colq;
        float w0[8], w1[8], w2[8], bb[8];
#pragma unroll
        for (int i = 0; i < 8; ++i) { w0[i] = p.conv_w[col + i]; w1[i] = p.conv_w[1024 + col + i]; w2[i] = p.conv_w[2048 + col + i]; bb[i] = p.conv_b[col + i]; }
        const float scl = which == 0 ? 0.08838834764831845f : 1.f;
#pragma unroll 2
        for (int i = 0; i < 8; ++i) {
          const int t = (tid >> 4) + i * 16, tt = ui.c * 128 + t;
          const bf16_t* base = p.pl + (size_t)(ui.row0 + t) * LDP + col;
          const u32x4 z4 = (u32x4){0u, 0u, 0u, 0u};
          const u32x4 r1 = *(const u32x4*)base;
          const u32x4 r0 = tt > 0 ? *(const u32x4*)(base - LDP) : z4;
          const u32x4 r2 = tt + 1 < ui.T ? *(const u32x4*)(base + LDP) : z4;
          float y[8];
#pragma unroll
          for (int q = 0; q < 4; ++q) {
            y[2 * q] = silu_f(bb[2 * q] + blo(r0[q]) * w0[2 * q] + blo(r1[q]) * w1[2 * q] + blo(r2[q]) * w2[2 * q]) * scl;
            y[2 * q + 1] = silu_f(bb[2 * q + 1] + bhi(r0[q]) * w0[2 * q + 1] + bhi(r1[q]) * w1[2 * q + 1] + bhi(r2[q]) * w2[2 * q + 1]) * scl;
          }
          u32x4 o;
#pragma unroll
          for (int q = 0; q < 4; ++q) o[q] = cvt_pk_bf16(y[2 * q], y[2 * q + 1]);
          if (which == 0) *(u32x4*)(Ks + t * VLD + dch * 8) = o;
          if (!ui.isctx) *(u32x4*)(p.hn + (size_t)(ui.row0 + t) * 1024 + col) = o;
        }
      }
#pragma unroll
      for (int i = 0; i < 8; ++i) {
        const int t = (tid >> 4) + i * 16;
        *(u32x4*)(Vs + t * VLD + dch * 8) = *(const u32x4*)(p.pl + (size_t)(ui.row0 + t) * LDP + 1024 + h * 128 + dch * 8);
      }
    }
    __syncthreads();
    if (tid == 0) {
      float b = 0.f, G = -3.0e38f;
      for (int t = 0; t < 128; ++t) { b += lff[t]; float g = igf[t] - b; ef[t] = g; G = fmaxf(G, g); }
      scal[0] = G; scal[1] = b;
    } else if (tid == 64) {
      float b = 0.f, G = -3.0e38f;
      for (int t = 127; t >= 0; --t) { b += lfb[t]; float g = igb[t] - b; eb[t] = g; G = fmaxf(G, g); }
      scal[2] = G; scal[3] = b;
    }
    __syncthreads();
    if (tid < 128) { ef[tid] = __expf(ef[tid] - scal[0]); }
    else { eb[tid - 128] = __expf(eb[tid - 128] - scal[2]); }
    __syncthreads();
#pragma unroll 1
    for (int dir = 0; dir < 2; ++dir) {
      const float* ee = dir ? eb : ef;
      f32x4 acc[2][8];
#pragma unroll
      for (int m = 0; m < 2; ++m)
#pragma unroll
        for (int j = 0; j < 8; ++j) acc[m][j] = (f32x4){0.f, 0.f, 0.f, 0.f};
#pragma unroll
      for (int kk = 0; kk < 4; ++kk) {
        const f32x4 e0 = *(const f32x4*)(ee + kk * 32 + lq * 8), e1 = *(const f32x4*)(ee + kk * 32 + lq * 8 + 4);
        bf16x8 af[2];
#pragma unroll
        for (int m = 0; m < 2; ++m) {
          const bf16x8 raw = frag_tr(Vs, VLD, kk * 32, wave * 32 + m * 16, lr, lq);
          const u32x4 ru = __builtin_bit_cast(u32x4, raw);
          u32x4 sc;
          sc[0] = cvt_pk_bf16(blo(ru[0]) * e0[0], bhi(ru[0]) * e0[1]);
          sc[1] = cvt_pk_bf16(blo(ru[1]) * e0[2], bhi(ru[1]) * e0[3]);
          sc[2] = cvt_pk_bf16(blo(ru[2]) * e1[0], bhi(ru[2]) * e1[1]);
          sc[3] = cvt_pk_bf16(blo(ru[3]) * e1[2], bhi(ru[3]) * e1[3]);
          af[m] = __builtin_bit_cast(bf16x8, sc);
        }
#pragma unroll
        for (int j = 0; j < 8; ++j) {
          const bf16x8 bfr = frag_tr(Ks, VLD, kk * 32, j * 16, lr, lq);
#pragma unroll
          for (int m = 0; m < 2; ++m) acc[m][j] = __builtin_amdgcn_mfma_f32_16x16x32_bf16(af[m], bfr, acc[m][j], 0, 0, 0);
        }
      }
      bf16_t* Dd = p.Dst + (size_t)(u * 2 + dir) * 16384;
#pragma unroll
      for (int m = 0; m < 2; ++m)
#pragma unroll
        for (int j = 0; j < 8; ++j)
#pragma unroll
          for (int e = 0; e < 4; ++e) Dd[(wave * 32 + m * 16 + lq * 4 + e) * 128 + j * 16 + lr] = f2bf(acc[m][j][e]);
    }
    {
      const int dir = tid >> 7, k = tid & 127;
      const float* e = dir ? eb : ef;
      float sacc = 0.f;
      for (int t = 0; t < 128; ++t) sacc += e[t] * bf2f(Ks[t * VLD + k]);
      p.ND[(size_t)(u * 2 + dir) * 128 + k] = sacc;
    }
    if (tid < 4) p.SC[(size_t)(u * 2 + (tid >> 1)) * 32 + (tid & 1)] = scal[tid];
    __syncthreads();
  }
}

__device__ __forceinline__ void ph4_scan(const P& p, int bid, int nb) {
  const int tid = threadIdx.x & 255;
  for (int it = bid; it < 1024; it += nb) {
    const int combo = it >> 4, vblk = it & 15;
    const int b = combo >> 3, h = (combo >> 1) & 3, dir = combo & 1;
    const int v = vblk * 8 + (tid >> 5), k0 = (tid & 31) * 4;
    float C0 = 0.f, C1 = 0.f, C2 = 0.f, C3 = 0.f, nacc = 0.f, m = 0.f;
    for (int i = 0; i < 18; ++i) {
      int u;
      if (i < 2) { const int cc = dir == 0 ? i : 1 - i; u = 512 + b * 8 + cc * 4 + h; }
      else {
        const int lc = i - 2, c = dir == 0 ? lc : 15 - lc;
        u = b * 64 + c * 4 + h;
        const size_t ci = (size_t)u * 2 + dir;
        uint2 o;
        o.x = (unsigned)f2bf(C0) | ((unsigned)f2bf(C1) << 16);
        o.y = (unsigned)f2bf(C2) | ((unsigned)f2bf(C3) << 16);
        *(uint2*)(p.CIN + ci * 16384 + v * 128 + k0) = o;
        if (vblk == 0 && tid < 128) p.NIN[ci * 128 + tid] = nacc;
        if (vblk == 0 && tid == 0) p.MIN_[ci * 32] = m;
      }
      const size_t di = (size_t)u * 2 + dir;
      const float G = p.SC[di * 32 + 0], bend = p.SC[di * 32 + 1];
      const float Mx = fmaxf(m, G);
      const float dec = __expf(m - Mx), inj = __expf(G - Mx);
      const uint2 d2 = *(const uint2*)(p.Dst + di * 16384 + v * 128 + k0);
      C0 = dec * C0 + inj * __uint_as_float(d2.x << 16);
      C1 = dec * C1 + inj * __uint_as_float(d2.x & 0xffff0000u);
      C2 = dec * C2 + inj * __uint_as_float(d2.y << 16);
      C3 = dec * C3 + inj * __uint_as_float(d2.y & 0xffff0000u);
      if (vblk == 0 && tid < 128) nacc = dec * nacc + inj * p.ND[di * 128 + tid];
      m = bend + Mx;
    }
  }
}

__device__ __forceinline__ void ph5_mlstm_out(const P& p, int bid, int nb, char* smem) {
  bf16_t* Vs = (bf16_t*)smem;
  bf16_t* Pw = Vs + 128 * VLD;
  float* fa = (float*)(Pw + 4 * 16 * VLD);
  float *igf = fa, *lff = fa + 128, *igb = fa + 256, *lfb = fa + 384, *gf = fa + 512, *gb = fa + 640, *bfw = fa + 768, *bbw = fa + 896,
        *pmf = fa + 1024, *pmb = fa + 1152, *nq = fa + 1280  ;
  const int tid = threadIdx.x & 255, lane = tid & 63, wave = tid >> 6, lr = lane & 15, lq = lane >> 4;
  const int trips5 = (1536 + nb - 1) / nb;
  for (int k5 = 0; k5 < trips5; ++k5) {
    const int it = (bid + k5 * nb) % 1536;
    if (it < 512) {
      const int u = it;
      const UnitInfo ui = decode_unit(u);
      const int h = ui.h;
      const size_t cif = (size_t)u * 2, cib = (size_t)u * 2 + 1;
      if (tid < 128) {
        const float* g = p.gates + (size_t)(ui.row0 + tid) * 16;
        igf[tid] = g[h] + p.b_gates[h];
        lff[tid] = logsig_f(g[4 + h] + p.b_gates[4 + h]);
        igb[tid] = g[8 + h] + p.b_gates[8 + h];
        lfb[tid] = logsig_f(g[12 + h] + p.b_gates[12 + h]);
      }
      {
        const int dch = tid & 15;
#pragma unroll
        for (int i = 0; i < 8; ++i) {
          const int t = (tid >> 4) + i * 16;
          *(u32x4*)(Vs + t * VLD + dch * 8) = *(const u32x4*)(p.pl + (size_t)(ui.row0 + t) * LDP + 1024 + h * 128 + dch * 8);
        }
      }
      {
        const int dir = tid >> 7, t = tid & 127;
        const u32x4* qr = (const u32x4*)(p.hn + (size_t)(ui.row0 + t) * 1024 + h * 128);
        const float* nin = p.NIN + (dir ? cib : cif) * 128;
        float sacc = 0.f;
#pragma unroll 4
        for (int c8 = 0; c8 < 16; ++c8) {
          const u32x4 qv = qr[c8];
#pragma unroll
          for (int q = 0; q < 4; ++q) sacc += blo(qv[q]) * nin[c8 * 8 + 2 * q] + bhi(qv[q]) * nin[c8 * 8 + 2 * q + 1];
        }
        nq[dir * 128 + t] = sacc;
      }
      __syncthreads();
      if (tid == 0) {
        float b = 0.f, pm = -3.0e38f;
        for (int t = 0; t < 128; ++t) { b += lff[t]; bfw[t] = b; float g = igf[t] - b; gf[t] = g; pm = fmaxf(pm, g); pmf[t] = pm; }
      } else if (tid == 64) {
        float b = 0.f, pm = -3.0e38f;
        for (int t = 127; t >= 0; --t) { b += lfb[t]; bbw[t] = b; float g = igb[t] - b; gb[t] = g; pm = fmaxf(pm, g); pmb[t] = pm; }
      }
      __syncthreads();
      const float minf_ = p.MIN_[cif * 32], minb_ = p.MIN_[cib * 32];
      bf16_t* Pme = Pw + wave * 16 * VLD;
      const __amdgpu_buffer_rsrc_t r_hn = mk_rsrc(p.hn), r_cin = mk_rsrc(p.CIN);
      const int fvoff = (lr * 1024 + lq * 8) * 2, cvoff = (lr * 128 + lq * 8) * 2;
#pragma unroll 1
      for (int m = 0; m < 2; ++m) {
        const int t0 = wave * 32 + m * 16;
        bf16x8 Qf[4];
#pragma unroll
        for (int kk = 0; kk < 4; ++kk) Qf[kk] = bload8(r_hn, fvoff + kk * 64, ((ui.row0 + t0) * 1024 + h * 128) * 2);
        f32x4 S[8];
#pragma unroll
        for (int j = 0; j < 8; ++j) {
          S[j] = (f32x4){0.f, 0.f, 0.f, 0.f};
#pragma unroll
          for (int kk = 0; kk < 4; ++kk) {
            const bf16x8 kf = bload8(r_hn, fvoff + kk * 64, ((ui.row0 + j * 16) * 1024 + 512 + h * 128) * 2);
            S[j] = __builtin_amdgcn_mfma_f32_16x16x32_bf16(Qf[kk], kf, S[j], 0, 0, 0);
          }
          if (j & 1) __builtin_amdgcn_sched_barrier(0);
        }
        f32x4 hsum[8];
#pragma unroll 1
        for (int dir = 0; dir < 2; ++dir) {
          const float mi = dir ? minb_ : minf_;
          const float* gg = dir ? gb : gf;
          const float* pmx = dir ? pmb : pmf;
          const float* bw = dir ? bbw : bfw;
          float Mrow[4], wi[4];
#pragma unroll
          for (int e = 0; e < 4; ++e) { Mrow[e] = fmaxf(mi, pmx[t0 + lq * 4 + e]); wi[e] = __expf(mi - Mrow[e]); }
          f32x4 acc[8];
#pragma unroll
          for (int jv = 0; jv < 8; ++jv) {
            acc[jv] = (f32x4){0.f, 0.f, 0.f, 0.f};
#pragma unroll
            for (int kk = 0; kk < 4; ++kk) {
              const bf16x8 cf = bload8(r_cin, cvoff + kk * 64, (int)((dir ? cib : cif) * 32768) + jv * 4096);
              acc[jv] = __builtin_amdgcn_mfma_f32_16x16x32_bf16(Qf[kk], cf, acc[jv], 0, 0, 0);
            }
#pragma unroll
            for (int e = 0; e < 4; ++e) acc[jv][e] *= wi[e];
            if (jv & 1) __builtin_amdgcn_sched_barrier(0);
          }
          float rs[4] = {0.f, 0.f, 0.f, 0.f};
#pragma unroll
          for (int j = 0; j < 8; ++j) {
            const int sidx = j * 16 + lr;
            const float gs = gg[sidx];
#pragma unroll
            for (int e = 0; e < 4; ++e) {
              const int t = t0 + lq * 4 + e;
              const bool keep = dir ? (sidx >= t) : (sidx <= t);
              const float pv = keep ? S[j][e] * __expf(gs - Mrow[e]) : 0.f;
              rs[e] += pv;
              Pme[(lq * 4 + e) * VLD + sidx] = f2bf(pv);
            }
          }
          float den[4];
#pragma unroll
          for (int e = 0; e < 4; ++e) {
            float r = rs[e];
            r += __shfl_xor(r, 1); r += __shfl_xor(r, 2); r += __shfl_xor(r, 4); r += __shfl_xor(r, 8);
            const int t = t0 + lq * 4 + e;
            const float dd = r + wi[e] * nq[dir * 128 + t];
            den[e] = fmaxf(fabsf(dd), __expf(-(bw[t] + Mrow[e])));
          }
          __builtin_amdgcn_fence(__ATOMIC_RELEASE, "wavefront");
          __builtin_amdgcn_wave_barrier();
#pragma unroll
          for (int kk = 0; kk < 4; ++kk) {
            const bf16x8 pf = *(const bf16x8*)(Pme + lr * VLD + kk * 32 + lq * 8);
#pragma unroll
            for (int jv = 0; jv < 8; ++jv) {
              const bf16x8 vf = frag_tr(Vs, VLD, kk * 32, jv * 16, lr, lq);
              acc[jv] = __builtin_amdgcn_mfma_f32_16x16x32_bf16(pf, vf, acc[jv], 0, 0, 0);
            }
          }
          __builtin_amdgcn_wave_barrier();
#pragma unroll
          for (int jv = 0; jv < 8; ++jv)
#pragma unroll
            for (int e = 0; e < 4; ++e) {
              const float hv = acc[jv][e] / den[e];
              if (dir == 0) hsum[jv][e] = hv; else hsum[jv][e] += hv;
            }
        }
#pragma unroll
        for (int e = 0; e < 4; ++e) {
          float sm = 0.f;
#pragma unroll
          for (int jv = 0; jv < 8; ++jv) sm += hsum[jv][e];
          sm += __shfl_xor(sm, 1); sm += __shfl_xor(sm, 2); sm += __shfl_xor(sm, 4); sm += __shfl_xor(sm, 8);
          const float mu = sm * (1.f / 128.f);
          float vs = 0.f;
#pragma unroll
          for (int jv = 0; jv < 8; ++jv) { const float d = hsum[jv][e] - mu; vs += d * d; }
          vs += __shfl_xor(vs, 1); vs += __shfl_xor(vs, 2); vs += __shfl_xor(vs, 4); vs += __shfl_xor(vs, 8);
          const float rstd = rsqrtf(vs * (1.f / 128.f) + 1e-6f);
          const bf16_t* op = p.pl + (size_t)(ui.row0 + t0 + lq * 4 + e) * LDP + 1536 + h * 128;
          bf16_t* mp = p.mix + (size_t)(ui.row0 + t0 + lq * 4 + e) * 1024 + h * 128;
#pragma unroll
          for (int jv = 0; jv < 8; ++jv) {
            const int v = jv * 16 + lr;
            const float o = bf2f(op[v]);
            mp[v] = f2bf((hsum[jv][e] - mu) * rstd * p.head_norm_w[h * 128 + v] / (1.f + __expf(-o)));
          }
        }
      }
      __syncthreads();
    } else {
      const int pu = it - 512, grp = pu >> 2, g = pu & 3;
      float* us = (float*)smem;
      float* dd = us + 8192;
      const int w = 2 << g;
      const size_t rbase = (size_t)grp * 64;
      for (int idx = tid; idx < 8192; idx += NTHR) {
        const int t = idx >> 7, i = idx & 127;
        us[idx] = bf2f(p.pl[(rbase + t) * LDP + 2048 + g * 128 + i]);
      }
      __syncthreads();
      for (int idx = tid; idx < 8192; idx += NTHR) {
        const int t = idx >> 7, i = idx & 127;
        int lo = t - w / 2, hi = t - w / 2 + w;
        lo = lo < 0 ? 0 : lo; hi = hi > 64 ? 64 : hi;
        float s = 0.f;
        for (int j = lo; j < hi; ++j) s += us[j * 128 + i];
        dd[idx] = s / (float)(hi - lo) - us[idx];
      }
      __syncthreads();
      {
        const int o = tid & 127, tg = tid >> 7;
        const float ps = p.pool_scale[g * 128 + o];
#pragma unroll 1
        for (int pass = 0; pass < 4; ++pass) {
          float acc[8];
#pragma unroll
          for (int i = 0; i < 8; ++i) acc[i] = 0.f;
          const float* dbase = dd + (tg * 32 + pass * 8) * 128;
#pragma unroll 4
          for (int i = 0; i < 128; ++i) {
            const float wv = p.pool_w[(size_t)(g * 128 + i) * 128 + o];
#pragma unroll
            for (int tt = 0; tt < 8; ++tt) acc[tt] += dbase[tt * 128 + i] * wv;
          }
#pragma unroll
          for (int tt = 0; tt < 8; ++tt) p.mix[(rbase + tg * 32 + pass * 8 + tt) * 1024 + 512 + g * 128 + o] = f2bf(acc[tt] * ps);
        }
      }
      __syncthreads();
    }
  }
}

#define SORT16(X) do { unsigned h_, l_; h_ = X[0] > X[1] ? X[0] : X[1]; l_ = X[0] > X[1] ? X[1] : X[0]; X[0] = h_; X[1] = l_; h_ = X[3] > X[2] ? X[3] : X[2]; l_ = X[3] > X[2] ? X[2] : X[3]; X[3] = h_; X[2] = l_; h_ = X[4] > X[5] ? X[4] : X[5]; l_ = X[4] > X[5] ? X[5] : X[4]; X[4] = h_; X[5] = l_; h_ = X[7] > X[6] ? X[7] : X[6]; l_ = X[7] > X[6] ? X[6] : X[7]; X[7] = h_; X[6] = l_; h_ = X[8] > X[9] ? X[8] : X[9]; l_ = X[8] > X[9] ? X[9] : X[8]; X[8] = h_; X[9] = l_; h_ = X[11] > X[10] ? X[11] : X[10]; l_ = X[11] > X[10] ? X[10] : X[11]; X[11] = h_; X[10] = l_; h_ = X[12] > X[13] ? X[12] : X[13]; l_ = X[12] > X[13] ? X[13] : X[12]; X[12] = h_; X[13] = l_; h_ = X[15] > X[14] ? X[15] : X[14]; l_ = X[15] > X[14] ? X[14] : X[15]; X[15] = h_; X[14] = l_; h_ = X[0] > X[2] ? X[0] : X[2]; l_ = X[0] > X[2] ? X[2] : X[0]; X[0] = h_; X[2] = l_; h_ = X[1] > X[3] ? X[1] : X[3]; l_ = X[1] > X[3] ? X[3] : X[1]; X[1] = h_; X[3] = l_; h_ = X[6] > X[4] ? X[6] : X[4]; l_ = X[6] > X[4] ? X[4] : X[6]; X[6] = h_; X[4] = l_; h_ = X[7] > X[5] ? X[7] : X[5]; l_ = X[7] > X[5] ? X[5] : X[7]; X[7] = h_; X[5] = l_; h_ = X[8] > X[10] ? X[8] : X[10]; l_ = X[8] > X[10] ? X[10] : X[8]; X[8] = h_; X[10] = l_; h_ = X[9] > X[11] ? X[9] : X[11]; l_ = X[9] > X[11] ? X[11] : X[9]; X[9] = h_; X[11] = l_; h_ = X[14] > X[12] ? X[14] : X[12]; l_ = X[14] > X[12] ? X[12] : X[14]; X[14] = h_; X[12] = l_; h_ = X[15] > X[13] ? X[15] : X[13]; l_ = X[15] > X[13] ? X[13] : X[15]; X[15] = h_; X[13] = l_; h_ = X[0] > X[1] ? X[0] : X[1]; l_ = X[0] > X[1] ? X[1] : X[0]; X[0] = h_; X[1] = l_; h_ = X[2] > X[3] ? X[2] : X[3]; l_ = X[2] > X[3] ? X[3] : X[2]; X[2] = h_; X[3] = l_; h_ = X[5] > X[4] ? X[5] : X[4]; l_ = X[5] > X[4] ? X[4] : X[5]; X[5] = h_; X[4] = l_; h_ = X[7] > X[6] ? X[7] : X[6]; l_ = X[7] > X[6] ? X[6] : X[7]; X[7] = h_; X[6] = l_; h_ = X[8] > X[9] ? X[8] : X[9]; l_ = X[8] > X[9] ? X[9] : X[8]; X[8] = h_; X[9] = l_; h_ = X[10] > X[11] ? X[10] : X[11]; l_ = X[10] > X[11] ? X[11] : X[10]; X[10] = h_; X[11] = l_; h_ = X[13] > X[12] ? X[13] : X[12]; l_ = X[13] > X[12] ? X[12] : X[13]; X[13] = h_; X[12] = l_; h_ = X[15] > X[14] ? X[15] : X[14]; l_ = X[15] > X[14] ? X[14] : X[15]; X[15] = h_; X[14] = l_; h_ = X[0] > X[4] ? X[0] : X[4]; l_ = X[0] > X[4] ? X[4] : X[0]; X[0] = h_; X[4] = l_; h_ = X[1] > X[5] ? X[1] : X[5]; l_ = X[1] > X[5] ? X[5] : X[1]; X[1] = h_; X[5] = l_; h_ = X[2] > X[6] ? X[2] : X[6]; l_ = X[2] > X[6] ? X[6] : X[2]; X[2] = h_; X[6] = l_; h_ = X[3] > X[7] ? X[3] : X[7]; l_ = X[3] > X[7] ? X[7] : X[3]; X[3] = h_; X[7] = l_; h_ = X[12] > X[8] ? X[12] : X[8]; l_ = X[12] > X[8] ? X[8] : X[12]; X[12] = h_; X[8] = l_; h_ = X[13] > X[9] ? X[13] : X[9]; l_ = X[13] > X[9] ? X[9] : X[13]; X[13] = h_; X[9] = l_; h_ = X[14] > X[10] ? X[14] : X[10]; l_ = X[14] > X[10] ? X[10] : X[14]; X[14] = h_; X[10] = l_; h_ = X[15] > X[11] ? X[15] : X[11]; l_ = X[15] > X[11] ? X[11] : X[15]; X[15] = h_; X[11] = l_; h_ = X[0] > X[2] ? X[0] : X[2]; l_ = X[0] > X[2] ? X[2] : X[0]; X[0] = h_; X[2] = l_; h_ = X[1] > X[3] ? X[1] : X[3]; l_ = X[1] > X[3] ? X[3] : X[1]; X[1] = h_; X[3] = l_; h_ = X[4] > X[6] ? X[4] : X[6]; l_ = X[4] > X[6] ? X[6] : X[4]; X[4] = h_; X[6] = l_; h_ = X[5] > X[7] ? X[5] : X[7]; l_ = X[5] > X[7] ? X[7] : X[5]; X[5] = h_; X[7] = l_; h_ = X[10] > X[8] ? X[10] : X[8]; l_ = X[10] > X[8] ? X[8] : X[10]; X[10] = h_; X[8] = l_; h_ = X[11] > X[9] ? X[11] : X[9]; l_ = X[11] > X[9] ? X[9] : X[11]; X[11] = h_; X[9] = l_; h_ = X[14] > X[12] ? X[14] : X[12]; l_ = X[14] > X[12] ? X[12] : X[14]; X[14] = h_; X[12] = l_; h_ = X[15] > X[13] ? X[15] : X[13]; l_ = X[15] > X[13] ? X[13] : X[15]; X[15] = h_; X[13] = l_; h_ = X[0] > X[1] ? X[0] : X[1]; l_ = X[0] > X[1] ? X[1] : X[0]; X[0] = h_; X[1] = l_; h_ = X[2] > X[3] ? X[2] : X[3]; l_ = X[2] > X[3] ? X[3] : X[2]; X[2] = h_; X[3] = l_; h_ = X[4] > X[5] ? X[4] : X[5]; l_ = X[4] > X[5] ? X[5] : X[4]; X[4] = h_; X[5] = l_; h_ = X[6] > X[7] ? X[6] : X[7]; l_ = X[6] > X[7] ? X[7] : X[6]; X[6] = h_; X[7] = l_; h_ = X[9] > X[8] ? X[9] : X[8]; l_ = X[9] > X[8] ? X[8] : X[9]; X[9] = h_; X[8] = l_; h_ = X[11] > X[10] ? X[11] : X[10]; l_ = X[11] > X[10] ? X[10] : X[11]; X[11] = h_; X[10] = l_; h_ = X[13] > X[12] ? X[13] : X[12]; l_ = X[13] > X[12] ? X[12] : X[13]; X[13] = h_; X[12] = l_; h_ = X[15] > X[14] ? X[15] : X[14]; l_ = X[15] > X[14] ? X[14] : X[15]; X[15] = h_; X[14] = l_; h_ = X[0] > X[8] ? X[0] : X[8]; l_ = X[0] > X[8] ? X[8] : X[0]; X[0] = h_; X[8] = l_; h_ = X[1] > X[9] ? X[1] : X[9]; l_ = X[1] > X[9] ? X[9] : X[1]; X[1] = h_; X[9] = l_; h_ = X[2] > X[10] ? X[2] : X[10]; l_ = X[2] > X[10] ? X[10] : X[2]; X[2] = h_; X[10] = l_; h_ = X[3] > X[11] ? X[3] : X[11]; l_ = X[3] > X[11] ? X[11] : X[3]; X[3] = h_; X[11] = l_; h_ = X[4] > X[12] ? X[4] : X[12]; l_ = X[4] > X[12] ? X[12] : X[4]; X[4] = h_; X[12] = l_; h_ = X[5] > X[13] ? X[5] : X[13]; l_ = X[5] > X[13] ? X[13] : X[5]; X[5] = h_; X[13] = l_; h_ = X[6] > X[14] ? X[6] : X[14]; l_ = X[6] > X[14] ? X[14] : X[6]; X[6] = h_; X[14] = l_; h_ = X[7] > X[15] ? X[7] : X[15]; l_ = X[7] > X[15] ? X[15] : X[7]; X[7] = h_; X[15] = l_; h_ = X[0] > X[4] ? X[0] : X[4]; l_ = X[0] > X[4] ? X[4] : X[0]; X[0] = h_; X[4] = l_; h_ = X[1] > X[5] ? X[1] : X[5]; l_ = X[1] > X[5] ? X[5] : X[1]; X[1] = h_; X[5] = l_; h_ = X[2] > X[6] ? X[2] : X[6]; l_ = X[2] > X[6] ? X[6] : X[2]; X[2] = h_; X[6] = l_; h_ = X[3] > X[7] ? X[3] : X[7]; l_ = X[3] > X[7] ? X[7] : X[3]; X[3] = h_; X[7] = l_; h_ = X[8] > X[12] ? X[8] : X[12]; l_ = X[8] > X[12] ? X[12] : X[8]; X[8] = h_; X[12] = l_; h_ = X[9] > X[13] ? X[9] : X[13]; l_ = X[9] > X[13] ? X[13] : X[9]; X[9] = h_; X[13] = l_; h_ = X[10] > X[14] ? X[10] : X[14]; l_ = X[10] > X[14] ? X[14] : X[10]; X[10] = h_; X[14] = l_; h_ = X[11] > X[15] ? X[11] : X[15]; l_ = X[11] > X[15] ? X[15] : X[11]; X[11] = h_; X[15] = l_; h_ = X[0] > X[2] ? X[0] : X[2]; l_ = X[0] > X[2] ? X[2] : X[0]; X[0] = h_; X[2] = l_; h_ = X[1] > X[3] ? X[1] : X[3]; l_ = X[1] > X[3] ? X[3] : X[1]; X[1] = h_; X[3] = l_; h_ = X[4] > X[6] ? X[4] : X[6]; l_ = X[4] > X[6] ? X[6] : X[4]; X[4] = h_; X[6] = l_; h_ = X[5] > X[7] ? X[5] : X[7]; l_ = X[5] > X[7] ? X[7] : X[5]; X[5] = h_; X[7] = l_; h_ = X[8] > X[10] ? X[8] : X[10]; l_ = X[8] > X[10] ? X[10] : X[8]; X[8] = h_; X[10] = l_; h_ = X[9] > X[11] ? X[9] : X[11]; l_ = X[9] > X[11] ? X[11] : X[9]; X[9] = h_; X[11] = l_; h_ = X[12] > X[14] ? X[12] : X[14]; l_ = X[12] > X[14] ? X[14] : X[12]; X[12] = h_; X[14] = l_; h_ = X[13] > X[15] ? X[13] : X[15]; l_ = X[13] > X[15] ? X[15] : X[13]; X[13] = h_; X[15] = l_; h_ = X[0] > X[1] ? X[0] : X[1]; l_ = X[0] > X[1] ? X[1] : X[0]; X[0] = h_; X[1] = l_; h_ = X[2] > X[3] ? X[2] : X[3]; l_ = X[2] > X[3] ? X[3] : X[2]; X[2] = h_; X[3] = l_; h_ = X[4] > X[5] ? X[4] : X[5]; l_ = X[4] > X[5] ? X[5] : X[4]; X[4] = h_; X[5] = l_; h_ = X[6] > X[7] ? X[6] : X[7]; l_ = X[6] > X[7] ? X[7] : X[6]; X[6] = h_; X[7] = l_; h_ = X[8] > X[9] ? X[8] : X[9]; l_ = X[8] > X[9] ? X[9] : X[8]; X[8] = h_; X[9] = l_; h_ = X[10] > X[11] ? X[10] : X[11]; l_ = X[10] > X[11] ? X[11] : X[10]; X[10] = h_; X[11] = l_; h_ = X[12] > X[13] ? X[12] : X[13]; l_ = X[12] > X[13] ? X[13] : X[12]; X[12] = h_; X[13] = l_; h_ = X[14] > X[15] ? X[14] : X[15]; l_ = X[14] > X[15] ? X[15] : X[14]; X[14] = h_; X[15] = l_; } while (0)
#define MERGE16(X) do { unsigned h_, l_; h_ = X[0] > X[8] ? X[0] : X[8]; l_ = X[0] > X[8] ? X[8] : X[0]; X[0] = h_; X[8] = l_; h_ = X[1] > X[9] ? X[1] : X[9]; l_ = X[1] > X[9] ? X[9] : X[1]; X[1] = h_; X[9] = l_; h_ = X[2] > X[10] ? X[2] : X[10]; l_ = X[2] > X[10] ? X[10] : X[2]; X[2] = h_; X[10] = l_; h_ = X[3] > X[11] ? X[3] : X[11]; l_ = X[3] > X[11] ? X[11] : X[3]; X[3] = h_; X[11] = l_; h_ = X[4] > X[12] ? X[4] : X[12]; l_ = X[4] > X[12] ? X[12] : X[4]; X[4] = h_; X[12] = l_; h_ = X[5] > X[13] ? X[5] : X[13]; l_ = X[5] > X[13] ? X[13] : X[5]; X[5] = h_; X[13] = l_; h_ = X[6] > X[14] ? X[6] : X[14]; l_ = X[6] > X[14] ? X[14] : X[6]; X[6] = h_; X[14] = l_; h_ = X[7] > X[15] ? X[7] : X[15]; l_ = X[7] > X[15] ? X[15] : X[7]; X[7] = h_; X[15] = l_; h_ = X[0] > X[4] ? X[0] : X[4]; l_ = X[0] > X[4] ? X[4] : X[0]; X[0] = h_; X[4] = l_; h_ = X[1] > X[5] ? X[1] : X[5]; l_ = X[1] > X[5] ? X[5] : X[1]; X[1] = h_; X[5] = l_; h_ = X[2] > X[6] ? X[2] : X[6]; l_ = X[2] > X[6] ? X[6] : X[2]; X[2] = h_; X[6] = l_; h_ = X[3] > X[7] ? X[3] : X[7]; l_ = X[3] > X[7] ? X[7] : X[3]; X[3] = h_; X[7] = l_; h_ = X[8] > X[12] ? X[8] : X[12]; l_ = X[8] > X[12] ? X[12] : X[8]; X[8] = h_; X[12] = l_; h_ = X[9] > X[13] ? X[9] : X[13]; l_ = X[9] > X[13] ? X[13] : X[9]; X[9] = h_; X[13] = l_; h_ = X[10] > X[14] ? X[10] : X[14]; l_ = X[10] > X[14] ? X[14] : X[10]; X[10] = h_; X[14] = l_; h_ = X[11] > X[15] ? X[11] : X[15]; l_ = X[11] > X[15] ? X[15] : X[11]; X[11] = h_; X[15] = l_; h_ = X[0] > X[2] ? X[0] : X[2]; l_ = X[0] > X[2] ? X[2] : X[0]; X[0] = h_; X[2] = l_; h_ = X[1] > X[3] ? X[1] : X[3]; l_ = X[1] > X[3] ? X[3] : X[1]; X[1] = h_; X[3] = l_; h_ = X[4] > X[6] ? X[4] : X[6]; l_ = X[4] > X[6] ? X[6] : X[4]; X[4] = h_; X[6] = l_; h_ = X[5] > X[7] ? X[5] : X[7]; l_ = X[5] > X[7] ? X[7] : X[5]; X[5] = h_; X[7] = l_; h_ = X[8] > X[10] ? X[8] : X[10]; l_ = X[8] > X[10] ? X[10] : X[8]; X[8] = h_; X[10] = l_; h_ = X[9] > X[11] ? X[9] : X[11]; l_ = X[9] > X[11] ? X[11] : X[9]; X[9] = h_; X[11] = l_; h_ = X[12] > X[14] ? X[12] : X[14]; l_ = X[12] > X[14] ? X[14] : X[12]; X[12] = h_; X[14] = l_; h_ = X[13] > X[15] ? X[13] : X[15]; l_ = X[13] > X[15] ? X[15] : X[13]; X[13] = h_; X[15] = l_; h_ = X[0] > X[1] ? X[0] : X[1]; l_ = X[0] > X[1] ? X[1] : X[0]; X[0] = h_; X[1] = l_; h_ = X[2] > X[3] ? X[2] : X[3]; l_ = X[2] > X[3] ? X[3] : X[2]; X[2] = h_; X[3] = l_; h_ = X[4] > X[5] ? X[4] : X[5]; l_ = X[4] > X[5] ? X[5] : X[4]; X[4] = h_; X[5] = l_; h_ = X[6] > X[7] ? X[6] : X[7]; l_ = X[6] > X[7] ? X[7] : X[6]; X[6] = h_; X[7] = l_; h_ = X[8] > X[9] ? X[8] : X[9]; l_ = X[8] > X[9] ? X[9] : X[8]; X[8] = h_; X[9] = l_; h_ = X[10] > X[11] ? X[10] : X[11]; l_ = X[10] > X[11] ? X[11] : X[10]; X[10] = h_; X[11] = l_; h_ = X[12] > X[13] ? X[12] : X[13]; l_ = X[12] > X[13] ? X[13] : X[12]; X[12] = h_; X[13] = l_; h_ = X[14] > X[15] ? X[14] : X[15]; l_ = X[14] > X[15] ? X[15] : X[14]; X[14] = h_; X[15] = l_; } while (0)

__device__ __forceinline__ unsigned f2ord(float f) { const unsigned u = __float_as_uint(f); return (u & 0x80000000u) ? ~u : (u | 0x80000000u); }
__device__ __forceinline__ float ord2f(unsigned o) { return __uint_as_float((o & 0x80000000u) ? (o & 0x7fffffffu) : ~o); }
#define CANDKEY(sum, c) ((f2ord(sum) & ~255u) | (255u - (unsigned)(c)))
__device__ __forceinline__ void xmerge16(unsigned (&X)[16], int mask) {
  unsigned T[16];
#pragma unroll
  for (int i = 0; i < 16; ++i) T[i] = (unsigned)__shfl_xor((int)X[15 - i], mask);
#pragma unroll
  for (int i = 0; i < 16; ++i) X[i] = X[i] > T[i] ? X[i] : T[i];
  MERGE16(X);
}

__device__ __forceinline__ void ph9_topk(const P& p, int bid, int nb, char* smem) {
  const int tid = threadIdx.x & 255, lane = tid & 63, wave = tid >> 6, lr = lane & 15, lq = lane >> 4;
  int* idxs = (int*)smem + wave * 512;
  const int gw = bid * 4 + wave, ngw = nb * 4;
  const __amdgpu_buffer_rsrc_t r_q = mk_rsrc(p.qb), r_k = mk_rsrc(p.keys_bf);
  for (int it = gw; it < 1024 * 8; it += ngw) {
    const int h = it & 7, tile = it >> 3;
    const int tok = tile * 16 + lr;
    unsigned R0[16], R1[16];
#pragma unroll
    for (int pp = 0; pp < 2; ++pp) {
      bf16x8 bq[4];
#pragma unroll
      for (int kk = 0; kk < 4; ++kk) bq[kk] = bload8(r_q, (lr * 2048 + lq * 8) * 2 + kk * 64, (tile * 16 * 2048 + h * 256 + pp * 128) * 2);
      f32x4 acc[8];
#pragma unroll
      for (int j = 0; j < 8; ++j) acc[j] = (f32x4){0.f, 0.f, 0.f, 0.f};
#pragma unroll
      for (int j = 0; j < 8; ++j)
#pragma unroll
        for (int kk = 0; kk < 4; ++kk) {
          const bf16x8 a = bload8(r_k, (lr * 128 + lq * 8) * 2 + kk * 64, ((h * 2 + pp) * 16384 + j * 2048) * 2);
          acc[j] = __builtin_amdgcn_mfma_f32_16x16x32_bf16(a, bq[kk], acc[j], 0, 0, 0);
        }
      unsigned X[16], Y[16];
#pragma unroll
      for (int j = 0; j < 4; ++j)
#pragma unroll
        for (int e = 0; e < 4; ++e) {
          X[j * 4 + e] = (f2ord(acc[j][e]) & ~127u) | (127u - (unsigned)(j * 16 + lq * 4 + e));
          Y[j * 4 + e] = (f2ord(acc[4 + j][e]) & ~127u) | (127u - (unsigned)((4 + j) * 16 + lq * 4 + e));
        }
      SORT16(X);
      SORT16(Y);
#pragma unroll
      for (int i = 0; i < 16; ++i) X[i] = X[i] > Y[15 - i] ? X[i] : Y[15 - i];
      MERGE16(X);
      xmerge16(X, 16);
      xmerge16(X, 32);
#pragma unroll
      for (int i = 0; i < 16; ++i) { if (pp == 0) R0[i] = X[i]; else R1[i] = X[i]; }
    }
    if (lq == 0) {
#pragma unroll
      for (int i = 0; i < 16; ++i) { idxs[lr * 32 + i] = 127 - (int)(R0[i] & 127u); idxs[lr * 32 + 16 + i] = 127 - (int)(R1[i] & 127u); }
    }
    float va[16], vb[16];
#pragma unroll
    for (int i = 0; i < 16; ++i) { va[i] = ord2f(R0[i] & ~127u); vb[i] = ord2f(R1[i] & ~127u); }
    unsigned F[16];
  F[0] = lq == 0 ? CANDKEY(va[0] + vb[0], 0) : (lq == 1 ? CANDKEY(va[1] + vb[0], 16) : (lq == 2 ? CANDKEY(va[3] + vb[0], 48) : CANDKEY(va[13] + vb[0], 208)));
  F[1] = lq == 0 ? CANDKEY(va[0] + vb[1], 1) : (lq == 1 ? CANDKEY(va[1] + vb[1], 17) : (lq == 2 ? CANDKEY(va[3] + vb[1], 49) : CANDKEY(va[14] + vb[0], 224)));
  F[2] = lq == 0 ? CANDKEY(va[0] + vb[2], 2) : (lq == 1 ? CANDKEY(va[1] + vb[2], 18) : (lq == 2 ? CANDKEY(va[3] + vb[2], 50) : CANDKEY(va[15] + vb[0], 240)));
  F[3] = lq == 0 ? CANDKEY(va[0] + vb[3], 3) : (lq == 1 ? CANDKEY(va[1] + vb[3], 19) : (lq == 2 ? CANDKEY(va[3] + vb[3], 51) : 0u));
  F[4] = lq == 0 ? CANDKEY(va[0] + vb[4], 4) : (lq == 1 ? CANDKEY(va[1] + vb[4], 20) : (lq == 2 ? CANDKEY(va[4] + vb[0], 64) : 0u));
  F[5] = lq == 0 ? CANDKEY(va[0] + vb[5], 5) : (lq == 1 ? CANDKEY(va[1] + vb[5], 21) : (lq == 2 ? CANDKEY(va[4] + vb[1], 65) : 0u));
  F[6] = lq == 0 ? CANDKEY(va[0] + vb[6], 6) : (lq == 1 ? CANDKEY(va[1] + vb[6], 22) : (lq == 2 ? CANDKEY(va[4] + vb[2], 66) : 0u));
  F[7] = lq == 0 ? CANDKEY(va[0] + vb[7], 7) : (lq == 1 ? CANDKEY(va[1] + vb[7], 23) : (lq == 2 ? CANDKEY(va[6] + vb[0], 96) : 0u));
  F[8] = lq == 0 ? CANDKEY(va[0] + vb[8], 8) : (lq == 1 ? CANDKEY(va[2] + vb[0], 32) : (lq == 2 ? CANDKEY(va[6] + vb[1], 97) : 0u));
  F[9] = lq == 0 ? CANDKEY(va[0] + vb[9], 9) : (lq == 1 ? CANDKEY(va[2] + vb[1], 33) : (lq == 2 ? CANDKEY(va[7] + vb[0], 112) : 0u));
  F[10] = lq == 0 ? CANDKEY(va[0] + vb[10], 10) : (lq == 1 ? CANDKEY(va[2] + vb[2], 34) : (lq == 2 ? CANDKEY(va[7] + vb[1], 113) : 0u));
  F[11] = lq == 0 ? CANDKEY(va[0] + vb[11], 11) : (lq == 1 ? CANDKEY(va[2] + vb[3], 35) : (lq == 2 ? CANDKEY(va[8] + vb[0], 128) : 0u));
  F[12] = lq == 0 ? CANDKEY(va[0] + vb[12], 12) : (lq == 1 ? CANDKEY(va[2] + vb[4], 36) : (lq == 2 ? CANDKEY(va[9] + vb[0], 144) : 0u));
  F[13] = lq == 0 ? CANDKEY(va[0] + vb[13], 13) : (lq == 1 ? CANDKEY(va[5] + vb[0], 80) : (lq == 2 ? CANDKEY(va[10] + vb[0], 160) : 0u));
  F[14] = lq == 0 ? CANDKEY(va[0] + vb[14], 14) : (lq == 1 ? CANDKEY(va[5] + vb[1], 81) : (lq == 2 ? CANDKEY(va[11] + vb[0], 176) : 0u));
  F[15] = lq == 0 ? CANDKEY(va[0] + vb[15], 15) : (lq == 1 ? 0u : (lq == 2 ? CANDKEY(va[12] + vb[0], 192) : 0u));

    SORT16(F);
    xmerge16(F, 16);
    xmerge16(F, 32);
    if (lq == 0) {
      float ev[16];
      const float mx = ord2f(F[0] & ~255u);
      float tot = 0.f;
#pragma unroll
      for (int r = 0; r < 16; ++r) { ev[r] = __expf(ord2f(F[r] & ~255u) - mx); tot += ev[r]; }
      const float inv = 1.f / tot;
      int ei[16];
#pragma unroll
      for (int r = 0; r < 16; ++r) {
        const int c = 255 - (int)(F[r] & 255u);
        ei[r] = idxs[lr * 32 + (c >> 4)] * 128 + idxs[lr * 32 + 16 + (c & 15)];
      }
      int* ep = p.eidx + (size_t)tok * 128 + h * 16;
      float* gp = p.gate + (size_t)tok * 128 + h * 16;
#pragma unroll
      for (int r = 0; r < 4; ++r) {
        *(u32x4*)(ep + r * 4) = (u32x4){(unsigned)ei[r * 4], (unsigned)ei[r * 4 + 1], (unsigned)ei[r * 4 + 2], (unsigned)ei[r * 4 + 3]};
        *(f32x4*)(gp + r * 4) = (f32x4){ev[r * 4] * inv, ev[r * 4 + 1] * inv, ev[r * 4 + 2] * inv, ev[r * 4 + 3] * inv};
      }
    }
  }
}

__device__ __forceinline__ void ph_convert_tables(const P& p, int bid, int nb) {
  const int wave = (threadIdx.x >> 6) & 3, lane = threadIdx.x & 63;
  for (int row = bid * 4 + wave; row < 32768; row += nb * 4) {
    const bool isu = row < 16384;
    const float* src = isu ? p.U + (size_t)row * 1024 : p.V + (size_t)(row - 16384) * 1024;
    unsigned char* dst = isu ? p.U8 + (size_t)row * 1024 : p.V8 + (size_t)(row - 16384) * 1024;
    const float sc = isu ? 512.f : 32.f;
#pragma unroll
    for (int j = 0; j < 4; ++j) {
      const f32x4 v = __builtin_nontemporal_load((const f32x4*)src + j * 64 + lane);
      int w = 0;
      w = __builtin_amdgcn_cvt_pk_fp8_f32(v.x * sc, v.y * sc, w, false);
      w = __builtin_amdgcn_cvt_pk_fp8_f32(v.z * sc, v.w * sc, w, true);
      *(int*)(dst + j * 256 + lane * 4) = w;
    }
  }
}

__device__ __forceinline__ float gelu_exact(float a) { return 0.5f * a * (1.f + erff(a * 0.70710678118654752f)); }

#define G_LOAD(buf, s_) do { const int s__ = (s_); const unsigned char* tab__ = s__ < 16 ? p.U8 : p.V8; const int er__ = (s__ & 8) ? e1 : e0; \
    _Pragma("unroll") for (int k = 0; k < 8; ++k) { const int e__ = __builtin_amdgcn_readlane(er__, (s__ & 7) * 8 + k); \
      buf[k] = *((const u32x4*)(tab__ + (size_t)e__ * 1024) + lane); } } while (0)
#define G_COMPUTE(buf, s_) do { const int s__ = (s_); \
    if (s__ < 16) { \
      float pp[8]; \
      _Pragma("unroll") for (int k = 0; k < 8; ++k) { \
        f32x2 ac = {0.f, 0.f}; \
        _Pragma("unroll") for (int d = 0; d < 4; ++d) { \
          ac = __builtin_amdgcn_cvt_pk_f32_fp8((int)buf[k][d], false) * x2[2 * d] + ac; \
          ac = __builtin_amdgcn_cvt_pk_f32_fp8((int)buf[k][d], true) * x2[2 * d + 1] + ac; } \
        pp[k] = ac.x + ac.y; } \
        \
      float q4[4], r2[2], tt; \
      _Pragma("unroll") for (int i = 0; i < 4; ++i) { const float sd = b5 ? pp[i] : pp[i + 4]; q4[i] = (b5 ? pp[i + 4] : pp[i]) + __shfl_xor(sd, 32); } \
      _Pragma("unroll") for (int i = 0; i < 2; ++i) { const float sd = b4 ? q4[i] : q4[i + 2]; r2[i] = (b4 ? q4[i + 2] : q4[i]) + __shfl_xor(sd, 16); } \
      { const float sd = b3 ? r2[0] : r2[1]; tt = (b3 ? r2[1] : r2[0]) + __shfl_xor(sd, 8); } \
      tt += __shfl_xor(tt, 4); tt += __shfl_xor(tt, 2); tt += __shfl_xor(tt, 1); \
      const float dv = __shfl(tt, (lane & 7) * 8); \
      if ((lane >> 3) == (s__ & 7)) { if (s__ & 8) a1 = dv; else a0 = dv; } \
    } else { \
      if (s__ == 16) { w0 = gelu_exact(a0 * (1.f / 512.f)) * g0; w1 = gelu_exact(a1 * (1.f / 512.f)) * g1; } \
      const int wr__ = __float_as_int((s__ & 8) ? w1 : w0); \
      _Pragma("unroll") for (int k = 0; k < 8; ++k) { \
        const float w__ = __int_as_float(__builtin_amdgcn_readlane(wr__, (s__ & 7) * 8 + k)); \
        const f32x2 ww = {w__, w__}; \
        _Pragma("unroll") for (int d = 0; d < 4; ++d) { \
          y2[2 * d] = __builtin_amdgcn_cvt_pk_f32_fp8((int)buf[k][d], false) * ww + y2[2 * d]; \
          y2[2 * d + 1] = __builtin_amdgcn_cvt_pk_f32_fp8((int)buf[k][d], true) * ww + y2[2 * d + 1]; } } \
    } } while (0)

__device__ __forceinline__ void ph10_gather(const P& p, int bid, int nb) {
  const int wave = __builtin_amdgcn_readfirstlane((threadIdx.x >> 6) & 3), lane = threadIdx.x & 63;
  const bool b5 = lane & 32, b4 = lane & 16, b3 = lane & 8;
  for (int tok = bid * 4 + wave; tok < TL; tok += nb * 4) {
    const int b = tok / SEQ;
    f32x2 x2[8], y2[8];
    {
      const u32x4 h0 = *((const u32x4*)(p.hn + (size_t)tok * 1024 + lane * 16));
      const u32x4 h1 = *((const u32x4*)(p.hn + (size_t)tok * 1024 + lane * 16 + 8));
#pragma unroll
      for (int i = 0; i < 4; ++i) { x2[i] = (f32x2){blo(h0[i]), bhi(h0[i])}; x2[4 + i] = (f32x2){blo(h1[i]), bhi(h1[i])}; }
#pragma unroll
      for (int i = 0; i < 8; ++i) y2[i] = (f32x2){0.f, 0.f};
    }
    const int e0 = p.eidx[(size_t)tok * 128 + lane], e1 = p.eidx[(size_t)tok * 128 + 64 + lane];
    const float g0 = p.gate[(size_t)tok * 128 + lane], g1 = p.gate[(size_t)tok * 128 + 64 + lane];
    float a0 = 0.f, a1 = 0.f, w0 = 0.f, w1 = 0.f;
    u32x4 A[8], B[8], C[8], D[8];
    G_LOAD(A, 0); G_LOAD(B, 1); G_LOAD(C, 2);
#pragma unroll 1
    for (int s = 0; s < 32; s += 4) {
      G_LOAD(D, s + 3);
      G_COMPUTE(A, s);
      if (s + 4 < 32) G_LOAD(A, s + 4);
      G_COMPUTE(B, s + 1);
      if (s + 5 < 32) G_LOAD(B, s + 5);
      G_COMPUTE(C, s + 2);
      if (s + 6 < 32) G_LOAD(C, s + 6);
      G_COMPUTE(D, s + 3);
    }
    float* orow = p.out + (size_t)tok * 1024 + lane * 16;
    const float* g2 = p.mod + b * 6144 + 5 * 1024 + lane * 16;
    float z[16];
    float ss = 0.f;
#pragma unroll
    for (int q = 0; q < 4; ++q) {
      const f32x4 xl = *(const f32x4*)(orow + q * 4);
      const f32x4 gg = *(const f32x4*)(g2 + q * 4);
      const float yv[4] = {y2[2 * q].x, y2[2 * q].y, y2[2 * q + 1].x, y2[2 * q + 1].y};
#pragma unroll
      for (int i = 0; i < 4; ++i) { const float zz = xl[i] + gg[i] * (yv[i] * (1.f / 32.f)); z[q * 4 + i] = zz; ss += zz * zz; }
    }
    ss = wave_sum(ss);
    const float rstd = rsqrtf(ss * (1.f / 1024.f) + 1e-6f);
#pragma unroll
    for (int q = 0; q < 4; ++q) {
      const f32x4 fw = *(const f32x4*)(p.final_norm_w + lane * 16 + q * 4);
      f32x4 o;
#pragma unroll
      for (int i = 0; i < 4; ++i) o[i] = z[q * 4 + i] * rstd * fw[i];
      *(f32x4*)(orow + q * 4) = o;
    }
  }
}

__global__ void __launch_bounds__(2 * NTHR, 2) mega(P p) {
  __shared__ __attribute__((aligned(16))) char smem_all[2 * LDS_HALF];
  cg::grid_group grid = cg::this_grid();
  const int half = __builtin_amdgcn_readfirstlane(threadIdx.x >> 8);
  char* smem = smem_all + half * LDS_HALF;
  const int bid = blockIdx.x * 2 + half, nb = gridDim.x * 2;
#ifndef REPEAT_MASK
#define REPEAT_MASK 0
#endif
#ifndef EXTRA_SYNCS
#define EXTRA_SYNCS 0
#endif
#define GSYNC() do { asm volatile("s_waitcnt vmcnt(0)" ::: "memory"); grid.sync(); } while (0)
#define RUN(k, call) if ((PHMASK & (1 << k)) && p.ph_lo <= k && k < p.ph_hi) { call; if (REPEAT_MASK & (1 << k)) { GSYNC(); call; } \
    if (k + 1 < p.ph_hi) { GSYNC(); for (int xs = 0; xs < EXTRA_SYNCS; ++xs) GSYNC(); } }
  RUN(0, ph0_prep(p, bid, nb, smem))
  RUN(1, ph_norm_rows<0>(p, bid, nb))
  RUN(2, ph_gemm<0>(p, bid, nb, smem))
  RUN(3, ph3_chunk_local(p, bid, nb, smem))
  RUN(4, ph4_scan(p, bid, nb))
  RUN(5, ph5_mlstm_out(p, bid, nb, smem))
  RUN(6, (ph_gemm<1>(p, bid, nb, smem), ph_convert_tables(p, bid, nb)))
  RUN(7, ph_norm_rows<1>(p, bid, nb))
  RUN(8, ph_gemm<2>(p, bid, nb, smem))
  RUN(9, ph9_topk(p, bid, nb, smem))
  RUN(10, ph10_gather(p, bid, nb))
#undef RUN
}

extern "C" void kernel_launch(void* const* d_in, const int* in_sizes, int n_in, void* d_out, int out_size, void* d_ws, size_t ws_size,
                              hipStream_t stream) {
  static int grid_blocks = 0;
  if (!grid_blocks) {
    int dev = 0, cus = 0, per_cu = 0;
    hipGetDevice(&dev);
    hipDeviceGetAttribute(&cus, hipDeviceAttributeMultiprocessorCount, dev);
    hipOccupancyMaxActiveBlocksPerMultiprocessor(&per_cu, (const void*)mega, 2 * NTHR, 0);
    per_cu = 1;
    grid_blocks = cus * per_cu;
    if (ws_size < WS_END) fprintf(stderr, "kernel_launch: workspace too small: %zu < %llu\n", ws_size, (unsigned long long)WS_END);
  }
  P p{};
  const float* const* in = (const float* const*)d_in;
  p.x = in[0]; p.c = in[1]; p.ctx = in[2]; p.c_ctx = in[3]; p.w_mod = in[4]; p.b_mod = in[5]; p.norm1_w = in[6]; p.w_in = in[7];
  p.conv_w = in[8]; p.conv_b = in[9]; p.b_gates = in[10]; p.head_norm_w = in[11]; p.pool_w = in[12]; p.pool_scale = in[13];
  p.w_out = in[14]; p.norm2_w = in[15]; p.wq = in[16]; p.keys = in[17]; p.U = in[18]; p.V = in[19]; p.final_norm_w = in[20];
  p.out = (float*)d_out;
  char* ws = (char*)d_ws;
  p.mod = (float*)(ws + OFF_MOD); p.gates = (float*)(ws + OFF_GATES);
  p.wt_in = (bf16_t*)(ws + OFF_WTIN); p.wt_out = (bf16_t*)(ws + OFF_WTOUT); p.wt_q = (bf16_t*)(ws + OFF_WTQ);
  p.keys_bf = (bf16_t*)(ws + OFF_KEYS); p.hn = (bf16_t*)(ws + OFF_HN); p.pl = (bf16_t*)(ws + OFF_PL);
  p.Dst = (bf16_t*)(ws + OFF_D); p.ND = (float*)(ws + OFF_ND); p.SC = (float*)(ws + OFF_SC);
  p.CIN = (bf16_t*)(ws + OFF_CIN); p.NIN = (float*)(ws + OFF_NIN); p.MIN_ = (float*)(ws + OFF_MIN);
  p.mix = (bf16_t*)(ws + OFF_D); p.qb = (bf16_t*)(ws + OFF_D);
  p.U8 = (unsigned char*)(ws + OFF_PL); p.V8 = (unsigned char*)(ws + OFF_PL + 16777216ull);
  p.eidx = (int*)(ws + OFF_EIDX); p.gate = (float*)(ws + OFF_GATE);
#if N_LAUNCHES == 1
  p.ph_lo = 0; p.ph_hi = NPH;
  void* args[] = {&p};
  hipError_t e = hipLaunchCooperativeKernel((const void*)mega, dim3(grid_blocks), dim3(2 * NTHR), args, 0, stream);
  if (e != hipSuccess) fprintf(stderr, "cooperative launch failed: %s (grid %d)\n", hipGetErrorString(e), grid_blocks);
#else
  for (int ph = 0; ph < NPH; ++ph) {
    p.ph_lo = ph; p.ph_hi = ph + 1;
    void* args[] = {&p};
    hipError_t e = hipLaunchCooperativeKernel((const void*)mega, dim3(grid_blocks), dim3(2 * NTHR), args, 0, stream);
    if (e != hipSuccess) fprintf(stderr, "launch %d failed: %s (grid %d)\n", ph, hipGetErrorString(e), grid_blocks);
  }
#endif
}
```

```cpp
#include <hip/hip_runtime.h>
#include <hip/hip_cooperative_groups.h>
#include <stdint.h>
#include <stdio.h>
namespace cg = cooperative_groups;

#ifndef PHMASK
#define PHMASK 0x7ff
#endif
#ifndef N_LAUNCHES
#define N_LAUNCHES 1
#endif

typedef unsigned short bf16_t;
typedef short bf16x8 __attribute__((ext_vector_type(8)));
typedef float f32x4 __attribute__((ext_vector_type(4)));
typedef unsigned u32x4 __attribute__((ext_vector_type(4)));
typedef float f32x2 __attribute__((ext_vector_type(2)));
typedef unsigned u32x2 __attribute__((ext_vector_type(2)));
typedef __bf16 bf16x2 __attribute__((ext_vector_type(2)));

#define NB 8
#define SEQ 2048
#define DM 1024
#define CTXL 256
#define TL 16384
#define TC 2048
#define TR 18432
#define LDP 2624
#define NPADIN 2688
#define NTHR 256
#define LDS_HALF 73728
#define NPH 11

#define OFF_MOD    (4096ull)
#define OFF_GATES  (OFF_MOD + 262144ull)
#define OFF_WTIN   (OFF_GATES + 1179648ull)
#define OFF_WTOUT  (OFF_WTIN + 5767168ull)
#define OFF_WTQ    (OFF_WTOUT + 2097152ull)
#define OFF_KEYS   (OFF_WTQ + 4194304ull)
#define OFF_POOLWT (OFF_KEYS + 524288ull)
#define OFF_HN     (OFF_POOLWT + 131072ull)
#define OFF_PL     (OFF_HN + 37748736ull)
#define OFF_D      (OFF_PL + 96731136ull)
#define OFF_ND     (OFF_D + 37748736ull)
#define OFF_SC     (OFF_ND + 589824ull)
#define OFF_CIN    (OFF_SC + 147456ull)
#define OFF_NIN    (OFF_CIN + 33554432ull)
#define OFF_MIN    (OFF_NIN + 524288ull)
#define OFF_EIDX   (OFF_MIN + 131072ull)
#define OFF_GATE   (OFF_EIDX + 8388608ull)
#define WS_END     (OFF_GATE + 8388608ull)

struct P {
  const float *x, *c, *ctx, *c_ctx, *w_mod, *b_mod, *norm1_w, *w_in, *conv_w, *conv_b, *b_gates, *head_norm_w,
      *pool_w, *pool_scale, *w_out, *norm2_w, *wq, *keys, *U, *V, *final_norm_w;
  float* out;
  float* mod;
  float* gates;
  bf16_t* wt_in;
  bf16_t* wt_out;
  bf16_t* wt_q;
  bf16_t* keys_bf;
  bf16_t* hn;
  bf16_t* pl;
  bf16_t* Dst;
  float* ND;
  float* SC;
  bf16_t* CIN;
  float* NIN;
  float* MIN_;
  bf16_t* mix;
  bf16_t* qb;
  unsigned char* U8;
  unsigned char* V8;
  int* eidx;
  float* gate;
  int ph_lo, ph_hi;
};

__device__ __forceinline__ bf16_t f2bf(float f) { return __builtin_bit_cast(bf16_t, (__bf16)f); }
__device__ __forceinline__ float bf2f(bf16_t h) { return __uint_as_float(((unsigned)h) << 16); }
__device__ __forceinline__ float wave_sum(float v) {
#pragma unroll
  for (int o = 32; o > 0; o >>= 1) v += __shfl_xor(v, o);
  return v;
}
__device__ __forceinline__ float silu_f(float v) { return v / (1.f + __expf(-v)); }
__device__ __forceinline__ float logsig_f(float v) { return fminf(v, 0.f) - log1pf(__expf(-fabsf(v))); }

__device__ __forceinline__ void ph0_prep(const P& p, int bid, int nb, char* smem) {
  float* sm = (float*)smem;
  const int tid = threadIdx.x & 255;
  const int N_MOD = 384, N_TIN = 16 * 44, N_TOUT = 256, N_TQ = 16 * 32, N_POOL = 16;
  const int total = N_MOD + N_TIN + N_TOUT + N_TQ + N_POOL;
  const int trips = (total + nb - 1) / nb;
  for (int k = 0; k < trips; ++k) {
    int r = (bid + k * nb) % total;
    if (r < N_MOD) {
      float* part = sm + 9 * 1024;
      for (int i = tid; i < 9 * 1024; i += NTHR) {
        int rr = i >> 10, kq = i & 1023;
        float v = rr < 8 ? p.c[rr * 1024 + kq] : p.c_ctx[kq];
        sm[i] = silu_f(v);
      }
      __syncthreads();
      {
        const int c = tid & 15, kg = tid >> 4, n = r * 16 + c;
        float acc[9];
#pragma unroll
        for (int q = 0; q < 9; ++q) acc[q] = 0.f;
#pragma unroll 8
        for (int i = 0; i < 64; ++i) {
          const int kq = kg + i * 16;
          const float w = p.w_mod[(size_t)kq * 6144 + n];
#pragma unroll
          for (int q = 0; q < 9; ++q) acc[q] += sm[q * 1024 + kq] * w;
        }
#pragma unroll
        for (int q = 0; q < 9; ++q) part[(kg * 9 + q) * 16 + c] = acc[q];
      }
      __syncthreads();
      if (tid < 144) {
        const int q = tid >> 4, c = tid & 15, n = r * 16 + c;
        float t = p.b_mod[n];
#pragma unroll
        for (int kg = 0; kg < 16; ++kg) t += part[(kg * 9 + q) * 16 + c];
        p.mod[q * 6144 + n] = t;
      }
      continue;
    }
    r -= N_MOD;
    const float* src = nullptr; bf16_t* dst = nullptr; int K = 1024, N = 0, ntn = 0;
    if (r < N_TIN) { src = p.w_in; dst = p.wt_in; N = 2576; ntn = 44; }
    else { r -= N_TIN;
      if (r < N_TOUT) { src = p.w_out; dst = p.wt_out; N = 1024; ntn = 16; }
      else { r -= N_TOUT;
        if (r < N_TQ) { src = p.wq; dst = p.wt_q; N = 2048; ntn = 32; }
        else { r -= N_TQ; int g = r >> 2; r &= 3; src = p.pool_w + g * 16384; dst = (bf16_t*)((char*)p.keys_bf + 524288) + g * 16384; K = 128; N = 128; ntn = 2; }
      }
    }
    {
      int kt = r / ntn, nt = r % ntn, k0 = kt * 64, n0 = nt * 64;
      int cc = tid & 63;
      for (int rr = tid >> 6; rr < 64; rr += 4) {
        int n = n0 + cc;
        sm[rr * 65 + cc] = n < N ? src[(size_t)(k0 + rr) * N + n] : 0.f;
      }
      __syncthreads();
      for (int rr = tid >> 6; rr < 64; rr += 4) dst[(size_t)(n0 + rr) * K + k0 + cc] = f2bf(sm[cc * 65 + rr]);
      __syncthreads();
    }
  }
  for (int i = bid * NTHR + tid; i < 262144; i += nb * NTHR) p.keys_bf[i] = f2bf(p.keys[i]);
}

template <int WHICH>
__device__ __forceinline__ void ph_norm_rows(const P& p, int bid, int nb) {
  const int wave = (threadIdx.x >> 6) & 3, lane = threadIdx.x & 63;
  const int nrows = WHICH == 0 ? TR : TL;
  for (int row = bid * 4 + wave; row < nrows; row += nb * 4) {
    const float* src = WHICH == 0 ? (row < TL ? p.x + (size_t)row * 1024 : p.ctx + (size_t)(row - TL) * 1024) : p.out + (size_t)row * 1024;
    const int mr = row < TL ? row / SEQ : 8;
    float4 v[4];
    float ss = 0.f;
#pragma unroll
    for (int j = 0; j < 4; ++j) {
      v[j] = ((const float4*)src)[j * 64 + lane];
      ss += v[j].x * v[j].x + v[j].y * v[j].y + v[j].z * v[j].z + v[j].w * v[j].w;
    }
    ss = wave_sum(ss);
    const float rstd = rsqrtf(ss * (1.f / 1024.f) + 1e-6f);
    const float* nw = WHICH == 0 ? p.norm1_w : p.norm2_w;
    const float* sh = p.mod + mr * 6144 + (WHICH == 0 ? 0 : 3) * 1024;
    const float* sc = sh + 1024;
#pragma unroll
    for (int j = 0; j < 4; ++j) {
      const int col = j * 256 + lane * 4;
      float4 w4 = *(const float4*)(nw + col), s4 = *(const float4*)(sh + col), c4 = *(const float4*)(sc + col);
      float y0 = v[j].x * rstd * w4.x * (1.f + c4.x) + s4.x;
      float y1 = v[j].y * rstd * w4.y * (1.f + c4.y) + s4.y;
      float y2 = v[j].z * rstd * w4.z * (1.f + c4.z) + s4.z;
      float y3 = v[j].w * rstd * w4.w * (1.f + c4.w) + s4.w;
      uint2 o;
      o.x = (unsigned)f2bf(y0) | ((unsigned)f2bf(y1) << 16);
      o.y = (unsigned)f2bf(y2) | ((unsigned)f2bf(y3) << 16);
      *(uint2*)(p.hn + (size_t)row * 1024 + col) = o;
    }
  }
}

#define GBK 64
#define GLD 72
template <int EPI>
__device__ __forceinline__ void gemm_tile(const P& p, const bf16_t* A, int lda, const bf16_t* Bt, int m0, int n0, bf16_t* sA, bf16_t* sB) {
  const int tid = threadIdx.x & 255, lane = tid & 63, wave = tid >> 6;
  const int wm = wave >> 1, wn = wave & 1;
  const int lr = lane & 15, lq = lane >> 4;
  f32x4 acc[4][4];
#pragma unroll
  for (int i = 0; i < 4; ++i)
#pragma unroll
    for (int j = 0; j < 4; ++j) acc[i][j] = (f32x4){0.f, 0.f, 0.f, 0.f};
  const int sr = tid >> 3, scol = (tid & 7) * 8;
  u32x4 ra[4], rb[4];
  const bf16_t* Ap = A + (size_t)(m0 + sr) * lda + scol;
  const bf16_t* Bp = Bt + (size_t)(n0 + sr) * 1024 + scol;
#pragma unroll
  for (int i = 0; i < 4; ++i) {
    ra[i] = *(const u32x4*)(Ap + (size_t)(i * 32) * lda);
    rb[i] = *(const u32x4*)(Bp + (size_t)(i * 32) * 1024);
  }
  for (int kt = 0; kt < 1024 / GBK; ++kt) {
    __syncthreads();
#pragma unroll
    for (int i = 0; i < 4; ++i) {
      *(u32x4*)(sA + (sr + i * 32) * GLD + scol) = ra[i];
      *(u32x4*)(sB + (sr + i * 32) * GLD + scol) = rb[i];
    }
    __syncthreads();
    {
      const int k0 = (kt + 1 < 1024 / GBK ? kt + 1 : kt) * GBK;
#pragma unroll
      for (int i = 0; i < 4; ++i) {
        ra[i] = *(const u32x4*)(Ap + (size_t)(i * 32) * lda + k0);
        rb[i] = *(const u32x4*)(Bp + (size_t)(i * 32) * 1024 + k0);
      }
    }
#pragma unroll
    for (int ks = 0; ks < 2; ++ks) {
      bf16x8 af[4], bfr[4];
#pragma unroll
      for (int i = 0; i < 4; ++i) {
        af[i] = *(const bf16x8*)(sA + (wm * 64 + i * 16 + lr) * GLD + ks * 32 + lq * 8);
        bfr[i] = *(const bf16x8*)(sB + (wn * 64 + i * 16 + lr) * GLD + ks * 32 + lq * 8);
      }
#pragma unroll
      for (int i = 0; i < 4; ++i)
#pragma unroll
        for (int j = 0; j < 4; ++j) acc[i][j] = __builtin_amdgcn_mfma_f32_16x16x32_bf16(af[i], bfr[j], acc[i][j], 0, 0, 0);
    }
  }
#pragma unroll
  for (int i = 0; i < 4; ++i)
#pragma unroll
    for (int j = 0; j < 4; ++j)
#pragma unroll
      for (int e = 0; e < 4; ++e) {
        const int row = m0 + wm * 64 + i * 16 + lq * 4 + e;
        const int col = n0 + wn * 64 + j * 16 + lr;
        const float v = acc[i][j][e];
        if (EPI == 0) {
          if (col < 2560) p.pl[(size_t)row * LDP + col] = f2bf(v);
          else if (col < 2576) p.gates[(size_t)row * 16 + (col - 2560)] = v;
        } else if (EPI == 1) {
          const int b = row / SEQ;
          p.out[(size_t)row * 1024 + col] = p.x[(size_t)row * 1024 + col] + p.mod[b * 6144 + 2 * 1024 + col] * v;
        } else {
          p.qb[(size_t)row * 2048 + col] = f2bf(v);
        }
      }
}

template <int EPI>
__device__ __forceinline__ void ph_gemm(const P& p, int bid, int nb, char* smem) {
  bf16_t* sA = (bf16_t*)smem;
  bf16_t* sB = sA + 128 * GLD;
  const int ntn = EPI == 0 ? 21 : (EPI == 1 ? 8 : 16);
  const int ntm = EPI == 0 ? 144 : 128;
  const bf16_t* A = EPI == 0 ? p.hn : (EPI == 1 ? p.mix : p.hn);
  const int lda = 1024;
  const bf16_t* Bt = EPI == 0 ? p.wt_in : (EPI == 1 ? p.wt_out : p.wt_q);
  const int nlat = 128 * ntn;
  const int ntiles = EPI == 0 ? nlat + 16 * 13 : ntm * ntn;
  const int trips = (ntiles + nb - 1) / nb;
  for (int k = 0; k < trips; ++k) {
    const int t = (bid + k * nb) % ntiles;
    int tm, tn;
    if (EPI == 0 && t >= nlat) { const int r = t - nlat; tm = 128 + r / 13; tn = r % 13; if (tn == 12) tn = 20; }
    else { tm = t / ntn; tn = t % ntn; }
    gemm_tile<EPI>(p, A, lda, Bt, tm * 128, tn * 128, sA, sB);
  }
}

struct UnitInfo { int isctx, b, c, h, T, seqrow0, row0; };
__device__ __forceinline__ UnitInfo decode_unit(int u) {
  UnitInfo r;
  if (u < 512) { r.isctx = 0; r.b = u >> 6; r.c = (u >> 2) & 15; r.h = u & 3; r.T = SEQ; r.seqrow0 = r.b * SEQ; }
  else { int uu = u - 512; r.isctx = 1; r.b = uu >> 3; r.c = (uu >> 2) & 1; r.h = uu & 3; r.T = CTXL; r.seqrow0 = TL + r.b * CTXL; }
  r.row0 = r.seqrow0 + r.c * 128;
  return r;
}
__device__ __forceinline__ float qk_act(const P& p, int seqrow0, int T, int t, int col) {
  const bf16_t* base = p.pl + (size_t)(seqrow0 + t) * LDP + col;
  float r0 = t > 0 ? bf2f(base[-LDP]) : 0.f;
  float r1 = bf2f(base[0]);
  float r2 = t + 1 < T ? bf2f(base[LDP]) : 0.f;
  float y = p.conv_b[col] + r0 * p.conv_w[col] + r1 * p.conv_w[1024 + col] + r2 * p.conv_w[2048 + col];
  return silu_f(y);
}


typedef short s16x4 __attribute__((ext_vector_type(4)));
#define LDS_AS __attribute__((address_space(3)))
__device__ __forceinline__ s16x4 ds_tr16(const bf16_t* ptr) { return __builtin_amdgcn_ds_read_tr16_b64_v4i16((LDS_AS s16x4*)ptr); }
__device__ __forceinline__ bf16x8 frag_tr(const bf16_t* M, int ld, int s0, int c0, int lr, int lq) {
  const bf16_t* a = M + (s0 + lq * 8 + (lr >> 2)) * ld + c0 + (lr & 3) * 4;
  const s16x4 t0 = ds_tr16(a), t1 = ds_tr16(a + 4 * ld);
  return __builtin_shufflevector(t0, t1, 0, 1, 2, 3, 4, 5, 6, 7);
}
__device__ __forceinline__ unsigned cvt_pk_bf16(float lo, float hi) { const f32x2 v = {lo, hi}; const bf16x2 b = __builtin_convertvector(v, bf16x2); return __builtin_bit_cast(unsigned, b); }
__device__ __forceinline__ float blo(unsigned u) { return __uint_as_float(u << 16); }
__device__ __forceinline__ float bhi(unsigned u) { return __uint_as_float(u & 0xffff0000u); }
#define VLD 136
__device__ __forceinline__ __amdgpu_buffer_rsrc_t mk_rsrc(const void* ptr) { return __builtin_amdgcn_make_buffer_rsrc((void*)ptr, 0, 0x7fffffff, 0x00020000); }
__device__ __forceinline__ bf16x8 bload8(__amdgpu_buffer_rsrc_t r, int voff, int soff) { return __builtin_bit_cast(bf16x8, __builtin_amdgcn_raw_buffer_load_b128(r, voff, soff, 0)); }


namespace pg8 {
#define PG8_LAS __attribute__((address_space(3)))
constexpr int BM = 256, BK = 64, HALF = 128, HTB = HALF * BK * 2, STAGE_BYTES = 8 * HTB, NXCD = 8, WGM = 8;
__host__ __device__ __forceinline__ int lds_byte(int r, int c) { const int st = (r >> 4) * 2 + (c >> 5), rr = r & 15, cc = c & 31, ob = rr * 64 + cc * 2; return st * 1024 + (ob ^ (((ob >> 9) & 1) << 5)); }
__host__ __device__ __forceinline__ void stage_rc(int b, int& R, int& C) { const int st = b / 1024, sb = b % 1024, swz = sb ^ (((sb >> 9) & 1) << 5); R = (st >> 1) * 16 + swz / 64; C = (st & 1) * 32 + (swz % 64) / 2; }
__host__ __device__ __forceinline__ int perm32(int rho) { const int n = rho >> 4, i = rho & 15; return 8 * (i >> 2) + 4 * n + (i & 3); }
struct Unit { int pm, pn; };
struct Gemm { const bf16_t* A; const bf16_t* Bt; int M, N, K; };
struct Order {
  int nM, nN, nwg, G, c, extra;
  __device__ void init(int nM_, int nN_, int G_, int c_, int extra_) { nM = nM_; nN = nN_; nwg = nM * nN; G = G_; c = c_; extra = extra_; }
  __device__ bool next(int i, Unit& u) const {
    const long L = (long)i * G + c;
    if (L >= nwg + extra) return false;
    if (L >= nwg) { const int r = (int)L - nwg; u.pm = nM + r / 7; const int q = r % 7; u.pn = q < 6 ? q : 10; return true; }
    int wgid = (int)L; { const int q = nwg / NXCD, r = nwg % NXCD, xcd = wgid % NXCD, off = wgid / NXCD; wgid = (xcd < r ? xcd * (q + 1) : r * (q + 1) + (xcd - r) * q) + off; }
    const int nig = WGM * nN, gid = wgid / nig, fm = gid * WGM, gsz = (nM - fm) < WGM ? (nM - fm) : WGM;
    u.pm = fm + ((wgid % nig) % gsz); u.pn = (wgid % nig) / gsz; return true;
  }
  __device__ __forceinline__ void a_ready(const Unit&) const {}
  __device__ __forceinline__ void done(const Unit&) const {}
};
template <class Epi, class Sched>
__device__ __forceinline__ void gemm_phase(PG8_LAS unsigned char* lds, const Gemm g, const Sched& S, const Epi& E) {
    const int tid = threadIdx.x, wid = __builtin_amdgcn_readfirstlane(tid >> 6), lane = tid & 63, wr = wid >> 2, wc = wid & 3, fr = lane & 15, fq = lane >> 4;
    const int K = g.K, nt = K / BK;
    unsigned voffA[2], voffB[2];
#pragma unroll
    for (int i = 0; i < 2; ++i) { int R, C; stage_rc(tid * 16 + i * 8192, R, C); const int Rb = Epi::PERM ? ((R & ~31) + perm32(R & 31)) : R;
        voffA[i] = (unsigned)(R * K + C) * 2u; voffB[i] = (unsigned)(Rb * K + C) * 2u; }
    const size_t kstep = (size_t)(BK * 2);
    const size_t hstep = (size_t)HALF * K * 2;
    const size_t tstep = 2 * hstep;
    const unsigned ldsw = (unsigned)wid * 1024u;
    const int aoff = lds_byte(wr * 64 + fr, fq * 8), boff = lds_byte(wc * 32 + fr, fq * 8);
#define PG8_SA(b, h) (((b) * 2 + (h)) * HTB)
#define PG8_SB(b, h) ((4 + (b) * 2 + (h)) * HTB)
#define PG8_STAGE(bufoff, gbase, voff) do { _Pragma("unroll") for (int _i = 0; _i < 2; ++_i) \
        __builtin_amdgcn_global_load_lds((const unsigned*)((const char*)(gbase) + (voff)[_i]), (PG8_LAS unsigned*)(lds + (bufoff) + ldsw + _i * 8192), 16, 0, 0); } while (0)
#define PG8_LDA(dst, b, h) do { _Pragma("unroll") for (int m = 0; m < 4; ++m) _Pragma("unroll") for (int k = 0; k < 2; ++k) dst[m][k] = *(const PG8_LAS bf16x8*)(lds + PG8_SA(b, h) + aoff + m * 2048 + k * 1024); } while (0)
#define PG8_LDB(dst, b, h) do { _Pragma("unroll") for (int n = 0; n < 2; ++n) _Pragma("unroll") for (int k = 0; k < 2; ++k) dst[n][k] = *(const PG8_LAS bf16x8*)(lds + PG8_SB(b, h) + boff + n * 2048 + k * 1024); } while (0)
#define PG8_MMA(ai, bj, At, Bt) do { __builtin_amdgcn_s_setprio(1); _Pragma("unroll") for (int m = 0; m < 4; ++m) _Pragma("unroll") for (int n = 0; n < 2; ++n) _Pragma("unroll") for (int k = 0; k < 2; ++k) \
        acc[ai][bj][m][n] = __builtin_amdgcn_mfma_f32_16x16x32_bf16(Bt[n][k], At[m][k], acc[ai][bj][m][n], 0, 0, 0); __builtin_amdgcn_s_setprio(0); } while (0)
#define PG8_WAIT_V(n) asm volatile("s_waitcnt vmcnt(" #n ")" ::: "memory")
#define PG8_WAIT_L(n) asm volatile("s_waitcnt lgkmcnt(" #n ")" ::: "memory")
#define PG8_BAR __builtin_amdgcn_s_barrier()
#define PG8_SCHED __builtin_amdgcn_sched_barrier(0)
    Unit cur, nxt; int ui = 0;
    if (!S.next(0, cur)) return;
    f32x4 acc[2][2][4][2];
#pragma unroll
    for (int a = 0; a < 2; ++a)
#pragma unroll
        for (int b = 0; b < 2; ++b)
#pragma unroll
            for (int m = 0; m < 4; ++m)
#pragma unroll
                for (int n = 0; n < 2; ++n) acc[a][b][m][n] = (f32x4){0.f, 0.f, 0.f, 0.f};
    bf16x8 At[4][2], B0[2][2], B1[2][2];
    const char* cA = (const char*)g.A + (size_t)cur.pm * tstep; const char* cB = (const char*)g.Bt + (size_t)cur.pn * tstep;
    S.a_ready(cur);
    PG8_STAGE(PG8_SB(0, 0), cB, voffB); PG8_STAGE(PG8_SA(0, 0), cA, voffA); PG8_STAGE(PG8_SB(0, 1), cB + hstep, voffB); PG8_STAGE(PG8_SA(0, 1), cA + hstep, voffA);
    if (wr == 1) PG8_BAR;
    PG8_WAIT_V(4); PG8_BAR;
    PG8_STAGE(PG8_SB(1, 0), cB + kstep, voffB); PG8_STAGE(PG8_SA(1, 0), cA + kstep, voffA); PG8_STAGE(PG8_SB(1, 1), cB + hstep + kstep, voffB);
    PG8_WAIT_V(6); PG8_BAR;
    for (;;) {
        const bool has_next = S.next(ui + 1, nxt);
        const char* nA = has_next ? (const char*)g.A + (size_t)nxt.pm * tstep : cA; const char* nB = has_next ? (const char*)g.Bt + (size_t)nxt.pn * tstep : cB;
        for (int t = 0; t < nt; t += 2) {
            const bool last = (t == nt - 2);
            const char* a1 = cA + (size_t)(t + 1) * kstep;
            const char* a2 = last ? nA : cA + (size_t)(t + 2) * kstep; const char* b2 = last ? nB : cB + (size_t)(t + 2) * kstep;
            const char* a3 = a2 + kstep; const char* b3 = b2 + kstep;
            if (last && has_next) S.a_ready(nxt);
            PG8_LDB(B0, 0, 0); PG8_SCHED; PG8_LDA(At, 0, 0); PG8_STAGE(PG8_SA(1, 1), a1 + hstep, voffA);
            PG8_WAIT_L(8); PG8_BAR; PG8_WAIT_L(0); PG8_MMA(0, 0, At, B0); PG8_BAR; PG8_SCHED;
            PG8_LDB(B1, 0, 1); PG8_STAGE(PG8_SB(0, 0), b2, voffB);
            PG8_BAR; PG8_WAIT_L(0); PG8_MMA(0, 1, At, B1); PG8_BAR;
            PG8_LDA(At, 0, 1); PG8_STAGE(PG8_SA(0, 0), a2, voffA);
            PG8_BAR; PG8_WAIT_L(0); PG8_MMA(1, 0, At, B0); PG8_BAR; PG8_SCHED;
            PG8_STAGE(PG8_SB(0, 1), b2 + hstep, voffB);
            PG8_WAIT_V(6); PG8_BAR; PG8_MMA(1, 1, At, B1); PG8_BAR;
            PG8_LDB(B0, 1, 0); PG8_SCHED; PG8_LDA(At, 1, 0); PG8_STAGE(PG8_SA(0, 1), a2 + hstep, voffA);
            PG8_WAIT_L(8); PG8_BAR; PG8_WAIT_L(0); PG8_MMA(0, 0, At, B0); PG8_BAR; PG8_SCHED;
            PG8_LDB(B1, 1, 1); PG8_STAGE(PG8_SB(1, 0), b3, voffB);
            PG8_BAR; PG8_WAIT_L(0); PG8_MMA(0, 1, At, B1); PG8_BAR;
            PG8_LDA(At, 1, 1); PG8_STAGE(PG8_SA(1, 0), a3, voffA);
            PG8_BAR; PG8_WAIT_L(0); PG8_MMA(1, 0, At, B0); PG8_BAR; PG8_SCHED;
            PG8_STAGE(PG8_SB(1, 1), b3 + hstep, voffB);
            PG8_WAIT_V(6); PG8_BAR; PG8_MMA(1, 1, At, B1); PG8_BAR;
        }
        if constexpr (!Epi::AFTER_DRAIN) { E(acc, cur, wr, wc, fr, fq); S.done(cur); }
        if (!has_next) break;
#pragma unroll
        for (int a = 0; a < 2; ++a)
#pragma unroll
            for (int b = 0; b < 2; ++b)
#pragma unroll
                for (int m = 0; m < 4; ++m)
#pragma unroll
                    for (int n = 0; n < 2; ++n) acc[a][b][m][n] = (f32x4){0.f, 0.f, 0.f, 0.f};
        cur = nxt; cA = nA; cB = nB; ++ui;
    }
    PG8_WAIT_V(0);
    if (wr == 0) PG8_BAR;
    PG8_BAR;
    if constexpr (Epi::AFTER_DRAIN) { E.fused(acc, cur, wr, wc, fr, fq, lds, wid, lane); S.done(cur); }
#undef PG8_SA
#undef PG8_SB
#undef PG8_STAGE
#undef PG8_LDA
#undef PG8_LDB
#undef PG8_MMA
#undef PG8_WAIT_V
#undef PG8_WAIT_L
#undef PG8_BAR
#undef PG8_SCHED
}
}

struct EpiIn {
  static constexpr bool PERM = true, AFTER_DRAIN = false;
  bf16_t* pl; float* gates;
  __device__ __forceinline__ void operator()(const f32x4 (&acc)[2][2][4][2], const pg8::Unit& u, int wr, int wc, int fr, int fq) const {
    const int row0 = u.pm * 256 + wr * 64 + fr;
#pragma unroll
    for (int ai = 0; ai < 2; ++ai)
#pragma unroll
      for (int m = 0; m < 4; ++m) {
        const int row = row0 + ai * 128 + m * 16;
#pragma unroll
        for (int bj = 0; bj < 2; ++bj) {
          const int c0 = u.pn * 256 + bj * 128 + wc * 32 + 8 * fq;
          const f32x4 v0 = acc[ai][bj][m][0], v1 = acc[ai][bj][m][1];
          if (c0 < 2560) {
            u32x4 w;
            w[0] = cvt_pk_bf16(v0[0], v0[1]); w[1] = cvt_pk_bf16(v0[2], v0[3]); w[2] = cvt_pk_bf16(v1[0], v1[1]); w[3] = cvt_pk_bf16(v1[2], v1[3]);
            *(u32x4*)(pl + (size_t)row * LDP + c0) = w;
          } else if (c0 < 2576) {
            *(f32x4*)(gates + (size_t)row * 16 + (c0 - 2560)) = v0;
            *(f32x4*)(gates + (size_t)row * 16 + (c0 - 2560) + 4) = v1;
          }
        }
      }
  }
};
struct EpiOut {
  static constexpr bool PERM = false, AFTER_DRAIN = false;
  const float* x; const float* mod; float* out;
  __device__ __forceinline__ void operator()(const f32x4 (&acc)[2][2][4][2], const pg8::Unit& u, int wr, int wc, int fr, int fq) const {
    const int row0 = u.pm * 256 + wr * 64 + fr, col0 = u.pn * 256 + wc * 32 + 4 * fq;
    const float* g1 = mod + (u.pm * 256 / SEQ) * 6144 + 2 * 1024;
#pragma unroll
    for (int ai = 0; ai < 2; ++ai)
#pragma unroll
      for (int m = 0; m < 4; ++m) {
        const size_t ro = (size_t)(row0 + ai * 128 + m * 16) * 1024;
#pragma unroll
        for (int bj = 0; bj < 2; ++bj)
#pragma unroll
          for (int n = 0; n < 2; ++n) {
            const int c = col0 + bj * 128 + n * 16;
            const f32x4 xv = *(const f32x4*)(x + ro + c), gv = *(const f32x4*)(g1 + c);
            *(f32x4*)(out + ro + c) = xv + gv * acc[ai][bj][m][n];
          }
      }
  }
};
struct EpiQ {
  static constexpr bool PERM = true, AFTER_DRAIN = false;
  bf16_t* q;
  __device__ __forceinline__ void operator()(const f32x4 (&acc)[2][2][4][2], const pg8::Unit& u, int wr, int wc, int fr, int fq) const {
    const int row0 = u.pm * 256 + wr * 64 + fr;
#pragma unroll
    for (int ai = 0; ai < 2; ++ai)
#pragma unroll
      for (int m = 0; m < 4; ++m)
#pragma unroll
        for (int bj = 0; bj < 2; ++bj) {
          const int c0 = u.pn * 256 + bj * 128 + wc * 32 + 8 * fq;
          const f32x4 v0 = acc[ai][bj][m][0], v1 = acc[ai][bj][m][1];
          u32x4 w;
          w[0] = cvt_pk_bf16(v0[0], v0[1]); w[1] = cvt_pk_bf16(v0[2], v0[3]); w[2] = cvt_pk_bf16(v1[0], v1[1]); w[3] = cvt_pk_bf16(v1[2], v1[3]);
          *(u32x4*)(q + (size_t)(row0 + ai * 128 + m * 16) * 2048 + c0) = w;
        }
  }
};
template <int EPI>
__device__ __forceinline__ void ph_gemm8(const P& p, char* lds_all) {
  PG8_LAS unsigned char* lds = (PG8_LAS unsigned char*)lds_all;
  pg8::Order S;
  if (EPI == 0) {
    S.init(64, 11, gridDim.x, blockIdx.x, 56);
    const pg8::Gemm g{p.hn, p.wt_in, TR, 2816, 1024};
    const EpiIn E{p.pl, p.gates};
    pg8::gemm_phase<EpiIn, pg8::Order>(lds, g, S, E);
  } else if (EPI == 1) {
    S.init(64, 4, gridDim.x, blockIdx.x, 0);
    const pg8::Gemm g{p.mix, p.wt_out, TL, 1024, 1024};
    const EpiOut E{p.x, p.mod, p.out};
    pg8::gemm_phase<EpiOut, pg8::Order>(lds, g, S, E);
  } else {
    S.init(64, 8, gridDim.x, blockIdx.x, 0);
    const pg8::Gemm g{p.hn, p.wt_q, TL, 2048, 1024};
    const EpiQ E{p.qb};
    pg8::gemm_phase<EpiQ, pg8::Order>(lds, g, S, E);
  }
}

template <bool REV>
__device__ __forceinline__ void scan128(const float* lf, const float* ig, float* bout, float* gout, float* pmout, float& Gtot, float& btot, int lane) {
  const int t0 = REV ? 127 - 2 * lane : 2 * lane, t1 = REV ? 126 - 2 * lane : 2 * lane + 1;
  const float v0 = lf[t0], v1 = lf[t1];
  float sacc = v0 + v1;
#pragma unroll
  for (int off = 1; off < 64; off <<= 1) { const float t = __shfl_up(sacc, off); if (lane >= off) sacc += t; }
  const float b1 = sacc, b0 = sacc - v1;
  const float g0 = ig[t0] - b0, g1 = ig[t1] - b1;
  float m = fmaxf(g0, g1);
#pragma unroll
  for (int off = 1; off < 64; off <<= 1) { const float t = __shfl_up(m, off); if (lane >= off) m = fmaxf(m, t); }
  float prev = __shfl_up(m, 1);
  if (lane == 0) prev = -3.0e38f;
  if (bout) { bout[t0] = b0; bout[t1] = b1; }
  gout[t0] = g0; gout[t1] = g1;
  if (pmout) { pmout[t0] = fmaxf(prev, g0); pmout[t1] = m; }
  Gtot = __shfl(m, 63); btot = __shfl(sacc, 63);
}

__device__ __forceinline__ void ph3_chunk_local(const P& p, int bid, int nb, char* smem) {
  bf16_t* Vs = (bf16_t*)smem;
  bf16_t* Ks = Vs + 128 * VLD;
  float* fa = (float*)(Ks + 128 * VLD);
  float *igf = fa, *lff = fa + 128, *igb = fa + 256, *lfb = fa + 384, *ef = fa + 512, *eb = fa + 640, *scal = fa + 768;
  const int tid = threadIdx.x & 255, lane = tid & 63, wave = tid >> 6, lr = lane & 15, lq = lane >> 4;
  const int trips3 = (576 + nb - 1) / nb;
  for (int k3 = 0; k3 < trips3; ++k3) {
    const int u = (bid + k3 * nb) % 576;
    const UnitInfo ui = decode_unit(u);
    const int h = ui.h;
    if (tid < 128) {
      const float* g = p.gates + (size_t)(ui.row0 + tid) * 16;
      igf[tid] = g[h] + p.b_gates[h];
      lff[tid] = logsig_f(g[4 + h] + p.b_gates[4 + h]);
      igb[tid] = g[8 + h] + p.b_gates[8 + h];
      lfb[tid] = logsig_f(g[12 + h] + p.b_gates[12 + h]);
    }
    {
      const int dch = tid & 15, colq = h * 128 + dch * 8, colk = 512 + colq;
#pragma unroll 1
      for (int which = 0; which < 2; ++which) {
        if (which == 1 && ui.isctx) break;
        const int col = which == 0 ? colk : colq;
        float w0[8], w1[8], w2[8], bb[8];
#pragma unroll
        for (int i = 0; i < 8; ++i) { w0[i] = p.conv_w[col + i]; w1[i] = p.conv_w[1024 + col + i]; w2[i] = p.conv_w[2048 + col + i]; bb[i] = p.conv_b[col + i]; }
        const float scl = which == 0 ? 0.08838834764831845f : 1.f;
#pragma unroll 2
        for (int i = 0; i < 8; ++i) {
          const int t = (tid >> 4) + i * 16, tt = ui.c * 128 + t;
          const bf16_t* base = p.pl + (size_t)(ui.row0 + t) * LDP + col;
          const u32x4 z4 = (u32x4){0u, 0u, 0u, 0u};
          const u32x4 r1 = *(const u32x4*)base;
          const u32x4 r0 = tt > 0 ? *(const u32x4*)(base - LDP) : z4;
          const u32x4 r2 = tt + 1 < ui.T ? *(const u32x4*)(base + LDP) : z4;
          float y[8];
#pragma unroll
          for (int q = 0; q < 4; ++q) {
            y[2 * q] = silu_f(bb[2 * q] + blo(r0[q]) * w0[2 * q] + blo(r1[q]) * w1[2 * q] + blo(r2[q]) * w2[2 * q]) * scl;
            y[2 * q + 1] = silu_f(bb[2 * q + 1] + bhi(r0[q]) * w0[2 * q + 1] + bhi(r1[q]) * w1[2 * q + 1] + bhi(r2[q]) * w2[2 * q + 1]) * scl;
          }
          u32x4 o;
#pragma unroll
          for (int q = 0; q < 4; ++q) o[q] = cvt_pk_bf16(y[2 * q], y[2 * q + 1]);
          if (which == 0) *(u32x4*)(Ks + t * VLD + dch * 8) = o;
          if (!ui.isctx) *(u32x4*)(p.hn + (size_t)(ui.row0 + t) * 1024 + col) = o;
        }
      }
#pragma unroll
      for (int i = 0; i < 8; ++i) {
        const int t = (tid >> 4) + i * 16;
        *(u32x4*)(Vs + t * VLD + dch * 8) = *(const u32x4*)(p.pl + (size_t)(ui.row0 + t) * LDP + 1024 + h * 128 + dch * 8);
      }
    }
    __syncthreads();
    if (wave == 0) {
      float G, bt;
      scan128<false>(lff, igf, nullptr, ef, nullptr, G, bt, lane);
      ef[2 * lane] = __expf(ef[2 * lane] - G); ef[2 * lane + 1] = __expf(ef[2 * lane + 1] - G);
      if (lane == 0) { scal[0] = G; scal[1] = bt; }
    } else if (wave == 1) {
      float G, bt;
      scan128<true>(lfb, igb, nullptr, eb, nullptr, G, bt, lane);
      eb[127 - 2 * lane] = __expf(eb[127 - 2 * lane] - G); eb[126 - 2 * lane] = __expf(eb[126 - 2 * lane] - G);
      if (lane == 0) { scal[2] = G; scal[3] = bt; }
    }
    __syncthreads();
#pragma unroll 1
    for (int dir = 0; dir < 2; ++dir) {
      const float* ee = dir ? eb : ef;
      f32x4 acc[2][8];
#pragma unroll
      for (int m = 0; m < 2; ++m)
#pragma unroll
        for (int j = 0; j < 8; ++j) acc[m][j] = (f32x4){0.f, 0.f, 0.f, 0.f};
#pragma unroll
      for (int kk = 0; kk < 4; ++kk) {
        const f32x4 e0 = *(const f32x4*)(ee + kk * 32 + lq * 8), e1 = *(const f32x4*)(ee + kk * 32 + lq * 8 + 4);
        bf16x8 af[2];
#pragma unroll
        for (int m = 0; m < 2; ++m) {
          const bf16x8 raw = frag_tr(Vs, VLD, kk * 32, wave * 32 + m * 16, lr, lq);
          const u32x4 ru = __builtin_bit_cast(u32x4, raw);
          u32x4 sc;
          sc[0] = cvt_pk_bf16(blo(ru[0]) * e0[0], bhi(ru[0]) * e0[1]);
          sc[1] = cvt_pk_bf16(blo(ru[1]) * e0[2], bhi(ru[1]) * e0[3]);
          sc[2] = cvt_pk_bf16(blo(ru[2]) * e1[0], bhi(ru[2]) * e1[1]);
          sc[3] = cvt_pk_bf16(blo(ru[3]) * e1[2], bhi(ru[3]) * e1[3]);
          af[m] = __builtin_bit_cast(bf16x8, sc);
        }
#pragma unroll
        for (int j = 0; j < 8; ++j) {
          const bf16x8 bfr = frag_tr(Ks, VLD, kk * 32, j * 16, lr, lq);
#pragma unroll
          for (int m = 0; m < 2; ++m) acc[m][j] = __builtin_amdgcn_mfma_f32_16x16x32_bf16(af[m], bfr, acc[m][j], 0, 0, 0);
        }
      }
      bf16_t* Dd = p.Dst + (size_t)(u * 2 + dir) * 16384;
#pragma unroll
      for (int m = 0; m < 2; ++m)
#pragma unroll
        for (int j = 0; j < 8; ++j)
#pragma unroll
          for (int e = 0; e < 4; ++e) Dd[(wave * 32 + m * 16 + lq * 4 + e) * 128 + j * 16 + lr] = f2bf(acc[m][j][e]);
    }
    {
      const int dir = tid >> 7, k = tid & 127;
      const float* e = dir ? eb : ef;
      float sacc = 0.f;
      for (int t = 0; t < 128; ++t) sacc += e[t] * bf2f(Ks[t * VLD + k]);
      p.ND[(size_t)(u * 2 + dir) * 128 + k] = sacc;
    }
    if (tid < 4) p.SC[(size_t)(u * 2 + (tid >> 1)) * 32 + (tid & 1)] = scal[tid];
    __syncthreads();
  }
}

__device__ __forceinline__ void ph4_scan(const P& p, int bid, int nb) {
  const int tid = threadIdx.x & 255;
  for (int it = bid; it < 1024; it += nb) {
    const int combo = it >> 4, vblk = it & 15;
    const int b = combo >> 3, h = (combo >> 1) & 3, dir = combo & 1;
    const int v = vblk * 8 + (tid >> 5), k0 = (tid & 31) * 4;
    float C0 = 0.f, C1 = 0.f, C2 = 0.f, C3 = 0.f, nacc = 0.f, m = 0.f;
    for (int i = 0; i < 18; ++i) {
      int u;
      if (i < 2) { const int cc = dir == 0 ? i : 1 - i; u = 512 + b * 8 + cc * 4 + h; }
      else {
        const int lc = i - 2, c = dir == 0 ? lc : 15 - lc;
        u = b * 64 + c * 4 + h;
        const size_t ci = (size_t)u * 2 + dir;
        uint2 o;
        o.x = (unsigned)f2bf(C0) | ((unsigned)f2bf(C1) << 16);
        o.y = (unsigned)f2bf(C2) | ((unsigned)f2bf(C3) << 16);
        *(uint2*)(p.CIN + ci * 16384 + v * 128 + k0) = o;
        if (vblk == 0 && tid < 128) p.NIN[ci * 128 + tid] = nacc;
        if (vblk == 0 && tid == 0) p.MIN_[ci * 32] = m;
      }
      const size_t di = (size_t)u * 2 + dir;
      const float G = p.SC[di * 32 + 0], bend = p.SC[di * 32 + 1];
      const float Mx = fmaxf(m, G);
      const float dec = __expf(m - Mx), inj = __expf(G - Mx);
      const uint2 d2 = *(const uint2*)(p.Dst + di * 16384 + v * 128 + k0);
      C0 = dec * C0 + inj * __uint_as_float(d2.x << 16);
      C1 = dec * C1 + inj * __uint_as_float(d2.x & 0xffff0000u);
      C2 = dec * C2 + inj * __uint_as_float(d2.y << 16);
      C3 = dec * C3 + inj * __uint_as_float(d2.y & 0xffff0000u);
      if (vblk == 0 && tid < 128) nacc = dec * nacc + inj * p.ND[di * 128 + tid];
      m = bend + Mx;
    }
  }
}

__device__ __forceinline__ void ph5_mlstm_out(const P& p, int bid, int nb, char* smem) {
  bf16_t* Vs = (bf16_t*)smem;
  bf16_t* Pw = Vs + 128 * VLD;
  float* fa = (float*)(Pw + 4 * 16 * VLD);
  float *igf = fa, *lff = fa + 128, *igb = fa + 256, *lfb = fa + 384, *gf = fa + 512, *gb = fa + 640, *bfw = fa + 768, *bbw = fa + 896,
        *pmf = fa + 1024, *pmb = fa + 1152, *nq = fa + 1280  ;
  const int tid = threadIdx.x & 255, lane = tid & 63, wave = tid >> 6, lr = lane & 15, lq = lane >> 4;
  const int trips5 = (1536 + nb - 1) / nb;
  for (int k5 = 0; k5 < trips5; ++k5) {
    const int it = (bid + k5 * nb) % 1536;
    if (it < 512) {
      const int u = it;
      const UnitInfo ui = decode_unit(u);
      const int h = ui.h;
      const size_t cif = (size_t)u * 2, cib = (size_t)u * 2 + 1;
      if (tid < 128) {
        const float* g = p.gates + (size_t)(ui.row0 + tid) * 16;
        igf[tid] = g[h] + p.b_gates[h];
        lff[tid] = logsig_f(g[4 + h] + p.b_gates[4 + h]);
        igb[tid] = g[8 + h] + p.b_gates[8 + h];
        lfb[tid] = logsig_f(g[12 + h] + p.b_gates[12 + h]);
      }
      {
        const int dch = tid & 15;
#pragma unroll
        for (int i = 0; i < 8; ++i) {
          const int t = (tid >> 4) + i * 16;
          *(u32x4*)(Vs + t * VLD + dch * 8) = *(const u32x4*)(p.pl + (size_t)(ui.row0 + t) * LDP + 1024 + h * 128 + dch * 8);
        }
      }
      {
        const int dir = tid >> 7, t = tid & 127;
        const u32x4* qr = (const u32x4*)(p.hn + (size_t)(ui.row0 + t) * 1024 + h * 128);
        const float* nin = p.NIN + (dir ? cib : cif) * 128;
        float sacc = 0.f;
#pragma unroll 4
        for (int c8 = 0; c8 < 16; ++c8) {
          const u32x4 qv = qr[c8];
#pragma unroll
          for (int q = 0; q < 4; ++q) sacc += blo(qv[q]) * nin[c8 * 8 + 2 * q] + bhi(qv[q]) * nin[c8 * 8 + 2 * q + 1];
        }
        nq[dir * 128 + t] = sacc;
      }
      __syncthreads();
      if (wave == 0) { float G, bt; scan128<false>(lff, igf, bfw, gf, pmf, G, bt, lane); }
      else if (wave == 1) { float G, bt; scan128<true>(lfb, igb, bbw, gb, pmb, G, bt, lane); }
      __syncthreads();
      const float minf_ = p.MIN_[cif * 32], minb_ = p.MIN_[cib * 32];
      bf16_t* Pme = Pw + wave * 16 * VLD;
      const __amdgpu_buffer_rsrc_t r_hn = mk_rsrc(p.hn), r_cin = mk_rsrc(p.CIN);
      const int fvoff = (lr * 1024 + lq * 8) * 2, cvoff = (lr * 128 + lq * 8) * 2;
#pragma unroll 1
      for (int m = 0; m < 2; ++m) {
        const int t0 = wave * 32 + m * 16;
        bf16x8 Qf[4];
#pragma unroll
        for (int kk = 0; kk < 4; ++kk) Qf[kk] = bload8(r_hn, fvoff + kk * 64, ((ui.row0 + t0) * 1024 + h * 128) * 2);
        f32x4 S[8];
#pragma unroll
        for (int j = 0; j < 8; ++j) {
          S[j] = (f32x4){0.f, 0.f, 0.f, 0.f};
#pragma unroll
          for (int kk = 0; kk < 4; ++kk) {
            const bf16x8 kf = bload8(r_hn, fvoff + kk * 64, ((ui.row0 + j * 16) * 1024 + 512 + h * 128) * 2);
            S[j] = __builtin_amdgcn_mfma_f32_16x16x32_bf16(Qf[kk], kf, S[j], 0, 0, 0);
          }
          if (j & 1) __builtin_amdgcn_sched_barrier(0);
        }
        f32x4 hsum[8];
#pragma unroll 1
        for (int dir = 0; dir < 2; ++dir) {
          const float mi = dir ? minb_ : minf_;
          const float* gg = dir ? gb : gf;
          const float* pmx = dir ? pmb : pmf;
          const float* bw = dir ? bbw : bfw;
          float Mrow[4], wi[4];
#pragma unroll
          for (int e = 0; e < 4; ++e) { Mrow[e] = fmaxf(mi, pmx[t0 + lq * 4 + e]); wi[e] = __expf(mi - Mrow[e]); }
          f32x4 acc[8];
#pragma unroll
          for (int jv = 0; jv < 8; ++jv) {
            acc[jv] = (f32x4){0.f, 0.f, 0.f, 0.f};
#pragma unroll
            for (int kk = 0; kk < 4; ++kk) {
              const bf16x8 cf = bload8(r_cin, cvoff + kk * 64, (int)((dir ? cib : cif) * 32768) + jv * 4096);
              acc[jv] = __builtin_amdgcn_mfma_f32_16x16x32_bf16(Qf[kk], cf, acc[jv], 0, 0, 0);
            }
#pragma unroll
            for (int e = 0; e < 4; ++e) acc[jv][e] *= wi[e];
            if (jv & 1) __builtin_amdgcn_sched_barrier(0);
          }
          float rs[4] = {0.f, 0.f, 0.f, 0.f};
#pragma unroll
          for (int j = 0; j < 8; ++j) {
            const int sidx = j * 16 + lr;
            const float gs = gg[sidx];
#pragma unroll
            for (int e = 0; e < 4; ++e) {
              const int t = t0 + lq * 4 + e;
              const bool keep = dir ? (sidx >= t) : (sidx <= t);
              const float pv = keep ? S[j][e] * __expf(gs - Mrow[e]) : 0.f;
              rs[e] += pv;
              Pme[(lq * 4 + e) * VLD + sidx] = f2bf(pv);
            }
          }
          float den[4];
#pragma unroll
          for (int e = 0; e < 4; ++e) {
            float r = rs[e];
            r += __shfl_xor(r, 1); r += __shfl_xor(r, 2); r += __shfl_xor(r, 4); r += __shfl_xor(r, 8);
            const int t = t0 + lq * 4 + e;
            const float dd = r + wi[e] * nq[dir * 128 + t];
            den[e] = fmaxf(fabsf(dd), __expf(-(bw[t] + Mrow[e])));
          }
          __builtin_amdgcn_fence(__ATOMIC_RELEASE, "wavefront");
          __builtin_amdgcn_wave_barrier();
#pragma unroll
          for (int kk = 0; kk < 4; ++kk) {
            const bf16x8 pf = *(const bf16x8*)(Pme + lr * VLD + kk * 32 + lq * 8);
#pragma unroll
            for (int jv = 0; jv < 8; ++jv) {
              const bf16x8 vf = frag_tr(Vs, VLD, kk * 32, jv * 16, lr, lq);
              acc[jv] = __builtin_amdgcn_mfma_f32_16x16x32_bf16(pf, vf, acc[jv], 0, 0, 0);
            }
          }
          __builtin_amdgcn_wave_barrier();
#pragma unroll
          for (int jv = 0; jv < 8; ++jv)
#pragma unroll
            for (int e = 0; e < 4; ++e) {
              const float hv = acc[jv][e] / den[e];
              if (dir == 0) hsum[jv][e] = hv; else hsum[jv][e] += hv;
            }
        }
#pragma unroll
        for (int e = 0; e < 4; ++e) {
          float sm = 0.f;
#pragma unroll
          for (int jv = 0; jv < 8; ++jv) sm += hsum[jv][e];
          sm += __shfl_xor(sm, 1); sm += __shfl_xor(sm, 2); sm += __shfl_xor(sm, 4); sm += __shfl_xor(sm, 8);
          const float mu = sm * (1.f / 128.f);
          float vs = 0.f;
#pragma unroll
          for (int jv = 0; jv < 8; ++jv) { const float d = hsum[jv][e] - mu; vs += d * d; }
          vs += __shfl_xor(vs, 1); vs += __shfl_xor(vs, 2); vs += __shfl_xor(vs, 4); vs += __shfl_xor(vs, 8);
          const float rstd = rsqrtf(vs * (1.f / 128.f) + 1e-6f);
          const bf16_t* op = p.pl + (size_t)(ui.row0 + t0 + lq * 4 + e) * LDP + 1536 + h * 128;
          bf16_t* mp = p.mix + (size_t)(ui.row0 + t0 + lq * 4 + e) * 1024 + h * 128;
#pragma unroll
          for (int jv = 0; jv < 8; ++jv) {
            const int v = jv * 16 + lr;
            const float o = bf2f(op[v]);
            mp[v] = f2bf((hsum[jv][e] - mu) * rstd * p.head_norm_w[h * 128 + v] / (1.f + __expf(-o)));
          }
        }
      }
      __syncthreads();
    } else {
      const int pu = it - 512, grp = pu >> 2, g = pu & 3;
      float* us = (float*)smem;
      bf16_t* db = (bf16_t*)(us + 8192);
      const int w = 2 << g;
      const size_t rbase = (size_t)grp * 64;
      for (int idx = tid; idx < 1024; idx += NTHR) {
        const int t = idx >> 4, ch = idx & 15;
        const u32x4 r = *(const u32x4*)(p.pl + (rbase + t) * LDP + 2048 + g * 128 + ch * 8);
        float* d = us + t * 128 + ch * 8;
#pragma unroll
        for (int q = 0; q < 4; ++q) { d[2 * q] = blo(r[q]); d[2 * q + 1] = bhi(r[q]); }
      }
      __syncthreads();
      for (int idx = tid; idx < 8192; idx += NTHR) {
        const int t = idx >> 7, i = idx & 127;
        int lo = t - w / 2, hi = t - w / 2 + w;
        lo = lo < 0 ? 0 : lo; hi = hi > 64 ? 64 : hi;
        float sacc = 0.f;
        for (int j = lo; j < hi; ++j) sacc += us[j * 128 + i];
        db[t * VLD + i] = f2bf(sacc / (float)(hi - lo) - us[idx]);
      }
      __syncthreads();
      {
        const bf16_t* wt = (const bf16_t*)((const char*)p.keys_bf + 524288) + g * 16384;
        bf16x8 af[4];
#pragma unroll
        for (int kk = 0; kk < 4; ++kk) af[kk] = *(const bf16x8*)(db + (wave * 16 + lr) * VLD + kk * 32 + lq * 8);
#pragma unroll
        for (int j = 0; j < 8; ++j) {
          f32x4 acc = (f32x4){0.f, 0.f, 0.f, 0.f};
#pragma unroll
          for (int kk = 0; kk < 4; ++kk) {
            const bf16x8 bfr = *(const bf16x8*)(wt + (j * 16 + lr) * 128 + kk * 32 + lq * 8);
            acc = __builtin_amdgcn_mfma_f32_16x16x32_bf16(af[kk], bfr, acc, 0, 0, 0);
          }
          const float ps = p.pool_scale[g * 128 + j * 16 + lr];
#pragma unroll
          for (int e = 0; e < 4; ++e) p.mix[(rbase + wave * 16 + lq * 4 + e) * 1024 + 512 + g * 128 + j * 16 + lr] = f2bf(acc[e] * ps);
        }
      }
      __syncthreads();
    }
  }
}

#define SORT16(X) do { unsigned h_, l_; h_ = X[0] > X[1] ? X[0] : X[1]; l_ = X[0] > X[1] ? X[1] : X[0]; X[0] = h_; X[1] = l_; h_ = X[3] > X[2] ? X[3] : X[2]; l_ = X[3] > X[2] ? X[2] : X[3]; X[3] = h_; X[2] = l_; h_ = X[4] > X[5] ? X[4] : X[5]; l_ = X[4] > X[5] ? X[5] : X[4]; X[4] = h_; X[5] = l_; h_ = X[7] > X[6] ? X[7] : X[6]; l_ = X[7] > X[6] ? X[6] : X[7]; X[7] = h_; X[6] = l_; h_ = X[8] > X[9] ? X[8] : X[9]; l_ = X[8] > X[9] ? X[9] : X[8]; X[8] = h_; X[9] = l_; h_ = X[11] > X[10] ? X[11] : X[10]; l_ = X[11] > X[10] ? X[10] : X[11]; X[11] = h_; X[10] = l_; h_ = X[12] > X[13] ? X[12] : X[13]; l_ = X[12] > X[13] ? X[13] : X[12]; X[12] = h_; X[13] = l_; h_ = X[15] > X[14] ? X[15] : X[14]; l_ = X[15] > X[14] ? X[14] : X[15]; X[15] = h_; X[14] = l_; h_ = X[0] > X[2] ? X[0] : X[2]; l_ = X[0] > X[2] ? X[2] : X[0]; X[0] = h_; X[2] = l_; h_ = X[1] > X[3] ? X[1] : X[3]; l_ = X[1] > X[3] ? X[3] : X[1]; X[1] = h_; X[3] = l_; h_ = X[6] > X[4] ? X[6] : X[4]; l_ = X[6] > X[4] ? X[4] : X[6]; X[6] = h_; X[4] = l_; h_ = X[7] > X[5] ? X[7] : X[5]; l_ = X[7] > X[5] ? X[5] : X[7]; X[7] = h_; X[5] = l_; h_ = X[8] > X[10] ? X[8] : X[10]; l_ = X[8] > X[10] ? X[10] : X[8]; X[8] = h_; X[10] = l_; h_ = X[9] > X[11] ? X[9] : X[11]; l_ = X[9] > X[11] ? X[11] : X[9]; X[9] = h_; X[11] = l_; h_ = X[14] > X[12] ? X[14] : X[12]; l_ = X[14] > X[12] ? X[12] : X[14]; X[14] = h_; X[12] = l_; h_ = X[15] > X[13] ? X[15] : X[13]; l_ = X[15] > X[13] ? X[13] : X[15]; X[15] = h_; X[13] = l_; h_ = X[0] > X[1] ? X[0] : X[1]; l_ = X[0] > X[1] ? X[1] : X[0]; X[0] = h_; X[1] = l_; h_ = X[2] > X[3] ? X[2] : X[3]; l_ = X[2] > X[3] ? X[3] : X[2]; X[2] = h_; X[3] = l_; h_ = X[5] > X[4] ? X[5] : X[4]; l_ = X[5] > X[4] ? X[4] : X[5]; X[5] = h_; X[4] = l_; h_ = X[7] > X[6] ? X[7] : X[6]; l_ = X[7] > X[6] ? X[6] : X[7]; X[7] = h_; X[6] = l_; h_ = X[8] > X[9] ? X[8] : X[9]; l_ = X[8] > X[9] ? X[9] : X[8]; X[8] = h_; X[9] = l_; h_ = X[10] > X[11] ? X[10] : X[11]; l_ = X[10] > X[11] ? X[11] : X[10]; X[10] = h_; X[11] = l_; h_ = X[13] > X[12] ? X[13] : X[12]; l_ = X[13] > X[12] ? X[12] : X[13]; X[13] = h_; X[12] = l_; h_ = X[15] > X[14] ? X[15] : X[14]; l_ = X[15] > X[14] ? X[14] : X[15]; X[15] = h_; X[14] = l_; h_ = X[0] > X[4] ? X[0] : X[4]; l_ = X[0] > X[4] ? X[4] : X[0]; X[0] = h_; X[4] = l_; h_ = X[1] > X[5] ? X[1] : X[5]; l_ = X[1] > X[5] ? X[5] : X[1]; X[1] = h_; X[5] = l_; h_ = X[2] > X[6] ? X[2] : X[6]; l_ = X[2] > X[6] ? X[6] : X[2]; X[2] = h_; X[6] = l_; h_ = X[3] > X[7] ? X[3] : X[7]; l_ = X[3] > X[7] ? X[7] : X[3]; X[3] = h_; X[7] = l_; h_ = X[12] > X[8] ? X[12] : X[8]; l_ = X[12] > X[8] ? X[8] : X[12]; X[12] = h_; X[8] = l_; h_ = X[13] > X[9] ? X[13] : X[9]; l_ = X[13] > X[9] ? X[9] : X[13]; X[13] = h_; X[9] = l_; h_ = X[14] > X[10] ? X[14] : X[10]; l_ = X[14] > X[10] ? X[10] : X[14]; X[14] = h_; X[10] = l_; h_ = X[15] > X[11] ? X[15] : X[11]; l_ = X[15] > X[11] ? X[11] : X[15]; X[15] = h_; X[11] = l_; h_ = X[0] > X[2] ? X[0] : X[2]; l_ = X[0] > X[2] ? X[2] : X[0]; X[0] = h_; X[2] = l_; h_ = X[1] > X[3] ? X[1] : X[3]; l_ = X[1] > X[3] ? X[3] : X[1]; X[1] = h_; X[3] = l_; h_ = X[4] > X[6] ? X[4] : X[6]; l_ = X[4] > X[6] ? X[6] : X[4]; X[4] = h_; X[6] = l_; h_ = X[5] > X[7] ? X[5] : X[7]; l_ = X[5] > X[7] ? X[7] : X[5]; X[5] = h_; X[7] = l_; h_ = X[10] > X[8] ? X[10] : X[8]; l_ = X[10] > X[8] ? X[8] : X[10]; X[10] = h_; X[8] = l_; h_ = X[11] > X[9] ? X[11] : X[9]; l_ = X[11] > X[9] ? X[9] : X[11]; X[11] = h_; X[9] = l_; h_ = X[14] > X[12] ? X[14] : X[12]; l_ = X[14] > X[12] ? X[12] : X[14]; X[14] = h_; X[12] = l_; h_ = X[15] > X[13] ? X[15] : X[13]; l_ = X[15] > X[13] ? X[13] : X[15]; X[15] = h_; X[13] = l_; h_ = X[0] > X[1] ? X[0] : X[1]; l_ = X[0] > X[1] ? X[1] : X[0]; X[0] = h_; X[1] = l_; h_ = X[2] > X[3] ? X[2] : X[3]; l_ = X[2] > X[3] ? X[3] : X[2]; X[2] = h_; X[3] = l_; h_ = X[4] > X[5] ? X[4] : X[5]; l_ = X[4] > X[5] ? X[5] : X[4]; X[4] = h_; X[5] = l_; h_ = X[6] > X[7] ? X[6] : X[7]; l_ = X[6] > X[7] ? X[7] : X[6]; X[6] = h_; X[7] = l_; h_ = X[9] > X[8] ? X[9] : X[8]; l_ = X[9] > X[8] ? X[8] : X[9]; X[9] = h_; X[8] = l_; h_ = X[11] > X[10] ? X[11] : X[10]; l_ = X[11] > X[10] ? X[10] : X[11]; X[11] = h_; X[10] = l_; h_ = X[13] > X[12] ? X[13] : X[12]; l_ = X[13] > X[12] ? X[12] : X[13]; X[13] = h_; X[12] = l_; h_ = X[15] > X[14] ? X[15] : X[14]; l_ = X[15] > X[14] ? X[14] : X[15]; X[15] = h_; X[14] = l_; h_ = X[0] > X[8] ? X[0] : X[8]; l_ = X[0] > X[8] ? X[8] : X[0]; X[0] = h_; X[8] = l_; h_ = X[1] > X[9] ? X[1] : X[9]; l_ = X[1] > X[9] ? X[9] : X[1]; X[1] = h_; X[9] = l_; h_ = X[2] > X[10] ? X[2] : X[10]; l_ = X[2] > X[10] ? X[10] : X[2]; X[2] = h_; X[10] = l_; h_ = X[3] > X[11] ? X[3] : X[11]; l_ = X[3] > X[11] ? X[11] : X[3]; X[3] = h_; X[11] = l_; h_ = X[4] > X[12] ? X[4] : X[12]; l_ = X[4] > X[12] ? X[12] : X[4]; X[4] = h_; X[12] = l_; h_ = X[5] > X[13] ? X[5] : X[13]; l_ = X[5] > X[13] ? X[13] : X[5]; X[5] = h_; X[13] = l_; h_ = X[6] > X[14] ? X[6] : X[14]; l_ = X[6] > X[14] ? X[14] : X[6]; X[6] = h_; X[14] = l_; h_ = X[7] > X[15] ? X[7] : X[15]; l_ = X[7] > X[15] ? X[15] : X[7]; X[7] = h_; X[15] = l_; h_ = X[0] > X[4] ? X[0] : X[4]; l_ = X[0] > X[4] ? X[4] : X[0]; X[0] = h_; X[4] = l_; h_ = X[1] > X[5] ? X[1] : X[5]; l_ = X[1] > X[5] ? X[5] : X[1]; X[1] = h_; X[5] = l_; h_ = X[2] > X[6] ? X[2] : X[6]; l_ = X[2] > X[6] ? X[6] : X[2]; X[2] = h_; X[6] = l_; h_ = X[3] > X[7] ? X[3] : X[7]; l_ = X[3] > X[7] ? X[7] : X[3]; X[3] = h_; X[7] = l_; h_ = X[8] > X[12] ? X[8] : X[12]; l_ = X[8] > X[12] ? X[12] : X[8]; X[8] = h_; X[12] = l_; h_ = X[9] > X[13] ? X[9] : X[13]; l_ = X[9] > X[13] ? X[13] : X[9]; X[9] = h_; X[13] = l_; h_ = X[10] > X[14] ? X[10] : X[14]; l_ = X[10] > X[14] ? X[14] : X[10]; X[10] = h_; X[14] = l_; h_ = X[11] > X[15] ? X[11] : X[15]; l_ = X[11] > X[15] ? X[15] : X[11]; X[11] = h_; X[15] = l_; h_ = X[0] > X[2] ? X[0] : X[2]; l_ = X[0] > X[2] ? X[2] : X[0]; X[0] = h_; X[2] = l_; h_ = X[1] > X[3] ? X[1] : X[3]; l_ = X[1] > X[3] ? X[3] : X[1]; X[1] = h_; X[3] = l_; h_ = X[4] > X[6] ? X[4] : X[6]; l_ = X[4] > X[6] ? X[6] : X[4]; X[4] = h_; X[6] = l_; h_ = X[5] > X[7] ? X[5] : X[7]; l_ = X[5] > X[7] ? X[7] : X[5]; X[5] = h_; X[7] = l_; h_ = X[8] > X[10] ? X[8] : X[10]; l_ = X[8] > X[10] ? X[10] : X[8]; X[8] = h_; X[10] = l_; h_ = X[9] > X[11] ? X[9] : X[11]; l_ = X[9] > X[11] ? X[11] : X[9]; X[9] = h_; X[11] = l_; h_ = X[12] > X[14] ? X[12] : X[14]; l_ = X[12] > X[14] ? X[14] : X[12]; X[12] = h_; X[14] = l_; h_ = X[13] > X[15] ? X[13] : X[15]; l_ = X[13] > X[15] ? X[15] : X[13]; X[13] = h_; X[15] = l_; h_ = X[0] > X[1] ? X[0] : X[1]; l_ = X[0] > X[1] ? X[1] : X[0]; X[0] = h_; X[1] = l_; h_ = X[2] > X[3] ? X[2] : X[3]; l_ = X[2] > X[3] ? X[3] : X[2]; X[2] = h_; X[3] = l_; h_ = X[4] > X[5] ? X[4] : X[5]; l_ = X[4] > X[5] ? X[5] : X[4]; X[4] = h_; X[5] = l_; h_ = X[6] > X[7] ? X[6] : X[7]; l_ = X[6] > X[7] ? X[7] : X[6]; X[6] = h_; X[7] = l_; h_ = X[8] > X[9] ? X[8] : X[9]; l_ = X[8] > X[9] ? X[9] : X[8]; X[8] = h_; X[9] = l_; h_ = X[10] > X[11] ? X[10] : X[11]; l_ = X[10] > X[11] ? X[11] : X[10]; X[10] = h_; X[11] = l_; h_ = X[12] > X[13] ? X[12] : X[13]; l_ = X[12] > X[13] ? X[13] : X[12]; X[12] = h_; X[13] = l_; h_ = X[14] > X[15] ? X[14] : X[15]; l_ = X[14] > X[15] ? X[15] : X[14]; X[14] = h_; X[15] = l_; } while (0)
#define MERGE16(X) do { unsigned h_, l_; h_ = X[0] > X[8] ? X[0] : X[8]; l_ = X[0] > X[8] ? X[8] : X[0]; X[0] = h_; X[8] = l_; h_ = X[1] > X[9] ? X[1] : X[9]; l_ = X[1] > X[9] ? X[9] : X[1]; X[1] = h_; X[9] = l_; h_ = X[2] > X[10] ? X[2] : X[10]; l_ = X[2] > X[10] ? X[10] : X[2]; X[2] = h_; X[10] = l_; h_ = X[3] > X[11] ? X[3] : X[11]; l_ = X[3] > X[11] ? X[11] : X[3]; X[3] = h_; X[11] = l_; h_ = X[4] > X[12] ? X[4] : X[12]; l_ = X[4] > X[12] ? X[12] : X[4]; X[4] = h_; X[12] = l_; h_ = X[5] > X[13] ? X[5] : X[13]; l_ = X[5] > X[13] ? X[13] : X[5]; X[5] = h_; X[13] = l_; h_ = X[6] > X[14] ? X[6] : X[14]; l_ = X[6] > X[14] ? X[14] : X[6]; X[6] = h_; X[14] = l_; h_ = X[7] > X[15] ? X[7] : X[15]; l_ = X[7] > X[15] ? X[15] : X[7]; X[7] = h_; X[15] = l_; h_ = X[0] > X[4] ? X[0] : X[4]; l_ = X[0] > X[4] ? X[4] : X[0]; X[0] = h_; X[4] = l_; h_ = X[1] > X[5] ? X[1] : X[5]; l_ = X[1] > X[5] ? X[5] : X[1]; X[1] = h_; X[5] = l_; h_ = X[2] > X[6] ? X[2] : X[6]; l_ = X[2] > X[6] ? X[6] : X[2]; X[2] = h_; X[6] = l_; h_ = X[3] > X[7] ? X[3] : X[7]; l_ = X[3] > X[7] ? X[7] : X[3]; X[3] = h_; X[7] = l_; h_ = X[8] > X[12] ? X[8] : X[12]; l_ = X[8] > X[12] ? X[12] : X[8]; X[8] = h_; X[12] = l_; h_ = X[9] > X[13] ? X[9] : X[13]; l_ = X[9] > X[13] ? X[13] : X[9]; X[9] = h_; X[13] = l_; h_ = X[10] > X[14] ? X[10] : X[14]; l_ = X[10] > X[14] ? X[14] : X[10]; X[10] = h_; X[14] = l_; h_ = X[11] > X[15] ? X[11] : X[15]; l_ = X[11] > X[15] ? X[15] : X[11]; X[11] = h_; X[15] = l_; h_ = X[0] > X[2] ? X[0] : X[2]; l_ = X[0] > X[2] ? X[2] : X[0]; X[0] = h_; X[2] = l_; h_ = X[1] > X[3] ? X[1] : X[3]; l_ = X[1] > X[3] ? X[3] : X[1]; X[1] = h_; X[3] = l_; h_ = X[4] > X[6] ? X[4] : X[6]; l_ = X[4] > X[6] ? X[6] : X[4]; X[4] = h_; X[6] = l_; h_ = X[5] > X[7] ? X[5] : X[7]; l_ = X[5] > X[7] ? X[7] : X[5]; X[5] = h_; X[7] = l_; h_ = X[8] > X[10] ? X[8] : X[10]; l_ = X[8] > X[10] ? X[10] : X[8]; X[8] = h_; X[10] = l_; h_ = X[9] > X[11] ? X[9] : X[11]; l_ = X[9] > X[11] ? X[11] : X[9]; X[9] = h_; X[11] = l_; h_ = X[12] > X[14] ? X[12] : X[14]; l_ = X[12] > X[14] ? X[14] : X[12]; X[12] = h_; X[14] = l_; h_ = X[13] > X[15] ? X[13] : X[15]; l_ = X[13] > X[15] ? X[15] : X[13]; X[13] = h_; X[15] = l_; h_ = X[0] > X[1] ? X[0] : X[1]; l_ = X[0] > X[1] ? X[1] : X[0]; X[0] = h_; X[1] = l_; h_ = X[2] > X[3] ? X[2] : X[3]; l_ = X[2] > X[3] ? X[3] : X[2]; X[2] = h_; X[3] = l_; h_ = X[4] > X[5] ? X[4] : X[5]; l_ = X[4] > X[5] ? X[5] : X[4]; X[4] = h_; X[5] = l_; h_ = X[6] > X[7] ? X[6] : X[7]; l_ = X[6] > X[7] ? X[7] : X[6]; X[6] = h_; X[7] = l_; h_ = X[8] > X[9] ? X[8] : X[9]; l_ = X[8] > X[9] ? X[9] : X[8]; X[8] = h_; X[9] = l_; h_ = X[10] > X[11] ? X[10] : X[11]; l_ = X[10] > X[11] ? X[11] : X[10]; X[10] = h_; X[11] = l_; h_ = X[12] > X[13] ? X[12] : X[13]; l_ = X[12] > X[13] ? X[13] : X[12]; X[12] = h_; X[13] = l_; h_ = X[14] > X[15] ? X[14] : X[15]; l_ = X[14] > X[15] ? X[15] : X[14]; X[14] = h_; X[15] = l_; } while (0)

__device__ __forceinline__ unsigned f2ord(float f) { const unsigned u = __float_as_uint(f); return (u & 0x80000000u) ? ~u : (u | 0x80000000u); }
__device__ __forceinline__ float ord2f(unsigned o) { return __uint_as_float((o & 0x80000000u) ? (o & 0x7fffffffu) : ~o); }
#define CANDKEY(sum, c) ((f2ord(sum) & ~255u) | (255u - (unsigned)(c)))
__device__ __forceinline__ void xmerge16(unsigned (&X)[16], int mask) {
  unsigned T[16];
#pragma unroll
  for (int i = 0; i < 16; ++i) T[i] = (unsigned)__shfl_xor((int)X[15 - i], mask);
#pragma unroll
  for (int i = 0; i < 16; ++i) X[i] = X[i] > T[i] ? X[i] : T[i];
  MERGE16(X);
}

__device__ __forceinline__ void ph9_topk(const P& p, int bid, int nb, char* smem) {
  const int tid = threadIdx.x & 255, lane = tid & 63, wave = tid >> 6, lr = lane & 15, lq = lane >> 4;
  int* idxs = (int*)smem + wave * 512;
  const int gw = bid * 4 + wave, ngw = nb * 4;
  const __amdgpu_buffer_rsrc_t r_q = mk_rsrc(p.qb), r_k = mk_rsrc(p.keys_bf);
  for (int it = gw; it < 1024 * 8; it += ngw) {
    const int h = it & 7, tile = it >> 3;
    const int tok = tile * 16 + lr;
    unsigned R0[16], R1[16];
#pragma unroll
    for (int pp = 0; pp < 2; ++pp) {
      bf16x8 bq[4];
#pragma unroll
      for (int kk = 0; kk < 4; ++kk) bq[kk] = bload8(r_q, (lr * 2048 + lq * 8) * 2 + kk * 64, (tile * 16 * 2048 + h * 256 + pp * 128) * 2);
      f32x4 acc[8];
#pragma unroll
      for (int j = 0; j < 8; ++j) acc[j] = (f32x4){0.f, 0.f, 0.f, 0.f};
#pragma unroll
      for (int j = 0; j < 8; ++j)
#pragma unroll
        for (int kk = 0; kk < 4; ++kk) {
          const bf16x8 a = bload8(r_k, (lr * 128 + lq * 8) * 2 + kk * 64, ((h * 2 + pp) * 16384 + j * 2048) * 2);
          acc[j] = __builtin_amdgcn_mfma_f32_16x16x32_bf16(a, bq[kk], acc[j], 0, 0, 0);
        }
      unsigned X[16], Y[16];
#pragma unroll
      for (int j = 0; j < 4; ++j)
#pragma unroll
        for (int e = 0; e < 4; ++e) {
          X[j * 4 + e] = (f2ord(acc[j][e]) & ~127u) | (127u - (unsigned)(j * 16 + lq * 4 + e));
          Y[j * 4 + e] = (f2ord(acc[4 + j][e]) & ~127u) | (127u - (unsigned)((4 + j) * 16 + lq * 4 + e));
        }
      SORT16(X);
      SORT16(Y);
#pragma unroll
      for (int i = 0; i < 16; ++i) X[i] = X[i] > Y[15 - i] ? X[i] : Y[15 - i];
      MERGE16(X);
      xmerge16(X, 16);
      xmerge16(X, 32);
#pragma unroll
      for (int i = 0; i < 16; ++i) { if (pp == 0) R0[i] = X[i]; else R1[i] = X[i]; }
    }
    if (lq == 0) {
#pragma unroll
      for (int i = 0; i < 16; ++i) { idxs[lr * 32 + i] = 127 - (int)(R0[i] & 127u); idxs[lr * 32 + 16 + i] = 127 - (int)(R1[i] & 127u); }
    }
    float va[16], vb[16];
#pragma unroll
    for (int i = 0; i < 16; ++i) { va[i] = ord2f(R0[i] & ~127u); vb[i] = ord2f(R1[i] & ~127u); }
    unsigned F[16];
  F[0] = lq == 0 ? CANDKEY(va[0] + vb[0], 0) : (lq == 1 ? CANDKEY(va[1] + vb[0], 16) : (lq == 2 ? CANDKEY(va[3] + vb[0], 48) : CANDKEY(va[13] + vb[0], 208)));
  F[1] = lq == 0 ? CANDKEY(va[0] + vb[1], 1) : (lq == 1 ? CANDKEY(va[1] + vb[1], 17) : (lq == 2 ? CANDKEY(va[3] + vb[1], 49) : CANDKEY(va[14] + vb[0], 224)));
  F[2] = lq == 0 ? CANDKEY(va[0] + vb[2], 2) : (lq == 1 ? CANDKEY(va[1] + vb[2], 18) : (lq == 2 ? CANDKEY(va[3] + vb[2], 50) : CANDKEY(va[15] + vb[0], 240)));
  F[3] = lq == 0 ? CANDKEY(va[0] + vb[3], 3) : (lq == 1 ? CANDKEY(va[1] + vb[3], 19) : (lq == 2 ? CANDKEY(va[3] + vb[3], 51) : 0u));
  F[4] = lq == 0 ? CANDKEY(va[0] + vb[4], 4) : (lq == 1 ? CANDKEY(va[1] + vb[4], 20) : (lq == 2 ? CANDKEY(va[4] + vb[0], 64) : 0u));
  F[5] = lq == 0 ? CANDKEY(va[0] + vb[5], 5) : (lq == 1 ? CANDKEY(va[1] + vb[5], 21) : (lq == 2 ? CANDKEY(va[4] + vb[1], 65) : 0u));
  F[6] = lq == 0 ? CANDKEY(va[0] + vb[6], 6) : (lq == 1 ? CANDKEY(va[1] + vb[6], 22) : (lq == 2 ? CANDKEY(va[4] + vb[2], 66) : 0u));
  F[7] = lq == 0 ? CANDKEY(va[0] + vb[7], 7) : (lq == 1 ? CANDKEY(va[1] + vb[7], 23) : (lq == 2 ? CANDKEY(va[6] + vb[0], 96) : 0u));
  F[8] = lq == 0 ? CANDKEY(va[0] + vb[8], 8) : (lq == 1 ? CANDKEY(va[2] + vb[0], 32) : (lq == 2 ? CANDKEY(va[6] + vb[1], 97) : 0u));
  F[9] = lq == 0 ? CANDKEY(va[0] + vb[9], 9) : (lq == 1 ? CANDKEY(va[2] + vb[1], 33) : (lq == 2 ? CANDKEY(va[7] + vb[0], 112) : 0u));
  F[10] = lq == 0 ? CANDKEY(va[0] + vb[10], 10) : (lq == 1 ? CANDKEY(va[2] + vb[2], 34) : (lq == 2 ? CANDKEY(va[7] + vb[1], 113) : 0u));
  F[11] = lq == 0 ? CANDKEY(va[0] + vb[11], 11) : (lq == 1 ? CANDKEY(va[2] + vb[3], 35) : (lq == 2 ? CANDKEY(va[8] + vb[0], 128) : 0u));
  F[12] = lq == 0 ? CANDKEY(va[0] + vb[12], 12) : (lq == 1 ? CANDKEY(va[2] + vb[4], 36) : (lq == 2 ? CANDKEY(va[9] + vb[0], 144) : 0u));
  F[13] = lq == 0 ? CANDKEY(va[0] + vb[13], 13) : (lq == 1 ? CANDKEY(va[5] + vb[0], 80) : (lq == 2 ? CANDKEY(va[10] + vb[0], 160) : 0u));
  F[14] = lq == 0 ? CANDKEY(va[0] + vb[14], 14) : (lq == 1 ? CANDKEY(va[5] + vb[1], 81) : (lq == 2 ? CANDKEY(va[11] + vb[0], 176) : 0u));
  F[15] = lq == 0 ? CANDKEY(va[0] + vb[15], 15) : (lq == 1 ? 0u : (lq == 2 ? CANDKEY(va[12] + vb[0], 192) : 0u));

    SORT16(F);
    xmerge16(F, 16);
    xmerge16(F, 32);
    if (lq == 0) {
      float ev[16];
      const float mx = ord2f(F[0] & ~255u);
      float tot = 0.f;
#pragma unroll
      for (int r = 0; r < 16; ++r) { ev[r] = __expf(ord2f(F[r] & ~255u) - mx); tot += ev[r]; }
      const float inv = 1.f / tot;
      int ei[16];
#pragma unroll
      for (int r = 0; r < 16; ++r) {
        const int c = 255 - (int)(F[r] & 255u);
        ei[r] = idxs[lr * 32 + (c >> 4)] * 128 + idxs[lr * 32 + 16 + (c & 15)];
      }
      int* ep = p.eidx + (size_t)tok * 128 + h * 16;
      float* gp = p.gate + (size_t)tok * 128 + h * 16;
#pragma unroll
      for (int r = 0; r < 4; ++r) {
        *(u32x4*)(ep + r * 4) = (u32x4){(unsigned)ei[r * 4], (unsigned)ei[r * 4 + 1], (unsigned)ei[r * 4 + 2], (unsigned)ei[r * 4 + 3]};
        *(f32x4*)(gp + r * 4) = (f32x4){ev[r * 4] * inv, ev[r * 4 + 1] * inv, ev[r * 4 + 2] * inv, ev[r * 4 + 3] * inv};
      }
    }
  }
}

__device__ __forceinline__ void ph_convert_tables(const P& p, int bid, int nb) {
  const int wave = (threadIdx.x >> 6) & 3, lane = threadIdx.x & 63;
  for (int row = bid * 4 + wave; row < 32768; row += nb * 4) {
    const bool isu = row < 16384;
    const float* src = isu ? p.U + (size_t)row * 1024 : p.V + (size_t)(row - 16384) * 1024;
    unsigned char* dst = isu ? p.U8 + (size_t)row * 1024 : p.V8 + (size_t)(row - 16384) * 1024;
    const float sc = isu ? 512.f : 32.f;
#pragma unroll
    for (int j = 0; j < 4; ++j) {
      const f32x4 v = __builtin_nontemporal_load((const f32x4*)src + j * 64 + lane);
      int w = 0;
      w = __builtin_amdgcn_cvt_pk_fp8_f32(v.x * sc, v.y * sc, w, false);
      w = __builtin_amdgcn_cvt_pk_fp8_f32(v.z * sc, v.w * sc, w, true);
      *(int*)(dst + j * 256 + lane * 4) = w;
    }
  }
}

__device__ __forceinline__ float gelu_exact(float a) { return 0.5f * a * (1.f + erff(a * 0.70710678118654752f)); }

#define G_LOAD(buf, s_) do { const int s__ = (s_); const unsigned char* tab__ = s__ < 16 ? p.U8 : p.V8; const int er__ = (s__ & 8) ? e1 : e0; \
    _Pragma("unroll") for (int k = 0; k < 8; ++k) { const int e__ = __builtin_amdgcn_readlane(er__, (s__ & 7) * 8 + k); \
      buf[k] = *((const u32x4*)(tab__ + (size_t)e__ * 1024) + lane); } } while (0)
#define G_COMPUTE(buf, s_) do { const int s__ = (s_); \
    if (s__ < 16) { \
      float pp[8]; \
      _Pragma("unroll") for (int k = 0; k < 8; ++k) { \
        f32x2 ac = {0.f, 0.f}; \
        _Pragma("unroll") for (int d = 0; d < 4; ++d) { \
          ac = __builtin_amdgcn_cvt_pk_f32_fp8((int)buf[k][d], false) * x2[2 * d] + ac; \
          ac = __builtin_amdgcn_cvt_pk_f32_fp8((int)buf[k][d], true) * x2[2 * d + 1] + ac; } \
        pp[k] = ac.x + ac.y; } \
        \
      float q4[4], r2[2], tt; \
      _Pragma("unroll") for (int i = 0; i < 4; ++i) { const float sd = b5 ? pp[i] : pp[i + 4]; q4[i] = (b5 ? pp[i + 4] : pp[i]) + __shfl_xor(sd, 32); } \
      _Pragma("unroll") for (int i = 0; i < 2; ++i) { const float sd = b4 ? q4[i] : q4[i + 2]; r2[i] = (b4 ? q4[i + 2] : q4[i]) + __shfl_xor(sd, 16); } \
      { const float sd = b3 ? r2[0] : r2[1]; tt = (b3 ? r2[1] : r2[0]) + __shfl_xor(sd, 8); } \
      tt += __shfl_xor(tt, 4); tt += __shfl_xor(tt, 2); tt += __shfl_xor(tt, 1); \
      const float dv = __shfl(tt, (lane & 7) * 8); \
      if ((lane >> 3) == (s__ & 7)) { if (s__ & 8) a1 = dv; else a0 = dv; } \
    } else { \
      if (s__ == 16) { w0 = gelu_exact(a0 * (1.f / 512.f)) * g0; w1 = gelu_exact(a1 * (1.f / 512.f)) * g1; } \
      const int wr__ = __float_as_int((s__ & 8) ? w1 : w0); \
      _Pragma("unroll") for (int k = 0; k < 8; ++k) { \
        const float w__ = __int_as_float(__builtin_amdgcn_readlane(wr__, (s__ & 7) * 8 + k)); \
        const f32x2 ww = {w__, w__}; \
        _Pragma("unroll") for (int d = 0; d < 4; ++d) { \
          y2[2 * d] = __builtin_amdgcn_cvt_pk_f32_fp8((int)buf[k][d], false) * ww + y2[2 * d]; \
          y2[2 * d + 1] = __builtin_amdgcn_cvt_pk_f32_fp8((int)buf[k][d], true) * ww + y2[2 * d + 1]; } } \
    } } while (0)

__device__ __forceinline__ void ph10_gather(const P& p, int bid, int nb) {
  const int wave = __builtin_amdgcn_readfirstlane((threadIdx.x >> 6) & 3), lane = threadIdx.x & 63;
  const bool b5 = lane & 32, b4 = lane & 16, b3 = lane & 8;
  for (int tok = bid * 4 + wave; tok < TL; tok += nb * 4) {
    const int b = tok / SEQ;
    f32x2 x2[8], y2[8];
    {
      const u32x4 h0 = *((const u32x4*)(p.hn + (size_t)tok * 1024 + lane * 16));
      const u32x4 h1 = *((const u32x4*)(p.hn + (size_t)tok * 1024 + lane * 16 + 8));
#pragma unroll
      for (int i = 0; i < 4; ++i) { x2[i] = (f32x2){blo(h0[i]), bhi(h0[i])}; x2[4 + i] = (f32x2){blo(h1[i]), bhi(h1[i])}; }
#pragma unroll
      for (int i = 0; i < 8; ++i) y2[i] = (f32x2){0.f, 0.f};
    }
    const int e0 = p.eidx[(size_t)tok * 128 + lane], e1 = p.eidx[(size_t)tok * 128 + 64 + lane];
    const float g0 = p.gate[(size_t)tok * 128 + lane], g1 = p.gate[(size_t)tok * 128 + 64 + lane];
    float a0 = 0.f, a1 = 0.f, w0 = 0.f, w1 = 0.f;
    u32x4 A[8], B[8], C[8], D[8];
    G_LOAD(A, 0); G_LOAD(B, 1); G_LOAD(C, 2);
#pragma unroll 1
    for (int s = 0; s < 32; s += 4) {
      G_LOAD(D, s + 3);
      G_COMPUTE(A, s);
      if (s + 4 < 32) G_LOAD(A, s + 4);
      G_COMPUTE(B, s + 1);
      if (s + 5 < 32) G_LOAD(B, s + 5);
      G_COMPUTE(C, s + 2);
      if (s + 6 < 32) G_LOAD(C, s + 6);
      G_COMPUTE(D, s + 3);
    }
    float* orow = p.out + (size_t)tok * 1024 + lane * 16;
    const float* g2 = p.mod + b * 6144 + 5 * 1024 + lane * 16;
    float z[16];
    float ss = 0.f;
#pragma unroll
    for (int q = 0; q < 4; ++q) {
      const f32x4 xl = *(const f32x4*)(orow + q * 4);
      const f32x4 gg = *(const f32x4*)(g2 + q * 4);
      const float yv[4] = {y2[2 * q].x, y2[2 * q].y, y2[2 * q + 1].x, y2[2 * q + 1].y};
#pragma unroll
      for (int i = 0; i < 4; ++i) { const float zz = xl[i] + gg[i] * (yv[i] * (1.f / 32.f)); z[q * 4 + i] = zz; ss += zz * zz; }
    }
    ss = wave_sum(ss);
    const float rstd = rsqrtf(ss * (1.f / 1024.f) + 1e-6f);
#pragma unroll
    for (int q = 0; q < 4; ++q) {
      const f32x4 fw = *(const f32x4*)(p.final_norm_w + lane * 16 + q * 4);
      f32x4 o;
#pragma unroll
      for (int i = 0; i < 4; ++i) o[i] = z[q * 4 + i] * rstd * fw[i];
      *(f32x4*)(orow + q * 4) = o;
    }
  }
}

__global__ void __launch_bounds__(2 * NTHR, 2) mega(P p) {
  __shared__ __attribute__((aligned(16))) char smem_all[2 * LDS_HALF];
  cg::grid_group grid = cg::this_grid();
  const int half = __builtin_amdgcn_readfirstlane(threadIdx.x >> 8);
  char* smem = smem_all + half * LDS_HALF;
  const int bid = blockIdx.x * 2 + half, nb = gridDim.x * 2;
#ifndef REPEAT_MASK
#define REPEAT_MASK 0
#endif
#ifndef EXTRA_SYNCS
#define EXTRA_SYNCS 0
#endif
#define GSYNC() do { asm volatile("s_waitcnt vmcnt(0)" ::: "memory"); grid.sync(); } while (0)
#define RUN(k, call) if ((PHMASK & (1 << k)) && p.ph_lo <= k && k < p.ph_hi) { call; if (REPEAT_MASK & (1 << k)) { GSYNC(); call; } \
    if (k + 1 < p.ph_hi) { GSYNC(); for (int xs = 0; xs < EXTRA_SYNCS; ++xs) GSYNC(); } }
  RUN(0, ph0_prep(p, bid, nb, smem))
  RUN(1, ph_norm_rows<0>(p, bid, nb))
  RUN(2, ph_gemm8<0>(p, smem_all))
  RUN(3, ph3_chunk_local(p, bid, nb, smem))
  RUN(4, ph4_scan(p, bid, nb))
  RUN(5, ph5_mlstm_out(p, bid, nb, smem))
  RUN(6, (ph_gemm8<1>(p, smem_all), ph_convert_tables(p, bid, nb)))
  RUN(7, ph_norm_rows<1>(p, bid, nb))
  RUN(8, ph_gemm8<2>(p, smem_all))
  RUN(9, ph9_topk(p, bid, nb, smem))
  RUN(10, ph10_gather(p, bid, nb))
#undef RUN
}

extern "C" void kernel_launch(void* const* d_in, const int* in_sizes, int n_in, void* d_out, int out_size, void* d_ws, size_t ws_size,
                              hipStream_t stream) {
  static int grid_blocks = 0;
  if (!grid_blocks) {
    int dev = 0, cus = 0, per_cu = 0;
    hipGetDevice(&dev);
    hipDeviceGetAttribute(&cus, hipDeviceAttributeMultiprocessorCount, dev);
    hipOccupancyMaxActiveBlocksPerMultiprocessor(&per_cu, (const void*)mega, 2 * NTHR, 0);
    per_cu = 1;
    grid_blocks = cus * per_cu;
    if (ws_size < WS_END) fprintf(stderr, "kernel_launch: workspace too small: %zu < %llu\n", ws_size, (unsigned long long)WS_END);
  }
  P p{};
  const float* const* in = (const float* const*)d_in;
  p.x = in[0]; p.c = in[1]; p.ctx = in[2]; p.c_ctx = in[3]; p.w_mod = in[4]; p.b_mod = in[5]; p.norm1_w = in[6]; p.w_in = in[7];
  p.conv_w = in[8]; p.conv_b = in[9]; p.b_gates = in[10]; p.head_norm_w = in[11]; p.pool_w = in[12]; p.pool_scale = in[13];
  p.w_out = in[14]; p.norm2_w = in[15]; p.wq = in[16]; p.keys = in[17]; p.U = in[18]; p.V = in[19]; p.final_norm_w = in[20];
  p.out = (float*)d_out;
  char* ws = (char*)d_ws;
  p.mod = (float*)(ws + OFF_MOD); p.gates = (float*)(ws + OFF_GATES);
  p.wt_in = (bf16_t*)(ws + OFF_WTIN); p.wt_out = (bf16_t*)(ws + OFF_WTOUT); p.wt_q = (bf16_t*)(ws + OFF_WTQ);
  p.keys_bf = (bf16_t*)(ws + OFF_KEYS); p.hn = (bf16_t*)(ws + OFF_HN); p.pl = (bf16_t*)(ws + OFF_PL);
  p.Dst = (bf16_t*)(ws + OFF_D); p.ND = (float*)(ws + OFF_ND); p.SC = (float*)(ws + OFF_SC);
  p.CIN = (bf16_t*)(ws + OFF_CIN); p.NIN = (float*)(ws + OFF_NIN); p.MIN_ = (float*)(ws + OFF_MIN);
  p.mix = (bf16_t*)(ws + OFF_D); p.qb = (bf16_t*)(ws + OFF_D);
  p.U8 = (unsigned char*)(ws + OFF_PL); p.V8 = (unsigned char*)(ws + OFF_PL + 16777216ull);
  p.eidx = (int*)(ws + OFF_EIDX); p.gate = (float*)(ws + OFF_GATE);
#if N_LAUNCHES == 1
  p.ph_lo = 0; p.ph_hi = NPH;
  void* args[] = {&p};
  hipError_t e = hipLaunchCooperativeKernel((const void*)mega, dim3(grid_blocks), dim3(2 * NTHR), args, 0, stream);
  if (e != hipSuccess) fprintf(stderr, "cooperative launch failed: %s (grid %d)\n", hipGetErrorString(e), grid_blocks);
#else
  for (int ph = 0; ph < NPH; ++ph) {
    p.ph_lo = ph; p.ph_hi = ph + 1;
    void* args[] = {&p};
    hipError_t e = hipLaunchCooperativeKernel((const void*)mega, dim3(grid_blocks), dim3(2 * NTHR), args, 0, stream);
    if (e != hipSuccess) fprintf(stderr, "launch %d failed: %s (grid %d)\n", ph, hipGetErrorString(e), grid_blocks);
  }
#endif
}
```

```cpp
#include <hip/hip_runtime.h>
#include <hip/hip_cooperative_groups.h>
#include <stdint.h>
#include <stdio.h>
namespace cg = cooperative_groups;

#ifndef PHMASK
#define PHMASK 0x7ff
#endif
#ifndef N_LAUNCHES
#define N_LAUNCHES 1
#endif

typedef unsigned short bf16_t;
typedef short bf16x8 __attribute__((ext_vector_type(8)));
typedef float f32x4 __attribute__((ext_vector_type(4)));
typedef unsigned u32x4 __attribute__((ext_vector_type(4)));
typedef float f32x2 __attribute__((ext_vector_type(2)));
typedef unsigned u32x2 __attribute__((ext_vector_type(2)));
typedef __bf16 bf16x2 __attribute__((ext_vector_type(2)));

#define NB 8
#define SEQ 2048
#define DM 1024
#define CTXL 256
#define TL 16384
#define TC 2048
#define TR 18432
#define LDP 2624
#define NPADIN 2688
#define NTHR 256
#define LDS_HALF 73728
#define NPH 11

#define OFF_MOD    (4096ull)
#define OFF_GATES  (OFF_MOD + 262144ull)
#define OFF_WTIN   (OFF_GATES + 1179648ull)
#define OFF_WTOUT  (OFF_WTIN + 5767168ull)
#define OFF_WTQ    (OFF_WTOUT + 2097152ull)
#define OFF_KEYS   (OFF_WTQ + 4194304ull)
#define OFF_POOLWT (OFF_KEYS + 524288ull)
#define OFF_HN     (OFF_POOLWT + 131072ull)
#define OFF_PL     (OFF_HN + 37748736ull)
#define OFF_D      (OFF_PL + 96731136ull)
#define OFF_ND     (OFF_D + 37748736ull)
#define OFF_SC     (OFF_ND + 589824ull)
#define OFF_CIN    (OFF_SC + 147456ull)
#define OFF_NIN    (OFF_CIN + 33554432ull)
#define OFF_MIN    (OFF_NIN + 524288ull)
#define OFF_EIDX   (OFF_MIN + 131072ull)
#define OFF_GATE   (OFF_EIDX + 8388608ull)
#define WS_END     (OFF_GATE + 8388608ull)

struct P {
  const float *x, *c, *ctx, *c_ctx, *w_mod, *b_mod, *norm1_w, *w_in, *conv_w, *conv_b, *b_gates, *head_norm_w,
      *pool_w, *pool_scale, *w_out, *norm2_w, *wq, *keys, *U, *V, *final_norm_w;
  float* out;
  float* mod;
  float* gates;
  bf16_t* wt_in;
  bf16_t* wt_out;
  bf16_t* wt_q;
  bf16_t* keys_bf;
  bf16_t* hn;
  bf16_t* pl;
  bf16_t* Dst;
  float* ND;
  float* SC;
  bf16_t* CIN;
  float* NIN;
  float* MIN_;
  bf16_t* mix;
  bf16_t* qb;
  unsigned char* U8;
  unsigned char* V8;
  int* eidx;
  float* gate;
  int ph_lo, ph_hi;
};

__device__ __forceinline__ bf16_t f2bf(float f) { return __builtin_bit_cast(bf16_t, (__bf16)f); }
__device__ __forceinline__ float bf2f(bf16_t h) { return __uint_as_float(((unsigned)h) << 16); }
__device__ __forceinline__ float wave_sum(float v) {
#pragma unroll
  for (int o = 32; o > 0; o >>= 1) v += __shfl_xor(v, o);
  return v;
}
__device__ __forceinline__ float silu_f(float v) { return v / (1.f + __expf(-v)); }
__device__ __forceinline__ float logsig_f(float v) { return fminf(v, 0.f) - log1pf(__expf(-fabsf(v))); }

__device__ __forceinline__ void ph0_prep(const P& p, int bid, int nb, char* smem) {
  float* sm = (float*)smem;
  const int tid = threadIdx.x & 255;
  const int N_MOD = 384, N_TIN = 16 * 44, N_TOUT = 256, N_TQ = 16 * 32, N_POOL = 16;
  const int total = N_MOD + N_TIN + N_TOUT + N_TQ + N_POOL;
  const int trips = (total + nb - 1) / nb;
  for (int k = 0; k < trips; ++k) {
    int r = (bid + k * nb) % total;
    if (r < N_MOD) {
      float* part = sm + 9 * 1024;
      for (int i = tid; i < 9 * 1024; i += NTHR) {
        int rr = i >> 10, kq = i & 1023;
        float v = rr < 8 ? p.c[rr * 1024 + kq] : p.c_ctx[kq];
        sm[i] = silu_f(v);
      }
      __syncthreads();
      {
        const int c = tid & 15, kg = tid >> 4, n = r * 16 + c;
        float acc[9];
#pragma unroll
        for (int q = 0; q < 9; ++q) acc[q] = 0.f;
#pragma unroll 8
        for (int i = 0; i < 64; ++i) {
          const int kq = kg + i * 16;
          const float w = p.w_mod[(size_t)kq * 6144 + n];
#pragma unroll
          for (int q = 0; q < 9; ++q) acc[q] += sm[q * 1024 + kq] * w;
        }
#pragma unroll
        for (int q = 0; q < 9; ++q) part[(kg * 9 + q) * 16 + c] = acc[q];
      }
      __syncthreads();
      if (tid < 144) {
        const int q = tid >> 4, c = tid & 15, n = r * 16 + c;
        float t = p.b_mod[n];
#pragma unroll
        for (int kg = 0; kg < 16; ++kg) t += part[(kg * 9 + q) * 16 + c];
        p.mod[q * 6144 + n] = t;
      }
      continue;
    }
    r -= N_MOD;
    const float* src = nullptr; bf16_t* dst = nullptr; int K = 1024, N = 0, ntn = 0;
    if (r < N_TIN) { src = p.w_in; dst = p.wt_in; N = 2576; ntn = 44; }
    else { r -= N_TIN;
      if (r < N_TOUT) { src = p.w_out; dst = p.wt_out; N = 1024; ntn = 16; }
      else { r -= N_TOUT;
        if (r < N_TQ) { src = p.wq; dst = p.wt_q; N = 2048; ntn = 32; }
        else { r -= N_TQ; int g = r >> 2; r &= 3; src = p.pool_w + g * 16384; dst = (bf16_t*)((char*)p.keys_bf + 524288) + g * 16384; K = 128; N = 128; ntn = 2; }
      }
    }
    {
      int kt = r / ntn, nt = r % ntn, k0 = kt * 64, n0 = nt * 64;
      int cc = tid & 63;
      for (int rr = tid >> 6; rr < 64; rr += 4) {
        int n = n0 + cc;
        sm[rr * 65 + cc] = n < N ? src[(size_t)(k0 + rr) * N + n] : 0.f;
      }
      __syncthreads();
      for (int rr = tid >> 6; rr < 64; rr += 4) dst[(size_t)(n0 + rr) * K + k0 + cc] = f2bf(sm[cc * 65 + rr]);
      __syncthreads();
    }
  }
  for (int i = bid * NTHR + tid; i < 262144; i += nb * NTHR) p.keys_bf[i] = f2bf(p.keys[i]);
}

template <int WHICH>
__device__ __forceinline__ void ph_norm_rows(const P& p, int bid, int nb) {
  const int wave = (threadIdx.x >> 6) & 3, lane = threadIdx.x & 63;
  const int nrows = WHICH == 0 ? TR : TL;
  for (int row = bid * 4 + wave; row < nrows; row += nb * 4) {
    const float* src = WHICH == 0 ? (row < TL ? p.x + (size_t)row * 1024 : p.ctx + (size_t)(row - TL) * 1024) : p.out + (size_t)row * 1024;
    const int mr = row < TL ? row / SEQ : 8;
    float4 v[4];
    float ss = 0.f;
#pragma unroll
    for (int j = 0; j < 4; ++j) {
      v[j] = ((const float4*)src)[j * 64 + lane];
      ss += v[j].x * v[j].x + v[j].y * v[j].y + v[j].z * v[j].z + v[j].w * v[j].w;
    }
    ss = wave_sum(ss);
    const float rstd = rsqrtf(ss * (1.f / 1024.f) + 1e-6f);
    const float* nw = WHICH == 0 ? p.norm1_w : p.norm2_w;
    const float* sh = p.mod + mr * 6144 + (WHICH == 0 ? 0 : 3) * 1024;
    const float* sc = sh + 1024;
#pragma unroll
    for (int j = 0; j < 4; ++j) {
      const int col = j * 256 + lane * 4;
      float4 w4 = *(const float4*)(nw + col), s4 = *(const float4*)(sh + col), c4 = *(const float4*)(sc + col);
      float y0 = v[j].x * rstd * w4.x * (1.f + c4.x) + s4.x;
      float y1 = v[j].y * rstd * w4.y * (1.f + c4.y) + s4.y;
      float y2 = v[j].z * rstd * w4.z * (1.f + c4.z) + s4.z;
      float y3 = v[j].w * rstd * w4.w * (1.f + c4.w) + s4.w;
      uint2 o;
      o.x = (unsigned)f2bf(y0) | ((unsigned)f2bf(y1) << 16);
      o.y = (unsigned)f2bf(y2) | ((unsigned)f2bf(y3) << 16);
      *(uint2*)(p.hn + (size_t)row * 1024 + col) = o;
    }
  }
}

#define GBK 64
#define GLD 72
template <int EPI>
__device__ __forceinline__ void gemm_tile(const P& p, const bf16_t* A, int lda, const bf16_t* Bt, int m0, int n0, bf16_t* sA, bf16_t* sB) {
  const int tid = threadIdx.x & 255, lane = tid & 63, wave = tid >> 6;
  const int wm = wave >> 1, wn = wave & 1;
  const int lr = lane & 15, lq = lane >> 4;
  f32x4 acc[4][4];
#pragma unroll
  for (int i = 0; i < 4; ++i)
#pragma unroll
    for (int j = 0; j < 4; ++j) acc[i][j] = (f32x4){0.f, 0.f, 0.f, 0.f};
  const int sr = tid >> 3, scol = (tid & 7) * 8;
  u32x4 ra[4], rb[4];
  const bf16_t* Ap = A + (size_t)(m0 + sr) * lda + scol;
  const bf16_t* Bp = Bt + (size_t)(n0 + sr) * 1024 + scol;
#pragma unroll
  for (int i = 0; i < 4; ++i) {
    ra[i] = *(const u32x4*)(Ap + (size_t)(i * 32) * lda);
    rb[i] = *(const u32x4*)(Bp + (size_t)(i * 32) * 1024);
  }
  for (int kt = 0; kt < 1024 / GBK; ++kt) {
    __syncthreads();
#pragma unroll
    for (int i = 0; i < 4; ++i) {
      *(u32x4*)(sA + (sr + i * 32) * GLD + scol) = ra[i];
      *(u32x4*)(sB + (sr + i * 32) * GLD + scol) = rb[i];
    }
    __syncthreads();
    {
      const int k0 = (kt + 1 < 1024 / GBK ? kt + 1 : kt) * GBK;
#pragma unroll
      for (int i = 0; i < 4; ++i) {
        ra[i] = *(const u32x4*)(Ap + (size_t)(i * 32) * lda + k0);
        rb[i] = *(const u32x4*)(Bp + (size_t)(i * 32) * 1024 + k0);
      }
    }
#pragma unroll
    for (int ks = 0; ks < 2; ++ks) {
      bf16x8 af[4], bfr[4];
#pragma unroll
      for (int i = 0; i < 4; ++i) {
        af[i] = *(const bf16x8*)(sA + (wm * 64 + i * 16 + lr) * GLD + ks * 32 + lq * 8);
        bfr[i] = *(const bf16x8*)(sB + (wn * 64 + i * 16 + lr) * GLD + ks * 32 + lq * 8);
      }
#pragma unroll
      for (int i = 0; i < 4; ++i)
#pragma unroll
        for (int j = 0; j < 4; ++j) acc[i][j] = __builtin_amdgcn_mfma_f32_16x16x32_bf16(af[i], bfr[j], acc[i][j], 0, 0, 0);
    }
  }
#pragma unroll
  for (int i = 0; i < 4; ++i)
#pragma unroll
    for (int j = 0; j < 4; ++j)
#pragma unroll
      for (int e = 0; e < 4; ++e) {
        const int row = m0 + wm * 64 + i * 16 + lq * 4 + e;
        const int col = n0 + wn * 64 + j * 16 + lr;
        const float v = acc[i][j][e];
        if (EPI == 0) {
          if (col < 2560) p.pl[(size_t)row * LDP + col] = f2bf(v);
          else if (col < 2576) p.gates[(size_t)row * 16 + (col - 2560)] = v;
        } else if (EPI == 1) {
          const int b = row / SEQ;
          p.out[(size_t)row * 1024 + col] = p.x[(size_t)row * 1024 + col] + p.mod[b * 6144 + 2 * 1024 + col] * v;
        } else {
          p.qb[(size_t)row * 2048 + col] = f2bf(v);
        }
      }
}

template <int EPI>
__device__ __forceinline__ void ph_gemm(const P& p, int bid, int nb, char* smem) {
  bf16_t* sA = (bf16_t*)smem;
  bf16_t* sB = sA + 128 * GLD;
  const int ntn = EPI == 0 ? 21 : (EPI == 1 ? 8 : 16);
  const int ntm = EPI == 0 ? 144 : 128;
  const bf16_t* A = EPI == 0 ? p.hn : (EPI == 1 ? p.mix : p.hn);
  const int lda = 1024;
  const bf16_t* Bt = EPI == 0 ? p.wt_in : (EPI == 1 ? p.wt_out : p.wt_q);
  const int nlat = 128 * ntn;
  const int ntiles = EPI == 0 ? nlat + 16 * 13 : ntm * ntn;
  const int trips = (ntiles + nb - 1) / nb;
  for (int k = 0; k < trips; ++k) {
    const int t = (bid + k * nb) % ntiles;
    int tm, tn;
    if (EPI == 0 && t >= nlat) { const int r = t - nlat; tm = 128 + r / 13; tn = r % 13; if (tn == 12) tn = 20; }
    else { tm = t / ntn; tn = t % ntn; }
    gemm_tile<EPI>(p, A, lda, Bt, tm * 128, tn * 128, sA, sB);
  }
}

struct UnitInfo { int isctx, b, c, h, T, seqrow0, row0; };
__device__ __forceinline__ UnitInfo decode_unit(int u) {
  UnitInfo r;
  if (u < 512) { r.isctx = 0; r.b = u >> 6; r.c = (u >> 2) & 15; r.h = u & 3; r.T = SEQ; r.seqrow0 = r.b * SEQ; }
  else { int uu = u - 512; r.isctx = 1; r.b = uu >> 3; r.c = (uu >> 2) & 1; r.h = uu & 3; r.T = CTXL; r.seqrow0 = TL + r.b * CTXL; }
  r.row0 = r.seqrow0 + r.c * 128;
  return r;
}
__device__ __forceinline__ float qk_act(const P& p, int seqrow0, int T, int t, int col) {
  const bf16_t* base = p.pl + (size_t)(seqrow0 + t) * LDP + col;
  float r0 = t > 0 ? bf2f(base[-LDP]) : 0.f;
  float r1 = bf2f(base[0]);
  float r2 = t + 1 < T ? bf2f(base[LDP]) : 0.f;
  float y = p.conv_b[col] + r0 * p.conv_w[col] + r1 * p.conv_w[1024 + col] + r2 * p.conv_w[2048 + col];
  return silu_f(y);
}


typedef short s16x4 __attribute__((ext_vector_type(4)));
#define LDS_AS __attribute__((address_space(3)))
__device__ __forceinline__ s16x4 ds_tr16(const bf16_t* ptr) { return __builtin_amdgcn_ds_read_tr16_b64_v4i16((LDS_AS s16x4*)ptr); }
__device__ __forceinline__ bf16x8 frag_tr(const bf16_t* M, int ld, int s0, int c0, int lr, int lq) {
  const bf16_t* a = M + (s0 + lq * 8 + (lr >> 2)) * ld + c0 + (lr & 3) * 4;
  const s16x4 t0 = ds_tr16(a), t1 = ds_tr16(a + 4 * ld);
  return __builtin_shufflevector(t0, t1, 0, 1, 2, 3, 4, 5, 6, 7);
}
__device__ __forceinline__ unsigned cvt_pk_bf16(float lo, float hi) { const f32x2 v = {lo, hi}; const bf16x2 b = __builtin_convertvector(v, bf16x2); return __builtin_bit_cast(unsigned, b); }
__device__ __forceinline__ float blo(unsigned u) { return __uint_as_float(u << 16); }
__device__ __forceinline__ float bhi(unsigned u) { return __uint_as_float(u & 0xffff0000u); }
#define VLD 136
__device__ __forceinline__ __amdgpu_buffer_rsrc_t mk_rsrc(const void* ptr) { return __builtin_amdgcn_make_buffer_rsrc((void*)ptr, 0, 0x7fffffff, 0x00020000); }
__device__ __forceinline__ bf16x8 bload8(__amdgpu_buffer_rsrc_t r, int voff, int soff) { return __builtin_bit_cast(bf16x8, __builtin_amdgcn_raw_buffer_load_b128(r, voff, soff, 0)); }


namespace pg8 {
#define PG8_LAS __attribute__((address_space(3)))
constexpr int BM = 256, BK = 64, HALF = 128, HTB = HALF * BK * 2, STAGE_BYTES = 8 * HTB, NXCD = 8, WGM = 8;
__host__ __device__ __forceinline__ int lds_byte(int r, int c) { const int st = (r >> 4) * 2 + (c >> 5), rr = r & 15, cc = c & 31, ob = rr * 64 + cc * 2; return st * 1024 + (ob ^ (((ob >> 9) & 1) << 5)); }
__host__ __device__ __forceinline__ void stage_rc(int b, int& R, int& C) { const int st = b / 1024, sb = b % 1024, swz = sb ^ (((sb >> 9) & 1) << 5); R = (st >> 1) * 16 + swz / 64; C = (st & 1) * 32 + (swz % 64) / 2; }
__host__ __device__ __forceinline__ int perm32(int rho) { const int n = rho >> 4, i = rho & 15; return 8 * (i >> 2) + 4 * n + (i & 3); }
struct Unit { int pm, pn; };
struct Gemm { const bf16_t* A; const bf16_t* Bt; int M, N, K; };
struct Order {
  int nM, nN, nwg, G, c, extra;
  __device__ void init(int nM_, int nN_, int G_, int c_, int extra_) { nM = nM_; nN = nN_; nwg = nM * nN; G = G_; c = c_; extra = extra_; }
  __device__ bool next(int i, Unit& u) const {
    const long L = (long)i * G + c;
    if (L >= nwg + extra) return false;
    if (L >= nwg) { const int r = (int)L - nwg; u.pm = nM + r / 7; const int q = r % 7; u.pn = q < 6 ? q : 10; return true; }
    int wgid = (int)L; { const int q = nwg / NXCD, r = nwg % NXCD, xcd = wgid % NXCD, off = wgid / NXCD; wgid = (xcd < r ? xcd * (q + 1) : r * (q + 1) + (xcd - r) * q) + off; }
    const int nig = WGM * nN, gid = wgid / nig, fm = gid * WGM, gsz = (nM - fm) < WGM ? (nM - fm) : WGM;
    u.pm = fm + ((wgid % nig) % gsz); u.pn = (wgid % nig) / gsz; return true;
  }
  __device__ __forceinline__ void a_ready(const Unit&) const {}
  __device__ __forceinline__ void done(const Unit&) const {}
};
template <class Epi, class Sched>
__device__ __forceinline__ void gemm_phase(PG8_LAS unsigned char* lds, const Gemm g, const Sched& S, const Epi& E) {
    const int tid = threadIdx.x, wid = __builtin_amdgcn_readfirstlane(tid >> 6), lane = tid & 63, wr = wid >> 2, wc = wid & 3, fr = lane & 15, fq = lane >> 4;
    const int K = g.K, nt = K / BK;
    unsigned voffA[2], voffB[2];
#pragma unroll
    for (int i = 0; i < 2; ++i) { int R, C; stage_rc(tid * 16 + i * 8192, R, C); const int Rb = Epi::PERM ? ((R & ~31) + perm32(R & 31)) : R;
        voffA[i] = (unsigned)(R * K + C) * 2u; voffB[i] = (unsigned)(Rb * K + C) * 2u; }
    const size_t kstep = (size_t)(BK * 2);
    const size_t hstep = (size_t)HALF * K * 2;
    const size_t tstep = 2 * hstep;
    const unsigned ldsw = (unsigned)wid * 1024u;
    const int aoff = lds_byte(wr * 64 + fr, fq * 8), boff = lds_byte(wc * 32 + fr, fq * 8);
#define PG8_SA(b, h) (((b) * 2 + (h)) * HTB)
#define PG8_SB(b, h) ((4 + (b) * 2 + (h)) * HTB)
#define PG8_STAGE(bufoff, gbase, voff) do { _Pragma("unroll") for (int _i = 0; _i < 2; ++_i) \
        __builtin_amdgcn_global_load_lds((const unsigned*)((const char*)(gbase) + (voff)[_i]), (PG8_LAS unsigned*)(lds + (bufoff) + ldsw + _i * 8192), 16, 0, 0); } while (0)
#define PG8_LDA(dst, b, h) do { _Pragma("unroll") for (int m = 0; m < 4; ++m) _Pragma("unroll") for (int k = 0; k < 2; ++k) dst[m][k] = *(const PG8_LAS bf16x8*)(lds + PG8_SA(b, h) + aoff + m * 2048 + k * 1024); } while (0)
#define PG8_LDB(dst, b, h) do { _Pragma("unroll") for (int n = 0; n < 2; ++n) _Pragma("unroll") for (int k = 0; k < 2; ++k) dst[n][k] = *(const PG8_LAS bf16x8*)(lds + PG8_SB(b, h) + boff + n * 2048 + k * 1024); } while (0)
#define PG8_MMA(ai, bj, At, Bt) do { __builtin_amdgcn_s_setprio(1); _Pragma("unroll") for (int m = 0; m < 4; ++m) _Pragma("unroll") for (int n = 0; n < 2; ++n) _Pragma("unroll") for (int k = 0; k < 2; ++k) \
        acc[ai][bj][m][n] = __builtin_amdgcn_mfma_f32_16x16x32_bf16(Bt[n][k], At[m][k], acc[ai][bj][m][n], 0, 0, 0); __builtin_amdgcn_s_setprio(0); } while (0)
#define PG8_WAIT_V(n) asm volatile("s_waitcnt vmcnt(" #n ")" ::: "memory")
#define PG8_WAIT_L(n) asm volatile("s_waitcnt lgkmcnt(" #n ")" ::: "memory")
#define PG8_BAR __builtin_amdgcn_s_barrier()
#define PG8_SCHED __builtin_amdgcn_sched_barrier(0)
    Unit cur, nxt; int ui = 0;
    if (!S.next(0, cur)) return;
    f32x4 acc[2][2][4][2];
#pragma unroll
    for (int a = 0; a < 2; ++a)
#pragma unroll
        for (int b = 0; b < 2; ++b)
#pragma unroll
            for (int m = 0; m < 4; ++m)
#pragma unroll
                for (int n = 0; n < 2; ++n) acc[a][b][m][n] = (f32x4){0.f, 0.f, 0.f, 0.f};
    bf16x8 At[4][2], B0[2][2], B1[2][2];
    const char* cA = (const char*)g.A + (size_t)cur.pm * tstep; const char* cB = (const char*)g.Bt + (size_t)cur.pn * tstep;
    S.a_ready(cur);
    PG8_STAGE(PG8_SB(0, 0), cB, voffB); PG8_STAGE(PG8_SA(0, 0), cA, voffA); PG8_STAGE(PG8_SB(0, 1), cB + hstep, voffB); PG8_STAGE(PG8_SA(0, 1), cA + hstep, voffA);
    if (wr == 1) PG8_BAR;
    PG8_WAIT_V(4); PG8_BAR;
    PG8_STAGE(PG8_SB(1, 0), cB + kstep, voffB); PG8_STAGE(PG8_SA(1, 0), cA + kstep, voffA); PG8_STAGE(PG8_SB(1, 1), cB + hstep + kstep, voffB);
    PG8_WAIT_V(6); PG8_BAR;
    for (;;) {
        const bool has_next = S.next(ui + 1, nxt);
        const char* nA = has_next ? (const char*)g.A + (size_t)nxt.pm * tstep : cA; const char* nB = has_next ? (const char*)g.Bt + (size_t)nxt.pn * tstep : cB;
        for (int t = 0; t < nt; t += 2) {
            const bool last = (t == nt - 2);
            const char* a1 = cA + (size_t)(t + 1) * kstep;
            const char* a2 = last ? nA : cA + (size_t)(t + 2) * kstep; const char* b2 = last ? nB : cB + (size_t)(t + 2) * kstep;
            const char* a3 = a2 + kstep; const char* b3 = b2 + kstep;
            if (last && has_next) S.a_ready(nxt);
            PG8_LDB(B0, 0, 0); PG8_SCHED; PG8_LDA(At, 0, 0); PG8_STAGE(PG8_SA(1, 1), a1 + hstep, voffA);
            PG8_WAIT_L(8); PG8_BAR; PG8_WAIT_L(0); PG8_MMA(0, 0, At, B0); PG8_BAR; PG8_SCHED;
            PG8_LDB(B1, 0, 1); PG8_STAGE(PG8_SB(0, 0), b2, voffB);
            PG8_BAR; PG8_WAIT_L(0); PG8_MMA(0, 1, At, B1); PG8_BAR;
            PG8_LDA(At, 0, 1); PG8_STAGE(PG8_SA(0, 0), a2, voffA);
            PG8_BAR; PG8_WAIT_L(0); PG8_MMA(1, 0, At, B0); PG8_BAR; PG8_SCHED;
            PG8_STAGE(PG8_SB(0, 1), b2 + hstep, voffB);
            PG8_WAIT_V(6); PG8_BAR; PG8_MMA(1, 1, At, B1); PG8_BAR;
            PG8_LDB(B0, 1, 0); PG8_SCHED; PG8_LDA(At, 1, 0); PG8_STAGE(PG8_SA(0, 1), a2 + hstep, voffA);
            PG8_WAIT_L(8); PG8_BAR; PG8_WAIT_L(0); PG8_MMA(0, 0, At, B0); PG8_BAR; PG8_SCHED;
            PG8_LDB(B1, 1, 1); PG8_STAGE(PG8_SB(1, 0), b3, voffB);
            PG8_BAR; PG8_WAIT_L(0); PG8_MMA(0, 1, At, B1); PG8_BAR;
            PG8_LDA(At, 1, 1); PG8_STAGE(PG8_SA(1, 0), a3, voffA);
            PG8_BAR; PG8_WAIT_L(0); PG8_MMA(1, 0, At, B0); PG8_BAR; PG8_SCHED;
            PG8_STAGE(PG8_SB(1, 1), b3 + hstep, voffB);
            PG8_WAIT_V(6); PG8_BAR; PG8_MMA(1, 1, At, B1); PG8_BAR;
        }
        if constexpr (!Epi::AFTER_DRAIN) { E(acc, cur, wr, wc, fr, fq); S.done(cur); }
        if (!has_next) break;
#pragma unroll
        for (int a = 0; a < 2; ++a)
#pragma unroll
            for (int b = 0; b < 2; ++b)
#pragma unroll
                for (int m = 0; m < 4; ++m)
#pragma unroll
                    for (int n = 0; n < 2; ++n) acc[a][b][m][n] = (f32x4){0.f, 0.f, 0.f, 0.f};
        cur = nxt; cA = nA; cB = nB; ++ui;
    }
    PG8_WAIT_V(0);
    if (wr == 0) PG8_BAR;
    PG8_BAR;
    if constexpr (Epi::AFTER_DRAIN) { E.fused(acc, cur, wr, wc, fr, fq, lds, wid, lane); S.done(cur); }
#undef PG8_SA
#undef PG8_SB
#undef PG8_STAGE
#undef PG8_LDA
#undef PG8_LDB
#undef PG8_MMA
#undef PG8_WAIT_V
#undef PG8_WAIT_L
#undef PG8_BAR
#undef PG8_SCHED
}
}

struct EpiIn {
  static constexpr bool PERM = true, AFTER_DRAIN = false;
  bf16_t* pl; float* gates;
  __device__ __forceinline__ void operator()(const f32x4 (&acc)[2][2][4][2], const pg8::Unit& u, int wr, int wc, int fr, int fq) const {
    const int row0 = u.pm * 256 + wr * 64 + fr;
#pragma unroll
    for (int ai = 0; ai < 2; ++ai)
#pragma unroll
      for (int m = 0; m < 4; ++m) {
        const int row = row0 + ai * 128 + m * 16;
#pragma unroll
        for (int bj = 0; bj < 2; ++bj) {
          const int c0 = u.pn * 256 + bj * 128 + wc * 32 + 8 * fq;
          const f32x4 v0 = acc[ai][bj][m][0], v1 = acc[ai][bj][m][1];
          if (c0 < 2560) {
            u32x4 w;
            w[0] = cvt_pk_bf16(v0[0], v0[1]); w[1] = cvt_pk_bf16(v0[2], v0[3]); w[2] = cvt_pk_bf16(v1[0], v1[1]); w[3] = cvt_pk_bf16(v1[2], v1[3]);
            *(u32x4*)(pl + (size_t)row * LDP + c0) = w;
          } else if (c0 < 2576) {
            *(f32x4*)(gates + (size_t)row * 16 + (c0 - 2560)) = v0;
            *(f32x4*)(gates + (size_t)row * 16 + (c0 - 2560) + 4) = v1;
          }
        }
      }
  }
};
struct EpiOut {
  static constexpr bool PERM = false, AFTER_DRAIN = false;
  const float* x; const float* mod; float* out;
  __device__ __forceinline__ void operator()(const f32x4 (&acc)[2][2][4][2], const pg8::Unit& u, int wr, int wc, int fr, int fq) const {
    const int row0 = u.pm * 256 + wr * 64 + fr, col0 = u.pn * 256 + wc * 32 + 4 * fq;
    const float* g1 = mod + (u.pm * 256 / SEQ) * 6144 + 2 * 1024;
#pragma unroll
    for (int ai = 0; ai < 2; ++ai)
#pragma unroll
      for (int m = 0; m < 4; ++m) {
        const size_t ro = (size_t)(row0 + ai * 128 + m * 16) * 1024;
#pragma unroll
        for (int bj = 0; bj < 2; ++bj)
#pragma unroll
          for (int n = 0; n < 2; ++n) {
            const int c = col0 + bj * 128 + n * 16;
            const f32x4 xv = *(const f32x4*)(x + ro + c), gv = *(const f32x4*)(g1 + c);
            *(f32x4*)(out + ro + c) = xv + gv * acc[ai][bj][m][n];
          }
      }
  }
};
struct EpiQ {
  static constexpr bool PERM = true, AFTER_DRAIN = false;
  bf16_t* q;
  __device__ __forceinline__ void operator()(const f32x4 (&acc)[2][2][4][2], const pg8::Unit& u, int wr, int wc, int fr, int fq) const {
    const int row0 = u.pm * 256 + wr * 64 + fr;
#pragma unroll
    for (int ai = 0; ai < 2; ++ai)
#pragma unroll
      for (int m = 0; m < 4; ++m)
#pragma unroll
        for (int bj = 0; bj < 2; ++bj) {
          const int c0 = u.pn * 256 + bj * 128 + wc * 32 + 8 * fq;
          const f32x4 v0 = acc[ai][bj][m][0], v1 = acc[ai][bj][m][1];
          u32x4 w;
          w[0] = cvt_pk_bf16(v0[0], v0[1]); w[1] = cvt_pk_bf16(v0[2], v0[3]); w[2] = cvt_pk_bf16(v1[0], v1[1]); w[3] = cvt_pk_bf16(v1[2], v1[3]);
          *(u32x4*)(q + (size_t)(row0 + ai * 128 + m * 16) * 2048 + c0) = w;
        }
  }
};
template <int EPI>
__device__ __forceinline__ void ph_gemm8(const P& p, char* lds_all) {
  PG8_LAS unsigned char* lds = (PG8_LAS unsigned char*)lds_all;
  pg8::Order S;
  if (EPI == 0) {
    S.init(64, 11, gridDim.x, blockIdx.x, 56);
    const pg8::Gemm g{p.hn, p.wt_in, TR, 2816, 1024};
    const EpiIn E{p.pl, p.gates};
    pg8::gemm_phase<EpiIn, pg8::Order>(lds, g, S, E);
  } else if (EPI == 1) {
    S.init(64, 4, gridDim.x, blockIdx.x, 0);
    const pg8::Gemm g{p.mix, p.wt_out, TL, 1024, 1024};
    const EpiOut E{p.x, p.mod, p.out};
    pg8::gemm_phase<EpiOut, pg8::Order>(lds, g, S, E);
  } else {
    S.init(64, 8, gridDim.x, blockIdx.x, 0);
    const pg8::Gemm g{p.hn, p.wt_q, TL, 2048, 1024};
    const EpiQ E{p.qb};
    pg8::gemm_phase<EpiQ, pg8::Order>(lds, g, S, E);
  }
}

template <bool REV>
__device__ __forceinline__ void scan128(const float* lf, const float* ig, float* bout, float* gout, float* pmout, float& Gtot, float& btot, int lane) {
  const int t0 = REV ? 127 - 2 * lane : 2 * lane, t1 = REV ? 126 - 2 * lane : 2 * lane + 1;
  const float v0 = lf[t0], v1 = lf[t1];
  float sacc = v0 + v1;
#pragma unroll
  for (int off = 1; off < 64; off <<= 1) { const float t = __shfl_up(sacc, off); if (lane >= off) sacc += t; }
  const float b1 = sacc, b0 = sacc - v1;
  const float g0 = ig[t0] - b0, g1 = ig[t1] - b1;
  float m = fmaxf(g0, g1);
#pragma unroll
  for (int off = 1; off < 64; off <<= 1) { const float t = __shfl_up(m, off); if (lane >= off) m = fmaxf(m, t); }
  float prev = __shfl_up(m, 1);
  if (lane == 0) prev = -3.0e38f;
  if (bout) { bout[t0] = b0; bout[t1] = b1; }
  gout[t0] = g0; gout[t1] = g1;
  if (pmout) { pmout[t0] = fmaxf(prev, g0); pmout[t1] = m; }
  Gtot = __shfl(m, 63); btot = __shfl(sacc, 63);
}

__device__ __forceinline__ void ph3_chunk_local(const P& p, int bid, int nb, char* smem) {
  bf16_t* Vs = (bf16_t*)smem;
  bf16_t* Ks = Vs + 128 * VLD;
  float* fa = (float*)(Ks + 128 * VLD);
  float *igf = fa, *lff = fa + 128, *igb = fa + 256, *lfb = fa + 384, *ef = fa + 512, *eb = fa + 640, *scal = fa + 768;
  const int tid = threadIdx.x & 255, lane = tid & 63, wave = tid >> 6, lr = lane & 15, lq = lane >> 4;
  const int trips3 = (576 + nb - 1) / nb;
  for (int k3 = 0; k3 < trips3; ++k3) {
    const int u = (bid + k3 * nb) % 576;
    const UnitInfo ui = decode_unit(u);
    const int h = ui.h;
    if (tid < 128) {
      const float* g = p.gates + (size_t)(ui.row0 + tid) * 16;
      igf[tid] = g[h] + p.b_gates[h];
      lff[tid] = logsig_f(g[4 + h] + p.b_gates[4 + h]);
      igb[tid] = g[8 + h] + p.b_gates[8 + h];
      lfb[tid] = logsig_f(g[12 + h] + p.b_gates[12 + h]);
    }
    {
      const int dch = tid & 15, colq = h * 128 + dch * 8, colk = 512 + colq;
#pragma unroll 1
      for (int which = 0; which < 2; ++which) {
        if (which == 1 && ui.isctx) break;
        const int col = which == 0 ? colk : colq;
        float w0[8], w1[8], w2[8], bb[8];
#pragma unroll
        for (int i = 0; i < 8; ++i) { w0[i] = p.conv_w[col + i]; w1[i] = p.conv_w[1024 + col + i]; w2[i] = p.conv_w[2048 + col + i]; bb[i] = p.conv_b[col + i]; }
        const float scl = which == 0 ? 0.08838834764831845f : 1.f;
#pragma unroll 2
        for (int i = 0; i < 8; ++i) {
          const int t = (tid >> 4) + i * 16, tt = ui.c * 128 + t;
          const bf16_t* base = p.pl + (size_t)(ui.row0 + t) * LDP + col;
          const u32x4 z4 = (u32x4){0u, 0u, 0u, 0u};
          const u32x4 r1 = *(const u32x4*)base;
          const u32x4 r0 = tt > 0 ? *(const u32x4*)(base - LDP) : z4;
          const u32x4 r2 = tt + 1 < ui.T ? *(const u32x4*)(base + LDP) : z4;
          float y[8];
#pragma unroll
          for (int q = 0; q < 4; ++q) {
            y[2 * q] = silu_f(bb[2 * q] + blo(r0[q]) * w0[2 * q] + blo(r1[q]) * w1[2 * q] + blo(r2[q]) * w2[2 * q]) * scl;
            y[2 * q + 1] = silu_f(bb[2 * q + 1] + bhi(r0[q]) * w0[2 * q + 1] + bhi(r1[q]) * w1[2 * q + 1] + bhi(r2[q]) * w2[2 * q + 1]) * scl;
          }
          u32x4 o;
#pragma unroll
          for (int q = 0; q < 4; ++q) o[q] = cvt_pk_bf16(y[2 * q], y[2 * q + 1]);
          if (which == 0) *(u32x4*)(Ks + t * VLD + dch * 8) = o;
          if (!ui.isctx) *(u32x4*)(p.hn + (size_t)(ui.row0 + t) * 1024 + col) = o;
        }
      }
#pragma unroll
      for (int i = 0; i < 8; ++i) {
        const int t = (tid >> 4) + i * 16;
        *(u32x4*)(Vs + t * VLD + dch * 8) = *(const u32x4*)(p.pl + (size_t)(ui.row0 + t) * LDP + 1024 + h * 128 + dch * 8);
      }
    }
    __syncthreads();
    if (wave == 0) {
      float G, bt;
      scan128<false>(lff, igf, nullptr, ef, nullptr, G, bt, lane);
      ef[2 * lane] = __expf(ef[2 * lane] - G); ef[2 * lane + 1] = __expf(ef[2 * lane + 1] - G);
      if (lane == 0) { scal[0] = G; scal[1] = bt; }
    } else if (wave == 1) {
      float G, bt;
      scan128<true>(lfb, igb, nullptr, eb, nullptr, G, bt, lane);
      eb[127 - 2 * lane] = __expf(eb[127 - 2 * lane] - G); eb[126 - 2 * lane] = __expf(eb[126 - 2 * lane] - G);
      if (lane == 0) { scal[2] = G; scal[3] = bt; }
    }
    __syncthreads();
#pragma unroll 1
    for (int dir = 0; dir < 2; ++dir) {
      const float* ee = dir ? eb : ef;
      f32x4 acc[2][8];
#pragma unroll
      for (int m = 0; m < 2; ++m)
#pragma unroll
        for (int j = 0; j < 8; ++j) acc[m][j] = (f32x4){0.f, 0.f, 0.f, 0.f};
#pragma unroll
      for (int kk = 0; kk < 4; ++kk) {
        const f32x4 e0 = *(const f32x4*)(ee + kk * 32 + lq * 8), e1 = *(const f32x4*)(ee + kk * 32 + lq * 8 + 4);
        bf16x8 af[2];
#pragma unroll
        for (int m = 0; m < 2; ++m) {
          const bf16x8 raw = frag_tr(Vs, VLD, kk * 32, wave * 32 + m * 16, lr, lq);
          const u32x4 ru = __builtin_bit_cast(u32x4, raw);
          u32x4 sc;
          sc[0] = cvt_pk_bf16(blo(ru[0]) * e0[0], bhi(ru[0]) * e0[1]);
          sc[1] = cvt_pk_bf16(blo(ru[1]) * e0[2], bhi(ru[1]) * e0[3]);
          sc[2] = cvt_pk_bf16(blo(ru[2]) * e1[0], bhi(ru[2]) * e1[1]);
          sc[3] = cvt_pk_bf16(blo(ru[3]) * e1[2], bhi(ru[3]) * e1[3]);
          af[m] = __builtin_bit_cast(bf16x8, sc);
        }
#pragma unroll
        for (int j = 0; j < 8; ++j) {
          const bf16x8 bfr = frag_tr(Ks, VLD, kk * 32, j * 16, lr, lq);
#pragma unroll
          for (int m = 0; m < 2; ++m) acc[m][j] = __builtin_amdgcn_mfma_f32_16x16x32_bf16(af[m], bfr, acc[m][j], 0, 0, 0);
        }
      }
      bf16_t* Dd = p.Dst + (size_t)(u * 2 + dir) * 16384;
#pragma unroll
      for (int m = 0; m < 2; ++m)
#pragma unroll
        for (int j = 0; j < 8; ++j)
#pragma unroll
          for (int e = 0; e < 4; ++e) Dd[(wave * 32 + m * 16 + lq * 4 + e) * 128 + j * 16 + lr] = f2bf(acc[m][j][e]);
    }
    {
      const int dir = tid >> 7, k = tid & 127;
      const float* e = dir ? eb : ef;
      float sacc = 0.f;
      for (int t = 0; t < 128; ++t) sacc += e[t] * bf2f(Ks[t * VLD + k]);
      p.ND[(size_t)(u * 2 + dir) * 128 + k] = sacc;
    }
    if (tid < 4) p.SC[(size_t)(u * 2 + (tid >> 1)) * 32 + (tid & 1)] = scal[tid];
    __syncthreads();
  }
}

__device__ __forceinline__ void ph4_scan(const P& p, int bid, int nb) {
  const int tid = threadIdx.x & 255;
  for (int it = bid; it < 1024; it += nb) {
    const int combo = it >> 4, vblk = it & 15;
    const int b = combo >> 3, h = (combo >> 1) & 3, dir = combo & 1;
    const int v = vblk * 8 + (tid >> 5), k0 = (tid & 31) * 4;
    float C0 = 0.f, C1 = 0.f, C2 = 0.f, C3 = 0.f, nacc = 0.f, m = 0.f;
    for (int i = 0; i < 18; ++i) {
      int u;
      if (i < 2) { const int cc = dir == 0 ? i : 1 - i; u = 512 + b * 8 + cc * 4 + h; }
      else {
        const int lc = i - 2, c = dir == 0 ? lc : 15 - lc;
        u = b * 64 + c * 4 + h;
        const size_t ci = (size_t)u * 2 + dir;
        uint2 o;
        o.x = (unsigned)f2bf(C0) | ((unsigned)f2bf(C1) << 16);
        o.y = (unsigned)f2bf(C2) | ((unsigned)f2bf(C3) << 16);
        *(uint2*)(p.CIN + ci * 16384 + v * 128 + k0) = o;
        if (vblk == 0 && tid < 128) p.NIN[ci * 128 + tid] = nacc;
        if (vblk == 0 && tid == 0) p.MIN_[ci * 32] = m;
      }
      const size_t di = (size_t)u * 2 + dir;
      const float G = p.SC[di * 32 + 0], bend = p.SC[di * 32 + 1];
      const float Mx = fmaxf(m, G);
      const float dec = __expf(m - Mx), inj = __expf(G - Mx);
      const uint2 d2 = *(const uint2*)(p.Dst + di * 16384 + v * 128 + k0);
      C0 = dec * C0 + inj * __uint_as_float(d2.x << 16);
      C1 = dec * C1 + inj * __uint_as_float(d2.x & 0xffff0000u);
      C2 = dec * C2 + inj * __uint_as_float(d2.y << 16);
      C3 = dec * C3 + inj * __uint_as_float(d2.y & 0xffff0000u);
      if (vblk == 0 && tid < 128) nacc = dec * nacc + inj * p.ND[di * 128 + tid];
      m = bend + Mx;
    }
  }
}

__device__ __forceinline__ void ph5_mlstm_out(const P& p, int bid, int nb, char* smem) {
  bf16_t* Vs = (bf16_t*)smem;
  bf16_t* Pw = Vs + 128 * VLD;
  float* fa = (float*)(Pw + 4 * 16 * VLD);
  float *igf = fa, *lff = fa + 128, *igb = fa + 256, *lfb = fa + 384, *gf = fa + 512, *gb = fa + 640, *bfw = fa + 768, *bbw = fa + 896,
        *pmf = fa + 1024, *pmb = fa + 1152, *nq = fa + 1280  ;
  const int tid = threadIdx.x & 255, lane = tid & 63, wave = tid >> 6, lr = lane & 15, lq = lane >> 4;
  const int trips5 = (1536 + nb - 1) / nb;
  for (int k5 = 0; k5 < trips5; ++k5) {
    const int it = (bid + k5 * nb) % 1536;
    if (it < 512) {
      const int u = it;
      const UnitInfo ui = decode_unit(u);
      const int h = ui.h;
      const size_t cif = (size_t)u * 2, cib = (size_t)u * 2 + 1;
      if (tid < 128) {
        const float* g = p.gates + (size_t)(ui.row0 + tid) * 16;
        igf[tid] = g[h] + p.b_gates[h];
        lff[tid] = logsig_f(g[4 + h] + p.b_gates[4 + h]);
        igb[tid] = g[8 + h] + p.b_gates[8 + h];
        lfb[tid] = logsig_f(g[12 + h] + p.b_gates[12 + h]);
      }
      {
        const int dch = tid & 15;
#pragma unroll
        for (int i = 0; i < 8; ++i) {
          const int t = (tid >> 4) + i * 16;
          *(u32x4*)(Vs + t * VLD + dch * 8) = *(const u32x4*)(p.pl + (size_t)(ui.row0 + t) * LDP + 1024 + h * 128 + dch * 8);
        }
      }
      {
        const int dir = tid >> 7, t = tid & 127;
        const u32x4* qr = (const u32x4*)(p.hn + (size_t)(ui.row0 + t) * 1024 + h * 128);
        const float* nin = p.NIN + (dir ? cib : cif) * 128;
        float sacc = 0.f;
#pragma unroll 4
        for (int c8 = 0; c8 < 16; ++c8) {
          const u32x4 qv = qr[c8];
#pragma unroll
          for (int q = 0; q < 4; ++q) sacc += blo(qv[q]) * nin[c8 * 8 + 2 * q] + bhi(qv[q]) * nin[c8 * 8 + 2 * q + 1];
        }
        nq[dir * 128 + t] = sacc;
      }
      __syncthreads();
      if (wave == 0) { float G, bt; scan128<false>(lff, igf, bfw, gf, pmf, G, bt, lane); }
      else if (wave == 1) { float G, bt; scan128<true>(lfb, igb, bbw, gb, pmb, G, bt, lane); }
      __syncthreads();
      const float minf_ = p.MIN_[cif * 32], minb_ = p.MIN_[cib * 32];
      bf16_t* Pme = Pw + wave * 16 * VLD;
      const __amdgpu_buffer_rsrc_t r_hn = mk_rsrc(p.hn), r_cin = mk_rsrc(p.CIN);
      const int fvoff = (lr * 1024 + lq * 8) * 2, cvoff = (lr * 128 + lq * 8) * 2;
#pragma unroll 1
      for (int m = 0; m < 2; ++m) {
        const int t0 = wave * 32 + m * 16;
        bf16x8 Qf[4];
#pragma unroll
        for (int kk = 0; kk < 4; ++kk) Qf[kk] = bload8(r_hn, fvoff + kk * 64, ((ui.row0 + t0) * 1024 + h * 128) * 2);
        f32x4 S[8];
#pragma unroll
        for (int j = 0; j < 8; ++j) {
          S[j] = (f32x4){0.f, 0.f, 0.f, 0.f};
#pragma unroll
          for (int kk = 0; kk < 4; ++kk) {
            const bf16x8 kf = bload8(r_hn, fvoff + kk * 64, ((ui.row0 + j * 16) * 1024 + 512 + h * 128) * 2);
            S[j] = __builtin_amdgcn_mfma_f32_16x16x32_bf16(Qf[kk], kf, S[j], 0, 0, 0);
          }
          if (j & 1) __builtin_amdgcn_sched_barrier(0);
        }
        f32x4 hsum[8];
#pragma unroll 1
        for (int dir = 0; dir < 2; ++dir) {
          const float mi = dir ? minb_ : minf_;
          const float* gg = dir ? gb : gf;
          const float* pmx = dir ? pmb : pmf;
          const float* bw = dir ? bbw : bfw;
          float Mrow[4], wi[4];
#pragma unroll
          for (int e = 0; e < 4; ++e) { Mrow[e] = fmaxf(mi, pmx[t0 + lq * 4 + e]); wi[e] = __expf(mi - Mrow[e]); }
          f32x4 acc[8];
#pragma unroll
          for (int jv = 0; jv < 8; ++jv) {
            acc[jv] = (f32x4){0.f, 0.f, 0.f, 0.f};
#pragma unroll
            for (int kk = 0; kk < 4; ++kk) {
              const bf16x8 cf = bload8(r_cin, cvoff + kk * 64, (int)((dir ? cib : cif) * 32768) + jv * 4096);
              acc[jv] = __builtin_amdgcn_mfma_f32_16x16x32_bf16(Qf[kk], cf, acc[jv], 0, 0, 0);
            }
#pragma unroll
            for (int e = 0; e < 4; ++e) acc[jv][e] *= wi[e];
            if (jv & 1) __builtin_amdgcn_sched_barrier(0);
          }
          float rs[4] = {0.f, 0.f, 0.f, 0.f};
#pragma unroll
          for (int j = 0; j < 8; ++j) {
            const int sidx = j * 16 + lr;
            const float gs = gg[sidx];
#pragma unroll
            for (int e = 0; e < 4; ++e) {
              const int t = t0 + lq * 4 + e;
              const bool keep = dir ? (sidx >= t) : (sidx <= t);
              const float pv = keep ? S[j][e] * __expf(gs - Mrow[e]) : 0.f;
              rs[e] += pv;
              Pme[(lq * 4 + e) * VLD + sidx] = f2bf(pv);
            }
          }
          float den[4];
#pragma unroll
          for (int e = 0; e < 4; ++e) {
            float r = rs[e];
            r += __shfl_xor(r, 1); r += __shfl_xor(r, 2); r += __shfl_xor(r, 4); r += __shfl_xor(r, 8);
            const int t = t0 + lq * 4 + e;
            const float dd = r + wi[e] * nq[dir * 128 + t];
            den[e] = fmaxf(fabsf(dd), __expf(-(bw[t] + Mrow[e])));
          }
          asm volatile("s_waitcnt lgkmcnt(0)" ::: "memory");
          __builtin_amdgcn_wave_barrier();
#pragma unroll
          for (int kk = 0; kk < 4; ++kk) {
            const bf16x8 pf = *(const bf16x8*)(Pme + lr * VLD + kk * 32 + lq * 8);
#pragma unroll
            for (int jv = 0; jv < 8; ++jv) {
              const bf16x8 vf = frag_tr(Vs, VLD, kk * 32, jv * 16, lr, lq);
              acc[jv] = __builtin_amdgcn_mfma_f32_16x16x32_bf16(pf, vf, acc[jv], 0, 0, 0);
            }
          }
          __builtin_amdgcn_wave_barrier();
#pragma unroll
          for (int jv = 0; jv < 8; ++jv)
#pragma unroll
            for (int e = 0; e < 4; ++e) {
              const float hv = acc[jv][e] / den[e];
              if (dir == 0) hsum[jv][e] = hv; else hsum[jv][e] += hv;
            }
        }
#pragma unroll
        for (int e = 0; e < 4; ++e) {
          float sm = 0.f;
#pragma unroll
          for (int jv = 0; jv < 8; ++jv) sm += hsum[jv][e];
          sm += __shfl_xor(sm, 1); sm += __shfl_xor(sm, 2); sm += __shfl_xor(sm, 4); sm += __shfl_xor(sm, 8);
          const float mu = sm * (1.f / 128.f);
          float vs = 0.f;
#pragma unroll
          for (int jv = 0; jv < 8; ++jv) { const float d = hsum[jv][e] - mu; vs += d * d; }
          vs += __shfl_xor(vs, 1); vs += __shfl_xor(vs, 2); vs += __shfl_xor(vs, 4); vs += __shfl_xor(vs, 8);
          const float rstd = rsqrtf(vs * (1.f / 128.f) + 1e-6f);
          const bf16_t* op = p.pl + (size_t)(ui.row0 + t0 + lq * 4 + e) * LDP + 1536 + h * 128;
          bf16_t* mp = p.mix + (size_t)(ui.row0 + t0 + lq * 4 + e) * 1024 + h * 128;
#pragma unroll
          for (int jv = 0; jv < 8; ++jv) {
            const int v = jv * 16 + lr;
            const float o = bf2f(op[v]);
            mp[v] = f2bf((hsum[jv][e] - mu) * rstd * p.head_norm_w[h * 128 + v] / (1.f + __expf(-o)));
          }
        }
      }
      __syncthreads();
    } else {
      const int pu = it - 512, grp = pu >> 2, g = pu & 3;
      float* us = (float*)smem;
      bf16_t* db = (bf16_t*)(us + 8192);
      const int w = 2 << g;
      const size_t rbase = (size_t)grp * 64;
      for (int idx = tid; idx < 1024; idx += NTHR) {
        const int t = idx >> 4, ch = idx & 15;
        const u32x4 r = *(const u32x4*)(p.pl + (rbase + t) * LDP + 2048 + g * 128 + ch * 8);
        float* d = us + t * 128 + ch * 8;
#pragma unroll
        for (int q = 0; q < 4; ++q) { d[2 * q] = blo(r[q]); d[2 * q + 1] = bhi(r[q]); }
      }
      __syncthreads();
      for (int idx = tid; idx < 8192; idx += NTHR) {
        const int t = idx >> 7, i = idx & 127;
        int lo = t - w / 2, hi = t - w / 2 + w;
        lo = lo < 0 ? 0 : lo; hi = hi > 64 ? 64 : hi;
        float sacc = 0.f;
        for (int j = lo; j < hi; ++j) sacc += us[j * 128 + i];
        db[t * VLD + i] = f2bf(sacc / (float)(hi - lo) - us[idx]);
      }
      __syncthreads();
      {
        const bf16_t* wt = (const bf16_t*)((const char*)p.keys_bf + 524288) + g * 16384;
        bf16x8 af[4];
#pragma unroll
        for (int kk = 0; kk < 4; ++kk) af[kk] = *(const bf16x8*)(db + (wave * 16 + lr) * VLD + kk * 32 + lq * 8);
#pragma unroll
        for (int j = 0; j < 8; ++j) {
          f32x4 acc = (f32x4){0.f, 0.f, 0.f, 0.f};
#pragma unroll
          for (int kk = 0; kk < 4; ++kk) {
            const bf16x8 bfr = *(const bf16x8*)(wt + (j * 16 + lr) * 128 + kk * 32 + lq * 8);
            acc = __builtin_amdgcn_mfma_f32_16x16x32_bf16(af[kk], bfr, acc, 0, 0, 0);
          }
          const float ps = p.pool_scale[g * 128 + j * 16 + lr];
#pragma unroll
          for (int e = 0; e < 4; ++e) p.mix[(rbase + wave * 16 + lq * 4 + e) * 1024 + 512 + g * 128 + j * 16 + lr] = f2bf(acc[e] * ps);
        }
      }
      __syncthreads();
    }
  }
}

#define SORT16(X) do { unsigned h_, l_; h_ = X[0] > X[1] ? X[0] : X[1]; l_ = X[0] > X[1] ? X[1] : X[0]; X[0] = h_; X[1] = l_; h_ = X[3] > X[2] ? X[3] : X[2]; l_ = X[3] > X[2] ? X[2] : X[3]; X[3] = h_; X[2] = l_; h_ = X[4] > X[5] ? X[4] : X[5]; l_ = X[4] > X[5] ? X[5] : X[4]; X[4] = h_; X[5] = l_; h_ = X[7] > X[6] ? X[7] : X[6]; l_ = X[7] > X[6] ? X[6] : X[7]; X[7] = h_; X[6] = l_; h_ = X[8] > X[9] ? X[8] : X[9]; l_ = X[8] > X[9] ? X[9] : X[8]; X[8] = h_; X[9] = l_; h_ = X[11] > X[10] ? X[11] : X[10]; l_ = X[11] > X[10] ? X[10] : X[11]; X[11] = h_; X[10] = l_; h_ = X[12] > X[13] ? X[12] : X[13]; l_ = X[12] > X[13] ? X[13] : X[12]; X[12] = h_; X[13] = l_; h_ = X[15] > X[14] ? X[15] : X[14]; l_ = X[15] > X[14] ? X[14] : X[15]; X[15] = h_; X[14] = l_; h_ = X[0] > X[2] ? X[0] : X[2]; l_ = X[0] > X[2] ? X[2] : X[0]; X[0] = h_; X[2] = l_; h_ = X[1] > X[3] ? X[1] : X[3]; l_ = X[1] > X[3] ? X[3] : X[1]; X[1] = h_; X[3] = l_; h_ = X[6] > X[4] ? X[6] : X[4]; l_ = X[6] > X[4] ? X[4] : X[6]; X[6] = h_; X[4] = l_; h_ = X[7] > X[5] ? X[7] : X[5]; l_ = X[7] > X[5] ? X[5] : X[7]; X[7] = h_; X[5] = l_; h_ = X[8] > X[10] ? X[8] : X[10]; l_ = X[8] > X[10] ? X[10] : X[8]; X[8] = h_; X[10] = l_; h_ = X[9] > X[11] ? X[9] : X[11]; l_ = X[9] > X[11] ? X[11] : X[9]; X[9] = h_; X[11] = l_; h_ = X[14] > X[12] ? X[14] : X[12]; l_ = X[14] > X[12] ? X[12] : X[14]; X[14] = h_; X[12] = l_; h_ = X[15] > X[13] ? X[15] : X[13]; l_ = X[15] > X[13] ? X[13] : X[15]; X[15] = h_; X[13] = l_; h_ = X[0] > X[1] ? X[0] : X[1]; l_ = X[0] > X[1] ? X[1] : X[0]; X[0] = h_; X[1] = l_; h_ = X[2] > X[3] ? X[2] : X[3]; l_ = X[2] > X[3] ? X[3] : X[2]; X[2] = h_; X[3] = l_; h_ = X[5] > X[4] ? X[5] : X[4]; l_ = X[5] > X[4] ? X[4] : X[5]; X[5] = h_; X[4] = l_; h_ = X[7] > X[6] ? X[7] : X[6]; l_ = X[7] > X[6] ? X[6] : X[7]; X[7] = h_; X[6] = l_; h_ = X[8] > X[9] ? X[8] : X[9]; l_ = X[8] > X[9] ? X[9] : X[8]; X[8] = h_; X[9] = l_; h_ = X[10] > X[11] ? X[10] : X[11]; l_ = X[10] > X[11] ? X[11] : X[10]; X[10] = h_; X[11] = l_; h_ = X[13] > X[12] ? X[13] : X[12]; l_ = X[13] > X[12] ? X[12] : X[13]; X[13] = h_; X[12] = l_; h_ = X[15] > X[14] ? X[15] : X[14]; l_ = X[15] > X[14] ? X[14] : X[15]; X[15] = h_; X[14] = l_; h_ = X[0] > X[4] ? X[0] : X[4]; l_ = X[0] > X[4] ? X[4] : X[0]; X[0] = h_; X[4] = l_; h_ = X[1] > X[5] ? X[1] : X[5]; l_ = X[1] > X[5] ? X[5] : X[1]; X[1] = h_; X[5] = l_; h_ = X[2] > X[6] ? X[2] : X[6]; l_ = X[2] > X[6] ? X[6] : X[2]; X[2] = h_; X[6] = l_; h_ = X[3] > X[7] ? X[3] : X[7]; l_ = X[3] > X[7] ? X[7] : X[3]; X[3] = h_; X[7] = l_; h_ = X[12] > X[8] ? X[12] : X[8]; l_ = X[12] > X[8] ? X[8] : X[12]; X[12] = h_; X[8] = l_; h_ = X[13] > X[9] ? X[13] : X[9]; l_ = X[13] > X[9] ? X[9] : X[13]; X[13] = h_; X[9] = l_; h_ = X[14] > X[10] ? X[14] : X[10]; l_ = X[14] > X[10] ? X[10] : X[14]; X[14] = h_; X[10] = l_; h_ = X[15] > X[11] ? X[15] : X[11]; l_ = X[15] > X[11] ? X[11] : X[15]; X[15] = h_; X[11] = l_; h_ = X[0] > X[2] ? X[0] : X[2]; l_ = X[0] > X[2] ? X[2] : X[0]; X[0] = h_; X[2] = l_; h_ = X[1] > X[3] ? X[1] : X[3]; l_ = X[1] > X[3] ? X[3] : X[1]; X[1] = h_; X[3] = l_; h_ = X[4] > X[6] ? X[4] : X[6]; l_ = X[4] > X[6] ? X[6] : X[4]; X[4] = h_; X[6] = l_; h_ = X[5] > X[7] ? X[5] : X[7]; l_ = X[5] > X[7] ? X[7] : X[5]; X[5] = h_; X[7] = l_; h_ = X[10] > X[8] ? X[10] : X[8]; l_ = X[10] > X[8] ? X[8] : X[10]; X[10] = h_; X[8] = l_; h_ = X[11] > X[9] ? X[11] : X[9]; l_ = X[11] > X[9] ? X[9] : X[11]; X[11] = h_; X[9] = l_; h_ = X[14] > X[12] ? X[14] : X[12]; l_ = X[14] > X[12] ? X[12] : X[14]; X[14] = h_; X[12] = l_; h_ = X[15] > X[13] ? X[15] : X[13]; l_ = X[15] > X[13] ? X[13] : X[15]; X[15] = h_; X[13] = l_; h_ = X[0] > X[1] ? X[0] : X[1]; l_ = X[0] > X[1] ? X[1] : X[0]; X[0] = h_; X[1] = l_; h_ = X[2] > X[3] ? X[2] : X[3]; l_ = X[2] > X[3] ? X[3] : X[2]; X[2] = h_; X[3] = l_; h_ = X[4] > X[5] ? X[4] : X[5]; l_ = X[4] > X[5] ? X[5] : X[4]; X[4] = h_; X[5] = l_; h_ = X[6] > X[7] ? X[6] : X[7]; l_ = X[6] > X[7] ? X[7] : X[6]; X[6] = h_; X[7] = l_; h_ = X[9] > X[8] ? X[9] : X[8]; l_ = X[9] > X[8] ? X[8] : X[9]; X[9] = h_; X[8] = l_; h_ = X[11] > X[10] ? X[11] : X[10]; l_ = X[11] > X[10] ? X[10] : X[11]; X[11] = h_; X[10] = l_; h_ = X[13] > X[12] ? X[13] : X[12]; l_ = X[13] > X[12] ? X[12] : X[13]; X[13] = h_; X[12] = l_; h_ = X[15] > X[14] ? X[15] : X[14]; l_ = X[15] > X[14] ? X[14] : X[15]; X[15] = h_; X[14] = l_; h_ = X[0] > X[8] ? X[0] : X[8]; l_ = X[0] > X[8] ? X[8] : X[0]; X[0] = h_; X[8] = l_; h_ = X[1] > X[9] ? X[1] : X[9]; l_ = X[1] > X[9] ? X[9] : X[1]; X[1] = h_; X[9] = l_; h_ = X[2] > X[10] ? X[2] : X[10]; l_ = X[2] > X[10] ? X[10] : X[2]; X[2] = h_; X[10] = l_; h_ = X[3] > X[11] ? X[3] : X[11]; l_ = X[3] > X[11] ? X[11] : X[3]; X[3] = h_; X[11] = l_; h_ = X[4] > X[12] ? X[4] : X[12]; l_ = X[4] > X[12] ? X[12] : X[4]; X[4] = h_; X[12] = l_; h_ = X[5] > X[13] ? X[5] : X[13]; l_ = X[5] > X[13] ? X[13] : X[5]; X[5] = h_; X[13] = l_; h_ = X[6] > X[14] ? X[6] : X[14]; l_ = X[6] > X[14] ? X[14] : X[6]; X[6] = h_; X[14] = l_; h_ = X[7] > X[15] ? X[7] : X[15]; l_ = X[7] > X[15] ? X[15] : X[7]; X[7] = h_; X[15] = l_; h_ = X[0] > X[4] ? X[0] : X[4]; l_ = X[0] > X[4] ? X[4] : X[0]; X[0] = h_; X[4] = l_; h_ = X[1] > X[5] ? X[1] : X[5]; l_ = X[1] > X[5] ? X[5] : X[1]; X[1] = h_; X[5] = l_; h_ = X[2] > X[6] ? X[2] : X[6]; l_ = X[2] > X[6] ? X[6] : X[2]; X[2] = h_; X[6] = l_; h_ = X[3] > X[7] ? X[3] : X[7]; l_ = X[3] > X[7] ? X[7] : X[3]; X[3] = h_; X[7] = l_; h_ = X[8] > X[12] ? X[8] : X[12]; l_ = X[8] > X[12] ? X[12] : X[8]; X[8] = h_; X[12] = l_; h_ = X[9] > X[13] ? X[9] : X[13]; l_ = X[9] > X[13] ? X[13] : X[9]; X[9] = h_; X[13] = l_; h_ = X[10] > X[14] ? X[10] : X[14]; l_ = X[10] > X[14] ? X[14] : X[10]; X[10] = h_; X[14] = l_; h_ = X[11] > X[15] ? X[11] : X[15]; l_ = X[11] > X[15] ? X[15] : X[11]; X[11] = h_; X[15] = l_; h_ = X[0] > X[2] ? X[0] : X[2]; l_ = X[0] > X[2] ? X[2] : X[0]; X[0] = h_; X[2] = l_; h_ = X[1] > X[3] ? X[1] : X[3]; l_ = X[1] > X[3] ? X[3] : X[1]; X[1] = h_; X[3] = l_; h_ = X[4] > X[6] ? X[4] : X[6]; l_ = X[4] > X[6] ? X[6] : X[4]; X[4] = h_; X[6] = l_; h_ = X[5] > X[7] ? X[5] : X[7]; l_ = X[5] > X[7] ? X[7] : X[5]; X[5] = h_; X[7] = l_; h_ = X[8] > X[10] ? X[8] : X[10]; l_ = X[8] > X[10] ? X[10] : X[8]; X[8] = h_; X[10] = l_; h_ = X[9] > X[11] ? X[9] : X[11]; l_ = X[9] > X[11] ? X[11] : X[9]; X[9] = h_; X[11] = l_; h_ = X[12] > X[14] ? X[12] : X[14]; l_ = X[12] > X[14] ? X[14] : X[12]; X[12] = h_; X[14] = l_; h_ = X[13] > X[15] ? X[13] : X[15]; l_ = X[13] > X[15] ? X[15] : X[13]; X[13] = h_; X[15] = l_; h_ = X[0] > X[1] ? X[0] : X[1]; l_ = X[0] > X[1] ? X[1] : X[0]; X[0] = h_; X[1] = l_; h_ = X[2] > X[3] ? X[2] : X[3]; l_ = X[2] > X[3] ? X[3] : X[2]; X[2] = h_; X[3] = l_; h_ = X[4] > X[5] ? X[4] : X[5]; l_ = X[4] > X[5] ? X[5] : X[4]; X[4] = h_; X[5] = l_; h_ = X[6] > X[7] ? X[6] : X[7]; l_ = X[6] > X[7] ? X[7] : X[6]; X[6] = h_; X[7] = l_; h_ = X[8] > X[9] ? X[8] : X[9]; l_ = X[8] > X[9] ? X[9] : X[8]; X[8] = h_; X[9] = l_; h_ = X[10] > X[11] ? X[10] : X[11]; l_ = X[10] > X[11] ? X[11] : X[10]; X[10] = h_; X[11] = l_; h_ = X[12] > X[13] ? X[12] : X[13]; l_ = X[12] > X[13] ? X[13] : X[12]; X[12] = h_; X[13] = l_; h_ = X[14] > X[15] ? X[14] : X[15]; l_ = X[14] > X[15] ? X[15] : X[14]; X[14] = h_; X[15] = l_; } while (0)
#define MERGE16(X) do { unsigned h_, l_; h_ = X[0] > X[8] ? X[0] : X[8]; l_ = X[0] > X[8] ? X[8] : X[0]; X[0] = h_; X[8] = l_; h_ = X[1] > X[9] ? X[1] : X[9]; l_ = X[1] > X[9] ? X[9] : X[1]; X[1] = h_; X[9] = l_; h_ = X[2] > X[10] ? X[2] : X[10]; l_ = X[2] > X[10] ? X[10] : X[2]; X[2] = h_; X[10] = l_; h_ = X[3] > X[11] ? X[3] : X[11]; l_ = X[3] > X[11] ? X[11] : X[3]; X[3] = h_; X[11] = l_; h_ = X[4] > X[12] ? X[4] : X[12]; l_ = X[4] > X[12] ? X[12] : X[4]; X[4] = h_; X[12] = l_; h_ = X[5] > X[13] ? X[5] : X[13]; l_ = X[5] > X[13] ? X[13] : X[5]; X[5] = h_; X[13] = l_; h_ = X[6] > X[14] ? X[6] : X[14]; l_ = X[6] > X[14] ? X[14] : X[6]; X[6] = h_; X[14] = l_; h_ = X[7] > X[15] ? X[7] : X[15]; l_ = X[7] > X[15] ? X[15] : X[7]; X[7] = h_; X[15] = l_; h_ = X[0] > X[4] ? X[0] : X[4]; l_ = X[0] > X[4] ? X[4] : X[0]; X[0] = h_; X[4] = l_; h_ = X[1] > X[5] ? X[1] : X[5]; l_ = X[1] > X[5] ? X[5] : X[1]; X[1] = h_; X[5] = l_; h_ = X[2] > X[6] ? X[2] : X[6]; l_ = X[2] > X[6] ? X[6] : X[2]; X[2] = h_; X[6] = l_; h_ = X[3] > X[7] ? X[3] : X[7]; l_ = X[3] > X[7] ? X[7] : X[3]; X[3] = h_; X[7] = l_; h_ = X[8] > X[12] ? X[8] : X[12]; l_ = X[8] > X[12] ? X[12] : X[8]; X[8] = h_; X[12] = l_; h_ = X[9] > X[13] ? X[9] : X[13]; l_ = X[9] > X[13] ? X[13] : X[9]; X[9] = h_; X[13] = l_; h_ = X[10] > X[14] ? X[10] : X[14]; l_ = X[10] > X[14] ? X[14] : X[10]; X[10] = h_; X[14] = l_; h_ = X[11] > X[15] ? X[11] : X[15]; l_ = X[11] > X[15] ? X[15] : X[11]; X[11] = h_; X[15] = l_; h_ = X[0] > X[2] ? X[0] : X[2]; l_ = X[0] > X[2] ? X[2] : X[0]; X[0] = h_; X[2] = l_; h_ = X[1] > X[3] ? X[1] : X[3]; l_ = X[1] > X[3] ? X[3] : X[1]; X[1] = h_; X[3] = l_; h_ = X[4] > X[6] ? X[4] : X[6]; l_ = X[4] > X[6] ? X[6] : X[4]; X[4] = h_; X[6] = l_; h_ = X[5] > X[7] ? X[5] : X[7]; l_ = X[5] > X[7] ? X[7] : X[5]; X[5] = h_; X[7] = l_; h_ = X[8] > X[10] ? X[8] : X[10]; l_ = X[8] > X[10] ? X[10] : X[8]; X[8] = h_; X[10] = l_; h_ = X[9] > X[11] ? X[9] : X[11]; l_ = X[9] > X[11] ? X[11] : X[9]; X[9] = h_; X[11] = l_; h_ = X[12] > X[14] ? X[12] : X[14]; l_ = X[12] > X[14] ? X[14] : X[12]; X[12] = h_; X[14] = l_; h_ = X[13] > X[15] ? X[13] : X[15]; l_ = X[13] > X[15] ? X[15] : X[13]; X[13] = h_; X[15] = l_; h_ = X[0] > X[1] ? X[0] : X[1]; l_ = X[0] > X[1] ? X[1] : X[0]; X[0] = h_; X[1] = l_; h_ = X[2] > X[3] ? X[2] : X[3]; l_ = X[2] > X[3] ? X[3] : X[2]; X[2] = h_; X[3] = l_; h_ = X[4] > X[5] ? X[4] : X[5]; l_ = X[4] > X[5] ? X[5] : X[4]; X[4] = h_; X[5] = l_; h_ = X[6] > X[7] ? X[6] : X[7]; l_ = X[6] > X[7] ? X[7] : X[6]; X[6] = h_; X[7] = l_; h_ = X[8] > X[9] ? X[8] : X[9]; l_ = X[8] > X[9] ? X[9] : X[8]; X[8] = h_; X[9] = l_; h_ = X[10] > X[11] ? X[10] : X[11]; l_ = X[10] > X[11] ? X[11] : X[10]; X[10] = h_; X[11] = l_; h_ = X[12] > X[13] ? X[12] : X[13]; l_ = X[12] > X[13] ? X[13] : X[12]; X[12] = h_; X[13] = l_; h_ = X[14] > X[15] ? X[14] : X[15]; l_ = X[14] > X[15] ? X[15] : X[14]; X[14] = h_; X[15] = l_; } while (0)

__device__ __forceinline__ unsigned f2ord(float f) { const unsigned u = __float_as_uint(f); return (u & 0x80000000u) ? ~u : (u | 0x80000000u); }
__device__ __forceinline__ float ord2f(unsigned o) { return __uint_as_float((o & 0x80000000u) ? (o & 0x7fffffffu) : ~o); }
#define CANDKEY(sum, c) ((f2ord(sum) & ~255u) | (255u - (unsigned)(c)))
__device__ __forceinline__ void xmerge16(unsigned (&X)[16], int mask) {
  unsigned T[16];
#pragma unroll
  for (int i = 0; i < 16; ++i) T[i] = (unsigned)__shfl_xor((int)X[15 - i], mask);
#pragma unroll
  for (int i = 0; i < 16; ++i) X[i] = X[i] > T[i] ? X[i] : T[i];
  MERGE16(X);
}

__device__ __forceinline__ void ph9_topk(const P& p, int bid, int nb, char* smem) {
  const int tid = threadIdx.x & 255, lane = tid & 63, wave = tid >> 6, lr = lane & 15, lq = lane >> 4;
  int* idxs = (int*)smem + wave * 512;
  const int gw = bid * 4 + wave, ngw = nb * 4;
  const __amdgpu_buffer_rsrc_t r_q = mk_rsrc(p.qb), r_k = mk_rsrc(p.keys_bf);
  for (int it = gw; it < 1024 * 8; it += ngw) {
    const int h = it & 7, tile = it >> 3;
    const int tok = tile * 16 + lr;
    unsigned R0[16], R1[16];
#pragma unroll
    for (int pp = 0; pp < 2; ++pp) {
      bf16x8 bq[4];
#pragma unroll
      for (int kk = 0; kk < 4; ++kk) bq[kk] = bload8(r_q, (lr * 2048 + lq * 8) * 2 + kk * 64, (tile * 16 * 2048 + h * 256 + pp * 128) * 2);
      f32x4 acc[8];
#pragma unroll
      for (int j = 0; j < 8; ++j) acc[j] = (f32x4){0.f, 0.f, 0.f, 0.f};
#pragma unroll
      for (int j = 0; j < 8; ++j)
#pragma unroll
        for (int kk = 0; kk < 4; ++kk) {
          const bf16x8 a = bload8(r_k, (lr * 128 + lq * 8) * 2 + kk * 64, ((h * 2 + pp) * 16384 + j * 2048) * 2);
          acc[j] = __builtin_amdgcn_mfma_f32_16x16x32_bf16(a, bq[kk], acc[j], 0, 0, 0);
        }
      unsigned X[16], Y[16];
#pragma unroll
      for (int j = 0; j < 4; ++j)
#pragma unroll
        for (int e = 0; e < 4; ++e) {
          X[j * 4 + e] = (f2ord(acc[j][e]) & ~127u) | (127u - (unsigned)(j * 16 + lq * 4 + e));
          Y[j * 4 + e] = (f2ord(acc[4 + j][e]) & ~127u) | (127u - (unsigned)((4 + j) * 16 + lq * 4 + e));
        }
      SORT16(X);
      SORT16(Y);
#pragma unroll
      for (int i = 0; i < 16; ++i) X[i] = X[i] > Y[15 - i] ? X[i] : Y[15 - i];
      MERGE16(X);
      xmerge16(X, 16);
      xmerge16(X, 32);
#pragma unroll
      for (int i = 0; i < 16; ++i) { if (pp == 0) R0[i] = X[i]; else R1[i] = X[i]; }
    }
    if (lq == 0) {
#pragma unroll
      for (int i = 0; i < 16; ++i) { idxs[lr * 32 + i] = 127 - (int)(R0[i] & 127u); idxs[lr * 32 + 16 + i] = 127 - (int)(R1[i] & 127u); }
    }
    asm volatile("s_waitcnt lgkmcnt(0)" ::: "memory");
    float va[16], vb[16];
#pragma unroll
    for (int i = 0; i < 16; ++i) { va[i] = ord2f(R0[i] & ~127u); vb[i] = ord2f(R1[i] & ~127u); }
    unsigned F[16];
  F[0] = lq == 0 ? CANDKEY(va[0] + vb[0], 0) : (lq == 1 ? CANDKEY(va[1] + vb[0], 16) : (lq == 2 ? CANDKEY(va[3] + vb[0], 48) : CANDKEY(va[13] + vb[0], 208)));
  F[1] = lq == 0 ? CANDKEY(va[0] + vb[1], 1) : (lq == 1 ? CANDKEY(va[1] + vb[1], 17) : (lq == 2 ? CANDKEY(va[3] + vb[1], 49) : CANDKEY(va[14] + vb[0], 224)));
  F[2] = lq == 0 ? CANDKEY(va[0] + vb[2], 2) : (lq == 1 ? CANDKEY(va[1] + vb[2], 18) : (lq == 2 ? CANDKEY(va[3] + vb[2], 50) : CANDKEY(va[15] + vb[0], 240)));
  F[3] = lq == 0 ? CANDKEY(va[0] + vb[3], 3) : (lq == 1 ? CANDKEY(va[1] + vb[3], 19) : (lq == 2 ? CANDKEY(va[3] + vb[3], 51) : 0u));
  F[4] = lq == 0 ? CANDKEY(va[0] + vb[4], 4) : (lq == 1 ? CANDKEY(va[1] + vb[4], 20) : (lq == 2 ? CANDKEY(va[4] + vb[0], 64) : 0u));
  F[5] = lq == 0 ? CANDKEY(va[0] + vb[5], 5) : (lq == 1 ? CANDKEY(va[1] + vb[5], 21) : (lq == 2 ? CANDKEY(va[4] + vb[1], 65) : 0u));
  F[6] = lq == 0 ? CANDKEY(va[0] + vb[6], 6) : (lq == 1 ? CANDKEY(va[1] + vb[6], 22) : (lq == 2 ? CANDKEY(va[4] + vb[2], 66) : 0u));
  F[7] = lq == 0 ? CANDKEY(va[0] + vb[7], 7) : (lq == 1 ? CANDKEY(va[1] + vb[7], 23) : (lq == 2 ? CANDKEY(va[6] + vb[0], 96) : 0u));
  F[8] = lq == 0 ? CANDKEY(va[0] + vb[8], 8) : (lq == 1 ? CANDKEY(va[2] + vb[0], 32) : (lq == 2 ? CANDKEY(va[6] + vb[1], 97) : 0u));
  F[9] = lq == 0 ? CANDKEY(va[0] + vb[9], 9) : (lq == 1 ? CANDKEY(va[2] + vb[1], 33) : (lq == 2 ? CANDKEY(va[7] + vb[0], 112) : 0u));
  F[10] = lq == 0 ? CANDKEY(va[0] + vb[10], 10) : (lq == 1 ? CANDKEY(va[2] + vb[2], 34) : (lq == 2 ? CANDKEY(va[7] + vb[1], 113) : 0u));
  F[11] = lq == 0 ? CANDKEY(va[0] + vb[11], 11) : (lq == 1 ? CANDKEY(va[2] + vb[3], 35) : (lq == 2 ? CANDKEY(va[8] + vb[0], 128) : 0u));
  F[12] = lq == 0 ? CANDKEY(va[0] + vb[12], 12) : (lq == 1 ? CANDKEY(va[2] + vb[4], 36) : (lq == 2 ? CANDKEY(va[9] + vb[0], 144) : 0u));
  F[13] = lq == 0 ? CANDKEY(va[0] + vb[13], 13) : (lq == 1 ? CANDKEY(va[5] + vb[0], 80) : (lq == 2 ? CANDKEY(va[10] + vb[0], 160) : 0u));
  F[14] = lq == 0 ? CANDKEY(va[0] + vb[14], 14) : (lq == 1 ? CANDKEY(va[5] + vb[1], 81) : (lq == 2 ? CANDKEY(va[11] + vb[0], 176) : 0u));
  F[15] = lq == 0 ? CANDKEY(va[0] + vb[15], 15) : (lq == 1 ? 0u : (lq == 2 ? CANDKEY(va[12] + vb[0], 192) : 0u));

    SORT16(F);
    xmerge16(F, 16);
    xmerge16(F, 32);
    if (lq == 0) {
      float ev[16];
      const float mx = ord2f(F[0] & ~255u);
      float tot = 0.f;
#pragma unroll
      for (int r = 0; r < 16; ++r) { ev[r] = __expf(ord2f(F[r] & ~255u) - mx); tot += ev[r]; }
      const float inv = 1.f / tot;
      int ei[16];
#pragma unroll
      for (int r = 0; r < 16; ++r) {
        const int c = 255 - (int)(F[r] & 255u);
        ei[r] = idxs[lr * 32 + (c >> 4)] * 128 + idxs[lr * 32 + 16 + (c & 15)];
      }
      int* ep = p.eidx + (size_t)tok * 128 + h * 16;
      float* gp = p.gate + (size_t)tok * 128 + h * 16;
#pragma unroll
      for (int r = 0; r < 4; ++r) {
        *(u32x4*)(ep + r * 4) = (u32x4){(unsigned)ei[r * 4], (unsigned)ei[r * 4 + 1], (unsigned)ei[r * 4 + 2], (unsigned)ei[r * 4 + 3]};
        *(f32x4*)(gp + r * 4) = (f32x4){ev[r * 4] * inv, ev[r * 4 + 1] * inv, ev[r * 4 + 2] * inv, ev[r * 4 + 3] * inv};
      }
    }
  }
}

__device__ __forceinline__ void ph_convert_tables(const P& p, int bid, int nb) {
  const int wave = (threadIdx.x >> 6) & 3, lane = threadIdx.x & 63;
  for (int row = bid * 4 + wave; row < 32768; row += nb * 4) {
    const bool isu = row < 16384;
    const float* src = isu ? p.U + (size_t)row * 1024 : p.V + (size_t)(row - 16384) * 1024;
    unsigned char* dst = isu ? p.U8 + (size_t)row * 1024 : p.V8 + (size_t)(row - 16384) * 1024;
    const float sc = isu ? 512.f : 32.f;
#pragma unroll
    for (int j = 0; j < 4; ++j) {
      const f32x4 v = __builtin_nontemporal_load((const f32x4*)src + j * 64 + lane);
      int w = 0;
      w = __builtin_amdgcn_cvt_pk_fp8_f32(v.x * sc, v.y * sc, w, false);
      w = __builtin_amdgcn_cvt_pk_fp8_f32(v.z * sc, v.w * sc, w, true);
      *(int*)(dst + j * 256 + lane * 4) = w;
    }
  }
}

__device__ __forceinline__ float gelu_exact(float a) { return 0.5f * a * (1.f + erff(a * 0.70710678118654752f)); }

#define G_LOAD(buf, j, g_) do { const int g__ = (g_); const int er__ = (g__ & 8) ? e1s[j] : e0s[j]; \
    _Pragma("unroll") for (int k = 0; k < 8; ++k) { const int e__ = __builtin_amdgcn_readlane(er__, (g__ & 7) * 8 + k); \
      buf[k] = *((const u32x4*)(tab + (size_t)e__ * 1024) + lane); } } while (0)
#define G_COMPUTE_U(buf, j, g_) do { const int g__ = (g_); \
      float pp[8]; \
      _Pragma("unroll") for (int k = 0; k < 8; ++k) { \
        f32x2 ac = {0.f, 0.f}; \
        _Pragma("unroll") for (int d = 0; d < 4; ++d) { \
          ac = __builtin_amdgcn_cvt_pk_f32_fp8((int)buf[k][d], false) * x2[j][2 * d] + ac; \
          ac = __builtin_amdgcn_cvt_pk_f32_fp8((int)buf[k][d], true) * x2[j][2 * d + 1] + ac; } \
        pp[k] = ac.x + ac.y; } \
        \
      float q4[4], r2[2], tt; \
      _Pragma("unroll") for (int i = 0; i < 4; ++i) { const float sd = b5 ? pp[i] : pp[i + 4]; q4[i] = (b5 ? pp[i + 4] : pp[i]) + __shfl_xor(sd, 32); } \
      _Pragma("unroll") for (int i = 0; i < 2; ++i) { const float sd = b4 ? q4[i] : q4[i + 2]; r2[i] = (b4 ? q4[i + 2] : q4[i]) + __shfl_xor(sd, 16); } \
      { const float sd = b3 ? r2[0] : r2[1]; tt = (b3 ? r2[1] : r2[0]) + __shfl_xor(sd, 8); } \
      tt += __shfl_xor(tt, 4); tt += __shfl_xor(tt, 2); tt += __shfl_xor(tt, 1); \
      const float dv = __shfl(tt, (lane & 7) * 8); \
      if ((lane >> 3) == (g__ & 7)) { if (g__ & 8) a1[j] = dv; else a0[j] = dv; } } while (0)
#define G_COMPUTE_V(buf, j, g_) do { const int g__ = (g_); \
      const int wr__ = __float_as_int((g__ & 8) ? w1s[j] : w0s[j]); \
      _Pragma("unroll") for (int k = 0; k < 8; ++k) { \
        const float w__ = __int_as_float(__builtin_amdgcn_readlane(wr__, (g__ & 7) * 8 + k)); \
        const f32x2 ww = {w__, w__}; \
        _Pragma("unroll") for (int d = 0; d < 4; ++d) { \
          y2[j][2 * d] = __builtin_amdgcn_cvt_pk_f32_fp8((int)buf[k][d], false) * ww + y2[j][2 * d]; \
          y2[j][2 * d + 1] = __builtin_amdgcn_cvt_pk_f32_fp8((int)buf[k][d], true) * ww + y2[j][2 * d + 1]; } } } while (0)
#define G_SWEEP(COMP) do { \
    G_LOAD(A, 0, 0); G_LOAD(B, 1, 0); G_LOAD(C, 0, 1); \
    _Pragma("unroll 1") for (int g = 0; g < 16; g += 2) { \
      const int gn = g + 2 < 16 ? g + 2 : g;              \
      G_LOAD(D, 1, g + 1); COMP(A, 0, g); \
      G_LOAD(A, 0, gn); COMP(B, 1, g); \
      G_LOAD(B, 1, gn); COMP(C, 0, g + 1); \
      G_LOAD(C, 0, gn + 1); COMP(D, 1, g + 1); } } while (0)

__device__ __forceinline__ void ph10_gather(const P& p, int bid, int nb, char* smem) {
  const int wave = __builtin_amdgcn_readfirstlane((threadIdx.x >> 6) & 3), lane = threadIdx.x & 63;
  const bool b5 = lane & 32, b4 = lane & 16, b3 = lane & 8;
  int* se = (int*)(smem + wave * 1024);
  float* sg = (float*)(se + 128);
  for (int oct = bid * 4 + wave; oct < TL / 8; oct += nb * 4) {
#pragma unroll 1
    for (int grp = 0; grp < 4; ++grp) {
      const int tok0 = oct * 8 + grp * 2;
      int e0s[2], e1s[2];
      float g0s[2], g1s[2], a0[2], a1[2], w0s[2], w1s[2];
      f32x2 x2[2][8], y2[2][8];
#pragma unroll
      for (int j = 0; j < 2; ++j) {
        const int tok = tok0 + j;
        const int e0 = p.eidx[(size_t)tok * 128 + lane], e1 = p.eidx[(size_t)tok * 128 + 64 + lane];
        const float g0 = p.gate[(size_t)tok * 128 + lane], g1 = p.gate[(size_t)tok * 128 + 64 + lane];
        const int sl0 = e0 >> 10, sl1 = e1 >> 10;
        int base = 0, pos0 = 0, pos1 = 0;
#pragma unroll
        for (int sidx = 0; sidx < 16; ++sidx) {
          const unsigned long long m0 = __ballot(sl0 == sidx), m1 = __ballot(sl1 == sidx);
          const int c0 = __popcll(m0), c1 = __popcll(m1);
          const int r0 = __builtin_amdgcn_mbcnt_hi((unsigned)(m0 >> 32), __builtin_amdgcn_mbcnt_lo((unsigned)m0, 0u));
          const int r1 = __builtin_amdgcn_mbcnt_hi((unsigned)(m1 >> 32), __builtin_amdgcn_mbcnt_lo((unsigned)m1, 0u));
          if (sl0 == sidx) pos0 = base + r0;
          if (sl1 == sidx) pos1 = base + c0 + r1;
          base += c0 + c1;
        }
        asm volatile("s_waitcnt lgkmcnt(0)" ::: "memory");
        se[pos0] = e0; se[pos1] = e1; sg[pos0] = g0; sg[pos1] = g1;
        asm volatile("s_waitcnt lgkmcnt(0)" ::: "memory");
        e0s[j] = se[lane]; e1s[j] = se[64 + lane]; g0s[j] = sg[lane]; g1s[j] = sg[64 + lane];
        asm volatile("s_waitcnt lgkmcnt(0)" ::: "memory");
        const u32x4 h0 = *((const u32x4*)(p.hn + (size_t)tok * 1024 + lane * 16));
        const u32x4 h1 = *((const u32x4*)(p.hn + (size_t)tok * 1024 + lane * 16 + 8));
#pragma unroll
        for (int i = 0; i < 4; ++i) { x2[j][i] = (f32x2){blo(h0[i]), bhi(h0[i])}; x2[j][4 + i] = (f32x2){blo(h1[i]), bhi(h1[i])}; }
        a0[j] = 0.f; a1[j] = 0.f;
      }
      u32x4 A[8], B[8], C[8], D[8];
      { const unsigned char* tab = p.U8; G_SWEEP(G_COMPUTE_U); }
#pragma unroll
      for (int j = 0; j < 2; ++j) { w0s[j] = gelu_exact(a0[j] * (1.f / 512.f)) * g0s[j]; w1s[j] = gelu_exact(a1[j] * (1.f / 512.f)) * g1s[j];
#pragma unroll
        for (int i = 0; i < 8; ++i) y2[j][i] = (f32x2){0.f, 0.f}; }
      { const unsigned char* tab = p.V8; G_SWEEP(G_COMPUTE_V); }
#pragma unroll
      for (int j = 0; j < 2; ++j) {
        const int tok = tok0 + j, b = tok / SEQ;
        float* orow = p.out + (size_t)tok * 1024 + lane * 16;
        const float* g2 = p.mod + b * 6144 + 5 * 1024 + lane * 16;
        float z[16];
        float ss = 0.f;
#pragma unroll
        for (int q = 0; q < 4; ++q) {
          const f32x4 xl = *(const f32x4*)(orow + q * 4);
          const f32x4 gg = *(const f32x4*)(g2 + q * 4);
          const float yv[4] = {y2[j][2 * q].x, y2[j][2 * q].y, y2[j][2 * q + 1].x, y2[j][2 * q + 1].y};
#pragma unroll
          for (int i = 0; i < 4; ++i) { const float zz = xl[i] + gg[i] * (yv[i] * (1.f / 32.f)); z[q * 4 + i] = zz; ss += zz * zz; }
        }
        ss = wave_sum(ss);
        const float rstd = rsqrtf(ss * (1.f / 1024.f) + 1e-6f);
#pragma unroll
        for (int q = 0; q < 4; ++q) {
          const f32x4 fw = *(const f32x4*)(p.final_norm_w + lane * 16 + q * 4);
          f32x4 o;
#pragma unroll
          for (int i = 0; i < 4; ++i) o[i] = z[q * 4 + i] * rstd * fw[i];
          *(f32x4*)(orow + q * 4) = o;
        }
      }
    }
  }
}

__global__ void __launch_bounds__(2 * NTHR, 2) mega(P p) {
  __shared__ __attribute__((aligned(16))) char smem_all[2 * LDS_HALF];
  cg::grid_group grid = cg::this_grid();
  const int half = __builtin_amdgcn_readfirstlane(threadIdx.x >> 8);
  char* smem = smem_all + half * LDS_HALF;
  const int bid = blockIdx.x * 2 + half, nb = gridDim.x * 2;
#ifndef REPEAT_MASK
#define REPEAT_MASK 0
#endif
#ifndef EXTRA_SYNCS
#define EXTRA_SYNCS 0
#endif
#define GSYNC() do { asm volatile("s_waitcnt vmcnt(0)" ::: "memory"); grid.sync(); } while (0)
#define RUN(k, call) if ((PHMASK & (1 << k)) && p.ph_lo <= k && k < p.ph_hi) { call; if (REPEAT_MASK & (1 << k)) { GSYNC(); call; } \
    if (k + 1 < p.ph_hi) { GSYNC(); for (int xs = 0; xs < EXTRA_SYNCS; ++xs) GSYNC(); } }
  RUN(0, ph0_prep(p, bid, nb, smem))
  RUN(1, ph_norm_rows<0>(p, bid, nb))
  RUN(2, ph_gemm8<0>(p, smem_all))
  RUN(3, ph3_chunk_local(p, bid, nb, smem))
  RUN(4, ph4_scan(p, bid, nb))
  RUN(5, ph5_mlstm_out(p, bid, nb, smem))
  RUN(6, (ph_gemm8<1>(p, smem_all), ph_convert_tables(p, bid, nb)))
  RUN(7, ph_norm_rows<1>(p, bid, nb))
  RUN(8, ph_gemm8<2>(p, smem_all))
  RUN(9, ph9_topk(p, bid, nb, smem))
  RUN(10, ph10_gather(p, bid, nb, smem))
#undef RUN
}

extern "C" void kernel_launch(void* const* d_in, const int* in_sizes, int n_in, void* d_out, int out_size, void* d_ws, size_t ws_size,
                              hipStream_t stream) {
  static int grid_blocks = 0;
  if (!grid_blocks) {
    int dev = 0, cus = 0, per_cu = 0;
    hipGetDevice(&dev);
    hipDeviceGetAttribute(&cus, hipDeviceAttributeMultiprocessorCount, dev);
    hipOccupancyMaxActiveBlocksPerMultiprocessor(&per_cu, (const void*)mega, 2 * NTHR, 0);
    per_cu = 1;
    grid_blocks = cus * per_cu;
    if (ws_size < WS_END) fprintf(stderr, "kernel_launch: workspace too small: %zu < %llu\n", ws_size, (unsigned long long)WS_END);
  }
  P p{};
  const float* const* in = (const float* const*)d_in;
  p.x = in[0]; p.c = in[1]; p.ctx = in[2]; p.c_ctx = in[3]; p.w_mod = in[4]; p.b_mod = in[5]; p.norm1_w = in[6]; p.w_in = in[7];
  p.conv_w = in[8]; p.conv_b = in[9]; p.b_gates = in[10]; p.head_norm_w = in[11]; p.pool_w = in[12]; p.pool_scale = in[13];
  p.w_out = in[14]; p.norm2_w = in[15]; p.wq = in[16]; p.keys = in[17]; p.U = in[18]; p.V = in[19]; p.final_norm_w = in[20];
  p.out = (float*)d_out;
  char* ws = (char*)d_ws;
  p.mod = (float*)(ws + OFF_MOD); p.gates = (float*)(ws + OFF_GATES);
  p.wt_in = (bf16_t*)(ws + OFF_WTIN); p.wt_out = (bf16_t*)(ws + OFF_WTOUT); p.wt_q = (bf16_t*)(ws + OFF_WTQ);
  p.keys_bf = (bf16_t*)(ws + OFF_KEYS); p.hn = (bf16_t*)(ws + OFF_HN); p.pl = (bf16_t*)(ws + OFF_PL);
  p.Dst = (bf16_t*)(ws + OFF_D); p.ND = (float*)(ws + OFF_ND); p.SC = (float*)(ws + OFF_SC);
  p.CIN = (bf16_t*)(ws + OFF_CIN); p.NIN = (float*)(ws + OFF_NIN); p.MIN_ = (float*)(ws + OFF_MIN);
  p.mix = (bf16_t*)(ws + OFF_D); p.qb = (bf16_t*)(ws + OFF_D);
  p.U8 = (unsigned char*)(ws + OFF_PL); p.V8 = (unsigned char*)(ws + OFF_PL + 16777216ull);
  p.eidx = (int*)(ws + OFF_EIDX); p.gate = (float*)(ws + OFF_GATE);
#if N_LAUNCHES == 1
  p.ph_lo = 0; p.ph_hi = NPH;
  void* args[] = {&p};
  hipError_t e = hipLaunchCooperativeKernel((const void*)mega, dim3(grid_blocks), dim3(2 * NTHR), args, 0, stream);
  if (e != hipSuccess) fprintf(stderr, "cooperative launch failed: %s (grid %d)\n", hipGetErrorString(e), grid_blocks);
#else
  for (int ph = 0; ph < NPH; ++ph) {
    p.ph_lo = ph; p.ph_hi = ph + 1;
    void* args[] = {&p};
    hipError_t e = hipLaunchCooperativeKernel((const void*)mega, dim3(grid_blocks), dim3(2 * NTHR), args, 0, stream);
    if (e != hipSuccess) fprintf(stderr, "launch %d failed: %s (grid %d)\n", ph, hipGetErrorString(e), grid_blocks);
  }
#endif
}
```

```cpp
#include <hip/hip_runtime.h>
#include <hip/hip_cooperative_groups.h>
#include <stdint.h>
#include <stdio.h>
namespace cg = cooperative_groups;

#ifndef PHMASK
#define PHMASK 0x7ff
#endif
#ifndef N_LAUNCHES
#define N_LAUNCHES 1
#endif

typedef unsigned short bf16_t;
typedef short bf16x8 __attribute__((ext_vector_type(8)));
typedef float f32x4 __attribute__((ext_vector_type(4)));
typedef unsigned u32x4 __attribute__((ext_vector_type(4)));
typedef float f32x2 __attribute__((ext_vector_type(2)));
typedef unsigned u32x2 __attribute__((ext_vector_type(2)));
typedef __bf16 bf16x2 __attribute__((ext_vector_type(2)));

#define NB 8
#define SEQ 2048
#define DM 1024
#define CTXL 256
#define TL 16384
#define TC 2048
#define TR 18432
#define LDP 2624
#define NPADIN 2688
#define NTHR 256
#define LDS_HALF 73728
#define NPH 11

#define OFF_MOD    (4096ull)
#define OFF_GATES  (OFF_MOD + 262144ull)
#define OFF_WTIN   (OFF_GATES + 1179648ull)
#define OFF_WTOUT  (OFF_WTIN + 5767168ull)
#define OFF_WTQ    (OFF_WTOUT + 2097152ull)
#define OFF_KEYS   (OFF_WTQ + 4194304ull)
#define OFF_POOLWT (OFF_KEYS + 524288ull)
#define OFF_HN     (OFF_POOLWT + 131072ull)
#define OFF_PL     (OFF_HN + 37748736ull)
#define OFF_D      (OFF_PL + 96731136ull)
#define OFF_ND     (OFF_D + 37748736ull)
#define OFF_SC     (OFF_ND + 589824ull)
#define OFF_CIN    (OFF_SC + 147456ull)
#define OFF_NIN    (OFF_CIN + 33554432ull)
#define OFF_MIN    (OFF_NIN + 524288ull)
#define OFF_EIDX   (OFF_MIN + 131072ull)
#define OFF_GATE   (OFF_EIDX + 4194304ull)
#define OFF_U8     (OFF_GATE + 8388608ull)
#define WS_END     (OFF_U8 + 33554432ull)

struct P {
  const float *x, *c, *ctx, *c_ctx, *w_mod, *b_mod, *norm1_w, *w_in, *conv_w, *conv_b, *b_gates, *head_norm_w,
      *pool_w, *pool_scale, *w_out, *norm2_w, *wq, *keys, *U, *V, *final_norm_w;
  float* out;
  float* mod;
  float* gates;
  bf16_t* wt_in;
  bf16_t* wt_out;
  bf16_t* wt_q;
  bf16_t* keys_bf;
  bf16_t* hn;
  bf16_t* pl;
  bf16_t* Dst;
  float* ND;
  float* SC;
  bf16_t* CIN;
  float* NIN;
  float* MIN_;
  bf16_t* mix;
  bf16_t* qb;
  unsigned char* U8;
  unsigned char* V8;
  unsigned short* eidx;
  float* gate;
  int ph_lo, ph_hi;
};

__device__ __forceinline__ bf16_t f2bf(float f) { return __builtin_bit_cast(bf16_t, (__bf16)f); }
__device__ __forceinline__ float bf2f(bf16_t h) { return __uint_as_float(((unsigned)h) << 16); }
__device__ __forceinline__ float wave_sum(float v) {
#pragma unroll
  for (int o = 32; o > 0; o >>= 1) v += __shfl_xor(v, o);
  return v;
}
__device__ __forceinline__ float silu_f(float v) { return v / (1.f + __expf(-v)); }
__device__ __forceinline__ float logsig_f(float v) { return fminf(v, 0.f) - log1pf(__expf(-fabsf(v))); }

__device__ __forceinline__ void ph0_prep(const P& p, int bid, int nb, char* smem) {
  float* sm = (float*)smem;
  const int tid = threadIdx.x & 255;
  const int N_MOD = 384, N_TIN = 16 * 44, N_TOUT = 256, N_TQ = 16 * 32, N_POOL = 16;
  const int total = N_MOD + N_TIN + N_TOUT + N_TQ + N_POOL;
  const int trips = (total + nb - 1) / nb;
  for (int k = 0; k < trips; ++k) {
    int r = (bid + k * nb) % total;
    if (r < N_MOD) {
      float* part = sm + 9 * 1024;
      for (int i = tid; i < 9 * 1024; i += NTHR) {
        int rr = i >> 10, kq = i & 1023;
        float v = rr < 8 ? p.c[rr * 1024 + kq] : p.c_ctx[kq];
        sm[i] = silu_f(v);
      }
      __syncthreads();
      {
        const int c = tid & 15, kg = tid >> 4, n = r * 16 + c;
        float acc[9];
#pragma unroll
        for (int q = 0; q < 9; ++q) acc[q] = 0.f;
#pragma unroll 8
        for (int i = 0; i < 64; ++i) {
          const int kq = kg + i * 16;
          const float w = p.w_mod[(size_t)kq * 6144 + n];
#pragma unroll
          for (int q = 0; q < 9; ++q) acc[q] += sm[q * 1024 + kq] * w;
        }
#pragma unroll
        for (int q = 0; q < 9; ++q) part[(kg * 9 + q) * 16 + c] = acc[q];
      }
      __syncthreads();
      if (tid < 144) {
        const int q = tid >> 4, c = tid & 15, n = r * 16 + c;
        float t = p.b_mod[n];
#pragma unroll
        for (int kg = 0; kg < 16; ++kg) t += part[(kg * 9 + q) * 16 + c];
        p.mod[q * 6144 + n] = t;
      }
      continue;
    }
    r -= N_MOD;
    const float* src = nullptr; bf16_t* dst = nullptr; int K = 1024, N = 0, ntn = 0;
    if (r < N_TIN) { src = p.w_in; dst = p.wt_in; N = 2576; ntn = 44; }
    else { r -= N_TIN;
      if (r < N_TOUT) { src = p.w_out; dst = p.wt_out; N = 1024; ntn = 16; }
      else { r -= N_TOUT;
        if (r < N_TQ) { src = p.wq; dst = p.wt_q; N = 2048; ntn = 32; }
        else { r -= N_TQ; int g = r >> 2; r &= 3; src = p.pool_w + g * 16384; dst = (bf16_t*)((char*)p.keys_bf + 524288) + g * 16384; K = 128; N = 128; ntn = 2; }
      }
    }
    {
      int kt = r / ntn, nt = r % ntn, k0 = kt * 64, n0 = nt * 64;
      int cc = tid & 63;
      for (int rr = tid >> 6; rr < 64; rr += 4) {
        int n = n0 + cc;
        sm[rr * 65 + cc] = n < N ? src[(size_t)(k0 + rr) * N + n] : 0.f;
      }
      __syncthreads();
      for (int rr = tid >> 6; rr < 64; rr += 4) dst[(size_t)(n0 + rr) * K + k0 + cc] = f2bf(sm[cc * 65 + rr]);
      __syncthreads();
    }
  }
  for (int i = bid * NTHR + tid; i < 262144; i += nb * NTHR) p.keys_bf[i] = f2bf(p.keys[i]);
}

template <int WHICH>
__device__ __forceinline__ void ph_norm_rows(const P& p, int bid, int nb) {
  const int wave = (threadIdx.x >> 6) & 3, lane = threadIdx.x & 63;
  const int nrows = WHICH == 0 ? TR : TL;
  for (int row = bid * 4 + wave; row < nrows; row += nb * 4) {
    const float* src = WHICH == 0 ? (row < TL ? p.x + (size_t)row * 1024 : p.ctx + (size_t)(row - TL) * 1024) : p.out + (size_t)row * 1024;
    const int mr = row < TL ? row / SEQ : 8;
    float4 v[4];
    float ss = 0.f;
#pragma unroll
    for (int j = 0; j < 4; ++j) {
      v[j] = ((const float4*)src)[j * 64 + lane];
      ss += v[j].x * v[j].x + v[j].y * v[j].y + v[j].z * v[j].z + v[j].w * v[j].w;
    }
    ss = wave_sum(ss);
    const float rstd = rsqrtf(ss * (1.f / 1024.f) + 1e-6f);
    const float* nw = WHICH == 0 ? p.norm1_w : p.norm2_w;
    const float* sh = p.mod + mr * 6144 + (WHICH == 0 ? 0 : 3) * 1024;
    const float* sc = sh + 1024;
#pragma unroll
    for (int j = 0; j < 4; ++j) {
      const int col = j * 256 + lane * 4;
      float4 w4 = *(const float4*)(nw + col), s4 = *(const float4*)(sh + col), c4 = *(const float4*)(sc + col);
      float y0 = v[j].x * rstd * w4.x * (1.f + c4.x) + s4.x;
      float y1 = v[j].y * rstd * w4.y * (1.f + c4.y) + s4.y;
      float y2 = v[j].z * rstd * w4.z * (1.f + c4.z) + s4.z;
      float y3 = v[j].w * rstd * w4.w * (1.f + c4.w) + s4.w;
      uint2 o;
      o.x = (unsigned)f2bf(y0) | ((unsigned)f2bf(y1) << 16);
      o.y = (unsigned)f2bf(y2) | ((unsigned)f2bf(y3) << 16);
      *(uint2*)(p.hn + (size_t)row * 1024 + col) = o;
    }
  }
}

#define GBK 64
#define GLD 72
template <int EPI>
__device__ __forceinline__ void gemm_tile(const P& p, const bf16_t* A, int lda, const bf16_t* Bt, int m0, int n0, bf16_t* sA, bf16_t* sB) {
  const int tid = threadIdx.x & 255, lane = tid & 63, wave = tid >> 6;
  const int wm = wave >> 1, wn = wave & 1;
  const int lr = lane & 15, lq = lane >> 4;
  f32x4 acc[4][4];
#pragma unroll
  for (int i = 0; i < 4; ++i)
#pragma unroll
    for (int j = 0; j < 4; ++j) acc[i][j] = (f32x4){0.f, 0.f, 0.f, 0.f};
  const int sr = tid >> 3, scol = (tid & 7) * 8;
  u32x4 ra[4], rb[4];
  const bf16_t* Ap = A + (size_t)(m0 + sr) * lda + scol;
  const bf16_t* Bp = Bt + (size_t)(n0 + sr) * 1024 + scol;
#pragma unroll
  for (int i = 0; i < 4; ++i) {
    ra[i] = *(const u32x4*)(Ap + (size_t)(i * 32) * lda);
    rb[i] = *(const u32x4*)(Bp + (size_t)(i * 32) * 1024);
  }
  for (int kt = 0; kt < 1024 / GBK; ++kt) {
    __syncthreads();
#pragma unroll
    for (int i = 0; i < 4; ++i) {
      *(u32x4*)(sA + (sr + i * 32) * GLD + scol) = ra[i];
      *(u32x4*)(sB + (sr + i * 32) * GLD + scol) = rb[i];
    }
    __syncthreads();
    {
      const int k0 = (kt + 1 < 1024 / GBK ? kt + 1 : kt) * GBK;
#pragma unroll
      for (int i = 0; i < 4; ++i) {
        ra[i] = *(const u32x4*)(Ap + (size_t)(i * 32) * lda + k0);
        rb[i] = *(const u32x4*)(Bp + (size_t)(i * 32) * 1024 + k0);
      }
    }
#pragma unroll
    for (int ks = 0; ks < 2; ++ks) {
      bf16x8 af[4], bfr[4];
#pragma unroll
      for (int i = 0; i < 4; ++i) {
        af[i] = *(const bf16x8*)(sA + (wm * 64 + i * 16 + lr) * GLD + ks * 32 + lq * 8);
        bfr[i] = *(const bf16x8*)(sB + (wn * 64 + i * 16 + lr) * GLD + ks * 32 + lq * 8);
      }
#pragma unroll
      for (int i = 0; i < 4; ++i)
#pragma unroll
        for (int j = 0; j < 4; ++j) acc[i][j] = __builtin_amdgcn_mfma_f32_16x16x32_bf16(af[i], bfr[j], acc[i][j], 0, 0, 0);
    }
  }
#pragma unroll
  for (int i = 0; i < 4; ++i)
#pragma unroll
    for (int j = 0; j < 4; ++j)
#pragma unroll
      for (int e = 0; e < 4; ++e) {
        const int row = m0 + wm * 64 + i * 16 + lq * 4 + e;
        const int col = n0 + wn * 64 + j * 16 + lr;
        const float v = acc[i][j][e];
        if (EPI == 0) {
          if (col < 2560) p.pl[(size_t)row * LDP + col] = f2bf(v);
          else if (col < 2576) p.gates[(size_t)row * 16 + (col - 2560)] = v;
        } else if (EPI == 1) {
          const int b = row / SEQ;
          p.out[(size_t)row * 1024 + col] = p.x[(size_t)row * 1024 + col] + p.mod[b * 6144 + 2 * 1024 + col] * v;
        } else {
          p.qb[(size_t)row * 2048 + col] = f2bf(v);
        }
      }
}

template <int EPI>
__device__ __forceinline__ void ph_gemm(const P& p, int bid, int nb, char* smem) {
  bf16_t* sA = (bf16_t*)smem;
  bf16_t* sB = sA + 128 * GLD;
  const int ntn = EPI == 0 ? 21 : (EPI == 1 ? 8 : 16);
  const int ntm = EPI == 0 ? 144 : 128;
  const bf16_t* A = EPI == 0 ? p.hn : (EPI == 1 ? p.mix : p.hn);
  const int lda = 1024;
  const bf16_t* Bt = EPI == 0 ? p.wt_in : (EPI == 1 ? p.wt_out : p.wt_q);
  const int nlat = 128 * ntn;
  const int ntiles = EPI == 0 ? nlat + 16 * 13 : ntm * ntn;
  const int trips = (ntiles + nb - 1) / nb;
  for (int k = 0; k < trips; ++k) {
    const int t = (bid + k * nb) % ntiles;
    int tm, tn;
    if (EPI == 0 && t >= nlat) { const int r = t - nlat; tm = 128 + r / 13; tn = r % 13; if (tn == 12) tn = 20; }
    else { tm = t / ntn; tn = t % ntn; }
    gemm_tile<EPI>(p, A, lda, Bt, tm * 128, tn * 128, sA, sB);
  }
}

struct UnitInfo { int isctx, b, c, h, T, seqrow0, row0; };
__device__ __forceinline__ UnitInfo decode_unit(int u) {
  UnitInfo r;
  if (u < 512) { r.isctx = 0; r.b = u >> 6; r.c = (u >> 2) & 15; r.h = u & 3; r.T = SEQ; r.seqrow0 = r.b * SEQ; }
  else { int uu = u - 512; r.isctx = 1; r.b = uu >> 3; r.c = (uu >> 2) & 1; r.h = uu & 3; r.T = CTXL; r.seqrow0 = TL + r.b * CTXL; }
  r.row0 = r.seqrow0 + r.c * 128;
  return r;
}
__device__ __forceinline__ float qk_act(const P& p, int seqrow0, int T, int t, int col) {
  const bf16_t* base = p.pl + (size_t)(seqrow0 + t) * LDP + col;
  float r0 = t > 0 ? bf2f(base[-LDP]) : 0.f;
  float r1 = bf2f(base[0]);
  float r2 = t + 1 < T ? bf2f(base[LDP]) : 0.f;
  float y = p.conv_b[col] + r0 * p.conv_w[col] + r1 * p.conv_w[1024 + col] + r2 * p.conv_w[2048 + col];
  return silu_f(y);
}


typedef short s16x4 __attribute__((ext_vector_type(4)));
#define LDS_AS __attribute__((address_space(3)))
__device__ __forceinline__ s16x4 ds_tr16(const bf16_t* ptr) { return __builtin_amdgcn_ds_read_tr16_b64_v4i16((LDS_AS s16x4*)ptr); }
__device__ __forceinline__ bf16x8 frag_tr(const bf16_t* M, int ld, int s0, int c0, int lr, int lq) {
  const bf16_t* a = M + (s0 + lq * 8 + (lr >> 2)) * ld + c0 + (lr & 3) * 4;
  const s16x4 t0 = ds_tr16(a), t1 = ds_tr16(a + 4 * ld);
  return __builtin_shufflevector(t0, t1, 0, 1, 2, 3, 4, 5, 6, 7);
}
__device__ __forceinline__ unsigned cvt_pk_bf16(float lo, float hi) { const f32x2 v = {lo, hi}; const bf16x2 b = __builtin_convertvector(v, bf16x2); return __builtin_bit_cast(unsigned, b); }
__device__ __forceinline__ float blo(unsigned u) { return __uint_as_float(u << 16); }
__device__ __forceinline__ float bhi(unsigned u) { return __uint_as_float(u & 0xffff0000u); }
#define VLD 136
__device__ __forceinline__ __amdgpu_buffer_rsrc_t mk_rsrc(const void* ptr) { return __builtin_amdgcn_make_buffer_rsrc((void*)ptr, 0, 0x7fffffff, 0x00020000); }
__device__ __forceinline__ bf16x8 bload8(__amdgpu_buffer_rsrc_t r, int voff, int soff) { return __builtin_bit_cast(bf16x8, __builtin_amdgcn_raw_buffer_load_b128(r, voff, soff, 0)); }


namespace pg8 {
#define PG8_LAS __attribute__((address_space(3)))
constexpr int BM = 256, BK = 64, HALF = 128, HTB = HALF * BK * 2, STAGE_BYTES = 8 * HTB, NXCD = 8, WGM = 8;
__host__ __device__ __forceinline__ int lds_byte(int r, int c) { const int st = (r >> 4) * 2 + (c >> 5), rr = r & 15, cc = c & 31, ob = rr * 64 + cc * 2; return st * 1024 + (ob ^ (((ob >> 9) & 1) << 5)); }
__host__ __device__ __forceinline__ void stage_rc(int b, int& R, int& C) { const int st = b / 1024, sb = b % 1024, swz = sb ^ (((sb >> 9) & 1) << 5); R = (st >> 1) * 16 + swz / 64; C = (st & 1) * 32 + (swz % 64) / 2; }
__host__ __device__ __forceinline__ int perm32(int rho) { const int n = rho >> 4, i = rho & 15; return 8 * (i >> 2) + 4 * n + (i & 3); }
struct Unit { int pm, pn; };
struct Gemm { const bf16_t* A; const bf16_t* Bt; int M, N, K; };
struct Order {
  int nM, nN, nwg, G, c, extra;
  __device__ void init(int nM_, int nN_, int G_, int c_, int extra_) { nM = nM_; nN = nN_; nwg = nM * nN; G = G_; c = c_; extra = extra_; }
  __device__ bool next(int i, Unit& u) const {
    const long L = (long)i * G + c;
    if (L >= nwg + extra) return false;
    if (L >= nwg) { const int r = (int)L - nwg; u.pm = nM + r / 7; const int q = r % 7; u.pn = q < 6 ? q : 10; return true; }
    int wgid = (int)L; { const int q = nwg / NXCD, r = nwg % NXCD, xcd = wgid % NXCD, off = wgid / NXCD; wgid = (xcd < r ? xcd * (q + 1) : r * (q + 1) + (xcd - r) * q) + off; }
    const int nig = WGM * nN, gid = wgid / nig, fm = gid * WGM, gsz = (nM - fm) < WGM ? (nM - fm) : WGM;
    u.pm = fm + ((wgid % nig) % gsz); u.pn = (wgid % nig) / gsz; return true;
  }
  __device__ __forceinline__ void a_ready(const Unit&) const {}
  __device__ __forceinline__ void done(const Unit&) const {}
};
template <class Epi, class Sched>
__device__ __forceinline__ void gemm_phase(PG8_LAS unsigned char* lds, const Gemm g, const Sched& S, const Epi& E) {
    const int tid = threadIdx.x, wid = __builtin_amdgcn_readfirstlane(tid >> 6), lane = tid & 63, wr = wid >> 2, wc = wid & 3, fr = lane & 15, fq = lane >> 4;
    const int K = g.K, nt = K / BK;
    unsigned voffA[2], voffB[2];
#pragma unroll
    for (int i = 0; i < 2; ++i) { int R, C; stage_rc(tid * 16 + i * 8192, R, C); const int Rb = Epi::PERM ? ((R & ~31) + perm32(R & 31)) : R;
        voffA[i] = (unsigned)(R * K + C) * 2u; voffB[i] = (unsigned)(Rb * K + C) * 2u; }
    const size_t kstep = (size_t)(BK * 2);
    const size_t hstep = (size_t)HALF * K * 2;
    const size_t tstep = 2 * hstep;
    const unsigned ldsw = (unsigned)wid * 1024u;
    const int aoff = lds_byte(wr * 64 + fr, fq * 8), boff = lds_byte(wc * 32 + fr, fq * 8);
#define PG8_SA(b, h) (((b) * 2 + (h)) * HTB)
#define PG8_SB(b, h) ((4 + (b) * 2 + (h)) * HTB)
#define PG8_STAGE(bufoff, gbase, voff) do { _Pragma("unroll") for (int _i = 0; _i < 2; ++_i) \
        __builtin_amdgcn_global_load_lds((const unsigned*)((const char*)(gbase) + (voff)[_i]), (PG8_LAS unsigned*)(lds + (bufoff) + ldsw + _i * 8192), 16, 0, 0); } while (0)
#define PG8_LDA(dst, b, h) do { _Pragma("unroll") for (int m = 0; m < 4; ++m) _Pragma("unroll") for (int k = 0; k < 2; ++k) dst[m][k] = *(const PG8_LAS bf16x8*)(lds + PG8_SA(b, h) + aoff + m * 2048 + k * 1024); } while (0)
#define PG8_LDB(dst, b, h) do { _Pragma("unroll") for (int n = 0; n < 2; ++n) _Pragma("unroll") for (int k = 0; k < 2; ++k) dst[n][k] = *(const PG8_LAS bf16x8*)(lds + PG8_SB(b, h) + boff + n * 2048 + k * 1024); } while (0)
#define PG8_MMA(ai, bj, At, Bt) do { __builtin_amdgcn_s_setprio(1); _Pragma("unroll") for (int m = 0; m < 4; ++m) _Pragma("unroll") for (int n = 0; n < 2; ++n) _Pragma("unroll") for (int k = 0; k < 2; ++k) \
        acc[ai][bj][m][n] = __builtin_amdgcn_mfma_f32_16x16x32_bf16(Bt[n][k], At[m][k], acc[ai][bj][m][n], 0, 0, 0); __builtin_amdgcn_s_setprio(0); } while (0)
#define PG8_WAIT_V(n) asm volatile("s_waitcnt vmcnt(" #n ")" ::: "memory")
#define PG8_WAIT_L(n) asm volatile("s_waitcnt lgkmcnt(" #n ")" ::: "memory")
#define PG8_BAR __builtin_amdgcn_s_barrier()
#define PG8_SCHED __builtin_amdgcn_sched_barrier(0)
    Unit cur, nxt; int ui = 0;
    if (!S.next(0, cur)) return;
    f32x4 acc[2][2][4][2];
#pragma unroll
    for (int a = 0; a < 2; ++a)
#pragma unroll
        for (int b = 0; b < 2; ++b)
#pragma unroll
            for (int m = 0; m < 4; ++m)
#pragma unroll
                for (int n = 0; n < 2; ++n) acc[a][b][m][n] = (f32x4){0.f, 0.f, 0.f, 0.f};
    bf16x8 At[4][2], B0[2][2], B1[2][2];
    const char* cA = (const char*)g.A + (size_t)cur.pm * tstep; const char* cB = (const char*)g.Bt + (size_t)cur.pn * tstep;
    S.a_ready(cur);
    PG8_STAGE(PG8_SB(0, 0), cB, voffB); PG8_STAGE(PG8_SA(0, 0), cA, voffA); PG8_STAGE(PG8_SB(0, 1), cB + hstep, voffB); PG8_STAGE(PG8_SA(0, 1), cA + hstep, voffA);
    if (wr == 1) PG8_BAR;
    PG8_WAIT_V(4); PG8_BAR;
    PG8_STAGE(PG8_SB(1, 0), cB + kstep, voffB); PG8_STAGE(PG8_SA(1, 0), cA + kstep, voffA); PG8_STAGE(PG8_SB(1, 1), cB + hstep + kstep, voffB);
    PG8_WAIT_V(6); PG8_BAR;
    for (;;) {
        const bool has_next = S.next(ui + 1, nxt);
        const char* nA = has_next ? (const char*)g.A + (size_t)nxt.pm * tstep : cA; const char* nB = has_next ? (const char*)g.Bt + (size_t)nxt.pn * tstep : cB;
        for (int t = 0; t < nt; t += 2) {
            const bool last = (t == nt - 2);
            const char* a1 = cA + (size_t)(t + 1) * kstep;
            const char* a2 = last ? nA : cA + (size_t)(t + 2) * kstep; const char* b2 = last ? nB : cB + (size_t)(t + 2) * kstep;
            const char* a3 = a2 + kstep; const char* b3 = b2 + kstep;
            if (last && has_next) S.a_ready(nxt);
            PG8_LDB(B0, 0, 0); PG8_SCHED; PG8_LDA(At, 0, 0); PG8_STAGE(PG8_SA(1, 1), a1 + hstep, voffA);
            PG8_WAIT_L(8); PG8_BAR; PG8_WAIT_L(0); PG8_MMA(0, 0, At, B0); PG8_BAR; PG8_SCHED;
            PG8_LDB(B1, 0, 1); PG8_STAGE(PG8_SB(0, 0), b2, voffB);
            PG8_BAR; PG8_WAIT_L(0); PG8_MMA(0, 1, At, B1); PG8_BAR;
            PG8_LDA(At, 0, 1); PG8_STAGE(PG8_SA(0, 0), a2, voffA);
            PG8_BAR; PG8_WAIT_L(0); PG8_MMA(1, 0, At, B0); PG8_BAR; PG8_SCHED;
            PG8_STAGE(PG8_SB(0, 1), b2 + hstep, voffB);
            PG8_WAIT_V(6); PG8_BAR; PG8_MMA(1, 1, At, B1); PG8_BAR;
            PG8_LDB(B0, 1, 0); PG8_SCHED; PG8_LDA(At, 1, 0); PG8_STAGE(PG8_SA(0, 1), a2 + hstep, voffA);
            PG8_WAIT_L(8); PG8_BAR; PG8_WAIT_L(0); PG8_MMA(0, 0, At, B0); PG8_BAR; PG8_SCHED;
            PG8_LDB(B1, 1, 1); PG8_STAGE(PG8_SB(1, 0), b3, voffB);
            PG8_BAR; PG8_WAIT_L(0); PG8_MMA(0, 1, At, B1); PG8_BAR;
            PG8_LDA(At, 1, 1); PG8_STAGE(PG8_SA(1, 0), a3, voffA);
            PG8_BAR; PG8_WAIT_L(0); PG8_MMA(1, 0, At, B0); PG8_BAR; PG8_SCHED;
            PG8_STAGE(PG8_SB(1, 1), b3 + hstep, voffB);
            PG8_WAIT_V(6); PG8_BAR; PG8_MMA(1, 1, At, B1); PG8_BAR;
        }
        if constexpr (!Epi::AFTER_DRAIN) { E(acc, cur, wr, wc, fr, fq); S.done(cur); }
        if (!has_next) break;
#pragma unroll
        for (int a = 0; a < 2; ++a)
#pragma unroll
            for (int b = 0; b < 2; ++b)
#pragma unroll
                for (int m = 0; m < 4; ++m)
#pragma unroll
                    for (int n = 0; n < 2; ++n) acc[a][b][m][n] = (f32x4){0.f, 0.f, 0.f, 0.f};
        cur = nxt; cA = nA; cB = nB; ++ui;
    }
    PG8_WAIT_V(0);
    if (wr == 0) PG8_BAR;
    PG8_BAR;
    if constexpr (Epi::AFTER_DRAIN) { E.fused(acc, cur, wr, wc, fr, fq, lds, wid, lane); S.done(cur); }
#undef PG8_SA
#undef PG8_SB
#undef PG8_STAGE
#undef PG8_LDA
#undef PG8_LDB
#undef PG8_MMA
#undef PG8_WAIT_V
#undef PG8_WAIT_L
#undef PG8_BAR
#undef PG8_SCHED
}
}

struct EpiIn {
  static constexpr bool PERM = true, AFTER_DRAIN = false;
  bf16_t* pl; float* gates;
  __device__ __forceinline__ void operator()(const f32x4 (&acc)[2][2][4][2], const pg8::Unit& u, int wr, int wc, int fr, int fq) const {
    const int row0 = u.pm * 256 + wr * 64 + fr;
#pragma unroll
    for (int ai = 0; ai < 2; ++ai)
#pragma unroll
      for (int m = 0; m < 4; ++m) {
        const int row = row0 + ai * 128 + m * 16;
#pragma unroll
        for (int bj = 0; bj < 2; ++bj) {
          const int c0 = u.pn * 256 + bj * 128 + wc * 32 + 8 * fq;
          const f32x4 v0 = acc[ai][bj][m][0], v1 = acc[ai][bj][m][1];
          if (c0 < 2560) {
            u32x4 w;
            w[0] = cvt_pk_bf16(v0[0], v0[1]); w[1] = cvt_pk_bf16(v0[2], v0[3]); w[2] = cvt_pk_bf16(v1[0], v1[1]); w[3] = cvt_pk_bf16(v1[2], v1[3]);
            *(u32x4*)(pl + (size_t)row * LDP + c0) = w;
          } else if (c0 < 2576) {
            *(f32x4*)(gates + (size_t)row * 16 + (c0 - 2560)) = v0;
            *(f32x4*)(gates + (size_t)row * 16 + (c0 - 2560) + 4) = v1;
          }
        }
      }
  }
};
struct EpiOut {
  static constexpr bool PERM = false, AFTER_DRAIN = false;
  const float* x; const float* mod; float* out;
  __device__ __forceinline__ void operator()(const f32x4 (&acc)[2][2][4][2], const pg8::Unit& u, int wr, int wc, int fr, int fq) const {
    const int row0 = u.pm * 256 + wr * 64 + fr, col0 = u.pn * 256 + wc * 32 + 4 * fq;
    const float* g1 = mod + (u.pm * 256 / SEQ) * 6144 + 2 * 1024;
#pragma unroll
    for (int ai = 0; ai < 2; ++ai)
#pragma unroll
      for (int m = 0; m < 4; ++m) {
        const size_t ro = (size_t)(row0 + ai * 128 + m * 16) * 1024;
#pragma unroll
        for (int bj = 0; bj < 2; ++bj)
#pragma unroll
          for (int n = 0; n < 2; ++n) {
            const int c = col0 + bj * 128 + n * 16;
            const f32x4 xv = *(const f32x4*)(x + ro + c), gv = *(const f32x4*)(g1 + c);
            *(f32x4*)(out + ro + c) = xv + gv * acc[ai][bj][m][n];
          }
      }
  }
};
struct EpiQ {
  static constexpr bool PERM = true, AFTER_DRAIN = false;
  bf16_t* q;
  __device__ __forceinline__ void operator()(const f32x4 (&acc)[2][2][4][2], const pg8::Unit& u, int wr, int wc, int fr, int fq) const {
    const int row0 = u.pm * 256 + wr * 64 + fr;
#pragma unroll
    for (int ai = 0; ai < 2; ++ai)
#pragma unroll
      for (int m = 0; m < 4; ++m)
#pragma unroll
        for (int bj = 0; bj < 2; ++bj) {
          const int c0 = u.pn * 256 + bj * 128 + wc * 32 + 8 * fq;
          const f32x4 v0 = acc[ai][bj][m][0], v1 = acc[ai][bj][m][1];
          u32x4 w;
          w[0] = cvt_pk_bf16(v0[0], v0[1]); w[1] = cvt_pk_bf16(v0[2], v0[3]); w[2] = cvt_pk_bf16(v1[0], v1[1]); w[3] = cvt_pk_bf16(v1[2], v1[3]);
          *(u32x4*)(q + (size_t)(row0 + ai * 128 + m * 16) * 2048 + c0) = w;
        }
  }
};
template <int EPI>
__device__ __forceinline__ void ph_gemm8(const P& p, char* lds_all) {
  PG8_LAS unsigned char* lds = (PG8_LAS unsigned char*)lds_all;
  pg8::Order S;
  if (EPI == 0) {
    S.init(64, 11, gridDim.x, blockIdx.x, 56);
    const pg8::Gemm g{p.hn, p.wt_in, TR, 2816, 1024};
    const EpiIn E{p.pl, p.gates};
    pg8::gemm_phase<EpiIn, pg8::Order>(lds, g, S, E);
  } else if (EPI == 1) {
    S.init(64, 4, gridDim.x, blockIdx.x, 0);
    const pg8::Gemm g{p.mix, p.wt_out, TL, 1024, 1024};
    const EpiOut E{p.x, p.mod, p.out};
    pg8::gemm_phase<EpiOut, pg8::Order>(lds, g, S, E);
  } else {
    S.init(64, 8, gridDim.x, blockIdx.x, 0);
    const pg8::Gemm g{p.hn, p.wt_q, TL, 2048, 1024};
    const EpiQ E{p.qb};
    pg8::gemm_phase<EpiQ, pg8::Order>(lds, g, S, E);
  }
}

template <bool REV>
__device__ __forceinline__ void scan128(const float* lf, const float* ig, float* bout, float* gout, float* pmout, float& Gtot, float& btot, int lane, float& g0o, float& g1o) {
  const int t0 = REV ? 127 - 2 * lane : 2 * lane, t1 = REV ? 126 - 2 * lane : 2 * lane + 1;
  const float v0 = lf[t0], v1 = lf[t1];
  float sacc = v0 + v1;
#pragma unroll
  for (int off = 1; off < 64; off <<= 1) { const float t = __shfl_up(sacc, off); if (lane >= off) sacc += t; }
  const float b1 = sacc, b0 = sacc - v1;
  const float g0 = ig[t0] - b0, g1 = ig[t1] - b1;
  float m = fmaxf(g0, g1);
#pragma unroll
  for (int off = 1; off < 64; off <<= 1) { const float t = __shfl_up(m, off); if (lane >= off) m = fmaxf(m, t); }
  float prev = __shfl_up(m, 1);
  if (lane == 0) prev = -3.0e38f;
  if (bout) { bout[t0] = b0; bout[t1] = b1; }
  if (gout) { gout[t0] = g0; gout[t1] = g1; }
  g0o = g0; g1o = g1;
  if (pmout) { pmout[t0] = fmaxf(prev, g0); pmout[t1] = m; }
  Gtot = __shfl(m, 63); btot = __shfl(sacc, 63);
}

__device__ __forceinline__ void ph3_chunk_local(const P& p, int bid, int nb, char* smem) {
  bf16_t* Vs = (bf16_t*)smem;
  bf16_t* Ks = Vs + 128 * VLD;
  float* fa = (float*)(Ks + 128 * VLD);
  float *igf = fa, *lff = fa + 128, *igb = fa + 256, *lfb = fa + 384, *ef = fa + 512, *eb = fa + 640, *scal = fa + 768;
  const int tid = threadIdx.x & 255, lane = tid & 63, wave = tid >> 6, lr = lane & 15, lq = lane >> 4;
  const int trips3 = (576 + nb - 1) / nb;
  for (int k3 = 0; k3 < trips3; ++k3) {
    const int u = (bid + k3 * nb) % 576;
    const UnitInfo ui = decode_unit(u);
    const int h = ui.h;
    if (tid < 128) {
      const float* g = p.gates + (size_t)(ui.row0 + tid) * 16;
      igf[tid] = g[h] + p.b_gates[h];
      lff[tid] = logsig_f(g[4 + h] + p.b_gates[4 + h]);
      igb[tid] = g[8 + h] + p.b_gates[8 + h];
      lfb[tid] = logsig_f(g[12 + h] + p.b_gates[12 + h]);
    }
    {
      const int dch = tid & 15, colq = h * 128 + dch * 8, colk = 512 + colq;
#pragma unroll 1
      for (int which = 0; which < 2; ++which) {
        if (which == 1 && ui.isctx) break;
        const int col = which == 0 ? colk : colq;
        float w0[8], w1[8], w2[8], bb[8];
#pragma unroll
        for (int i = 0; i < 8; ++i) { w0[i] = p.conv_w[col + i]; w1[i] = p.conv_w[1024 + col + i]; w2[i] = p.conv_w[2048 + col + i]; bb[i] = p.conv_b[col + i]; }
        const float scl = which == 0 ? 0.08838834764831845f : 1.f;
#pragma unroll 2
        for (int i = 0; i < 8; ++i) {
          const int t = (tid >> 4) + i * 16, tt = ui.c * 128 + t;
          const bf16_t* base = p.pl + (size_t)(ui.row0 + t) * LDP + col;
          const u32x4 z4 = (u32x4){0u, 0u, 0u, 0u};
          const u32x4 r1 = *(const u32x4*)base;
          const u32x4 r0 = tt > 0 ? *(const u32x4*)(base - LDP) : z4;
          const u32x4 r2 = tt + 1 < ui.T ? *(const u32x4*)(base + LDP) : z4;
          float y[8];
#pragma unroll
          for (int q = 0; q < 4; ++q) {
            y[2 * q] = silu_f(bb[2 * q] + blo(r0[q]) * w0[2 * q] + blo(r1[q]) * w1[2 * q] + blo(r2[q]) * w2[2 * q]) * scl;
            y[2 * q + 1] = silu_f(bb[2 * q + 1] + bhi(r0[q]) * w0[2 * q + 1] + bhi(r1[q]) * w1[2 * q + 1] + bhi(r2[q]) * w2[2 * q + 1]) * scl;
          }
          u32x4 o;
#pragma unroll
          for (int q = 0; q < 4; ++q) o[q] = cvt_pk_bf16(y[2 * q], y[2 * q + 1]);
          if (which == 0) *(u32x4*)(Ks + t * VLD + dch * 8) = o;
          if (!ui.isctx) *(u32x4*)(p.hn + (size_t)(ui.row0 + t) * 1024 + col) = o;
        }
      }
#pragma unroll
      for (int i = 0; i < 8; ++i) {
        const int t = (tid >> 4) + i * 16;
        *(u32x4*)(Vs + t * VLD + dch * 8) = *(const u32x4*)(p.pl + (size_t)(ui.row0 + t) * LDP + 1024 + h * 128 + dch * 8);
      }
    }
    __syncthreads();
    if (wave == 0) {
      float G, bt, ga, gb2;
      scan128<false>(lff, igf, nullptr, nullptr, nullptr, G, bt, lane, ga, gb2);
      ef[2 * lane] = __expf(ga - G); ef[2 * lane + 1] = __expf(gb2 - G);
      if (lane == 0) { scal[0] = G; scal[1] = bt; }
    } else if (wave == 1) {
      float G, bt, ga, gb2;
      scan128<true>(lfb, igb, nullptr, nullptr, nullptr, G, bt, lane, ga, gb2);
      eb[127 - 2 * lane] = __expf(ga - G); eb[126 - 2 * lane] = __expf(gb2 - G);
      if (lane == 0) { scal[2] = G; scal[3] = bt; }
    }
    __syncthreads();
#pragma unroll 1
    for (int dir = 0; dir < 2; ++dir) {
      const float* ee = dir ? eb : ef;
      f32x4 acc[2][8];
#pragma unroll
      for (int m = 0; m < 2; ++m)
#pragma unroll
        for (int j = 0; j < 8; ++j) acc[m][j] = (f32x4){0.f, 0.f, 0.f, 0.f};
#pragma unroll
      for (int kk = 0; kk < 4; ++kk) {
        const f32x4 e0 = *(const f32x4*)(ee + kk * 32 + lq * 8), e1 = *(const f32x4*)(ee + kk * 32 + lq * 8 + 4);
        bf16x8 af[2];
#pragma unroll
        for (int m = 0; m < 2; ++m) {
          const bf16x8 raw = frag_tr(Vs, VLD, kk * 32, wave * 32 + m * 16, lr, lq);
          const u32x4 ru = __builtin_bit_cast(u32x4, raw);
          u32x4 sc;
          sc[0] = cvt_pk_bf16(blo(ru[0]) * e0[0], bhi(ru[0]) * e0[1]);
          sc[1] = cvt_pk_bf16(blo(ru[1]) * e0[2], bhi(ru[1]) * e0[3]);
          sc[2] = cvt_pk_bf16(blo(ru[2]) * e1[0], bhi(ru[2]) * e1[1]);
          sc[3] = cvt_pk_bf16(blo(ru[3]) * e1[2], bhi(ru[3]) * e1[3]);
          af[m] = __builtin_bit_cast(bf16x8, sc);
        }
#pragma unroll
        for (int j = 0; j < 8; ++j) {
          const bf16x8 bfr = frag_tr(Ks, VLD, kk * 32, j * 16, lr, lq);
#pragma unroll
          for (int m = 0; m < 2; ++m) acc[m][j] = __builtin_amdgcn_mfma_f32_16x16x32_bf16(af[m], bfr, acc[m][j], 0, 0, 0);
        }
      }
      bf16_t* Dd = p.Dst + (size_t)(u * 2 + dir) * 16384;
#pragma unroll
      for (int m = 0; m < 2; ++m)
#pragma unroll
        for (int j = 0; j < 8; ++j)
#pragma unroll
          for (int e = 0; e < 4; ++e) Dd[(wave * 32 + m * 16 + lq * 4 + e) * 128 + j * 16 + lr] = f2bf(acc[m][j][e]);
    }
    {
      const int dir = tid >> 7, k = tid & 127;
      const float* e = dir ? eb : ef;
      float sacc = 0.f;
      for (int t = 0; t < 128; ++t) sacc += e[t] * bf2f(Ks[t * VLD + k]);
      p.ND[(size_t)(u * 2 + dir) * 128 + k] = sacc;
    }
    if (tid < 4) p.SC[(size_t)(u * 2 + (tid >> 1)) * 32 + (tid & 1)] = scal[tid];
    __syncthreads();
  }
}

__device__ __forceinline__ void ph4_scan(const P& p, int bid, int nb) {
  const int tid = threadIdx.x & 255;
  for (int it = bid; it < 1024; it += nb) {
    const int combo = it >> 4, vblk = it & 15;
    const int b = combo >> 3, h = (combo >> 1) & 3, dir = combo & 1;
    const int v = vblk * 8 + (tid >> 5), k0 = (tid & 31) * 4;
    float C0 = 0.f, C1 = 0.f, C2 = 0.f, C3 = 0.f, nacc = 0.f, m = 0.f;
    for (int i = 0; i < 18; ++i) {
      int u;
      if (i < 2) { const int cc = dir == 0 ? i : 1 - i; u = 512 + b * 8 + cc * 4 + h; }
      else {
        const int lc = i - 2, c = dir == 0 ? lc : 15 - lc;
        u = b * 64 + c * 4 + h;
        const size_t ci = (size_t)u * 2 + dir;
        uint2 o;
        o.x = (unsigned)f2bf(C0) | ((unsigned)f2bf(C1) << 16);
        o.y = (unsigned)f2bf(C2) | ((unsigned)f2bf(C3) << 16);
        *(uint2*)(p.CIN + ci * 16384 + v * 128 + k0) = o;
        if (vblk == 0 && tid < 128) p.NIN[ci * 128 + tid] = nacc;
        if (vblk == 0 && tid == 0) p.MIN_[ci * 32] = m;
      }
      const size_t di = (size_t)u * 2 + dir;
      const float G = p.SC[di * 32 + 0], bend = p.SC[di * 32 + 1];
      const float Mx = fmaxf(m, G);
      const float dec = __expf(m - Mx), inj = __expf(G - Mx);
      const uint2 d2 = *(const uint2*)(p.Dst + di * 16384 + v * 128 + k0);
      C0 = dec * C0 + inj * __uint_as_float(d2.x << 16);
      C1 = dec * C1 + inj * __uint_as_float(d2.x & 0xffff0000u);
      C2 = dec * C2 + inj * __uint_as_float(d2.y << 16);
      C3 = dec * C3 + inj * __uint_as_float(d2.y & 0xffff0000u);
      if (vblk == 0 && tid < 128) nacc = dec * nacc + inj * p.ND[di * 128 + tid];
      m = bend + Mx;
    }
  }
}

__device__ __forceinline__ void ph5_mlstm_out(const P& p, int bid, int nb, char* smem) {
  bf16_t* Vs = (bf16_t*)smem;
  bf16_t* Pw = Vs + 128 * VLD;
  float* fa = (float*)(Pw + 4 * 16 * VLD);
  float *igf = fa, *lff = fa + 128, *igb = fa + 256, *lfb = fa + 384, *gf = fa + 512, *gb = fa + 640, *bfw = fa + 768, *bbw = fa + 896,
        *pmf = fa + 1024, *pmb = fa + 1152, *nq = fa + 1280  ;
  const int tid = threadIdx.x & 255, lane = tid & 63, wave = tid >> 6, lr = lane & 15, lq = lane >> 4;
  const int trips5 = (1536 + nb - 1) / nb;
  for (int k5 = 0; k5 < trips5; ++k5) {
    const int it = (bid + k5 * nb) % 1536;
    if (it < 512) {
      const int u = it;
      const UnitInfo ui = decode_unit(u);
      const int h = ui.h;
      const size_t cif = (size_t)u * 2, cib = (size_t)u * 2 + 1;
      if (tid < 128) {
        const float* g = p.gates + (size_t)(ui.row0 + tid) * 16;
        igf[tid] = g[h] + p.b_gates[h];
        lff[tid] = logsig_f(g[4 + h] + p.b_gates[4 + h]);
        igb[tid] = g[8 + h] + p.b_gates[8 + h];
        lfb[tid] = logsig_f(g[12 + h] + p.b_gates[12 + h]);
      }
      {
        const int dch = tid & 15;
#pragma unroll
        for (int i = 0; i < 8; ++i) {
          const int t = (tid >> 4) + i * 16;
          *(u32x4*)(Vs + t * VLD + dch * 8) = *(const u32x4*)(p.pl + (size_t)(ui.row0 + t) * LDP + 1024 + h * 128 + dch * 8);
        }
      }
      {
        const int dir = tid >> 7, t = tid & 127;
        const u32x4* qr = (const u32x4*)(p.hn + (size_t)(ui.row0 + t) * 1024 + h * 128);
        const float* nin = p.NIN + (dir ? cib : cif) * 128;
        float sacc = 0.f;
#pragma unroll 4
        for (int c8 = 0; c8 < 16; ++c8) {
          const u32x4 qv = qr[c8];
#pragma unroll
          for (int q = 0; q < 4; ++q) sacc += blo(qv[q]) * nin[c8 * 8 + 2 * q] + bhi(qv[q]) * nin[c8 * 8 + 2 * q + 1];
        }
        nq[dir * 128 + t] = sacc;
      }
      __syncthreads();
      if (wave == 0) { float G, bt, ga, gb2; scan128<false>(lff, igf, bfw, gf, pmf, G, bt, lane, ga, gb2); }
      else if (wave == 1) { float G, bt, ga, gb2; scan128<true>(lfb, igb, bbw, gb, pmb, G, bt, lane, ga, gb2); }
      __syncthreads();
      const float minf_ = p.MIN_[cif * 32], minb_ = p.MIN_[cib * 32];
      bf16_t* Pme = Pw + wave * 16 * VLD;
      const __amdgpu_buffer_rsrc_t r_hn = mk_rsrc(p.hn), r_cin = mk_rsrc(p.CIN);
      const int fvoff = (lr * 1024 + lq * 8) * 2, cvoff = (lr * 128 + lq * 8) * 2;
#pragma unroll 1
      for (int m = 0; m < 2; ++m) {
        const int t0 = wave * 32 + m * 16;
        bf16x8 Qf[4];
#pragma unroll
        for (int kk = 0; kk < 4; ++kk) Qf[kk] = bload8(r_hn, fvoff + kk * 64, ((ui.row0 + t0) * 1024 + h * 128) * 2);
        f32x4 S[8];
#pragma unroll
        for (int j = 0; j < 8; ++j) {
          S[j] = (f32x4){0.f, 0.f, 0.f, 0.f};
#pragma unroll
          for (int kk = 0; kk < 4; ++kk) {
            const bf16x8 kf = bload8(r_hn, fvoff + kk * 64, ((ui.row0 + j * 16) * 1024 + 512 + h * 128) * 2);
            S[j] = __builtin_amdgcn_mfma_f32_16x16x32_bf16(Qf[kk], kf, S[j], 0, 0, 0);
          }
          if (j & 1) __builtin_amdgcn_sched_barrier(0);
        }
        f32x4 hsum[8];
#pragma unroll 1
        for (int dir = 0; dir < 2; ++dir) {
          const float mi = dir ? minb_ : minf_;
          const float* gg = dir ? gb : gf;
          const float* pmx = dir ? pmb : pmf;
          const float* bw = dir ? bbw : bfw;
          float Mrow[4], wi[4];
#pragma unroll
          for (int e = 0; e < 4; ++e) { Mrow[e] = fmaxf(mi, pmx[t0 + lq * 4 + e]); wi[e] = __expf(mi - Mrow[e]); }
          f32x4 acc[8];
#pragma unroll
          for (int jv = 0; jv < 8; ++jv) {
            acc[jv] = (f32x4){0.f, 0.f, 0.f, 0.f};
#pragma unroll
            for (int kk = 0; kk < 4; ++kk) {
              const bf16x8 cf = bload8(r_cin, cvoff + kk * 64, (int)((dir ? cib : cif) * 32768) + jv * 4096);
              acc[jv] = __builtin_amdgcn_mfma_f32_16x16x32_bf16(Qf[kk], cf, acc[jv], 0, 0, 0);
            }
#pragma unroll
            for (int e = 0; e < 4; ++e) acc[jv][e] *= wi[e];
            if (jv & 1) __builtin_amdgcn_sched_barrier(0);
          }
          float rs[4] = {0.f, 0.f, 0.f, 0.f};
#pragma unroll
          for (int j = 0; j < 8; ++j) {
            const int sidx = j * 16 + lr;
            const float gs = gg[sidx];
#pragma unroll
            for (int e = 0; e < 4; ++e) {
              const int t = t0 + lq * 4 + e;
              const bool keep = dir ? (sidx >= t) : (sidx <= t);
              const float pv = keep ? S[j][e] * __expf(gs - Mrow[e]) : 0.f;
              rs[e] += pv;
              Pme[(lq * 4 + e) * VLD + sidx] = f2bf(pv);
            }
          }
          float den[4];
#pragma unroll
          for (int e = 0; e < 4; ++e) {
            float r = rs[e];
            r += __shfl_xor(r, 1); r += __shfl_xor(r, 2); r += __shfl_xor(r, 4); r += __shfl_xor(r, 8);
            const int t = t0 + lq * 4 + e;
            const float dd = r + wi[e] * nq[dir * 128 + t];
            den[e] = fmaxf(fabsf(dd), __expf(-(bw[t] + Mrow[e])));
          }
          asm volatile("s_waitcnt lgkmcnt(0)" ::: "memory");
          __builtin_amdgcn_wave_barrier();
#pragma unroll
          for (int kk = 0; kk < 4; ++kk) {
            const bf16x8 pf = *(const bf16x8*)(Pme + lr * VLD + kk * 32 + lq * 8);
#pragma unroll
            for (int jv = 0; jv < 8; ++jv) {
              const bf16x8 vf = frag_tr(Vs, VLD, kk * 32, jv * 16, lr, lq);
              acc[jv] = __builtin_amdgcn_mfma_f32_16x16x32_bf16(pf, vf, acc[jv], 0, 0, 0);
            }
          }
          __builtin_amdgcn_wave_barrier();
#pragma unroll
          for (int jv = 0; jv < 8; ++jv)
#pragma unroll
            for (int e = 0; e < 4; ++e) {
              const float hv = acc[jv][e] / den[e];
              if (dir == 0) hsum[jv][e] = hv; else hsum[jv][e] += hv;
            }
        }
#pragma unroll
        for (int e = 0; e < 4; ++e) {
          float sm = 0.f;
#pragma unroll
          for (int jv = 0; jv < 8; ++jv) sm += hsum[jv][e];
          sm += __shfl_xor(sm, 1); sm += __shfl_xor(sm, 2); sm += __shfl_xor(sm, 4); sm += __shfl_xor(sm, 8);
          const float mu = sm * (1.f / 128.f);
          float vs = 0.f;
#pragma unroll
          for (int jv = 0; jv < 8; ++jv) { const float d = hsum[jv][e] - mu; vs += d * d; }
          vs += __shfl_xor(vs, 1); vs += __shfl_xor(vs, 2); vs += __shfl_xor(vs, 4); vs += __shfl_xor(vs, 8);
          const float rstd = rsqrtf(vs * (1.f / 128.f) + 1e-6f);
          const bf16_t* op = p.pl + (size_t)(ui.row0 + t0 + lq * 4 + e) * LDP + 1536 + h * 128;
          bf16_t* mp = p.mix + (size_t)(ui.row0 + t0 + lq * 4 + e) * 1024 + h * 128;
#pragma unroll
          for (int jv = 0; jv < 8; ++jv) {
            const int v = jv * 16 + lr;
            const float o = bf2f(op[v]);
            mp[v] = f2bf((hsum[jv][e] - mu) * rstd * p.head_norm_w[h * 128 + v] / (1.f + __expf(-o)));
          }
        }
      }
      __syncthreads();
    } else {
      const int pu = it - 512, grp = pu >> 2, g = pu & 3;
      float* us = (float*)smem;
      bf16_t* db = (bf16_t*)(us + 8192);
      const int w = 2 << g;
      const size_t rbase = (size_t)grp * 64;
      for (int idx = tid; idx < 1024; idx += NTHR) {
        const int t = idx >> 4, ch = idx & 15;
        const u32x4 r = *(const u32x4*)(p.pl + (rbase + t) * LDP + 2048 + g * 128 + ch * 8);
        float* d = us + t * 128 + ch * 8;
#pragma unroll
        for (int q = 0; q < 4; ++q) { d[2 * q] = blo(r[q]); d[2 * q + 1] = bhi(r[q]); }
      }
      __syncthreads();
      for (int idx = tid; idx < 8192; idx += NTHR) {
        const int t = idx >> 7, i = idx & 127;
        int lo = t - w / 2, hi = t - w / 2 + w;
        lo = lo < 0 ? 0 : lo; hi = hi > 64 ? 64 : hi;
        float sacc = 0.f;
        for (int j = lo; j < hi; ++j) sacc += us[j * 128 + i];
        db[t * VLD + i] = f2bf(sacc / (float)(hi - lo) - us[idx]);
      }
      __syncthreads();
      {
        const bf16_t* wt = (const bf16_t*)((const char*)p.keys_bf + 524288) + g * 16384;
        bf16x8 af[4];
#pragma unroll
        for (int kk = 0; kk < 4; ++kk) af[kk] = *(const bf16x8*)(db + (wave * 16 + lr) * VLD + kk * 32 + lq * 8);
#pragma unroll
        for (int j = 0; j < 8; ++j) {
          f32x4 acc = (f32x4){0.f, 0.f, 0.f, 0.f};
#pragma unroll
          for (int kk = 0; kk < 4; ++kk) {
            const bf16x8 bfr = *(const bf16x8*)(wt + (j * 16 + lr) * 128 + kk * 32 + lq * 8);
            acc = __builtin_amdgcn_mfma_f32_16x16x32_bf16(af[kk], bfr, acc, 0, 0, 0);
          }
          const float ps = p.pool_scale[g * 128 + j * 16 + lr];
#pragma unroll
          for (int e = 0; e < 4; ++e) p.mix[(rbase + wave * 16 + lq * 4 + e) * 1024 + 512 + g * 128 + j * 16 + lr] = f2bf(acc[e] * ps);
        }
      }
      __syncthreads();
    }
  }
}

#define SORT16(X) do { unsigned h_, l_; h_ = X[0] > X[1] ? X[0] : X[1]; l_ = X[0] > X[1] ? X[1] : X[0]; X[0] = h_; X[1] = l_; h_ = X[3] > X[2] ? X[3] : X[2]; l_ = X[3] > X[2] ? X[2] : X[3]; X[3] = h_; X[2] = l_; h_ = X[4] > X[5] ? X[4] : X[5]; l_ = X[4] > X[5] ? X[5] : X[4]; X[4] = h_; X[5] = l_; h_ = X[7] > X[6] ? X[7] : X[6]; l_ = X[7] > X[6] ? X[6] : X[7]; X[7] = h_; X[6] = l_; h_ = X[8] > X[9] ? X[8] : X[9]; l_ = X[8] > X[9] ? X[9] : X[8]; X[8] = h_; X[9] = l_; h_ = X[11] > X[10] ? X[11] : X[10]; l_ = X[11] > X[10] ? X[10] : X[11]; X[11] = h_; X[10] = l_; h_ = X[12] > X[13] ? X[12] : X[13]; l_ = X[12] > X[13] ? X[13] : X[12]; X[12] = h_; X[13] = l_; h_ = X[15] > X[14] ? X[15] : X[14]; l_ = X[15] > X[14] ? X[14] : X[15]; X[15] = h_; X[14] = l_; h_ = X[0] > X[2] ? X[0] : X[2]; l_ = X[0] > X[2] ? X[2] : X[0]; X[0] = h_; X[2] = l_; h_ = X[1] > X[3] ? X[1] : X[3]; l_ = X[1] > X[3] ? X[3] : X[1]; X[1] = h_; X[3] = l_; h_ = X[6] > X[4] ? X[6] : X[4]; l_ = X[6] > X[4] ? X[4] : X[6]; X[6] = h_; X[4] = l_; h_ = X[7] > X[5] ? X[7] : X[5]; l_ = X[7] > X[5] ? X[5] : X[7]; X[7] = h_; X[5] = l_; h_ = X[8] > X[10] ? X[8] : X[10]; l_ = X[8] > X[10] ? X[10] : X[8]; X[8] = h_; X[10] = l_; h_ = X[9] > X[11] ? X[9] : X[11]; l_ = X[9] > X[11] ? X[11] : X[9]; X[9] = h_; X[11] = l_; h_ = X[14] > X[12] ? X[14] : X[12]; l_ = X[14] > X[12] ? X[12] : X[14]; X[14] = h_; X[12] = l_; h_ = X[15] > X[13] ? X[15] : X[13]; l_ = X[15] > X[13] ? X[13] : X[15]; X[15] = h_; X[13] = l_; h_ = X[0] > X[1] ? X[0] : X[1]; l_ = X[0] > X[1] ? X[1] : X[0]; X[0] = h_; X[1] = l_; h_ = X[2] > X[3] ? X[2] : X[3]; l_ = X[2] > X[3] ? X[3] : X[2]; X[2] = h_; X[3] = l_; h_ = X[5] > X[4] ? X[5] : X[4]; l_ = X[5] > X[4] ? X[4] : X[5]; X[5] = h_; X[4] = l_; h_ = X[7] > X[6] ? X[7] : X[6]; l_ = X[7] > X[6] ? X[6] : X[7]; X[7] = h_; X[6] = l_; h_ = X[8] > X[9] ? X[8] : X[9]; l_ = X[8] > X[9] ? X[9] : X[8]; X[8] = h_; X[9] = l_; h_ = X[10] > X[11] ? X[10] : X[11]; l_ = X[10] > X[11] ? X[11] : X[10]; X[10] = h_; X[11] = l_; h_ = X[13] > X[12] ? X[13] : X[12]; l_ = X[13] > X[12] ? X[12] : X[13]; X[13] = h_; X[12] = l_; h_ = X[15] > X[14] ? X[15] : X[14]; l_ = X[15] > X[14] ? X[14] : X[15]; X[15] = h_; X[14] = l_; h_ = X[0] > X[4] ? X[0] : X[4]; l_ = X[0] > X[4] ? X[4] : X[0]; X[0] = h_; X[4] = l_; h_ = X[1] > X[5] ? X[1] : X[5]; l_ = X[1] > X[5] ? X[5] : X[1]; X[1] = h_; X[5] = l_; h_ = X[2] > X[6] ? X[2] : X[6]; l_ = X[2] > X[6] ? X[6] : X[2]; X[2] = h_; X[6] = l_; h_ = X[3] > X[7] ? X[3] : X[7]; l_ = X[3] > X[7] ? X[7] : X[3]; X[3] = h_; X[7] = l_; h_ = X[12] > X[8] ? X[12] : X[8]; l_ = X[12] > X[8] ? X[8] : X[12]; X[12] = h_; X[8] = l_; h_ = X[13] > X[9] ? X[13] : X[9]; l_ = X[13] > X[9] ? X[9] : X[13]; X[13] = h_; X[9] = l_; h_ = X[14] > X[10] ? X[14] : X[10]; l_ = X[14] > X[10] ? X[10] : X[14]; X[14] = h_; X[10] = l_; h_ = X[15] > X[11] ? X[15] : X[11]; l_ = X[15] > X[11] ? X[11] : X[15]; X[15] = h_; X[11] = l_; h_ = X[0] > X[2] ? X[0] : X[2]; l_ = X[0] > X[2] ? X[2] : X[0]; X[0] = h_; X[2] = l_; h_ = X[1] > X[3] ? X[1] : X[3]; l_ = X[1] > X[3] ? X[3] : X[1]; X[1] = h_; X[3] = l_; h_ = X[4] > X[6] ? X[4] : X[6]; l_ = X[4] > X[6] ? X[6] : X[4]; X[4] = h_; X[6] = l_; h_ = X[5] > X[7] ? X[5] : X[7]; l_ = X[5] > X[7] ? X[7] : X[5]; X[5] = h_; X[7] = l_; h_ = X[10] > X[8] ? X[10] : X[8]; l_ = X[10] > X[8] ? X[8] : X[10]; X[10] = h_; X[8] = l_; h_ = X[11] > X[9] ? X[11] : X[9]; l_ = X[11] > X[9] ? X[9] : X[11]; X[11] = h_; X[9] = l_; h_ = X[14] > X[12] ? X[14] : X[12]; l_ = X[14] > X[12] ? X[12] : X[14]; X[14] = h_; X[12] = l_; h_ = X[15] > X[13] ? X[15] : X[13]; l_ = X[15] > X[13] ? X[13] : X[15]; X[15] = h_; X[13] = l_; h_ = X[0] > X[1] ? X[0] : X[1]; l_ = X[0] > X[1] ? X[1] : X[0]; X[0] = h_; X[1] = l_; h_ = X[2] > X[3] ? X[2] : X[3]; l_ = X[2] > X[3] ? X[3] : X[2]; X[2] = h_; X[3] = l_; h_ = X[4] > X[5] ? X[4] : X[5]; l_ = X[4] > X[5] ? X[5] : X[4]; X[4] = h_; X[5] = l_; h_ = X[6] > X[7] ? X[6] : X[7]; l_ = X[6] > X[7] ? X[7] : X[6]; X[6] = h_; X[7] = l_; h_ = X[9] > X[8] ? X[9] : X[8]; l_ = X[9] > X[8] ? X[8] : X[9]; X[9] = h_; X[8] = l_; h_ = X[11] > X[10] ? X[11] : X[10]; l_ = X[11] > X[10] ? X[10] : X[11]; X[11] = h_; X[10] = l_; h_ = X[13] > X[12] ? X[13] : X[12]; l_ = X[13] > X[12] ? X[12] : X[13]; X[13] = h_; X[12] = l_; h_ = X[15] > X[14] ? X[15] : X[14]; l_ = X[15] > X[14] ? X[14] : X[15]; X[15] = h_; X[14] = l_; h_ = X[0] > X[8] ? X[0] : X[8]; l_ = X[0] > X[8] ? X[8] : X[0]; X[0] = h_; X[8] = l_; h_ = X[1] > X[9] ? X[1] : X[9]; l_ = X[1] > X[9] ? X[9] : X[1]; X[1] = h_; X[9] = l_; h_ = X[2] > X[10] ? X[2] : X[10]; l_ = X[2] > X[10] ? X[10] : X[2]; X[2] = h_; X[10] = l_; h_ = X[3] > X[11] ? X[3] : X[11]; l_ = X[3] > X[11] ? X[11] : X[3]; X[3] = h_; X[11] = l_; h_ = X[4] > X[12] ? X[4] : X[12]; l_ = X[4] > X[12] ? X[12] : X[4]; X[4] = h_; X[12] = l_; h_ = X[5] > X[13] ? X[5] : X[13]; l_ = X[5] > X[13] ? X[13] : X[5]; X[5] = h_; X[13] = l_; h_ = X[6] > X[14] ? X[6] : X[14]; l_ = X[6] > X[14] ? X[14] : X[6]; X[6] = h_; X[14] = l_; h_ = X[7] > X[15] ? X[7] : X[15]; l_ = X[7] > X[15] ? X[15] : X[7]; X[7] = h_; X[15] = l_; h_ = X[0] > X[4] ? X[0] : X[4]; l_ = X[0] > X[4] ? X[4] : X[0]; X[0] = h_; X[4] = l_; h_ = X[1] > X[5] ? X[1] : X[5]; l_ = X[1] > X[5] ? X[5] : X[1]; X[1] = h_; X[5] = l_; h_ = X[2] > X[6] ? X[2] : X[6]; l_ = X[2] > X[6] ? X[6] : X[2]; X[2] = h_; X[6] = l_; h_ = X[3] > X[7] ? X[3] : X[7]; l_ = X[3] > X[7] ? X[7] : X[3]; X[3] = h_; X[7] = l_; h_ = X[8] > X[12] ? X[8] : X[12]; l_ = X[8] > X[12] ? X[12] : X[8]; X[8] = h_; X[12] = l_; h_ = X[9] > X[13] ? X[9] : X[13]; l_ = X[9] > X[13] ? X[13] : X[9]; X[9] = h_; X[13] = l_; h_ = X[10] > X[14] ? X[10] : X[14]; l_ = X[10] > X[14] ? X[14] : X[10]; X[10] = h_; X[14] = l_; h_ = X[11] > X[15] ? X[11] : X[15]; l_ = X[11] > X[15] ? X[15] : X[11]; X[11] = h_; X[15] = l_; h_ = X[0] > X[2] ? X[0] : X[2]; l_ = X[0] > X[2] ? X[2] : X[0]; X[0] = h_; X[2] = l_; h_ = X[1] > X[3] ? X[1] : X[3]; l_ = X[1] > X[3] ? X[3] : X[1]; X[1] = h_; X[3] = l_; h_ = X[4] > X[6] ? X[4] : X[6]; l_ = X[4] > X[6] ? X[6] : X[4]; X[4] = h_; X[6] = l_; h_ = X[5] > X[7] ? X[5] : X[7]; l_ = X[5] > X[7] ? X[7] : X[5]; X[5] = h_; X[7] = l_; h_ = X[8] > X[10] ? X[8] : X[10]; l_ = X[8] > X[10] ? X[10] : X[8]; X[8] = h_; X[10] = l_; h_ = X[9] > X[11] ? X[9] : X[11]; l_ = X[9] > X[11] ? X[11] : X[9]; X[9] = h_; X[11] = l_; h_ = X[12] > X[14] ? X[12] : X[14]; l_ = X[12] > X[14] ? X[14] : X[12]; X[12] = h_; X[14] = l_; h_ = X[13] > X[15] ? X[13] : X[15]; l_ = X[13] > X[15] ? X[15] : X[13]; X[13] = h_; X[15] = l_; h_ = X[0] > X[1] ? X[0] : X[1]; l_ = X[0] > X[1] ? X[1] : X[0]; X[0] = h_; X[1] = l_; h_ = X[2] > X[3] ? X[2] : X[3]; l_ = X[2] > X[3] ? X[3] : X[2]; X[2] = h_; X[3] = l_; h_ = X[4] > X[5] ? X[4] : X[5]; l_ = X[4] > X[5] ? X[5] : X[4]; X[4] = h_; X[5] = l_; h_ = X[6] > X[7] ? X[6] : X[7]; l_ = X[6] > X[7] ? X[7] : X[6]; X[6] = h_; X[7] = l_; h_ = X[8] > X[9] ? X[8] : X[9]; l_ = X[8] > X[9] ? X[9] : X[8]; X[8] = h_; X[9] = l_; h_ = X[10] > X[11] ? X[10] : X[11]; l_ = X[10] > X[11] ? X[11] : X[10]; X[10] = h_; X[11] = l_; h_ = X[12] > X[13] ? X[12] : X[13]; l_ = X[12] > X[13] ? X[13] : X[12]; X[12] = h_; X[13] = l_; h_ = X[14] > X[15] ? X[14] : X[15]; l_ = X[14] > X[15] ? X[15] : X[14]; X[14] = h_; X[15] = l_; } while (0)
#define MERGE16(X) do { unsigned h_, l_; h_ = X[0] > X[8] ? X[0] : X[8]; l_ = X[0] > X[8] ? X[8] : X[0]; X[0] = h_; X[8] = l_; h_ = X[1] > X[9] ? X[1] : X[9]; l_ = X[1] > X[9] ? X[9] : X[1]; X[1] = h_; X[9] = l_; h_ = X[2] > X[10] ? X[2] : X[10]; l_ = X[2] > X[10] ? X[10] : X[2]; X[2] = h_; X[10] = l_; h_ = X[3] > X[11] ? X[3] : X[11]; l_ = X[3] > X[11] ? X[11] : X[3]; X[3] = h_; X[11] = l_; h_ = X[4] > X[12] ? X[4] : X[12]; l_ = X[4] > X[12] ? X[12] : X[4]; X[4] = h_; X[12] = l_; h_ = X[5] > X[13] ? X[5] : X[13]; l_ = X[5] > X[13] ? X[13] : X[5]; X[5] = h_; X[13] = l_; h_ = X[6] > X[14] ? X[6] : X[14]; l_ = X[6] > X[14] ? X[14] : X[6]; X[6] = h_; X[14] = l_; h_ = X[7] > X[15] ? X[7] : X[15]; l_ = X[7] > X[15] ? X[15] : X[7]; X[7] = h_; X[15] = l_; h_ = X[0] > X[4] ? X[0] : X[4]; l_ = X[0] > X[4] ? X[4] : X[0]; X[0] = h_; X[4] = l_; h_ = X[1] > X[5] ? X[1] : X[5]; l_ = X[1] > X[5] ? X[5] : X[1]; X[1] = h_; X[5] = l_; h_ = X[2] > X[6] ? X[2] : X[6]; l_ = X[2] > X[6] ? X[6] : X[2]; X[2] = h_; X[6] = l_; h_ = X[3] > X[7] ? X[3] : X[7]; l_ = X[3] > X[7] ? X[7] : X[3]; X[3] = h_; X[7] = l_; h_ = X[8] > X[12] ? X[8] : X[12]; l_ = X[8] > X[12] ? X[12] : X[8]; X[8] = h_; X[12] = l_; h_ = X[9] > X[13] ? X[9] : X[13]; l_ = X[9] > X[13] ? X[13] : X[9]; X[9] = h_; X[13] = l_; h_ = X[10] > X[14] ? X[10] : X[14]; l_ = X[10] > X[14] ? X[14] : X[10]; X[10] = h_; X[14] = l_; h_ = X[11] > X[15] ? X[11] : X[15]; l_ = X[11] > X[15] ? X[15] : X[11]; X[11] = h_; X[15] = l_; h_ = X[0] > X[2] ? X[0] : X[2]; l_ = X[0] > X[2] ? X[2] : X[0]; X[0] = h_; X[2] = l_; h_ = X[1] > X[3] ? X[1] : X[3]; l_ = X[1] > X[3] ? X[3] : X[1]; X[1] = h_; X[3] = l_; h_ = X[4] > X[6] ? X[4] : X[6]; l_ = X[4] > X[6] ? X[6] : X[4]; X[4] = h_; X[6] = l_; h_ = X[5] > X[7] ? X[5] : X[7]; l_ = X[5] > X[7] ? X[7] : X[5]; X[5] = h_; X[7] = l_; h_ = X[8] > X[10] ? X[8] : X[10]; l_ = X[8] > X[10] ? X[10] : X[8]; X[8] = h_; X[10] = l_; h_ = X[9] > X[11] ? X[9] : X[11]; l_ = X[9] > X[11] ? X[11] : X[9]; X[9] = h_; X[11] = l_; h_ = X[12] > X[14] ? X[12] : X[14]; l_ = X[12] > X[14] ? X[14] : X[12]; X[12] = h_; X[14] = l_; h_ = X[13] > X[15] ? X[13] : X[15]; l_ = X[13] > X[15] ? X[15] : X[13]; X[13] = h_; X[15] = l_; h_ = X[0] > X[1] ? X[0] : X[1]; l_ = X[0] > X[1] ? X[1] : X[0]; X[0] = h_; X[1] = l_; h_ = X[2] > X[3] ? X[2] : X[3]; l_ = X[2] > X[3] ? X[3] : X[2]; X[2] = h_; X[3] = l_; h_ = X[4] > X[5] ? X[4] : X[5]; l_ = X[4] > X[5] ? X[5] : X[4]; X[4] = h_; X[5] = l_; h_ = X[6] > X[7] ? X[6] : X[7]; l_ = X[6] > X[7] ? X[7] : X[6]; X[6] = h_; X[7] = l_; h_ = X[8] > X[9] ? X[8] : X[9]; l_ = X[8] > X[9] ? X[9] : X[8]; X[8] = h_; X[9] = l_; h_ = X[10] > X[11] ? X[10] : X[11]; l_ = X[10] > X[11] ? X[11] : X[10]; X[10] = h_; X[11] = l_; h_ = X[12] > X[13] ? X[12] : X[13]; l_ = X[12] > X[13] ? X[13] : X[12]; X[12] = h_; X[13] = l_; h_ = X[14] > X[15] ? X[14] : X[15]; l_ = X[14] > X[15] ? X[15] : X[14]; X[14] = h_; X[15] = l_; } while (0)

__device__ __forceinline__ unsigned f2ord(float f) { const unsigned u = __float_as_uint(f); return (u & 0x80000000u) ? ~u : (u | 0x80000000u); }
__device__ __forceinline__ float ord2f(unsigned o) { return __uint_as_float((o & 0x80000000u) ? (o & 0x7fffffffu) : ~o); }
#define CANDKEY(sum, c) ((f2ord(sum) & ~255u) | (255u - (unsigned)(c)))
__device__ __forceinline__ void xmerge16(unsigned (&X)[16], int mask) {
  unsigned T[16];
#pragma unroll
  for (int i = 0; i < 16; ++i) T[i] = (unsigned)__shfl_xor((int)X[15 - i], mask);
#pragma unroll
  for (int i = 0; i < 16; ++i) X[i] = X[i] > T[i] ? X[i] : T[i];
  MERGE16(X);
}

__device__ __forceinline__ void ph9_topk(const P& p, int bid, int nb, char* smem) {
  const int tid = threadIdx.x & 255, lane = tid & 63, wave = tid >> 6, lr = lane & 15, lq = lane >> 4;
  bf16_t* kl = (bf16_t*)smem;
  int* idxs = (int*)(smem + 65536) + wave * 512;
  const int h = ((bid >> 1) & 3) * 2 + (bid & 1), nper = nb >> 3, wgi = bid >> 3;
  for (int idx = tid; idx < 4096; idx += NTHR) {
    const int row = idx >> 4, c = idx & 15;
    *(u32x4*)(kl + row * 128 + ((c ^ (row & 15)) << 3)) = *(const u32x4*)(p.keys_bf + (size_t)h * 32768 + row * 128 + c * 8);
  }
  __syncthreads();
  const __amdgpu_buffer_rsrc_t r_q = mk_rsrc(p.qb);
  for (int tile = wgi * 4 + wave; tile < 1024; tile += nper * 4) {
    const int tok = tile * 16 + lr;
    unsigned R0[16], R1[16];
#pragma unroll
    for (int pp = 0; pp < 2; ++pp) {
      bf16x8 bq[4];
#pragma unroll
      for (int kk = 0; kk < 4; ++kk) bq[kk] = bload8(r_q, (lr * 2048 + lq * 8) * 2 + kk * 64, (tile * 16 * 2048 + h * 256 + pp * 128) * 2);
      f32x4 acc[8];
#pragma unroll
      for (int j = 0; j < 8; ++j) acc[j] = (f32x4){0.f, 0.f, 0.f, 0.f};
#pragma unroll
      for (int j = 0; j < 8; ++j)
#pragma unroll
        for (int kk = 0; kk < 4; ++kk) {
          const bf16x8 a = *(const bf16x8*)(kl + (pp * 128 + j * 16 + lr) * 128 + (((kk * 4 + lq) ^ lr) << 3));
          acc[j] = __builtin_amdgcn_mfma_f32_16x16x32_bf16(a, bq[kk], acc[j], 0, 0, 0);
        }
      unsigned X[16], Y[16];
#pragma unroll
      for (int j = 0; j < 4; ++j)
#pragma unroll
        for (int e = 0; e < 4; ++e) {
          X[j * 4 + e] = (f2ord(acc[j][e]) & ~127u) | (127u - (unsigned)(j * 16 + lq * 4 + e));
          Y[j * 4 + e] = (f2ord(acc[4 + j][e]) & ~127u) | (127u - (unsigned)((4 + j) * 16 + lq * 4 + e));
        }
      SORT16(X);
      SORT16(Y);
#pragma unroll
      for (int i = 0; i < 16; ++i) X[i] = X[i] > Y[15 - i] ? X[i] : Y[15 - i];
      MERGE16(X);
      xmerge16(X, 16);
      xmerge16(X, 32);
#pragma unroll
      for (int i = 0; i < 16; ++i) { if (pp == 0) R0[i] = X[i]; else R1[i] = X[i]; }
    }
    if (lq == 0) {
#pragma unroll
      for (int i = 0; i < 16; ++i) { idxs[lr * 32 + i] = 127 - (int)(R0[i] & 127u); idxs[lr * 32 + 16 + i] = 127 - (int)(R1[i] & 127u); }
    }
    asm volatile("s_waitcnt lgkmcnt(0)" ::: "memory");
    float va[16], vb[16];
#pragma unroll
    for (int i = 0; i < 16; ++i) { va[i] = ord2f(R0[i] & ~127u); vb[i] = ord2f(R1[i] & ~127u); }
    unsigned F[16];
  F[0] = lq == 0 ? CANDKEY(va[0] + vb[0], 0) : (lq == 1 ? CANDKEY(va[1] + vb[0], 16) : (lq == 2 ? CANDKEY(va[3] + vb[0], 48) : CANDKEY(va[13] + vb[0], 208)));
  F[1] = lq == 0 ? CANDKEY(va[0] + vb[1], 1) : (lq == 1 ? CANDKEY(va[1] + vb[1], 17) : (lq == 2 ? CANDKEY(va[3] + vb[1], 49) : CANDKEY(va[14] + vb[0], 224)));
  F[2] = lq == 0 ? CANDKEY(va[0] + vb[2], 2) : (lq == 1 ? CANDKEY(va[1] + vb[2], 18) : (lq == 2 ? CANDKEY(va[3] + vb[2], 50) : CANDKEY(va[15] + vb[0], 240)));
  F[3] = lq == 0 ? CANDKEY(va[0] + vb[3], 3) : (lq == 1 ? CANDKEY(va[1] + vb[3], 19) : (lq == 2 ? CANDKEY(va[3] + vb[3], 51) : 0u));
  F[4] = lq == 0 ? CANDKEY(va[0] + vb[4], 4) : (lq == 1 ? CANDKEY(va[1] + vb[4], 20) : (lq == 2 ? CANDKEY(va[4] + vb[0], 64) : 0u));
  F[5] = lq == 0 ? CANDKEY(va[0] + vb[5], 5) : (lq == 1 ? CANDKEY(va[1] + vb[5], 21) : (lq == 2 ? CANDKEY(va[4] + vb[1], 65) : 0u));
  F[6] = lq == 0 ? CANDKEY(va[0] + vb[6], 6) : (lq == 1 ? CANDKEY(va[1] + vb[6], 22) : (lq == 2 ? CANDKEY(va[4] + vb[2], 66) : 0u));
  F[7] = lq == 0 ? CANDKEY(va[0] + vb[7], 7) : (lq == 1 ? CANDKEY(va[1] + vb[7], 23) : (lq == 2 ? CANDKEY(va[6] + vb[0], 96) : 0u));
  F[8] = lq == 0 ? CANDKEY(va[0] + vb[8], 8) : (lq == 1 ? CANDKEY(va[2] + vb[0], 32) : (lq == 2 ? CANDKEY(va[6] + vb[1], 97) : 0u));
  F[9] = lq == 0 ? CANDKEY(va[0] + vb[9], 9) : (lq == 1 ? CANDKEY(va[2] + vb[1], 33) : (lq == 2 ? CANDKEY(va[7] + vb[0], 112) : 0u));
  F[10] = lq == 0 ? CANDKEY(va[0] + vb[10], 10) : (lq == 1 ? CANDKEY(va[2] + vb[2], 34) : (lq == 2 ? CANDKEY(va[7] + vb[1], 113) : 0u));
  F[11] = lq == 0 ? CANDKEY(va[0] + vb[11], 11) : (lq == 1 ? CANDKEY(va[2] + vb[3], 35) : (lq == 2 ? CANDKEY(va[8] + vb[0], 128) : 0u));
  F[12] = lq == 0 ? CANDKEY(va[0] + vb[12], 12) : (lq == 1 ? CANDKEY(va[2] + vb[4], 36) : (lq == 2 ? CANDKEY(va[9] + vb[0], 144) : 0u));
  F[13] = lq == 0 ? CANDKEY(va[0] + vb[13], 13) : (lq == 1 ? CANDKEY(va[5] + vb[0], 80) : (lq == 2 ? CANDKEY(va[10] + vb[0], 160) : 0u));
  F[14] = lq == 0 ? CANDKEY(va[0] + vb[14], 14) : (lq == 1 ? CANDKEY(va[5] + vb[1], 81) : (lq == 2 ? CANDKEY(va[11] + vb[0], 176) : 0u));
  F[15] = lq == 0 ? CANDKEY(va[0] + vb[15], 15) : (lq == 1 ? 0u : (lq == 2 ? CANDKEY(va[12] + vb[0], 192) : 0u));

    SORT16(F);
    xmerge16(F, 16);
    xmerge16(F, 32);
    if (lq == 0) {
      float ev[16];
      const float mx = ord2f(F[0] & ~255u);
      float tot = 0.f;
#pragma unroll
      for (int r = 0; r < 16; ++r) { ev[r] = __expf(ord2f(F[r] & ~255u) - mx); tot += ev[r]; }
      const float inv = 1.f / tot;
      int ei[16];
#pragma unroll
      for (int r = 0; r < 16; ++r) {
        const int c = 255 - (int)(F[r] & 255u);
        ei[r] = idxs[lr * 32 + (c >> 4)] * 128 + idxs[lr * 32 + 16 + (c & 15)];
      }
      unsigned short* ep = p.eidx + (size_t)tok * 128 + h * 16;
      float* gp = p.gate + (size_t)tok * 128 + h * 16;
#pragma unroll
      for (int r = 0; r < 4; ++r) {
        *(f32x4*)(gp + r * 4) = (f32x4){ev[r * 4] * inv, ev[r * 4 + 1] * inv, ev[r * 4 + 2] * inv, ev[r * 4 + 3] * inv};
      }
#pragma unroll
      for (int r = 0; r < 2; ++r)
        *(u32x4*)(ep + r * 8) = (u32x4){(unsigned)ei[r * 8] | ((unsigned)ei[r * 8 + 1] << 16), (unsigned)ei[r * 8 + 2] | ((unsigned)ei[r * 8 + 3] << 16),
                                         (unsigned)ei[r * 8 + 4] | ((unsigned)ei[r * 8 + 5] << 16), (unsigned)ei[r * 8 + 6] | ((unsigned)ei[r * 8 + 7] << 16)};
    }
  }
}

__device__ __forceinline__ void ph_convert_tables(const P& p, int bid, int nb) {
  const int wave = (threadIdx.x >> 6) & 3, lane = threadIdx.x & 63;
  for (int row = bid * 4 + wave; row < 32768; row += nb * 4) {
    const bool isu = row < 16384;
    const float* src = isu ? p.U + (size_t)row * 1024 : p.V + (size_t)(row - 16384) * 1024;
    unsigned char* dst = isu ? p.U8 + (size_t)row * 1024 : p.V8 + (size_t)(row - 16384) * 1024;
    const float sc = isu ? 512.f : 32.f;
#pragma unroll
    for (int j = 0; j < 4; ++j) {
      const f32x4 v = __builtin_nontemporal_load((const f32x4*)src + j * 64 + lane);
      int w = 0;
      w = __builtin_amdgcn_cvt_pk_fp8_f32(v.x * sc, v.y * sc, w, false);
      w = __builtin_amdgcn_cvt_pk_fp8_f32(v.z * sc, v.w * sc, w, true);
      *(int*)(dst + j * 256 + lane * 4) = w;
    }
  }
}

__device__ __forceinline__ float gelu_exact(float a) { return 0.5f * a * (1.f + erff(a * 0.70710678118654752f)); }

#define G_LOAD(buf, j, g_) do { const int g__ = (g_); const int er__ = (g__ & 8) ? e1s[j] : e0s[j]; \
    _Pragma("unroll") for (int k = 0; k < 8; ++k) { const int e__ = __builtin_amdgcn_readlane(er__, (g__ & 7) * 8 + k); \
      buf[k] = *((const u32x4*)(tab + (size_t)e__ * 1024) + lane); } } while (0)
#define G_COMPUTE_U(buf, j, g_) do { const int g__ = (g_); \
      float pp[8]; \
      _Pragma("unroll") for (int k = 0; k < 8; ++k) { \
        f32x2 ac = {0.f, 0.f}; \
        _Pragma("unroll") for (int d = 0; d < 4; ++d) { \
          ac = __builtin_amdgcn_cvt_pk_f32_fp8((int)buf[k][d], false) * x2[j][2 * d] + ac; \
          ac = __builtin_amdgcn_cvt_pk_f32_fp8((int)buf[k][d], true) * x2[j][2 * d + 1] + ac; } \
        pp[k] = ac.x + ac.y; } \
        \
      float q4[4], r2[2], tt; \
      _Pragma("unroll") for (int i = 0; i < 4; ++i) { const float sd = b5 ? pp[i] : pp[i + 4]; q4[i] = (b5 ? pp[i + 4] : pp[i]) + __shfl_xor(sd, 32); } \
      _Pragma("unroll") for (int i = 0; i < 2; ++i) { const float sd = b4 ? q4[i] : q4[i + 2]; r2[i] = (b4 ? q4[i + 2] : q4[i]) + __shfl_xor(sd, 16); } \
      { const float sd = b3 ? r2[0] : r2[1]; tt = (b3 ? r2[1] : r2[0]) + __shfl_xor(sd, 8); } \
      tt += __shfl_xor(tt, 4); tt += __shfl_xor(tt, 2); tt += __shfl_xor(tt, 1); \
      const float dv = __shfl(tt, (lane & 7) * 8); \
      if ((lane >> 3) == (g__ & 7)) { if (g__ & 8) a1[j] = dv; else a0[j] = dv; } } while (0)
#define G_COMPUTE_V(buf, j, g_) do { const int g__ = (g_); \
      const int wr__ = __float_as_int((g__ & 8) ? w1s[j] : w0s[j]); \
      _Pragma("unroll") for (int k = 0; k < 8; ++k) { \
        const float w__ = __int_as_float(__builtin_amdgcn_readlane(wr__, (g__ & 7) * 8 + k)); \
        const f32x2 ww = {w__, w__}; \
        _Pragma("unroll") for (int d = 0; d < 4; ++d) { \
          y2[j][2 * d] = __builtin_amdgcn_cvt_pk_f32_fp8((int)buf[k][d], false) * ww + y2[j][2 * d]; \
          y2[j][2 * d + 1] = __builtin_amdgcn_cvt_pk_f32_fp8((int)buf[k][d], true) * ww + y2[j][2 * d + 1]; } } } while (0)
#define G_SWEEP(COMP) do { \
    G_LOAD(A, 0, 0); G_LOAD(B, 1, 0); G_LOAD(C, 0, 1); \
    _Pragma("unroll 1") for (int g = 0; g < 16; g += 2) { \
      const int gn = g + 2 < 16 ? g + 2 : g;              \
      G_LOAD(D, 1, g + 1); COMP(A, 0, g); \
      G_LOAD(A, 0, gn); COMP(B, 1, g); \
      G_LOAD(B, 1, gn); COMP(C, 0, g + 1); \
      G_LOAD(C, 0, gn + 1); COMP(D, 1, g + 1); } } while (0)

__device__ __forceinline__ void ph10_gather(const P& p, int bid, int nb, char* smem) {
  const int wave = __builtin_amdgcn_readfirstlane((threadIdx.x >> 6) & 3), lane = threadIdx.x & 63;
  const bool b5 = lane & 32, b4 = lane & 16, b3 = lane & 8;
  int* se = (int*)(smem + wave * 1024);
  float* sg = (float*)(se + 128);
  for (int oct = bid * 4 + wave; oct < TL / 8; oct += nb * 4) {
#pragma unroll 1
    for (int grp = 0; grp < 4; ++grp) {
      int diag_bad = 0;
      const int tok0 = oct * 8 + grp * 2;
      int e0s[2], e1s[2];
      float g0s[2], g1s[2], a0[2], a1[2], w0s[2], w1s[2];
      f32x2 x2[2][8], y2[2][8];
#pragma unroll
      for (int j = 0; j < 2; ++j) {
        const int tok = tok0 + j;
        const int e0 = (int)p.eidx[(size_t)tok * 128 + lane], e1 = (int)p.eidx[(size_t)tok * 128 + 64 + lane];
        const float g0 = p.gate[(size_t)tok * 128 + lane], g1 = p.gate[(size_t)tok * 128 + 64 + lane];
        {
          const float gs = wave_sum(g0 + g1);
          const bool bad = (e0 < 0) || (e0 > 16383) || (e1 < 0) || (e1 > 16383) || !(fabsf(gs - 8.f) < 1e-2f);
          if (__ballot(bad) != 0ull) diag_bad = 1;
        }
        const int sl0 = e0 >> 10, sl1 = e1 >> 10;
        int base = 0, pos0 = 0, pos1 = 0;
#pragma unroll
        for (int sidx = 0; sidx < 16; ++sidx) {
          const unsigned long long m0 = __ballot(sl0 == sidx), m1 = __ballot(sl1 == sidx);
          const int c0 = __popcll(m0), c1 = __popcll(m1);
          const int r0 = __builtin_amdgcn_mbcnt_hi((unsigned)(m0 >> 32), __builtin_amdgcn_mbcnt_lo((unsigned)m0, 0u));
          const int r1 = __builtin_amdgcn_mbcnt_hi((unsigned)(m1 >> 32), __builtin_amdgcn_mbcnt_lo((unsigned)m1, 0u));
          if (sl0 == sidx) pos0 = base + r0;
          if (sl1 == sidx) pos1 = base + c0 + r1;
          base += c0 + c1;
        }
        asm volatile("s_waitcnt lgkmcnt(0)" ::: "memory");
        se[pos0] = e0; se[pos1] = e1; sg[pos0] = g0; sg[pos1] = g1;
        asm volatile("s_waitcnt lgkmcnt(0)" ::: "memory");
        e0s[j] = se[lane]; e1s[j] = se[64 + lane]; g0s[j] = sg[lane]; g1s[j] = sg[64 + lane];
        asm volatile("s_waitcnt lgkmcnt(0)" ::: "memory");
        const u32x4 h0 = *((const u32x4*)(p.hn + (size_t)tok * 1024 + lane * 16));
        const u32x4 h1 = *((const u32x4*)(p.hn + (size_t)tok * 1024 + lane * 16 + 8));
#pragma unroll
        for (int i = 0; i < 4; ++i) { x2[j][i] = (f32x2){blo(h0[i]), bhi(h0[i])}; x2[j][4 + i] = (f32x2){blo(h1[i]), bhi(h1[i])}; }
        a0[j] = 0.f; a1[j] = 0.f;
      }
      u32x4 A[8], B[8], C[8], D[8];
      { const unsigned char* tab = p.U8; G_SWEEP(G_COMPUTE_U); }
#pragma unroll
      for (int j = 0; j < 2; ++j) { w0s[j] = gelu_exact(a0[j] * (1.f / 512.f)) * g0s[j]; w1s[j] = gelu_exact(a1[j] * (1.f / 512.f)) * g1s[j];
#pragma unroll
        for (int i = 0; i < 8; ++i) y2[j][i] = (f32x2){0.f, 0.f}; }
      { const unsigned char* tab = p.V8; G_SWEEP(G_COMPUTE_V); }
#pragma unroll
      for (int j = 0; j < 2; ++j) {
        const int tok = tok0 + j, b = tok / SEQ;
        float* orow = p.out + (size_t)tok * 1024 + lane * 16;
        const float* g2 = p.mod + b * 6144 + 5 * 1024 + lane * 16;
        float z[16];
        float ss = 0.f;
#pragma unroll
        for (int q = 0; q < 4; ++q) {
          const f32x4 xl = *(const f32x4*)(orow + q * 4);
          const f32x4 gg = *(const f32x4*)(g2 + q * 4);
          const float yv[4] = {y2[j][2 * q].x, y2[j][2 * q].y, y2[j][2 * q + 1].x, y2[j][2 * q + 1].y};
#pragma unroll
          for (int i = 0; i < 4; ++i) { const float zz = xl[i] + gg[i] * (yv[i] * (1.f / 32.f)); z[q * 4 + i] = zz; ss += zz * zz; }
        }
        ss = wave_sum(ss);
        const float rstd = rsqrtf(ss * (1.f / 1024.f) + 1e-6f);
#pragma unroll
        for (int q = 0; q < 4; ++q) {
          const f32x4 fw = *(const f32x4*)(p.final_norm_w + lane * 16 + q * 4);
          f32x4 o;
#pragma unroll
          for (int i = 0; i < 4; ++i) o[i] = diag_bad ? __builtin_inff() : z[q * 4 + i] * rstd * fw[i];
          *(f32x4*)(orow + q * 4) = o;
        }
      }
    }
  }
}

__global__ void __launch_bounds__(2 * NTHR, 2) mega(P p) {
  __shared__ __attribute__((aligned(16))) char smem_all[2 * LDS_HALF];
  cg::grid_group grid = cg::this_grid();
  const int half = __builtin_amdgcn_readfirstlane(threadIdx.x >> 8);
  char* smem = smem_all + half * LDS_HALF;
  const int bid = blockIdx.x * 2 + half, nb = gridDim.x * 2;
#ifndef REPEAT_MASK
#define REPEAT_MASK 0
#endif
#ifndef EXTRA_SYNCS
#define EXTRA_SYNCS 0
#endif
#define GSYNC() do { asm volatile("s_waitcnt vmcnt(0)" ::: "memory"); grid.sync(); } while (0)
#define RUN(k, call) if ((PHMASK & (1 << k)) && p.ph_lo <= k && k < p.ph_hi) { call; if (REPEAT_MASK & (1 << k)) { GSYNC(); call; } \
    if (k + 1 < p.ph_hi) { GSYNC(); for (int xs = 0; xs < EXTRA_SYNCS; ++xs) GSYNC(); } }
  RUN(0, ph0_prep(p, bid, nb, smem))
  RUN(1, ph_norm_rows<0>(p, bid, nb))
  RUN(2, ph_gemm8<0>(p, smem_all))
  RUN(3, ph3_chunk_local(p, bid, nb, smem))
  RUN(4, ph4_scan(p, bid, nb))
  RUN(5, ph5_mlstm_out(p, bid, nb, smem))
  RUN(6, (ph_gemm8<1>(p, smem_all), ph_convert_tables(p, bid, nb)))
  RUN(7, ph_norm_rows<1>(p, bid, nb))
  RUN(8, ph_gemm8<2>(p, smem_all))
  RUN(9, ph9_topk(p, bid, nb, smem))
  RUN(10, ph10_gather(p, bid, nb, smem))
#undef RUN
}

extern "C" void kernel_launch(void* const* d_in, const int* in_sizes, int n_in, void* d_out, int out_size, void* d_ws, size_t ws_size,
                              hipStream_t stream) {
  static int grid_blocks = 0;
  if (!grid_blocks) {
    int dev = 0, cus = 0, per_cu = 0;
    hipGetDevice(&dev);
    hipDeviceGetAttribute(&cus, hipDeviceAttributeMultiprocessorCount, dev);
    hipOccupancyMaxActiveBlocksPerMultiprocessor(&per_cu, (const void*)mega, 2 * NTHR, 0);
    per_cu = 1;
    grid_blocks = cus * per_cu;
    if (ws_size < WS_END) fprintf(stderr, "kernel_launch: workspace too small: %zu < %llu\n", ws_size, (unsigned long long)WS_END);
  }
  P p{};
  const float* const* in = (const float* const*)d_in;
  p.x = in[0]; p.c = in[1]; p.ctx = in[2]; p.c_ctx = in[3]; p.w_mod = in[4]; p.b_mod = in[5]; p.norm1_w = in[6]; p.w_in = in[7];
  p.conv_w = in[8]; p.conv_b = in[9]; p.b_gates = in[10]; p.head_norm_w = in[11]; p.pool_w = in[12]; p.pool_scale = in[13];
  p.w_out = in[14]; p.norm2_w = in[15]; p.wq = in[16]; p.keys = in[17]; p.U = in[18]; p.V = in[19]; p.final_norm_w = in[20];
  p.out = (float*)d_out;
  char* ws = (char*)d_ws;
  p.mod = (float*)(ws + OFF_MOD); p.gates = (float*)(ws + OFF_GATES);
  p.wt_in = (bf16_t*)(ws + OFF_WTIN); p.wt_out = (bf16_t*)(ws + OFF_WTOUT); p.wt_q = (bf16_t*)(ws + OFF_WTQ);
  p.keys_bf = (bf16_t*)(ws + OFF_KEYS); p.hn = (bf16_t*)(ws + OFF_HN); p.pl = (bf16_t*)(ws + OFF_PL);
  p.Dst = (bf16_t*)(ws + OFF_D); p.ND = (float*)(ws + OFF_ND); p.SC = (float*)(ws + OFF_SC);
  p.CIN = (bf16_t*)(ws + OFF_CIN); p.NIN = (float*)(ws + OFF_NIN); p.MIN_ = (float*)(ws + OFF_MIN);
  p.mix = (bf16_t*)(ws + OFF_D); p.qb = (bf16_t*)(ws + OFF_D);
  p.U8 = (unsigned char*)(ws + OFF_U8); p.V8 = (unsigned char*)(ws + OFF_U8 + 16777216ull);
  p.eidx = (unsigned short*)(ws + OFF_EIDX); p.gate = (float*)(ws + OFF_GATE);
#if N_LAUNCHES == 1
  p.ph_lo = 0; p.ph_hi = NPH;
  void* args[] = {&p};
  hipError_t e = hipLaunchCooperativeKernel((const void*)mega, dim3(grid_blocks), dim3(2 * NTHR), args, 0, stream);
  if (e != hipSuccess) fprintf(stderr, "cooperative launch failed: %s (grid %d)\n", hipGetErrorString(e), grid_blocks);
#else
  for (int ph = 0; ph < NPH; ++ph) {
    p.ph_lo = ph; p.ph_hi = ph + 1;
    void* args[] = {&p};
    hipError_t e = hipLaunchCooperativeKernel((const void*)mega, dim3(grid_blocks), dim3(2 * NTHR), args, 0, stream);
    if (e != hipSuccess) fprintf(stderr, "launch %d failed: %s (grid %d)\n", ph, hipGetErrorString(e), grid_blocks);
  }
#endif
}
```

```cpp
#include <hip/hip_runtime.h>
#include <hip/hip_cooperative_groups.h>
#include <stdint.h>
#include <stdio.h>
namespace cg = cooperative_groups;

#ifndef PHMASK
#define PHMASK 0x7ff
#endif
#ifndef N_LAUNCHES
#define N_LAUNCHES 1
#endif

typedef unsigned short bf16_t;
typedef short bf16x8 __attribute__((ext_vector_type(8)));
typedef float f32x4 __attribute__((ext_vector_type(4)));
typedef unsigned u32x4 __attribute__((ext_vector_type(4)));
typedef float f32x2 __attribute__((ext_vector_type(2)));
typedef unsigned u32x2 __attribute__((ext_vector_type(2)));
typedef __bf16 bf16x2 __attribute__((ext_vector_type(2)));

#define NB 8
#define SEQ 2048
#define DM 1024
#define CTXL 256
#define TL 16384
#define TC 2048
#define TR 18432
#define LDP 2624
#define NPADIN 2688
#define NTHR 256
#define LDS_HALF 73728
#define NPH 11

#define OFF_MOD    (4096ull)
#define OFF_GATES  (OFF_MOD + 262144ull)
#define OFF_WTIN   (OFF_GATES + 1179648ull)
#define OFF_WTOUT  (OFF_WTIN + 5767168ull)
#define OFF_WTQ    (OFF_WTOUT + 2097152ull)
#define OFF_KEYS   (OFF_WTQ + 4194304ull)
#define OFF_POOLWT (OFF_KEYS + 524288ull)
#define OFF_HN     (OFF_POOLWT + 131072ull)
#define OFF_PL     (OFF_HN + 37748736ull)
#define OFF_D      (OFF_PL + 96731136ull)
#define OFF_ND     (OFF_D + 37748736ull)
#define OFF_SC     (OFF_ND + 589824ull)
#define OFF_CIN    (OFF_SC + 147456ull)
#define OFF_NIN    (OFF_CIN + 33554432ull)
#define OFF_MIN    (OFF_NIN + 524288ull)
#define OFF_EIDX   (OFF_MIN + 131072ull)
#define OFF_GATE   (OFF_EIDX + 4194304ull)
#define OFF_U8     (OFF_GATE + 8388608ull)
#define WS_END     (OFF_U8 + 33554432ull)

struct P {
  const float *x, *c, *ctx, *c_ctx, *w_mod, *b_mod, *norm1_w, *w_in, *conv_w, *conv_b, *b_gates, *head_norm_w,
      *pool_w, *pool_scale, *w_out, *norm2_w, *wq, *keys, *U, *V, *final_norm_w;
  float* out;
  float* mod;
  float* gates;
  bf16_t* wt_in;
  bf16_t* wt_out;
  bf16_t* wt_q;
  bf16_t* keys_bf;
  bf16_t* hn;
  bf16_t* pl;
  bf16_t* Dst;
  float* ND;
  float* SC;
  bf16_t* CIN;
  float* NIN;
  float* MIN_;
  bf16_t* mix;
  bf16_t* qb;
  unsigned char* U8;
  unsigned char* V8;
  unsigned short* eidx;
  float* gate;
  int ph_lo, ph_hi;
  unsigned* bar;
};

__device__ __forceinline__ bf16_t f2bf(float f) { return __builtin_bit_cast(bf16_t, (__bf16)f); }
__device__ __forceinline__ float bf2f(bf16_t h) { return __uint_as_float(((unsigned)h) << 16); }
__device__ __forceinline__ float wave_sum(float v) {
#pragma unroll
  for (int o = 32; o > 0; o >>= 1) v += __shfl_xor(v, o);
  return v;
}
__device__ __forceinline__ float silu_f(float v) { return v / (1.f + __expf(-v)); }
__device__ __forceinline__ float logsig_f(float v) { return fminf(v, 0.f) - log1pf(__expf(-fabsf(v))); }

__device__ __forceinline__ __amdgpu_buffer_rsrc_t mk_rsrc(const void* ptr) { return __builtin_amdgcn_make_buffer_rsrc((void*)ptr, 0, 0x7fffffff, 0x00020000); }
__device__ __forceinline__ bf16x8 bload8(__amdgpu_buffer_rsrc_t r, int voff, int soff) { return __builtin_bit_cast(bf16x8, __builtin_amdgcn_raw_buffer_load_b128(r, voff, soff, 0)); }
#define AUX_SC1 16
__device__ __forceinline__ bf16x8 bload8c(__amdgpu_buffer_rsrc_t r, int voff, int soff) { return __builtin_bit_cast(bf16x8, __builtin_amdgcn_raw_buffer_load_b128(r, voff, soff, AUX_SC1)); }
__device__ __forceinline__ u32x2 uload2c(__amdgpu_buffer_rsrc_t r, int voff, int soff) { return __builtin_bit_cast(u32x2, __builtin_amdgcn_raw_buffer_load_b64(r, voff, soff, AUX_SC1)); }
__device__ __forceinline__ float fload1c(__amdgpu_buffer_rsrc_t r, int voff, int soff) { return __builtin_bit_cast(float, __builtin_amdgcn_raw_buffer_load_b32(r, voff, soff, AUX_SC1)); }
__device__ __forceinline__ f32x4 fload4c(__amdgpu_buffer_rsrc_t r, int voff, int soff) { return __builtin_bit_cast(f32x4, __builtin_amdgcn_raw_buffer_load_b128(r, voff, soff, AUX_SC1)); }
__device__ __forceinline__ u32x4 uload4c(__amdgpu_buffer_rsrc_t r, int voff, int soff) { return __builtin_bit_cast(u32x4, __builtin_amdgcn_raw_buffer_load_b128(r, voff, soff, AUX_SC1)); }

__device__ __forceinline__ void ph0_prep(const P& p, int bid, int nb, char* smem) {
  float* sm = (float*)smem;
  const int tid = threadIdx.x & 255;
  const int N_MOD = 384, N_TIN = 16 * 44, N_TOUT = 256, N_TQ = 16 * 32, N_POOL = 16;
  const int total = N_MOD + N_TIN + N_TOUT + N_TQ + N_POOL;
  const int trips = (total + nb - 1) / nb;
  for (int k = 0; k < trips; ++k) {
    int r = (bid + k * nb) % total;
    if (r < N_MOD) {
      float* part = sm + 9 * 1024;
      for (int i = tid; i < 9 * 1024; i += NTHR) {
        int rr = i >> 10, kq = i & 1023;
        float v = rr < 8 ? p.c[rr * 1024 + kq] : p.c_ctx[kq];
        sm[i] = silu_f(v);
      }
      __syncthreads();
      {
        const int c = tid & 15, kg = tid >> 4, n = r * 16 + c;
        float acc[9];
#pragma unroll
        for (int q = 0; q < 9; ++q) acc[q] = 0.f;
#pragma unroll 8
        for (int i = 0; i < 64; ++i) {
          const int kq = kg + i * 16;
          const float w = p.w_mod[(size_t)kq * 6144 + n];
#pragma unroll
          for (int q = 0; q < 9; ++q) acc[q] += sm[q * 1024 + kq] * w;
        }
#pragma unroll
        for (int q = 0; q < 9; ++q) part[(kg * 9 + q) * 16 + c] = acc[q];
      }
      __syncthreads();
      if (tid < 144) {
        const int q = tid >> 4, c = tid & 15, n = r * 16 + c;
        float t = p.b_mod[n];
#pragma unroll
        for (int kg = 0; kg < 16; ++kg) t += part[(kg * 9 + q) * 16 + c];
        p.mod[q * 6144 + n] = t;
      }
      continue;
    }
    r -= N_MOD;
    const float* src = nullptr; bf16_t* dst = nullptr; int K = 1024, N = 0, ntn = 0;
    if (r < N_TIN) { src = p.w_in; dst = p.wt_in; N = 2576; ntn = 44; }
    else { r -= N_TIN;
      if (r < N_TOUT) { src = p.w_out; dst = p.wt_out; N = 1024; ntn = 16; }
      else { r -= N_TOUT;
        if (r < N_TQ) { src = p.wq; dst = p.wt_q; N = 2048; ntn = 32; }
        else { r -= N_TQ; int g = r >> 2; r &= 3; src = p.pool_w + g * 16384; dst = (bf16_t*)((char*)p.keys_bf + 524288) + g * 16384; K = 128; N = 128; ntn = 2; }
      }
    }
    {
      int kt = r / ntn, nt = r % ntn, k0 = kt * 64, n0 = nt * 64;
      int cc = tid & 63;
      for (int rr = tid >> 6; rr < 64; rr += 4) {
        int n = n0 + cc;
        sm[rr * 65 + cc] = n < N ? src[(size_t)(k0 + rr) * N + n] : 0.f;
      }
      __syncthreads();
      for (int rr = tid >> 6; rr < 64; rr += 4) dst[(size_t)(n0 + rr) * K + k0 + cc] = f2bf(sm[cc * 65 + rr]);
      __syncthreads();
    }
  }
  for (int i = bid * NTHR + tid; i < 262144; i += nb * NTHR) p.keys_bf[i] = f2bf(p.keys[i]);
}

template <int WHICH>
__device__ __forceinline__ void ph_norm_rows(const P& p, int bid, int nb) {
  const int wave = (threadIdx.x >> 6) & 3, lane = threadIdx.x & 63;
  const int nrows = WHICH == 0 ? TR : TL;
  for (int row = bid * 4 + wave; row < nrows; row += nb * 4) {
    const float* src = WHICH == 0 ? (row < TL ? p.x + (size_t)row * 1024 : p.ctx + (size_t)(row - TL) * 1024) : p.out + (size_t)row * 1024;
    const int mr = row < TL ? row / SEQ : 8;
    float4 v[4];
    float ss = 0.f;
#pragma unroll
    for (int j = 0; j < 4; ++j) {
      if (WHICH == 1) { const f32x4 t = fload4c(mk_rsrc(p.out), (row * 1024 + (j * 64 + lane) * 4) * 4, 0); v[j] = make_float4(t[0], t[1], t[2], t[3]); }
      else v[j] = ((const float4*)src)[j * 64 + lane];
      ss += v[j].x * v[j].x + v[j].y * v[j].y + v[j].z * v[j].z + v[j].w * v[j].w;
    }
    ss = wave_sum(ss);
    const float rstd = rsqrtf(ss * (1.f / 1024.f) + 1e-6f);
    const float* nw = WHICH == 0 ? p.norm1_w : p.norm2_w;
    const float* sh = p.mod + mr * 6144 + (WHICH == 0 ? 0 : 3) * 1024;
    const float* sc = sh + 1024;
#pragma unroll
    for (int j = 0; j < 4; ++j) {
      const int col = j * 256 + lane * 4;
      float4 w4 = *(const float4*)(nw + col), s4 = *(const float4*)(sh + col), c4 = *(const float4*)(sc + col);
      float y0 = v[j].x * rstd * w4.x * (1.f + c4.x) + s4.x;
      float y1 = v[j].y * rstd * w4.y * (1.f + c4.y) + s4.y;
      float y2 = v[j].z * rstd * w4.z * (1.f + c4.z) + s4.z;
      float y3 = v[j].w * rstd * w4.w * (1.f + c4.w) + s4.w;
      uint2 o;
      o.x = (unsigned)f2bf(y0) | ((unsigned)f2bf(y1) << 16);
      o.y = (unsigned)f2bf(y2) | ((unsigned)f2bf(y3) << 16);
      *(uint2*)(p.hn + (size_t)row * 1024 + col) = o;
    }
  }
}

#define GBK 64
#define GLD 72
template <int EPI>
__device__ __forceinline__ void gemm_tile(const P& p, const bf16_t* A, int lda, const bf16_t* Bt, int m0, int n0, bf16_t* sA, bf16_t* sB) {
  const int tid = threadIdx.x & 255, lane = tid & 63, wave = tid >> 6;
  const int wm = wave >> 1, wn = wave & 1;
  const int lr = lane & 15, lq = lane >> 4;
  f32x4 acc[4][4];
#pragma unroll
  for (int i = 0; i < 4; ++i)
#pragma unroll
    for (int j = 0; j < 4; ++j) acc[i][j] = (f32x4){0.f, 0.f, 0.f, 0.f};
  const int sr = tid >> 3, scol = (tid & 7) * 8;
  u32x4 ra[4], rb[4];
  const bf16_t* Ap = A + (size_t)(m0 + sr) * lda + scol;
  const bf16_t* Bp = Bt + (size_t)(n0 + sr) * 1024 + scol;
#pragma unroll
  for (int i = 0; i < 4; ++i) {
    ra[i] = *(const u32x4*)(Ap + (size_t)(i * 32) * lda);
    rb[i] = *(const u32x4*)(Bp + (size_t)(i * 32) * 1024);
  }
  for (int kt = 0; kt < 1024 / GBK; ++kt) {
    __syncthreads();
#pragma unroll
    for (int i = 0; i < 4; ++i) {
      *(u32x4*)(sA + (sr + i * 32) * GLD + scol) = ra[i];
      *(u32x4*)(sB + (sr + i * 32) * GLD + scol) = rb[i];
    }
    __syncthreads();
    {
      const int k0 = (kt + 1 < 1024 / GBK ? kt + 1 : kt) * GBK;
#pragma unroll
      for (int i = 0; i < 4; ++i) {
        ra[i] = *(const u32x4*)(Ap + (size_t)(i * 32) * lda + k0);
        rb[i] = *(const u32x4*)(Bp + (size_t)(i * 32) * 1024 + k0);
      }
    }
#pragma unroll
    for (int ks = 0; ks < 2; ++ks) {
      bf16x8 af[4], bfr[4];
#pragma unroll
      for (int i = 0; i < 4; ++i) {
        af[i] = *(const bf16x8*)(sA + (wm * 64 + i * 16 + lr) * GLD + ks * 32 + lq * 8);
        bfr[i] = *(const bf16x8*)(sB + (wn * 64 + i * 16 + lr) * GLD + ks * 32 + lq * 8);
      }
#pragma unroll
      for (int i = 0; i < 4; ++i)
#pragma unroll
        for (int j = 0; j < 4; ++j) acc[i][j] = __builtin_amdgcn_mfma_f32_16x16x32_bf16(af[i], bfr[j], acc[i][j], 0, 0, 0);
    }
  }
#pragma unroll
  for (int i = 0; i < 4; ++i)
#pragma unroll
    for (int j = 0; j < 4; ++j)
#pragma unroll
      for (int e = 0; e < 4; ++e) {
        const int row = m0 + wm * 64 + i * 16 + lq * 4 + e;
        const int col = n0 + wn * 64 + j * 16 + lr;
        const float v = acc[i][j][e];
        if (EPI == 0) {
          if (col < 2560) p.pl[(size_t)row * LDP + col] = f2bf(v);
          else if (col < 2576) p.gates[(size_t)row * 16 + (col - 2560)] = v;
        } else if (EPI == 1) {
          const int b = row / SEQ;
          p.out[(size_t)row * 1024 + col] = p.x[(size_t)row * 1024 + col] + p.mod[b * 6144 + 2 * 1024 + col] * v;
        } else {
          p.qb[(size_t)row * 2048 + col] = f2bf(v);
        }
      }
}

template <int EPI>
__device__ __forceinline__ void ph_gemm(const P& p, int bid, int nb, char* smem) {
  bf16_t* sA = (bf16_t*)smem;
  bf16_t* sB = sA + 128 * GLD;
  const int ntn = EPI == 0 ? 21 : (EPI == 1 ? 8 : 16);
  const int ntm = EPI == 0 ? 144 : 128;
  const bf16_t* A = EPI == 0 ? p.hn : (EPI == 1 ? p.mix : p.hn);
  const int lda = 1024;
  const bf16_t* Bt = EPI == 0 ? p.wt_in : (EPI == 1 ? p.wt_out : p.wt_q);
  const int nlat = 128 * ntn;
  const int ntiles = EPI == 0 ? nlat + 16 * 13 : ntm * ntn;
  const int trips = (ntiles + nb - 1) / nb;
  for (int k = 0; k < trips; ++k) {
    const int t = (bid + k * nb) % ntiles;
    int tm, tn;
    if (EPI == 0 && t >= nlat) { const int r = t - nlat; tm = 128 + r / 13; tn = r % 13; if (tn == 12) tn = 20; }
    else { tm = t / ntn; tn = t % ntn; }
    gemm_tile<EPI>(p, A, lda, Bt, tm * 128, tn * 128, sA, sB);
  }
}

struct UnitInfo { int isctx, b, c, h, T, seqrow0, row0; };
__device__ __forceinline__ UnitInfo decode_unit(int u) {
  UnitInfo r;
  if (u < 512) { r.isctx = 0; r.b = u >> 6; r.c = (u >> 2) & 15; r.h = u & 3; r.T = SEQ; r.seqrow0 = r.b * SEQ; }
  else { int uu = u - 512; r.isctx = 1; r.b = uu >> 3; r.c = (uu >> 2) & 1; r.h = uu & 3; r.T = CTXL; r.seqrow0 = TL + r.b * CTXL; }
  r.row0 = r.seqrow0 + r.c * 128;
  return r;
}
__device__ __forceinline__ float qk_act(const P& p, int seqrow0, int T, int t, int col) {
  const bf16_t* base = p.pl + (size_t)(seqrow0 + t) * LDP + col;
  float r0 = t > 0 ? bf2f(base[-LDP]) : 0.f;
  float r1 = bf2f(base[0]);
  float r2 = t + 1 < T ? bf2f(base[LDP]) : 0.f;
  float y = p.conv_b[col] + r0 * p.conv_w[col] + r1 * p.conv_w[1024 + col] + r2 * p.conv_w[2048 + col];
  return silu_f(y);
}


typedef short s16x4 __attribute__((ext_vector_type(4)));
#define LDS_AS __attribute__((address_space(3)))
__device__ __forceinline__ s16x4 ds_tr16(const bf16_t* ptr) { return __builtin_amdgcn_ds_read_tr16_b64_v4i16((LDS_AS s16x4*)ptr); }
__device__ __forceinline__ bf16x8 frag_tr(const bf16_t* M, int ld, int s0, int c0, int lr, int lq) {
  const bf16_t* a = M + (s0 + lq * 8 + (lr >> 2)) * ld + c0 + (lr & 3) * 4;
  const s16x4 t0 = ds_tr16(a), t1 = ds_tr16(a + 4 * ld);
  return __builtin_shufflevector(t0, t1, 0, 1, 2, 3, 4, 5, 6, 7);
}
__device__ __forceinline__ unsigned cvt_pk_bf16(float lo, float hi) { const f32x2 v = {lo, hi}; const bf16x2 b = __builtin_convertvector(v, bf16x2); return __builtin_bit_cast(unsigned, b); }
__device__ __forceinline__ float blo(unsigned u) { return __uint_as_float(u << 16); }
__device__ __forceinline__ float bhi(unsigned u) { return __uint_as_float(u & 0xffff0000u); }
#define VLD 136


namespace pg8 {
#define PG8_LAS __attribute__((address_space(3)))
constexpr int BM = 256, BK = 64, HALF = 128, HTB = HALF * BK * 2, STAGE_BYTES = 8 * HTB, NXCD = 8, WGM = 8;
__host__ __device__ __forceinline__ int lds_byte(int r, int c) { const int st = (r >> 4) * 2 + (c >> 5), rr = r & 15, cc = c & 31, ob = rr * 64 + cc * 2; return st * 1024 + (ob ^ (((ob >> 9) & 1) << 5)); }
__host__ __device__ __forceinline__ void stage_rc(int b, int& R, int& C) { const int st = b / 1024, sb = b % 1024, swz = sb ^ (((sb >> 9) & 1) << 5); R = (st >> 1) * 16 + swz / 64; C = (st & 1) * 32 + (swz % 64) / 2; }
__host__ __device__ __forceinline__ int perm32(int rho) { const int n = rho >> 4, i = rho & 15; return 8 * (i >> 2) + 4 * n + (i & 3); }
struct Unit { int pm, pn; };
struct Gemm { const bf16_t* A; const bf16_t* Bt; int M, N, K; };
struct Order {
  int nM, nN, nwg, G, c, extra;
  __device__ void init(int nM_, int nN_, int G_, int c_, int extra_) { nM = nM_; nN = nN_; nwg = nM * nN; G = G_; c = c_; extra = extra_; }
  __device__ bool next(int i, Unit& u) const {
    const long L = (long)i * G + c;
    if (L >= nwg + extra) return false;
    if (L >= nwg) { const int r = (int)L - nwg; u.pm = nM + r / 7; const int q = r % 7; u.pn = q < 6 ? q : 10; return true; }
    int wgid = (int)L; { const int q = nwg / NXCD, r = nwg % NXCD, xcd = wgid % NXCD, off = wgid / NXCD; wgid = (xcd < r ? xcd * (q + 1) : r * (q + 1) + (xcd - r) * q) + off; }
    const int nig = WGM * nN, gid = wgid / nig, fm = gid * WGM, gsz = (nM - fm) < WGM ? (nM - fm) : WGM;
    u.pm = fm + ((wgid % nig) % gsz); u.pn = (wgid % nig) / gsz; return true;
  }
  __device__ __forceinline__ void a_ready(const Unit&) const {}
  __device__ __forceinline__ void done(const Unit&) const {}
};
template <class Epi, class Sched>
__device__ __forceinline__ void gemm_phase(PG8_LAS unsigned char* lds, const Gemm g, const Sched& S, const Epi& E) {
    const int tid = threadIdx.x, wid = __builtin_amdgcn_readfirstlane(tid >> 6), lane = tid & 63, wr = wid >> 2, wc = wid & 3, fr = lane & 15, fq = lane >> 4;
    const int K = g.K, nt = K / BK;
    unsigned voffA[2], voffB[2];
#pragma unroll
    for (int i = 0; i < 2; ++i) { int R, C; stage_rc(tid * 16 + i * 8192, R, C); const int Rb = Epi::PERM ? ((R & ~31) + perm32(R & 31)) : R;
        voffA[i] = (unsigned)(R * K + C) * 2u; voffB[i] = (unsigned)(Rb * K + C) * 2u; }
    const size_t kstep = (size_t)(BK * 2);
    const size_t hstep = (size_t)HALF * K * 2;
    const size_t tstep = 2 * hstep;
    const unsigned ldsw = (unsigned)wid * 1024u;
    const int aoff = lds_byte(wr * 64 + fr, fq * 8), boff = lds_byte(wc * 32 + fr, fq * 8);
#define PG8_SA(b, h) (((b) * 2 + (h)) * HTB)
#define PG8_SB(b, h) ((4 + (b) * 2 + (h)) * HTB)
#define PG8_STAGE_X(bufoff, gbase, voff, aux) do { _Pragma("unroll") for (int _i = 0; _i < 2; ++_i) \
        __builtin_amdgcn_global_load_lds((const unsigned*)((const char*)(gbase) + (voff)[_i]), (PG8_LAS unsigned*)(lds + (bufoff) + ldsw + _i * 8192), 16, 0, aux); } while (0)
#define PG8_STAGE(bufoff, gbase, voff) PG8_STAGE_X(bufoff, gbase, voff, 0)
#define PG8_STAGE_A(bufoff, gbase, voff) do { if (Epi::A_COHERENT) PG8_STAGE_X(bufoff, gbase, voff, AUX_SC1); else PG8_STAGE_X(bufoff, gbase, voff, 0); } while (0)
#define PG8_LDA(dst, b, h) do { _Pragma("unroll") for (int m = 0; m < 4; ++m) _Pragma("unroll") for (int k = 0; k < 2; ++k) dst[m][k] = *(const PG8_LAS bf16x8*)(lds + PG8_SA(b, h) + aoff + m * 2048 + k * 1024); } while (0)
#define PG8_LDB(dst, b, h) do { _Pragma("unroll") for (int n = 0; n < 2; ++n) _Pragma("unroll") for (int k = 0; k < 2; ++k) dst[n][k] = *(const PG8_LAS bf16x8*)(lds + PG8_SB(b, h) + boff + n * 2048 + k * 1024); } while (0)
#define PG8_MMA(ai, bj, At, Bt) do { __builtin_amdgcn_s_setprio(1); _Pragma("unroll") for (int m = 0; m < 4; ++m) _Pragma("unroll") for (int n = 0; n < 2; ++n) _Pragma("unroll") for (int k = 0; k < 2; ++k) \
        acc[ai][bj][m][n] = __builtin_amdgcn_mfma_f32_16x16x32_bf16(Bt[n][k], At[m][k], acc[ai][bj][m][n], 0, 0, 0); __builtin_amdgcn_s_setprio(0); } while (0)
#define PG8_WAIT_V(n) asm volatile("s_waitcnt vmcnt(" #n ")" ::: "memory")
#define PG8_WAIT_L(n) asm volatile("s_waitcnt lgkmcnt(" #n ")" ::: "memory")
#define PG8_BAR __builtin_amdgcn_s_barrier()
#define PG8_SCHED __builtin_amdgcn_sched_barrier(0)
    Unit cur, nxt; int ui = 0;
    if (!S.next(0, cur)) return;
    f32x4 acc[2][2][4][2];
#pragma unroll
    for (int a = 0; a < 2; ++a)
#pragma unroll
        for (int b = 0; b < 2; ++b)
#pragma unroll
            for (int m = 0; m < 4; ++m)
#pragma unroll
                for (int n = 0; n < 2; ++n) acc[a][b][m][n] = (f32x4){0.f, 0.f, 0.f, 0.f};
    bf16x8 At[4][2], B0[2][2], B1[2][2];
    const char* cA = (const char*)g.A + (size_t)cur.pm * tstep; const char* cB = (const char*)g.Bt + (size_t)cur.pn * tstep;
    S.a_ready(cur);
    PG8_STAGE(PG8_SB(0, 0), cB, voffB); PG8_STAGE_A(PG8_SA(0, 0), cA, voffA); PG8_STAGE(PG8_SB(0, 1), cB + hstep, voffB); PG8_STAGE_A(PG8_SA(0, 1), cA + hstep, voffA);
    if (wr == 1) PG8_BAR;
    PG8_WAIT_V(4); PG8_BAR;
    PG8_STAGE(PG8_SB(1, 0), cB + kstep, voffB); PG8_STAGE_A(PG8_SA(1, 0), cA + kstep, voffA); PG8_STAGE(PG8_SB(1, 1), cB + hstep + kstep, voffB);
    PG8_WAIT_V(6); PG8_BAR;
    for (;;) {
        const bool has_next = S.next(ui + 1, nxt);
        const char* nA = has_next ? (const char*)g.A + (size_t)nxt.pm * tstep : cA; const char* nB = has_next ? (const char*)g.Bt + (size_t)nxt.pn * tstep : cB;
        for (int t = 0; t < nt; t += 2) {
            const bool last = (t == nt - 2);
            const char* a1 = cA + (size_t)(t + 1) * kstep;
            const char* a2 = last ? nA : cA + (size_t)(t + 2) * kstep; const char* b2 = last ? nB : cB + (size_t)(t + 2) * kstep;
            const char* a3 = a2 + kstep; const char* b3 = b2 + kstep;
            if (last && has_next) S.a_ready(nxt);
            PG8_LDB(B0, 0, 0); PG8_SCHED; PG8_LDA(At, 0, 0); PG8_STAGE_A(PG8_SA(1, 1), a1 + hstep, voffA);
            PG8_WAIT_L(8); PG8_BAR; PG8_WAIT_L(0); PG8_MMA(0, 0, At, B0); PG8_BAR; PG8_SCHED;
            PG8_LDB(B1, 0, 1); PG8_STAGE(PG8_SB(0, 0), b2, voffB);
            PG8_BAR; PG8_WAIT_L(0); PG8_MMA(0, 1, At, B1); PG8_BAR;
            PG8_LDA(At, 0, 1); PG8_STAGE_A(PG8_SA(0, 0), a2, voffA);
            PG8_BAR; PG8_WAIT_L(0); PG8_MMA(1, 0, At, B0); PG8_BAR; PG8_SCHED;
            PG8_STAGE(PG8_SB(0, 1), b2 + hstep, voffB);
            PG8_WAIT_V(6); PG8_BAR; PG8_MMA(1, 1, At, B1); PG8_BAR;
            PG8_LDB(B0, 1, 0); PG8_SCHED; PG8_LDA(At, 1, 0); PG8_STAGE_A(PG8_SA(0, 1), a2 + hstep, voffA);
            PG8_WAIT_L(8); PG8_BAR; PG8_WAIT_L(0); PG8_MMA(0, 0, At, B0); PG8_BAR; PG8_SCHED;
            PG8_LDB(B1, 1, 1); PG8_STAGE(PG8_SB(1, 0), b3, voffB);
            PG8_BAR; PG8_WAIT_L(0); PG8_MMA(0, 1, At, B1); PG8_BAR;
            PG8_LDA(At, 1, 1); PG8_STAGE_A(PG8_SA(1, 0), a3, voffA);
            PG8_BAR; PG8_WAIT_L(0); PG8_MMA(1, 0, At, B0); PG8_BAR; PG8_SCHED;
            PG8_STAGE(PG8_SB(1, 1), b3 + hstep, voffB);
            PG8_WAIT_V(6); PG8_BAR; PG8_MMA(1, 1, At, B1); PG8_BAR;
        }
        if constexpr (!Epi::AFTER_DRAIN) { E(acc, cur, wr, wc, fr, fq); S.done(cur); }
        if (!has_next) break;
#pragma unroll
        for (int a = 0; a < 2; ++a)
#pragma unroll
            for (int b = 0; b < 2; ++b)
#pragma unroll
                for (int m = 0; m < 4; ++m)
#pragma unroll
                    for (int n = 0; n < 2; ++n) acc[a][b][m][n] = (f32x4){0.f, 0.f, 0.f, 0.f};
        cur = nxt; cA = nA; cB = nB; ++ui;
    }
    PG8_WAIT_V(0);
    if (wr == 0) PG8_BAR;
    PG8_BAR;
    if constexpr (Epi::AFTER_DRAIN) { E.fused(acc, cur, wr, wc, fr, fq, lds, wid, lane); S.done(cur); }
#undef PG8_SA
#undef PG8_SB
#undef PG8_STAGE
#undef PG8_LDA
#undef PG8_LDB
#undef PG8_MMA
#undef PG8_WAIT_V
#undef PG8_WAIT_L
#undef PG8_BAR
#undef PG8_SCHED
}
}

struct EpiIn {
  static constexpr bool PERM = true, AFTER_DRAIN = false, A_COHERENT = true;
  bf16_t* pl; float* gates;
  __device__ __forceinline__ void operator()(const f32x4 (&acc)[2][2][4][2], const pg8::Unit& u, int wr, int wc, int fr, int fq) const {
    const int row0 = u.pm * 256 + wr * 64 + fr;
#pragma unroll
    for (int ai = 0; ai < 2; ++ai)
#pragma unroll
      for (int m = 0; m < 4; ++m) {
        const int row = row0 + ai * 128 + m * 16;
#pragma unroll
        for (int bj = 0; bj < 2; ++bj) {
          const int c0 = u.pn * 256 + bj * 128 + wc * 32 + 8 * fq;
          const f32x4 v0 = acc[ai][bj][m][0], v1 = acc[ai][bj][m][1];
          if (c0 < 2560) {
            u32x4 w;
            w[0] = cvt_pk_bf16(v0[0], v0[1]); w[1] = cvt_pk_bf16(v0[2], v0[3]); w[2] = cvt_pk_bf16(v1[0], v1[1]); w[3] = cvt_pk_bf16(v1[2], v1[3]);
            *(u32x4*)(pl + (size_t)row * LDP + c0) = w;
          } else if (c0 < 2576) {
            *(f32x4*)(gates + (size_t)row * 16 + (c0 - 2560)) = v0;
            *(f32x4*)(gates + (size_t)row * 16 + (c0 - 2560) + 4) = v1;
          }
        }
      }
  }
};
struct EpiOut {
  static constexpr bool PERM = false, AFTER_DRAIN = false, A_COHERENT = true;
  const float* x; const float* mod; float* out;
  __device__ __forceinline__ void operator()(const f32x4 (&acc)[2][2][4][2], const pg8::Unit& u, int wr, int wc, int fr, int fq) const {
    const int row0 = u.pm * 256 + wr * 64 + fr, col0 = u.pn * 256 + wc * 32 + 4 * fq;
    const float* g1 = mod + (u.pm * 256 / SEQ) * 6144 + 2 * 1024;
#pragma unroll
    for (int ai = 0; ai < 2; ++ai)
#pragma unroll
      for (int m = 0; m < 4; ++m) {
        const size_t ro = (size_t)(row0 + ai * 128 + m * 16) * 1024;
#pragma unroll
        for (int bj = 0; bj < 2; ++bj)
#pragma unroll
          for (int n = 0; n < 2; ++n) {
            const int c = col0 + bj * 128 + n * 16;
            const f32x4 xv = *(const f32x4*)(x + ro + c), gv = *(const f32x4*)(g1 + c);
            *(f32x4*)(out + ro + c) = xv + gv * acc[ai][bj][m][n];
          }
      }
  }
};
struct EpiQ {
  static constexpr bool PERM = true, AFTER_DRAIN = false, A_COHERENT = true;
  bf16_t* q;
  __device__ __forceinline__ void operator()(const f32x4 (&acc)[2][2][4][2], const pg8::Unit& u, int wr, int wc, int fr, int fq) const {
    const int row0 = u.pm * 256 + wr * 64 + fr;
#pragma unroll
    for (int ai = 0; ai < 2; ++ai)
#pragma unroll
      for (int m = 0; m < 4; ++m)
#pragma unroll
        for (int bj = 0; bj < 2; ++bj) {
          const int c0 = u.pn * 256 + bj * 128 + wc * 32 + 8 * fq;
          const f32x4 v0 = acc[ai][bj][m][0], v1 = acc[ai][bj][m][1];
          u32x4 w;
          w[0] = cvt_pk_bf16(v0[0], v0[1]); w[1] = cvt_pk_bf16(v0[2], v0[3]); w[2] = cvt_pk_bf16(v1[0], v1[1]); w[3] = cvt_pk_bf16(v1[2], v1[3]);
          *(u32x4*)(q + (size_t)(row0 + ai * 128 + m * 16) * 2048 + c0) = w;
        }
  }
};
template <int EPI>
__device__ __forceinline__ void ph_gemm8(const P& p, char* lds_all) {
  PG8_LAS unsigned char* lds = (PG8_LAS unsigned char*)lds_all;
  pg8::Order S;
  if (EPI == 0) {
    S.init(64, 11, gridDim.x, blockIdx.x, 56);
    const pg8::Gemm g{p.hn, p.wt_in, TR, 2816, 1024};
    const EpiIn E{p.pl, p.gates};
    pg8::gemm_phase<EpiIn, pg8::Order>(lds, g, S, E);
  } else if (EPI == 1) {
    S.init(64, 4, gridDim.x, blockIdx.x, 0);
    const pg8::Gemm g{p.mix, p.wt_out, TL, 1024, 1024};
    const EpiOut E{p.x, p.mod, p.out};
    pg8::gemm_phase<EpiOut, pg8::Order>(lds, g, S, E);
  } else {
    S.init(64, 8, gridDim.x, blockIdx.x, 0);
    const pg8::Gemm g{p.hn, p.wt_q, TL, 2048, 1024};
    const EpiQ E{p.qb};
    pg8::gemm_phase<EpiQ, pg8::Order>(lds, g, S, E);
  }
}

template <bool REV>
__device__ __forceinline__ void scan128(const float* lf, const float* ig, float* bout, float* gout, float* pmout, float& Gtot, float& btot, int lane, float& g0o, float& g1o) {
  const int t0 = REV ? 127 - 2 * lane : 2 * lane, t1 = REV ? 126 - 2 * lane : 2 * lane + 1;
  const float v0 = lf[t0], v1 = lf[t1];
  float sacc = v0 + v1;
#pragma unroll
  for (int off = 1; off < 64; off <<= 1) { const float t = __shfl_up(sacc, off); if (lane >= off) sacc += t; }
  const float b1 = sacc, b0 = sacc - v1;
  const float g0 = ig[t0] - b0, g1 = ig[t1] - b1;
  float m = fmaxf(g0, g1);
#pragma unroll
  for (int off = 1; off < 64; off <<= 1) { const float t = __shfl_up(m, off); if (lane >= off) m = fmaxf(m, t); }
  float prev = __shfl_up(m, 1);
  if (lane == 0) prev = -3.0e38f;
  if (bout) { bout[t0] = b0; bout[t1] = b1; }
  if (gout) { gout[t0] = g0; gout[t1] = g1; }
  g0o = g0; g1o = g1;
  if (pmout) { pmout[t0] = fmaxf(prev, g0); pmout[t1] = m; }
  Gtot = __shfl(m, 63); btot = __shfl(sacc, 63);
}

__device__ __forceinline__ void ph3_chunk_local(const P& p, int bid, int nb, char* smem) {
  bf16_t* Vs = (bf16_t*)smem;
  bf16_t* Ks = Vs + 128 * VLD;
  float* fa = (float*)(Ks + 128 * VLD);
  float *igf = fa, *lff = fa + 128, *igb = fa + 256, *lfb = fa + 384, *ef = fa + 512, *eb = fa + 640, *scal = fa + 768;
  const int tid = threadIdx.x & 255, lane = tid & 63, wave = tid >> 6, lr = lane & 15, lq = lane >> 4;
  const int trips3 = (576 + nb - 1) / nb;
  for (int k3 = 0; k3 < trips3; ++k3) {
    const int u = (bid + k3 * nb) % 576;
    const UnitInfo ui = decode_unit(u);
    const int h = ui.h;
    if (tid < 128) {
      const float* g = p.gates + (size_t)(ui.row0 + tid) * 16;
      igf[tid] = g[h] + p.b_gates[h];
      lff[tid] = logsig_f(g[4 + h] + p.b_gates[4 + h]);
      igb[tid] = g[8 + h] + p.b_gates[8 + h];
      lfb[tid] = logsig_f(g[12 + h] + p.b_gates[12 + h]);
    }
    {
      const int dch = tid & 15, colq = h * 128 + dch * 8, colk = 512 + colq;
#pragma unroll 1
      for (int which = 0; which < 2; ++which) {
        if (which == 1 && ui.isctx) break;
        const int col = which == 0 ? colk : colq;
        float w0[8], w1[8], w2[8], bb[8];
#pragma unroll
        for (int i = 0; i < 8; ++i) { w0[i] = p.conv_w[col + i]; w1[i] = p.conv_w[1024 + col + i]; w2[i] = p.conv_w[2048 + col + i]; bb[i] = p.conv_b[col + i]; }
        const float scl = which == 0 ? 0.08838834764831845f : 1.f;
#pragma unroll 2
        for (int i = 0; i < 8; ++i) {
          const int t = (tid >> 4) + i * 16, tt = ui.c * 128 + t;
          const bf16_t* base = p.pl + (size_t)(ui.row0 + t) * LDP + col;
          const u32x4 z4 = (u32x4){0u, 0u, 0u, 0u};
          const u32x4 r1 = *(const u32x4*)base;
          const u32x4 r0 = tt > 0 ? *(const u32x4*)(base - LDP) : z4;
          const u32x4 r2 = tt + 1 < ui.T ? *(const u32x4*)(base + LDP) : z4;
          float y[8];
#pragma unroll
          for (int q = 0; q < 4; ++q) {
            y[2 * q] = silu_f(bb[2 * q] + blo(r0[q]) * w0[2 * q] + blo(r1[q]) * w1[2 * q] + blo(r2[q]) * w2[2 * q]) * scl;
            y[2 * q + 1] = silu_f(bb[2 * q + 1] + bhi(r0[q]) * w0[2 * q + 1] + bhi(r1[q]) * w1[2 * q + 1] + bhi(r2[q]) * w2[2 * q + 1]) * scl;
          }
          u32x4 o;
#pragma unroll
          for (int q = 0; q < 4; ++q) o[q] = cvt_pk_bf16(y[2 * q], y[2 * q + 1]);
          if (which == 0) *(u32x4*)(Ks + t * VLD + dch * 8) = o;
          if (!ui.isctx) *(u32x4*)(p.hn + (size_t)(ui.row0 + t) * 1024 + col) = o;
        }
      }
#pragma unroll
      for (int i = 0; i < 8; ++i) {
        const int t = (tid >> 4) + i * 16;
        *(u32x4*)(Vs + t * VLD + dch * 8) = *(const u32x4*)(p.pl + (size_t)(ui.row0 + t) * LDP + 1024 + h * 128 + dch * 8);
      }
    }
    __syncthreads();
    if (wave == 0) {
      float G, bt, ga, gb2;
      scan128<false>(lff, igf, nullptr, nullptr, nullptr, G, bt, lane, ga, gb2);
      ef[2 * lane] = __expf(ga - G); ef[2 * lane + 1] = __expf(gb2 - G);
      if (lane == 0) { scal[0] = G; scal[1] = bt; }
    } else if (wave == 1) {
      float G, bt, ga, gb2;
      scan128<true>(lfb, igb, nullptr, nullptr, nullptr, G, bt, lane, ga, gb2);
      eb[127 - 2 * lane] = __expf(ga - G); eb[126 - 2 * lane] = __expf(gb2 - G);
      if (lane == 0) { scal[2] = G; scal[3] = bt; }
    }
    __syncthreads();
#pragma unroll 1
    for (int dir = 0; dir < 2; ++dir) {
      const float* ee = dir ? eb : ef;
      f32x4 acc[2][8];
#pragma unroll
      for (int m = 0; m < 2; ++m)
#pragma unroll
        for (int j = 0; j < 8; ++j) acc[m][j] = (f32x4){0.f, 0.f, 0.f, 0.f};
#pragma unroll
      for (int kk = 0; kk < 4; ++kk) {
        const f32x4 e0 = *(const f32x4*)(ee + kk * 32 + lq * 8), e1 = *(const f32x4*)(ee + kk * 32 + lq * 8 + 4);
        bf16x8 af[2];
#pragma unroll
        for (int m = 0; m < 2; ++m) {
          const bf16x8 raw = frag_tr(Vs, VLD, kk * 32, wave * 32 + m * 16, lr, lq);
          const u32x4 ru = __builtin_bit_cast(u32x4, raw);
          u32x4 sc;
          sc[0] = cvt_pk_bf16(blo(ru[0]) * e0[0], bhi(ru[0]) * e0[1]);
          sc[1] = cvt_pk_bf16(blo(ru[1]) * e0[2], bhi(ru[1]) * e0[3]);
          sc[2] = cvt_pk_bf16(blo(ru[2]) * e1[0], bhi(ru[2]) * e1[1]);
          sc[3] = cvt_pk_bf16(blo(ru[3]) * e1[2], bhi(ru[3]) * e1[3]);
          af[m] = __builtin_bit_cast(bf16x8, sc);
        }
#pragma unroll
        for (int j = 0; j < 8; ++j) {
          const bf16x8 bfr = frag_tr(Ks, VLD, kk * 32, j * 16, lr, lq);
#pragma unroll
          for (int m = 0; m < 2; ++m) acc[m][j] = __builtin_amdgcn_mfma_f32_16x16x32_bf16(af[m], bfr, acc[m][j], 0, 0, 0);
        }
      }
      bf16_t* Dd = p.Dst + (size_t)(u * 2 + dir) * 16384;
#pragma unroll
      for (int m = 0; m < 2; ++m)
#pragma unroll
        for (int j = 0; j < 8; ++j)
#pragma unroll
          for (int e = 0; e < 4; ++e) Dd[(wave * 32 + m * 16 + lq * 4 + e) * 128 + j * 16 + lr] = f2bf(acc[m][j][e]);
    }
    {
      const int dir = tid >> 7, k = tid & 127;
      const float* e = dir ? eb : ef;
      float sacc = 0.f;
      for (int t = 0; t < 128; ++t) sacc += e[t] * bf2f(Ks[t * VLD + k]);
      p.ND[(size_t)(u * 2 + dir) * 128 + k] = sacc;
    }
    if (tid < 4) p.SC[(size_t)(u * 2 + (tid >> 1)) * 32 + (tid & 1)] = scal[tid];
    __syncthreads();
  }
}

__device__ __forceinline__ void ph4_scan(const P& p, int bid, int nb) {
  const int tid = threadIdx.x & 255;
  const __amdgpu_buffer_rsrc_t r_d = mk_rsrc(p.Dst), r_sc = mk_rsrc(p.SC), r_nd = mk_rsrc(p.ND);
  for (int it = bid; it < 1024; it += nb) {
    const int combo = it >> 4, vblk = it & 15;
    const int b = combo >> 3, h = (combo >> 1) & 3, dir = combo & 1;
    const int v = vblk * 8 + (tid >> 5), k0 = (tid & 31) * 4;
    float C0 = 0.f, C1 = 0.f, C2 = 0.f, C3 = 0.f, nacc = 0.f, m = 0.f;
    for (int i = 0; i < 18; ++i) {
      int u;
      if (i < 2) { const int cc = dir == 0 ? i : 1 - i; u = 512 + b * 8 + cc * 4 + h; }
      else {
        const int lc = i - 2, c = dir == 0 ? lc : 15 - lc;
        u = b * 64 + c * 4 + h;
        const size_t ci = (size_t)u * 2 + dir;
        uint2 o;
        o.x = (unsigned)f2bf(C0) | ((unsigned)f2bf(C1) << 16);
        o.y = (unsigned)f2bf(C2) | ((unsigned)f2bf(C3) << 16);
        *(uint2*)(p.CIN + ci * 16384 + v * 128 + k0) = o;
        if (vblk == 0 && tid < 128) p.NIN[ci * 128 + tid] = nacc;
        if (vblk == 0 && tid == 0) p.MIN_[ci * 32] = m;
      }
      const size_t di = (size_t)u * 2 + dir;
      const float G = fload1c(r_sc, (int)di * 128, 0), bend = fload1c(r_sc, (int)di * 128 + 4, 0);
      const float Mx = fmaxf(m, G);
      const float dec = __expf(m - Mx), inj = __expf(G - Mx);
      const u32x2 d2 = uload2c(r_d, ((int)di * 16384 + v * 128 + k0) * 2, 0);
      C0 = dec * C0 + inj * __uint_as_float(d2.x << 16);
      C1 = dec * C1 + inj * __uint_as_float(d2.x & 0xffff0000u);
      C2 = dec * C2 + inj * __uint_as_float(d2.y << 16);
      C3 = dec * C3 + inj * __uint_as_float(d2.y & 0xffff0000u);
      if (vblk == 0 && tid < 128) nacc = dec * nacc + inj * fload1c(r_nd, ((int)di * 128 + tid) * 4, 0);
      m = bend + Mx;
    }
  }
}

__device__ __forceinline__ void ph5_mlstm_out(const P& p, int bid, int nb, char* smem) {
  bf16_t* Vs = (bf16_t*)smem;
  bf16_t* Pw = Vs + 128 * VLD;
  float* fa = (float*)(Pw + 4 * 16 * VLD);
  float *igf = fa, *lff = fa + 128, *igb = fa + 256, *lfb = fa + 384, *gf = fa + 512, *gb = fa + 640, *bfw = fa + 768, *bbw = fa + 896,
        *pmf = fa + 1024, *pmb = fa + 1152, *nq = fa + 1280  ;
  const int tid = threadIdx.x & 255, lane = tid & 63, wave = tid >> 6, lr = lane & 15, lq = lane >> 4;
  const int trips5 = (1536 + nb - 1) / nb;
  for (int k5 = 0; k5 < trips5; ++k5) {
    const int it = (bid + k5 * nb) % 1536;
    if (it < 512) {
      const int u = it;
      const UnitInfo ui = decode_unit(u);
      const int h = ui.h;
      const size_t cif = (size_t)u * 2, cib = (size_t)u * 2 + 1;
      if (tid < 128) {
        const float* g = p.gates + (size_t)(ui.row0 + tid) * 16;
        igf[tid] = g[h] + p.b_gates[h];
        lff[tid] = logsig_f(g[4 + h] + p.b_gates[4 + h]);
        igb[tid] = g[8 + h] + p.b_gates[8 + h];
        lfb[tid] = logsig_f(g[12 + h] + p.b_gates[12 + h]);
      }
      {
        const int dch = tid & 15;
#pragma unroll
        for (int i = 0; i < 8; ++i) {
          const int t = (tid >> 4) + i * 16;
          *(u32x4*)(Vs + t * VLD + dch * 8) = *(const u32x4*)(p.pl + (size_t)(ui.row0 + t) * LDP + 1024 + h * 128 + dch * 8);
        }
      }
      {
        const int dir = tid >> 7, t = tid & 127;
        const __amdgpu_buffer_rsrc_t r_hq = mk_rsrc(p.hn);
        const int qoff = ((ui.row0 + t) * 1024 + h * 128) * 2;
        const float* nin = p.NIN + (dir ? cib : cif) * 128;
        float sacc = 0.f;
#pragma unroll 4
        for (int c8 = 0; c8 < 16; ++c8) {
          const u32x4 qv = uload4c(r_hq, qoff + c8 * 16, 0);
#pragma unroll
          for (int q = 0; q < 4; ++q) sacc += blo(qv[q]) * nin[c8 * 8 + 2 * q] + bhi(qv[q]) * nin[c8 * 8 + 2 * q + 1];
        }
        nq[dir * 128 + t] = sacc;
      }
      __syncthreads();
      if (wave == 0) { float G, bt, ga, gb2; scan128<false>(lff, igf, bfw, gf, pmf, G, bt, lane, ga, gb2); }
      else if (wave == 1) { float G, bt, ga, gb2; scan128<true>(lfb, igb, bbw, gb, pmb, G, bt, lane, ga, gb2); }
      __syncthreads();
      const float minf_ = p.MIN_[cif * 32], minb_ = p.MIN_[cib * 32];
      bf16_t* Pme = Pw + wave * 16 * VLD;
      const __amdgpu_buffer_rsrc_t r_hn = mk_rsrc(p.hn), r_cin = mk_rsrc(p.CIN);
      const int fvoff = (lr * 1024 + lq * 8) * 2, cvoff = (lr * 128 + lq * 8) * 2;
#pragma unroll 1
      for (int m = 0; m < 2; ++m) {
        const int t0 = wave * 32 + m * 16;
        bf16x8 Qf[4];
#pragma unroll
        for (int kk = 0; kk < 4; ++kk) Qf[kk] = bload8c(r_hn, fvoff + kk * 64, ((ui.row0 + t0) * 1024 + h * 128) * 2);
        f32x4 S[8];
#pragma unroll
        for (int j = 0; j < 8; ++j) {
          S[j] = (f32x4){0.f, 0.f, 0.f, 0.f};
#pragma unroll
          for (int kk = 0; kk < 4; ++kk) {
            const bf16x8 kf = bload8c(r_hn, fvoff + kk * 64, ((ui.row0 + j * 16) * 1024 + 512 + h * 128) * 2);
            S[j] = __builtin_amdgcn_mfma_f32_16x16x32_bf16(Qf[kk], kf, S[j], 0, 0, 0);
          }
          if (j & 1) __builtin_amdgcn_sched_barrier(0);
        }
        f32x4 hsum[8];
#pragma unroll 1
        for (int dir = 0; dir < 2; ++dir) {
          const float mi = dir ? minb_ : minf_;
          const float* gg = dir ? gb : gf;
          const float* pmx = dir ? pmb : pmf;
          const float* bw = dir ? bbw : bfw;
          float Mrow[4], wi[4];
#pragma unroll
          for (int e = 0; e < 4; ++e) { Mrow[e] = fmaxf(mi, pmx[t0 + lq * 4 + e]); wi[e] = __expf(mi - Mrow[e]); }
          f32x4 acc[8];
#pragma unroll
          for (int jv = 0; jv < 8; ++jv) {
            acc[jv] = (f32x4){0.f, 0.f, 0.f, 0.f};
#pragma unroll
            for (int kk = 0; kk < 4; ++kk) {
              const bf16x8 cf = bload8c(r_cin, cvoff + kk * 64, (int)((dir ? cib : cif) * 32768) + jv * 4096);
              acc[jv] = __builtin_amdgcn_mfma_f32_16x16x32_bf16(Qf[kk], cf, acc[jv], 0, 0, 0);
            }
#pragma unroll
            for (int e = 0; e < 4; ++e) acc[jv][e] *= wi[e];
            if (jv & 1) __builtin_amdgcn_sched_barrier(0);
          }
          float rs[4] = {0.f, 0.f, 0.f, 0.f};
#pragma unroll
          for (int j = 0; j < 8; ++j) {
            const int sidx = j * 16 + lr;
            const float gs = gg[sidx];
#pragma unroll
            for (int e = 0; e < 4; ++e) {
              const int t = t0 + lq * 4 + e;
              const bool keep = dir ? (sidx >= t) : (sidx <= t);
              const float pv = keep ? S[j][e] * __expf(gs - Mrow[e]) : 0.f;
              rs[e] += pv;
              Pme[(lq * 4 + e) * VLD + sidx] = f2bf(pv);
            }
          }
          float den[4];
#pragma unroll
          for (int e = 0; e < 4; ++e) {
            float r = rs[e];
            r += __shfl_xor(r, 1); r += __shfl_xor(r, 2); r += __shfl_xor(r, 4); r += __shfl_xor(r, 8);
            const int t = t0 + lq * 4 + e;
            const float dd = r + wi[e] * nq[dir * 128 + t];
            den[e] = fmaxf(fabsf(dd), __expf(-(bw[t] + Mrow[e])));
          }
          asm volatile("s_waitcnt lgkmcnt(0)" ::: "memory");
          __builtin_amdgcn_wave_barrier();
#pragma unroll
          for (int kk = 0; kk < 4; ++kk) {
            const bf16x8 pf = *(const bf16x8*)(Pme + lr * VLD + kk * 32 + lq * 8);
#pragma unroll
            for (int jv = 0; jv < 8; ++jv) {
              const bf16x8 vf = frag_tr(Vs, VLD, kk * 32, jv * 16, lr, lq);
              acc[jv] = __builtin_amdgcn_mfma_f32_16x16x32_bf16(pf, vf, acc[jv], 0, 0, 0);
            }
          }
          __builtin_amdgcn_wave_barrier();
#pragma unroll
          for (int jv = 0; jv < 8; ++jv)
#pragma unroll
            for (int e = 0; e < 4; ++e) {
              const float hv = acc[jv][e] / den[e];
              if (dir == 0) hsum[jv][e] = hv; else hsum[jv][e] += hv;
            }
        }
#pragma unroll
        for (int e = 0; e < 4; ++e) {
          float sm = 0.f;
#pragma unroll
          for (int jv = 0; jv < 8; ++jv) sm += hsum[jv][e];
          sm += __shfl_xor(sm, 1); sm += __shfl_xor(sm, 2); sm += __shfl_xor(sm, 4); sm += __shfl_xor(sm, 8);
          const float mu = sm * (1.f / 128.f);
          float vs = 0.f;
#pragma unroll
          for (int jv = 0; jv < 8; ++jv) { const float d = hsum[jv][e] - mu; vs += d * d; }
          vs += __shfl_xor(vs, 1); vs += __shfl_xor(vs, 2); vs += __shfl_xor(vs, 4); vs += __shfl_xor(vs, 8);
          const float rstd = rsqrtf(vs * (1.f / 128.f) + 1e-6f);
          const bf16_t* op = p.pl + (size_t)(ui.row0 + t0 + lq * 4 + e) * LDP + 1536 + h * 128;
          bf16_t* mp = p.mix + (size_t)(ui.row0 + t0 + lq * 4 + e) * 1024 + h * 128;
#pragma unroll
          for (int jv = 0; jv < 8; ++jv) {
            const int v = jv * 16 + lr;
            const float o = bf2f(op[v]);
            mp[v] = f2bf((hsum[jv][e] - mu) * rstd * p.head_norm_w[h * 128 + v] / (1.f + __expf(-o)));
          }
        }
      }
      __syncthreads();
    } else {
      const int pu = it - 512, grp = pu >> 2, g = pu & 3;
      float* us = (float*)smem;
      bf16_t* db = (bf16_t*)(us + 8192);
      const int w = 2 << g;
      const size_t rbase = (size_t)grp * 64;
      for (int idx = tid; idx < 1024; idx += NTHR) {
        const int t = idx >> 4, ch = idx & 15;
        const u32x4 r = *(const u32x4*)(p.pl + (rbase + t) * LDP + 2048 + g * 128 + ch * 8);
        float* d = us + t * 128 + ch * 8;
#pragma unroll
        for (int q = 0; q < 4; ++q) { d[2 * q] = blo(r[q]); d[2 * q + 1] = bhi(r[q]); }
      }
      __syncthreads();
      for (int idx = tid; idx < 8192; idx += NTHR) {
        const int t = idx >> 7, i = idx & 127;
        int lo = t - w / 2, hi = t - w / 2 + w;
        lo = lo < 0 ? 0 : lo; hi = hi > 64 ? 64 : hi;
        float sacc = 0.f;
        for (int j = lo; j < hi; ++j) sacc += us[j * 128 + i];
        db[t * VLD + i] = f2bf(sacc / (float)(hi - lo) - us[idx]);
      }
      __syncthreads();
      {
        const bf16_t* wt = (const bf16_t*)((const char*)p.keys_bf + 524288) + g * 16384;
        bf16x8 af[4];
#pragma unroll
        for (int kk = 0; kk < 4; ++kk) af[kk] = *(const bf16x8*)(db + (wave * 16 + lr) * VLD + kk * 32 + lq * 8);
#pragma unroll
        for (int j = 0; j < 8; ++j) {
          f32x4 acc = (f32x4){0.f, 0.f, 0.f, 0.f};
#pragma unroll
          for (int kk = 0; kk < 4; ++kk) {
            const bf16x8 bfr = *(const bf16x8*)(wt + (j * 16 + lr) * 128 + kk * 32 + lq * 8);
            acc = __builtin_amdgcn_mfma_f32_16x16x32_bf16(af[kk], bfr, acc, 0, 0, 0);
          }
          const float ps = p.pool_scale[g * 128 + j * 16 + lr];
#pragma unroll
          for (int e = 0; e < 4; ++e) p.mix[(rbase + wave * 16 + lq * 4 + e) * 1024 + 512 + g * 128 + j * 16 + lr] = f2bf(acc[e] * ps);
        }
      }
      __syncthreads();
    }
  }
}

#define SORT16(X) do { unsigned h_, l_; h_ = X[0] > X[1] ? X[0] : X[1]; l_ = X[0] > X[1] ? X[1] : X[0]; X[0] = h_; X[1] = l_; h_ = X[3] > X[2] ? X[3] : X[2]; l_ = X[3] > X[2] ? X[2] : X[3]; X[3] = h_; X[2] = l_; h_ = X[4] > X[5] ? X[4] : X[5]; l_ = X[4] > X[5] ? X[5] : X[4]; X[4] = h_; X[5] = l_; h_ = X[7] > X[6] ? X[7] : X[6]; l_ = X[7] > X[6] ? X[6] : X[7]; X[7] = h_; X[6] = l_; h_ = X[8] > X[9] ? X[8] : X[9]; l_ = X[8] > X[9] ? X[9] : X[8]; X[8] = h_; X[9] = l_; h_ = X[11] > X[10] ? X[11] : X[10]; l_ = X[11] > X[10] ? X[10] : X[11]; X[11] = h_; X[10] = l_; h_ = X[12] > X[13] ? X[12] : X[13]; l_ = X[12] > X[13] ? X[13] : X[12]; X[12] = h_; X[13] = l_; h_ = X[15] > X[14] ? X[15] : X[14]; l_ = X[15] > X[14] ? X[14] : X[15]; X[15] = h_; X[14] = l_; h_ = X[0] > X[2] ? X[0] : X[2]; l_ = X[0] > X[2] ? X[2] : X[0]; X[0] = h_; X[2] = l_; h_ = X[1] > X[3] ? X[1] : X[3]; l_ = X[1] > X[3] ? X[3] : X[1]; X[1] = h_; X[3] = l_; h_ = X[6] > X[4] ? X[6] : X[4]; l_ = X[6] > X[4] ? X[4] : X[6]; X[6] = h_; X[4] = l_; h_ = X[7] > X[5] ? X[7] : X[5]; l_ = X[7] > X[5] ? X[5] : X[7]; X[7] = h_; X[5] = l_; h_ = X[8] > X[10] ? X[8] : X[10]; l_ = X[8] > X[10] ? X[10] : X[8]; X[8] = h_; X[10] = l_; h_ = X[9] > X[11] ? X[9] : X[11]; l_ = X[9] > X[11] ? X[11] : X[9]; X[9] = h_; X[11] = l_; h_ = X[14] > X[12] ? X[14] : X[12]; l_ = X[14] > X[12] ? X[12] : X[14]; X[14] = h_; X[12] = l_; h_ = X[15] > X[13] ? X[15] : X[13]; l_ = X[15] > X[13] ? X[13] : X[15]; X[15] = h_; X[13] = l_; h_ = X[0] > X[1] ? X[0] : X[1]; l_ = X[0] > X[1] ? X[1] : X[0]; X[0] = h_; X[1] = l_; h_ = X[2] > X[3] ? X[2] : X[3]; l_ = X[2] > X[3] ? X[3] : X[2]; X[2] = h_; X[3] = l_; h_ = X[5] > X[4] ? X[5] : X[4]; l_ = X[5] > X[4] ? X[4] : X[5]; X[5] = h_; X[4] = l_; h_ = X[7] > X[6] ? X[7] : X[6]; l_ = X[7] > X[6] ? X[6] : X[7]; X[7] = h_; X[6] = l_; h_ = X[8] > X[9] ? X[8] : X[9]; l_ = X[8] > X[9] ? X[9] : X[8]; X[8] = h_; X[9] = l_; h_ = X[10] > X[11] ? X[10] : X[11]; l_ = X[10] > X[11] ? X[11] : X[10]; X[10] = h_; X[11] = l_; h_ = X[13] > X[12] ? X[13] : X[12]; l_ = X[13] > X[12] ? X[12] : X[13]; X[13] = h_; X[12] = l_; h_ = X[15] > X[14] ? X[15] : X[14]; l_ = X[15] > X[14] ? X[14] : X[15]; X[15] = h_; X[14] = l_; h_ = X[0] > X[4] ? X[0] : X[4]; l_ = X[0] > X[4] ? X[4] : X[0]; X[0] = h_; X[4] = l_; h_ = X[1] > X[5] ? X[1] : X[5]; l_ = X[1] > X[5] ? X[5] : X[1]; X[1] = h_; X[5] = l_; h_ = X[2] > X[6] ? X[2] : X[6]; l_ = X[2] > X[6] ? X[6] : X[2]; X[2] = h_; X[6] = l_; h_ = X[3] > X[7] ? X[3] : X[7]; l_ = X[3] > X[7] ? X[7] : X[3]; X[3] = h_; X[7] = l_; h_ = X[12] > X[8] ? X[12] : X[8]; l_ = X[12] > X[8] ? X[8] : X[12]; X[12] = h_; X[8] = l_; h_ = X[13] > X[9] ? X[13] : X[9]; l_ = X[13] > X[9] ? X[9] : X[13]; X[13] = h_; X[9] = l_; h_ = X[14] > X[10] ? X[14] : X[10]; l_ = X[14] > X[10] ? X[10] : X[14]; X[14] = h_; X[10] = l_; h_ = X[15] > X[11] ? X[15] : X[11]; l_ = X[15] > X[11] ? X[11] : X[15]; X[15] = h_; X[11] = l_; h_ = X[0] > X[2] ? X[0] : X[2]; l_ = X[0] > X[2] ? X[2] : X[0]; X[0] = h_; X[2] = l_; h_ = X[1] > X[3] ? X[1] : X[3]; l_ = X[1] > X[3] ? X[3] : X[1]; X[1] = h_; X[3] = l_; h_ = X[4] > X[6] ? X[4] : X[6]; l_ = X[4] > X[6] ? X[6] : X[4]; X[4] = h_; X[6] = l_; h_ = X[5] > X[7] ? X[5] : X[7]; l_ = X[5] > X[7] ? X[7] : X[5]; X[5] = h_; X[7] = l_; h_ = X[10] > X[8] ? X[10] : X[8]; l_ = X[10] > X[8] ? X[8] : X[10]; X[10] = h_; X[8] = l_; h_ = X[11] > X[9] ? X[11] : X[9]; l_ = X[11] > X[9] ? X[9] : X[11]; X[11] = h_; X[9] = l_; h_ = X[14] > X[12] ? X[14] : X[12]; l_ = X[14] > X[12] ? X[12] : X[14]; X[14] = h_; X[12] = l_; h_ = X[15] > X[13] ? X[15] : X[13]; l_ = X[15] > X[13] ? X[13] : X[15]; X[15] = h_; X[13] = l_; h_ = X[0] > X[1] ? X[0] : X[1]; l_ = X[0] > X[1] ? X[1] : X[0]; X[0] = h_; X[1] = l_; h_ = X[2] > X[3] ? X[2] : X[3]; l_ = X[2] > X[3] ? X[3] : X[2]; X[2] = h_; X[3] = l_; h_ = X[4] > X[5] ? X[4] : X[5]; l_ = X[4] > X[5] ? X[5] : X[4]; X[4] = h_; X[5] = l_; h_ = X[6] > X[7] ? X[6] : X[7]; l_ = X[6] > X[7] ? X[7] : X[6]; X[6] = h_; X[7] = l_; h_ = X[9] > X[8] ? X[9] : X[8]; l_ = X[9] > X[8] ? X[8] : X[9]; X[9] = h_; X[8] = l_; h_ = X[11] > X[10] ? X[11] : X[10]; l_ = X[11] > X[10] ? X[10] : X[11]; X[11] = h_; X[10] = l_; h_ = X[13] > X[12] ? X[13] : X[12]; l_ = X[13] > X[12] ? X[12] : X[13]; X[13] = h_; X[12] = l_; h_ = X[15] > X[14] ? X[15] : X[14]; l_ = X[15] > X[14] ? X[14] : X[15]; X[15] = h_; X[14] = l_; h_ = X[0] > X[8] ? X[0] : X[8]; l_ = X[0] > X[8] ? X[8] : X[0]; X[0] = h_; X[8] = l_; h_ = X[1] > X[9] ? X[1] : X[9]; l_ = X[1] > X[9] ? X[9] : X[1]; X[1] = h_; X[9] = l_; h_ = X[2] > X[10] ? X[2] : X[10]; l_ = X[2] > X[10] ? X[10] : X[2]; X[2] = h_; X[10] = l_; h_ = X[3] > X[11] ? X[3] : X[11]; l_ = X[3] > X[11] ? X[11] : X[3]; X[3] = h_; X[11] = l_; h_ = X[4] > X[12] ? X[4] : X[12]; l_ = X[4] > X[12] ? X[12] : X[4]; X[4] = h_; X[12] = l_; h_ = X[5] > X[13] ? X[5] : X[13]; l_ = X[5] > X[13] ? X[13] : X[5]; X[5] = h_; X[13] = l_; h_ = X[6] > X[14] ? X[6] : X[14]; l_ = X[6] > X[14] ? X[14] : X[6]; X[6] = h_; X[14] = l_; h_ = X[7] > X[15] ? X[7] : X[15]; l_ = X[7] > X[15] ? X[15] : X[7]; X[7] = h_; X[15] = l_; h_ = X[0] > X[4] ? X[0] : X[4]; l_ = X[0] > X[4] ? X[4] : X[0]; X[0] = h_; X[4] = l_; h_ = X[1] > X[5] ? X[1] : X[5]; l_ = X[1] > X[5] ? X[5] : X[1]; X[1] = h_; X[5] = l_; h_ = X[2] > X[6] ? X[2] : X[6]; l_ = X[2] > X[6] ? X[6] : X[2]; X[2] = h_; X[6] = l_; h_ = X[3] > X[7] ? X[3] : X[7]; l_ = X[3] > X[7] ? X[7] : X[3]; X[3] = h_; X[7] = l_; h_ = X[8] > X[12] ? X[8] : X[12]; l_ = X[8] > X[12] ? X[12] : X[8]; X[8] = h_; X[12] = l_; h_ = X[9] > X[13] ? X[9] : X[13]; l_ = X[9] > X[13] ? X[13] : X[9]; X[9] = h_; X[13] = l_; h_ = X[10] > X[14] ? X[10] : X[14]; l_ = X[10] > X[14] ? X[14] : X[10]; X[10] = h_; X[14] = l_; h_ = X[11] > X[15] ? X[11] : X[15]; l_ = X[11] > X[15] ? X[15] : X[11]; X[11] = h_; X[15] = l_; h_ = X[0] > X[2] ? X[0] : X[2]; l_ = X[0] > X[2] ? X[2] : X[0]; X[0] = h_; X[2] = l_; h_ = X[1] > X[3] ? X[1] : X[3]; l_ = X[1] > X[3] ? X[3] : X[1]; X[1] = h_; X[3] = l_; h_ = X[4] > X[6] ? X[4] : X[6]; l_ = X[4] > X[6] ? X[6] : X[4]; X[4] = h_; X[6] = l_; h_ = X[5] > X[7] ? X[5] : X[7]; l_ = X[5] > X[7] ? X[7] : X[5]; X[5] = h_; X[7] = l_; h_ = X[8] > X[10] ? X[8] : X[10]; l_ = X[8] > X[10] ? X[10] : X[8]; X[8] = h_; X[10] = l_; h_ = X[9] > X[11] ? X[9] : X[11]; l_ = X[9] > X[11] ? X[11] : X[9]; X[9] = h_; X[11] = l_; h_ = X[12] > X[14] ? X[12] : X[14]; l_ = X[12] > X[14] ? X[14] : X[12]; X[12] = h_; X[14] = l_; h_ = X[13] > X[15] ? X[13] : X[15]; l_ = X[13] > X[15] ? X[15] : X[13]; X[13] = h_; X[15] = l_; h_ = X[0] > X[1] ? X[0] : X[1]; l_ = X[0] > X[1] ? X[1] : X[0]; X[0] = h_; X[1] = l_; h_ = X[2] > X[3] ? X[2] : X[3]; l_ = X[2] > X[3] ? X[3] : X[2]; X[2] = h_; X[3] = l_; h_ = X[4] > X[5] ? X[4] : X[5]; l_ = X[4] > X[5] ? X[5] : X[4]; X[4] = h_; X[5] = l_; h_ = X[6] > X[7] ? X[6] : X[7]; l_ = X[6] > X[7] ? X[7] : X[6]; X[6] = h_; X[7] = l_; h_ = X[8] > X[9] ? X[8] : X[9]; l_ = X[8] > X[9] ? X[9] : X[8]; X[8] = h_; X[9] = l_; h_ = X[10] > X[11] ? X[10] : X[11]; l_ = X[10] > X[11] ? X[11] : X[10]; X[10] = h_; X[11] = l_; h_ = X[12] > X[13] ? X[12] : X[13]; l_ = X[12] > X[13] ? X[13] : X[12]; X[12] = h_; X[13] = l_; h_ = X[14] > X[15] ? X[14] : X[15]; l_ = X[14] > X[15] ? X[15] : X[14]; X[14] = h_; X[15] = l_; } while (0)
#define MERGE16(X) do { unsigned h_, l_; h_ = X[0] > X[8] ? X[0] : X[8]; l_ = X[0] > X[8] ? X[8] : X[0]; X[0] = h_; X[8] = l_; h_ = X[1] > X[9] ? X[1] : X[9]; l_ = X[1] > X[9] ? X[9] : X[1]; X[1] = h_; X[9] = l_; h_ = X[2] > X[10] ? X[2] : X[10]; l_ = X[2] > X[10] ? X[10] : X[2]; X[2] = h_; X[10] = l_; h_ = X[3] > X[11] ? X[3] : X[11]; l_ = X[3] > X[11] ? X[11] : X[3]; X[3] = h_; X[11] = l_; h_ = X[4] > X[12] ? X[4] : X[12]; l_ = X[4] > X[12] ? X[12] : X[4]; X[4] = h_; X[12] = l_; h_ = X[5] > X[13] ? X[5] : X[13]; l_ = X[5] > X[13] ? X[13] : X[5]; X[5] = h_; X[13] = l_; h_ = X[6] > X[14] ? X[6] : X[14]; l_ = X[6] > X[14] ? X[14] : X[6]; X[6] = h_; X[14] = l_; h_ = X[7] > X[15] ? X[7] : X[15]; l_ = X[7] > X[15] ? X[15] : X[7]; X[7] = h_; X[15] = l_; h_ = X[0] > X[4] ? X[0] : X[4]; l_ = X[0] > X[4] ? X[4] : X[0]; X[0] = h_; X[4] = l_; h_ = X[1] > X[5] ? X[1] : X[5]; l_ = X[1] > X[5] ? X[5] : X[1]; X[1] = h_; X[5] = l_; h_ = X[2] > X[6] ? X[2] : X[6]; l_ = X[2] > X[6] ? X[6] : X[2]; X[2] = h_; X[6] = l_; h_ = X[3] > X[7] ? X[3] : X[7]; l_ = X[3] > X[7] ? X[7] : X[3]; X[3] = h_; X[7] = l_; h_ = X[8] > X[12] ? X[8] : X[12]; l_ = X[8] > X[12] ? X[12] : X[8]; X[8] = h_; X[12] = l_; h_ = X[9] > X[13] ? X[9] : X[13]; l_ = X[9] > X[13] ? X[13] : X[9]; X[9] = h_; X[13] = l_; h_ = X[10] > X[14] ? X[10] : X[14]; l_ = X[10] > X[14] ? X[14] : X[10]; X[10] = h_; X[14] = l_; h_ = X[11] > X[15] ? X[11] : X[15]; l_ = X[11] > X[15] ? X[15] : X[11]; X[11] = h_; X[15] = l_; h_ = X[0] > X[2] ? X[0] : X[2]; l_ = X[0] > X[2] ? X[2] : X[0]; X[0] = h_; X[2] = l_; h_ = X[1] > X[3] ? X[1] : X[3]; l_ = X[1] > X[3] ? X[3] : X[1]; X[1] = h_; X[3] = l_; h_ = X[4] > X[6] ? X[4] : X[6]; l_ = X[4] > X[6] ? X[6] : X[4]; X[4] = h_; X[6] = l_; h_ = X[5] > X[7] ? X[5] : X[7]; l_ = X[5] > X[7] ? X[7] : X[5]; X[5] = h_; X[7] = l_; h_ = X[8] > X[10] ? X[8] : X[10]; l_ = X[8] > X[10] ? X[10] : X[8]; X[8] = h_; X[10] = l_; h_ = X[9] > X[11] ? X[9] : X[11]; l_ = X[9] > X[11] ? X[11] : X[9]; X[9] = h_; X[11] = l_; h_ = X[12] > X[14] ? X[12] : X[14]; l_ = X[12] > X[14] ? X[14] : X[12]; X[12] = h_; X[14] = l_; h_ = X[13] > X[15] ? X[13] : X[15]; l_ = X[13] > X[15] ? X[15] : X[13]; X[13] = h_; X[15] = l_; h_ = X[0] > X[1] ? X[0] : X[1]; l_ = X[0] > X[1] ? X[1] : X[0]; X[0] = h_; X[1] = l_; h_ = X[2] > X[3] ? X[2] : X[3]; l_ = X[2] > X[3] ? X[3] : X[2]; X[2] = h_; X[3] = l_; h_ = X[4] > X[5] ? X[4] : X[5]; l_ = X[4] > X[5] ? X[5] : X[4]; X[4] = h_; X[5] = l_; h_ = X[6] > X[7] ? X[6] : X[7]; l_ = X[6] > X[7] ? X[7] : X[6]; X[6] = h_; X[7] = l_; h_ = X[8] > X[9] ? X[8] : X[9]; l_ = X[8] > X[9] ? X[9] : X[8]; X[8] = h_; X[9] = l_; h_ = X[10] > X[11] ? X[10] : X[11]; l_ = X[10] > X[11] ? X[11] : X[10]; X[10] = h_; X[11] = l_; h_ = X[12] > X[13] ? X[12] : X[13]; l_ = X[12] > X[13] ? X[13] : X[12]; X[12] = h_; X[13] = l_; h_ = X[14] > X[15] ? X[14] : X[15]; l_ = X[14] > X[15] ? X[15] : X[14]; X[14] = h_; X[15] = l_; } while (0)

__device__ __forceinline__ unsigned f2ord(float f) { const unsigned u = __float_as_uint(f); return (u & 0x80000000u) ? ~u : (u | 0x80000000u); }
__device__ __forceinline__ float ord2f(unsigned o) { return __uint_as_float((o & 0x80000000u) ? (o & 0x7fffffffu) : ~o); }
#define CANDKEY(sum, c) ((f2ord(sum) & ~255u) | (255u - (unsigned)(c)))
__device__ __forceinline__ void xmerge16(unsigned (&X)[16], int mask) {
  unsigned T[16];
#pragma unroll
  for (int i = 0; i < 16; ++i) T[i] = (unsigned)__shfl_xor((int)X[15 - i], mask);
#pragma unroll
  for (int i = 0; i < 16; ++i) X[i] = X[i] > T[i] ? X[i] : T[i];
  MERGE16(X);
}

__device__ __forceinline__ void ph9_topk(const P& p, int bid, int nb, char* smem) {
  const int tid = threadIdx.x & 255, lane = tid & 63, wave = tid >> 6, lr = lane & 15, lq = lane >> 4;
  bf16_t* kl = (bf16_t*)smem;
  int* idxs = (int*)(smem + 65536) + wave * 512;
  const int h = ((bid >> 1) & 3) * 2 + (bid & 1), nper = nb >> 3, wgi = bid >> 3;
  for (int idx = tid; idx < 4096; idx += NTHR) {
    const int row = idx >> 4, c = idx & 15;
    *(u32x4*)(kl + row * 128 + ((c ^ (row & 15)) << 3)) = *(const u32x4*)(p.keys_bf + (size_t)h * 32768 + row * 128 + c * 8);
  }
  __syncthreads();
  const __amdgpu_buffer_rsrc_t r_q = mk_rsrc(p.qb);
  for (int tile = wgi * 4 + wave; tile < 1024; tile += nper * 4) {
    const int tok = tile * 16 + lr;
    unsigned R0[16], R1[16];
#pragma unroll
    for (int pp = 0; pp < 2; ++pp) {
      bf16x8 bq[4];
#pragma unroll
      for (int kk = 0; kk < 4; ++kk) bq[kk] = bload8c(r_q, (lr * 2048 + lq * 8) * 2 + kk * 64, (tile * 16 * 2048 + h * 256 + pp * 128) * 2);
      f32x4 acc[8];
#pragma unroll
      for (int j = 0; j < 8; ++j) acc[j] = (f32x4){0.f, 0.f, 0.f, 0.f};
#pragma unroll
      for (int j = 0; j < 8; ++j)
#pragma unroll
        for (int kk = 0; kk < 4; ++kk) {
          const bf16x8 a = *(const bf16x8*)(kl + (pp * 128 + j * 16 + lr) * 128 + (((kk * 4 + lq) ^ lr) << 3));
          acc[j] = __builtin_amdgcn_mfma_f32_16x16x32_bf16(a, bq[kk], acc[j], 0, 0, 0);
        }
      unsigned X[16], Y[16];
#pragma unroll
      for (int j = 0; j < 4; ++j)
#pragma unroll
        for (int e = 0; e < 4; ++e) {
          X[j * 4 + e] = (f2ord(acc[j][e]) & ~127u) | (127u - (unsigned)(j * 16 + lq * 4 + e));
          Y[j * 4 + e] = (f2ord(acc[4 + j][e]) & ~127u) | (127u - (unsigned)((4 + j) * 16 + lq * 4 + e));
        }
      SORT16(X);
      SORT16(Y);
#pragma unroll
      for (int i = 0; i < 16; ++i) X[i] = X[i] > Y[15 - i] ? X[i] : Y[15 - i];
      MERGE16(X);
      xmerge16(X, 16);
      xmerge16(X, 32);
#pragma unroll
      for (int i = 0; i < 16; ++i) { if (pp == 0) R0[i] = X[i]; else R1[i] = X[i]; }
    }
    if (lq == 0) {
#pragma unroll
      for (int i = 0; i < 16; ++i) { idxs[lr * 32 + i] = 127 - (int)(R0[i] & 127u); idxs[lr * 32 + 16 + i] = 127 - (int)(R1[i] & 127u); }
    }
    asm volatile("s_waitcnt lgkmcnt(0)" ::: "memory");
    float va[16], vb[16];
#pragma unroll
    for (int i = 0; i < 16; ++i) { va[i] = ord2f(R0[i] & ~127u); vb[i] = ord2f(R1[i] & ~127u); }
    unsigned F[16];
  F[0] = lq == 0 ? CANDKEY(va[0] + vb[0], 0) : (lq == 1 ? CANDKEY(va[1] + vb[0], 16) : (lq == 2 ? CANDKEY(va[3] + vb[0], 48) : CANDKEY(va[13] + vb[0], 208)));
  F[1] = lq == 0 ? CANDKEY(va[0] + vb[1], 1) : (lq == 1 ? CANDKEY(va[1] + vb[1], 17) : (lq == 2 ? CANDKEY(va[3] + vb[1], 49) : CANDKEY(va[14] + vb[0], 224)));
  F[2] = lq == 0 ? CANDKEY(va[0] + vb[2], 2) : (lq == 1 ? CANDKEY(va[1] + vb[2], 18) : (lq == 2 ? CANDKEY(va[3] + vb[2], 50) : CANDKEY(va[15] + vb[0], 240)));
  F[3] = lq == 0 ? CANDKEY(va[0] + vb[3], 3) : (lq == 1 ? CANDKEY(va[1] + vb[3], 19) : (lq == 2 ? CANDKEY(va[3] + vb[3], 51) : 0u));
  F[4] = lq == 0 ? CANDKEY(va[0] + vb[4], 4) : (lq == 1 ? CANDKEY(va[1] + vb[4], 20) : (lq == 2 ? CANDKEY(va[4] + vb[0], 64) : 0u));
  F[5] = lq == 0 ? CANDKEY(va[0] + vb[5], 5) : (lq == 1 ? CANDKEY(va[1] + vb[5], 21) : (lq == 2 ? CANDKEY(va[4] + vb[1], 65) : 0u));
  F[6] = lq == 0 ? CANDKEY(va[0] + vb[6], 6) : (lq == 1 ? CANDKEY(va[1] + vb[6], 22) : (lq == 2 ? CANDKEY(va[4] + vb[2], 66) : 0u));
  F[7] = lq == 0 ? CANDKEY(va[0] + vb[7], 7) : (lq == 1 ? CANDKEY(va[1] + vb[7], 23) : (lq == 2 ? CANDKEY(va[6] + vb[0], 96) : 0u));
  F[8] = lq == 0 ? CANDKEY(va[0] + vb[8], 8) : (lq == 1 ? CANDKEY(va[2] + vb[0], 32) : (lq == 2 ? CANDKEY(va[6] + vb[1], 97) : 0u));
  F[9] = lq == 0 ? CANDKEY(va[0] + vb[9], 9) : (lq == 1 ? CANDKEY(va[2] + vb[1], 33) : (lq == 2 ? CANDKEY(va[7] + vb[0], 112) : 0u));
  F[10] = lq == 0 ? CANDKEY(va[0] + vb[10], 10) : (lq == 1 ? CANDKEY(va[2] + vb[2], 34) : (lq == 2 ? CANDKEY(va[7] + vb[1], 113) : 0u));
  F[11] = lq == 0 ? CANDKEY(va[0] + vb[11], 11) : (lq == 1 ? CANDKEY(va[2] + vb[3], 35) : (lq == 2 ? CANDKEY(va[8] + vb[0], 128) : 0u));
  F[12] = lq == 0 ? CANDKEY(va[0] + vb[12], 12) : (lq == 1 ? CANDKEY(va[2] + vb[4], 36) : (lq == 2 ? CANDKEY(va[9] + vb[0], 144) : 0u));
  F[13] = lq == 0 ? CANDKEY(va[0] + vb[13], 13) : (lq == 1 ? CANDKEY(va[5] + vb[0], 80) : (lq == 2 ? CANDKEY(va[10] + vb[0], 160) : 0u));
  F[14] = lq == 0 ? CANDKEY(va[0] + vb[14], 14) : (lq == 1 ? CANDKEY(va[5] + vb[1], 81) : (lq == 2 ? CANDKEY(va[11] + vb[0], 176) : 0u));
  F[15] = lq == 0 ? CANDKEY(va[0] + vb[15], 15) : (lq == 1 ? 0u : (lq == 2 ? CANDKEY(va[12] + vb[0], 192) : 0u));

    SORT16(F);
    xmerge16(F, 16);
    xmerge16(F, 32);
    if (lq == 0) {
      float ev[16];
      const float mx = ord2f(F[0] & ~255u);
      float tot = 0.f;
#pragma unroll
      for (int r = 0; r < 16; ++r) { ev[r] = __expf(ord2f(F[r] & ~255u) - mx); tot += ev[r]; }
      const float inv = 1.f / tot;
      int ei[16];
#pragma unroll
      for (int r = 0; r < 16; ++r) {
        const int c = 255 - (int)(F[r] & 255u);
        ei[r] = idxs[lr * 32 + (c >> 4)] * 128 + idxs[lr * 32 + 16 + (c & 15)];
      }
      unsigned short* ep = p.eidx + (size_t)tok * 128 + h * 16;
      float* gp = p.gate + (size_t)tok * 128 + h * 16;
#pragma unroll
      for (int r = 0; r < 4; ++r) {
        *(f32x4*)(gp + r * 4) = (f32x4){ev[r * 4] * inv, ev[r * 4 + 1] * inv, ev[r * 4 + 2] * inv, ev[r * 4 + 3] * inv};
      }
#pragma unroll
      for (int r = 0; r < 2; ++r)
        *(u32x4*)(ep + r * 8) = (u32x4){(unsigned)ei[r * 8] | ((unsigned)ei[r * 8 + 1] << 16), (unsigned)ei[r * 8 + 2] | ((unsigned)ei[r * 8 + 3] << 16),
                                         (unsigned)ei[r * 8 + 4] | ((unsigned)ei[r * 8 + 5] << 16), (unsigned)ei[r * 8 + 6] | ((unsigned)ei[r * 8 + 7] << 16)};
    }
  }
}

__device__ __forceinline__ void ph_convert_tables(const P& p, int bid, int nb) {
  const int wave = (threadIdx.x >> 6) & 3, lane = threadIdx.x & 63;
  for (int row = bid * 4 + wave; row < 32768; row += nb * 4) {
    const bool isu = row < 16384;
    const float* src = isu ? p.U + (size_t)row * 1024 : p.V + (size_t)(row - 16384) * 1024;
    unsigned char* dst = isu ? p.U8 + (size_t)row * 1024 : p.V8 + (size_t)(row - 16384) * 1024;
    const float sc = isu ? 512.f : 32.f;
#pragma unroll
    for (int j = 0; j < 4; ++j) {
      const f32x4 v = __builtin_nontemporal_load((const f32x4*)src + j * 64 + lane);
      int w = 0;
      w = __builtin_amdgcn_cvt_pk_fp8_f32(v.x * sc, v.y * sc, w, false);
      w = __builtin_amdgcn_cvt_pk_fp8_f32(v.z * sc, v.w * sc, w, true);
      *(int*)(dst + j * 256 + lane * 4) = w;
    }
  }
}

__device__ __forceinline__ float gelu_exact(float a) { return 0.5f * a * (1.f + erff(a * 0.70710678118654752f)); }

#define G_LOAD(buf, j, g_) do { const int g__ = (g_); const int er__ = (g__ & 8) ? e1s[j] : e0s[j]; \
    _Pragma("unroll") for (int k = 0; k < 8; ++k) { const int e__ = __builtin_amdgcn_readlane(er__, (g__ & 7) * 8 + k); \
      buf[k] = *((const u32x4*)(tab + (size_t)e__ * 1024) + lane); } } while (0)
#define G_COMPUTE_U(buf, j, g_) do { const int g__ = (g_); \
      float pp[8]; \
      _Pragma("unroll") for (int k = 0; k < 8; ++k) { \
        f32x2 ac = {0.f, 0.f}; \
        _Pragma("unroll") for (int d = 0; d < 4; ++d) { \
          ac = __builtin_amdgcn_cvt_pk_f32_fp8((int)buf[k][d], false) * x2[j][2 * d] + ac; \
          ac = __builtin_amdgcn_cvt_pk_f32_fp8((int)buf[k][d], true) * x2[j][2 * d + 1] + ac; } \
        pp[k] = ac.x + ac.y; } \
        \
      float q4[4], r2[2], tt; \
      _Pragma("unroll") for (int i = 0; i < 4; ++i) { const float sd = b5 ? pp[i] : pp[i + 4]; q4[i] = (b5 ? pp[i + 4] : pp[i]) + __shfl_xor(sd, 32); } \
      _Pragma("unroll") for (int i = 0; i < 2; ++i) { const float sd = b4 ? q4[i] : q4[i + 2]; r2[i] = (b4 ? q4[i + 2] : q4[i]) + __shfl_xor(sd, 16); } \
      { const float sd = b3 ? r2[0] : r2[1]; tt = (b3 ? r2[1] : r2[0]) + __shfl_xor(sd, 8); } \
      tt += __shfl_xor(tt, 4); tt += __shfl_xor(tt, 2); tt += __shfl_xor(tt, 1); \
      const float dv = __shfl(tt, (lane & 7) * 8); \
      if ((lane >> 3) == (g__ & 7)) { if (g__ & 8) a1[j] = dv; else a0[j] = dv; } } while (0)
#define G_COMPUTE_V(buf, j, g_) do { const int g__ = (g_); \
      const int wr__ = __float_as_int((g__ & 8) ? w1s[j] : w0s[j]); \
      _Pragma("unroll") for (int k = 0; k < 8; ++k) { \
        const float w__ = __int_as_float(__builtin_amdgcn_readlane(wr__, (g__ & 7) * 8 + k)); \
        const f32x2 ww = {w__, w__}; \
        _Pragma("unroll") for (int d = 0; d < 4; ++d) { \
          y2[j][2 * d] = __builtin_amdgcn_cvt_pk_f32_fp8((int)buf[k][d], false) * ww + y2[j][2 * d]; \
          y2[j][2 * d + 1] = __builtin_amdgcn_cvt_pk_f32_fp8((int)buf[k][d], true) * ww + y2[j][2 * d + 1]; } } } while (0)
#define G_SWEEP(COMP) do { \
    G_LOAD(A, 0, 0); G_LOAD(B, 1, 0); G_LOAD(C, 0, 1); \
    _Pragma("unroll 1") for (int g = 0; g < 16; g += 2) { \
      const int gn = g + 2 < 16 ? g + 2 : g;              \
      G_LOAD(D, 1, g + 1); COMP(A, 0, g); \
      G_LOAD(A, 0, gn); COMP(B, 1, g); \
      G_LOAD(B, 1, gn); COMP(C, 0, g + 1); \
      G_LOAD(C, 0, gn + 1); COMP(D, 1, g + 1); } } while (0)

__device__ __forceinline__ void ph10_gather(const P& p, int bid, int nb, char* smem) {
  const int wave = __builtin_amdgcn_readfirstlane((threadIdx.x >> 6) & 3), lane = threadIdx.x & 63;
  const bool b5 = lane & 32, b4 = lane & 16, b3 = lane & 8;
  int* se = (int*)(smem + wave * 1024);
  float* sg = (float*)(se + 128);
  for (int oct = bid * 4 + wave; oct < TL / 8; oct += nb * 4) {
#pragma unroll 1
    for (int grp = 0; grp < 4; ++grp) {
      int diag_bad = 0;
      const int tok0 = oct * 8 + grp * 2;
      int e0s[2], e1s[2];
      float g0s[2], g1s[2], a0[2], a1[2], w0s[2], w1s[2];
      f32x2 x2[2][8], y2[2][8];
#pragma unroll
      for (int j = 0; j < 2; ++j) {
        const int tok = tok0 + j;
        const int e0 = (int)p.eidx[(size_t)tok * 128 + lane], e1 = (int)p.eidx[(size_t)tok * 128 + 64 + lane];
        const float g0 = p.gate[(size_t)tok * 128 + lane], g1 = p.gate[(size_t)tok * 128 + 64 + lane];
        {
          const float gs = wave_sum(g0 + g1);
          const bool bad = (e0 < 0) || (e0 > 16383) || (e1 < 0) || (e1 > 16383) || !(fabsf(gs - 8.f) < 1e-2f);
          if (__ballot(bad) != 0ull) diag_bad = 1;
        }
        const int sl0 = e0 >> 10, sl1 = e1 >> 10;
        int base = 0, pos0 = 0, pos1 = 0;
#pragma unroll
        for (int sidx = 0; sidx < 16; ++sidx) {
          const unsigned long long m0 = __ballot(sl0 == sidx), m1 = __ballot(sl1 == sidx);
          const int c0 = __popcll(m0), c1 = __popcll(m1);
          const int r0 = __builtin_amdgcn_mbcnt_hi((unsigned)(m0 >> 32), __builtin_amdgcn_mbcnt_lo((unsigned)m0, 0u));
          const int r1 = __builtin_amdgcn_mbcnt_hi((unsigned)(m1 >> 32), __builtin_amdgcn_mbcnt_lo((unsigned)m1, 0u));
          if (sl0 == sidx) pos0 = base + r0;
          if (sl1 == sidx) pos1 = base + c0 + r1;
          base += c0 + c1;
        }
        asm volatile("s_waitcnt lgkmcnt(0)" ::: "memory");
        se[pos0] = e0; se[pos1] = e1; sg[pos0] = g0; sg[pos1] = g1;
        asm volatile("s_waitcnt lgkmcnt(0)" ::: "memory");
        e0s[j] = se[lane]; e1s[j] = se[64 + lane]; g0s[j] = sg[lane]; g1s[j] = sg[64 + lane];
        asm volatile("s_waitcnt lgkmcnt(0)" ::: "memory");
        const __amdgpu_buffer_rsrc_t r_h2 = mk_rsrc(p.hn);
        const u32x4 h0 = uload4c(r_h2, (tok * 1024 + lane * 16) * 2, 0);
        const u32x4 h1 = uload4c(r_h2, (tok * 1024 + lane * 16 + 8) * 2, 0);
#pragma unroll
        for (int i = 0; i < 4; ++i) { x2[j][i] = (f32x2){blo(h0[i]), bhi(h0[i])}; x2[j][4 + i] = (f32x2){blo(h1[i]), bhi(h1[i])}; }
        a0[j] = 0.f; a1[j] = 0.f;
      }
      u32x4 A[8], B[8], C[8], D[8];
      { const unsigned char* tab = p.U8; G_SWEEP(G_COMPUTE_U); }
#pragma unroll
      for (int j = 0; j < 2; ++j) { w0s[j] = gelu_exact(a0[j] * (1.f / 512.f)) * g0s[j]; w1s[j] = gelu_exact(a1[j] * (1.f / 512.f)) * g1s[j];
#pragma unroll
        for (int i = 0; i < 8; ++i) y2[j][i] = (f32x2){0.f, 0.f}; }
      { const unsigned char* tab = p.V8; G_SWEEP(G_COMPUTE_V); }
#pragma unroll
      for (int j = 0; j < 2; ++j) {
        const int tok = tok0 + j, b = tok / SEQ;
        float* orow = p.out + (size_t)tok * 1024 + lane * 16;
        const float* g2 = p.mod + b * 6144 + 5 * 1024 + lane * 16;
        float z[16];
        float ss = 0.f;
#pragma unroll
        for (int q = 0; q < 4; ++q) {
          const f32x4 xl = fload4c(mk_rsrc(p.out), (tok * 1024 + lane * 16 + q * 4) * 4, 0);
          const f32x4 gg = *(const f32x4*)(g2 + q * 4);
          const float yv[4] = {y2[j][2 * q].x, y2[j][2 * q].y, y2[j][2 * q + 1].x, y2[j][2 * q + 1].y};
#pragma unroll
          for (int i = 0; i < 4; ++i) { const float zz = xl[i] + gg[i] * (yv[i] * (1.f / 32.f)); z[q * 4 + i] = zz; ss += zz * zz; }
        }
        ss = wave_sum(ss);
        const float rstd = rsqrtf(ss * (1.f / 1024.f) + 1e-6f);
#pragma unroll
        for (int q = 0; q < 4; ++q) {
          const f32x4 fw = *(const f32x4*)(p.final_norm_w + lane * 16 + q * 4);
          f32x4 o;
#pragma unroll
          for (int i = 0; i < 4; ++i) o[i] = diag_bad ? __builtin_inff() : z[q * 4 + i] * rstd * fw[i];
          *(f32x4*)(orow + q * 4) = o;
        }
      }
    }
  }
}

__global__ void __launch_bounds__(2 * NTHR, 2) mega(P p) {
  __shared__ __attribute__((aligned(16))) char smem_all[2 * LDS_HALF];
  cg::grid_group grid = cg::this_grid();
  const int half = __builtin_amdgcn_readfirstlane(threadIdx.x >> 8);
  char* smem = smem_all + half * LDS_HALF;
  const int bid = blockIdx.x * 2 + half, nb = gridDim.x * 2;
  int nsync = 0;
  const int bng = (gridDim.x % 8 == 0) ? 8 : 1, bper = gridDim.x / bng, bgrp = blockIdx.x % bng;
  if (blockIdx.x == 0) { p.bar[threadIdx.x] = 0u; p.bar[512 + threadIdx.x] = 0u; }
#ifndef REPEAT_MASK
#define REPEAT_MASK 0
#endif
#ifndef EXTRA_SYNCS
#define EXTRA_SYNCS 0
#endif
#define GSYNC() do { asm volatile("s_waitcnt vmcnt(0)" ::: "memory"); \
    if (nsync == 0) { grid.sync(); } else { __syncthreads(); \
      if (threadIdx.x == 0) { __builtin_amdgcn_fence(__ATOMIC_RELEASE, "agent"); asm volatile("s_waitcnt vmcnt(0)" ::: "memory"); \
        const unsigned old = __hip_atomic_fetch_add(p.bar + bgrp * 32, 1u, __ATOMIC_RELAXED, __HIP_MEMORY_SCOPE_AGENT); \
        if (old + 1u == (unsigned)(nsync * bper)) { \
          const unsigned o2 = __hip_atomic_fetch_add(p.bar + 256, 1u, __ATOMIC_RELAXED, __HIP_MEMORY_SCOPE_AGENT); \
          if (o2 + 1u == (unsigned)(nsync * bng)) \
            for (int i = 0; i < bng; ++i) __hip_atomic_store(p.bar + 512 + i * 32, (unsigned)nsync, __ATOMIC_RELAXED, __HIP_MEMORY_SCOPE_AGENT); } \
        while (__hip_atomic_load(p.bar + 512 + bgrp * 32, __ATOMIC_RELAXED, __HIP_MEMORY_SCOPE_AGENT) < (unsigned)nsync) __builtin_amdgcn_s_sleep(1); \
        __builtin_amdgcn_fence(__ATOMIC_ACQUIRE, "agent"); asm volatile("s_waitcnt vmcnt(0)" ::: "memory"); } \
      __syncthreads(); } \
    ++nsync; } while (0)
#define RUN(k, call) if ((PHMASK & (1 << k)) && p.ph_lo <= k && k < p.ph_hi) { call; if (REPEAT_MASK & (1 << k)) { GSYNC(); call; } \
    if (k + 1 < p.ph_hi) { GSYNC(); for (int xs = 0; xs < EXTRA_SYNCS; ++xs) GSYNC(); } }
  RUN(0, ph0_prep(p, bid, nb, smem))
  RUN(1, ph_norm_rows<0>(p, bid, nb))
  RUN(2, ph_gemm8<0>(p, smem_all))
  RUN(3, ph3_chunk_local(p, bid, nb, smem))
  RUN(4, ph4_scan(p, bid, nb))
  RUN(5, ph5_mlstm_out(p, bid, nb, smem))
  RUN(6, (ph_gemm8<1>(p, smem_all), ph_convert_tables(p, bid, nb)))
  RUN(7, ph_norm_rows<1>(p, bid, nb))
  RUN(8, ph_gemm8<2>(p, smem_all))
  RUN(9, ph9_topk(p, bid, nb, smem))
  RUN(10, ph10_gather(p, bid, nb, smem))
#undef RUN
}

extern "C" void kernel_launch(void* const* d_in, const int* in_sizes, int n_in, void* d_out, int out_size, void* d_ws, size_t ws_size,
                              hipStream_t stream) {
  static int grid_blocks = 0;
  if (!grid_blocks) {
    int dev = 0, cus = 0, per_cu = 0;
    hipGetDevice(&dev);
    hipDeviceGetAttribute(&cus, hipDeviceAttributeMultiprocessorCount, dev);
    hipOccupancyMaxActiveBlocksPerMultiprocessor(&per_cu, (const void*)mega, 2 * NTHR, 0);
    per_cu = 1;
    grid_blocks = cus * per_cu;
    if (ws_size < WS_END) fprintf(stderr, "kernel_launch: workspace too small: %zu < %llu\n", ws_size, (unsigned long long)WS_END);
  }
  P p{};
  const float* const* in = (const float* const*)d_in;
  p.x = in[0]; p.c = in[1]; p.ctx = in[2]; p.c_ctx = in[3]; p.w_mod = in[4]; p.b_mod = in[5]; p.norm1_w = in[6]; p.w_in = in[7];
  p.conv_w = in[8]; p.conv_b = in[9]; p.b_gates = in[10]; p.head_norm_w = in[11]; p.pool_w = in[12]; p.pool_scale = in[13];
  p.w_out = in[14]; p.norm2_w = in[15]; p.wq = in[16]; p.keys = in[17]; p.U = in[18]; p.V = in[19]; p.final_norm_w = in[20];
  p.out = (float*)d_out;
  p.bar = (unsigned*)d_ws;
  char* ws = (char*)d_ws;
  p.mod = (float*)(ws + OFF_MOD); p.gates = (float*)(ws + OFF_GATES);
  p.wt_in = (bf16_t*)(ws + OFF_WTIN); p.wt_out = (bf16_t*)(ws + OFF_WTOUT); p.wt_q = (bf16_t*)(ws + OFF_WTQ);
  p.keys_bf = (bf16_t*)(ws + OFF_KEYS); p.hn = (bf16_t*)(ws + OFF_HN); p.pl = (bf16_t*)(ws + OFF_PL);
  p.Dst = (bf16_t*)(ws + OFF_D); p.ND = (float*)(ws + OFF_ND); p.SC = (float*)(ws + OFF_SC);
  p.CIN = (bf16_t*)(ws + OFF_CIN); p.NIN = (float*)(ws + OFF_NIN); p.MIN_ = (float*)(ws + OFF_MIN);
  p.mix = (bf16_t*)(ws + OFF_D); p.qb = (bf16_t*)(ws + OFF_D);
  p.U8 = (unsigned char*)(ws + OFF_U8); p.V8 = (unsigned char*)(ws + OFF_U8 + 16777216ull);
  p.eidx = (unsigned short*)(ws + OFF_EIDX); p.gate = (float*)(ws + OFF_GATE);
#if N_LAUNCHES == 1
  p.ph_lo = 0; p.ph_hi = NPH;
  void* args[] = {&p};
  hipError_t e = hipLaunchCooperativeKernel((const void*)mega, dim3(grid_blocks), dim3(2 * NTHR), args, 0, stream);
  if (e != hipSuccess) fprintf(stderr, "cooperative launch failed: %s (grid %d)\n", hipGetErrorString(e), grid_blocks);
#else
  for (int ph = 0; ph < NPH; ++ph) {
    p.ph_lo = ph; p.ph_hi = ph + 1;
    void* args[] = {&p};
    hipError_t e = hipLaunchCooperativeKernel((const void*)mega, dim3(grid_blocks), dim3(2 * NTHR), args, 0, stream);
    if (e != hipSuccess) fprintf(stderr, "launch %d failed: %s (grid %d)\n", ph, hipGetErrorString(e), grid_blocks);
  }
#endif
}
```

```cpp
#include <hip/hip_runtime.h>
#include <hip/hip_cooperative_groups.h>
#include <stdint.h>
#include <stdio.h>
namespace cg = cooperative_groups;

#ifndef PHMASK
#define PHMASK 0x7ff
#endif
#ifndef N_LAUNCHES
#define N_LAUNCHES 1
#endif

typedef unsigned short bf16_t;
typedef short bf16x8 __attribute__((ext_vector_type(8)));
typedef float f32x4 __attribute__((ext_vector_type(4)));
typedef unsigned u32x4 __attribute__((ext_vector_type(4)));
typedef float f32x2 __attribute__((ext_vector_type(2)));
typedef unsigned u32x2 __attribute__((ext_vector_type(2)));
typedef __bf16 bf16x2 __attribute__((ext_vector_type(2)));

#define NB 8
#define SEQ 2048
#define DM 1024
#define CTXL 256
#define TL 16384
#define TC 2048
#define TR 18432
#define LDP 2624
#define NPADIN 2688
#define NTHR 256
#define LDS_HALF 73728
#define NPH 11

#define OFF_MOD    (4096ull)
#define OFF_GATES  (OFF_MOD + 262144ull)
#define OFF_WTIN   (OFF_GATES + 1179648ull)
#define OFF_WTOUT  (OFF_WTIN + 5767168ull)
#define OFF_WTQ    (OFF_WTOUT + 2097152ull)
#define OFF_KEYS   (OFF_WTQ + 4194304ull)
#define OFF_POOLWT (OFF_KEYS + 524288ull)
#define OFF_HN     (OFF_POOLWT + 131072ull)
#define OFF_PL     (OFF_HN + 37748736ull)
#define OFF_D      (OFF_PL + 96731136ull)
#define OFF_ND     (OFF_D + 37748736ull)
#define OFF_SC     (OFF_ND + 589824ull)
#define OFF_CIN    (OFF_SC + 147456ull)
#define OFF_NIN    (OFF_CIN + 33554432ull)
#define OFF_MIN    (OFF_NIN + 524288ull)
#define OFF_EIDX   (OFF_MIN + 131072ull)
#define OFF_GATE   (OFF_EIDX + 4194304ull)
#define OFF_U8     (OFF_GATE + 8388608ull)
#define WS_END     (OFF_U8 + 33554432ull)

struct P {
  const float *x, *c, *ctx, *c_ctx, *w_mod, *b_mod, *norm1_w, *w_in, *conv_w, *conv_b, *b_gates, *head_norm_w,
      *pool_w, *pool_scale, *w_out, *norm2_w, *wq, *keys, *U, *V, *final_norm_w;
  float* out;
  float* mod;
  float* gates;
  bf16_t* wt_in;
  bf16_t* wt_out;
  bf16_t* wt_q;
  bf16_t* keys_bf;
  bf16_t* hn;
  bf16_t* pl;
  bf16_t* Dst;
  float* ND;
  float* SC;
  bf16_t* CIN;
  float* NIN;
  float* MIN_;
  bf16_t* mix;
  bf16_t* qb;
  unsigned char* U8;
  unsigned char* V8;
  unsigned short* eidx;
  float* gate;
  int ph_lo, ph_hi;
  unsigned* flg;
  unsigned* bar;
};

__device__ __forceinline__ bf16_t f2bf(float f) { return __builtin_bit_cast(bf16_t, (__bf16)f); }
__device__ __forceinline__ float bf2f(bf16_t h) { return __uint_as_float(((unsigned)h) << 16); }
__device__ __forceinline__ float wave_sum(float v) {
#pragma unroll
  for (int o = 32; o > 0; o >>= 1) v += __shfl_xor(v, o);
  return v;
}
__device__ __forceinline__ float silu_f(float v) { return v / (1.f + __expf(-v)); }
__device__ __forceinline__ float logsig_f(float v) { return fminf(v, 0.f) - log1pf(__expf(-fabsf(v))); }

__device__ __forceinline__ __amdgpu_buffer_rsrc_t mk_rsrc(const void* ptr) { return __builtin_amdgcn_make_buffer_rsrc((void*)ptr, 0, 0x7fffffff, 0x00020000); }
__device__ __forceinline__ bf16x8 bload8(__amdgpu_buffer_rsrc_t r, int voff, int soff) { return __builtin_bit_cast(bf16x8, __builtin_amdgcn_raw_buffer_load_b128(r, voff, soff, 0)); }
#define AUX_SC1 16
__device__ __forceinline__ bf16x8 bload8c(__amdgpu_buffer_rsrc_t r, int voff, int soff) { return __builtin_bit_cast(bf16x8, __builtin_amdgcn_raw_buffer_load_b128(r, voff, soff, AUX_SC1)); }
__device__ __forceinline__ u32x2 uload2c(__amdgpu_buffer_rsrc_t r, int voff, int soff) { return __builtin_bit_cast(u32x2, __builtin_amdgcn_raw_buffer_load_b64(r, voff, soff, AUX_SC1)); }
__device__ __forceinline__ float fload1c(__amdgpu_buffer_rsrc_t r, int voff, int soff) { return __builtin_bit_cast(float, __builtin_amdgcn_raw_buffer_load_b32(r, voff, soff, AUX_SC1)); }
__device__ __forceinline__ f32x4 fload4c(__amdgpu_buffer_rsrc_t r, int voff, int soff) { return __builtin_bit_cast(f32x4, __builtin_amdgcn_raw_buffer_load_b128(r, voff, soff, AUX_SC1)); }
__device__ __forceinline__ u32x4 uload4c(__amdgpu_buffer_rsrc_t r, int voff, int soff) { return __builtin_bit_cast(u32x4, __builtin_amdgcn_raw_buffer_load_b128(r, voff, soff, AUX_SC1)); }

__device__ __forceinline__ void ph0_prep(const P& p, int bid, int nb, char* smem) {
  float* sm = (float*)smem;
  const int tid = threadIdx.x & 255;
  const int N_MOD = 384, N_TIN = 16 * 44, N_TOUT = 256, N_TQ = 16 * 32, N_POOL = 16;
  const int total = N_MOD + N_TIN + N_TOUT + N_TQ + N_POOL;
  const int trips = (total + nb - 1) / nb;
  for (int k = 0; k < trips; ++k) {
    int r = (bid + k * nb) % total;
    if (r < N_MOD) {
      float* part = sm + 9 * 1024;
      for (int i = tid; i < 9 * 1024; i += NTHR) {
        int rr = i >> 10, kq = i & 1023;
        float v = rr < 8 ? p.c[rr * 1024 + kq] : p.c_ctx[kq];
        sm[i] = silu_f(v);
      }
      __syncthreads();
      {
        const int c = tid & 15, kg = tid >> 4, n = r * 16 + c;
        float acc[9];
#pragma unroll
        for (int q = 0; q < 9; ++q) acc[q] = 0.f;
#pragma unroll 8
        for (int i = 0; i < 64; ++i) {
          const int kq = kg + i * 16;
          const float w = p.w_mod[(size_t)kq * 6144 + n];
#pragma unroll
          for (int q = 0; q < 9; ++q) acc[q] += sm[q * 1024 + kq] * w;
        }
#pragma unroll
        for (int q = 0; q < 9; ++q) part[(kg * 9 + q) * 16 + c] = acc[q];
      }
      __syncthreads();
      if (tid < 144) {
        const int q = tid >> 4, c = tid & 15, n = r * 16 + c;
        float t = p.b_mod[n];
#pragma unroll
        for (int kg = 0; kg < 16; ++kg) t += part[(kg * 9 + q) * 16 + c];
        p.mod[q * 6144 + n] = t;
      }
      continue;
    }
    r -= N_MOD;
    const float* src = nullptr; bf16_t* dst = nullptr; int K = 1024, N = 0, ntn = 0;
    if (r < N_TIN) { src = p.w_in; dst = p.wt_in; N = 2576; ntn = 44; }
    else { r -= N_TIN;
      if (r < N_TOUT) { src = p.w_out; dst = p.wt_out; N = 1024; ntn = 16; }
      else { r -= N_TOUT;
        if (r < N_TQ) { src = p.wq; dst = p.wt_q; N = 2048; ntn = 32; }
        else { r -= N_TQ; int g = r >> 2; r &= 3; src = p.pool_w + g * 16384; dst = (bf16_t*)((char*)p.keys_bf + 524288) + g * 16384; K = 128; N = 128; ntn = 2; }
      }
    }
    {
      int kt = r / ntn, nt = r % ntn, k0 = kt * 64, n0 = nt * 64;
      int cc = tid & 63;
      for (int rr = tid >> 6; rr < 64; rr += 4) {
        int n = n0 + cc;
        sm[rr * 65 + cc] = n < N ? src[(size_t)(k0 + rr) * N + n] : 0.f;
      }
      __syncthreads();
      for (int rr = tid >> 6; rr < 64; rr += 4) dst[(size_t)(n0 + rr) * K + k0 + cc] = f2bf(sm[cc * 65 + rr]);
      __syncthreads();
    }
  }
  for (int i = bid * NTHR + tid; i < 262144; i += nb * NTHR) p.keys_bf[i] = f2bf(p.keys[i]);
}

template <int WHICH>
__device__ __forceinline__ void ph_norm_rows(const P& p, int bid, int nb) {
  const int wave = (threadIdx.x >> 6) & 3, lane = threadIdx.x & 63;
  const int nrows = WHICH == 0 ? TR : TL;
  for (int row = bid * 4 + wave; row < nrows; row += nb * 4) {
    const float* src = WHICH == 0 ? (row < TL ? p.x + (size_t)row * 1024 : p.ctx + (size_t)(row - TL) * 1024) : p.out + (size_t)row * 1024;
    const int mr = row < TL ? row / SEQ : 8;
    float4 v[4];
    float ss = 0.f;
#pragma unroll
    for (int j = 0; j < 4; ++j) {
      if (WHICH == 1) { const f32x4 t = fload4c(mk_rsrc(p.out), (row * 1024 + (j * 64 + lane) * 4) * 4, 0); v[j] = make_float4(t[0], t[1], t[2], t[3]); }
      else v[j] = ((const float4*)src)[j * 64 + lane];
      ss += v[j].x * v[j].x + v[j].y * v[j].y + v[j].z * v[j].z + v[j].w * v[j].w;
    }
    ss = wave_sum(ss);
    const float rstd = rsqrtf(ss * (1.f / 1024.f) + 1e-6f);
    const float* nw = WHICH == 0 ? p.norm1_w : p.norm2_w;
    const float* sh = p.mod + mr * 6144 + (WHICH == 0 ? 0 : 3) * 1024;
    const float* sc = sh + 1024;
#pragma unroll
    for (int j = 0; j < 4; ++j) {
      const int col = j * 256 + lane * 4;
      float4 w4 = *(const float4*)(nw + col), s4 = *(const float4*)(sh + col), c4 = *(const float4*)(sc + col);
      float y0 = v[j].x * rstd * w4.x * (1.f + c4.x) + s4.x;
      float y1 = v[j].y * rstd * w4.y * (1.f + c4.y) + s4.y;
      float y2 = v[j].z * rstd * w4.z * (1.f + c4.z) + s4.z;
      float y3 = v[j].w * rstd * w4.w * (1.f + c4.w) + s4.w;
      uint2 o;
      o.x = (unsigned)f2bf(y0) | ((unsigned)f2bf(y1) << 16);
      o.y = (unsigned)f2bf(y2) | ((unsigned)f2bf(y3) << 16);
      *(uint2*)(p.hn + (size_t)row * 1024 + col) = o;
    }
  }
}

#define GBK 64
#define GLD 72
template <int EPI>
__device__ __forceinline__ void gemm_tile(const P& p, const bf16_t* A, int lda, const bf16_t* Bt, int m0, int n0, bf16_t* sA, bf16_t* sB) {
  const int tid = threadIdx.x & 255, lane = tid & 63, wave = tid >> 6;
  const int wm = wave >> 1, wn = wave & 1;
  const int lr = lane & 15, lq = lane >> 4;
  f32x4 acc[4][4];
#pragma unroll
  for (int i = 0; i < 4; ++i)
#pragma unroll
    for (int j = 0; j < 4; ++j) acc[i][j] = (f32x4){0.f, 0.f, 0.f, 0.f};
  const int sr = tid >> 3, scol = (tid & 7) * 8;
  u32x4 ra[4], rb[4];
  const bf16_t* Ap = A + (size_t)(m0 + sr) * lda + scol;
  const bf16_t* Bp = Bt + (size_t)(n0 + sr) * 1024 + scol;
#pragma unroll
  for (int i = 0; i < 4; ++i) {
    ra[i] = *(const u32x4*)(Ap + (size_t)(i * 32) * lda);
    rb[i] = *(const u32x4*)(Bp + (size_t)(i * 32) * 1024);
  }
  for (int kt = 0; kt < 1024 / GBK; ++kt) {
    __syncthreads();
#pragma unroll
    for (int i = 0; i < 4; ++i) {
      *(u32x4*)(sA + (sr + i * 32) * GLD + scol) = ra[i];
      *(u32x4*)(sB + (sr + i * 32) * GLD + scol) = rb[i];
    }
    __syncthreads();
    {
      const int k0 = (kt + 1 < 1024 / GBK ? kt + 1 : kt) * GBK;
#pragma unroll
      for (int i = 0; i < 4; ++i) {
        ra[i] = *(const u32x4*)(Ap + (size_t)(i * 32) * lda + k0);
        rb[i] = *(const u32x4*)(Bp + (size_t)(i * 32) * 1024 + k0);
      }
    }
#pragma unroll
    for (int ks = 0; ks < 2; ++ks) {
      bf16x8 af[4], bfr[4];
#pragma unroll
      for (int i = 0; i < 4; ++i) {
        af[i] = *(const bf16x8*)(sA + (wm * 64 + i * 16 + lr) * GLD + ks * 32 + lq * 8);
        bfr[i] = *(const bf16x8*)(sB + (wn * 64 + i * 16 + lr) * GLD + ks * 32 + lq * 8);
      }
#pragma unroll
      for (int i = 0; i < 4; ++i)
#pragma unroll
        for (int j = 0; j < 4; ++j) acc[i][j] = __builtin_amdgcn_mfma_f32_16x16x32_bf16(af[i], bfr[j], acc[i][j], 0, 0, 0);
    }
  }
#pragma unroll
  for (int i = 0; i < 4; ++i)
#pragma unroll
    for (int j = 0; j < 4; ++j)
#pragma unroll
      for (int e = 0; e < 4; ++e) {
        const int row = m0 + wm * 64 + i * 16 + lq * 4 + e;
        const int col = n0 + wn * 64 + j * 16 + lr;
        const float v = acc[i][j][e];
        if (EPI == 0) {
          if (col < 2560) p.pl[(size_t)row * LDP + col] = f2bf(v);
          else if (col < 2576) p.gates[(size_t)row * 16 + (col - 2560)] = v;
        } else if (EPI == 1) {
          const int b = row / SEQ;
          p.out[(size_t)row * 1024 + col] = p.x[(size_t)row * 1024 + col] + p.mod[b * 6144 + 2 * 1024 + col] * v;
        } else {
          p.qb[(size_t)row * 2048 + col] = f2bf(v);
        }
      }
}

template <int EPI>
__device__ __forceinline__ void ph_gemm(const P& p, int bid, int nb, char* smem) {
  bf16_t* sA = (bf16_t*)smem;
  bf16_t* sB = sA + 128 * GLD;
  const int ntn = EPI == 0 ? 21 : (EPI == 1 ? 8 : 16);
  const int ntm = EPI == 0 ? 144 : 128;
  const bf16_t* A = EPI == 0 ? p.hn : (EPI == 1 ? p.mix : p.hn);
  const int lda = 1024;
  const bf16_t* Bt = EPI == 0 ? p.wt_in : (EPI == 1 ? p.wt_out : p.wt_q);
  const int nlat = 128 * ntn;
  const int ntiles = EPI == 0 ? nlat + 16 * 13 : ntm * ntn;
  const int trips = (ntiles + nb - 1) / nb;
  for (int k = 0; k < trips; ++k) {
    const int t = (bid + k * nb) % ntiles;
    int tm, tn;
    if (EPI == 0 && t >= nlat) { const int r = t - nlat; tm = 128 + r / 13; tn = r % 13; if (tn == 12) tn = 20; }
    else { tm = t / ntn; tn = t % ntn; }
    gemm_tile<EPI>(p, A, lda, Bt, tm * 128, tn * 128, sA, sB);
  }
}

struct UnitInfo { int isctx, b, c, h, T, seqrow0, row0; };
__device__ __forceinline__ UnitInfo decode_unit(int u) {
  UnitInfo r;
  if (u < 512) { r.isctx = 0; r.b = u >> 6; r.c = (u >> 2) & 15; r.h = u & 3; r.T = SEQ; r.seqrow0 = r.b * SEQ; }
  else { int uu = u - 512; r.isctx = 1; r.b = uu >> 3; r.c = (uu >> 2) & 1; r.h = uu & 3; r.T = CTXL; r.seqrow0 = TL + r.b * CTXL; }
  r.row0 = r.seqrow0 + r.c * 128;
  return r;
}
__device__ __forceinline__ float qk_act(const P& p, int seqrow0, int T, int t, int col) {
  const bf16_t* base = p.pl + (size_t)(seqrow0 + t) * LDP + col;
  float r0 = t > 0 ? bf2f(base[-LDP]) : 0.f;
  float r1 = bf2f(base[0]);
  float r2 = t + 1 < T ? bf2f(base[LDP]) : 0.f;
  float y = p.conv_b[col] + r0 * p.conv_w[col] + r1 * p.conv_w[1024 + col] + r2 * p.conv_w[2048 + col];
  return silu_f(y);
}


typedef short s16x4 __attribute__((ext_vector_type(4)));
#define LDS_AS __attribute__((address_space(3)))
__device__ __forceinline__ s16x4 ds_tr16(const bf16_t* ptr) { return __builtin_amdgcn_ds_read_tr16_b64_v4i16((LDS_AS s16x4*)ptr); }
__device__ __forceinline__ bf16x8 frag_tr(const bf16_t* M, int ld, int s0, int c0, int lr, int lq) {
  const bf16_t* a = M + (s0 + lq * 8 + (lr >> 2)) * ld + c0 + (lr & 3) * 4;
  const s16x4 t0 = ds_tr16(a), t1 = ds_tr16(a + 4 * ld);
  return __builtin_shufflevector(t0, t1, 0, 1, 2, 3, 4, 5, 6, 7);
}
__device__ __forceinline__ unsigned cvt_pk_bf16(float lo, float hi) { const f32x2 v = {lo, hi}; const bf16x2 b = __builtin_convertvector(v, bf16x2); return __builtin_bit_cast(unsigned, b); }
__device__ __forceinline__ float blo(unsigned u) { return __uint_as_float(u << 16); }
__device__ __forceinline__ float bhi(unsigned u) { return __uint_as_float(u & 0xffff0000u); }
#define VLD 136


namespace pg8 {
#define PG8_LAS __attribute__((address_space(3)))
constexpr int BM = 256, BK = 64, HALF = 128, HTB = HALF * BK * 2, STAGE_BYTES = 8 * HTB, NXCD = 8, WGM = 8;
__host__ __device__ __forceinline__ int lds_byte(int r, int c) { const int st = (r >> 4) * 2 + (c >> 5), rr = r & 15, cc = c & 31, ob = rr * 64 + cc * 2; return st * 1024 + (ob ^ (((ob >> 9) & 1) << 5)); }
__host__ __device__ __forceinline__ void stage_rc(int b, int& R, int& C) { const int st = b / 1024, sb = b % 1024, swz = sb ^ (((sb >> 9) & 1) << 5); R = (st >> 1) * 16 + swz / 64; C = (st & 1) * 32 + (swz % 64) / 2; }
__host__ __device__ __forceinline__ int perm32(int rho) { const int n = rho >> 4, i = rho & 15; return 8 * (i >> 2) + 4 * n + (i & 3); }
struct Unit { int pm, pn; };
struct Gemm { const bf16_t* A; const bf16_t* Bt; int M, N, K; };
struct Order {
  int nM, nN, nwg, G, c, extra;
  __device__ void init(int nM_, int nN_, int G_, int c_, int extra_) { nM = nM_; nN = nN_; nwg = nM * nN; G = G_; c = c_; extra = extra_; }
  __device__ bool next(int i, Unit& u) const {
    const long L = (long)i * G + c;
    if (L >= nwg + extra) return false;
    if (L >= nwg) { const int r = (int)L - nwg; u.pm = nM + r / 7; const int q = r % 7; u.pn = q < 6 ? q : 10; return true; }
    int wgid = (int)L; { const int q = nwg / NXCD, r = nwg % NXCD, xcd = wgid % NXCD, off = wgid / NXCD; wgid = (xcd < r ? xcd * (q + 1) : r * (q + 1) + (xcd - r) * q) + off; }
    const int nig = WGM * nN, gid = wgid / nig, fm = gid * WGM, gsz = (nM - fm) < WGM ? (nM - fm) : WGM;
    u.pm = fm + ((wgid % nig) % gsz); u.pn = (wgid % nig) / gsz; return true;
  }
  __device__ __forceinline__ void a_ready(const Unit&) const {}
  __device__ __forceinline__ void done(const Unit&) const {}
};
template <class Epi, class Sched>
__device__ __forceinline__ void gemm_phase(PG8_LAS unsigned char* lds, const Gemm g, const Sched& S, const Epi& E) {
    const int tid = threadIdx.x, wid = __builtin_amdgcn_readfirstlane(tid >> 6), lane = tid & 63, wr = wid >> 2, wc = wid & 3, fr = lane & 15, fq = lane >> 4;
    const int K = g.K, nt = K / BK;
    unsigned voffA[2], voffB[2];
#pragma unroll
    for (int i = 0; i < 2; ++i) { int R, C; stage_rc(tid * 16 + i * 8192, R, C); const int Rb = Epi::PERM ? ((R & ~31) + perm32(R & 31)) : R;
        voffA[i] = (unsigned)(R * K + C) * 2u; voffB[i] = (unsigned)(Rb * K + C) * 2u; }
    const size_t kstep = (size_t)(BK * 2);
    const size_t hstep = (size_t)HALF * K * 2;
    const size_t tstep = 2 * hstep;
    const unsigned ldsw = (unsigned)wid * 1024u;
    const int aoff = lds_byte(wr * 64 + fr, fq * 8), boff = lds_byte(wc * 32 + fr, fq * 8);
#define PG8_SA(b, h) (((b) * 2 + (h)) * HTB)
#define PG8_SB(b, h) ((4 + (b) * 2 + (h)) * HTB)
#define PG8_STAGE_X(bufoff, gbase, voff, aux) do { _Pragma("unroll") for (int _i = 0; _i < 2; ++_i) \
        __builtin_amdgcn_global_load_lds((const unsigned*)((const char*)(gbase) + (voff)[_i]), (PG8_LAS unsigned*)(lds + (bufoff) + ldsw + _i * 8192), 16, 0, aux); } while (0)
#define PG8_STAGE(bufoff, gbase, voff) PG8_STAGE_X(bufoff, gbase, voff, 0)
#define PG8_STAGE_A(bufoff, gbase, voff) do { if (Epi::A_COHERENT) PG8_STAGE_X(bufoff, gbase, voff, AUX_SC1); else PG8_STAGE_X(bufoff, gbase, voff, 0); } while (0)
#define PG8_LDA(dst, b, h) do { _Pragma("unroll") for (int m = 0; m < 4; ++m) _Pragma("unroll") for (int k = 0; k < 2; ++k) dst[m][k] = *(const PG8_LAS bf16x8*)(lds + PG8_SA(b, h) + aoff + m * 2048 + k * 1024); } while (0)
#define PG8_LDB(dst, b, h) do { _Pragma("unroll") for (int n = 0; n < 2; ++n) _Pragma("unroll") for (int k = 0; k < 2; ++k) dst[n][k] = *(const PG8_LAS bf16x8*)(lds + PG8_SB(b, h) + boff + n * 2048 + k * 1024); } while (0)
#define PG8_MMA(ai, bj, At, Bt) do { __builtin_amdgcn_s_setprio(1); _Pragma("unroll") for (int m = 0; m < 4; ++m) _Pragma("unroll") for (int n = 0; n < 2; ++n) _Pragma("unroll") for (int k = 0; k < 2; ++k) \
        acc[ai][bj][m][n] = __builtin_amdgcn_mfma_f32_16x16x32_bf16(Bt[n][k], At[m][k], acc[ai][bj][m][n], 0, 0, 0); __builtin_amdgcn_s_setprio(0); } while (0)
#define PG8_WAIT_V(n) asm volatile("s_waitcnt vmcnt(" #n ")" ::: "memory")
#define PG8_WAIT_L(n) asm volatile("s_waitcnt lgkmcnt(" #n ")" ::: "memory")
#define PG8_BAR __builtin_amdgcn_s_barrier()
#define PG8_SCHED __builtin_amdgcn_sched_barrier(0)
    Unit cur, nxt; int ui = 0;
    if (!S.next(0, cur)) return;
    f32x4 acc[2][2][4][2];
#pragma unroll
    for (int a = 0; a < 2; ++a)
#pragma unroll
        for (int b = 0; b < 2; ++b)
#pragma unroll
            for (int m = 0; m < 4; ++m)
#pragma unroll
                for (int n = 0; n < 2; ++n) acc[a][b][m][n] = (f32x4){0.f, 0.f, 0.f, 0.f};
    bf16x8 At[4][2], B0[2][2], B1[2][2];
    const char* cA = (const char*)g.A + (size_t)cur.pm * tstep; const char* cB = (const char*)g.Bt + (size_t)cur.pn * tstep;
    S.a_ready(cur);
    PG8_STAGE(PG8_SB(0, 0), cB, voffB); PG8_STAGE_A(PG8_SA(0, 0), cA, voffA); PG8_STAGE(PG8_SB(0, 1), cB + hstep, voffB); PG8_STAGE_A(PG8_SA(0, 1), cA + hstep, voffA);
    if (wr == 1) PG8_BAR;
    PG8_WAIT_V(4); PG8_BAR;
    PG8_STAGE(PG8_SB(1, 0), cB + kstep, voffB); PG8_STAGE_A(PG8_SA(1, 0), cA + kstep, voffA); PG8_STAGE(PG8_SB(1, 1), cB + hstep + kstep, voffB);
    PG8_WAIT_V(6); PG8_BAR;
    for (;;) {
        const bool has_next = S.next(ui + 1, nxt);
        const char* nA = has_next ? (const char*)g.A + (size_t)nxt.pm * tstep : cA; const char* nB = has_next ? (const char*)g.Bt + (size_t)nxt.pn * tstep : cB;
        for (int t = 0; t < nt; t += 2) {
            const bool last = (t == nt - 2);
            const char* a1 = cA + (size_t)(t + 1) * kstep;
            const char* a2 = last ? nA : cA + (size_t)(t + 2) * kstep; const char* b2 = last ? nB : cB + (size_t)(t + 2) * kstep;
            const char* a3 = a2 + kstep; const char* b3 = b2 + kstep;
            if (last && has_next) S.a_ready(nxt);
            PG8_LDB(B0, 0, 0); PG8_SCHED; PG8_LDA(At, 0, 0); PG8_STAGE_A(PG8_SA(1, 1), a1 + hstep, voffA);
            PG8_WAIT_L(8); PG8_BAR; PG8_WAIT_L(0); PG8_MMA(0, 0, At, B0); PG8_BAR; PG8_SCHED;
            PG8_LDB(B1, 0, 1); PG8_STAGE(PG8_SB(0, 0), b2, voffB);
            PG8_BAR; PG8_WAIT_L(0); PG8_MMA(0, 1, At, B1); PG8_BAR;
            PG8_LDA(At, 0, 1); PG8_STAGE_A(PG8_SA(0, 0), a2, voffA);
            PG8_BAR; PG8_WAIT_L(0); PG8_MMA(1, 0, At, B0); PG8_BAR; PG8_SCHED;
            PG8_STAGE(PG8_SB(0, 1), b2 + hstep, voffB);
            PG8_WAIT_V(6); PG8_BAR; PG8_MMA(1, 1, At, B1); PG8_BAR;
            PG8_LDB(B0, 1, 0); PG8_SCHED; PG8_LDA(At, 1, 0); PG8_STAGE_A(PG8_SA(0, 1), a2 + hstep, voffA);
            PG8_WAIT_L(8); PG8_BAR; PG8_WAIT_L(0); PG8_MMA(0, 0, At, B0); PG8_BAR; PG8_SCHED;
            PG8_LDB(B1, 1, 1); PG8_STAGE(PG8_SB(1, 0), b3, voffB);
            PG8_BAR; PG8_WAIT_L(0); PG8_MMA(0, 1, At, B1); PG8_BAR;
            PG8_LDA(At, 1, 1); PG8_STAGE_A(PG8_SA(1, 0), a3, voffA);
            PG8_BAR; PG8_WAIT_L(0); PG8_MMA(1, 0, At, B0); PG8_BAR; PG8_SCHED;
            PG8_STAGE(PG8_SB(1, 1), b3 + hstep, voffB);
            PG8_WAIT_V(6); PG8_BAR; PG8_MMA(1, 1, At, B1); PG8_BAR;
        }
        if constexpr (!Epi::AFTER_DRAIN) { E(acc, cur, wr, wc, fr, fq); S.done(cur); }
        if (!has_next) break;
#pragma unroll
        for (int a = 0; a < 2; ++a)
#pragma unroll
            for (int b = 0; b < 2; ++b)
#pragma unroll
                for (int m = 0; m < 4; ++m)
#pragma unroll
                    for (int n = 0; n < 2; ++n) acc[a][b][m][n] = (f32x4){0.f, 0.f, 0.f, 0.f};
        cur = nxt; cA = nA; cB = nB; ++ui;
    }
    PG8_WAIT_V(0);
    if (wr == 0) PG8_BAR;
    PG8_BAR;
    if constexpr (Epi::AFTER_DRAIN) { E.fused(acc, cur, wr, wc, fr, fq, lds, wid, lane); S.done(cur); }
#undef PG8_SA
#undef PG8_SB
#undef PG8_STAGE
#undef PG8_LDA
#undef PG8_LDB
#undef PG8_MMA
#undef PG8_WAIT_V
#undef PG8_WAIT_L
#undef PG8_BAR
#undef PG8_SCHED
}
}

struct EpiIn {
  static constexpr bool PERM = true, AFTER_DRAIN = false, A_COHERENT = true;
  bf16_t* pl; float* gates;
  __device__ __forceinline__ void operator()(const f32x4 (&acc)[2][2][4][2], const pg8::Unit& u, int wr, int wc, int fr, int fq) const {
    const int row0 = u.pm * 256 + wr * 64 + fr;
#pragma unroll
    for (int ai = 0; ai < 2; ++ai)
#pragma unroll
      for (int m = 0; m < 4; ++m) {
        const int row = row0 + ai * 128 + m * 16;
#pragma unroll
        for (int bj = 0; bj < 2; ++bj) {
          const int c0 = u.pn * 256 + bj * 128 + wc * 32 + 8 * fq;
          const f32x4 v0 = acc[ai][bj][m][0], v1 = acc[ai][bj][m][1];
          if (c0 < 2560) {
            u32x4 w;
            w[0] = cvt_pk_bf16(v0[0], v0[1]); w[1] = cvt_pk_bf16(v0[2], v0[3]); w[2] = cvt_pk_bf16(v1[0], v1[1]); w[3] = cvt_pk_bf16(v1[2], v1[3]);
            *(u32x4*)(pl + (size_t)row * LDP + c0) = w;
          } else if (c0 < 2576) {
            *(f32x4*)(gates + (size_t)row * 16 + (c0 - 2560)) = v0;
            *(f32x4*)(gates + (size_t)row * 16 + (c0 - 2560) + 4) = v1;
          }
        }
      }
  }
};
struct EpiOut {
  static constexpr bool PERM = false, AFTER_DRAIN = false, A_COHERENT = true;
  const float* x; const float* mod; float* out;
  __device__ __forceinline__ void operator()(const f32x4 (&acc)[2][2][4][2], const pg8::Unit& u, int wr, int wc, int fr, int fq) const {
    const int row0 = u.pm * 256 + wr * 64 + fr, col0 = u.pn * 256 + wc * 32 + 4 * fq;
    const float* g1 = mod + (u.pm * 256 / SEQ) * 6144 + 2 * 1024;
#pragma unroll
    for (int ai = 0; ai < 2; ++ai)
#pragma unroll
      for (int m = 0; m < 4; ++m) {
        const size_t ro = (size_t)(row0 + ai * 128 + m * 16) * 1024;
#pragma unroll
        for (int bj = 0; bj < 2; ++bj)
#pragma unroll
          for (int n = 0; n < 2; ++n) {
            const int c = col0 + bj * 128 + n * 16;
            const f32x4 xv = *(const f32x4*)(x + ro + c), gv = *(const f32x4*)(g1 + c);
            *(f32x4*)(out + ro + c) = xv + gv * acc[ai][bj][m][n];
          }
      }
  }
};
struct EpiQ {
  static constexpr bool PERM = true, AFTER_DRAIN = false, A_COHERENT = true;
  bf16_t* q;
  __device__ __forceinline__ void operator()(const f32x4 (&acc)[2][2][4][2], const pg8::Unit& u, int wr, int wc, int fr, int fq) const {
    const int row0 = u.pm * 256 + wr * 64 + fr;
#pragma unroll
    for (int ai = 0; ai < 2; ++ai)
#pragma unroll
      for (int m = 0; m < 4; ++m)
#pragma unroll
        for (int bj = 0; bj < 2; ++bj) {
          const int c0 = u.pn * 256 + bj * 128 + wc * 32 + 8 * fq;
          const f32x4 v0 = acc[ai][bj][m][0], v1 = acc[ai][bj][m][1];
          u32x4 w;
          w[0] = cvt_pk_bf16(v0[0], v0[1]); w[1] = cvt_pk_bf16(v0[2], v0[3]); w[2] = cvt_pk_bf16(v1[0], v1[1]); w[3] = cvt_pk_bf16(v1[2], v1[3]);
          *(u32x4*)(q + (size_t)(row0 + ai * 128 + m * 16) * 2048 + c0) = w;
        }
  }
};
template <int EPI>
__device__ __forceinline__ void ph_gemm8(const P& p, char* lds_all) {
  PG8_LAS unsigned char* lds = (PG8_LAS unsigned char*)lds_all;
  pg8::Order S;
  if (EPI == 0) {
    S.init(64, 11, gridDim.x, blockIdx.x, 56);
    const pg8::Gemm g{p.hn, p.wt_in, TR, 2816, 1024};
    const EpiIn E{p.pl, p.gates};
    pg8::gemm_phase<EpiIn, pg8::Order>(lds, g, S, E);
  } else if (EPI == 1) {
    S.init(64, 4, gridDim.x, blockIdx.x, 0);
    const pg8::Gemm g{p.mix, p.wt_out, TL, 1024, 1024};
    const EpiOut E{p.x, p.mod, p.out};
    pg8::gemm_phase<EpiOut, pg8::Order>(lds, g, S, E);
  } else {
    S.init(64, 8, gridDim.x, blockIdx.x, 0);
    const pg8::Gemm g{p.hn, p.wt_q, TL, 2048, 1024};
    const EpiQ E{p.qb};
    pg8::gemm_phase<EpiQ, pg8::Order>(lds, g, S, E);
  }
}

template <bool REV>
__device__ __forceinline__ void scan128(const float* lf, const float* ig, float* bout, float* gout, float* pmout, float& Gtot, float& btot, int lane, float& g0o, float& g1o) {
  const int t0 = REV ? 127 - 2 * lane : 2 * lane, t1 = REV ? 126 - 2 * lane : 2 * lane + 1;
  const float v0 = lf[t0], v1 = lf[t1];
  float sacc = v0 + v1;
#pragma unroll
  for (int off = 1; off < 64; off <<= 1) { const float t = __shfl_up(sacc, off); if (lane >= off) sacc += t; }
  const float b1 = sacc, b0 = sacc - v1;
  const float g0 = ig[t0] - b0, g1 = ig[t1] - b1;
  float m = fmaxf(g0, g1);
#pragma unroll
  for (int off = 1; off < 64; off <<= 1) { const float t = __shfl_up(m, off); if (lane >= off) m = fmaxf(m, t); }
  float prev = __shfl_up(m, 1);
  if (lane == 0) prev = -3.0e38f;
  if (bout) { bout[t0] = b0; bout[t1] = b1; }
  if (gout) { gout[t0] = g0; gout[t1] = g1; }
  g0o = g0; g1o = g1;
  if (pmout) { pmout[t0] = fmaxf(prev, g0); pmout[t1] = m; }
  Gtot = __shfl(m, 63); btot = __shfl(sacc, 63);
}

__device__ __forceinline__ void ph3_chunk_local(const P& p, int bid, int nb, char* smem) {
  bf16_t* Vs = (bf16_t*)smem;
  bf16_t* Ks = Vs + 128 * VLD;
  float* fa = (float*)(Ks + 128 * VLD);
  float *igf = fa, *lff = fa + 128, *igb = fa + 256, *lfb = fa + 384, *ef = fa + 512, *eb = fa + 640, *scal = fa + 768;
  const int tid = threadIdx.x & 255, lane = tid & 63, wave = tid >> 6, lr = lane & 15, lq = lane >> 4;
  const int trips3 = (576 + nb - 1) / nb;
  for (int k3 = 0; k3 < trips3; ++k3) {
    const int u = (bid + k3 * nb) % 576;
    const UnitInfo ui = decode_unit(u);
    const int h = ui.h;
    if (tid < 128) {
      const float* g = p.gates + (size_t)(ui.row0 + tid) * 16;
      igf[tid] = g[h] + p.b_gates[h];
      lff[tid] = logsig_f(g[4 + h] + p.b_gates[4 + h]);
      igb[tid] = g[8 + h] + p.b_gates[8 + h];
      lfb[tid] = logsig_f(g[12 + h] + p.b_gates[12 + h]);
    }
    {
      const int dch = tid & 15, colq = h * 128 + dch * 8, colk = 512 + colq;
#pragma unroll 1
      for (int which = 0; which < 2; ++which) {
        if (which == 1 && ui.isctx) break;
        const int col = which == 0 ? colk : colq;
        float w0[8], w1[8], w2[8], bb[8];
#pragma unroll
        for (int i = 0; i < 8; ++i) { w0[i] = p.conv_w[col + i]; w1[i] = p.conv_w[1024 + col + i]; w2[i] = p.conv_w[2048 + col + i]; bb[i] = p.conv_b[col + i]; }
        const float scl = which == 0 ? 0.08838834764831845f : 1.f;
#pragma unroll 2
        for (int i = 0; i < 8; ++i) {
          const int t = (tid >> 4) + i * 16, tt = ui.c * 128 + t;
          const bf16_t* base = p.pl + (size_t)(ui.row0 + t) * LDP + col;
          const u32x4 z4 = (u32x4){0u, 0u, 0u, 0u};
          const u32x4 r1 = *(const u32x4*)base;
          const u32x4 r0 = tt > 0 ? *(const u32x4*)(base - LDP) : z4;
          const u32x4 r2 = tt + 1 < ui.T ? *(const u32x4*)(base + LDP) : z4;
          float y[8];
#pragma unroll
          for (int q = 0; q < 4; ++q) {
            y[2 * q] = silu_f(bb[2 * q] + blo(r0[q]) * w0[2 * q] + blo(r1[q]) * w1[2 * q] + blo(r2[q]) * w2[2 * q]) * scl;
            y[2 * q + 1] = silu_f(bb[2 * q + 1] + bhi(r0[q]) * w0[2 * q + 1] + bhi(r1[q]) * w1[2 * q + 1] + bhi(r2[q]) * w2[2 * q + 1]) * scl;
          }
          u32x4 o;
#pragma unroll
          for (int q = 0; q < 4; ++q) o[q] = cvt_pk_bf16(y[2 * q], y[2 * q + 1]);
          if (which == 0) *(u32x4*)(Ks + t * VLD + dch * 8) = o;
          if (!ui.isctx) *(u32x4*)(p.hn + (size_t)(ui.row0 + t) * 1024 + col) = o;
        }
      }
#pragma unroll
      for (int i = 0; i < 8; ++i) {
        const int t = (tid >> 4) + i * 16;
        *(u32x4*)(Vs + t * VLD + dch * 8) = *(const u32x4*)(p.pl + (size_t)(ui.row0 + t) * LDP + 1024 + h * 128 + dch * 8);
      }
    }
    __syncthreads();
    if (wave == 0) {
      float G, bt, ga, gb2;
      scan128<false>(lff, igf, nullptr, nullptr, nullptr, G, bt, lane, ga, gb2);
      ef[2 * lane] = __expf(ga - G); ef[2 * lane + 1] = __expf(gb2 - G);
      if (lane == 0) { scal[0] = G; scal[1] = bt; }
    } else if (wave == 1) {
      float G, bt, ga, gb2;
      scan128<true>(lfb, igb, nullptr, nullptr, nullptr, G, bt, lane, ga, gb2);
      eb[127 - 2 * lane] = __expf(ga - G); eb[126 - 2 * lane] = __expf(gb2 - G);
      if (lane == 0) { scal[2] = G; scal[3] = bt; }
    }
    __syncthreads();
#pragma unroll 1
    for (int dir = 0; dir < 2; ++dir) {
      const float* ee = dir ? eb : ef;
      f32x4 acc[2][8];
#pragma unroll
      for (int m = 0; m < 2; ++m)
#pragma unroll
        for (int j = 0; j < 8; ++j) acc[m][j] = (f32x4){0.f, 0.f, 0.f, 0.f};
#pragma unroll
      for (int kk = 0; kk < 4; ++kk) {
        const f32x4 e0 = *(const f32x4*)(ee + kk * 32 + lq * 8), e1 = *(const f32x4*)(ee + kk * 32 + lq * 8 + 4);
        bf16x8 af[2];
#pragma unroll
        for (int m = 0; m < 2; ++m) {
          const bf16x8 raw = frag_tr(Vs, VLD, kk * 32, wave * 32 + m * 16, lr, lq);
          const u32x4 ru = __builtin_bit_cast(u32x4, raw);
          u32x4 sc;
          sc[0] = cvt_pk_bf16(blo(ru[0]) * e0[0], bhi(ru[0]) * e0[1]);
          sc[1] = cvt_pk_bf16(blo(ru[1]) * e0[2], bhi(ru[1]) * e0[3]);
          sc[2] = cvt_pk_bf16(blo(ru[2]) * e1[0], bhi(ru[2]) * e1[1]);
          sc[3] = cvt_pk_bf16(blo(ru[3]) * e1[2], bhi(ru[3]) * e1[3]);
          af[m] = __builtin_bit_cast(bf16x8, sc);
        }
#pragma unroll
        for (int j = 0; j < 8; ++j) {
          const bf16x8 bfr = frag_tr(Ks, VLD, kk * 32, j * 16, lr, lq);
#pragma unroll
          for (int m = 0; m < 2; ++m) acc[m][j] = __builtin_amdgcn_mfma_f32_16x16x32_bf16(af[m], bfr, acc[m][j], 0, 0, 0);
        }
      }
      bf16_t* Dd = p.Dst + (size_t)(u * 2 + dir) * 16384;
#pragma unroll
      for (int m = 0; m < 2; ++m)
#pragma unroll
        for (int j = 0; j < 8; ++j)
#pragma unroll
          for (int e = 0; e < 4; ++e) Dd[(wave * 32 + m * 16 + lq * 4 + e) * 128 + j * 16 + lr] = f2bf(acc[m][j][e]);
    }
    {
      const int dir = tid >> 7, k = tid & 127;
      const float* e = dir ? eb : ef;
      float sacc = 0.f;
      for (int t = 0; t < 128; ++t) sacc += e[t] * bf2f(Ks[t * VLD + k]);
      p.ND[(size_t)(u * 2 + dir) * 128 + k] = sacc;
    }
    if (tid < 4) p.SC[(size_t)(u * 2 + (tid >> 1)) * 32 + (tid & 1)] = scal[tid];
    __syncthreads();
  }
}

__device__ __forceinline__ void ph4_scan(const P& p, int bid, int nb) {
  const int tid = threadIdx.x & 255;
  const __amdgpu_buffer_rsrc_t r_d = mk_rsrc(p.Dst), r_sc = mk_rsrc(p.SC), r_nd = mk_rsrc(p.ND);
  for (int it = bid; it < 1024; it += nb) {
    const int combo = it >> 4, vblk = it & 15;
    const int b = combo >> 3, h = (combo >> 1) & 3, dir = combo & 1;
    const int v = vblk * 8 + (tid >> 5), k0 = (tid & 31) * 4;
    const bool nrow = vblk == 0 && tid < 128;
    u32x2 dd[18]; float Gs[18], bs[18], nds[18];
#pragma unroll
    for (int i = 0; i < 18; ++i) {
      int u;
      if (i < 2) { const int cc = dir == 0 ? i : 1 - i; u = 512 + b * 8 + cc * 4 + h; }
      else { const int lc = i - 2, c = dir == 0 ? lc : 15 - lc; u = b * 64 + c * 4 + h; }
      const int di = u * 2 + dir;
      Gs[i] = fload1c(r_sc, di * 128, 0); bs[i] = fload1c(r_sc, di * 128 + 4, 0);
      dd[i] = uload2c(r_d, (di * 16384 + v * 128 + k0) * 2, 0);
      nds[i] = nrow ? fload1c(r_nd, (di * 128 + tid) * 4, 0) : 0.f;
    }
    float C0 = 0.f, C1 = 0.f, C2 = 0.f, C3 = 0.f, nacc = 0.f, m = 0.f;
#pragma unroll
    for (int i = 0; i < 18; ++i) {
      if (i >= 2) {
        const int lc = i - 2, c = dir == 0 ? lc : 15 - lc;
        const int u = b * 64 + c * 4 + h;
        const size_t ci = (size_t)u * 2 + dir;
        uint2 o;
        o.x = (unsigned)f2bf(C0) | ((unsigned)f2bf(C1) << 16);
        o.y = (unsigned)f2bf(C2) | ((unsigned)f2bf(C3) << 16);
        *(uint2*)(p.CIN + ci * 16384 + v * 128 + k0) = o;
        if (nrow) p.NIN[ci * 128 + tid] = nacc;
        if (vblk == 0 && tid == 0) p.MIN_[ci * 32] = m;
      }
      const float G = Gs[i], bend = bs[i];
      const float Mx = fmaxf(m, G);
      const float dec = __expf(m - Mx), inj = __expf(G - Mx);
      const u32x2 d2 = dd[i];
      C0 = dec * C0 + inj * __uint_as_float(d2.x << 16);
      C1 = dec * C1 + inj * __uint_as_float(d2.x & 0xffff0000u);
      C2 = dec * C2 + inj * __uint_as_float(d2.y << 16);
      C3 = dec * C3 + inj * __uint_as_float(d2.y & 0xffff0000u);
      nacc = dec * nacc + inj * nds[i];
      m = bend + Mx;
    }
  }
}

__device__ __forceinline__ void ph5_mlstm_out(const P& p, int bid, int nb, char* smem) {
  bf16_t* Vs = (bf16_t*)smem;
  bf16_t* Pw = Vs + 128 * VLD;
  float* fa = (float*)(Pw + 4 * 16 * VLD);
  float *igf = fa, *lff = fa + 128, *igb = fa + 256, *lfb = fa + 384, *gf = fa + 512, *gb = fa + 640, *bfw = fa + 768, *bbw = fa + 896,
        *pmf = fa + 1024, *pmb = fa + 1152, *nq = fa + 1280  ;
  const int tid = threadIdx.x & 255, lane = tid & 63, wave = tid >> 6, lr = lane & 15, lq = lane >> 4;
  const int trips5 = (1536 + nb - 1) / nb;
  for (int k5 = 0; k5 < trips5; ++k5) {
    const int it = (bid + k5 * nb) % 1536;
    if (it < 512) {
      const int u = it;
      const UnitInfo ui = decode_unit(u);
      const int h = ui.h;
      const size_t cif = (size_t)u * 2, cib = (size_t)u * 2 + 1;
      if (tid < 128) {
        const float* g = p.gates + (size_t)(ui.row0 + tid) * 16;
        igf[tid] = g[h] + p.b_gates[h];
        lff[tid] = logsig_f(g[4 + h] + p.b_gates[4 + h]);
        igb[tid] = g[8 + h] + p.b_gates[8 + h];
        lfb[tid] = logsig_f(g[12 + h] + p.b_gates[12 + h]);
      }
      {
        const int dch = tid & 15;
#pragma unroll
        for (int i = 0; i < 8; ++i) {
          const int t = (tid >> 4) + i * 16;
          *(u32x4*)(Vs + t * VLD + dch * 8) = *(const u32x4*)(p.pl + (size_t)(ui.row0 + t) * LDP + 1024 + h * 128 + dch * 8);
        }
      }
      {
        const int dir = tid >> 7, t = tid & 127;
        const __amdgpu_buffer_rsrc_t r_hq = mk_rsrc(p.hn);
        const int qoff = ((ui.row0 + t) * 1024 + h * 128) * 2;
        const float* nin = p.NIN + (dir ? cib : cif) * 128;
        float sacc = 0.f;
#pragma unroll 4
        for (int c8 = 0; c8 < 16; ++c8) {
          const u32x4 qv = uload4c(r_hq, qoff + c8 * 16, 0);
#pragma unroll
          for (int q = 0; q < 4; ++q) sacc += blo(qv[q]) * nin[c8 * 8 + 2 * q] + bhi(qv[q]) * nin[c8 * 8 + 2 * q + 1];
        }
        nq[dir * 128 + t] = sacc;
      }
      __syncthreads();
      if (wave == 0) { float G, bt, ga, gb2; scan128<false>(lff, igf, bfw, gf, pmf, G, bt, lane, ga, gb2); }
      else if (wave == 1) { float G, bt, ga, gb2; scan128<true>(lfb, igb, bbw, gb, pmb, G, bt, lane, ga, gb2); }
      __syncthreads();
      const float minf_ = p.MIN_[cif * 32], minb_ = p.MIN_[cib * 32];
      bf16_t* Pme = Pw + wave * 16 * VLD;
      const __amdgpu_buffer_rsrc_t r_hn = mk_rsrc(p.hn), r_cin = mk_rsrc(p.CIN);
      const int fvoff = (lr * 1024 + lq * 8) * 2, cvoff = (lr * 128 + lq * 8) * 2;
#pragma unroll 1
      for (int m = 0; m < 2; ++m) {
        const int t0 = wave * 32 + m * 16;
        bf16x8 Qf[4];
#pragma unroll
        for (int kk = 0; kk < 4; ++kk) Qf[kk] = bload8c(r_hn, fvoff + kk * 64, ((ui.row0 + t0) * 1024 + h * 128) * 2);
        f32x4 S[8];
#pragma unroll
        for (int j = 0; j < 8; ++j) {
          S[j] = (f32x4){0.f, 0.f, 0.f, 0.f};
#pragma unroll
          for (int kk = 0; kk < 4; ++kk) {
            const bf16x8 kf = bload8c(r_hn, fvoff + kk * 64, ((ui.row0 + j * 16) * 1024 + 512 + h * 128) * 2);
            S[j] = __builtin_amdgcn_mfma_f32_16x16x32_bf16(Qf[kk], kf, S[j], 0, 0, 0);
          }
          if (j & 1) __builtin_amdgcn_sched_barrier(0);
        }
        f32x4 hsum[8];
#pragma unroll 1
        for (int dir = 0; dir < 2; ++dir) {
          const float mi = dir ? minb_ : minf_;
          const float* gg = dir ? gb : gf;
          const float* pmx = dir ? pmb : pmf;
          const float* bw = dir ? bbw : bfw;
          float Mrow[4], wi[4];
#pragma unroll
          for (int e = 0; e < 4; ++e) { Mrow[e] = fmaxf(mi, pmx[t0 + lq * 4 + e]); wi[e] = __expf(mi - Mrow[e]); }
          f32x4 acc[8];
#pragma unroll
          for (int jv = 0; jv < 8; ++jv) {
            acc[jv] = (f32x4){0.f, 0.f, 0.f, 0.f};
#pragma unroll
            for (int kk = 0; kk < 4; ++kk) {
              const bf16x8 cf = bload8c(r_cin, cvoff + kk * 64, (int)((dir ? cib : cif) * 32768) + jv * 4096);
              acc[jv] = __builtin_amdgcn_mfma_f32_16x16x32_bf16(Qf[kk], cf, acc[jv], 0, 0, 0);
            }
#pragma unroll
            for (int e = 0; e < 4; ++e) acc[jv][e] *= wi[e];
            if (jv & 1) __builtin_amdgcn_sched_barrier(0);
          }
          float rs[4] = {0.f, 0.f, 0.f, 0.f};
#pragma unroll
          for (int j = 0; j < 8; ++j) {
            const int sidx = j * 16 + lr;
            const float gs = gg[sidx];
#pragma unroll
            for (int e = 0; e < 4; ++e) {
              const int t = t0 + lq * 4 + e;
              const bool keep = dir ? (sidx >= t) : (sidx <= t);
              const float pv = keep ? S[j][e] * __expf(gs - Mrow[e]) : 0.f;
              rs[e] += pv;
              Pme[(lq * 4 + e) * VLD + sidx] = f2bf(pv);
            }
          }
          float den[4];
#pragma unroll
          for (int e = 0; e < 4; ++e) {
            float r = rs[e];
            r += __shfl_xor(r, 1); r += __shfl_xor(r, 2); r += __shfl_xor(r, 4); r += __shfl_xor(r, 8);
            const int t = t0 + lq * 4 + e;
            const float dd = r + wi[e] * nq[dir * 128 + t];
            den[e] = fmaxf(fabsf(dd), __expf(-(bw[t] + Mrow[e])));
          }
          asm volatile("s_waitcnt lgkmcnt(0)" ::: "memory");
          __builtin_amdgcn_wave_barrier();
#pragma unroll
          for (int kk = 0; kk < 4; ++kk) {
            const bf16x8 pf = *(const bf16x8*)(Pme + lr * VLD + kk * 32 + lq * 8);
#pragma unroll
            for (int jv = 0; jv < 8; ++jv) {
              const bf16x8 vf = frag_tr(Vs, VLD, kk * 32, jv * 16, lr, lq);
              acc[jv] = __builtin_amdgcn_mfma_f32_16x16x32_bf16(pf, vf, acc[jv], 0, 0, 0);
            }
          }
          __builtin_amdgcn_wave_barrier();
#pragma unroll
          for (int jv = 0; jv < 8; ++jv)
#pragma unroll
            for (int e = 0; e < 4; ++e) {
              const float hv = acc[jv][e] / den[e];
              if (dir == 0) hsum[jv][e] = hv; else hsum[jv][e] += hv;
            }
        }
#pragma unroll
        for (int e = 0; e < 4; ++e) {
          float sm = 0.f;
#pragma unroll
          for (int jv = 0; jv < 8; ++jv) sm += hsum[jv][e];
          sm += __shfl_xor(sm, 1); sm += __shfl_xor(sm, 2); sm += __shfl_xor(sm, 4); sm += __shfl_xor(sm, 8);
          const float mu = sm * (1.f / 128.f);
          float vs = 0.f;
#pragma unroll
          for (int jv = 0; jv < 8; ++jv) { const float d = hsum[jv][e] - mu; vs += d * d; }
          vs += __shfl_xor(vs, 1); vs += __shfl_xor(vs, 2); vs += __shfl_xor(vs, 4); vs += __shfl_xor(vs, 8);
          const float rstd = rsqrtf(vs * (1.f / 128.f) + 1e-6f);
          const bf16_t* op = p.pl + (size_t)(ui.row0 + t0 + lq * 4 + e) * LDP + 1536 + h * 128;
          bf16_t* mp = p.mix + (size_t)(ui.row0 + t0 + lq * 4 + e) * 1024 + h * 128;
#pragma unroll
          for (int jv = 0; jv < 8; ++jv) {
            const int v = jv * 16 + lr;
            const float o = bf2f(op[v]);
            mp[v] = f2bf((hsum[jv][e] - mu) * rstd * p.head_norm_w[h * 128 + v] / (1.f + __expf(-o)));
          }
        }
      }
      __syncthreads();
    } else {
      const int pu = it - 512, grp = pu >> 2, g = pu & 3;
      float* us = (float*)smem;
      bf16_t* db = (bf16_t*)(us + 8192);
      const int w = 2 << g;
      const size_t rbase = (size_t)grp * 64;
      for (int idx = tid; idx < 1024; idx += NTHR) {
        const int t = idx >> 4, ch = idx & 15;
        const u32x4 r = *(const u32x4*)(p.pl + (rbase + t) * LDP + 2048 + g * 128 + ch * 8);
        float* d = us + t * 128 + ch * 8;
#pragma unroll
        for (int q = 0; q < 4; ++q) { d[2 * q] = blo(r[q]); d[2 * q + 1] = bhi(r[q]); }
      }
      __syncthreads();
      for (int idx = tid; idx < 8192; idx += NTHR) {
        const int t = idx >> 7, i = idx & 127;
        int lo = t - w / 2, hi = t - w / 2 + w;
        lo = lo < 0 ? 0 : lo; hi = hi > 64 ? 64 : hi;
        float sacc = 0.f;
        for (int j = lo; j < hi; ++j) sacc += us[j * 128 + i];
        db[t * VLD + i] = f2bf(sacc / (float)(hi - lo) - us[idx]);
      }
      __syncthreads();
      {
        const bf16_t* wt = (const bf16_t*)((const char*)p.keys_bf + 524288) + g * 16384;
        bf16x8 af[4];
#pragma unroll
        for (int kk = 0; kk < 4; ++kk) af[kk] = *(const bf16x8*)(db + (wave * 16 + lr) * VLD + kk * 32 + lq * 8);
#pragma unroll
        for (int j = 0; j < 8; ++j) {
          f32x4 acc = (f32x4){0.f, 0.f, 0.f, 0.f};
#pragma unroll
          for (int kk = 0; kk < 4; ++kk) {
            const bf16x8 bfr = *(const bf16x8*)(wt + (j * 16 + lr) * 128 + kk * 32 + lq * 8);
            acc = __builtin_amdgcn_mfma_f32_16x16x32_bf16(af[kk], bfr, acc, 0, 0, 0);
          }
          const float ps = p.pool_scale[g * 128 + j * 16 + lr];
#pragma unroll
          for (int e = 0; e < 4; ++e) p.mix[(rbase + wave * 16 + lq * 4 + e) * 1024 + 512 + g * 128 + j * 16 + lr] = f2bf(acc[e] * ps);
        }
      }
      __syncthreads();
    }
  }
}

#define SORT16(X) do { unsigned h_, l_; h_ = X[0] > X[1] ? X[0] : X[1]; l_ = X[0] > X[1] ? X[1] : X[0]; X[0] = h_; X[1] = l_; h_ = X[3] > X[2] ? X[3] : X[2]; l_ = X[3] > X[2] ? X[2] : X[3]; X[3] = h_; X[2] = l_; h_ = X[4] > X[5] ? X[4] : X[5]; l_ = X[4] > X[5] ? X[5] : X[4]; X[4] = h_; X[5] = l_; h_ = X[7] > X[6] ? X[7] : X[6]; l_ = X[7] > X[6] ? X[6] : X[7]; X[7] = h_; X[6] = l_; h_ = X[8] > X[9] ? X[8] : X[9]; l_ = X[8] > X[9] ? X[9] : X[8]; X[8] = h_; X[9] = l_; h_ = X[11] > X[10] ? X[11] : X[10]; l_ = X[11] > X[10] ? X[10] : X[11]; X[11] = h_; X[10] = l_; h_ = X[12] > X[13] ? X[12] : X[13]; l_ = X[12] > X[13] ? X[13] : X[12]; X[12] = h_; X[13] = l_; h_ = X[15] > X[14] ? X[15] : X[14]; l_ = X[15] > X[14] ? X[14] : X[15]; X[15] = h_; X[14] = l_; h_ = X[0] > X[2] ? X[0] : X[2]; l_ = X[0] > X[2] ? X[2] : X[0]; X[0] = h_; X[2] = l_; h_ = X[1] > X[3] ? X[1] : X[3]; l_ = X[1] > X[3] ? X[3] : X[1]; X[1] = h_; X[3] = l_; h_ = X[6] > X[4] ? X[6] : X[4]; l_ = X[6] > X[4] ? X[4] : X[6]; X[6] = h_; X[4] = l_; h_ = X[7] > X[5] ? X[7] : X[5]; l_ = X[7] > X[5] ? X[5] : X[7]; X[7] = h_; X[5] = l_; h_ = X[8] > X[10] ? X[8] : X[10]; l_ = X[8] > X[10] ? X[10] : X[8]; X[8] = h_; X[10] = l_; h_ = X[9] > X[11] ? X[9] : X[11]; l_ = X[9] > X[11] ? X[11] : X[9]; X[9] = h_; X[11] = l_; h_ = X[14] > X[12] ? X[14] : X[12]; l_ = X[14] > X[12] ? X[12] : X[14]; X[14] = h_; X[12] = l_; h_ = X[15] > X[13] ? X[15] : X[13]; l_ = X[15] > X[13] ? X[13] : X[15]; X[15] = h_; X[13] = l_; h_ = X[0] > X[1] ? X[0] : X[1]; l_ = X[0] > X[1] ? X[1] : X[0]; X[0] = h_; X[1] = l_; h_ = X[2] > X[3] ? X[2] : X[3]; l_ = X[2] > X[3] ? X[3] : X[2]; X[2] = h_; X[3] = l_; h_ = X[5] > X[4] ? X[5] : X[4]; l_ = X[5] > X[4] ? X[4] : X[5]; X[5] = h_; X[4] = l_; h_ = X[7] > X[6] ? X[7] : X[6]; l_ = X[7] > X[6] ? X[6] : X[7]; X[7] = h_; X[6] = l_; h_ = X[8] > X[9] ? X[8] : X[9]; l_ = X[8] > X[9] ? X[9] : X[8]; X[8] = h_; X[9] = l_; h_ = X[10] > X[11] ? X[10] : X[11]; l_ = X[10] > X[11] ? X[11] : X[10]; X[10] = h_; X[11] = l_; h_ = X[13] > X[12] ? X[13] : X[12]; l_ = X[13] > X[12] ? X[12] : X[13]; X[13] = h_; X[12] = l_; h_ = X[15] > X[14] ? X[15] : X[14]; l_ = X[15] > X[14] ? X[14] : X[15]; X[15] = h_; X[14] = l_; h_ = X[0] > X[4] ? X[0] : X[4]; l_ = X[0] > X[4] ? X[4] : X[0]; X[0] = h_; X[4] = l_; h_ = X[1] > X[5] ? X[1] : X[5]; l_ = X[1] > X[5] ? X[5] : X[1]; X[1] = h_; X[5] = l_; h_ = X[2] > X[6] ? X[2] : X[6]; l_ = X[2] > X[6] ? X[6] : X[2]; X[2] = h_; X[6] = l_; h_ = X[3] > X[7] ? X[3] : X[7]; l_ = X[3] > X[7] ? X[7] : X[3]; X[3] = h_; X[7] = l_; h_ = X[12] > X[8] ? X[12] : X[8]; l_ = X[12] > X[8] ? X[8] : X[12]; X[12] = h_; X[8] = l_; h_ = X[13] > X[9] ? X[13] : X[9]; l_ = X[13] > X[9] ? X[9] : X[13]; X[13] = h_; X[9] = l_; h_ = X[14] > X[10] ? X[14] : X[10]; l_ = X[14] > X[10] ? X[10] : X[14]; X[14] = h_; X[10] = l_; h_ = X[15] > X[11] ? X[15] : X[11]; l_ = X[15] > X[11] ? X[11] : X[15]; X[15] = h_; X[11] = l_; h_ = X[0] > X[2] ? X[0] : X[2]; l_ = X[0] > X[2] ? X[2] : X[0]; X[0] = h_; X[2] = l_; h_ = X[1] > X[3] ? X[1] : X[3]; l_ = X[1] > X[3] ? X[3] : X[1]; X[1] = h_; X[3] = l_; h_ = X[4] > X[6] ? X[4] : X[6]; l_ = X[4] > X[6] ? X[6] : X[4]; X[4] = h_; X[6] = l_; h_ = X[5] > X[7] ? X[5] : X[7]; l_ = X[5] > X[7] ? X[7] : X[5]; X[5] = h_; X[7] = l_; h_ = X[10] > X[8] ? X[10] : X[8]; l_ = X[10] > X[8] ? X[8] : X[10]; X[10] = h_; X[8] = l_; h_ = X[11] > X[9] ? X[11] : X[9]; l_ = X[11] > X[9] ? X[9] : X[11]; X[11] = h_; X[9] = l_; h_ = X[14] > X[12] ? X[14] : X[12]; l_ = X[14] > X[12] ? X[12] : X[14]; X[14] = h_; X[12] = l_; h_ = X[15] > X[13] ? X[15] : X[13]; l_ = X[15] > X[13] ? X[13] : X[15]; X[15] = h_; X[13] = l_; h_ = X[0] > X[1] ? X[0] : X[1]; l_ = X[0] > X[1] ? X[1] : X[0]; X[0] = h_; X[1] = l_; h_ = X[2] > X[3] ? X[2] : X[3]; l_ = X[2] > X[3] ? X[3] : X[2]; X[2] = h_; X[3] = l_; h_ = X[4] > X[5] ? X[4] : X[5]; l_ = X[4] > X[5] ? X[5] : X[4]; X[4] = h_; X[5] = l_; h_ = X[6] > X[7] ? X[6] : X[7]; l_ = X[6] > X[7] ? X[7] : X[6]; X[6] = h_; X[7] = l_; h_ = X[9] > X[8] ? X[9] : X[8]; l_ = X[9] > X[8] ? X[8] : X[9]; X[9] = h_; X[8] = l_; h_ = X[11] > X[10] ? X[11] : X[10]; l_ = X[11] > X[10] ? X[10] : X[11]; X[11] = h_; X[10] = l_; h_ = X[13] > X[12] ? X[13] : X[12]; l_ = X[13] > X[12] ? X[12] : X[13]; X[13] = h_; X[12] = l_; h_ = X[15] > X[14] ? X[15] : X[14]; l_ = X[15] > X[14] ? X[14] : X[15]; X[15] = h_; X[14] = l_; h_ = X[0] > X[8] ? X[0] : X[8]; l_ = X[0] > X[8] ? X[8] : X[0]; X[0] = h_; X[8] = l_; h_ = X[1] > X[9] ? X[1] : X[9]; l_ = X[1] > X[9] ? X[9] : X[1]; X[1] = h_; X[9] = l_; h_ = X[2] > X[10] ? X[2] : X[10]; l_ = X[2] > X[10] ? X[10] : X[2]; X[2] = h_; X[10] = l_; h_ = X[3] > X[11] ? X[3] : X[11]; l_ = X[3] > X[11] ? X[11] : X[3]; X[3] = h_; X[11] = l_; h_ = X[4] > X[12] ? X[4] : X[12]; l_ = X[4] > X[12] ? X[12] : X[4]; X[4] = h_; X[12] = l_; h_ = X[5] > X[13] ? X[5] : X[13]; l_ = X[5] > X[13] ? X[13] : X[5]; X[5] = h_; X[13] = l_; h_ = X[6] > X[14] ? X[6] : X[14]; l_ = X[6] > X[14] ? X[14] : X[6]; X[6] = h_; X[14] = l_; h_ = X[7] > X[15] ? X[7] : X[15]; l_ = X[7] > X[15] ? X[15] : X[7]; X[7] = h_; X[15] = l_; h_ = X[0] > X[4] ? X[0] : X[4]; l_ = X[0] > X[4] ? X[4] : X[0]; X[0] = h_; X[4] = l_; h_ = X[1] > X[5] ? X[1] : X[5]; l_ = X[1] > X[5] ? X[5] : X[1]; X[1] = h_; X[5] = l_; h_ = X[2] > X[6] ? X[2] : X[6]; l_ = X[2] > X[6] ? X[6] : X[2]; X[2] = h_; X[6] = l_; h_ = X[3] > X[7] ? X[3] : X[7]; l_ = X[3] > X[7] ? X[7] : X[3]; X[3] = h_; X[7] = l_; h_ = X[8] > X[12] ? X[8] : X[12]; l_ = X[8] > X[12] ? X[12] : X[8]; X[8] = h_; X[12] = l_; h_ = X[9] > X[13] ? X[9] : X[13]; l_ = X[9] > X[13] ? X[13] : X[9]; X[9] = h_; X[13] = l_; h_ = X[10] > X[14] ? X[10] : X[14]; l_ = X[10] > X[14] ? X[14] : X[10]; X[10] = h_; X[14] = l_; h_ = X[11] > X[15] ? X[11] : X[15]; l_ = X[11] > X[15] ? X[15] : X[11]; X[11] = h_; X[15] = l_; h_ = X[0] > X[2] ? X[0] : X[2]; l_ = X[0] > X[2] ? X[2] : X[0]; X[0] = h_; X[2] = l_; h_ = X[1] > X[3] ? X[1] : X[3]; l_ = X[1] > X[3] ? X[3] : X[1]; X[1] = h_; X[3] = l_; h_ = X[4] > X[6] ? X[4] : X[6]; l_ = X[4] > X[6] ? X[6] : X[4]; X[4] = h_; X[6] = l_; h_ = X[5] > X[7] ? X[5] : X[7]; l_ = X[5] > X[7] ? X[7] : X[5]; X[5] = h_; X[7] = l_; h_ = X[8] > X[10] ? X[8] : X[10]; l_ = X[8] > X[10] ? X[10] : X[8]; X[8] = h_; X[10] = l_; h_ = X[9] > X[11] ? X[9] : X[11]; l_ = X[9] > X[11] ? X[11] : X[9]; X[9] = h_; X[11] = l_; h_ = X[12] > X[14] ? X[12] : X[14]; l_ = X[12] > X[14] ? X[14] : X[12]; X[12] = h_; X[14] = l_; h_ = X[13] > X[15] ? X[13] : X[15]; l_ = X[13] > X[15] ? X[15] : X[13]; X[13] = h_; X[15] = l_; h_ = X[0] > X[1] ? X[0] : X[1]; l_ = X[0] > X[1] ? X[1] : X[0]; X[0] = h_; X[1] = l_; h_ = X[2] > X[3] ? X[2] : X[3]; l_ = X[2] > X[3] ? X[3] : X[2]; X[2] = h_; X[3] = l_; h_ = X[4] > X[5] ? X[4] : X[5]; l_ = X[4] > X[5] ? X[5] : X[4]; X[4] = h_; X[5] = l_; h_ = X[6] > X[7] ? X[6] : X[7]; l_ = X[6] > X[7] ? X[7] : X[6]; X[6] = h_; X[7] = l_; h_ = X[8] > X[9] ? X[8] : X[9]; l_ = X[8] > X[9] ? X[9] : X[8]; X[8] = h_; X[9] = l_; h_ = X[10] > X[11] ? X[10] : X[11]; l_ = X[10] > X[11] ? X[11] : X[10]; X[10] = h_; X[11] = l_; h_ = X[12] > X[13] ? X[12] : X[13]; l_ = X[12] > X[13] ? X[13] : X[12]; X[12] = h_; X[13] = l_; h_ = X[14] > X[15] ? X[14] : X[15]; l_ = X[14] > X[15] ? X[15] : X[14]; X[14] = h_; X[15] = l_; } while (0)
#define MERGE16(X) do { unsigned h_, l_; h_ = X[0] > X[8] ? X[0] : X[8]; l_ = X[0] > X[8] ? X[8] : X[0]; X[0] = h_; X[8] = l_; h_ = X[1] > X[9] ? X[1] : X[9]; l_ = X[1] > X[9] ? X[9] : X[1]; X[1] = h_; X[9] = l_; h_ = X[2] > X[10] ? X[2] : X[10]; l_ = X[2] > X[10] ? X[10] : X[2]; X[2] = h_; X[10] = l_; h_ = X[3] > X[11] ? X[3] : X[11]; l_ = X[3] > X[11] ? X[11] : X[3]; X[3] = h_; X[11] = l_; h_ = X[4] > X[12] ? X[4] : X[12]; l_ = X[4] > X[12] ? X[12] : X[4]; X[4] = h_; X[12] = l_; h_ = X[5] > X[13] ? X[5] : X[13]; l_ = X[5] > X[13] ? X[13] : X[5]; X[5] = h_; X[13] = l_; h_ = X[6] > X[14] ? X[6] : X[14]; l_ = X[6] > X[14] ? X[14] : X[6]; X[6] = h_; X[14] = l_; h_ = X[7] > X[15] ? X[7] : X[15]; l_ = X[7] > X[15] ? X[15] : X[7]; X[7] = h_; X[15] = l_; h_ = X[0] > X[4] ? X[0] : X[4]; l_ = X[0] > X[4] ? X[4] : X[0]; X[0] = h_; X[4] = l_; h_ = X[1] > X[5] ? X[1] : X[5]; l_ = X[1] > X[5] ? X[5] : X[1]; X[1] = h_; X[5] = l_; h_ = X[2] > X[6] ? X[2] : X[6]; l_ = X[2] > X[6] ? X[6] : X[2]; X[2] = h_; X[6] = l_; h_ = X[3] > X[7] ? X[3] : X[7]; l_ = X[3] > X[7] ? X[7] : X[3]; X[3] = h_; X[7] = l_; h_ = X[8] > X[12] ? X[8] : X[12]; l_ = X[8] > X[12] ? X[12] : X[8]; X[8] = h_; X[12] = l_; h_ = X[9] > X[13] ? X[9] : X[13]; l_ = X[9] > X[13] ? X[13] : X[9]; X[9] = h_; X[13] = l_; h_ = X[10] > X[14] ? X[10] : X[14]; l_ = X[10] > X[14] ? X[14] : X[10]; X[10] = h_; X[14] = l_; h_ = X[11] > X[15] ? X[11] : X[15]; l_ = X[11] > X[15] ? X[15] : X[11]; X[11] = h_; X[15] = l_; h_ = X[0] > X[2] ? X[0] : X[2]; l_ = X[0] > X[2] ? X[2] : X[0]; X[0] = h_; X[2] = l_; h_ = X[1] > X[3] ? X[1] : X[3]; l_ = X[1] > X[3] ? X[3] : X[1]; X[1] = h_; X[3] = l_; h_ = X[4] > X[6] ? X[4] : X[6]; l_ = X[4] > X[6] ? X[6] : X[4]; X[4] = h_; X[6] = l_; h_ = X[5] > X[7] ? X[5] : X[7]; l_ = X[5] > X[7] ? X[7] : X[5]; X[5] = h_; X[7] = l_; h_ = X[8] > X[10] ? X[8] : X[10]; l_ = X[8] > X[10] ? X[10] : X[8]; X[8] = h_; X[10] = l_; h_ = X[9] > X[11] ? X[9] : X[11]; l_ = X[9] > X[11] ? X[11] : X[9]; X[9] = h_; X[11] = l_; h_ = X[12] > X[14] ? X[12] : X[14]; l_ = X[12] > X[14] ? X[14] : X[12]; X[12] = h_; X[14] = l_; h_ = X[13] > X[15] ? X[13] : X[15]; l_ = X[13] > X[15] ? X[15] : X[13]; X[13] = h_; X[15] = l_; h_ = X[0] > X[1] ? X[0] : X[1]; l_ = X[0] > X[1] ? X[1] : X[0]; X[0] = h_; X[1] = l_; h_ = X[2] > X[3] ? X[2] : X[3]; l_ = X[2] > X[3] ? X[3] : X[2]; X[2] = h_; X[3] = l_; h_ = X[4] > X[5] ? X[4] : X[5]; l_ = X[4] > X[5] ? X[5] : X[4]; X[4] = h_; X[5] = l_; h_ = X[6] > X[7] ? X[6] : X[7]; l_ = X[6] > X[7] ? X[7] : X[6]; X[6] = h_; X[7] = l_; h_ = X[8] > X[9] ? X[8] : X[9]; l_ = X[8] > X[9] ? X[9] : X[8]; X[8] = h_; X[9] = l_; h_ = X[10] > X[11] ? X[10] : X[11]; l_ = X[10] > X[11] ? X[11] : X[10]; X[10] = h_; X[11] = l_; h_ = X[12] > X[13] ? X[12] : X[13]; l_ = X[12] > X[13] ? X[13] : X[12]; X[12] = h_; X[13] = l_; h_ = X[14] > X[15] ? X[14] : X[15]; l_ = X[14] > X[15] ? X[15] : X[14]; X[14] = h_; X[15] = l_; } while (0)

__device__ __forceinline__ unsigned f2ord(float f) { const unsigned u = __float_as_uint(f); return (u & 0x80000000u) ? ~u : (u | 0x80000000u); }
__device__ __forceinline__ float ord2f(unsigned o) { return __uint_as_float((o & 0x80000000u) ? (o & 0x7fffffffu) : ~o); }
#define CANDKEY(sum, c) ((f2ord(sum) & ~255u) | (255u - (unsigned)(c)))
__device__ __forceinline__ void xmerge16(unsigned (&X)[16], int mask) {
  unsigned T[16];
#pragma unroll
  for (int i = 0; i < 16; ++i) T[i] = (unsigned)__shfl_xor((int)X[15 - i], mask);
#pragma unroll
  for (int i = 0; i < 16; ++i) X[i] = X[i] > T[i] ? X[i] : T[i];
  MERGE16(X);
}

__device__ __forceinline__ void ph9_topk(const P& p, int bid, int nb, char* smem) {
  const int tid = threadIdx.x & 255, lane = tid & 63, wave = tid >> 6, lr = lane & 15, lq = lane >> 4;
  bf16_t* kl = (bf16_t*)smem;
  int* idxs = (int*)(smem + 65536) + wave * 512;
  const int h = ((bid >> 1) & 3) * 2 + (bid & 1), nper = nb >> 3, wgi = bid >> 3;
  for (int idx = tid; idx < 4096; idx += NTHR) {
    const int row = idx >> 4, c = idx & 15;
    *(u32x4*)(kl + row * 128 + ((c ^ (row & 15)) << 3)) = *(const u32x4*)(p.keys_bf + (size_t)h * 32768 + row * 128 + c * 8);
  }
  __syncthreads();
  const __amdgpu_buffer_rsrc_t r_q = mk_rsrc(p.qb);
  for (int tile = wgi * 4 + wave; tile < 1024; tile += nper * 4) {
    const int tok = tile * 16 + lr;
    unsigned R0[16], R1[16];
#pragma unroll
    for (int pp = 0; pp < 2; ++pp) {
      bf16x8 bq[4];
#pragma unroll
      for (int kk = 0; kk < 4; ++kk) bq[kk] = bload8c(r_q, (lr * 2048 + lq * 8) * 2 + kk * 64, (tile * 16 * 2048 + h * 256 + pp * 128) * 2);
      f32x4 acc[8];
#pragma unroll
      for (int j = 0; j < 8; ++j) acc[j] = (f32x4){0.f, 0.f, 0.f, 0.f};
#pragma unroll
      for (int j = 0; j < 8; ++j)
#pragma unroll
        for (int kk = 0; kk < 4; ++kk) {
          const bf16x8 a = *(const bf16x8*)(kl + (pp * 128 + j * 16 + lr) * 128 + (((kk * 4 + lq) ^ lr) << 3));
          acc[j] = __builtin_amdgcn_mfma_f32_16x16x32_bf16(a, bq[kk], acc[j], 0, 0, 0);
        }
      unsigned X[16], Y[16];
#pragma unroll
      for (int j = 0; j < 4; ++j)
#pragma unroll
        for (int e = 0; e < 4; ++e) {
          X[j * 4 + e] = (f2ord(acc[j][e]) & ~127u) | (127u - (unsigned)(j * 16 + lq * 4 + e));
          Y[j * 4 + e] = (f2ord(acc[4 + j][e]) & ~127u) | (127u - (unsigned)((4 + j) * 16 + lq * 4 + e));
        }
      SORT16(X);
      SORT16(Y);
#pragma unroll
      for (int i = 0; i < 16; ++i) X[i] = X[i] > Y[15 - i] ? X[i] : Y[15 - i];
      MERGE16(X);
      xmerge16(X, 16);
      xmerge16(X, 32);
#pragma unroll
      for (int i = 0; i < 16; ++i) { if (pp == 0) R0[i] = X[i]; else R1[i] = X[i]; }
    }
    if (lq == 0) {
#pragma unroll
      for (int i = 0; i < 16; ++i) { idxs[lr * 32 + i] = 127 - (int)(R0[i] & 127u); idxs[lr * 32 + 16 + i] = 127 - (int)(R1[i] & 127u); }
    }
    asm volatile("s_waitcnt lgkmcnt(0)" ::: "memory");
    float va[16], vb[16];
#pragma unroll
    for (int i = 0; i < 16; ++i) { va[i] = ord2f(R0[i] & ~127u); vb[i] = ord2f(R1[i] & ~127u); }
    unsigned F[16];
  F[0] = lq == 0 ? CANDKEY(va[0] + vb[0], 0) : (lq == 1 ? CANDKEY(va[1] + vb[0], 16) : (lq == 2 ? CANDKEY(va[3] + vb[0], 48) : CANDKEY(va[13] + vb[0], 208)));
  F[1] = lq == 0 ? CANDKEY(va[0] + vb[1], 1) : (lq == 1 ? CANDKEY(va[1] + vb[1], 17) : (lq == 2 ? CANDKEY(va[3] + vb[1], 49) : CANDKEY(va[14] + vb[0], 224)));
  F[2] = lq == 0 ? CANDKEY(va[0] + vb[2], 2) : (lq == 1 ? CANDKEY(va[1] + vb[2], 18) : (lq == 2 ? CANDKEY(va[3] + vb[2], 50) : CANDKEY(va[15] + vb[0], 240)));
  F[3] = lq == 0 ? CANDKEY(va[0] + vb[3], 3) : (lq == 1 ? CANDKEY(va[1] + vb[3], 19) : (lq == 2 ? CANDKEY(va[3] + vb[3], 51) : 0u));
  F[4] = lq == 0 ? CANDKEY(va[0] + vb[4], 4) : (lq == 1 ? CANDKEY(va[1] + vb[4], 20) : (lq == 2 ? CANDKEY(va[4] + vb[0], 64) : 0u));
  F[5] = lq == 0 ? CANDKEY(va[0] + vb[5], 5) : (lq == 1 ? CANDKEY(va[1] + vb[5], 21) : (lq == 2 ? CANDKEY(va[4] + vb[1], 65) : 0u));
  F[6] = lq == 0 ? CANDKEY(va[0] + vb[6], 6) : (lq == 1 ? CANDKEY(va[1] + vb[6], 22) : (lq == 2 ? CANDKEY(va[4] + vb[2], 66) : 0u));
  F[7] = lq == 0 ? CANDKEY(va[0] + vb[7], 7) : (lq == 1 ? CANDKEY(va[1] + vb[7], 23) : (lq == 2 ? CANDKEY(va[6] + vb[0], 96) : 0u));
  F[8] = lq == 0 ? CANDKEY(va[0] + vb[8], 8) : (lq == 1 ? CANDKEY(va[2] + vb[0], 32) : (lq == 2 ? CANDKEY(va[6] + vb[1], 97) : 0u));
  F[9] = lq == 0 ? CANDKEY(va[0] + vb[9], 9) : (lq == 1 ? CANDKEY(va[2] + vb[1], 33) : (lq == 2 ? CANDKEY(va[7] + vb[0], 112) : 0u));
  F[10] = lq == 0 ? CANDKEY(va[0] + vb[10], 10) : (lq == 1 ? CANDKEY(va[2] + vb[2], 34) : (lq == 2 ? CANDKEY(va[7] + vb[1], 113) : 0u));
  F[11] = lq == 0 ? CANDKEY(va[0] + vb[11], 11) : (lq == 1 ? CANDKEY(va[2] + vb[3], 35) : (lq == 2 ? CANDKEY(va[8] + vb[0], 128) : 0u));
  F[12] = lq == 0 ? CANDKEY(va[0] + vb[12], 12) : (lq == 1 ? CANDKEY(va[2] + vb[4], 36) : (lq == 2 ? CANDKEY(va[9] + vb[0], 144) : 0u));
  F[13] = lq == 0 ? CANDKEY(va[0] + vb[13], 13) : (lq == 1 ? CANDKEY(va[5] + vb[0], 80) : (lq == 2 ? CANDKEY(va[10] + vb[0], 160) : 0u));
  F[14] = lq == 0 ? CANDKEY(va[0] + vb[14], 14) : (lq == 1 ? CANDKEY(va[5] + vb[1], 81) : (lq == 2 ? CANDKEY(va[11] + vb[0], 176) : 0u));
  F[15] = lq == 0 ? CANDKEY(va[0] + vb[15], 15) : (lq == 1 ? 0u : (lq == 2 ? CANDKEY(va[12] + vb[0], 192) : 0u));

    SORT16(F);
    xmerge16(F, 16);
    xmerge16(F, 32);
    if (lq == 0) {
      float ev[16];
      const float mx = ord2f(F[0] & ~255u);
      float tot = 0.f;
#pragma unroll
      for (int r = 0; r < 16; ++r) { ev[r] = __expf(ord2f(F[r] & ~255u) - mx); tot += ev[r]; }
      const float inv = 1.f / tot;
      int ei[16];
#pragma unroll
      for (int r = 0; r < 16; ++r) {
        const int c = 255 - (int)(F[r] & 255u);
        ei[r] = idxs[lr * 32 + (c >> 4)] * 128 + idxs[lr * 32 + 16 + (c & 15)];
      }
      unsigned short* ep = p.eidx + (size_t)tok * 128 + h * 16;
      float* gp = p.gate + (size_t)tok * 128 + h * 16;
#pragma unroll
      for (int r = 0; r < 4; ++r) {
        *(f32x4*)(gp + r * 4) = (f32x4){ev[r * 4] * inv, ev[r * 4 + 1] * inv, ev[r * 4 + 2] * inv, ev[r * 4 + 3] * inv};
      }
#pragma unroll
      for (int r = 0; r < 2; ++r)
        *(u32x4*)(ep + r * 8) = (u32x4){(unsigned)ei[r * 8] | ((unsigned)ei[r * 8 + 1] << 16), (unsigned)ei[r * 8 + 2] | ((unsigned)ei[r * 8 + 3] << 16),
                                         (unsigned)ei[r * 8 + 4] | ((unsigned)ei[r * 8 + 5] << 16), (unsigned)ei[r * 8 + 6] | ((unsigned)ei[r * 8 + 7] << 16)};
    }
  }
}

__device__ __forceinline__ void ph_convert_tables(const P& p, int bid, int nb) {
  const int wave = (threadIdx.x >> 6) & 3, lane = threadIdx.x & 63;
  for (int row = bid * 4 + wave; row < 32768; row += nb * 4) {
    const bool isu = row < 16384;
    const float* src = isu ? p.U + (size_t)row * 1024 : p.V + (size_t)(row - 16384) * 1024;
    unsigned char* dst = isu ? p.U8 + (size_t)row * 1024 : p.V8 + (size_t)(row - 16384) * 1024;
    const float sc = isu ? 512.f : 32.f;
#pragma unroll
    for (int j = 0; j < 4; ++j) {
      const f32x4 v = __builtin_nontemporal_load((const f32x4*)src + j * 64 + lane);
      int w = 0;
      w = __builtin_amdgcn_cvt_pk_fp8_f32(v.x * sc, v.y * sc, w, false);
      w = __builtin_amdgcn_cvt_pk_fp8_f32(v.z * sc, v.w * sc, w, true);
      *(int*)(dst + j * 256 + lane * 4) = w;
    }
  }
}

__device__ __forceinline__ float gelu_exact(float a) { return 0.5f * a * (1.f + erff(a * 0.70710678118654752f)); }

#define G_LOAD(buf, j, g_) do { const int g__ = (g_); const int er__ = (g__ & 8) ? e1s[j] : e0s[j]; \
    _Pragma("unroll") for (int k = 0; k < 8; ++k) { const int e__ = __builtin_amdgcn_readlane(er__, (g__ & 7) * 8 + k); \
      buf[k] = *((const u32x4*)(tab + (size_t)e__ * 1024) + lane); } } while (0)
#define G_COMPUTE_U(buf, j, g_) do { const int g__ = (g_); \
      float pp[8]; \
      _Pragma("unroll") for (int k = 0; k < 8; ++k) { \
        f32x2 ac = {0.f, 0.f}; \
        _Pragma("unroll") for (int d = 0; d < 4; ++d) { \
          ac = __builtin_amdgcn_cvt_pk_f32_fp8((int)buf[k][d], false) * x2[j][2 * d] + ac; \
          ac = __builtin_amdgcn_cvt_pk_f32_fp8((int)buf[k][d], true) * x2[j][2 * d + 1] + ac; } \
        pp[k] = ac.x + ac.y; } \
        \
      float q4[4], r2[2], tt; \
      _Pragma("unroll") for (int i = 0; i < 4; ++i) { const float sd = b5 ? pp[i] : pp[i + 4]; q4[i] = (b5 ? pp[i + 4] : pp[i]) + __shfl_xor(sd, 32); } \
      _Pragma("unroll") for (int i = 0; i < 2; ++i) { const float sd = b4 ? q4[i] : q4[i + 2]; r2[i] = (b4 ? q4[i + 2] : q4[i]) + __shfl_xor(sd, 16); } \
      { const float sd = b3 ? r2[0] : r2[1]; tt = (b3 ? r2[1] : r2[0]) + __shfl_xor(sd, 8); } \
      tt += __shfl_xor(tt, 4); tt += __shfl_xor(tt, 2); tt += __shfl_xor(tt, 1); \
      const float dv = __shfl(tt, (lane & 7) * 8); \
      if ((lane >> 3) == (g__ & 7)) { if (g__ & 8) a1[j] = dv; else a0[j] = dv; } } while (0)
#define G_COMPUTE_V(buf, j, g_) do { const int g__ = (g_); \
      const int wr__ = __float_as_int((g__ & 8) ? w1s[j] : w0s[j]); \
      _Pragma("unroll") for (int k = 0; k < 8; ++k) { \
        const float w__ = __int_as_float(__builtin_amdgcn_readlane(wr__, (g__ & 7) * 8 + k)); \
        const f32x2 ww = {w__, w__}; \
        _Pragma("unroll") for (int d = 0; d < 4; ++d) { \
          y2[j][2 * d] = __builtin_amdgcn_cvt_pk_f32_fp8((int)buf[k][d], false) * ww + y2[j][2 * d]; \
          y2[j][2 * d + 1] = __builtin_amdgcn_cvt_pk_f32_fp8((int)buf[k][d], true) * ww + y2[j][2 * d + 1]; } } } while (0)
#define G_SWEEP(COMP) do { \
    G_LOAD(A, 0, 0); G_LOAD(B, 1, 0); G_LOAD(C, 0, 1); \
    _Pragma("unroll 1") for (int g = 0; g < 16; g += 2) { \
      const int gn = g + 2 < 16 ? g + 2 : g;              \
      G_LOAD(D, 1, g + 1); COMP(A, 0, g); \
      G_LOAD(A, 0, gn); COMP(B, 1, g); \
      G_LOAD(B, 1, gn); COMP(C, 0, g + 1); \
      G_LOAD(C, 0, gn + 1); COMP(D, 1, g + 1); } } while (0)

__device__ __forceinline__ void ph10_gather(const P& p, int bid, int nb, char* smem) {
  const int wave = __builtin_amdgcn_readfirstlane((threadIdx.x >> 6) & 3), lane = threadIdx.x & 63;
  const bool b5 = lane & 32, b4 = lane & 16, b3 = lane & 8;
  int* se = (int*)(smem + wave * 1024);
  float* sg = (float*)(se + 128);
  for (int oct = bid * 4 + wave; oct < TL / 8; oct += nb * 4) {
#pragma unroll 1
    for (int grp = 0; grp < 4; ++grp) {
      int diag_bad = 0;
      const int tok0 = oct * 8 + grp * 2;
      int e0s[2], e1s[2];
      float g0s[2], g1s[2], a0[2], a1[2], w0s[2], w1s[2];
      f32x2 x2[2][8], y2[2][8];
#pragma unroll
      for (int j = 0; j < 2; ++j) {
        const int tok = tok0 + j;
        const int e0 = (int)p.eidx[(size_t)tok * 128 + lane], e1 = (int)p.eidx[(size_t)tok * 128 + 64 + lane];
        const float g0 = p.gate[(size_t)tok * 128 + lane], g1 = p.gate[(size_t)tok * 128 + 64 + lane];
        {
          const float gs = wave_sum(g0 + g1);
          const bool bad = (e0 < 0) || (e0 > 16383) || (e1 < 0) || (e1 > 16383) || !(fabsf(gs - 8.f) < 1e-2f);
          if (__ballot(bad) != 0ull) diag_bad = 1;
        }
        const int sl0 = e0 >> 10, sl1 = e1 >> 10;
        int base = 0, pos0 = 0, pos1 = 0;
#pragma unroll
        for (int sidx = 0; sidx < 16; ++sidx) {
          const unsigned long long m0 = __ballot(sl0 == sidx), m1 = __ballot(sl1 == sidx);
          const int c0 = __popcll(m0), c1 = __popcll(m1);
          const int r0 = __builtin_amdgcn_mbcnt_hi((unsigned)(m0 >> 32), __builtin_amdgcn_mbcnt_lo((unsigned)m0, 0u));
          const int r1 = __builtin_amdgcn_mbcnt_hi((unsigned)(m1 >> 32), __builtin_amdgcn_mbcnt_lo((unsigned)m1, 0u));
          if (sl0 == sidx) pos0 = base + r0;
          if (sl1 == sidx) pos1 = base + c0 + r1;
          base += c0 + c1;
        }
        asm volatile("s_waitcnt lgkmcnt(0)" ::: "memory");
        se[pos0] = e0; se[pos1] = e1; sg[pos0] = g0; sg[pos1] = g1;
        asm volatile("s_waitcnt lgkmcnt(0)" ::: "memory");
        e0s[j] = se[lane]; e1s[j] = se[64 + lane]; g0s[j] = sg[lane]; g1s[j] = sg[64 + lane];
        asm volatile("s_waitcnt lgkmcnt(0)" ::: "memory");
        const __amdgpu_buffer_rsrc_t r_h2 = mk_rsrc(p.hn);
        const u32x4 h0 = uload4c(r_h2, (tok * 1024 + lane * 16) * 2, 0);
        const u32x4 h1 = uload4c(r_h2, (tok * 1024 + lane * 16 + 8) * 2, 0);
#pragma unroll
        for (int i = 0; i < 4; ++i) { x2[j][i] = (f32x2){blo(h0[i]), bhi(h0[i])}; x2[j][4 + i] = (f32x2){blo(h1[i]), bhi(h1[i])}; }
        a0[j] = 0.f; a1[j] = 0.f;
      }
      u32x4 A[8], B[8], C[8], D[8];
      { const unsigned char* tab = p.U8; G_SWEEP(G_COMPUTE_U); }
#pragma unroll
      for (int j = 0; j < 2; ++j) { w0s[j] = gelu_exact(a0[j] * (1.f / 512.f)) * g0s[j]; w1s[j] = gelu_exact(a1[j] * (1.f / 512.f)) * g1s[j];
#pragma unroll
        for (int i = 0; i < 8; ++i) y2[j][i] = (f32x2){0.f, 0.f}; }
      { const unsigned char* tab = p.V8; G_SWEEP(G_COMPUTE_V); }
#pragma unroll
      for (int j = 0; j < 2; ++j) {
        const int tok = tok0 + j, b = tok / SEQ;
        float* orow = p.out + (size_t)tok * 1024 + lane * 16;
        const float* g2 = p.mod + b * 6144 + 5 * 1024 + lane * 16;
        float z[16];
        float ss = 0.f;
#pragma unroll
        for (int q = 0; q < 4; ++q) {
          const f32x4 xl = fload4c(mk_rsrc(p.out), (tok * 1024 + lane * 16 + q * 4) * 4, 0);
          const f32x4 gg = *(const f32x4*)(g2 + q * 4);
          const float yv[4] = {y2[j][2 * q].x, y2[j][2 * q].y, y2[j][2 * q + 1].x, y2[j][2 * q + 1].y};
#pragma unroll
          for (int i = 0; i < 4; ++i) { const float zz = xl[i] + gg[i] * (yv[i] * (1.f / 32.f)); z[q * 4 + i] = zz; ss += zz * zz; }
        }
        ss = wave_sum(ss);
        const float rstd = rsqrtf(ss * (1.f / 1024.f) + 1e-6f);
#pragma unroll
        for (int q = 0; q < 4; ++q) {
          const f32x4 fw = *(const f32x4*)(p.final_norm_w + lane * 16 + q * 4);
          f32x4 o;
#pragma unroll
          for (int i = 0; i < 4; ++i) o[i] = diag_bad ? __builtin_inff() : z[q * 4 + i] * rstd * fw[i];
          *(f32x4*)(orow + q * 4) = o;
        }
      }
    }
  }
}

__global__ void __launch_bounds__(2 * NTHR, 2) mega(P p) {
  __shared__ __attribute__((aligned(16))) char smem_all[2 * LDS_HALF];
  cg::grid_group grid = cg::this_grid();
  const int half = __builtin_amdgcn_readfirstlane(threadIdx.x >> 8);
  char* smem = smem_all + half * LDS_HALF;
  const int bid = blockIdx.x * 2 + half, nb = gridDim.x * 2;
  int nsync = 0;
  const int bng = (gridDim.x % 8 == 0) ? 8 : 1, bper = gridDim.x / bng, bgrp = blockIdx.x % bng;
  if (blockIdx.x == 0) { p.bar[threadIdx.x] = 0u; for (int i = threadIdx.x; i < (int)gridDim.x * 32; i += 2 * NTHR) p.flg[i] = 0u; }
#ifndef REPEAT_MASK
#define REPEAT_MASK 0
#endif
#ifndef EXTRA_SYNCS
#define EXTRA_SYNCS 0
#endif
#define GSYNC() do { asm volatile("s_waitcnt vmcnt(0)" ::: "memory"); \
    if (nsync == 0) { grid.sync(); } else { __syncthreads(); \
      if (threadIdx.x < 64) { \
        int rel = 0; \
        if (threadIdx.x == 0) { __builtin_amdgcn_fence(__ATOMIC_RELEASE, "agent"); asm volatile("s_waitcnt vmcnt(0)" ::: "memory"); \
          const unsigned old = __hip_atomic_fetch_add(p.bar + bgrp * 32, 1u, __ATOMIC_RELAXED, __HIP_MEMORY_SCOPE_AGENT); \
          if (old + 1u == (unsigned)(nsync * bper)) { \
            const unsigned o2 = __hip_atomic_fetch_add(p.bar + 256, 1u, __ATOMIC_RELAXED, __HIP_MEMORY_SCOPE_AGENT); \
            if (o2 + 1u == (unsigned)(nsync * bng)) rel = 1; } } \
        rel = __builtin_amdgcn_readfirstlane(rel); \
        if (rel) for (int i = threadIdx.x; i < (int)gridDim.x; i += 64) __hip_atomic_store(p.flg + i * 32, (unsigned)nsync, __ATOMIC_RELAXED, __HIP_MEMORY_SCOPE_AGENT); \
        if (threadIdx.x == 0) { \
          while (__hip_atomic_load(p.flg + blockIdx.x * 32, __ATOMIC_RELAXED, __HIP_MEMORY_SCOPE_AGENT) < (unsigned)nsync) __builtin_amdgcn_s_sleep(2); \
          __builtin_amdgcn_fence(__ATOMIC_ACQUIRE, "agent"); asm volatile("s_waitcnt vmcnt(0)" ::: "memory"); } } \
      __syncthreads(); } \
    ++nsync; } while (0)
#define RUN(k, call) if ((PHMASK & (1 << k)) && p.ph_lo <= k && k < p.ph_hi) { call; if (REPEAT_MASK & (1 << k)) { GSYNC(); call; } \
    if (k + 1 < p.ph_hi) { GSYNC(); for (int xs = 0; xs < EXTRA_SYNCS; ++xs) GSYNC(); } }
  RUN(0, ph0_prep(p, bid, nb, smem))
  RUN(1, ph_norm_rows<0>(p, bid, nb))
  RUN(2, ph_gemm8<0>(p, smem_all))
  RUN(3, ph3_chunk_local(p, bid, nb, smem))
  RUN(4, ph4_scan(p, bid, nb))
  RUN(5, ph5_mlstm_out(p, bid, nb, smem))
  RUN(6, (ph_gemm8<1>(p, smem_all), ph_convert_tables(p, bid, nb)))
  RUN(7, ph_norm_rows<1>(p, bid, nb))
  RUN(8, ph_gemm8<2>(p, smem_all))
  RUN(9, ph9_topk(p, bid, nb, smem))
  RUN(10, ph10_gather(p, bid, nb, smem))
#undef RUN
}

extern "C" void kernel_launch(void* const* d_in, const int* in_sizes, int n_in, void* d_out, int out_size, void* d_ws, size_t ws_size,
                              hipStream_t stream) {
  static int grid_blocks = 0;
  if (!grid_blocks) {
    int dev = 0, cus = 0, per_cu = 0;
    hipGetDevice(&dev);
    hipDeviceGetAttribute(&cus, hipDeviceAttributeMultiprocessorCount, dev);
    hipOccupancyMaxActiveBlocksPerMultiprocessor(&per_cu, (const void*)mega, 2 * NTHR, 0);
    per_cu = 1;
    grid_blocks = cus * per_cu;
    if (ws_size < WS_END + 128ull * 1024 || grid_blocks > 1024) fprintf(stderr, "kernel_launch: workspace too small: %zu < %llu\n", ws_size, (unsigned long long)WS_END);
  }
  P p{};
  const float* const* in = (const float* const*)d_in;
  p.x = in[0]; p.c = in[1]; p.ctx = in[2]; p.c_ctx = in[3]; p.w_mod = in[4]; p.b_mod = in[5]; p.norm1_w = in[6]; p.w_in = in[7];
  p.conv_w = in[8]; p.conv_b = in[9]; p.b_gates = in[10]; p.head_norm_w = in[11]; p.pool_w = in[12]; p.pool_scale = in[13];
  p.w_out = in[14]; p.norm2_w = in[15]; p.wq = in[16]; p.keys = in[17]; p.U = in[18]; p.V = in[19]; p.final_norm_w = in[20];
  p.out = (float*)d_out;
  p.bar = (unsigned*)d_ws; p.flg = (unsigned*)((char*)d_ws + WS_END);
  char* ws = (char*)d_ws;
  p.mod = (float*)(ws + OFF_MOD); p.gates = (float*)(ws + OFF_GATES);
  p.wt_in = (bf16_t*)(ws + OFF_WTIN); p.wt_out = (bf16_t*)(ws + OFF_WTOUT); p.wt_q = (bf16_t*)(ws + OFF_WTQ);
  p.keys_bf = (bf16_t*)(ws + OFF_KEYS); p.hn = (bf16_t*)(ws + OFF_HN); p.pl = (bf16_t*)(ws + OFF_PL);
  p.Dst = (bf16_t*)(ws + OFF_D); p.ND = (float*)(ws + OFF_ND); p.SC = (float*)(ws + OFF_SC);
  p.CIN = (bf16_t*)(ws + OFF_CIN); p.NIN = (float*)(ws + OFF_NIN); p.MIN_ = (float*)(ws + OFF_MIN);
  p.mix = (bf16_t*)(ws + OFF_D); p.qb = (bf16_t*)(ws + OFF_D);
  p.U8 = (unsigned char*)(ws + OFF_U8); p.V8 = (unsigned char*)(ws + OFF_U8 + 16777216ull);
  p.eidx = (unsigned short*)(ws + OFF_EIDX); p.gate = (float*)(ws + OFF_GATE);
#if N_LAUNCHES == 1
  p.ph_lo = 0; p.ph_hi = NPH;
  void* args[] = {&p};
  hipError_t e = hipLaunchCooperativeKernel((const void*)mega, dim3(grid_blocks), dim3(2 * NTHR), args, 0, stream);
  if (e != hipSuccess) fprintf(stderr, "cooperative launch failed: %s (grid %d)\n", hipGetErrorString(e), grid_blocks);
#else
  for (int ph = 0; ph < NPH; ++ph) {
    p.ph_lo = ph; p.ph_hi = ph + 1;
    void* args[] = {&p};
    hipError_t e = hipLaunchCooperativeKernel((const void*)mega, dim3(grid_blocks), dim3(2 * NTHR), args, 0, stream);
    if (e != hipSuccess) fprintf(stderr, "launch %d failed: %s (grid %d)\n", ph, hipGetErrorString(e), grid_blocks);
  }
#endif
}
```

```cpp
#include <hip/hip_runtime.h>
#include <hip/hip_cooperative_groups.h>
#include <stdint.h>
#include <stdio.h>
namespace cg = cooperative_groups;

#ifndef PHMASK
#define PHMASK 0x7ff
#endif
#ifndef N_LAUNCHES
#define N_LAUNCHES 1
#endif

typedef unsigned short bf16_t;
typedef short bf16x8 __attribute__((ext_vector_type(8)));
typedef float f32x4 __attribute__((ext_vector_type(4)));
typedef unsigned u32x4 __attribute__((ext_vector_type(4)));
typedef float f32x2 __attribute__((ext_vector_type(2)));
typedef unsigned u32x2 __attribute__((ext_vector_type(2)));
typedef __bf16 bf16x2 __attribute__((ext_vector_type(2)));

#define NB 8
#define SEQ 2048
#define DM 1024
#define CTXL 256
#define TL 16384
#define TC 2048
#define TR 18432
#define LDP 2624
#define NPADIN 2688
#define NTHR 256
#define LDS_HALF 73728
#define NPH 11

#define OFF_MOD    (4096ull)
#define OFF_GATES  (OFF_MOD + 262144ull)
#define OFF_WTIN   (OFF_GATES + 1179648ull)
#define OFF_WTOUT  (OFF_WTIN + 5767168ull)
#define OFF_WTQ    (OFF_WTOUT + 2097152ull)
#define OFF_KEYS   (OFF_WTQ + 4194304ull)
#define OFF_POOLWT (OFF_KEYS + 524288ull)
#define OFF_HN     (OFF_POOLWT + 131072ull)
#define OFF_PL     (OFF_HN + 37748736ull)
#define OFF_D      (OFF_PL + 96731136ull)
#define OFF_ND     (OFF_D + 37748736ull)
#define OFF_SC     (OFF_ND + 589824ull)
#define OFF_CIN    (OFF_SC + 147456ull)
#define OFF_NIN    (OFF_CIN + 33554432ull)
#define OFF_MIN    (OFF_NIN + 524288ull)
#define OFF_EIDX   (OFF_MIN + 131072ull)
#define OFF_GATE   (OFF_EIDX + 4194304ull)
#define OFF_U8     (OFF_GATE + 8388608ull)
#define WS_END     (OFF_U8 + 33554432ull)

struct P {
  const float *x, *c, *ctx, *c_ctx, *w_mod, *b_mod, *norm1_w, *w_in, *conv_w, *conv_b, *b_gates, *head_norm_w,
      *pool_w, *pool_scale, *w_out, *norm2_w, *wq, *keys, *U, *V, *final_norm_w;
  float* out;
  float* mod;
  float* gates;
  bf16_t* wt_in;
  bf16_t* wt_out;
  bf16_t* wt_q;
  bf16_t* keys_bf;
  bf16_t* hn;
  bf16_t* pl;
  bf16_t* Dst;
  float* ND;
  float* SC;
  bf16_t* CIN;
  float* NIN;
  float* MIN_;
  bf16_t* mix;
  bf16_t* qb;
  unsigned char* U8;
  unsigned char* V8;
  unsigned short* eidx;
  float* gate;
  int ph_lo, ph_hi;
  unsigned* flg;
  unsigned* bar;
};

__device__ __forceinline__ bf16_t f2bf(float f) { return __builtin_bit_cast(bf16_t, (__bf16)f); }
__device__ __forceinline__ float bf2f(bf16_t h) { return __uint_as_float(((unsigned)h) << 16); }
__device__ __forceinline__ float wave_sum(float v) {
#pragma unroll
  for (int o = 32; o > 0; o >>= 1) v += __shfl_xor(v, o);
  return v;
}
__device__ __forceinline__ float silu_f(float v) { return v / (1.f + __expf(-v)); }
__device__ __forceinline__ float logsig_f(float v) { return fminf(v, 0.f) - log1pf(__expf(-fabsf(v))); }

__device__ __forceinline__ __amdgpu_buffer_rsrc_t mk_rsrc(const void* ptr) { return __builtin_amdgcn_make_buffer_rsrc((void*)ptr, 0, 0x7fffffff, 0x00020000); }
__device__ __forceinline__ bf16x8 bload8(__amdgpu_buffer_rsrc_t r, int voff, int soff) { return __builtin_bit_cast(bf16x8, __builtin_amdgcn_raw_buffer_load_b128(r, voff, soff, 0)); }
#define AUX_SC1 16
__device__ __forceinline__ bf16x8 bload8c(__amdgpu_buffer_rsrc_t r, int voff, int soff) { return __builtin_bit_cast(bf16x8, __builtin_amdgcn_raw_buffer_load_b128(r, voff, soff, AUX_SC1)); }
__device__ __forceinline__ u32x2 uload2c(__amdgpu_buffer_rsrc_t r, int voff, int soff) { return __builtin_bit_cast(u32x2, __builtin_amdgcn_raw_buffer_load_b64(r, voff, soff, AUX_SC1)); }
__device__ __forceinline__ float fload1c(__amdgpu_buffer_rsrc_t r, int voff, int soff) { return __builtin_bit_cast(float, __builtin_amdgcn_raw_buffer_load_b32(r, voff, soff, AUX_SC1)); }
__device__ __forceinline__ f32x4 fload4c(__amdgpu_buffer_rsrc_t r, int voff, int soff) { return __builtin_bit_cast(f32x4, __builtin_amdgcn_raw_buffer_load_b128(r, voff, soff, AUX_SC1)); }
__device__ __forceinline__ void ustore4c(__amdgpu_buffer_rsrc_t r, int voff, u32x4 v) { __builtin_amdgcn_raw_buffer_store_b128(v, r, voff, 0, AUX_SC1); }
__device__ __forceinline__ void ustore2c(__amdgpu_buffer_rsrc_t r, int voff, u32x2 v) { __builtin_amdgcn_raw_buffer_store_b64(v, r, voff, 0, AUX_SC1); }
__device__ __forceinline__ u32x4 uload4c(__amdgpu_buffer_rsrc_t r, int voff, int soff) { return __builtin_bit_cast(u32x4, __builtin_amdgcn_raw_buffer_load_b128(r, voff, soff, AUX_SC1)); }

__device__ __forceinline__ void ph0_prep(const P& p, int bid, int nb, char* smem) {
  float* sm = (float*)smem;
  const int tid = threadIdx.x & 255;
  const int N_MOD = 384, N_TIN = 16 * 44, N_TOUT = 256, N_TQ = 16 * 32, N_POOL = 16;
  const int total = N_MOD + N_TIN + N_TOUT + N_TQ + N_POOL;
  const int trips = (total + nb - 1) / nb;
  for (int k = 0; k < trips; ++k) {
    int r = (bid + k * nb) % total;
    if (r < N_MOD) {
      float* part = sm + 9 * 1024;
      for (int i = tid; i < 9 * 1024; i += NTHR) {
        int rr = i >> 10, kq = i & 1023;
        float v = rr < 8 ? p.c[rr * 1024 + kq] : p.c_ctx[kq];
        sm[i] = silu_f(v);
      }
      __syncthreads();
      {
        const int c = tid & 15, kg = tid >> 4, n = r * 16 + c;
        float acc[9];
#pragma unroll
        for (int q = 0; q < 9; ++q) acc[q] = 0.f;
#pragma unroll 8
        for (int i = 0; i < 64; ++i) {
          const int kq = kg + i * 16;
          const float w = p.w_mod[(size_t)kq * 6144 + n];
#pragma unroll
          for (int q = 0; q < 9; ++q) acc[q] += sm[q * 1024 + kq] * w;
        }
#pragma unroll
        for (int q = 0; q < 9; ++q) part[(kg * 9 + q) * 16 + c] = acc[q];
      }
      __syncthreads();
      if (tid < 144) {
        const int q = tid >> 4, c = tid & 15, n = r * 16 + c;
        float t = p.b_mod[n];
#pragma unroll
        for (int kg = 0; kg < 16; ++kg) t += part[(kg * 9 + q) * 16 + c];
        p.mod[q * 6144 + n] = t;
      }
      continue;
    }
    r -= N_MOD;
    const float* src = nullptr; bf16_t* dst = nullptr; int K = 1024, N = 0, ntn = 0;
    if (r < N_TIN) { src = p.w_in; dst = p.wt_in; N = 2576; ntn = 44; }
    else { r -= N_TIN;
      if (r < N_TOUT) { src = p.w_out; dst = p.wt_out; N = 1024; ntn = 16; }
      else { r -= N_TOUT;
        if (r < N_TQ) { src = p.wq; dst = p.wt_q; N = 2048; ntn = 32; }
        else { r -= N_TQ; int g = r >> 2; r &= 3; src = p.pool_w + g * 16384; dst = (bf16_t*)((char*)p.keys_bf + 524288) + g * 16384; K = 128; N = 128; ntn = 2; }
      }
    }
    {
      int kt = r / ntn, nt = r % ntn, k0 = kt * 64, n0 = nt * 64;
      int cc = tid & 63;
      for (int rr = tid >> 6; rr < 64; rr += 4) {
        int n = n0 + cc;
        sm[rr * 65 + cc] = n < N ? src[(size_t)(k0 + rr) * N + n] : 0.f;
      }
      __syncthreads();
      for (int rr = tid >> 6; rr < 64; rr += 4) dst[(size_t)(n0 + rr) * K + k0 + cc] = f2bf(sm[cc * 65 + rr]);
      __syncthreads();
    }
  }
  for (int i = bid * NTHR + tid; i < 262144; i += nb * NTHR) p.keys_bf[i] = f2bf(p.keys[i]);
}

template <int WHICH>
__device__ __forceinline__ void ph_norm_rows(const P& p, int bid, int nb) {
  const int wave = (threadIdx.x >> 6) & 3, lane = threadIdx.x & 63;
  const int nrows = WHICH == 0 ? TR : TL;
  for (int row = bid * 4 + wave; row < nrows; row += nb * 4) {
    const float* src = WHICH == 0 ? (row < TL ? p.x + (size_t)row * 1024 : p.ctx + (size_t)(row - TL) * 1024) : p.out + (size_t)row * 1024;
    const int mr = row < TL ? row / SEQ : 8;
    float4 v[4];
    float ss = 0.f;
#pragma unroll
    for (int j = 0; j < 4; ++j) {
      if (WHICH == 1) { const f32x4 t = fload4c(mk_rsrc(p.out), (row * 1024 + (j * 64 + lane) * 4) * 4, 0); v[j] = make_float4(t[0], t[1], t[2], t[3]); }
      else v[j] = ((const float4*)src)[j * 64 + lane];
      ss += v[j].x * v[j].x + v[j].y * v[j].y + v[j].z * v[j].z + v[j].w * v[j].w;
    }
    ss = wave_sum(ss);
    const float rstd = rsqrtf(ss * (1.f / 1024.f) + 1e-6f);
    const float* nw = WHICH == 0 ? p.norm1_w : p.norm2_w;
    const float* sh = p.mod + mr * 6144 + (WHICH == 0 ? 0 : 3) * 1024;
    const float* sc = sh + 1024;
#pragma unroll
    for (int j = 0; j < 4; ++j) {
      const int col = j * 256 + lane * 4;
      float4 w4 = *(const float4*)(nw + col), s4 = *(const float4*)(sh + col), c4 = *(const float4*)(sc + col);
      float y0 = v[j].x * rstd * w4.x * (1.f + c4.x) + s4.x;
      float y1 = v[j].y * rstd * w4.y * (1.f + c4.y) + s4.y;
      float y2 = v[j].z * rstd * w4.z * (1.f + c4.z) + s4.z;
      float y3 = v[j].w * rstd * w4.w * (1.f + c4.w) + s4.w;
      uint2 o;
      o.x = (unsigned)f2bf(y0) | ((unsigned)f2bf(y1) << 16);
      o.y = (unsigned)f2bf(y2) | ((unsigned)f2bf(y3) << 16);
      ustore2c(mk_rsrc(p.hn), (row * 1024 + col) * 2, (u32x2){o.x, o.y});
    }
  }
}

#define GBK 64
#define GLD 72
template <int EPI>
__device__ __forceinline__ void gemm_tile(const P& p, const bf16_t* A, int lda, const bf16_t* Bt, int m0, int n0, bf16_t* sA, bf16_t* sB) {
  const int tid = threadIdx.x & 255, lane = tid & 63, wave = tid >> 6;
  const int wm = wave >> 1, wn = wave & 1;
  const int lr = lane & 15, lq = lane >> 4;
  f32x4 acc[4][4];
#pragma unroll
  for (int i = 0; i < 4; ++i)
#pragma unroll
    for (int j = 0; j < 4; ++j) acc[i][j] = (f32x4){0.f, 0.f, 0.f, 0.f};
  const int sr = tid >> 3, scol = (tid & 7) * 8;
  u32x4 ra[4], rb[4];
  const bf16_t* Ap = A + (size_t)(m0 + sr) * lda + scol;
  const bf16_t* Bp = Bt + (size_t)(n0 + sr) * 1024 + scol;
#pragma unroll
  for (int i = 0; i < 4; ++i) {
    ra[i] = *(const u32x4*)(Ap + (size_t)(i * 32) * lda);
    rb[i] = *(const u32x4*)(Bp + (size_t)(i * 32) * 1024);
  }
  for (int kt = 0; kt < 1024 / GBK; ++kt) {
    __syncthreads();
#pragma unroll
    for (int i = 0; i < 4; ++i) {
      *(u32x4*)(sA + (sr + i * 32) * GLD + scol) = ra[i];
      *(u32x4*)(sB + (sr + i * 32) * GLD + scol) = rb[i];
    }
    __syncthreads();
    {
      const int k0 = (kt + 1 < 1024 / GBK ? kt + 1 : kt) * GBK;
#pragma unroll
      for (int i = 0; i < 4; ++i) {
        ra[i] = *(const u32x4*)(Ap + (size_t)(i * 32) * lda + k0);
        rb[i] = *(const u32x4*)(Bp + (size_t)(i * 32) * 1024 + k0);
      }
    }
#pragma unroll
    for (int ks = 0; ks < 2; ++ks) {
      bf16x8 af[4], bfr[4];
#pragma unroll
      for (int i = 0; i < 4; ++i) {
        af[i] = *(const bf16x8*)(sA + (wm * 64 + i * 16 + lr) * GLD + ks * 32 + lq * 8);
        bfr[i] = *(const bf16x8*)(sB + (wn * 64 + i * 16 + lr) * GLD + ks * 32 + lq * 8);
      }
#pragma unroll
      for (int i = 0; i < 4; ++i)
#pragma unroll
        for (int j = 0; j < 4; ++j) acc[i][j] = __builtin_amdgcn_mfma_f32_16x16x32_bf16(af[i], bfr[j], acc[i][j], 0, 0, 0);
    }
  }
#pragma unroll
  for (int i = 0; i < 4; ++i)
#pragma unroll
    for (int j = 0; j < 4; ++j)
#pragma unroll
      for (int e = 0; e < 4; ++e) {
        const int row = m0 + wm * 64 + i * 16 + lq * 4 + e;
        const int col = n0 + wn * 64 + j * 16 + lr;
        const float v = acc[i][j][e];
        if (EPI == 0) {
          if (col < 2560) p.pl[(size_t)row * LDP + col] = f2bf(v);
          else if (col < 2576) p.gates[(size_t)row * 16 + (col - 2560)] = v;
        } else if (EPI == 1) {
          const int b = row / SEQ;
          p.out[(size_t)row * 1024 + col] = p.x[(size_t)row * 1024 + col] + p.mod[b * 6144 + 2 * 1024 + col] * v;
        } else {
          p.qb[(size_t)row * 2048 + col] = f2bf(v);
        }
      }
}

template <int EPI>
__device__ __forceinline__ void ph_gemm(const P& p, int bid, int nb, char* smem) {
  bf16_t* sA = (bf16_t*)smem;
  bf16_t* sB = sA + 128 * GLD;
  const int ntn = EPI == 0 ? 21 : (EPI == 1 ? 8 : 16);
  const int ntm = EPI == 0 ? 144 : 128;
  const bf16_t* A = EPI == 0 ? p.hn : (EPI == 1 ? p.mix : p.hn);
  const int lda = 1024;
  const bf16_t* Bt = EPI == 0 ? p.wt_in : (EPI == 1 ? p.wt_out : p.wt_q);
  const int nlat = 128 * ntn;
  const int ntiles = EPI == 0 ? nlat + 16 * 13 : ntm * ntn;
  const int trips = (ntiles + nb - 1) / nb;
  for (int k = 0; k < trips; ++k) {
    const int t = (bid + k * nb) % ntiles;
    int tm, tn;
    if (EPI == 0 && t >= nlat) { const int r = t - nlat; tm = 128 + r / 13; tn = r % 13; if (tn == 12) tn = 20; }
    else { tm = t / ntn; tn = t % ntn; }
    gemm_tile<EPI>(p, A, lda, Bt, tm * 128, tn * 128, sA, sB);
  }
}

struct UnitInfo { int isctx, b, c, h, T, seqrow0, row0; };
__device__ __forceinline__ UnitInfo decode_unit(int u) {
  UnitInfo r;
  if (u < 512) { r.isctx = 0; r.b = u >> 6; r.c = (u >> 2) & 15; r.h = u & 3; r.T = SEQ; r.seqrow0 = r.b * SEQ; }
  else { int uu = u - 512; r.isctx = 1; r.b = uu >> 3; r.c = (uu >> 2) & 1; r.h = uu & 3; r.T = CTXL; r.seqrow0 = TL + r.b * CTXL; }
  r.row0 = r.seqrow0 + r.c * 128;
  return r;
}
__device__ __forceinline__ float qk_act(const P& p, int seqrow0, int T, int t, int col) {
  const bf16_t* base = p.pl + (size_t)(seqrow0 + t) * LDP + col;
  float r0 = t > 0 ? bf2f(base[-LDP]) : 0.f;
  float r1 = bf2f(base[0]);
  float r2 = t + 1 < T ? bf2f(base[LDP]) : 0.f;
  float y = p.conv_b[col] + r0 * p.conv_w[col] + r1 * p.conv_w[1024 + col] + r2 * p.conv_w[2048 + col];
  return silu_f(y);
}


typedef short s16x4 __attribute__((ext_vector_type(4)));
#define LDS_AS __attribute__((address_space(3)))
__device__ __forceinline__ s16x4 ds_tr16(const bf16_t* ptr) { return __builtin_amdgcn_ds_read_tr16_b64_v4i16((LDS_AS s16x4*)ptr); }
__device__ __forceinline__ bf16x8 frag_tr(const bf16_t* M, int ld, int s0, int c0, int lr, int lq) {
  const bf16_t* a = M + (s0 + lq * 8 + (lr >> 2)) * ld + c0 + (lr & 3) * 4;
  const s16x4 t0 = ds_tr16(a), t1 = ds_tr16(a + 4 * ld);
  return __builtin_shufflevector(t0, t1, 0, 1, 2, 3, 4, 5, 6, 7);
}
__device__ __forceinline__ unsigned cvt_pk_bf16(float lo, float hi) { const f32x2 v = {lo, hi}; const bf16x2 b = __builtin_convertvector(v, bf16x2); return __builtin_bit_cast(unsigned, b); }
__device__ __forceinline__ float blo(unsigned u) { return __uint_as_float(u << 16); }
__device__ __forceinline__ float bhi(unsigned u) { return __uint_as_float(u & 0xffff0000u); }
#define VLD 136


namespace pg8 {
#define PG8_LAS __attribute__((address_space(3)))
constexpr int BM = 256, BK = 64, HALF = 128, HTB = HALF * BK * 2, STAGE_BYTES = 8 * HTB, NXCD = 8, WGM = 8;
__host__ __device__ __forceinline__ int lds_byte(int r, int c) { const int st = (r >> 4) * 2 + (c >> 5), rr = r & 15, cc = c & 31, ob = rr * 64 + cc * 2; return st * 1024 + (ob ^ (((ob >> 9) & 1) << 5)); }
__host__ __device__ __forceinline__ void stage_rc(int b, int& R, int& C) { const int st = b / 1024, sb = b % 1024, swz = sb ^ (((sb >> 9) & 1) << 5); R = (st >> 1) * 16 + swz / 64; C = (st & 1) * 32 + (swz % 64) / 2; }
__host__ __device__ __forceinline__ int perm32(int rho) { const int n = rho >> 4, i = rho & 15; return 8 * (i >> 2) + 4 * n + (i & 3); }
struct Unit { int pm, pn; };
struct Gemm { const bf16_t* A; const bf16_t* Bt; int M, N, K; };
struct Order {
  int nM, nN, nwg, G, c, extra;
  __device__ void init(int nM_, int nN_, int G_, int c_, int extra_) { nM = nM_; nN = nN_; nwg = nM * nN; G = G_; c = c_; extra = extra_; }
  __device__ bool next(int i, Unit& u) const {
    const long L = (long)i * G + c;
    if (L >= nwg + extra) return false;
    if (L >= nwg) { const int r = (int)L - nwg; u.pm = nM + r / 7; const int q = r % 7; u.pn = q < 6 ? q : 10; return true; }
    int wgid = (int)L; { const int q = nwg / NXCD, r = nwg % NXCD, xcd = wgid % NXCD, off = wgid / NXCD; wgid = (xcd < r ? xcd * (q + 1) : r * (q + 1) + (xcd - r) * q) + off; }
    const int nig = WGM * nN, gid = wgid / nig, fm = gid * WGM, gsz = (nM - fm) < WGM ? (nM - fm) : WGM;
    u.pm = fm + ((wgid % nig) % gsz); u.pn = (wgid % nig) / gsz; return true;
  }
  __device__ __forceinline__ void a_ready(const Unit&) const {}
  __device__ __forceinline__ void done(const Unit&) const {}
};
template <class Epi, class Sched>
__device__ __forceinline__ void gemm_phase(PG8_LAS unsigned char* lds, const Gemm g, const Sched& S, const Epi& E) {
    const int tid = threadIdx.x, wid = __builtin_amdgcn_readfirstlane(tid >> 6), lane = tid & 63, wr = wid >> 2, wc = wid & 3, fr = lane & 15, fq = lane >> 4;
    const int K = g.K, nt = K / BK;
    unsigned voffA[2], voffB[2];
#pragma unroll
    for (int i = 0; i < 2; ++i) { int R, C; stage_rc(tid * 16 + i * 8192, R, C); const int Rb = Epi::PERM ? ((R & ~31) + perm32(R & 31)) : R;
        voffA[i] = (unsigned)(R * K + C) * 2u; voffB[i] = (unsigned)(Rb * K + C) * 2u; }
    const size_t kstep = (size_t)(BK * 2);
    const size_t hstep = (size_t)HALF * K * 2;
    const size_t tstep = 2 * hstep;
    const unsigned ldsw = (unsigned)wid * 1024u;
    const int aoff = lds_byte(wr * 64 + fr, fq * 8), boff = lds_byte(wc * 32 + fr, fq * 8);
#define PG8_SA(b, h) (((b) * 2 + (h)) * HTB)
#define PG8_SB(b, h) ((4 + (b) * 2 + (h)) * HTB)
#define PG8_STAGE_X(bufoff, gbase, voff, aux) do { _Pragma("unroll") for (int _i = 0; _i < 2; ++_i) \
        __builtin_amdgcn_global_load_lds((const unsigned*)((const char*)(gbase) + (voff)[_i]), (PG8_LAS unsigned*)(lds + (bufoff) + ldsw + _i * 8192), 16, 0, aux); } while (0)
#define PG8_STAGE(bufoff, gbase, voff) PG8_STAGE_X(bufoff, gbase, voff, 0)
#define PG8_STAGE_A(bufoff, gbase, voff) do { if (Epi::A_COHERENT) PG8_STAGE_X(bufoff, gbase, voff, AUX_SC1); else PG8_STAGE_X(bufoff, gbase, voff, 0); } while (0)
#define PG8_LDA(dst, b, h) do { _Pragma("unroll") for (int m = 0; m < 4; ++m) _Pragma("unroll") for (int k = 0; k < 2; ++k) dst[m][k] = *(const PG8_LAS bf16x8*)(lds + PG8_SA(b, h) + aoff + m * 2048 + k * 1024); } while (0)
#define PG8_LDB(dst, b, h) do { _Pragma("unroll") for (int n = 0; n < 2; ++n) _Pragma("unroll") for (int k = 0; k < 2; ++k) dst[n][k] = *(const PG8_LAS bf16x8*)(lds + PG8_SB(b, h) + boff + n * 2048 + k * 1024); } while (0)
#define PG8_MMA(ai, bj, At, Bt) do { __builtin_amdgcn_s_setprio(1); _Pragma("unroll") for (int m = 0; m < 4; ++m) _Pragma("unroll") for (int n = 0; n < 2; ++n) _Pragma("unroll") for (int k = 0; k < 2; ++k) \
        acc[ai][bj][m][n] = __builtin_amdgcn_mfma_f32_16x16x32_bf16(Bt[n][k], At[m][k], acc[ai][bj][m][n], 0, 0, 0); __builtin_amdgcn_s_setprio(0); } while (0)
#define PG8_WAIT_V(n) asm volatile("s_waitcnt vmcnt(" #n ")" ::: "memory")
#define PG8_WAIT_L(n) asm volatile("s_waitcnt lgkmcnt(" #n ")" ::: "memory")
#define PG8_BAR __builtin_amdgcn_s_barrier()
#define PG8_SCHED __builtin_amdgcn_sched_barrier(0)
    Unit cur, nxt; int ui = 0;
    if (!S.next(0, cur)) return;
    f32x4 acc[2][2][4][2];
#pragma unroll
    for (int a = 0; a < 2; ++a)
#pragma unroll
        for (int b = 0; b < 2; ++b)
#pragma unroll
            for (int m = 0; m < 4; ++m)
#pragma unroll
                for (int n = 0; n < 2; ++n) acc[a][b][m][n] = (f32x4){0.f, 0.f, 0.f, 0.f};
    bf16x8 At[4][2], B0[2][2], B1[2][2];
    const char* cA = (const char*)g.A + (size_t)cur.pm * tstep; const char* cB = (const char*)g.Bt + (size_t)cur.pn * tstep;
    S.a_ready(cur);
    PG8_STAGE(PG8_SB(0, 0), cB, voffB); PG8_STAGE_A(PG8_SA(0, 0), cA, voffA); PG8_STAGE(PG8_SB(0, 1), cB + hstep, voffB); PG8_STAGE_A(PG8_SA(0, 1), cA + hstep, voffA);
    if (wr == 1) PG8_BAR;
    PG8_WAIT_V(4); PG8_BAR;
    PG8_STAGE(PG8_SB(1, 0), cB + kstep, voffB); PG8_STAGE_A(PG8_SA(1, 0), cA + kstep, voffA); PG8_STAGE(PG8_SB(1, 1), cB + hstep + kstep, voffB);
    PG8_WAIT_V(6); PG8_BAR;
    for (;;) {
        const bool has_next = S.next(ui + 1, nxt);
        const char* nA = has_next ? (const char*)g.A + (size_t)nxt.pm * tstep : cA; const char* nB = has_next ? (const char*)g.Bt + (size_t)nxt.pn * tstep : cB;
        for (int t = 0; t < nt; t += 2) {
            const bool last = (t == nt - 2);
            const char* a1 = cA + (size_t)(t + 1) * kstep;
            const char* a2 = last ? nA : cA + (size_t)(t + 2) * kstep; const char* b2 = last ? nB : cB + (size_t)(t + 2) * kstep;
            const char* a3 = a2 + kstep; const char* b3 = b2 + kstep;
            if (last && has_next) S.a_ready(nxt);
            PG8_LDB(B0, 0, 0); PG8_SCHED; PG8_LDA(At, 0, 0); PG8_STAGE_A(PG8_SA(1, 1), a1 + hstep, voffA);
            PG8_WAIT_L(8); PG8_BAR; PG8_WAIT_L(0); PG8_MMA(0, 0, At, B0); PG8_BAR; PG8_SCHED;
            PG8_LDB(B1, 0, 1); PG8_STAGE(PG8_SB(0, 0), b2, voffB);
            PG8_BAR; PG8_WAIT_L(0); PG8_MMA(0, 1, At, B1); PG8_BAR;
            PG8_LDA(At, 0, 1); PG8_STAGE_A(PG8_SA(0, 0), a2, voffA);
            PG8_BAR; PG8_WAIT_L(0); PG8_MMA(1, 0, At, B0); PG8_BAR; PG8_SCHED;
            PG8_STAGE(PG8_SB(0, 1), b2 + hstep, voffB);
            PG8_WAIT_V(6); PG8_BAR; PG8_MMA(1, 1, At, B1); PG8_BAR;
            PG8_LDB(B0, 1, 0); PG8_SCHED; PG8_LDA(At, 1, 0); PG8_STAGE_A(PG8_SA(0, 1), a2 + hstep, voffA);
            PG8_WAIT_L(8); PG8_BAR; PG8_WAIT_L(0); PG8_MMA(0, 0, At, B0); PG8_BAR; PG8_SCHED;
            PG8_LDB(B1, 1, 1); PG8_STAGE(PG8_SB(1, 0), b3, voffB);
            PG8_BAR; PG8_WAIT_L(0); PG8_MMA(0, 1, At, B1); PG8_BAR;
            PG8_LDA(At, 1, 1); PG8_STAGE_A(PG8_SA(1, 0), a3, voffA);
            PG8_BAR; PG8_WAIT_L(0); PG8_MMA(1, 0, At, B0); PG8_BAR; PG8_SCHED;
            PG8_STAGE(PG8_SB(1, 1), b3 + hstep, voffB);
            PG8_WAIT_V(6); PG8_BAR; PG8_MMA(1, 1, At, B1); PG8_BAR;
        }
        if constexpr (!Epi::AFTER_DRAIN) { E(acc, cur, wr, wc, fr, fq); S.done(cur); }
        if (!has_next) break;
#pragma unroll
        for (int a = 0; a < 2; ++a)
#pragma unroll
            for (int b = 0; b < 2; ++b)
#pragma unroll
                for (int m = 0; m < 4; ++m)
#pragma unroll
                    for (int n = 0; n < 2; ++n) acc[a][b][m][n] = (f32x4){0.f, 0.f, 0.f, 0.f};
        cur = nxt; cA = nA; cB = nB; ++ui;
    }
    PG8_WAIT_V(0);
    if (wr == 0) PG8_BAR;
    PG8_BAR;
    if constexpr (Epi::AFTER_DRAIN) { E.fused(acc, cur, wr, wc, fr, fq, lds, wid, lane); S.done(cur); }
#undef PG8_SA
#undef PG8_SB
#undef PG8_STAGE
#undef PG8_LDA
#undef PG8_LDB
#undef PG8_MMA
#undef PG8_WAIT_V
#undef PG8_WAIT_L
#undef PG8_BAR
#undef PG8_SCHED
}
}

struct EpiIn {
  static constexpr bool PERM = true, AFTER_DRAIN = false, A_COHERENT = true;
  bf16_t* pl; float* gates;
  __device__ __forceinline__ void operator()(const f32x4 (&acc)[2][2][4][2], const pg8::Unit& u, int wr, int wc, int fr, int fq) const {
    const int row0 = u.pm * 256 + wr * 64 + fr;
#pragma unroll
    for (int ai = 0; ai < 2; ++ai)
#pragma unroll
      for (int m = 0; m < 4; ++m) {
        const int row = row0 + ai * 128 + m * 16;
#pragma unroll
        for (int bj = 0; bj < 2; ++bj) {
          const int c0 = u.pn * 256 + bj * 128 + wc * 32 + 8 * fq;
          const f32x4 v0 = acc[ai][bj][m][0], v1 = acc[ai][bj][m][1];
          if (c0 < 2560) {
            u32x4 w;
            w[0] = cvt_pk_bf16(v0[0], v0[1]); w[1] = cvt_pk_bf16(v0[2], v0[3]); w[2] = cvt_pk_bf16(v1[0], v1[1]); w[3] = cvt_pk_bf16(v1[2], v1[3]);
            *(u32x4*)(pl + (size_t)row * LDP + c0) = w;
          } else if (c0 < 2576) {
            *(f32x4*)(gates + (size_t)row * 16 + (c0 - 2560)) = v0;
            *(f32x4*)(gates + (size_t)row * 16 + (c0 - 2560) + 4) = v1;
          }
        }
      }
  }
};
struct EpiOut {
  static constexpr bool PERM = false, AFTER_DRAIN = false, A_COHERENT = true;
  const float* x; const float* mod; float* out;
  __device__ __forceinline__ void operator()(const f32x4 (&acc)[2][2][4][2], const pg8::Unit& u, int wr, int wc, int fr, int fq) const {
    const int row0 = u.pm * 256 + wr * 64 + fr, col0 = u.pn * 256 + wc * 32 + 4 * fq;
    const float* g1 = mod + (u.pm * 256 / SEQ) * 6144 + 2 * 1024;
#pragma unroll
    for (int ai = 0; ai < 2; ++ai)
#pragma unroll
      for (int m = 0; m < 4; ++m) {
        const size_t ro = (size_t)(row0 + ai * 128 + m * 16) * 1024;
#pragma unroll
        for (int bj = 0; bj < 2; ++bj)
#pragma unroll
          for (int n = 0; n < 2; ++n) {
            const int c = col0 + bj * 128 + n * 16;
            const f32x4 xv = *(const f32x4*)(x + ro + c), gv = *(const f32x4*)(g1 + c);
            *(f32x4*)(out + ro + c) = xv + gv * acc[ai][bj][m][n];
          }
      }
  }
};
struct EpiQ {
  static constexpr bool PERM = true, AFTER_DRAIN = false, A_COHERENT = true;
  bf16_t* q;
  __device__ __forceinline__ void operator()(const f32x4 (&acc)[2][2][4][2], const pg8::Unit& u, int wr, int wc, int fr, int fq) const {
    const int row0 = u.pm * 256 + wr * 64 + fr;
#pragma unroll
    for (int ai = 0; ai < 2; ++ai)
#pragma unroll
      for (int m = 0; m < 4; ++m)
#pragma unroll
        for (int bj = 0; bj < 2; ++bj) {
          const int c0 = u.pn * 256 + bj * 128 + wc * 32 + 8 * fq;
          const f32x4 v0 = acc[ai][bj][m][0], v1 = acc[ai][bj][m][1];
          u32x4 w;
          w[0] = cvt_pk_bf16(v0[0], v0[1]); w[1] = cvt_pk_bf16(v0[2], v0[3]); w[2] = cvt_pk_bf16(v1[0], v1[1]); w[3] = cvt_pk_bf16(v1[2], v1[3]);
          *(u32x4*)(q + (size_t)(row0 + ai * 128 + m * 16) * 2048 + c0) = w;
        }
  }
};
template <int EPI>
__device__ __forceinline__ void ph_gemm8(const P& p, char* lds_all) {
  PG8_LAS unsigned char* lds = (PG8_LAS unsigned char*)lds_all;
  pg8::Order S;
  if (EPI == 0) {
    S.init(64, 11, gridDim.x, blockIdx.x, 56);
    const pg8::Gemm g{p.hn, p.wt_in, TR, 2816, 1024};
    const EpiIn E{p.pl, p.gates};
    pg8::gemm_phase<EpiIn, pg8::Order>(lds, g, S, E);
  } else if (EPI == 1) {
    S.init(64, 4, gridDim.x, blockIdx.x, 0);
    const pg8::Gemm g{p.mix, p.wt_out, TL, 1024, 1024};
    const EpiOut E{p.x, p.mod, p.out};
    pg8::gemm_phase<EpiOut, pg8::Order>(lds, g, S, E);
  } else {
    S.init(64, 8, gridDim.x, blockIdx.x, 0);
    const pg8::Gemm g{p.hn, p.wt_q, TL, 2048, 1024};
    const EpiQ E{p.qb};
    pg8::gemm_phase<EpiQ, pg8::Order>(lds, g, S, E);
  }
}

template <bool REV>
__device__ __forceinline__ void scan128(const float* lf, const float* ig, float* bout, float* gout, float* pmout, float& Gtot, float& btot, int lane, float& g0o, float& g1o) {
  const int t0 = REV ? 127 - 2 * lane : 2 * lane, t1 = REV ? 126 - 2 * lane : 2 * lane + 1;
  const float v0 = lf[t0], v1 = lf[t1];
  float sacc = v0 + v1;
#pragma unroll
  for (int off = 1; off < 64; off <<= 1) { const float t = __shfl_up(sacc, off); if (lane >= off) sacc += t; }
  const float b1 = sacc, b0 = sacc - v1;
  const float g0 = ig[t0] - b0, g1 = ig[t1] - b1;
  float m = fmaxf(g0, g1);
#pragma unroll
  for (int off = 1; off < 64; off <<= 1) { const float t = __shfl_up(m, off); if (lane >= off) m = fmaxf(m, t); }
  float prev = __shfl_up(m, 1);
  if (lane == 0) prev = -3.0e38f;
  if (bout) { bout[t0] = b0; bout[t1] = b1; }
  if (gout) { gout[t0] = g0; gout[t1] = g1; }
  g0o = g0; g1o = g1;
  if (pmout) { pmout[t0] = fmaxf(prev, g0); pmout[t1] = m; }
  Gtot = __shfl(m, 63); btot = __shfl(sacc, 63);
}

__device__ __forceinline__ void ph3_chunk_local(const P& p, int bid, int nb, char* smem) {
  bf16_t* Vs = (bf16_t*)smem;
  bf16_t* Ks = Vs + 128 * VLD;
  float* fa = (float*)(Ks + 128 * VLD);
  float *igf = fa, *lff = fa + 128, *igb = fa + 256, *lfb = fa + 384, *ef = fa + 512, *eb = fa + 640, *scal = fa + 768;
  const int tid = threadIdx.x & 255, lane = tid & 63, wave = tid >> 6, lr = lane & 15, lq = lane >> 4;
  const int trips3 = (576 + nb - 1) / nb;
  for (int k3 = 0; k3 < trips3; ++k3) {
    const int u = (bid + k3 * nb) % 576;
    const UnitInfo ui = decode_unit(u);
    const int h = ui.h;
    if (tid < 128) {
      const float* g = p.gates + (size_t)(ui.row0 + tid) * 16;
      igf[tid] = g[h] + p.b_gates[h];
      lff[tid] = logsig_f(g[4 + h] + p.b_gates[4 + h]);
      igb[tid] = g[8 + h] + p.b_gates[8 + h];
      lfb[tid] = logsig_f(g[12 + h] + p.b_gates[12 + h]);
    }
    {
      const int dch = tid & 15, colq = h * 128 + dch * 8, colk = 512 + colq;
#pragma unroll 1
      for (int which = 0; which < 2; ++which) {
        if (which == 1 && ui.isctx) break;
        const int col = which == 0 ? colk : colq;
        float w0[8], w1[8], w2[8], bb[8];
#pragma unroll
        for (int i = 0; i < 8; ++i) { w0[i] = p.conv_w[col + i]; w1[i] = p.conv_w[1024 + col + i]; w2[i] = p.conv_w[2048 + col + i]; bb[i] = p.conv_b[col + i]; }
        const float scl = which == 0 ? 0.08838834764831845f : 1.f;
#pragma unroll 1
        for (int ib = 0; ib < 8; ib += 4) {
        u32x4 r0a[4], r1a[4], r2a[4];
#pragma unroll
        for (int i2 = 0; i2 < 4; ++i2) {
          const int t = (tid >> 4) + (ib + i2) * 16, tt = ui.c * 128 + t;
          const bf16_t* base = p.pl + (size_t)(ui.row0 + t) * LDP + col;
          const u32x4 z4 = (u32x4){0u, 0u, 0u, 0u};
          r1a[i2] = *(const u32x4*)base;
          r0a[i2] = tt > 0 ? *(const u32x4*)(base - LDP) : z4;
          r2a[i2] = tt + 1 < ui.T ? *(const u32x4*)(base + LDP) : z4;
        }
#pragma unroll
        for (int i2 = 0; i2 < 4; ++i2) {
          const int t = (tid >> 4) + (ib + i2) * 16;
          const u32x4 r0 = r0a[i2], r1 = r1a[i2], r2 = r2a[i2];
          float y[8];
#pragma unroll
          for (int q = 0; q < 4; ++q) {
            y[2 * q] = silu_f(bb[2 * q] + blo(r0[q]) * w0[2 * q] + blo(r1[q]) * w1[2 * q] + blo(r2[q]) * w2[2 * q]) * scl;
            y[2 * q + 1] = silu_f(bb[2 * q + 1] + bhi(r0[q]) * w0[2 * q + 1] + bhi(r1[q]) * w1[2 * q + 1] + bhi(r2[q]) * w2[2 * q + 1]) * scl;
          }
          u32x4 o;
#pragma unroll
          for (int q = 0; q < 4; ++q) o[q] = cvt_pk_bf16(y[2 * q], y[2 * q + 1]);
          if (which == 0) *(u32x4*)(Ks + t * VLD + dch * 8) = o;
          if (!ui.isctx) ustore4c(mk_rsrc(p.hn), ((ui.row0 + t) * 1024 + col) * 2, o);
        }
        }
      }
#pragma unroll
      for (int i = 0; i < 8; ++i) {
        const int t = (tid >> 4) + i * 16;
        *(u32x4*)(Vs + t * VLD + dch * 8) = *(const u32x4*)(p.pl + (size_t)(ui.row0 + t) * LDP + 1024 + h * 128 + dch * 8);
      }
    }
    __syncthreads();
    if (wave == 0) {
      float G, bt, ga, gb2;
      scan128<false>(lff, igf, nullptr, nullptr, nullptr, G, bt, lane, ga, gb2);
      ef[2 * lane] = __expf(ga - G); ef[2 * lane + 1] = __expf(gb2 - G);
      if (lane == 0) { scal[0] = G; scal[1] = bt; }
    } else if (wave == 1) {
      float G, bt, ga, gb2;
      scan128<true>(lfb, igb, nullptr, nullptr, nullptr, G, bt, lane, ga, gb2);
      eb[127 - 2 * lane] = __expf(ga - G); eb[126 - 2 * lane] = __expf(gb2 - G);
      if (lane == 0) { scal[2] = G; scal[3] = bt; }
    }
    __syncthreads();
#pragma unroll 1
    for (int dir = 0; dir < 2; ++dir) {
      const float* ee = dir ? eb : ef;
      f32x4 acc[2][8];
#pragma unroll
      for (int m = 0; m < 2; ++m)
#pragma unroll
        for (int j = 0; j < 8; ++j) acc[m][j] = (f32x4){0.f, 0.f, 0.f, 0.f};
#pragma unroll
      for (int kk = 0; kk < 4; ++kk) {
        const f32x4 e0 = *(const f32x4*)(ee + kk * 32 + lq * 8), e1 = *(const f32x4*)(ee + kk * 32 + lq * 8 + 4);
        bf16x8 af[2];
#pragma unroll
        for (int m = 0; m < 2; ++m) {
          const bf16x8 raw = frag_tr(Vs, VLD, kk * 32, wave * 32 + m * 16, lr, lq);
          const u32x4 ru = __builtin_bit_cast(u32x4, raw);
          u32x4 sc;
          sc[0] = cvt_pk_bf16(blo(ru[0]) * e0[0], bhi(ru[0]) * e0[1]);
          sc[1] = cvt_pk_bf16(blo(ru[1]) * e0[2], bhi(ru[1]) * e0[3]);
          sc[2] = cvt_pk_bf16(blo(ru[2]) * e1[0], bhi(ru[2]) * e1[1]);
          sc[3] = cvt_pk_bf16(blo(ru[3]) * e1[2], bhi(ru[3]) * e1[3]);
          af[m] = __builtin_bit_cast(bf16x8, sc);
        }
#pragma unroll
        for (int j = 0; j < 8; ++j) {
          const bf16x8 bfr = frag_tr(Ks, VLD, kk * 32, j * 16, lr, lq);
#pragma unroll
          for (int m = 0; m < 2; ++m) acc[m][j] = __builtin_amdgcn_mfma_f32_16x16x32_bf16(af[m], bfr, acc[m][j], 0, 0, 0);
        }
      }
      bf16_t* Dd = p.Dst + (size_t)(u * 2 + dir) * 16384;
#pragma unroll
      for (int m = 0; m < 2; ++m)
#pragma unroll
        for (int j = 0; j < 8; ++j)
#pragma unroll
          for (int e = 0; e < 4; ++e) Dd[(wave * 32 + m * 16 + lq * 4 + e) * 128 + j * 16 + lr] = f2bf(acc[m][j][e]);
    }
    {
      const int dir = tid >> 7, k = tid & 127;
      const float* e = dir ? eb : ef;
      float sacc = 0.f;
      for (int t = 0; t < 128; ++t) sacc += e[t] * bf2f(Ks[t * VLD + k]);
      p.ND[(size_t)(u * 2 + dir) * 128 + k] = sacc;
    }
    if (tid < 4) p.SC[(size_t)(u * 2 + (tid >> 1)) * 32 + (tid & 1)] = scal[tid];
    __syncthreads();
  }
}

__device__ __forceinline__ void ph4_scan(const P& p, int bid, int nb) {
  const int tid = threadIdx.x & 255;
  const __amdgpu_buffer_rsrc_t r_d = mk_rsrc(p.Dst), r_sc = mk_rsrc(p.SC), r_nd = mk_rsrc(p.ND);
  for (int it = bid; it < 1024; it += nb) {
    const int combo = it >> 4, vblk = it & 15;
    const int b = combo >> 3, h = (combo >> 1) & 3, dir = combo & 1;
    const int v = vblk * 8 + (tid >> 5), k0 = (tid & 31) * 4;
    const bool nrow = vblk == 0 && tid < 128;
    u32x2 dd[18]; float Gs[18], bs[18], nds[18];
#pragma unroll
    for (int i = 0; i < 18; ++i) {
      int u;
      if (i < 2) { const int cc = dir == 0 ? i : 1 - i; u = 512 + b * 8 + cc * 4 + h; }
      else { const int lc = i - 2, c = dir == 0 ? lc : 15 - lc; u = b * 64 + c * 4 + h; }
      const int di = u * 2 + dir;
      Gs[i] = fload1c(r_sc, di * 128, 0); bs[i] = fload1c(r_sc, di * 128 + 4, 0);
      dd[i] = uload2c(r_d, (di * 16384 + v * 128 + k0) * 2, 0);
      nds[i] = nrow ? fload1c(r_nd, (di * 128 + tid) * 4, 0) : 0.f;
    }
    float C0 = 0.f, C1 = 0.f, C2 = 0.f, C3 = 0.f, nacc = 0.f, m = 0.f;
#pragma unroll
    for (int i = 0; i < 18; ++i) {
      if (i >= 2) {
        const int lc = i - 2, c = dir == 0 ? lc : 15 - lc;
        const int u = b * 64 + c * 4 + h;
        const size_t ci = (size_t)u * 2 + dir;
        uint2 o;
        o.x = (unsigned)f2bf(C0) | ((unsigned)f2bf(C1) << 16);
        o.y = (unsigned)f2bf(C2) | ((unsigned)f2bf(C3) << 16);
        *(uint2*)(p.CIN + ci * 16384 + v * 128 + k0) = o;
        if (nrow) p.NIN[ci * 128 + tid] = nacc;
        if (vblk == 0 && tid == 0) p.MIN_[ci * 32] = m;
      }
      const float G = Gs[i], bend = bs[i];
      const float Mx = fmaxf(m, G);
      const float dec = __expf(m - Mx), inj = __expf(G - Mx);
      const u32x2 d2 = dd[i];
      C0 = dec * C0 + inj * __uint_as_float(d2.x << 16);
      C1 = dec * C1 + inj * __uint_as_float(d2.x & 0xffff0000u);
      C2 = dec * C2 + inj * __uint_as_float(d2.y << 16);
      C3 = dec * C3 + inj * __uint_as_float(d2.y & 0xffff0000u);
      nacc = dec * nacc + inj * nds[i];
      m = bend + Mx;
    }
  }
}

__device__ __forceinline__ void ph5_mlstm_out(const P& p, int bid, int nb, char* smem) {
  bf16_t* Vs = (bf16_t*)smem;
  bf16_t* Pw = Vs + 128 * VLD;
  float* fa = (float*)(Pw + 4 * 16 * VLD);
  float *igf = fa, *lff = fa + 128, *igb = fa + 256, *lfb = fa + 384, *gf = fa + 512, *gb = fa + 640, *bfw = fa + 768, *bbw = fa + 896,
        *pmf = fa + 1024, *pmb = fa + 1152, *nq = fa + 1280  ;
  const int tid = threadIdx.x & 255, lane = tid & 63, wave = tid >> 6, lr = lane & 15, lq = lane >> 4;
  const int trips5 = (1536 + nb - 1) / nb;
  for (int k5 = 0; k5 < trips5; ++k5) {
    const int it = (bid + k5 * nb) % 1536;
    if (it < 512) {
      const int u = it;
      const UnitInfo ui = decode_unit(u);
      const int h = ui.h;
      const size_t cif = (size_t)u * 2, cib = (size_t)u * 2 + 1;
      if (tid < 128) {
        const float* g = p.gates + (size_t)(ui.row0 + tid) * 16;
        igf[tid] = g[h] + p.b_gates[h];
        lff[tid] = logsig_f(g[4 + h] + p.b_gates[4 + h]);
        igb[tid] = g[8 + h] + p.b_gates[8 + h];
        lfb[tid] = logsig_f(g[12 + h] + p.b_gates[12 + h]);
      }
      {
        const int dch = tid & 15;
#pragma unroll
        for (int i = 0; i < 8; ++i) {
          const int t = (tid >> 4) + i * 16;
          *(u32x4*)(Vs + t * VLD + dch * 8) = *(const u32x4*)(p.pl + (size_t)(ui.row0 + t) * LDP + 1024 + h * 128 + dch * 8);
        }
      }
      {
        const int dir = tid >> 7, t = tid & 127;
        const __amdgpu_buffer_rsrc_t r_hq = mk_rsrc(p.hn);
        const int qoff = ((ui.row0 + t) * 1024 + h * 128) * 2;
        const float* nin = p.NIN + (dir ? cib : cif) * 128;
        float sacc = 0.f;
#pragma unroll 4
        for (int c8 = 0; c8 < 16; ++c8) {
          const u32x4 qv = uload4c(r_hq, qoff + c8 * 16, 0);
#pragma unroll
          for (int q = 0; q < 4; ++q) sacc += blo(qv[q]) * nin[c8 * 8 + 2 * q] + bhi(qv[q]) * nin[c8 * 8 + 2 * q + 1];
        }
        nq[dir * 128 + t] = sacc;
      }
      __syncthreads();
      if (wave == 0) { float G, bt, ga, gb2; scan128<false>(lff, igf, bfw, gf, pmf, G, bt, lane, ga, gb2); }
      else if (wave == 1) { float G, bt, ga, gb2; scan128<true>(lfb, igb, bbw, gb, pmb, G, bt, lane, ga, gb2); }
      __syncthreads();
      const float minf_ = p.MIN_[cif * 32], minb_ = p.MIN_[cib * 32];
      bf16_t* Pme = Pw + wave * 16 * VLD;
      const __amdgpu_buffer_rsrc_t r_hn = mk_rsrc(p.hn), r_cin = mk_rsrc(p.CIN);
      const int fvoff = (lr * 1024 + lq * 8) * 2, cvoff = (lr * 128 + lq * 8) * 2;
#pragma unroll 1
      for (int m = 0; m < 2; ++m) {
        const int t0 = wave * 32 + m * 16;
        bf16x8 Qf[4];
#pragma unroll
        for (int kk = 0; kk < 4; ++kk) Qf[kk] = bload8c(r_hn, fvoff + kk * 64, ((ui.row0 + t0) * 1024 + h * 128) * 2);
        f32x4 S[8];
#pragma unroll
        for (int j = 0; j < 8; ++j) {
          S[j] = (f32x4){0.f, 0.f, 0.f, 0.f};
#pragma unroll
          for (int kk = 0; kk < 4; ++kk) {
            const bf16x8 kf = bload8c(r_hn, fvoff + kk * 64, ((ui.row0 + j * 16) * 1024 + 512 + h * 128) * 2);
            S[j] = __builtin_amdgcn_mfma_f32_16x16x32_bf16(Qf[kk], kf, S[j], 0, 0, 0);
          }
          if (j & 1) __builtin_amdgcn_sched_barrier(0);
        }
        f32x4 hsum[8];
#pragma unroll 1
        for (int dir = 0; dir < 2; ++dir) {
          const float mi = dir ? minb_ : minf_;
          const float* gg = dir ? gb : gf;
          const float* pmx = dir ? pmb : pmf;
          const float* bw = dir ? bbw : bfw;
          float Mrow[4], wi[4];
#pragma unroll
          for (int e = 0; e < 4; ++e) { Mrow[e] = fmaxf(mi, pmx[t0 + lq * 4 + e]); wi[e] = __expf(mi - Mrow[e]); }
          f32x4 acc[8];
#pragma unroll
          for (int jv = 0; jv < 8; ++jv) {
            acc[jv] = (f32x4){0.f, 0.f, 0.f, 0.f};
#pragma unroll
            for (int kk = 0; kk < 4; ++kk) {
              const bf16x8 cf = bload8c(r_cin, cvoff + kk * 64, (int)((dir ? cib : cif) * 32768) + jv * 4096);
              acc[jv] = __builtin_amdgcn_mfma_f32_16x16x32_bf16(Qf[kk], cf, acc[jv], 0, 0, 0);
            }
#pragma unroll
            for (int e = 0; e < 4; ++e) acc[jv][e] *= wi[e];
            if (jv & 1) __builtin_amdgcn_sched_barrier(0);
          }
          float rs[4] = {0.f, 0.f, 0.f, 0.f};
#pragma unroll
          for (int j = 0; j < 8; ++j) {
            const int sidx = j * 16 + lr;
            const float gs = gg[sidx];
#pragma unroll
            for (int e = 0; e < 4; ++e) {
              const int t = t0 + lq * 4 + e;
              const bool keep = dir ? (sidx >= t) : (sidx <= t);
              const float pv = keep ? S[j][e] * __expf(gs - Mrow[e]) : 0.f;
              rs[e] += pv;
              Pme[(lq * 4 + e) * VLD + sidx] = f2bf(pv);
            }
          }
          float den[4];
#pragma unroll
          for (int e = 0; e < 4; ++e) {
            float r = rs[e];
            r += __shfl_xor(r, 1); r += __shfl_xor(r, 2); r += __shfl_xor(r, 4); r += __shfl_xor(r, 8);
            const int t = t0 + lq * 4 + e;
            const float dd = r + wi[e] * nq[dir * 128 + t];
            den[e] = fmaxf(fabsf(dd), __expf(-(bw[t] + Mrow[e])));
          }
          asm volatile("s_waitcnt lgkmcnt(0)" ::: "memory");
          __builtin_amdgcn_wave_barrier();
#pragma unroll
          for (int kk = 0; kk < 4; ++kk) {
            const bf16x8 pf = *(const bf16x8*)(Pme + lr * VLD + kk * 32 + lq * 8);
#pragma unroll
            for (int jv = 0; jv < 8; ++jv) {
              const bf16x8 vf = frag_tr(Vs, VLD, kk * 32, jv * 16, lr, lq);
              acc[jv] = __builtin_amdgcn_mfma_f32_16x16x32_bf16(pf, vf, acc[jv], 0, 0, 0);
            }
          }
          __builtin_amdgcn_wave_barrier();
#pragma unroll
          for (int jv = 0; jv < 8; ++jv)
#pragma unroll
            for (int e = 0; e < 4; ++e) {
              const float hv = acc[jv][e] / den[e];
              if (dir == 0) hsum[jv][e] = hv; else hsum[jv][e] += hv;
            }
        }
#pragma unroll
        for (int e = 0; e < 4; ++e) {
          float sm = 0.f;
#pragma unroll
          for (int jv = 0; jv < 8; ++jv) sm += hsum[jv][e];
          sm += __shfl_xor(sm, 1); sm += __shfl_xor(sm, 2); sm += __shfl_xor(sm, 4); sm += __shfl_xor(sm, 8);
          const float mu = sm * (1.f / 128.f);
          float vs = 0.f;
#pragma unroll
          for (int jv = 0; jv < 8; ++jv) { const float d = hsum[jv][e] - mu; vs += d * d; }
          vs += __shfl_xor(vs, 1); vs += __shfl_xor(vs, 2); vs += __shfl_xor(vs, 4); vs += __shfl_xor(vs, 8);
          const float rstd = rsqrtf(vs * (1.f / 128.f) + 1e-6f);
          const bf16_t* op = p.pl + (size_t)(ui.row0 + t0 + lq * 4 + e) * LDP + 1536 + h * 128;
          bf16_t* mp = p.mix + (size_t)(ui.row0 + t0 + lq * 4 + e) * 1024 + h * 128;
#pragma unroll
          for (int jv = 0; jv < 8; ++jv) {
            const int v = jv * 16 + lr;
            const float o = bf2f(op[v]);
            mp[v] = f2bf((hsum[jv][e] - mu) * rstd * p.head_norm_w[h * 128 + v] / (1.f + __expf(-o)));
          }
        }
      }
      __syncthreads();
    } else {
      const int pu = it - 512, grp = pu >> 2, g = pu & 3;
      float* us = (float*)smem;
      bf16_t* db = (bf16_t*)(us + 8192);
      const int w = 2 << g;
      const size_t rbase = (size_t)grp * 64;
      for (int idx = tid; idx < 1024; idx += NTHR) {
        const int t = idx >> 4, ch = idx & 15;
        const u32x4 r = *(const u32x4*)(p.pl + (rbase + t) * LDP + 2048 + g * 128 + ch * 8);
        float* d = us + t * 128 + ch * 8;
#pragma unroll
        for (int q = 0; q < 4; ++q) { d[2 * q] = blo(r[q]); d[2 * q + 1] = bhi(r[q]); }
      }
      __syncthreads();
      for (int idx = tid; idx < 8192; idx += NTHR) {
        const int t = idx >> 7, i = idx & 127;
        int lo = t - w / 2, hi = t - w / 2 + w;
        lo = lo < 0 ? 0 : lo; hi = hi > 64 ? 64 : hi;
        float sacc = 0.f;
        for (int j = lo; j < hi; ++j) sacc += us[j * 128 + i];
        db[t * VLD + i] = f2bf(sacc / (float)(hi - lo) - us[idx]);
      }
      __syncthreads();
      {
        const bf16_t* wt = (const bf16_t*)((const char*)p.keys_bf + 524288) + g * 16384;
        bf16x8 af[4];
#pragma unroll
        for (int kk = 0; kk < 4; ++kk) af[kk] = *(const bf16x8*)(db + (wave * 16 + lr) * VLD + kk * 32 + lq * 8);
#pragma unroll
        for (int j = 0; j < 8; ++j) {
          f32x4 acc = (f32x4){0.f, 0.f, 0.f, 0.f};
#pragma unroll
          for (int kk = 0; kk < 4; ++kk) {
            const bf16x8 bfr = *(const bf16x8*)(wt + (j * 16 + lr) * 128 + kk * 32 + lq * 8);
            acc = __builtin_amdgcn_mfma_f32_16x16x32_bf16(af[kk], bfr, acc, 0, 0, 0);
          }
          const float ps = p.pool_scale[g * 128 + j * 16 + lr];
#pragma unroll
          for (int e = 0; e < 4; ++e) p.mix[(rbase + wave * 16 + lq * 4 + e) * 1024 + 512 + g * 128 + j * 16 + lr] = f2bf(acc[e] * ps);
        }
      }
      __syncthreads();
    }
  }
}

#define SORT16(X) do { unsigned h_, l_; h_ = X[0] > X[1] ? X[0] : X[1]; l_ = X[0] > X[1] ? X[1] : X[0]; X[0] = h_; X[1] = l_; h_ = X[3] > X[2] ? X[3] : X[2]; l_ = X[3] > X[2] ? X[2] : X[3]; X[3] = h_; X[2] = l_; h_ = X[4] > X[5] ? X[4] : X[5]; l_ = X[4] > X[5] ? X[5] : X[4]; X[4] = h_; X[5] = l_; h_ = X[7] > X[6] ? X[7] : X[6]; l_ = X[7] > X[6] ? X[6] : X[7]; X[7] = h_; X[6] = l_; h_ = X[8] > X[9] ? X[8] : X[9]; l_ = X[8] > X[9] ? X[9] : X[8]; X[8] = h_; X[9] = l_; h_ = X[11] > X[10] ? X[11] : X[10]; l_ = X[11] > X[10] ? X[10] : X[11]; X[11] = h_; X[10] = l_; h_ = X[12] > X[13] ? X[12] : X[13]; l_ = X[12] > X[13] ? X[13] : X[12]; X[12] = h_; X[13] = l_; h_ = X[15] > X[14] ? X[15] : X[14]; l_ = X[15] > X[14] ? X[14] : X[15]; X[15] = h_; X[14] = l_; h_ = X[0] > X[2] ? X[0] : X[2]; l_ = X[0] > X[2] ? X[2] : X[0]; X[0] = h_; X[2] = l_; h_ = X[1] > X[3] ? X[1] : X[3]; l_ = X[1] > X[3] ? X[3] : X[1]; X[1] = h_; X[3] = l_; h_ = X[6] > X[4] ? X[6] : X[4]; l_ = X[6] > X[4] ? X[4] : X[6]; X[6] = h_; X[4] = l_; h_ = X[7] > X[5] ? X[7] : X[5]; l_ = X[7] > X[5] ? X[5] : X[7]; X[7] = h_; X[5] = l_; h_ = X[8] > X[10] ? X[8] : X[10]; l_ = X[8] > X[10] ? X[10] : X[8]; X[8] = h_; X[10] = l_; h_ = X[9] > X[11] ? X[9] : X[11]; l_ = X[9] > X[11] ? X[11] : X[9]; X[9] = h_; X[11] = l_; h_ = X[14] > X[12] ? X[14] : X[12]; l_ = X[14] > X[12] ? X[12] : X[14]; X[14] = h_; X[12] = l_; h_ = X[15] > X[13] ? X[15] : X[13]; l_ = X[15] > X[13] ? X[13] : X[15]; X[15] = h_; X[13] = l_; h_ = X[0] > X[1] ? X[0] : X[1]; l_ = X[0] > X[1] ? X[1] : X[0]; X[0] = h_; X[1] = l_; h_ = X[2] > X[3] ? X[2] : X[3]; l_ = X[2] > X[3] ? X[3] : X[2]; X[2] = h_; X[3] = l_; h_ = X[5] > X[4] ? X[5] : X[4]; l_ = X[5] > X[4] ? X[4] : X[5]; X[5] = h_; X[4] = l_; h_ = X[7] > X[6] ? X[7] : X[6]; l_ = X[7] > X[6] ? X[6] : X[7]; X[7] = h_; X[6] = l_; h_ = X[8] > X[9] ? X[8] : X[9]; l_ = X[8] > X[9] ? X[9] : X[8]; X[8] = h_; X[9] = l_; h_ = X[10] > X[11] ? X[10] : X[11]; l_ = X[10] > X[11] ? X[11] : X[10]; X[10] = h_; X[11] = l_; h_ = X[13] > X[12] ? X[13] : X[12]; l_ = X[13] > X[12] ? X[12] : X[13]; X[13] = h_; X[12] = l_; h_ = X[15] > X[14] ? X[15] : X[14]; l_ = X[15] > X[14] ? X[14] : X[15]; X[15] = h_; X[14] = l_; h_ = X[0] > X[4] ? X[0] : X[4]; l_ = X[0] > X[4] ? X[4] : X[0]; X[0] = h_; X[4] = l_; h_ = X[1] > X[5] ? X[1] : X[5]; l_ = X[1] > X[5] ? X[5] : X[1]; X[1] = h_; X[5] = l_; h_ = X[2] > X[6] ? X[2] : X[6]; l_ = X[2] > X[6] ? X[6] : X[2]; X[2] = h_; X[6] = l_; h_ = X[3] > X[7] ? X[3] : X[7]; l_ = X[3] > X[7] ? X[7] : X[3]; X[3] = h_; X[7] = l_; h_ = X[12] > X[8] ? X[12] : X[8]; l_ = X[12] > X[8] ? X[8] : X[12]; X[12] = h_; X[8] = l_; h_ = X[13] > X[9] ? X[13] : X[9]; l_ = X[13] > X[9] ? X[9] : X[13]; X[13] = h_; X[9] = l_; h_ = X[14] > X[10] ? X[14] : X[10]; l_ = X[14] > X[10] ? X[10] : X[14]; X[14] = h_; X[10] = l_; h_ = X[15] > X[11] ? X[15] : X[11]; l_ = X[15] > X[11] ? X[11] : X[15]; X[15] = h_; X[11] = l_; h_ = X[0] > X[2] ? X[0] : X[2]; l_ = X[0] > X[2] ? X[2] : X[0]; X[0] = h_; X[2] = l_; h_ = X[1] > X[3] ? X[1] : X[3]; l_ = X[1] > X[3] ? X[3] : X[1]; X[1] = h_; X[3] = l_; h_ = X[4] > X[6] ? X[4] : X[6]; l_ = X[4] > X[6] ? X[6] : X[4]; X[4] = h_; X[6] = l_; h_ = X[5] > X[7] ? X[5] : X[7]; l_ = X[5] > X[7] ? X[7] : X[5]; X[5] = h_; X[7] = l_; h_ = X[10] > X[8] ? X[10] : X[8]; l_ = X[10] > X[8] ? X[8] : X[10]; X[10] = h_; X[8] = l_; h_ = X[11] > X[9] ? X[11] : X[9]; l_ = X[11] > X[9] ? X[9] : X[11]; X[11] = h_; X[9] = l_; h_ = X[14] > X[12] ? X[14] : X[12]; l_ = X[14] > X[12] ? X[12] : X[14]; X[14] = h_; X[12] = l_; h_ = X[15] > X[13] ? X[15] : X[13]; l_ = X[15] > X[13] ? X[13] : X[15]; X[15] = h_; X[13] = l_; h_ = X[0] > X[1] ? X[0] : X[1]; l_ = X[0] > X[1] ? X[1] : X[0]; X[0] = h_; X[1] = l_; h_ = X[2] > X[3] ? X[2] : X[3]; l_ = X[2] > X[3] ? X[3] : X[2]; X[2] = h_; X[3] = l_; h_ = X[4] > X[5] ? X[4] : X[5]; l_ = X[4] > X[5] ? X[5] : X[4]; X[4] = h_; X[5] = l_; h_ = X[6] > X[7] ? X[6] : X[7]; l_ = X[6] > X[7] ? X[7] : X[6]; X[6] = h_; X[7] = l_; h_ = X[9] > X[8] ? X[9] : X[8]; l_ = X[9] > X[8] ? X[8] : X[9]; X[9] = h_; X[8] = l_; h_ = X[11] > X[10] ? X[11] : X[10]; l_ = X[11] > X[10] ? X[10] : X[11]; X[11] = h_; X[10] = l_; h_ = X[13] > X[12] ? X[13] : X[12]; l_ = X[13] > X[12] ? X[12] : X[13]; X[13] = h_; X[12] = l_; h_ = X[15] > X[14] ? X[15] : X[14]; l_ = X[15] > X[14] ? X[14] : X[15]; X[15] = h_; X[14] = l_; h_ = X[0] > X[8] ? X[0] : X[8]; l_ = X[0] > X[8] ? X[8] : X[0]; X[0] = h_; X[8] = l_; h_ = X[1] > X[9] ? X[1] : X[9]; l_ = X[1] > X[9] ? X[9] : X[1]; X[1] = h_; X[9] = l_; h_ = X[2] > X[10] ? X[2] : X[10]; l_ = X[2] > X[10] ? X[10] : X[2]; X[2] = h_; X[10] = l_; h_ = X[3] > X[11] ? X[3] : X[11]; l_ = X[3] > X[11] ? X[11] : X[3]; X[3] = h_; X[11] = l_; h_ = X[4] > X[12] ? X[4] : X[12]; l_ = X[4] > X[12] ? X[12] : X[4]; X[4] = h_; X[12] = l_; h_ = X[5] > X[13] ? X[5] : X[13]; l_ = X[5] > X[13] ? X[13] : X[5]; X[5] = h_; X[13] = l_; h_ = X[6] > X[14] ? X[6] : X[14]; l_ = X[6] > X[14] ? X[14] : X[6]; X[6] = h_; X[14] = l_; h_ = X[7] > X[15] ? X[7] : X[15]; l_ = X[7] > X[15] ? X[15] : X[7]; X[7] = h_; X[15] = l_; h_ = X[0] > X[4] ? X[0] : X[4]; l_ = X[0] > X[4] ? X[4] : X[0]; X[0] = h_; X[4] = l_; h_ = X[1] > X[5] ? X[1] : X[5]; l_ = X[1] > X[5] ? X[5] : X[1]; X[1] = h_; X[5] = l_; h_ = X[2] > X[6] ? X[2] : X[6]; l_ = X[2] > X[6] ? X[6] : X[2]; X[2] = h_; X[6] = l_; h_ = X[3] > X[7] ? X[3] : X[7]; l_ = X[3] > X[7] ? X[7] : X[3]; X[3] = h_; X[7] = l_; h_ = X[8] > X[12] ? X[8] : X[12]; l_ = X[8] > X[12] ? X[12] : X[8]; X[8] = h_; X[12] = l_; h_ = X[9] > X[13] ? X[9] : X[13]; l_ = X[9] > X[13] ? X[13] : X[9]; X[9] = h_; X[13] = l_; h_ = X[10] > X[14] ? X[10] : X[14]; l_ = X[10] > X[14] ? X[14] : X[10]; X[10] = h_; X[14] = l_; h_ = X[11] > X[15] ? X[11] : X[15]; l_ = X[11] > X[15] ? X[15] : X[11]; X[11] = h_; X[15] = l_; h_ = X[0] > X[2] ? X[0] : X[2]; l_ = X[0] > X[2] ? X[2] : X[0]; X[0] = h_; X[2] = l_; h_ = X[1] > X[3] ? X[1] : X[3]; l_ = X[1] > X[3] ? X[3] : X[1]; X[1] = h_; X[3] = l_; h_ = X[4] > X[6] ? X[4] : X[6]; l_ = X[4] > X[6] ? X[6] : X[4]; X[4] = h_; X[6] = l_; h_ = X[5] > X[7] ? X[5] : X[7]; l_ = X[5] > X[7] ? X[7] : X[5]; X[5] = h_; X[7] = l_; h_ = X[8] > X[10] ? X[8] : X[10]; l_ = X[8] > X[10] ? X[10] : X[8]; X[8] = h_; X[10] = l_; h_ = X[9] > X[11] ? X[9] : X[11]; l_ = X[9] > X[11] ? X[11] : X[9]; X[9] = h_; X[11] = l_; h_ = X[12] > X[14] ? X[12] : X[14]; l_ = X[12] > X[14] ? X[14] : X[12]; X[12] = h_; X[14] = l_; h_ = X[13] > X[15] ? X[13] : X[15]; l_ = X[13] > X[15] ? X[15] : X[13]; X[13] = h_; X[15] = l_; h_ = X[0] > X[1] ? X[0] : X[1]; l_ = X[0] > X[1] ? X[1] : X[0]; X[0] = h_; X[1] = l_; h_ = X[2] > X[3] ? X[2] : X[3]; l_ = X[2] > X[3] ? X[3] : X[2]; X[2] = h_; X[3] = l_; h_ = X[4] > X[5] ? X[4] : X[5]; l_ = X[4] > X[5] ? X[5] : X[4]; X[4] = h_; X[5] = l_; h_ = X[6] > X[7] ? X[6] : X[7]; l_ = X[6] > X[7] ? X[7] : X[6]; X[6] = h_; X[7] = l_; h_ = X[8] > X[9] ? X[8] : X[9]; l_ = X[8] > X[9] ? X[9] : X[8]; X[8] = h_; X[9] = l_; h_ = X[10] > X[11] ? X[10] : X[11]; l_ = X[10] > X[11] ? X[11] : X[10]; X[10] = h_; X[11] = l_; h_ = X[12] > X[13] ? X[12] : X[13]; l_ = X[12] > X[13] ? X[13] : X[12]; X[12] = h_; X[13] = l_; h_ = X[14] > X[15] ? X[14] : X[15]; l_ = X[14] > X[15] ? X[15] : X[14]; X[14] = h_; X[15] = l_; } while (0)
#define MERGE16(X) do { unsigned h_, l_; h_ = X[0] > X[8] ? X[0] : X[8]; l_ = X[0] > X[8] ? X[8] : X[0]; X[0] = h_; X[8] = l_; h_ = X[1] > X[9] ? X[1] : X[9]; l_ = X[1] > X[9] ? X[9] : X[1]; X[1] = h_; X[9] = l_; h_ = X[2] > X[10] ? X[2] : X[10]; l_ = X[2] > X[10] ? X[10] : X[2]; X[2] = h_; X[10] = l_; h_ = X[3] > X[11] ? X[3] : X[11]; l_ = X[3] > X[11] ? X[11] : X[3]; X[3] = h_; X[11] = l_; h_ = X[4] > X[12] ? X[4] : X[12]; l_ = X[4] > X[12] ? X[12] : X[4]; X[4] = h_; X[12] = l_; h_ = X[5] > X[13] ? X[5] : X[13]; l_ = X[5] > X[13] ? X[13] : X[5]; X[5] = h_; X[13] = l_; h_ = X[6] > X[14] ? X[6] : X[14]; l_ = X[6] > X[14] ? X[14] : X[6]; X[6] = h_; X[14] = l_; h_ = X[7] > X[15] ? X[7] : X[15]; l_ = X[7] > X[15] ? X[15] : X[7]; X[7] = h_; X[15] = l_; h_ = X[0] > X[4] ? X[0] : X[4]; l_ = X[0] > X[4] ? X[4] : X[0]; X[0] = h_; X[4] = l_; h_ = X[1] > X[5] ? X[1] : X[5]; l_ = X[1] > X[5] ? X[5] : X[1]; X[1] = h_; X[5] = l_; h_ = X[2] > X[6] ? X[2] : X[6]; l_ = X[2] > X[6] ? X[6] : X[2]; X[2] = h_; X[6] = l_; h_ = X[3] > X[7] ? X[3] : X[7]; l_ = X[3] > X[7] ? X[7] : X[3]; X[3] = h_; X[7] = l_; h_ = X[8] > X[12] ? X[8] : X[12]; l_ = X[8] > X[12] ? X[12] : X[8]; X[8] = h_; X[12] = l_; h_ = X[9] > X[13] ? X[9] : X[13]; l_ = X[9] > X[13] ? X[13] : X[9]; X[9] = h_; X[13] = l_; h_ = X[10] > X[14] ? X[10] : X[14]; l_ = X[10] > X[14] ? X[14] : X[10]; X[10] = h_; X[14] = l_; h_ = X[11] > X[15] ? X[11] : X[15]; l_ = X[11] > X[15] ? X[15] : X[11]; X[11] = h_; X[15] = l_; h_ = X[0] > X[2] ? X[0] : X[2]; l_ = X[0] > X[2] ? X[2] : X[0]; X[0] = h_; X[2] = l_; h_ = X[1] > X[3] ? X[1] : X[3]; l_ = X[1] > X[3] ? X[3] : X[1]; X[1] = h_; X[3] = l_; h_ = X[4] > X[6] ? X[4] : X[6]; l_ = X[4] > X[6] ? X[6] : X[4]; X[4] = h_; X[6] = l_; h_ = X[5] > X[7] ? X[5] : X[7]; l_ = X[5] > X[7] ? X[7] : X[5]; X[5] = h_; X[7] = l_; h_ = X[8] > X[10] ? X[8] : X[10]; l_ = X[8] > X[10] ? X[10] : X[8]; X[8] = h_; X[10] = l_; h_ = X[9] > X[11] ? X[9] : X[11]; l_ = X[9] > X[11] ? X[11] : X[9]; X[9] = h_; X[11] = l_; h_ = X[12] > X[14] ? X[12] : X[14]; l_ = X[12] > X[14] ? X[14] : X[12]; X[12] = h_; X[14] = l_; h_ = X[13] > X[15] ? X[13] : X[15]; l_ = X[13] > X[15] ? X[15] : X[13]; X[13] = h_; X[15] = l_; h_ = X[0] > X[1] ? X[0] : X[1]; l_ = X[0] > X[1] ? X[1] : X[0]; X[0] = h_; X[1] = l_; h_ = X[2] > X[3] ? X[2] : X[3]; l_ = X[2] > X[3] ? X[3] : X[2]; X[2] = h_; X[3] = l_; h_ = X[4] > X[5] ? X[4] : X[5]; l_ = X[4] > X[5] ? X[5] : X[4]; X[4] = h_; X[5] = l_; h_ = X[6] > X[7] ? X[6] : X[7]; l_ = X[6] > X[7] ? X[7] : X[6]; X[6] = h_; X[7] = l_; h_ = X[8] > X[9] ? X[8] : X[9]; l_ = X[8] > X[9] ? X[9] : X[8]; X[8] = h_; X[9] = l_; h_ = X[10] > X[11] ? X[10] : X[11]; l_ = X[10] > X[11] ? X[11] : X[10]; X[10] = h_; X[11] = l_; h_ = X[12] > X[13] ? X[12] : X[13]; l_ = X[12] > X[13] ? X[13] : X[12]; X[12] = h_; X[13] = l_; h_ = X[14] > X[15] ? X[14] : X[15]; l_ = X[14] > X[15] ? X[15] : X[14]; X[14] = h_; X[15] = l_; } while (0)

__device__ __forceinline__ unsigned f2ord(float f) { const unsigned u = __float_as_uint(f); return (u & 0x80000000u) ? ~u : (u | 0x80000000u); }
__device__ __forceinline__ float ord2f(unsigned o) { return __uint_as_float((o & 0x80000000u) ? (o & 0x7fffffffu) : ~o); }
#define CANDKEY(sum, c) ((f2ord(sum) & ~255u) | (255u - (unsigned)(c)))
__device__ __forceinline__ void xmerge16(unsigned (&X)[16], int mask) {
  unsigned T[16];
#pragma unroll
  for (int i = 0; i < 16; ++i) T[i] = (unsigned)__shfl_xor((int)X[15 - i], mask);
#pragma unroll
  for (int i = 0; i < 16; ++i) X[i] = X[i] > T[i] ? X[i] : T[i];
  MERGE16(X);
}

__device__ __forceinline__ void ph9_topk(const P& p, int bid, int nb, char* smem) {
  const int tid = threadIdx.x & 255, lane = tid & 63, wave = tid >> 6, lr = lane & 15, lq = lane >> 4;
  bf16_t* kl = (bf16_t*)smem;
  int* idxs = (int*)(smem + 65536) + wave * 512;
  const int h = ((bid >> 1) & 3) * 2 + (bid & 1), nper = nb >> 3, wgi = bid >> 3;
  for (int idx = tid; idx < 4096; idx += NTHR) {
    const int row = idx >> 4, c = idx & 15;
    *(u32x4*)(kl + row * 128 + ((c ^ (row & 15)) << 3)) = *(const u32x4*)(p.keys_bf + (size_t)h * 32768 + row * 128 + c * 8);
  }
  __syncthreads();
  const __amdgpu_buffer_rsrc_t r_q = mk_rsrc(p.qb);
  bf16x8 bq[4];
#pragma unroll
  for (int kk = 0; kk < 4; ++kk) bq[kk] = bload8c(r_q, (lr * 2048 + lq * 8) * 2 + kk * 64, ((wgi * 4 + wave) * 16 * 2048 + h * 256) * 2);
  for (int tile = wgi * 4 + wave; tile < 1024; tile += nper * 4) {
    const int tok = tile * 16 + lr;
    unsigned R0[16], R1[16];
#pragma unroll
    for (int pp = 0; pp < 2; ++pp) {
      bf16x8 bn[4];
      {
        const int ntile = pp == 0 ? tile : (tile + nper * 4 < 1024 ? tile + nper * 4 : tile);
#pragma unroll
        for (int kk = 0; kk < 4; ++kk) bn[kk] = bload8c(r_q, (lr * 2048 + lq * 8) * 2 + kk * 64, (ntile * 16 * 2048 + h * 256 + (pp ^ 1) * 128) * 2);
      }
      f32x4 acc[8];
#pragma unroll
      for (int j = 0; j < 8; ++j) acc[j] = (f32x4){0.f, 0.f, 0.f, 0.f};
#pragma unroll
      for (int j = 0; j < 8; ++j)
#pragma unroll
        for (int kk = 0; kk < 4; ++kk) {
          const bf16x8 a = *(const bf16x8*)(kl + (pp * 128 + j * 16 + lr) * 128 + (((kk * 4 + lq) ^ lr) << 3));
          acc[j] = __builtin_amdgcn_mfma_f32_16x16x32_bf16(a, bq[kk], acc[j], 0, 0, 0);
        }
      unsigned X[16], Y[16];
#pragma unroll
      for (int j = 0; j < 4; ++j)
#pragma unroll
        for (int e = 0; e < 4; ++e) {
          X[j * 4 + e] = (f2ord(acc[j][e]) & ~127u) | (127u - (unsigned)(j * 16 + lq * 4 + e));
          Y[j * 4 + e] = (f2ord(acc[4 + j][e]) & ~127u) | (127u - (unsigned)((4 + j) * 16 + lq * 4 + e));
        }
      SORT16(X);
      SORT16(Y);
#pragma unroll
      for (int i = 0; i < 16; ++i) X[i] = X[i] > Y[15 - i] ? X[i] : Y[15 - i];
      MERGE16(X);
      xmerge16(X, 16);
      xmerge16(X, 32);
#pragma unroll
      for (int i = 0; i < 16; ++i) { if (pp == 0) R0[i] = X[i]; else R1[i] = X[i]; }
#pragma unroll
      for (int kk = 0; kk < 4; ++kk) bq[kk] = bn[kk];
    }
    if (lq == 0) {
#pragma unroll
      for (int i = 0; i < 16; ++i) { idxs[lr * 32 + i] = 127 - (int)(R0[i] & 127u); idxs[lr * 32 + 16 + i] = 127 - (int)(R1[i] & 127u); }
    }
    asm volatile("s_waitcnt lgkmcnt(0)" ::: "memory");
    float va[16], vb[16];
#pragma unroll
    for (int i = 0; i < 16; ++i) { va[i] = ord2f(R0[i] & ~127u); vb[i] = ord2f(R1[i] & ~127u); }
    unsigned F[16];
  F[0] = lq == 0 ? CANDKEY(va[0] + vb[0], 0) : (lq == 1 ? CANDKEY(va[1] + vb[0], 16) : (lq == 2 ? CANDKEY(va[3] + vb[0], 48) : CANDKEY(va[13] + vb[0], 208)));
  F[1] = lq == 0 ? CANDKEY(va[0] + vb[1], 1) : (lq == 1 ? CANDKEY(va[1] + vb[1], 17) : (lq == 2 ? CANDKEY(va[3] + vb[1], 49) : CANDKEY(va[14] + vb[0], 224)));
  F[2] = lq == 0 ? CANDKEY(va[0] + vb[2], 2) : (lq == 1 ? CANDKEY(va[1] + vb[2], 18) : (lq == 2 ? CANDKEY(va[3] + vb[2], 50) : CANDKEY(va[15] + vb[0], 240)));
  F[3] = lq == 0 ? CANDKEY(va[0] + vb[3], 3) : (lq == 1 ? CANDKEY(va[1] + vb[3], 19) : (lq == 2 ? CANDKEY(va[3] + vb[3], 51) : 0u));
  F[4] = lq == 0 ? CANDKEY(va[0] + vb[4], 4) : (lq == 1 ? CANDKEY(va[1] + vb[4], 20) : (lq == 2 ? CANDKEY(va[4] + vb[0], 64) : 0u));
  F[5] = lq == 0 ? CANDKEY(va[0] + vb[5], 5) : (lq == 1 ? CANDKEY(va[1] + vb[5], 21) : (lq == 2 ? CANDKEY(va[4] + vb[1], 65) : 0u));
  F[6] = lq == 0 ? CANDKEY(va[0] + vb[6], 6) : (lq == 1 ? CANDKEY(va[1] + vb[6], 22) : (lq == 2 ? CANDKEY(va[4] + vb[2], 66) : 0u));
  F[7] = lq == 0 ? CANDKEY(va[0] + vb[7], 7) : (lq == 1 ? CANDKEY(va[1] + vb[7], 23) : (lq == 2 ? CANDKEY(va[6] + vb[0], 96) : 0u));
  F[8] = lq == 0 ? CANDKEY(va[0] + vb[8], 8) : (lq == 1 ? CANDKEY(va[2] + vb[0], 32) : (lq == 2 ? CANDKEY(va[6] + vb[1], 97) : 0u));
  F[9] = lq == 0 ? CANDKEY(va[0] + vb[9], 9) : (lq == 1 ? CANDKEY(va[2] + vb[1], 33) : (lq == 2 ? CANDKEY(va[7] + vb[0], 112) : 0u));
  F[10] = lq == 0 ? CANDKEY(va[0] + vb[10], 10) : (lq == 1 ? CANDKEY(va[2] + vb[2], 34) : (lq == 2 ? CANDKEY(va[7] + vb[1], 113) : 0u));
  F[11] = lq == 0 ? CANDKEY(va[0] + vb[11], 11) : (lq == 1 ? CANDKEY(va[2] + vb[3], 35) : (lq == 2 ? CANDKEY(va[8] + vb[0], 128) : 0u));
  F[12] = lq == 0 ? CANDKEY(va[0] + vb[12], 12) : (lq == 1 ? CANDKEY(va[2] + vb[4], 36) : (lq == 2 ? CANDKEY(va[9] + vb[0], 144) : 0u));
  F[13] = lq == 0 ? CANDKEY(va[0] + vb[13], 13) : (lq == 1 ? CANDKEY(va[5] + vb[0], 80) : (lq == 2 ? CANDKEY(va[10] + vb[0], 160) : 0u));
  F[14] = lq == 0 ? CANDKEY(va[0] + vb[14], 14) : (lq == 1 ? CANDKEY(va[5] + vb[1], 81) : (lq == 2 ? CANDKEY(va[11] + vb[0], 176) : 0u));
  F[15] = lq == 0 ? CANDKEY(va[0] + vb[15], 15) : (lq == 1 ? 0u : (lq == 2 ? CANDKEY(va[12] + vb[0], 192) : 0u));

    SORT16(F);
    xmerge16(F, 16);
    xmerge16(F, 32);
    if (lq == 0) {
      float ev[16];
      const float mx = ord2f(F[0] & ~255u);
      float tot = 0.f;
#pragma unroll
      for (int r = 0; r < 16; ++r) { ev[r] = __expf(ord2f(F[r] & ~255u) - mx); tot += ev[r]; }
      const float inv = 1.f / tot;
      int ei[16];
#pragma unroll
      for (int r = 0; r < 16; ++r) {
        const int c = 255 - (int)(F[r] & 255u);
        ei[r] = idxs[lr * 32 + (c >> 4)] * 128 + idxs[lr * 32 + 16 + (c & 15)];
      }
      unsigned short* ep = p.eidx + (size_t)tok * 128 + h * 16;
      float* gp = p.gate + (size_t)tok * 128 + h * 16;
#pragma unroll
      for (int r = 0; r < 4; ++r) {
        *(f32x4*)(gp + r * 4) = (f32x4){ev[r * 4] * inv, ev[r * 4 + 1] * inv, ev[r * 4 + 2] * inv, ev[r * 4 + 3] * inv};
      }
#pragma unroll
      for (int r = 0; r < 2; ++r)
        *(u32x4*)(ep + r * 8) = (u32x4){(unsigned)ei[r * 8] | ((unsigned)ei[r * 8 + 1] << 16), (unsigned)ei[r * 8 + 2] | ((unsigned)ei[r * 8 + 3] << 16),
                                         (unsigned)ei[r * 8 + 4] | ((unsigned)ei[r * 8 + 5] << 16), (unsigned)ei[r * 8 + 6] | ((unsigned)ei[r * 8 + 7] << 16)};
    }
  }
}

__device__ __forceinline__ void ph_convert_tables(const P& p, int bid, int nb) {
  const int wave = (threadIdx.x >> 6) & 3, lane = threadIdx.x & 63;
  for (int row = bid * 4 + wave; row < 32768; row += nb * 4) {
    const bool isu = row < 16384;
    const float* src = isu ? p.U + (size_t)row * 1024 : p.V + (size_t)(row - 16384) * 1024;
    unsigned char* dst = isu ? p.U8 + (size_t)row * 1024 : p.V8 + (size_t)(row - 16384) * 1024;
    const float sc = isu ? 512.f : 32.f;
#pragma unroll
    for (int j = 0; j < 4; ++j) {
      const f32x4 v = __builtin_nontemporal_load((const f32x4*)src + j * 64 + lane);
      int w = 0;
      w = __builtin_amdgcn_cvt_pk_fp8_f32(v.x * sc, v.y * sc, w, false);
      w = __builtin_amdgcn_cvt_pk_fp8_f32(v.z * sc, v.w * sc, w, true);
      *(int*)(dst + j * 256 + lane * 4) = w;
    }
  }
}

__device__ __forceinline__ float gelu_exact(float a) { return 0.5f * a * (1.f + erff(a * 0.70710678118654752f)); }

#define G_LOAD(buf, j, g_) do { const int g__ = (g_); const int er__ = (g__ & 8) ? e1s[j] : e0s[j]; \
    _Pragma("unroll") for (int k = 0; k < 8; ++k) { const int e__ = __builtin_amdgcn_readlane(er__, (g__ & 7) * 8 + k); \
      buf[k] = *((const u32x4*)(tab + (size_t)e__ * 1024) + lane); } } while (0)
#define G_COMPUTE_U(buf, j, g_) do { const int g__ = (g_); \
      float pp[8]; \
      _Pragma("unroll") for (int k = 0; k < 8; ++k) { \
        f32x2 ac = {0.f, 0.f}; \
        _Pragma("unroll") for (int d = 0; d < 4; ++d) { \
          ac = __builtin_amdgcn_cvt_pk_f32_fp8((int)buf[k][d], false) * x2[j][2 * d] + ac; \
          ac = __builtin_amdgcn_cvt_pk_f32_fp8((int)buf[k][d], true) * x2[j][2 * d + 1] + ac; } \
        pp[k] = ac.x + ac.y; } \
        \
      float q4[4], r2[2], tt; \
      _Pragma("unroll") for (int i = 0; i < 4; ++i) { const float sd = b5 ? pp[i] : pp[i + 4]; q4[i] = (b5 ? pp[i + 4] : pp[i]) + __shfl_xor(sd, 32); } \
      _Pragma("unroll") for (int i = 0; i < 2; ++i) { const float sd = b4 ? q4[i] : q4[i + 2]; r2[i] = (b4 ? q4[i + 2] : q4[i]) + __shfl_xor(sd, 16); } \
      { const float sd = b3 ? r2[0] : r2[1]; tt = (b3 ? r2[1] : r2[0]) + __shfl_xor(sd, 8); } \
      tt += __shfl_xor(tt, 4); tt += __shfl_xor(tt, 2); tt += __shfl_xor(tt, 1); \
      const float dv = __shfl(tt, (lane & 7) * 8); \
      if ((lane >> 3) == (g__ & 7)) { if (g__ & 8) a1[j] = dv; else a0[j] = dv; } } while (0)
#define G_COMPUTE_V(buf, j, g_) do { const int g__ = (g_); \
      const int wr__ = __float_as_int((g__ & 8) ? w1s[j] : w0s[j]); \
      _Pragma("unroll") for (int k = 0; k < 8; ++k) { \
        const float w__ = __int_as_float(__builtin_amdgcn_readlane(wr__, (g__ & 7) * 8 + k)); \
        const f32x2 ww = {w__, w__}; \
        _Pragma("unroll") for (int d = 0; d < 4; ++d) { \
          y2[j][2 * d] = __builtin_amdgcn_cvt_pk_f32_fp8((int)buf[k][d], false) * ww + y2[j][2 * d]; \
          y2[j][2 * d + 1] = __builtin_amdgcn_cvt_pk_f32_fp8((int)buf[k][d], true) * ww + y2[j][2 * d + 1]; } } } while (0)
#define G_SWEEP(COMP) do { \
    G_LOAD(A, 0, 0); G_LOAD(B, 1, 0); G_LOAD(C, 0, 1); \
    _Pragma("unroll 1") for (int g = 0; g < 16; g += 2) { \
      const int gn = g + 2 < 16 ? g + 2 : g;              \
      G_LOAD(D, 1, g + 1); COMP(A, 0, g); \
      G_LOAD(A, 0, gn); COMP(B, 1, g); \
      G_LOAD(B, 1, gn); COMP(C, 0, g + 1); \
      G_LOAD(C, 0, gn + 1); COMP(D, 1, g + 1); } } while (0)

__device__ __forceinline__ void ph10_gather(const P& p, int bid, int nb, char* smem) {
  const int wave = __builtin_amdgcn_readfirstlane((threadIdx.x >> 6) & 3), lane = threadIdx.x & 63;
  const bool b5 = lane & 32, b4 = lane & 16, b3 = lane & 8;
  int* se = (int*)(smem + wave * 1024);
  float* sg = (float*)(se + 128);
  for (int oct = bid * 4 + wave; oct < TL / 8; oct += nb * 4) {
#pragma unroll 1
    for (int grp = 0; grp < 4; ++grp) {
      int diag_bad = 0;
      const int tok0 = oct * 8 + grp * 2;
      int e0s[2], e1s[2];
      float g0s[2], g1s[2], a0[2], a1[2], w0s[2], w1s[2];
      f32x2 x2[2][8], y2[2][8];
#pragma unroll
      for (int j = 0; j < 2; ++j) {
        const int tok = tok0 + j;
        const int e0 = (int)p.eidx[(size_t)tok * 128 + lane], e1 = (int)p.eidx[(size_t)tok * 128 + 64 + lane];
        const float g0 = p.gate[(size_t)tok * 128 + lane], g1 = p.gate[(size_t)tok * 128 + 64 + lane];
        {
          const float gs = wave_sum(g0 + g1);
          const bool bad = (e0 < 0) || (e0 > 16383) || (e1 < 0) || (e1 > 16383) || !(fabsf(gs - 8.f) < 1e-2f);
          if (__ballot(bad) != 0ull) diag_bad = 1;
        }
        const int sl0 = e0 >> 10, sl1 = e1 >> 10;
        int base = 0, pos0 = 0, pos1 = 0;
#pragma unroll
        for (int sidx = 0; sidx < 16; ++sidx) {
          const unsigned long long m0 = __ballot(sl0 == sidx), m1 = __ballot(sl1 == sidx);
          const int c0 = __popcll(m0), c1 = __popcll(m1);
          const int r0 = __builtin_amdgcn_mbcnt_hi((unsigned)(m0 >> 32), __builtin_amdgcn_mbcnt_lo((unsigned)m0, 0u));
          const int r1 = __builtin_amdgcn_mbcnt_hi((unsigned)(m1 >> 32), __builtin_amdgcn_mbcnt_lo((unsigned)m1, 0u));
          if (sl0 == sidx) pos0 = base + r0;
          if (sl1 == sidx) pos1 = base + c0 + r1;
          base += c0 + c1;
        }
        asm volatile("s_waitcnt lgkmcnt(0)" ::: "memory");
        se[pos0] = e0; se[pos1] = e1; sg[pos0] = g0; sg[pos1] = g1;
        asm volatile("s_waitcnt lgkmcnt(0)" ::: "memory");
        e0s[j] = se[lane]; e1s[j] = se[64 + lane]; g0s[j] = sg[lane]; g1s[j] = sg[64 + lane];
        asm volatile("s_waitcnt lgkmcnt(0)" ::: "memory");
        const __amdgpu_buffer_rsrc_t r_h2 = mk_rsrc(p.hn);
        const u32x4 h0 = uload4c(r_h2, (tok * 1024 + lane * 16) * 2, 0);
        const u32x4 h1 = uload4c(r_h2, (tok * 1024 + lane * 16 + 8) * 2, 0);
#pragma unroll
        for (int i = 0; i < 4; ++i) { x2[j][i] = (f32x2){blo(h0[i]), bhi(h0[i])}; x2[j][4 + i] = (f32x2){blo(h1[i]), bhi(h1[i])}; }
        a0[j] = 0.f; a1[j] = 0.f;
      }
      u32x4 A[8], B[8], C[8], D[8];
      { const unsigned char* tab = p.U8; G_SWEEP(G_COMPUTE_U); }
#pragma unroll
      for (int j = 0; j < 2; ++j) { w0s[j] = gelu_exact(a0[j] * (1.f / 512.f)) * g0s[j]; w1s[j] = gelu_exact(a1[j] * (1.f / 512.f)) * g1s[j];
#pragma unroll
        for (int i = 0; i < 8; ++i) y2[j][i] = (f32x2){0.f, 0.f}; }
      { const unsigned char* tab = p.V8; G_SWEEP(G_COMPUTE_V); }
#pragma unroll
      for (int j = 0; j < 2; ++j) {
        const int tok = tok0 + j, b = tok / SEQ;
        float* orow = p.out + (size_t)tok * 1024 + lane * 16;
        const float* g2 = p.mod + b * 6144 + 5 * 1024 + lane * 16;
        float z[16];
        float ss = 0.f;
#pragma unroll
        for (int q = 0; q < 4; ++q) {
          const f32x4 xl = fload4c(mk_rsrc(p.out), (tok * 1024 + lane * 16 + q * 4) * 4, 0);
          const f32x4 gg = *(const f32x4*)(g2 + q * 4);
          const float yv[4] = {y2[j][2 * q].x, y2[j][2 * q].y, y2[j][2 * q + 1].x, y2[j][2 * q + 1].y};
#pragma unroll
          for (int i = 0; i < 4; ++i) { const float zz = xl[i] + gg[i] * (yv[i] * (1.f / 32.f)); z[q * 4 + i] = zz; ss += zz * zz; }
        }
        ss = wave_sum(ss);
        const float rstd = rsqrtf(ss * (1.f / 1024.f) + 1e-6f);
#pragma unroll
        for (int q = 0; q < 4; ++q) {
          const f32x4 fw = *(const f32x4*)(p.final_norm_w + lane * 16 + q * 4);
          f32x4 o;
#pragma unroll
          for (int i = 0; i < 4; ++i) o[i] = diag_bad ? __builtin_inff() : z[q * 4 + i] * rstd * fw[i];
          *(f32x4*)(orow + q * 4) = o;
        }
      }
    }
  }
}

__global__ void __launch_bounds__(2 * NTHR, 2) mega(P p) {
  __shared__ __attribute__((aligned(16))) char smem_all[2 * LDS_HALF];
  cg::grid_group grid = cg::this_grid();
  const int half = __builtin_amdgcn_readfirstlane(threadIdx.x >> 8);
  char* smem = smem_all + half * LDS_HALF;
  const int bid = blockIdx.x * 2 + half, nb = gridDim.x * 2;
  int nsync = 0;
  const int bng = (gridDim.x % 8 == 0) ? 8 : 1, bper = gridDim.x / bng, bgrp = blockIdx.x % bng;
  if (blockIdx.x == 0) { p.bar[threadIdx.x] = 0u; for (int i = threadIdx.x; i < (int)gridDim.x * 32; i += 2 * NTHR) p.flg[i] = 0u; }
#ifndef REPEAT_MASK
#define REPEAT_MASK 0
#endif
#ifndef EXTRA_SYNCS
#define EXTRA_SYNCS 0
#endif
#define GSYNC() do { asm volatile("s_waitcnt vmcnt(0)" ::: "memory"); \
    if (nsync == 0) { grid.sync(); } else { __syncthreads(); \
      if (threadIdx.x < 64) { \
        int rel = 0; \
        if (threadIdx.x == 0) { __builtin_amdgcn_fence(__ATOMIC_RELEASE, "agent"); asm volatile("s_waitcnt vmcnt(0)" ::: "memory"); \
          const unsigned old = __hip_atomic_fetch_add(p.bar + bgrp * 32, 1u, __ATOMIC_RELAXED, __HIP_MEMORY_SCOPE_AGENT); \
          if (old + 1u == (unsigned)(nsync * bper)) { \
            const unsigned o2 = __hip_atomic_fetch_add(p.bar + 256, 1u, __ATOMIC_RELAXED, __HIP_MEMORY_SCOPE_AGENT); \
            if (o2 + 1u == (unsigned)(nsync * bng)) rel = 1; } } \
        rel = __builtin_amdgcn_readfirstlane(rel); \
        if (rel) for (int i = threadIdx.x; i < (int)gridDim.x; i += 64) __hip_atomic_store(p.flg + i * 32, (unsigned)nsync, __ATOMIC_RELAXED, __HIP_MEMORY_SCOPE_AGENT); \
        if (threadIdx.x == 0) { \
          while (__hip_atomic_load(p.flg + blockIdx.x * 32, __ATOMIC_RELAXED, __HIP_MEMORY_SCOPE_AGENT) < (unsigned)nsync) __builtin_amdgcn_s_sleep(2); \
          __builtin_amdgcn_fence(__ATOMIC_ACQUIRE, "agent"); asm volatile("s_waitcnt vmcnt(0)" ::: "memory"); } } \
      __syncthreads(); } \
    ++nsync; } while (0)
#define RUN(k, call) if ((PHMASK & (1 << k)) && p.ph_lo <= k && k < p.ph_hi) { call; if (REPEAT_MASK & (1 << k)) { GSYNC(); call; } \
    if (k + 1 < p.ph_hi) { GSYNC(); for (int xs = 0; xs < EXTRA_SYNCS; ++xs) GSYNC(); } }
  RUN(0, ph0_prep(p, bid, nb, smem))
  RUN(1, ph_norm_rows<0>(p, bid, nb))
  RUN(2, ph_gemm8<0>(p, smem_all))
  RUN(3, ph3_chunk_local(p, bid, nb, smem))
  RUN(4, ph4_scan(p, bid, nb))
  RUN(5, ph5_mlstm_out(p, bid, nb, smem))
  RUN(6, (ph_gemm8<1>(p, smem_all), ph_convert_tables(p, bid, nb)))
  RUN(7, ph_norm_rows<1>(p, bid, nb))
  RUN(8, ph_gemm8<2>(p, smem_all))
  RUN(9, ph9_topk(p, bid, nb, smem))
  RUN(10, ph10_gather(p, bid, nb, smem))
#undef RUN
}

extern "C" void kernel_launch(void* const* d_in, const int* in_sizes, int n_in, void* d_out, int out_size, void* d_ws, size_t ws_size,
                              hipStream_t stream) {
  static int grid_blocks = 0;
  if (!grid_blocks) {
    int dev = 0, cus = 0, per_cu = 0;
    hipGetDevice(&dev);
    hipDeviceGetAttribute(&cus, hipDeviceAttributeMultiprocessorCount, dev);
    hipOccupancyMaxActiveBlocksPerMultiprocessor(&per_cu, (const void*)mega, 2 * NTHR, 0);
    per_cu = 1;
    grid_blocks = cus * per_cu;
    if (ws_size < WS_END + 128ull * 1024 || grid_blocks > 1024) fprintf(stderr, "kernel_launch: workspace too small: %zu < %llu\n", ws_size, (unsigned long long)WS_END);
  }
  P p{};
  const float* const* in = (const float* const*)d_in;
  p.x = in[0]; p.c = in[1]; p.ctx = in[2]; p.c_ctx = in[3]; p.w_mod = in[4]; p.b_mod = in[5]; p.norm1_w = in[6]; p.w_in = in[7];
  p.conv_w = in[8]; p.conv_b = in[9]; p.b_gates = in[10]; p.head_norm_w = in[11]; p.pool_w = in[12]; p.pool_scale = in[13];
  p.w_out = in[14]; p.norm2_w = in[15]; p.wq = in[16]; p.keys = in[17]; p.U = in[18]; p.V = in[19]; p.final_norm_w = in[20];
  p.out = (float*)d_out;
  p.bar = (unsigned*)d_ws; p.flg = (unsigned*)((char*)d_ws + WS_END);
  char* ws = (char*)d_ws;
  p.mod = (float*)(ws + OFF_MOD); p.gates = (float*)(ws + OFF_GATES);
  p.wt_in = (bf16_t*)(ws + OFF_WTIN); p.wt_out = (bf16_t*)(ws + OFF_WTOUT); p.wt_q = (bf16_t*)(ws + OFF_WTQ);
  p.keys_bf = (bf16_t*)(ws + OFF_KEYS); p.hn = (bf16_t*)(ws + OFF_HN); p.pl = (bf16_t*)(ws + OFF_PL);
  p.Dst = (bf16_t*)(ws + OFF_D); p.ND = (float*)(ws + OFF_ND); p.SC = (float*)(ws + OFF_SC);
  p.CIN = (bf16_t*)(ws + OFF_CIN); p.NIN = (float*)(ws + OFF_NIN); p.MIN_ = (float*)(ws + OFF_MIN);
  p.mix = (bf16_t*)(ws + OFF_D); p.qb = (bf16_t*)(ws + OFF_D);
  p.U8 = (unsigned char*)(ws + OFF_U8); p.V8 = (unsigned char*)(ws + OFF_U8 + 16777216ull);
  p.eidx = (unsigned short*)(ws + OFF_EIDX); p.gate = (float*)(ws + OFF_GATE);
#if N_LAUNCHES == 1
  p.ph_lo = 0; p.ph_hi = NPH;
  void* args[] = {&p};
  hipError_t e = hipLaunchCooperativeKernel((const void*)mega, dim3(grid_blocks), dim3(2 * NTHR), args, 0, stream);
  if (e != hipSuccess) fprintf(stderr, "cooperative launch failed: %s (grid %d)\n", hipGetErrorString(e), grid_blocks);
#else
  for (int ph = 0; ph < NPH; ++ph) {
    p.ph_lo = ph; p.ph_hi = ph + 1;
    void* args[] = {&p};
    hipError_t e = hipLaunchCooperativeKernel((const void*)mega, dim3(grid_blocks), dim3(2 * NTHR), args, 0, stream);
    if (e != hipSuccess) fprintf(stderr, "launch %d failed: %s (grid %d)\n", ph, hipGetErrorString(e), grid_blocks);
  }
#endif
}
```

```cpp
#include <hip/hip_runtime.h>
#include <hip/hip_cooperative_groups.h>
#include <stdint.h>
#include <stdio.h>
namespace cg = cooperative_groups;

#ifndef PHMASK
#define PHMASK 0x7ff
#endif
#ifndef N_LAUNCHES
#define N_LAUNCHES 1
#endif

typedef unsigned short bf16_t;
typedef short bf16x8 __attribute__((ext_vector_type(8)));
typedef float f32x4 __attribute__((ext_vector_type(4)));
typedef unsigned u32x4 __attribute__((ext_vector_type(4)));
typedef float f32x2 __attribute__((ext_vector_type(2)));
typedef unsigned u32x2 __attribute__((ext_vector_type(2)));
typedef __bf16 bf16x2 __attribute__((ext_vector_type(2)));

#define NB 8
#define SEQ 2048
#define DM 1024
#define CTXL 256
#define TL 16384
#define TC 2048
#define TR 18432
#define LDP 2624
#define NPADIN 2688
#define NTHR 256
#define LDS_HALF 73728
#define NPH 11

#define OFF_MOD    (4096ull)
#define OFF_GATES  (OFF_MOD + 262144ull)
#define OFF_WTIN   (OFF_GATES + 1179648ull)
#define OFF_WTOUT  (OFF_WTIN + 5767168ull)
#define OFF_WTQ    (OFF_WTOUT + 2097152ull)
#define OFF_KEYS   (OFF_WTQ + 4194304ull)
#define OFF_POOLWT (OFF_KEYS + 524288ull)
#define OFF_HN     (OFF_POOLWT + 131072ull)
#define OFF_PL     (OFF_HN + 37748736ull)
#define OFF_D      (OFF_PL + 96731136ull)
#define OFF_ND     (OFF_D + 37748736ull)
#define OFF_SC     (OFF_ND + 589824ull)
#define OFF_CIN    (OFF_SC + 147456ull)
#define OFF_NIN    (OFF_CIN + 33554432ull)
#define OFF_MIN    (OFF_NIN + 524288ull)
#define OFF_EIDX   (OFF_MIN + 131072ull)
#define OFF_GATE   (OFF_EIDX + 4194304ull)
#define OFF_U8     (OFF_GATE + 8388608ull)
#define WS_END     (OFF_U8 + 33554432ull)

struct P {
  const float *x, *c, *ctx, *c_ctx, *w_mod, *b_mod, *norm1_w, *w_in, *conv_w, *conv_b, *b_gates, *head_norm_w,
      *pool_w, *pool_scale, *w_out, *norm2_w, *wq, *keys, *U, *V, *final_norm_w;
  float* out;
  float* mod;
  float* gates;
  bf16_t* wt_in;
  bf16_t* wt_out;
  bf16_t* wt_q;
  bf16_t* keys_bf;
  bf16_t* hn;
  bf16_t* pl;
  bf16_t* Dst;
  float* ND;
  float* SC;
  bf16_t* CIN;
  float* NIN;
  float* MIN_;
  bf16_t* mix;
  bf16_t* qb;
  unsigned char* U8;
  unsigned char* V8;
  unsigned short* eidx;
  float* gate;
  int ph_lo, ph_hi;
  unsigned* flg;
  unsigned* bar;
};

__device__ __forceinline__ bf16_t f2bf(float f) { return __builtin_bit_cast(bf16_t, (__bf16)f); }
__device__ __forceinline__ float bf2f(bf16_t h) { return __uint_as_float(((unsigned)h) << 16); }
__device__ __forceinline__ float wave_sum(float v) {
#pragma unroll
  for (int o = 32; o > 0; o >>= 1) v += __shfl_xor(v, o);
  return v;
}
__device__ __forceinline__ float silu_f(float v) { return v / (1.f + __expf(-v)); }
__device__ __forceinline__ float logsig_f(float v) { return fminf(v, 0.f) - log1pf(__expf(-fabsf(v))); }

__device__ __forceinline__ __amdgpu_buffer_rsrc_t mk_rsrc(const void* ptr) { return __builtin_amdgcn_make_buffer_rsrc((void*)ptr, 0, 0x7fffffff, 0x00020000); }
__device__ __forceinline__ bf16x8 bload8(__amdgpu_buffer_rsrc_t r, int voff, int soff) { return __builtin_bit_cast(bf16x8, __builtin_amdgcn_raw_buffer_load_b128(r, voff, soff, 0)); }
#define AUX_SC1 16
__device__ __forceinline__ bf16x8 bload8c(__amdgpu_buffer_rsrc_t r, int voff, int soff) { return __builtin_bit_cast(bf16x8, __builtin_amdgcn_raw_buffer_load_b128(r, voff, soff, AUX_SC1)); }
__device__ __forceinline__ u32x2 uload2c(__amdgpu_buffer_rsrc_t r, int voff, int soff) { return __builtin_bit_cast(u32x2, __builtin_amdgcn_raw_buffer_load_b64(r, voff, soff, AUX_SC1)); }
__device__ __forceinline__ float fload1c(__amdgpu_buffer_rsrc_t r, int voff, int soff) { return __builtin_bit_cast(float, __builtin_amdgcn_raw_buffer_load_b32(r, voff, soff, AUX_SC1)); }
__device__ __forceinline__ f32x4 fload4c(__amdgpu_buffer_rsrc_t r, int voff, int soff) { return __builtin_bit_cast(f32x4, __builtin_amdgcn_raw_buffer_load_b128(r, voff, soff, AUX_SC1)); }
__device__ __forceinline__ void ustore4c(__amdgpu_buffer_rsrc_t r, int voff, u32x4 v) { __builtin_amdgcn_raw_buffer_store_b128(v, r, voff, 0, AUX_SC1); }
__device__ __forceinline__ void ustore2c(__amdgpu_buffer_rsrc_t r, int voff, u32x2 v) { __builtin_amdgcn_raw_buffer_store_b64(v, r, voff, 0, AUX_SC1); }
__device__ __forceinline__ u32x4 uload4c(__amdgpu_buffer_rsrc_t r, int voff, int soff) { return __builtin_bit_cast(u32x4, __builtin_amdgcn_raw_buffer_load_b128(r, voff, soff, AUX_SC1)); }

__device__ __forceinline__ void ph0_prep(const P& p, int bid, int nb, char* smem) {
  float* sm = (float*)smem;
  const int tid = threadIdx.x & 255;
  const int N_MOD = 384, N_TIN = 16 * 44, N_TOUT = 256, N_TQ = 16 * 32, N_POOL = 16;
  const int total = N_MOD + N_TIN + N_TOUT + N_TQ + N_POOL;
  const int trips = (total + nb - 1) / nb;
  for (int k = 0; k < trips; ++k) {
    int r = (bid + k * nb) % total;
    if (r < N_MOD) {
      float* part = sm + 9 * 1024;
      for (int i = tid; i < 9 * 1024; i += NTHR) {
        int rr = i >> 10, kq = i & 1023;
        float v = rr < 8 ? p.c[rr * 1024 + kq] : p.c_ctx[kq];
        sm[i] = silu_f(v);
      }
      __syncthreads();
      {
        const int c = tid & 15, kg = tid >> 4, n = r * 16 + c;
        float acc[9];
#pragma unroll
        for (int q = 0; q < 9; ++q) acc[q] = 0.f;
#pragma unroll 8
        for (int i = 0; i < 64; ++i) {
          const int kq = kg + i * 16;
          const float w = p.w_mod[(size_t)kq * 6144 + n];
#pragma unroll
          for (int q = 0; q < 9; ++q) acc[q] += sm[q * 1024 + kq] * w;
        }
#pragma unroll
        for (int q = 0; q < 9; ++q) part[(kg * 9 + q) * 16 + c] = acc[q];
      }
      __syncthreads();
      if (tid < 144) {
        const int q = tid >> 4, c = tid & 15, n = r * 16 + c;
        float t = p.b_mod[n];
#pragma unroll
        for (int kg = 0; kg < 16; ++kg) t += part[(kg * 9 + q) * 16 + c];
        p.mod[q * 6144 + n] = t;
      }
      continue;
    }
    r -= N_MOD;
    const float* src = nullptr; bf16_t* dst = nullptr; int K = 1024, N = 0, ntn = 0;
    if (r < N_TIN) { src = p.w_in; dst = p.wt_in; N = 2576; ntn = 44; }
    else { r -= N_TIN;
      if (r < N_TOUT) { src = p.w_out; dst = p.wt_out; N = 1024; ntn = 16; }
      else { r -= N_TOUT;
        if (r < N_TQ) { src = p.wq; dst = p.wt_q; N = 2048; ntn = 32; }
        else { r -= N_TQ; int g = r >> 2; r &= 3; src = p.pool_w + g * 16384; dst = (bf16_t*)((char*)p.keys_bf + 524288) + g * 16384; K = 128; N = 128; ntn = 2; }
      }
    }
    {
      int kt = r / ntn, nt = r % ntn, k0 = kt * 64, n0 = nt * 64;
      int cc = tid & 63;
      for (int rr = tid >> 6; rr < 64; rr += 4) {
        int n = n0 + cc;
        sm[rr * 65 + cc] = n < N ? src[(size_t)(k0 + rr) * N + n] : 0.f;
      }
      __syncthreads();
      for (int rr = tid >> 6; rr < 64; rr += 4) dst[(size_t)(n0 + rr) * K + k0 + cc] = f2bf(sm[cc * 65 + rr]);
      __syncthreads();
    }
  }
  for (int i = bid * NTHR + tid; i < 262144; i += nb * NTHR) p.keys_bf[i] = f2bf(p.keys[i]);
}

template <int WHICH>
__device__ __forceinline__ void ph_norm_rows(const P& p, int bid, int nb) {
  const int wave = (threadIdx.x >> 6) & 3, lane = threadIdx.x & 63;
  const int nrows = WHICH == 0 ? TR : TL;
  for (int row = bid * 4 + wave; row < nrows; row += nb * 4) {
    const float* src = WHICH == 0 ? (row < TL ? p.x + (size_t)row * 1024 : p.ctx + (size_t)(row - TL) * 1024) : p.out + (size_t)row * 1024;
    const int mr = row < TL ? row / SEQ : 8;
    float4 v[4];
    float ss = 0.f;
#pragma unroll
    for (int j = 0; j < 4; ++j) {
      if (WHICH == 1) { const f32x4 t = fload4c(mk_rsrc(p.out), (row * 1024 + (j * 64 + lane) * 4) * 4, 0); v[j] = make_float4(t[0], t[1], t[2], t[3]); }
      else v[j] = ((const float4*)src)[j * 64 + lane];
      ss += v[j].x * v[j].x + v[j].y * v[j].y + v[j].z * v[j].z + v[j].w * v[j].w;
    }
    ss = wave_sum(ss);
    const float rstd = rsqrtf(ss * (1.f / 1024.f) + 1e-6f);
    const float* nw = WHICH == 0 ? p.norm1_w : p.norm2_w;
    const float* sh = p.mod + mr * 6144 + (WHICH == 0 ? 0 : 3) * 1024;
    const float* sc = sh + 1024;
#pragma unroll
    for (int j = 0; j < 4; ++j) {
      const int col = j * 256 + lane * 4;
      float4 w4 = *(const float4*)(nw + col), s4 = *(const float4*)(sh + col), c4 = *(const float4*)(sc + col);
      float y0 = v[j].x * rstd * w4.x * (1.f + c4.x) + s4.x;
      float y1 = v[j].y * rstd * w4.y * (1.f + c4.y) + s4.y;
      float y2 = v[j].z * rstd * w4.z * (1.f + c4.z) + s4.z;
      float y3 = v[j].w * rstd * w4.w * (1.f + c4.w) + s4.w;
      uint2 o;
      o.x = (unsigned)f2bf(y0) | ((unsigned)f2bf(y1) << 16);
      o.y = (unsigned)f2bf(y2) | ((unsigned)f2bf(y3) << 16);
      ustore2c(mk_rsrc(p.hn), (row * 1024 + col) * 2, (u32x2){o.x, o.y});
    }
  }
}

#define GBK 64
#define GLD 72
template <int EPI>
__device__ __forceinline__ void gemm_tile(const P& p, const bf16_t* A, int lda, const bf16_t* Bt, int m0, int n0, bf16_t* sA, bf16_t* sB) {
  const int tid = threadIdx.x & 255, lane = tid & 63, wave = tid >> 6;
  const int wm = wave >> 1, wn = wave & 1;
  const int lr = lane & 15, lq = lane >> 4;
  f32x4 acc[4][4];
#pragma unroll
  for (int i = 0; i < 4; ++i)
#pragma unroll
    for (int j = 0; j < 4; ++j) acc[i][j] = (f32x4){0.f, 0.f, 0.f, 0.f};
  const int sr = tid >> 3, scol = (tid & 7) * 8;
  u32x4 ra[4], rb[4];
  const bf16_t* Ap = A + (size_t)(m0 + sr) * lda + scol;
  const bf16_t* Bp = Bt + (size_t)(n0 + sr) * 1024 + scol;
#pragma unroll
  for (int i = 0; i < 4; ++i) {
    ra[i] = *(const u32x4*)(Ap + (size_t)(i * 32) * lda);
    rb[i] = *(const u32x4*)(Bp + (size_t)(i * 32) * 1024);
  }
  for (int kt = 0; kt < 1024 / GBK; ++kt) {
    __syncthreads();
#pragma unroll
    for (int i = 0; i < 4; ++i) {
      *(u32x4*)(sA + (sr + i * 32) * GLD + scol) = ra[i];
      *(u32x4*)(sB + (sr + i * 32) * GLD + scol) = rb[i];
    }
    __syncthreads();
    {
      const int k0 = (kt + 1 < 1024 / GBK ? kt + 1 : kt) * GBK;
#pragma unroll
      for (int i = 0; i < 4; ++i) {
        ra[i] = *(const u32x4*)(Ap + (size_t)(i * 32) * lda + k0);
        rb[i] = *(const u32x4*)(Bp + (size_t)(i * 32) * 1024 + k0);
      }
    }
#pragma unroll
    for (int ks = 0; ks < 2; ++ks) {
      bf16x8 af[4], bfr[4];
#pragma unroll
      for (int i = 0; i < 4; ++i) {
        af[i] = *(const bf16x8*)(sA + (wm * 64 + i * 16 + lr) * GLD + ks * 32 + lq * 8);
        bfr[i] = *(const bf16x8*)(sB + (wn * 64 + i * 16 + lr) * GLD + ks * 32 + lq * 8);
      }
#pragma unroll
      for (int i = 0; i < 4; ++i)
#pragma unroll
        for (int j = 0; j < 4; ++j) acc[i][j] = __builtin_amdgcn_mfma_f32_16x16x32_bf16(af[i], bfr[j], acc[i][j], 0, 0, 0);
    }
  }
#pragma unroll
  for (int i = 0; i < 4; ++i)
#pragma unroll
    for (int j = 0; j < 4; ++j)
#pragma unroll
      for (int e = 0; e < 4; ++e) {
        const int row = m0 + wm * 64 + i * 16 + lq * 4 + e;
        const int col = n0 + wn * 64 + j * 16 + lr;
        const float v = acc[i][j][e];
        if (EPI == 0) {
          if (col < 2560) p.pl[(size_t)row * LDP + col] = f2bf(v);
          else if (col < 2576) p.gates[(size_t)row * 16 + (col - 2560)] = v;
        } else if (EPI == 1) {
          const int b = row / SEQ;
          p.out[(size_t)row * 1024 + col] = p.x[(size_t)row * 1024 + col] + p.mod[b * 6144 + 2 * 1024 + col] * v;
        } else {
          p.qb[(size_t)row * 2048 + col] = f2bf(v);
        }
      }
}

template <int EPI>
__device__ __forceinline__ void ph_gemm(const P& p, int bid, int nb, char* smem) {
  bf16_t* sA = (bf16_t*)smem;
  bf16_t* sB = sA + 128 * GLD;
  const int ntn = EPI == 0 ? 21 : (EPI == 1 ? 8 : 16);
  const int ntm = EPI == 0 ? 144 : 128;
  const bf16_t* A = EPI == 0 ? p.hn : (EPI == 1 ? p.mix : p.hn);
  const int lda = 1024;
  const bf16_t* Bt = EPI == 0 ? p.wt_in : (EPI == 1 ? p.wt_out : p.wt_q);
  const int nlat = 128 * ntn;
  const int ntiles = EPI == 0 ? nlat + 16 * 13 : ntm * ntn;
  const int trips = (ntiles + nb - 1) / nb;
  for (int k = 0; k < trips; ++k) {
    const int t = (bid + k * nb) % ntiles;
    int tm, tn;
    if (EPI == 0 && t >= nlat) { const int r = t - nlat; tm = 128 + r / 13; tn = r % 13; if (tn == 12) tn = 20; }
    else { tm = t / ntn; tn = t % ntn; }
    gemm_tile<EPI>(p, A, lda, Bt, tm * 128, tn * 128, sA, sB);
  }
}

struct UnitInfo { int isctx, b, c, h, T, seqrow0, row0; };
__device__ __forceinline__ UnitInfo decode_unit(int u) {
  UnitInfo r;
  if (u < 512) { r.isctx = 0; r.b = u >> 6; r.c = (u >> 2) & 15; r.h = u & 3; r.T = SEQ; r.seqrow0 = r.b * SEQ; }
  else { int uu = u - 512; r.isctx = 1; r.b = uu >> 3; r.c = (uu >> 2) & 1; r.h = uu & 3; r.T = CTXL; r.seqrow0 = TL + r.b * CTXL; }
  r.row0 = r.seqrow0 + r.c * 128;
  return r;
}
__device__ __forceinline__ float qk_act(const P& p, int seqrow0, int T, int t, int col) {
  const bf16_t* base = p.pl + (size_t)(seqrow0 + t) * LDP + col;
  float r0 = t > 0 ? bf2f(base[-LDP]) : 0.f;
  float r1 = bf2f(base[0]);
  float r2 = t + 1 < T ? bf2f(base[LDP]) : 0.f;
  float y = p.conv_b[col] + r0 * p.conv_w[col] + r1 * p.conv_w[1024 + col] + r2 * p.conv_w[2048 + col];
  return silu_f(y);
}


typedef short s16x4 __attribute__((ext_vector_type(4)));
#define LDS_AS __attribute__((address_space(3)))
__device__ __forceinline__ s16x4 ds_tr16(const bf16_t* ptr) { return __builtin_amdgcn_ds_read_tr16_b64_v4i16((LDS_AS s16x4*)ptr); }
__device__ __forceinline__ bf16x8 frag_tr(const bf16_t* M, int ld, int s0, int c0, int lr, int lq) {
  const bf16_t* a = M + (s0 + lq * 8 + (lr >> 2)) * ld + c0 + (lr & 3) * 4;
  const s16x4 t0 = ds_tr16(a), t1 = ds_tr16(a + 4 * ld);
  return __builtin_shufflevector(t0, t1, 0, 1, 2, 3, 4, 5, 6, 7);
}
__device__ __forceinline__ unsigned cvt_pk_bf16(float lo, float hi) { const f32x2 v = {lo, hi}; const bf16x2 b = __builtin_convertvector(v, bf16x2); return __builtin_bit_cast(unsigned, b); }
__device__ __forceinline__ float blo(unsigned u) { return __uint_as_float(u << 16); }
__device__ __forceinline__ float bhi(unsigned u) { return __uint_as_float(u & 0xffff0000u); }
#define VLD 136


namespace pg8 {
#define PG8_LAS __attribute__((address_space(3)))
constexpr int BM = 256, BK = 64, HALF = 128, HTB = HALF * BK * 2, STAGE_BYTES = 8 * HTB, NXCD = 8, WGM = 8;
__host__ __device__ __forceinline__ int lds_byte(int r, int c) { const int st = (r >> 4) * 2 + (c >> 5), rr = r & 15, cc = c & 31, ob = rr * 64 + cc * 2; return st * 1024 + (ob ^ (((ob >> 9) & 1) << 5)); }
__host__ __device__ __forceinline__ void stage_rc(int b, int& R, int& C) { const int st = b / 1024, sb = b % 1024, swz = sb ^ (((sb >> 9) & 1) << 5); R = (st >> 1) * 16 + swz / 64; C = (st & 1) * 32 + (swz % 64) / 2; }
__host__ __device__ __forceinline__ int perm32(int rho) { const int n = rho >> 4, i = rho & 15; return 8 * (i >> 2) + 4 * n + (i & 3); }
struct Unit { int pm, pn; };
struct Gemm { const bf16_t* A; const bf16_t* Bt; int M, N, K; };
struct Order {
  int nM, nN, nwg, G, c, extra;
  __device__ void init(int nM_, int nN_, int G_, int c_, int extra_) { nM = nM_; nN = nN_; nwg = nM * nN; G = G_; c = c_; extra = extra_; }
  __device__ bool next(int i, Unit& u) const {
    const long L = (long)i * G + c;
    if (L >= nwg + extra) return false;
    if (L >= nwg) { const int r = (int)L - nwg; u.pm = nM + r / 7; const int q = r % 7; u.pn = q < 6 ? q : 10; return true; }
    int wgid = (int)L; { const int q = nwg / NXCD, r = nwg % NXCD, xcd = wgid % NXCD, off = wgid / NXCD; wgid = (xcd < r ? xcd * (q + 1) : r * (q + 1) + (xcd - r) * q) + off; }
    const int nig = WGM * nN, gid = wgid / nig, fm = gid * WGM, gsz = (nM - fm) < WGM ? (nM - fm) : WGM;
    u.pm = fm + ((wgid % nig) % gsz); u.pn = (wgid % nig) / gsz; return true;
  }
  __device__ __forceinline__ void a_ready(const Unit&) const {}
  __device__ __forceinline__ void done(const Unit&) const {}
};
template <class Epi, class Sched>
__device__ __forceinline__ void gemm_phase(PG8_LAS unsigned char* lds, const Gemm g, const Sched& S, const Epi& E) {
    const int tid = threadIdx.x, wid = __builtin_amdgcn_readfirstlane(tid >> 6), lane = tid & 63, wr = wid >> 2, wc = wid & 3, fr = lane & 15, fq = lane >> 4;
    const int K = g.K, nt = K / BK;
    unsigned voffA[2], voffB[2];
#pragma unroll
    for (int i = 0; i < 2; ++i) { int R, C; stage_rc(tid * 16 + i * 8192, R, C); const int Rb = Epi::PERM ? ((R & ~31) + perm32(R & 31)) : R;
        voffA[i] = (unsigned)(R * K + C) * 2u; voffB[i] = (unsigned)(Rb * K + C) * 2u; }
    const size_t kstep = (size_t)(BK * 2);
    const size_t hstep = (size_t)HALF * K * 2;
    const size_t tstep = 2 * hstep;
    const unsigned ldsw = (unsigned)wid * 1024u;
    const int aoff = lds_byte(wr * 64 + fr, fq * 8), boff = lds_byte(wc * 32 + fr, fq * 8);
#define PG8_SA(b, h) (((b) * 2 + (h)) * HTB)
#define PG8_SB(b, h) ((4 + (b) * 2 + (h)) * HTB)
#define PG8_STAGE_X(bufoff, gbase, voff, aux) do { _Pragma("unroll") for (int _i = 0; _i < 2; ++_i) \
        __builtin_amdgcn_global_load_lds((const unsigned*)((const char*)(gbase) + (voff)[_i]), (PG8_LAS unsigned*)(lds + (bufoff) + ldsw + _i * 8192), 16, 0, aux); } while (0)
#define PG8_STAGE(bufoff, gbase, voff) PG8_STAGE_X(bufoff, gbase, voff, 0)
#define PG8_STAGE_A(bufoff, gbase, voff) do { if (Epi::A_COHERENT) PG8_STAGE_X(bufoff, gbase, voff, AUX_SC1); else PG8_STAGE_X(bufoff, gbase, voff, 0); } while (0)
#define PG8_LDA(dst, b, h) do { _Pragma("unroll") for (int m = 0; m < 4; ++m) _Pragma("unroll") for (int k = 0; k < 2; ++k) dst[m][k] = *(const PG8_LAS bf16x8*)(lds + PG8_SA(b, h) + aoff + m * 2048 + k * 1024); } while (0)
#define PG8_LDB(dst, b, h) do { _Pragma("unroll") for (int n = 0; n < 2; ++n) _Pragma("unroll") for (int k = 0; k < 2; ++k) dst[n][k] = *(const PG8_LAS bf16x8*)(lds + PG8_SB(b, h) + boff + n * 2048 + k * 1024); } while (0)
#define PG8_MMA(ai, bj, At, Bt) do { __builtin_amdgcn_s_setprio(1); _Pragma("unroll") for (int m = 0; m < 4; ++m) _Pragma("unroll") for (int n = 0; n < 2; ++n) _Pragma("unroll") for (int k = 0; k < 2; ++k) \
        acc[ai][bj][m][n] = __builtin_amdgcn_mfma_f32_16x16x32_bf16(Bt[n][k], At[m][k], acc[ai][bj][m][n], 0, 0, 0); __builtin_amdgcn_s_setprio(0); } while (0)
#define PG8_WAIT_V(n) asm volatile("s_waitcnt vmcnt(" #n ")" ::: "memory")
#define PG8_WAIT_L(n) asm volatile("s_waitcnt lgkmcnt(" #n ")" ::: "memory")
#define PG8_BAR __builtin_amdgcn_s_barrier()
#define PG8_SCHED __builtin_amdgcn_sched_barrier(0)
    Unit cur, nxt; int ui = 0;
    if (!S.next(0, cur)) return;
    f32x4 acc[2][2][4][2];
#pragma unroll
    for (int a = 0; a < 2; ++a)
#pragma unroll
        for (int b = 0; b < 2; ++b)
#pragma unroll
            for (int m = 0; m < 4; ++m)
#pragma unroll
                for (int n = 0; n < 2; ++n) acc[a][b][m][n] = (f32x4){0.f, 0.f, 0.f, 0.f};
    bf16x8 At[4][2], B0[2][2], B1[2][2];
    const char* cA = (const char*)g.A + (size_t)cur.pm * tstep; const char* cB = (const char*)g.Bt + (size_t)cur.pn * tstep;
    S.a_ready(cur);
    PG8_STAGE(PG8_SB(0, 0), cB, voffB); PG8_STAGE_A(PG8_SA(0, 0), cA, voffA); PG8_STAGE(PG8_SB(0, 1), cB + hstep, voffB); PG8_STAGE_A(PG8_SA(0, 1), cA + hstep, voffA);
    if (wr == 1) PG8_BAR;
    PG8_WAIT_V(4); PG8_BAR;
    PG8_STAGE(PG8_SB(1, 0), cB + kstep, voffB); PG8_STAGE_A(PG8_SA(1, 0), cA + kstep, voffA); PG8_STAGE(PG8_SB(1, 1), cB + hstep + kstep, voffB);
    PG8_WAIT_V(6); PG8_BAR;
    for (;;) {
        const bool has_next = S.next(ui + 1, nxt);
        const char* nA = has_next ? (const char*)g.A + (size_t)nxt.pm * tstep : cA; const char* nB = has_next ? (const char*)g.Bt + (size_t)nxt.pn * tstep : cB;
        for (int t = 0; t < nt; t += 2) {
            const bool last = (t == nt - 2);
            const char* a1 = cA + (size_t)(t + 1) * kstep;
            const char* a2 = last ? nA : cA + (size_t)(t + 2) * kstep; const char* b2 = last ? nB : cB + (size_t)(t + 2) * kstep;
            const char* a3 = a2 + kstep; const char* b3 = b2 + kstep;
            if (last && has_next) S.a_ready(nxt);
            PG8_LDB(B0, 0, 0); PG8_SCHED; PG8_LDA(At, 0, 0); PG8_STAGE_A(PG8_SA(1, 1), a1 + hstep, voffA);
            PG8_WAIT_L(8); PG8_BAR; PG8_WAIT_L(0); PG8_MMA(0, 0, At, B0); PG8_BAR; PG8_SCHED;
            PG8_LDB(B1, 0, 1); PG8_STAGE(PG8_SB(0, 0), b2, voffB);
            PG8_BAR; PG8_WAIT_L(0); PG8_MMA(0, 1, At, B1); PG8_BAR;
            PG8_LDA(At, 0, 1); PG8_STAGE_A(PG8_SA(0, 0), a2, voffA);
            PG8_BAR; PG8_WAIT_L(0); PG8_MMA(1, 0, At, B0); PG8_BAR; PG8_SCHED;
            PG8_STAGE(PG8_SB(0, 1), b2 + hstep, voffB);
            PG8_WAIT_V(6); PG8_BAR; PG8_MMA(1, 1, At, B1); PG8_BAR;
            PG8_LDB(B0, 1, 0); PG8_SCHED; PG8_LDA(At, 1, 0); PG8_STAGE_A(PG8_SA(0, 1), a2 + hstep, voffA);
            PG8_WAIT_L(8); PG8_BAR; PG8_WAIT_L(0); PG8_MMA(0, 0, At, B0); PG8_BAR; PG8_SCHED;
            PG8_LDB(B1, 1, 1); PG8_STAGE(PG8_SB(1, 0), b3, voffB);
            PG8_BAR; PG8_WAIT_L(0); PG8_MMA(0, 1, At, B1); PG8_BAR;
            PG8_LDA(At, 1, 1); PG8_STAGE_A(PG8_SA(1, 0), a3, voffA);
            PG8_BAR; PG8_WAIT_L(0); PG8_MMA(1, 0, At, B0); PG8_BAR; PG8_SCHED;
            PG8_STAGE(PG8_SB(1, 1), b3 + hstep, voffB);
            PG8_WAIT_V(6); PG8_BAR; PG8_MMA(1, 1, At, B1); PG8_BAR;
        }
        if constexpr (!Epi::AFTER_DRAIN) { E(acc, cur, wr, wc, fr, fq); S.done(cur); }
        if (!has_next) break;
#pragma unroll
        for (int a = 0; a < 2; ++a)
#pragma unroll
            for (int b = 0; b < 2; ++b)
#pragma unroll
                for (int m = 0; m < 4; ++m)
#pragma unroll
                    for (int n = 0; n < 2; ++n) acc[a][b][m][n] = (f32x4){0.f, 0.f, 0.f, 0.f};
        cur = nxt; cA = nA; cB = nB; ++ui;
    }
    PG8_WAIT_V(0);
    if (wr == 0) PG8_BAR;
    PG8_BAR;
    if constexpr (Epi::AFTER_DRAIN) { E.fused(acc, cur, wr, wc, fr, fq, lds, wid, lane); S.done(cur); }
#undef PG8_SA
#undef PG8_SB
#undef PG8_STAGE
#undef PG8_LDA
#undef PG8_LDB
#undef PG8_MMA
#undef PG8_WAIT_V
#undef PG8_WAIT_L
#undef PG8_BAR
#undef PG8_SCHED
}
}

struct EpiIn {
  static constexpr bool PERM = true, AFTER_DRAIN = false, A_COHERENT = true;
  bf16_t* pl; float* gates;
  __device__ __forceinline__ void operator()(const f32x4 (&acc)[2][2][4][2], const pg8::Unit& u, int wr, int wc, int fr, int fq) const {
    const int row0 = u.pm * 256 + wr * 64 + fr;
#pragma unroll
    for (int ai = 0; ai < 2; ++ai)
#pragma unroll
      for (int m = 0; m < 4; ++m) {
        const int row = row0 + ai * 128 + m * 16;
#pragma unroll
        for (int bj = 0; bj < 2; ++bj) {
          const int c0 = u.pn * 256 + bj * 128 + wc * 32 + 8 * fq;
          const f32x4 v0 = acc[ai][bj][m][0], v1 = acc[ai][bj][m][1];
          if (c0 < 2560) {
            u32x4 w;
            w[0] = cvt_pk_bf16(v0[0], v0[1]); w[1] = cvt_pk_bf16(v0[2], v0[3]); w[2] = cvt_pk_bf16(v1[0], v1[1]); w[3] = cvt_pk_bf16(v1[2], v1[3]);
            *(u32x4*)(pl + (size_t)row * LDP + c0) = w;
          } else if (c0 < 2576) {
            *(f32x4*)(gates + (size_t)row * 16 + (c0 - 2560)) = v0;
            *(f32x4*)(gates + (size_t)row * 16 + (c0 - 2560) + 4) = v1;
          }
        }
      }
  }
};
struct EpiOut {
  static constexpr bool PERM = false, AFTER_DRAIN = false, A_COHERENT = true;
  const float* x; const float* mod; float* out;
  __device__ __forceinline__ void operator()(const f32x4 (&acc)[2][2][4][2], const pg8::Unit& u, int wr, int wc, int fr, int fq) const {
    const int row0 = u.pm * 256 + wr * 64 + fr, col0 = u.pn * 256 + wc * 32 + 4 * fq;
    const float* g1 = mod + (u.pm * 256 / SEQ) * 6144 + 2 * 1024;
#pragma unroll
    for (int ai = 0; ai < 2; ++ai)
#pragma unroll
      for (int m = 0; m < 4; ++m) {
        const size_t ro = (size_t)(row0 + ai * 128 + m * 16) * 1024;
#pragma unroll
        for (int bj = 0; bj < 2; ++bj)
#pragma unroll
          for (int n = 0; n < 2; ++n) {
            const int c = col0 + bj * 128 + n * 16;
            const f32x4 xv = *(const f32x4*)(x + ro + c), gv = *(const f32x4*)(g1 + c);
            *(f32x4*)(out + ro + c) = xv + gv * acc[ai][bj][m][n];
          }
      }
  }
};
struct EpiQ {
  static constexpr bool PERM = true, AFTER_DRAIN = false, A_COHERENT = true;
  bf16_t* q;
  __device__ __forceinline__ void operator()(const f32x4 (&acc)[2][2][4][2], const pg8::Unit& u, int wr, int wc, int fr, int fq) const {
    const int row0 = u.pm * 256 + wr * 64 + fr;
#pragma unroll
    for (int ai = 0; ai < 2; ++ai)
#pragma unroll
      for (int m = 0; m < 4; ++m)
#pragma unroll
        for (int bj = 0; bj < 2; ++bj) {
          const int c0 = u.pn * 256 + bj * 128 + wc * 32 + 8 * fq;
          const f32x4 v0 = acc[ai][bj][m][0], v1 = acc[ai][bj][m][1];
          u32x4 w;
          w[0] = cvt_pk_bf16(v0[0], v0[1]); w[1] = cvt_pk_bf16(v0[2], v0[3]); w[2] = cvt_pk_bf16(v1[0], v1[1]); w[3] = cvt_pk_bf16(v1[2], v1[3]);
          *(u32x4*)(q + (size_t)(row0 + ai * 128 + m * 16) * 2048 + c0) = w;
        }
  }
};
template <int EPI>
__device__ __forceinline__ void ph_gemm8(const P& p, char* lds_all) {
  PG8_LAS unsigned char* lds = (PG8_LAS unsigned char*)lds_all;
  pg8::Order S;
  if (EPI == 0) {
    S.init(64, 11, gridDim.x, blockIdx.x, 56);
    const pg8::Gemm g{p.hn, p.wt_in, TR, 2816, 1024};
    const EpiIn E{p.pl, p.gates};
    pg8::gemm_phase<EpiIn, pg8::Order>(lds, g, S, E);
  } else if (EPI == 1) {
    S.init(64, 4, gridDim.x, blockIdx.x, 0);
    const pg8::Gemm g{p.mix, p.wt_out, TL, 1024, 1024};
    const EpiOut E{p.x, p.mod, p.out};
    pg8::gemm_phase<EpiOut, pg8::Order>(lds, g, S, E);
  } else {
    S.init(64, 8, gridDim.x, blockIdx.x, 0);
    const pg8::Gemm g{p.hn, p.wt_q, TL, 2048, 1024};
    const EpiQ E{p.qb};
    pg8::gemm_phase<EpiQ, pg8::Order>(lds, g, S, E);
  }
}

template <bool REV>
__device__ __forceinline__ void scan128(const float* lf, const float* ig, float* bout, float* gout, float* pmout, float& Gtot, float& btot, int lane, float& g0o, float& g1o) {
  const int t0 = REV ? 127 - 2 * lane : 2 * lane, t1 = REV ? 126 - 2 * lane : 2 * lane + 1;
  const float v0 = lf[t0], v1 = lf[t1];
  float sacc = v0 + v1;
#pragma unroll
  for (int off = 1; off < 64; off <<= 1) { const float t = __shfl_up(sacc, off); if (lane >= off) sacc += t; }
  const float b1 = sacc, b0 = sacc - v1;
  const float g0 = ig[t0] - b0, g1 = ig[t1] - b1;
  float m = fmaxf(g0, g1);
#pragma unroll
  for (int off = 1; off < 64; off <<= 1) { const float t = __shfl_up(m, off); if (lane >= off) m = fmaxf(m, t); }
  float prev = __shfl_up(m, 1);
  if (lane == 0) prev = -3.0e38f;
  if (bout) { bout[t0] = b0; bout[t1] = b1; }
  if (gout) { gout[t0] = g0; gout[t1] = g1; }
  g0o = g0; g1o = g1;
  if (pmout) { pmout[t0] = fmaxf(prev, g0); pmout[t1] = m; }
  Gtot = __shfl(m, 63); btot = __shfl(sacc, 63);
}

__device__ __forceinline__ void ph3_chunk_local(const P& p, int bid, int nb, char* smem) {
  bf16_t* Vs = (bf16_t*)smem;
  bf16_t* Ks = Vs + 128 * VLD;
  float* fa = (float*)(Ks + 128 * VLD);
  float *igf = fa, *lff = fa + 128, *igb = fa + 256, *lfb = fa + 384, *ef = fa + 512, *eb = fa + 640, *scal = fa + 768;
  const int tid = threadIdx.x & 255, lane = tid & 63, wave = tid >> 6, lr = lane & 15, lq = lane >> 4;
  const int trips3 = (576 + nb - 1) / nb;
  for (int k3 = 0; k3 < trips3; ++k3) {
    const int u = bid + k3 * nb;
    if (u >= 576) { __syncthreads(); __syncthreads(); __syncthreads(); continue; }
    const UnitInfo ui = decode_unit(u);
    const int h = ui.h;
    if (tid < 128) {
      const float* g = p.gates + (size_t)(ui.row0 + tid) * 16;
      igf[tid] = g[h] + p.b_gates[h];
      lff[tid] = logsig_f(g[4 + h] + p.b_gates[4 + h]);
      igb[tid] = g[8 + h] + p.b_gates[8 + h];
      lfb[tid] = logsig_f(g[12 + h] + p.b_gates[12 + h]);
    }
    {
      const int dch = tid & 15, colq = h * 128 + dch * 8, colk = 512 + colq;
#pragma unroll 1
      for (int which = 0; which < 2; ++which) {
        if (which == 1 && ui.isctx) break;
        const int col = which == 0 ? colk : colq;
        float w0[8], w1[8], w2[8], bb[8];
#pragma unroll
        for (int i = 0; i < 8; ++i) { w0[i] = p.conv_w[col + i]; w1[i] = p.conv_w[1024 + col + i]; w2[i] = p.conv_w[2048 + col + i]; bb[i] = p.conv_b[col + i]; }
        const float scl = which == 0 ? 0.08838834764831845f : 1.f;
#pragma unroll 1
        for (int ib = 0; ib < 8; ib += 4) {
        u32x4 r0a[4], r1a[4], r2a[4];
#pragma unroll
        for (int i2 = 0; i2 < 4; ++i2) {
          const int t = (tid >> 4) + (ib + i2) * 16, tt = ui.c * 128 + t;
          const bf16_t* base = p.pl + (size_t)(ui.row0 + t) * LDP + col;
          const u32x4 z4 = (u32x4){0u, 0u, 0u, 0u};
          r1a[i2] = *(const u32x4*)base;
          r0a[i2] = tt > 0 ? *(const u32x4*)(base - LDP) : z4;
          r2a[i2] = tt + 1 < ui.T ? *(const u32x4*)(base + LDP) : z4;
        }
#pragma unroll
        for (int i2 = 0; i2 < 4; ++i2) {
          const int t = (tid >> 4) + (ib + i2) * 16;
          const u32x4 r0 = r0a[i2], r1 = r1a[i2], r2 = r2a[i2];
          float y[8];
#pragma unroll
          for (int q = 0; q < 4; ++q) {
            y[2 * q] = silu_f(bb[2 * q] + blo(r0[q]) * w0[2 * q] + blo(r1[q]) * w1[2 * q] + blo(r2[q]) * w2[2 * q]) * scl;
            y[2 * q + 1] = silu_f(bb[2 * q + 1] + bhi(r0[q]) * w0[2 * q + 1] + bhi(r1[q]) * w1[2 * q + 1] + bhi(r2[q]) * w2[2 * q + 1]) * scl;
          }
          u32x4 o;
#pragma unroll
          for (int q = 0; q < 4; ++q) o[q] = cvt_pk_bf16(y[2 * q], y[2 * q + 1]);
          if (which == 0) *(u32x4*)(Ks + t * VLD + dch * 8) = o;
          if (!ui.isctx) ustore4c(mk_rsrc(p.hn), ((ui.row0 + t) * 1024 + col) * 2, o);
        }
        }
      }
#pragma unroll
      for (int i = 0; i < 8; ++i) {
        const int t = (tid >> 4) + i * 16;
        *(u32x4*)(Vs + t * VLD + dch * 8) = *(const u32x4*)(p.pl + (size_t)(ui.row0 + t) * LDP + 1024 + h * 128 + dch * 8);
      }
    }
    __syncthreads();
    if (wave == 0) {
      float G, bt, ga, gb2;
      scan128<false>(lff, igf, nullptr, nullptr, nullptr, G, bt, lane, ga, gb2);
      ef[2 * lane] = __expf(ga - G); ef[2 * lane + 1] = __expf(gb2 - G);
      if (lane == 0) { scal[0] = G; scal[1] = bt; }
    } else if (wave == 1) {
      float G, bt, ga, gb2;
      scan128<true>(lfb, igb, nullptr, nullptr, nullptr, G, bt, lane, ga, gb2);
      eb[127 - 2 * lane] = __expf(ga - G); eb[126 - 2 * lane] = __expf(gb2 - G);
      if (lane == 0) { scal[2] = G; scal[3] = bt; }
    }
    __syncthreads();
#pragma unroll 1
    for (int dir = 0; dir < 2; ++dir) {
      const float* ee = dir ? eb : ef;
      f32x4 acc[2][8];
#pragma unroll
      for (int m = 0; m < 2; ++m)
#pragma unroll
        for (int j = 0; j < 8; ++j) acc[m][j] = (f32x4){0.f, 0.f, 0.f, 0.f};
#pragma unroll
      for (int kk = 0; kk < 4; ++kk) {
        const f32x4 e0 = *(const f32x4*)(ee + kk * 32 + lq * 8), e1 = *(const f32x4*)(ee + kk * 32 + lq * 8 + 4);
        bf16x8 af[2];
#pragma unroll
        for (int m = 0; m < 2; ++m) {
          const bf16x8 raw = frag_tr(Vs, VLD, kk * 32, wave * 32 + m * 16, lr, lq);
          const u32x4 ru = __builtin_bit_cast(u32x4, raw);
          u32x4 sc;
          sc[0] = cvt_pk_bf16(blo(ru[0]) * e0[0], bhi(ru[0]) * e0[1]);
          sc[1] = cvt_pk_bf16(blo(ru[1]) * e0[2], bhi(ru[1]) * e0[3]);
          sc[2] = cvt_pk_bf16(blo(ru[2]) * e1[0], bhi(ru[2]) * e1[1]);
          sc[3] = cvt_pk_bf16(blo(ru[3]) * e1[2], bhi(ru[3]) * e1[3]);
          af[m] = __builtin_bit_cast(bf16x8, sc);
        }
#pragma unroll
        for (int j = 0; j < 8; ++j) {
          const bf16x8 bfr = frag_tr(Ks, VLD, kk * 32, j * 16, lr, lq);
#pragma unroll
          for (int m = 0; m < 2; ++m) acc[m][j] = __builtin_amdgcn_mfma_f32_16x16x32_bf16(af[m], bfr, acc[m][j], 0, 0, 0);
        }
      }
      bf16_t* Dd = p.Dst + (size_t)(u * 2 + dir) * 16384;
#pragma unroll
      for (int m = 0; m < 2; ++m)
#pragma unroll
        for (int j = 0; j < 8; ++j)
#pragma unroll
          for (int e = 0; e < 4; ++e) Dd[(wave * 32 + m * 16 + lq * 4 + e) * 128 + j * 16 + lr] = f2bf(acc[m][j][e]);
    }
    {
      const int dir = tid >> 7, k = tid & 127;
      const float* e = dir ? eb : ef;
      float sacc = 0.f;
      for (int t = 0; t < 128; ++t) sacc += e[t] * bf2f(Ks[t * VLD + k]);
      p.ND[(size_t)(u * 2 + dir) * 128 + k] = sacc;
    }
    if (tid < 4) p.SC[(size_t)(u * 2 + (tid >> 1)) * 32 + (tid & 1)] = scal[tid];
    __syncthreads();
  }
}

__device__ __forceinline__ void ph4_scan(const P& p, int bid, int nb) {
  const int tid = threadIdx.x & 255;
  const __amdgpu_buffer_rsrc_t r_d = mk_rsrc(p.Dst), r_sc = mk_rsrc(p.SC), r_nd = mk_rsrc(p.ND);
  for (int it = bid; it < 1024; it += nb) {
    const int combo = it >> 4, vblk = it & 15;
    const int b = combo >> 3, h = (combo >> 1) & 3, dir = combo & 1;
    const int v = vblk * 8 + (tid >> 5), k0 = (tid & 31) * 4;
    const bool nrow = vblk == 0 && tid < 128;
    u32x2 dd[18]; float Gs[18], bs[18], nds[18];
#pragma unroll
    for (int i = 0; i < 18; ++i) {
      int u;
      if (i < 2) { const int cc = dir == 0 ? i : 1 - i; u = 512 + b * 8 + cc * 4 + h; }
      else { const int lc = i - 2, c = dir == 0 ? lc : 15 - lc; u = b * 64 + c * 4 + h; }
      const int di = u * 2 + dir;
      Gs[i] = fload1c(r_sc, di * 128, 0); bs[i] = fload1c(r_sc, di * 128 + 4, 0);
      dd[i] = uload2c(r_d, (di * 16384 + v * 128 + k0) * 2, 0);
      nds[i] = nrow ? fload1c(r_nd, (di * 128 + tid) * 4, 0) : 0.f;
    }
    float C0 = 0.f, C1 = 0.f, C2 = 0.f, C3 = 0.f, nacc = 0.f, m = 0.f;
#pragma unroll
    for (int i = 0; i < 18; ++i) {
      if (i >= 2) {
        const int lc = i - 2, c = dir == 0 ? lc : 15 - lc;
        const int u = b * 64 + c * 4 + h;
        const size_t ci = (size_t)u * 2 + dir;
        uint2 o;
        o.x = (unsigned)f2bf(C0) | ((unsigned)f2bf(C1) << 16);
        o.y = (unsigned)f2bf(C2) | ((unsigned)f2bf(C3) << 16);
        *(uint2*)(p.CIN + ci * 16384 + v * 128 + k0) = o;
        if (nrow) p.NIN[ci * 128 + tid] = nacc;
        if (vblk == 0 && tid == 0) p.MIN_[ci * 32] = m;
      }
      const float G = Gs[i], bend = bs[i];
      const float Mx = fmaxf(m, G);
      const float dec = __expf(m - Mx), inj = __expf(G - Mx);
      const u32x2 d2 = dd[i];
      C0 = dec * C0 + inj * __uint_as_float(d2.x << 16);
      C1 = dec * C1 + inj * __uint_as_float(d2.x & 0xffff0000u);
      C2 = dec * C2 + inj * __uint_as_float(d2.y << 16);
      C3 = dec * C3 + inj * __uint_as_float(d2.y & 0xffff0000u);
      nacc = dec * nacc + inj * nds[i];
      m = bend + Mx;
    }
  }
}

__device__ __forceinline__ void ph5_mlstm_out(const P& p, int bid, int nb, char* smem) {
  bf16_t* Vs = (bf16_t*)smem;
  bf16_t* Pw = Vs + 128 * VLD;
  float* fa = (float*)(Pw + 4 * 16 * VLD);
  float *igf = fa, *lff = fa + 128, *igb = fa + 256, *lfb = fa + 384, *gf = fa + 512, *gb = fa + 640, *bfw = fa + 768, *bbw = fa + 896,
        *pmf = fa + 1024, *pmb = fa + 1152, *nq = fa + 1280  ;
  const int tid = threadIdx.x & 255, lane = tid & 63, wave = tid >> 6, lr = lane & 15, lq = lane >> 4;
  const int trips5 = (1536 + nb - 1) / nb;
  for (int k5 = 0; k5 < trips5; ++k5) {
    const int it = (bid + k5 * nb) % 1536;
    if (it < 512) {
      const int u = it;
      const UnitInfo ui = decode_unit(u);
      const int h = ui.h;
      const size_t cif = (size_t)u * 2, cib = (size_t)u * 2 + 1;
      if (tid < 128) {
        const float* g = p.gates + (size_t)(ui.row0 + tid) * 16;
        igf[tid] = g[h] + p.b_gates[h];
        lff[tid] = logsig_f(g[4 + h] + p.b_gates[4 + h]);
        igb[tid] = g[8 + h] + p.b_gates[8 + h];
        lfb[tid] = logsig_f(g[12 + h] + p.b_gates[12 + h]);
      }
      {
        const int dch = tid & 15;
#pragma unroll
        for (int i = 0; i < 8; ++i) {
          const int t = (tid >> 4) + i * 16;
          *(u32x4*)(Vs + t * VLD + dch * 8) = *(const u32x4*)(p.pl + (size_t)(ui.row0 + t) * LDP + 1024 + h * 128 + dch * 8);
        }
      }
      {
        const int dir = tid >> 7, t = tid & 127;
        const __amdgpu_buffer_rsrc_t r_hq = mk_rsrc(p.hn);
        const int qoff = ((ui.row0 + t) * 1024 + h * 128) * 2;
        const float* nin = p.NIN + (dir ? cib : cif) * 128;
        float sacc = 0.f;
#pragma unroll 4
        for (int c8 = 0; c8 < 16; ++c8) {
          const u32x4 qv = uload4c(r_hq, qoff + c8 * 16, 0);
#pragma unroll
          for (int q = 0; q < 4; ++q) sacc += blo(qv[q]) * nin[c8 * 8 + 2 * q] + bhi(qv[q]) * nin[c8 * 8 + 2 * q + 1];
        }
        nq[dir * 128 + t] = sacc;
      }
      __syncthreads();
      if (wave == 0) { float G, bt, ga, gb2; scan128<false>(lff, igf, bfw, gf, pmf, G, bt, lane, ga, gb2); }
      else if (wave == 1) { float G, bt, ga, gb2; scan128<true>(lfb, igb, bbw, gb, pmb, G, bt, lane, ga, gb2); }
      __syncthreads();
      const float minf_ = p.MIN_[cif * 32], minb_ = p.MIN_[cib * 32];
      bf16_t* Pme = Pw + wave * 16 * VLD;
      const __amdgpu_buffer_rsrc_t r_hn = mk_rsrc(p.hn), r_cin = mk_rsrc(p.CIN);
      const int fvoff = (lr * 1024 + lq * 8) * 2, cvoff = (lr * 128 + lq * 8) * 2;
#pragma unroll 1
      for (int m = 0; m < 2; ++m) {
        const int t0 = wave * 32 + m * 16;
        bf16x8 Qf[4];
#pragma unroll
        for (int kk = 0; kk < 4; ++kk) Qf[kk] = bload8c(r_hn, fvoff + kk * 64, ((ui.row0 + t0) * 1024 + h * 128) * 2);
        f32x4 S[8];
#pragma unroll
        for (int j = 0; j < 8; ++j) {
          S[j] = (f32x4){0.f, 0.f, 0.f, 0.f};
#pragma unroll
          for (int kk = 0; kk < 4; ++kk) {
            const bf16x8 kf = bload8c(r_hn, fvoff + kk * 64, ((ui.row0 + j * 16) * 1024 + 512 + h * 128) * 2);
            S[j] = __builtin_amdgcn_mfma_f32_16x16x32_bf16(Qf[kk], kf, S[j], 0, 0, 0);
          }
          if (j & 1) __builtin_amdgcn_sched_barrier(0);
        }
        f32x4 hsum[8];
#pragma unroll 1
        for (int dir = 0; dir < 2; ++dir) {
          const float mi = dir ? minb_ : minf_;
          const float* gg = dir ? gb : gf;
          const float* pmx = dir ? pmb : pmf;
          const float* bw = dir ? bbw : bfw;
          float Mrow[4], wi[4];
#pragma unroll
          for (int e = 0; e < 4; ++e) { Mrow[e] = fmaxf(mi, pmx[t0 + lq * 4 + e]); wi[e] = __expf(mi - Mrow[e]); }
          f32x4 acc[8];
#pragma unroll
          for (int jv = 0; jv < 8; ++jv) {
            acc[jv] = (f32x4){0.f, 0.f, 0.f, 0.f};
#pragma unroll
            for (int kk = 0; kk < 4; ++kk) {
              const bf16x8 cf = bload8c(r_cin, cvoff + kk * 64, (int)((dir ? cib : cif) * 32768) + jv * 4096);
              acc[jv] = __builtin_amdgcn_mfma_f32_16x16x32_bf16(Qf[kk], cf, acc[jv], 0, 0, 0);
            }
#pragma unroll
            for (int e = 0; e < 4; ++e) acc[jv][e] *= wi[e];
            if (jv & 1) __builtin_amdgcn_sched_barrier(0);
          }
          float rs[4] = {0.f, 0.f, 0.f, 0.f};
#pragma unroll
          for (int j = 0; j < 8; ++j) {
            const int sidx = j * 16 + lr;
            const float gs = gg[sidx];
#pragma unroll
            for (int e = 0; e < 4; ++e) {
              const int t = t0 + lq * 4 + e;
              const bool keep = dir ? (sidx >= t) : (sidx <= t);
              const float pv = keep ? S[j][e] * __expf(gs - Mrow[e]) : 0.f;
              rs[e] += pv;
              Pme[(lq * 4 + e) * VLD + sidx] = f2bf(pv);
            }
          }
          float den[4];
#pragma unroll
          for (int e = 0; e < 4; ++e) {
            float r = rs[e];
            r += __shfl_xor(r, 1); r += __shfl_xor(r, 2); r += __shfl_xor(r, 4); r += __shfl_xor(r, 8);
            const int t = t0 + lq * 4 + e;
            const float dd = r + wi[e] * nq[dir * 128 + t];
            den[e] = fmaxf(fabsf(dd), __expf(-(bw[t] + Mrow[e])));
          }
          asm volatile("s_waitcnt lgkmcnt(0)" ::: "memory");
          __builtin_amdgcn_wave_barrier();
#pragma unroll
          for (int kk = 0; kk < 4; ++kk) {
            const bf16x8 pf = *(const bf16x8*)(Pme + lr * VLD + kk * 32 + lq * 8);
#pragma unroll
            for (int jv = 0; jv < 8; ++jv) {
              const bf16x8 vf = frag_tr(Vs, VLD, kk * 32, jv * 16, lr, lq);
              acc[jv] = __builtin_amdgcn_mfma_f32_16x16x32_bf16(pf, vf, acc[jv], 0, 0, 0);
            }
          }
          __builtin_amdgcn_wave_barrier();
#pragma unroll
          for (int jv = 0; jv < 8; ++jv)
#pragma unroll
            for (int e = 0; e < 4; ++e) {
              const float hv = acc[jv][e] / den[e];
              if (dir == 0) hsum[jv][e] = hv; else hsum[jv][e] += hv;
            }
        }
#pragma unroll
        for (int e = 0; e < 4; ++e) {
          float sm = 0.f;
#pragma unroll
          for (int jv = 0; jv < 8; ++jv) sm += hsum[jv][e];
          sm += __shfl_xor(sm, 1); sm += __shfl_xor(sm, 2); sm += __shfl_xor(sm, 4); sm += __shfl_xor(sm, 8);
          const float mu = sm * (1.f / 128.f);
          float vs = 0.f;
#pragma unroll
          for (int jv = 0; jv < 8; ++jv) { const float d = hsum[jv][e] - mu; vs += d * d; }
          vs += __shfl_xor(vs, 1); vs += __shfl_xor(vs, 2); vs += __shfl_xor(vs, 4); vs += __shfl_xor(vs, 8);
          const float rstd = rsqrtf(vs * (1.f / 128.f) + 1e-6f);
          const bf16_t* op = p.pl + (size_t)(ui.row0 + t0 + lq * 4 + e) * LDP + 1536 + h * 128;
          bf16_t* mp = p.mix + (size_t)(ui.row0 + t0 + lq * 4 + e) * 1024 + h * 128;
#pragma unroll
          for (int jv = 0; jv < 8; ++jv) {
            const int v = jv * 16 + lr;
            const float o = bf2f(op[v]);
            mp[v] = f2bf((hsum[jv][e] - mu) * rstd * p.head_norm_w[h * 128 + v] / (1.f + __expf(-o)));
          }
        }
      }
      __syncthreads();
    } else {
      const int pu = it - 512, grp = pu >> 2, g = pu & 3;
      float* us = (float*)smem;
      bf16_t* db = (bf16_t*)(us + 8192);
      const int w = 2 << g;
      const size_t rbase = (size_t)grp * 64;
      for (int idx = tid; idx < 1024; idx += NTHR) {
        const int t = idx >> 4, ch = idx & 15;
        const u32x4 r = *(const u32x4*)(p.pl + (rbase + t) * LDP + 2048 + g * 128 + ch * 8);
        float* d = us + t * 128 + ch * 8;
#pragma unroll
        for (int q = 0; q < 4; ++q) { d[2 * q] = blo(r[q]); d[2 * q + 1] = bhi(r[q]); }
      }
      __syncthreads();
      for (int idx = tid; idx < 8192; idx += NTHR) {
        const int t = idx >> 7, i = idx & 127;
        int lo = t - w / 2, hi = t - w / 2 + w;
        lo = lo < 0 ? 0 : lo; hi = hi > 64 ? 64 : hi;
        float sacc = 0.f;
        for (int j = lo; j < hi; ++j) sacc += us[j * 128 + i];
        db[t * VLD + i] = f2bf(sacc / (float)(hi - lo) - us[idx]);
      }
      __syncthreads();
      {
        const bf16_t* wt = (const bf16_t*)((const char*)p.keys_bf + 524288) + g * 16384;
        bf16x8 af[4];
#pragma unroll
        for (int kk = 0; kk < 4; ++kk) af[kk] = *(const bf16x8*)(db + (wave * 16 + lr) * VLD + kk * 32 + lq * 8);
#pragma unroll
        for (int j = 0; j < 8; ++j) {
          f32x4 acc = (f32x4){0.f, 0.f, 0.f, 0.f};
#pragma unroll
          for (int kk = 0; kk < 4; ++kk) {
            const bf16x8 bfr = *(const bf16x8*)(wt + (j * 16 + lr) * 128 + kk * 32 + lq * 8);
            acc = __builtin_amdgcn_mfma_f32_16x16x32_bf16(af[kk], bfr, acc, 0, 0, 0);
          }
          const float ps = p.pool_scale[g * 128 + j * 16 + lr];
#pragma unroll
          for (int e = 0; e < 4; ++e) p.mix[(rbase + wave * 16 + lq * 4 + e) * 1024 + 512 + g * 128 + j * 16 + lr] = f2bf(acc[e] * ps);
        }
      }
      __syncthreads();
    }
  }
}

#define SORT16(X) do { unsigned h_, l_; h_ = X[0] > X[1] ? X[0] : X[1]; l_ = X[0] > X[1] ? X[1] : X[0]; X[0] = h_; X[1] = l_; h_ = X[3] > X[2] ? X[3] : X[2]; l_ = X[3] > X[2] ? X[2] : X[3]; X[3] = h_; X[2] = l_; h_ = X[4] > X[5] ? X[4] : X[5]; l_ = X[4] > X[5] ? X[5] : X[4]; X[4] = h_; X[5] = l_; h_ = X[7] > X[6] ? X[7] : X[6]; l_ = X[7] > X[6] ? X[6] : X[7]; X[7] = h_; X[6] = l_; h_ = X[8] > X[9] ? X[8] : X[9]; l_ = X[8] > X[9] ? X[9] : X[8]; X[8] = h_; X[9] = l_; h_ = X[11] > X[10] ? X[11] : X[10]; l_ = X[11] > X[10] ? X[10] : X[11]; X[11] = h_; X[10] = l_; h_ = X[12] > X[13] ? X[12] : X[13]; l_ = X[12] > X[13] ? X[13] : X[12]; X[12] = h_; X[13] = l_; h_ = X[15] > X[14] ? X[15] : X[14]; l_ = X[15] > X[14] ? X[14] : X[15]; X[15] = h_; X[14] = l_; h_ = X[0] > X[2] ? X[0] : X[2]; l_ = X[0] > X[2] ? X[2] : X[0]; X[0] = h_; X[2] = l_; h_ = X[1] > X[3] ? X[1] : X[3]; l_ = X[1] > X[3] ? X[3] : X[1]; X[1] = h_; X[3] = l_; h_ = X[6] > X[4] ? X[6] : X[4]; l_ = X[6] > X[4] ? X[4] : X[6]; X[6] = h_; X[4] = l_; h_ = X[7] > X[5] ? X[7] : X[5]; l_ = X[7] > X[5] ? X[5] : X[7]; X[7] = h_; X[5] = l_; h_ = X[8] > X[10] ? X[8] : X[10]; l_ = X[8] > X[10] ? X[10] : X[8]; X[8] = h_; X[10] = l_; h_ = X[9] > X[11] ? X[9] : X[11]; l_ = X[9] > X[11] ? X[11] : X[9]; X[9] = h_; X[11] = l_; h_ = X[14] > X[12] ? X[14] : X[12]; l_ = X[14] > X[12] ? X[12] : X[14]; X[14] = h_; X[12] = l_; h_ = X[15] > X[13] ? X[15] : X[13]; l_ = X[15] > X[13] ? X[13] : X[15]; X[15] = h_; X[13] = l_; h_ = X[0] > X[1] ? X[0] : X[1]; l_ = X[0] > X[1] ? X[1] : X[0]; X[0] = h_; X[1] = l_; h_ = X[2] > X[3] ? X[2] : X[3]; l_ = X[2] > X[3] ? X[3] : X[2]; X[2] = h_; X[3] = l_; h_ = X[5] > X[4] ? X[5] : X[4]; l_ = X[5] > X[4] ? X[4] : X[5]; X[5] = h_; X[4] = l_; h_ = X[7] > X[6] ? X[7] : X[6]; l_ = X[7] > X[6] ? X[6] : X[7]; X[7] = h_; X[6] = l_; h_ = X[8] > X[9] ? X[8] : X[9]; l_ = X[8] > X[9] ? X[9] : X[8]; X[8] = h_; X[9] = l_; h_ = X[10] > X[11] ? X[10] : X[11]; l_ = X[10] > X[11] ? X[11] : X[10]; X[10] = h_; X[11] = l_; h_ = X[13] > X[12] ? X[13] : X[12]; l_ = X[13] > X[12] ? X[12] : X[13]; X[13] = h_; X[12] = l_; h_ = X[15] > X[14] ? X[15] : X[14]; l_ = X[15] > X[14] ? X[14] : X[15]; X[15] = h_; X[14] = l_; h_ = X[0] > X[4] ? X[0] : X[4]; l_ = X[0] > X[4] ? X[4] : X[0]; X[0] = h_; X[4] = l_; h_ = X[1] > X[5] ? X[1] : X[5]; l_ = X[1] > X[5] ? X[5] : X[1]; X[1] = h_; X[5] = l_; h_ = X[2] > X[6] ? X[2] : X[6]; l_ = X[2] > X[6] ? X[6] : X[2]; X[2] = h_; X[6] = l_; h_ = X[3] > X[7] ? X[3] : X[7]; l_ = X[3] > X[7] ? X[7] : X[3]; X[3] = h_; X[7] = l_; h_ = X[12] > X[8] ? X[12] : X[8]; l_ = X[12] > X[8] ? X[8] : X[12]; X[12] = h_; X[8] = l_; h_ = X[13] > X[9] ? X[13] : X[9]; l_ = X[13] > X[9] ? X[9] : X[13]; X[13] = h_; X[9] = l_; h_ = X[14] > X[10] ? X[14] : X[10]; l_ = X[14] > X[10] ? X[10] : X[14]; X[14] = h_; X[10] = l_; h_ = X[15] > X[11] ? X[15] : X[11]; l_ = X[15] > X[11] ? X[11] : X[15]; X[15] = h_; X[11] = l_; h_ = X[0] > X[2] ? X[0] : X[2]; l_ = X[0] > X[2] ? X[2] : X[0]; X[0] = h_; X[2] = l_; h_ = X[1] > X[3] ? X[1] : X[3]; l_ = X[1] > X[3] ? X[3] : X[1]; X[1] = h_; X[3] = l_; h_ = X[4] > X[6] ? X[4] : X[6]; l_ = X[4] > X[6] ? X[6] : X[4]; X[4] = h_; X[6] = l_; h_ = X[5] > X[7] ? X[5] : X[7]; l_ = X[5] > X[7] ? X[7] : X[5]; X[5] = h_; X[7] = l_; h_ = X[10] > X[8] ? X[10] : X[8]; l_ = X[10] > X[8] ? X[8] : X[10]; X[10] = h_; X[8] = l_; h_ = X[11] > X[9] ? X[11] : X[9]; l_ = X[11] > X[9] ? X[9] : X[11]; X[11] = h_; X[9] = l_; h_ = X[14] > X[12] ? X[14] : X[12]; l_ = X[14] > X[12] ? X[12] : X[14]; X[14] = h_; X[12] = l_; h_ = X[15] > X[13] ? X[15] : X[13]; l_ = X[15] > X[13] ? X[13] : X[15]; X[15] = h_; X[13] = l_; h_ = X[0] > X[1] ? X[0] : X[1]; l_ = X[0] > X[1] ? X[1] : X[0]; X[0] = h_; X[1] = l_; h_ = X[2] > X[3] ? X[2] : X[3]; l_ = X[2] > X[3] ? X[3] : X[2]; X[2] = h_; X[3] = l_; h_ = X[4] > X[5] ? X[4] : X[5]; l_ = X[4] > X[5] ? X[5] : X[4]; X[4] = h_; X[5] = l_; h_ = X[6] > X[7] ? X[6] : X[7]; l_ = X[6] > X[7] ? X[7] : X[6]; X[6] = h_; X[7] = l_; h_ = X[9] > X[8] ? X[9] : X[8]; l_ = X[9] > X[8] ? X[8] : X[9]; X[9] = h_; X[8] = l_; h_ = X[11] > X[10] ? X[11] : X[10]; l_ = X[11] > X[10] ? X[10] : X[11]; X[11] = h_; X[10] = l_; h_ = X[13] > X[12] ? X[13] : X[12]; l_ = X[13] > X[12] ? X[12] : X[13]; X[13] = h_; X[12] = l_; h_ = X[15] > X[14] ? X[15] : X[14]; l_ = X[15] > X[14] ? X[14] : X[15]; X[15] = h_; X[14] = l_; h_ = X[0] > X[8] ? X[0] : X[8]; l_ = X[0] > X[8] ? X[8] : X[0]; X[0] = h_; X[8] = l_; h_ = X[1] > X[9] ? X[1] : X[9]; l_ = X[1] > X[9] ? X[9] : X[1]; X[1] = h_; X[9] = l_; h_ = X[2] > X[10] ? X[2] : X[10]; l_ = X[2] > X[10] ? X[10] : X[2]; X[2] = h_; X[10] = l_; h_ = X[3] > X[11] ? X[3] : X[11]; l_ = X[3] > X[11] ? X[11] : X[3]; X[3] = h_; X[11] = l_; h_ = X[4] > X[12] ? X[4] : X[12]; l_ = X[4] > X[12] ? X[12] : X[4]; X[4] = h_; X[12] = l_; h_ = X[5] > X[13] ? X[5] : X[13]; l_ = X[5] > X[13] ? X[13] : X[5]; X[5] = h_; X[13] = l_; h_ = X[6] > X[14] ? X[6] : X[14]; l_ = X[6] > X[14] ? X[14] : X[6]; X[6] = h_; X[14] = l_; h_ = X[7] > X[15] ? X[7] : X[15]; l_ = X[7] > X[15] ? X[15] : X[7]; X[7] = h_; X[15] = l_; h_ = X[0] > X[4] ? X[0] : X[4]; l_ = X[0] > X[4] ? X[4] : X[0]; X[0] = h_; X[4] = l_; h_ = X[1] > X[5] ? X[1] : X[5]; l_ = X[1] > X[5] ? X[5] : X[1]; X[1] = h_; X[5] = l_; h_ = X[2] > X[6] ? X[2] : X[6]; l_ = X[2] > X[6] ? X[6] : X[2]; X[2] = h_; X[6] = l_; h_ = X[3] > X[7] ? X[3] : X[7]; l_ = X[3] > X[7] ? X[7] : X[3]; X[3] = h_; X[7] = l_; h_ = X[8] > X[12] ? X[8] : X[12]; l_ = X[8] > X[12] ? X[12] : X[8]; X[8] = h_; X[12] = l_; h_ = X[9] > X[13] ? X[9] : X[13]; l_ = X[9] > X[13] ? X[13] : X[9]; X[9] = h_; X[13] = l_; h_ = X[10] > X[14] ? X[10] : X[14]; l_ = X[10] > X[14] ? X[14] : X[10]; X[10] = h_; X[14] = l_; h_ = X[11] > X[15] ? X[11] : X[15]; l_ = X[11] > X[15] ? X[15] : X[11]; X[11] = h_; X[15] = l_; h_ = X[0] > X[2] ? X[0] : X[2]; l_ = X[0] > X[2] ? X[2] : X[0]; X[0] = h_; X[2] = l_; h_ = X[1] > X[3] ? X[1] : X[3]; l_ = X[1] > X[3] ? X[3] : X[1]; X[1] = h_; X[3] = l_; h_ = X[4] > X[6] ? X[4] : X[6]; l_ = X[4] > X[6] ? X[6] : X[4]; X[4] = h_; X[6] = l_; h_ = X[5] > X[7] ? X[5] : X[7]; l_ = X[5] > X[7] ? X[7] : X[5]; X[5] = h_; X[7] = l_; h_ = X[8] > X[10] ? X[8] : X[10]; l_ = X[8] > X[10] ? X[10] : X[8]; X[8] = h_; X[10] = l_; h_ = X[9] > X[11] ? X[9] : X[11]; l_ = X[9] > X[11] ? X[11] : X[9]; X[9] = h_; X[11] = l_; h_ = X[12] > X[14] ? X[12] : X[14]; l_ = X[12] > X[14] ? X[14] : X[12]; X[12] = h_; X[14] = l_; h_ = X[13] > X[15] ? X[13] : X[15]; l_ = X[13] > X[15] ? X[15] : X[13]; X[13] = h_; X[15] = l_; h_ = X[0] > X[1] ? X[0] : X[1]; l_ = X[0] > X[1] ? X[1] : X[0]; X[0] = h_; X[1] = l_; h_ = X[2] > X[3] ? X[2] : X[3]; l_ = X[2] > X[3] ? X[3] : X[2]; X[2] = h_; X[3] = l_; h_ = X[4] > X[5] ? X[4] : X[5]; l_ = X[4] > X[5] ? X[5] : X[4]; X[4] = h_; X[5] = l_; h_ = X[6] > X[7] ? X[6] : X[7]; l_ = X[6] > X[7] ? X[7] : X[6]; X[6] = h_; X[7] = l_; h_ = X[8] > X[9] ? X[8] : X[9]; l_ = X[8] > X[9] ? X[9] : X[8]; X[8] = h_; X[9] = l_; h_ = X[10] > X[11] ? X[10] : X[11]; l_ = X[10] > X[11] ? X[11] : X[10]; X[10] = h_; X[11] = l_; h_ = X[12] > X[13] ? X[12] : X[13]; l_ = X[12] > X[13] ? X[13] : X[12]; X[12] = h_; X[13] = l_; h_ = X[14] > X[15] ? X[14] : X[15]; l_ = X[14] > X[15] ? X[15] : X[14]; X[14] = h_; X[15] = l_; } while (0)
#define MERGE16(X) do { unsigned h_, l_; h_ = X[0] > X[8] ? X[0] : X[8]; l_ = X[0] > X[8] ? X[8] : X[0]; X[0] = h_; X[8] = l_; h_ = X[1] > X[9] ? X[1] : X[9]; l_ = X[1] > X[9] ? X[9] : X[1]; X[1] = h_; X[9] = l_; h_ = X[2] > X[10] ? X[2] : X[10]; l_ = X[2] > X[10] ? X[10] : X[2]; X[2] = h_; X[10] = l_; h_ = X[3] > X[11] ? X[3] : X[11]; l_ = X[3] > X[11] ? X[11] : X[3]; X[3] = h_; X[11] = l_; h_ = X[4] > X[12] ? X[4] : X[12]; l_ = X[4] > X[12] ? X[12] : X[4]; X[4] = h_; X[12] = l_; h_ = X[5] > X[13] ? X[5] : X[13]; l_ = X[5] > X[13] ? X[13] : X[5]; X[5] = h_; X[13] = l_; h_ = X[6] > X[14] ? X[6] : X[14]; l_ = X[6] > X[14] ? X[14] : X[6]; X[6] = h_; X[14] = l_; h_ = X[7] > X[15] ? X[7] : X[15]; l_ = X[7] > X[15] ? X[15] : X[7]; X[7] = h_; X[15] = l_; h_ = X[0] > X[4] ? X[0] : X[4]; l_ = X[0] > X[4] ? X[4] : X[0]; X[0] = h_; X[4] = l_; h_ = X[1] > X[5] ? X[1] : X[5]; l_ = X[1] > X[5] ? X[5] : X[1]; X[1] = h_; X[5] = l_; h_ = X[2] > X[6] ? X[2] : X[6]; l_ = X[2] > X[6] ? X[6] : X[2]; X[2] = h_; X[6] = l_; h_ = X[3] > X[7] ? X[3] : X[7]; l_ = X[3] > X[7] ? X[7] : X[3]; X[3] = h_; X[7] = l_; h_ = X[8] > X[12] ? X[8] : X[12]; l_ = X[8] > X[12] ? X[12] : X[8]; X[8] = h_; X[12] = l_; h_ = X[9] > X[13] ? X[9] : X[13]; l_ = X[9] > X[13] ? X[13] : X[9]; X[9] = h_; X[13] = l_; h_ = X[10] > X[14] ? X[10] : X[14]; l_ = X[10] > X[14] ? X[14] : X[10]; X[10] = h_; X[14] = l_; h_ = X[11] > X[15] ? X[11] : X[15]; l_ = X[11] > X[15] ? X[15] : X[11]; X[11] = h_; X[15] = l_; h_ = X[0] > X[2] ? X[0] : X[2]; l_ = X[0] > X[2] ? X[2] : X[0]; X[0] = h_; X[2] = l_; h_ = X[1] > X[3] ? X[1] : X[3]; l_ = X[1] > X[3] ? X[3] : X[1]; X[1] = h_; X[3] = l_; h_ = X[4] > X[6] ? X[4] : X[6]; l_ = X[4] > X[6] ? X[6] : X[4]; X[4] = h_; X[6] = l_; h_ = X[5] > X[7] ? X[5] : X[7]; l_ = X[5] > X[7] ? X[7] : X[5]; X[5] = h_; X[7] = l_; h_ = X[8] > X[10] ? X[8] : X[10]; l_ = X[8] > X[10] ? X[10] : X[8]; X[8] = h_; X[10] = l_; h_ = X[9] > X[11] ? X[9] : X[11]; l_ = X[9] > X[11] ? X[11] : X[9]; X[9] = h_; X[11] = l_; h_ = X[12] > X[14] ? X[12] : X[14]; l_ = X[12] > X[14] ? X[14] : X[12]; X[12] = h_; X[14] = l_; h_ = X[13] > X[15] ? X[13] : X[15]; l_ = X[13] > X[15] ? X[15] : X[13]; X[13] = h_; X[15] = l_; h_ = X[0] > X[1] ? X[0] : X[1]; l_ = X[0] > X[1] ? X[1] : X[0]; X[0] = h_; X[1] = l_; h_ = X[2] > X[3] ? X[2] : X[3]; l_ = X[2] > X[3] ? X[3] : X[2]; X[2] = h_; X[3] = l_; h_ = X[4] > X[5] ? X[4] : X[5]; l_ = X[4] > X[5] ? X[5] : X[4]; X[4] = h_; X[5] = l_; h_ = X[6] > X[7] ? X[6] : X[7]; l_ = X[6] > X[7] ? X[7] : X[6]; X[6] = h_; X[7] = l_; h_ = X[8] > X[9] ? X[8] : X[9]; l_ = X[8] > X[9] ? X[9] : X[8]; X[8] = h_; X[9] = l_; h_ = X[10] > X[11] ? X[10] : X[11]; l_ = X[10] > X[11] ? X[11] : X[10]; X[10] = h_; X[11] = l_; h_ = X[12] > X[13] ? X[12] : X[13]; l_ = X[12] > X[13] ? X[13] : X[12]; X[12] = h_; X[13] = l_; h_ = X[14] > X[15] ? X[14] : X[15]; l_ = X[14] > X[15] ? X[15] : X[14]; X[14] = h_; X[15] = l_; } while (0)

__device__ __forceinline__ unsigned f2ord(float f) { const unsigned u = __float_as_uint(f); return (u & 0x80000000u) ? ~u : (u | 0x80000000u); }
__device__ __forceinline__ float ord2f(unsigned o) { return __uint_as_float((o & 0x80000000u) ? (o & 0x7fffffffu) : ~o); }
#define CANDKEY(sum, c) ((f2ord(sum) & ~255u) | (255u - (unsigned)(c)))
__device__ __forceinline__ void xmerge16(unsigned (&X)[16], int mask) {
  unsigned T[16];
#pragma unroll
  for (int i = 0; i < 16; ++i) T[i] = (unsigned)__shfl_xor((int)X[15 - i], mask);
#pragma unroll
  for (int i = 0; i < 16; ++i) X[i] = X[i] > T[i] ? X[i] : T[i];
  MERGE16(X);
}

__device__ __forceinline__ void ph9_topk(const P& p, int bid, int nb, char* smem) {
  const int tid = threadIdx.x & 255, lane = tid & 63, wave = tid >> 6, lr = lane & 15, lq = lane >> 4;
  bf16_t* kl = (bf16_t*)smem;
  int* idxs = (int*)(smem + 65536) + wave * 512;
  const int h = ((bid >> 1) & 3) * 2 + (bid & 1), nper = nb >> 3, wgi = bid >> 3;
  for (int idx = tid; idx < 4096; idx += NTHR) {
    const int row = idx >> 4, c = idx & 15;
    *(u32x4*)(kl + row * 128 + ((c ^ (row & 15)) << 3)) = *(const u32x4*)(p.keys_bf + (size_t)h * 32768 + row * 128 + c * 8);
  }
  __syncthreads();
  const __amdgpu_buffer_rsrc_t r_q = mk_rsrc(p.qb);
  bf16x8 bq[4];
#pragma unroll
  for (int kk = 0; kk < 4; ++kk) bq[kk] = bload8c(r_q, (lr * 2048 + lq * 8) * 2 + kk * 64, ((wgi * 4 + wave) * 16 * 2048 + h * 256) * 2);
  for (int tile = wgi * 4 + wave; tile < 1024; tile += nper * 4) {
    const int tok = tile * 16 + lr;
    unsigned R0[16], R1[16];
#pragma unroll
    for (int pp = 0; pp < 2; ++pp) {
      bf16x8 bn[4];
      {
        const int ntile = pp == 0 ? tile : (tile + nper * 4 < 1024 ? tile + nper * 4 : tile);
#pragma unroll
        for (int kk = 0; kk < 4; ++kk) bn[kk] = bload8c(r_q, (lr * 2048 + lq * 8) * 2 + kk * 64, (ntile * 16 * 2048 + h * 256 + (pp ^ 1) * 128) * 2);
      }
      f32x4 acc[8];
#pragma unroll
      for (int j = 0; j < 8; ++j) acc[j] = (f32x4){0.f, 0.f, 0.f, 0.f};
#pragma unroll
      for (int j = 0; j < 8; ++j)
#pragma unroll
        for (int kk = 0; kk < 4; ++kk) {
          const bf16x8 a = *(const bf16x8*)(kl + (pp * 128 + j * 16 + lr) * 128 + (((kk * 4 + lq) ^ lr) << 3));
          acc[j] = __builtin_amdgcn_mfma_f32_16x16x32_bf16(a, bq[kk], acc[j], 0, 0, 0);
        }
      unsigned X[16], Y[16];
#pragma unroll
      for (int j = 0; j < 4; ++j)
#pragma unroll
        for (int e = 0; e < 4; ++e) {
          X[j * 4 + e] = (f2ord(acc[j][e]) & ~127u) | (127u - (unsigned)(j * 16 + lq * 4 + e));
          Y[j * 4 + e] = (f2ord(acc[4 + j][e]) & ~127u) | (127u - (unsigned)((4 + j) * 16 + lq * 4 + e));
        }
      SORT16(X);
      SORT16(Y);
#pragma unroll
      for (int i = 0; i < 16; ++i) X[i] = X[i] > Y[15 - i] ? X[i] : Y[15 - i];
      MERGE16(X);
      xmerge16(X, 16);
      xmerge16(X, 32);
#pragma unroll
      for (int i = 0; i < 16; ++i) { if (pp == 0) R0[i] = X[i]; else R1[i] = X[i]; }
#pragma unroll
      for (int kk = 0; kk < 4; ++kk) bq[kk] = bn[kk];
    }
    if (lq == 0) {
#pragma unroll
      for (int i = 0; i < 16; ++i) { idxs[lr * 32 + i] = 127 - (int)(R0[i] & 127u); idxs[lr * 32 + 16 + i] = 127 - (int)(R1[i] & 127u); }
    }
    asm volatile("s_waitcnt lgkmcnt(0)" ::: "memory");
    float va[16], vb[16];
#pragma unroll
    for (int i = 0; i < 16; ++i) { va[i] = ord2f(R0[i] & ~127u); vb[i] = ord2f(R1[i] & ~127u); }
    unsigned F[16];
  F[0] = lq == 0 ? CANDKEY(va[0] + vb[0], 0) : (lq == 1 ? CANDKEY(va[1] + vb[0], 16) : (lq == 2 ? CANDKEY(va[3] + vb[0], 48) : CANDKEY(va[13] + vb[0], 208)));
  F[1] = lq == 0 ? CANDKEY(va[0] + vb[1], 1) : (lq == 1 ? CANDKEY(va[1] + vb[1], 17) : (lq == 2 ? CANDKEY(va[3] + vb[1], 49) : CANDKEY(va[14] + vb[0], 224)));
  F[2] = lq == 0 ? CANDKEY(va[0] + vb[2], 2) : (lq == 1 ? CANDKEY(va[1] + vb[2], 18) : (lq == 2 ? CANDKEY(va[3] + vb[2], 50) : CANDKEY(va[15] + vb[0], 240)));
  F[3] = lq == 0 ? CANDKEY(va[0] + vb[3], 3) : (lq == 1 ? CANDKEY(va[1] + vb[3], 19) : (lq == 2 ? CANDKEY(va[3] + vb[3], 51) : 0u));
  F[4] = lq == 0 ? CANDKEY(va[0] + vb[4], 4) : (lq == 1 ? CANDKEY(va[1] + vb[4], 20) : (lq == 2 ? CANDKEY(va[4] + vb[0], 64) : 0u));
  F[5] = lq == 0 ? CANDKEY(va[0] + vb[5], 5) : (lq == 1 ? CANDKEY(va[1] + vb[5], 21) : (lq == 2 ? CANDKEY(va[4] + vb[1], 65) : 0u));
  F[6] = lq == 0 ? CANDKEY(va[0] + vb[6], 6) : (lq == 1 ? CANDKEY(va[1] + vb[6], 22) : (lq == 2 ? CANDKEY(va[4] + vb[2], 66) : 0u));
  F[7] = lq == 0 ? CANDKEY(va[0] + vb[7], 7) : (lq == 1 ? CANDKEY(va[1] + vb[7], 23) : (lq == 2 ? CANDKEY(va[6] + vb[0], 96) : 0u));
  F[8] = lq == 0 ? CANDKEY(va[0] + vb[8], 8) : (lq == 1 ? CANDKEY(va[2] + vb[0], 32) : (lq == 2 ? CANDKEY(va[6] + vb[1], 97) : 0u));
  F[9] = lq == 0 ? CANDKEY(va[0] + vb[9], 9) : (lq == 1 ? CANDKEY(va[2] + vb[1], 33) : (lq == 2 ? CANDKEY(va[7] + vb[0], 112) : 0u));
  F[10] = lq == 0 ? CANDKEY(va[0] + vb[10], 10) : (lq == 1 ? CANDKEY(va[2] + vb[2], 34) : (lq == 2 ? CANDKEY(va[7] + vb[1], 113) : 0u));
  F[11] = lq == 0 ? CANDKEY(va[0] + vb[11], 11) : (lq == 1 ? CANDKEY(va[2] + vb[3], 35) : (lq == 2 ? CANDKEY(va[8] + vb[0], 128) : 0u));
  F[12] = lq == 0 ? CANDKEY(va[0] + vb[12], 12) : (lq == 1 ? CANDKEY(va[2] + vb[4], 36) : (lq == 2 ? CANDKEY(va[9] + vb[0], 144) : 0u));
  F[13] = lq == 0 ? CANDKEY(va[0] + vb[13], 13) : (lq == 1 ? CANDKEY(va[5] + vb[0], 80) : (lq == 2 ? CANDKEY(va[10] + vb[0], 160) : 0u));
  F[14] = lq == 0 ? CANDKEY(va[0] + vb[14], 14) : (lq == 1 ? CANDKEY(va[5] + vb[1], 81) : (lq == 2 ? CANDKEY(va[11] + vb[0], 176) : 0u));
  F[15] = lq == 0 ? CANDKEY(va[0] + vb[15], 15) : (lq == 1 ? 0u : (lq == 2 ? CANDKEY(va[12] + vb[0], 192) : 0u));

    SORT16(F);
    xmerge16(F, 16);
    xmerge16(F, 32);
    if (lq == 0) {
      float ev[16];
      const float mx = ord2f(F[0] & ~255u);
      float tot = 0.f;
#pragma unroll
      for (int r = 0; r < 16; ++r) { ev[r] = __expf(ord2f(F[r] & ~255u) - mx); tot += ev[r]; }
      const float inv = 1.f / tot;
      int ei[16];
#pragma unroll
      for (int r = 0; r < 16; ++r) {
        const int c = 255 - (int)(F[r] & 255u);
        ei[r] = idxs[lr * 32 + (c >> 4)] * 128 + idxs[lr * 32 + 16 + (c & 15)];
      }
      unsigned short* ep = p.eidx + (size_t)tok * 128 + h * 16;
      float* gp = p.gate + (size_t)tok * 128 + h * 16;
#pragma unroll
      for (int r = 0; r < 4; ++r) {
        *(f32x4*)(gp + r * 4) = (f32x4){ev[r * 4] * inv, ev[r * 4 + 1] * inv, ev[r * 4 + 2] * inv, ev[r * 4 + 3] * inv};
      }
#pragma unroll
      for (int r = 0; r < 2; ++r)
        *(u32x4*)(ep + r * 8) = (u32x4){(unsigned)ei[r * 8] | ((unsigned)ei[r * 8 + 1] << 16), (unsigned)ei[r * 8 + 2] | ((unsigned)ei[r * 8 + 3] << 16),
                                         (unsigned)ei[r * 8 + 4] | ((unsigned)ei[r * 8 + 5] << 16), (unsigned)ei[r * 8 + 6] | ((unsigned)ei[r * 8 + 7] << 16)};
    }
  }
}

__device__ __forceinline__ void ph_convert_tables(const P& p, int bid, int nb) {
  const int wave = (threadIdx.x >> 6) & 3, lane = threadIdx.x & 63;
  for (int row = bid * 4 + wave; row < 32768; row += nb * 4) {
    const bool isu = row < 16384;
    const float* src = isu ? p.U + (size_t)row * 1024 : p.V + (size_t)(row - 16384) * 1024;
    unsigned char* dst = isu ? p.U8 + (size_t)row * 1024 : p.V8 + (size_t)(row - 16384) * 1024;
    const float sc = isu ? 512.f : 32.f;
#pragma unroll
    for (int j = 0; j < 4; ++j) {
      const f32x4 v = __builtin_nontemporal_load((const f32x4*)src + j * 64 + lane);
      int w = 0;
      w = __builtin_amdgcn_cvt_pk_fp8_f32(v.x * sc, v.y * sc, w, false);
      w = __builtin_amdgcn_cvt_pk_fp8_f32(v.z * sc, v.w * sc, w, true);
      *(int*)(dst + j * 256 + lane * 4) = w;
    }
  }
}

__device__ __forceinline__ float gelu_exact(float a) { return 0.5f * a * (1.f + erff(a * 0.70710678118654752f)); }

#define G_LOAD(buf, j, g_) do { const int g__ = (g_); const int er__ = (g__ & 8) ? e1s[j] : e0s[j]; \
    _Pragma("unroll") for (int k = 0; k < 8; ++k) { const int e__ = __builtin_amdgcn_readlane(er__, (g__ & 7) * 8 + k); \
      buf[k] = *((const u32x4*)(tab + (size_t)e__ * 1024) + lane); } } while (0)
#define G_COMPUTE_U(buf, j, g_) do { const int g__ = (g_); \
      float pp[8]; \
      _Pragma("unroll") for (int k = 0; k < 8; ++k) { \
        f32x2 ac = {0.f, 0.f}; \
        _Pragma("unroll") for (int d = 0; d < 4; ++d) { \
          ac = __builtin_amdgcn_cvt_pk_f32_fp8((int)buf[k][d], false) * x2[j][2 * d] + ac; \
          ac = __builtin_amdgcn_cvt_pk_f32_fp8((int)buf[k][d], true) * x2[j][2 * d + 1] + ac; } \
        pp[k] = ac.x + ac.y; } \
        \
      float q4[4], r2[2], tt; \
      _Pragma("unroll") for (int i = 0; i < 4; ++i) { const float sd = b5 ? pp[i] : pp[i + 4]; q4[i] = (b5 ? pp[i + 4] : pp[i]) + __shfl_xor(sd, 32); } \
      _Pragma("unroll") for (int i = 0; i < 2; ++i) { const float sd = b4 ? q4[i] : q4[i + 2]; r2[i] = (b4 ? q4[i + 2] : q4[i]) + __shfl_xor(sd, 16); } \
      { const float sd = b3 ? r2[0] : r2[1]; tt = (b3 ? r2[1] : r2[0]) + __shfl_xor(sd, 8); } \
      tt += __shfl_xor(tt, 4); tt += __shfl_xor(tt, 2); tt += __shfl_xor(tt, 1); \
      const float dv = __shfl(tt, (lane & 7) * 8); \
      if ((lane >> 3) == (g__ & 7)) { if (g__ & 8) a1[j] = dv; else a0[j] = dv; } } while (0)
#define G_COMPUTE_V(buf, j, g_) do { const int g__ = (g_); \
      const int wr__ = __float_as_int((g__ & 8) ? w1s[j] : w0s[j]); \
      _Pragma("unroll") for (int k = 0; k < 8; ++k) { \
        const float w__ = __int_as_float(__builtin_amdgcn_readlane(wr__, (g__ & 7) * 8 + k)); \
        const f32x2 ww = {w__, w__}; \
        _Pragma("unroll") for (int d = 0; d < 4; ++d) { \
          y2[j][2 * d] = __builtin_amdgcn_cvt_pk_f32_fp8((int)buf[k][d], false) * ww + y2[j][2 * d]; \
          y2[j][2 * d + 1] = __builtin_amdgcn_cvt_pk_f32_fp8((int)buf[k][d], true) * ww + y2[j][2 * d + 1]; } } } while (0)
#define G_SWEEP(COMP) do { \
    G_LOAD(A, 0, 0); G_LOAD(B, 1, 0); G_LOAD(C, 0, 1); \
    _Pragma("unroll 1") for (int g = 0; g < 16; g += 2) { \
      const int gn = g + 2 < 16 ? g + 2 : g;              \
      G_LOAD(D, 1, g + 1); COMP(A, 0, g); \
      G_LOAD(A, 0, gn); COMP(B, 1, g); \
      G_LOAD(B, 1, gn); COMP(C, 0, g + 1); \
      G_LOAD(C, 0, gn + 1); COMP(D, 1, g + 1); } } while (0)

__device__ __forceinline__ void ph10_gather(const P& p, int bid, int nb, char* smem) {
  const int wave = __builtin_amdgcn_readfirstlane((threadIdx.x >> 6) & 3), lane = threadIdx.x & 63;
  const bool b5 = lane & 32, b4 = lane & 16, b3 = lane & 8;
  int* se = (int*)(smem + wave * 1024);
  float* sg = (float*)(se + 128);
  for (int oct = bid * 4 + wave; oct < TL / 8; oct += nb * 4) {
#pragma unroll 1
    for (int grp = 0; grp < 4; ++grp) {
      int diag_bad = 0;
      const int tok0 = oct * 8 + grp * 2;
      int e0s[2], e1s[2];
      float g0s[2], g1s[2], a0[2], a1[2], w0s[2], w1s[2];
      f32x2 x2[2][8], y2[2][8];
#pragma unroll
      for (int j = 0; j < 2; ++j) {
        const int tok = tok0 + j;
        const int e0 = (int)p.eidx[(size_t)tok * 128 + lane], e1 = (int)p.eidx[(size_t)tok * 128 + 64 + lane];
        const float g0 = p.gate[(size_t)tok * 128 + lane], g1 = p.gate[(size_t)tok * 128 + 64 + lane];
        {
          const float gs = wave_sum(g0 + g1);
          const bool bad = (e0 < 0) || (e0 > 16383) || (e1 < 0) || (e1 > 16383) || !(fabsf(gs - 8.f) < 1e-2f);
          if (__ballot(bad) != 0ull) diag_bad = 1;
        }
        const int sl0 = e0 >> 10, sl1 = e1 >> 10;
        int base = 0, pos0 = 0, pos1 = 0;
#pragma unroll
        for (int sidx = 0; sidx < 16; ++sidx) {
          const unsigned long long m0 = __ballot(sl0 == sidx), m1 = __ballot(sl1 == sidx);
          const int c0 = __popcll(m0), c1 = __popcll(m1);
          const int r0 = __builtin_amdgcn_mbcnt_hi((unsigned)(m0 >> 32), __builtin_amdgcn_mbcnt_lo((unsigned)m0, 0u));
          const int r1 = __builtin_amdgcn_mbcnt_hi((unsigned)(m1 >> 32), __builtin_amdgcn_mbcnt_lo((unsigned)m1, 0u));
          if (sl0 == sidx) pos0 = base + r0;
          if (sl1 == sidx) pos1 = base + c0 + r1;
          base += c0 + c1;
        }
        asm volatile("s_waitcnt lgkmcnt(0)" ::: "memory");
        se[pos0] = e0; se[pos1] = e1; sg[pos0] = g0; sg[pos1] = g1;
        asm volatile("s_waitcnt lgkmcnt(0)" ::: "memory");
        e0s[j] = se[lane]; e1s[j] = se[64 + lane]; g0s[j] = sg[lane]; g1s[j] = sg[64 + lane];
        asm volatile("s_waitcnt lgkmcnt(0)" ::: "memory");
        const __amdgpu_buffer_rsrc_t r_h2 = mk_rsrc(p.hn);
        const u32x4 h0 = uload4c(r_h2, (tok * 1024 + lane * 16) * 2, 0);
        const u32x4 h1 = uload4c(r_h2, (tok * 1024 + lane * 16 + 8) * 2, 0);
#pragma unroll
        for (int i = 0; i < 4; ++i) { x2[j][i] = (f32x2){blo(h0[i]), bhi(h0[i])}; x2[j][4 + i] = (f32x2){blo(h1[i]), bhi(h1[i])}; }
        a0[j] = 0.f; a1[j] = 0.f;
      }
      u32x4 A[8], B[8], C[8], D[8];
      { const unsigned char* tab = p.U8; G_SWEEP(G_COMPUTE_U); }
#pragma unroll
      for (int j = 0; j < 2; ++j) { w0s[j] = gelu_exact(a0[j] * (1.f / 512.f)) * g0s[j]; w1s[j] = gelu_exact(a1[j] * (1.f / 512.f)) * g1s[j];
#pragma unroll
        for (int i = 0; i < 8; ++i) y2[j][i] = (f32x2){0.f, 0.f}; }
      { const unsigned char* tab = p.V8; G_SWEEP(G_COMPUTE_V); }
#pragma unroll
      for (int j = 0; j < 2; ++j) {
        const int tok = tok0 + j, b = tok / SEQ;
        float* orow = p.out + (size_t)tok * 1024 + lane * 16;
        const float* g2 = p.mod + b * 6144 + 5 * 1024 + lane * 16;
        float z[16];
        float ss = 0.f;
#pragma unroll
        for (int q = 0; q < 4; ++q) {
          const f32x4 xl = fload4c(mk_rsrc(p.out), (tok * 1024 + lane * 16 + q * 4) * 4, 0);
          const f32x4 gg = *(const f32x4*)(g2 + q * 4);
          const float yv[4] = {y2[j][2 * q].x, y2[j][2 * q].y, y2[j][2 * q + 1].x, y2[j][2 * q + 1].y};
#pragma unroll
          for (int i = 0; i < 4; ++i) { const float zz = xl[i] + gg[i] * (yv[i] * (1.f / 32.f)); z[q * 4 + i] = zz; ss += zz * zz; }
        }
        ss = wave_sum(ss);
        const float rstd = rsqrtf(ss * (1.f / 1024.f) + 1e-6f);
#pragma unroll
        for (int q = 0; q < 4; ++q) {
          const f32x4 fw = *(const f32x4*)(p.final_norm_w + lane * 16 + q * 4);
          f32x4 o;
#pragma unroll
          for (int i = 0; i < 4; ++i) o[i] = diag_bad ? __builtin_inff() : z[q * 4 + i] * rstd * fw[i];
          *(f32x4*)(orow + q * 4) = o;
        }
      }
    }
  }
}

__global__ void __launch_bounds__(2 * NTHR, 2) mega(P p) {
  __shared__ __attribute__((aligned(16))) char smem_all[2 * LDS_HALF];
  cg::grid_group grid = cg::this_grid();
  const int half = __builtin_amdgcn_readfirstlane(threadIdx.x >> 8);
  char* smem = smem_all + half * LDS_HALF;
  const int bid = blockIdx.x * 2 + half, nb = gridDim.x * 2;
  int nsync = 0;
  const int bng = (gridDim.x % 8 == 0) ? 8 : 1, bper = gridDim.x / bng, bgrp = blockIdx.x % bng;
  if (blockIdx.x == 0) { p.bar[threadIdx.x] = 0u; for (int i = threadIdx.x; i < (int)gridDim.x * 32; i += 2 * NTHR) p.flg[i] = 0u; }
#ifndef REPEAT_MASK
#define REPEAT_MASK 0
#endif
#ifndef EXTRA_SYNCS
#define EXTRA_SYNCS 0
#endif
#define GSYNC() do { asm volatile("s_waitcnt vmcnt(0)" ::: "memory"); \
    if (nsync == 0) { grid.sync(); } else { __syncthreads(); \
      if (threadIdx.x < 64) { \
        int rel = 0; \
        if (threadIdx.x == 0) { __builtin_amdgcn_fence(__ATOMIC_RELEASE, "agent"); asm volatile("s_waitcnt vmcnt(0)" ::: "memory"); \
          const unsigned old = __hip_atomic_fetch_add(p.bar + bgrp * 32, 1u, __ATOMIC_RELAXED, __HIP_MEMORY_SCOPE_AGENT); \
          if (old + 1u == (unsigned)(nsync * bper)) { \
            const unsigned o2 = __hip_atomic_fetch_add(p.bar + 256, 1u, __ATOMIC_RELAXED, __HIP_MEMORY_SCOPE_AGENT); \
            if (o2 + 1u == (unsigned)(nsync * bng)) rel = 1; } } \
        rel = __builtin_amdgcn_readfirstlane(rel); \
        if (rel) for (int i = threadIdx.x; i < (int)gridDim.x; i += 64) __hip_atomic_store(p.flg + i * 32, (unsigned)nsync, __ATOMIC_RELAXED, __HIP_MEMORY_SCOPE_AGENT); \
        if (threadIdx.x == 0) { \
          while (__hip_atomic_load(p.flg + blockIdx.x * 32, __ATOMIC_RELAXED, __HIP_MEMORY_SCOPE_AGENT) < (unsigned)nsync) __builtin_amdgcn_s_sleep(2); \
          __builtin_amdgcn_fence(__ATOMIC_ACQUIRE, "agent"); asm volatile("s_waitcnt vmcnt(0)" ::: "memory"); } } \
      __syncthreads(); } \
    ++nsync; } while (0)
#define RUN(k, call) if ((PHMASK & (1 << k)) && p.ph_lo <= k && k < p.ph_hi) { call; if (REPEAT_MASK & (1 << k)) { GSYNC(); call; } \
    if (k + 1 < p.ph_hi) { GSYNC(); for (int xs = 0; xs < EXTRA_SYNCS; ++xs) GSYNC(); } }
  RUN(0, ph0_prep(p, bid, nb, smem))
  RUN(1, ph_norm_rows<0>(p, bid, nb))
  RUN(2, ph_gemm8<0>(p, smem_all))
  RUN(3, ph3_chunk_local(p, bid, nb, smem))
  RUN(4, ph4_scan(p, bid, nb))
  RUN(5, ph5_mlstm_out(p, bid, nb, smem))
  RUN(6, (ph_gemm8<1>(p, smem_all), ph_convert_tables(p, bid, nb)))
  RUN(7, ph_norm_rows<1>(p, bid, nb))
  RUN(8, ph_gemm8<2>(p, smem_all))
  RUN(9, ph9_topk(p, bid, nb, smem))
  RUN(10, ph10_gather(p, bid, nb, smem))
#undef RUN
}

extern "C" void kernel_launch(void* const* d_in, const int* in_sizes, int n_in, void* d_out, int out_size, void* d_ws, size_t ws_size,
                              hipStream_t stream) {
  static int grid_blocks = 0;
  if (!grid_blocks) {
    int dev = 0, cus = 0, per_cu = 0;
    hipGetDevice(&dev);
    hipDeviceGetAttribute(&cus, hipDeviceAttributeMultiprocessorCount, dev);
    hipOccupancyMaxActiveBlocksPerMultiprocessor(&per_cu, (const void*)mega, 2 * NTHR, 0);
    per_cu = 1;
    grid_blocks = cus * per_cu;
    if (ws_size < WS_END + 128ull * 1024 || grid_blocks > 1024) fprintf(stderr, "kernel_launch: workspace too small: %zu < %llu\n", ws_size, (unsigned long long)WS_END);
  }
  P p{};
  const float* const* in = (const float* const*)d_in;
  p.x = in[0]; p.c = in[1]; p.ctx = in[2]; p.c_ctx = in[3]; p.w_mod = in[4]; p.b_mod = in[5]; p.norm1_w = in[6]; p.w_in = in[7];
  p.conv_w = in[8]; p.conv_b = in[9]; p.b_gates = in[10]; p.head_norm_w = in[11]; p.pool_w = in[12]; p.pool_scale = in[13];
  p.w_out = in[14]; p.norm2_w = in[15]; p.wq = in[16]; p.keys = in[17]; p.U = in[18]; p.V = in[19]; p.final_norm_w = in[20];
  p.out = (float*)d_out;
  p.bar = (unsigned*)d_ws; p.flg = (unsigned*)((char*)d_ws + WS_END);
  char* ws = (char*)d_ws;
  p.mod = (float*)(ws + OFF_MOD); p.gates = (float*)(ws + OFF_GATES);
  p.wt_in = (bf16_t*)(ws + OFF_WTIN); p.wt_out = (bf16_t*)(ws + OFF_WTOUT); p.wt_q = (bf16_t*)(ws + OFF_WTQ);
  p.keys_bf = (bf16_t*)(ws + OFF_KEYS); p.hn = (bf16_t*)(ws + OFF_HN); p.pl = (bf16_t*)(ws + OFF_PL);
  p.Dst = (bf16_t*)(ws + OFF_D); p.ND = (float*)(ws + OFF_ND); p.SC = (float*)(ws + OFF_SC);
  p.CIN = (bf16_t*)(ws + OFF_CIN); p.NIN = (float*)(ws + OFF_NIN); p.MIN_ = (float*)(ws + OFF_MIN);
  p.mix = (bf16_t*)(ws + OFF_D); p.qb = (bf16_t*)(ws + OFF_D);
  p.U8 = (unsigned char*)(ws + OFF_U8); p.V8 = (unsigned char*)(ws + OFF_U8 + 16777216ull);
  p.eidx = (unsigned short*)(ws + OFF_EIDX); p.gate = (float*)(ws + OFF_GATE);
#if N_LAUNCHES == 1
  p.ph_lo = 0; p.ph_hi = NPH;
  void* args[] = {&p};
  hipError_t e = hipLaunchCooperativeKernel((const void*)mega, dim3(grid_blocks), dim3(2 * NTHR), args, 0, stream);
  if (e != hipSuccess) fprintf(stderr, "cooperative launch failed: %s (grid %d)\n", hipGetErrorString(e), grid_blocks);
#else
  for (int ph = 0; ph < NPH; ++ph) {
    p.ph_lo = ph; p.ph_hi = ph + 1;
    void* args[] = {&p};
    hipError_t e = hipLaunchCooperativeKernel((const void*)mega, dim3(grid_blocks), dim3(2 * NTHR), args, 0, stream);
    if (e != hipSuccess) fprintf(stderr, "launch %d failed: %s (grid %d)\n", ph, hipGetErrorString(e), grid_blocks);
  }
#endif
}
```

```cpp
#include <hip/hip_runtime.h>
#include <hip/hip_cooperative_groups.h>
#include <stdint.h>
#include <stdio.h>
namespace cg = cooperative_groups;

#ifndef PHMASK
#define PHMASK 0x7ff
#endif
#ifndef N_LAUNCHES
#define N_LAUNCHES 1
#endif

typedef unsigned short bf16_t;
typedef short bf16x8 __attribute__((ext_vector_type(8)));
typedef float f32x4 __attribute__((ext_vector_type(4)));
typedef unsigned u32x4 __attribute__((ext_vector_type(4)));
typedef float f32x2 __attribute__((ext_vector_type(2)));
typedef unsigned u32x2 __attribute__((ext_vector_type(2)));
typedef __bf16 bf16x2 __attribute__((ext_vector_type(2)));

#define NB 8
#define SEQ 2048
#define DM 1024
#define CTXL 256
#define TL 16384
#define TC 2048
#define TR 18432
#define LDP 2624
#define NPADIN 2688
#define NTHR 256
#define LDS_HALF 73728
#define NPH 11

#define OFF_MOD    (4096ull)
#define OFF_GATES  (OFF_MOD + 262144ull)
#define OFF_WTIN   (OFF_GATES + 1179648ull)
#define OFF_WTOUT  (OFF_WTIN + 5767168ull)
#define OFF_WTQ    (OFF_WTOUT + 2097152ull)
#define OFF_KEYS   (OFF_WTQ + 4194304ull)
#define OFF_POOLWT (OFF_KEYS + 524288ull)
#define OFF_HN     (OFF_POOLWT + 131072ull)
#define OFF_PL     (OFF_HN + 37748736ull)
#define OFF_D      (OFF_PL + 96731136ull)
#define OFF_ND     (OFF_D + 37748736ull)
#define OFF_SC     (OFF_ND + 589824ull)
#define OFF_CIN    (OFF_SC + 147456ull)
#define OFF_NIN    (OFF_CIN + 33554432ull)
#define OFF_MIN    (OFF_NIN + 524288ull)
#define OFF_EIDX   (OFF_MIN + 131072ull)
#define OFF_GATE   (OFF_EIDX + 4194304ull)
#define OFF_U8     (OFF_GATE + 8388608ull)
#define WS_END     (OFF_U8 + 33554432ull)

struct P {
  const float *x, *c, *ctx, *c_ctx, *w_mod, *b_mod, *norm1_w, *w_in, *conv_w, *conv_b, *b_gates, *head_norm_w,
      *pool_w, *pool_scale, *w_out, *norm2_w, *wq, *keys, *U, *V, *final_norm_w;
  float* out;
  float* mod;
  float* gates;
  bf16_t* wt_in;
  bf16_t* wt_out;
  bf16_t* wt_q;
  bf16_t* keys_bf;
  bf16_t* hn;
  bf16_t* pl;
  bf16_t* Dst;
  float* ND;
  float* SC;
  bf16_t* CIN;
  float* NIN;
  float* MIN_;
  bf16_t* mix;
  bf16_t* qb;
  unsigned char* U8;
  unsigned char* V8;
  unsigned short* eidx;
  float* gate;
  int ph_lo, ph_hi;
  unsigned* flg;
  unsigned* bar;
};

__device__ __forceinline__ bf16_t f2bf(float f) { return __builtin_bit_cast(bf16_t, (__bf16)f); }
__device__ __forceinline__ float bf2f(bf16_t h) { return __uint_as_float(((unsigned)h) << 16); }
__device__ __forceinline__ float wave_sum(float v) {
#pragma unroll
  for (int o = 32; o > 0; o >>= 1) v += __shfl_xor(v, o);
  return v;
}
__device__ __forceinline__ float silu_f(float v) { return v / (1.f + __expf(-v)); }
__device__ __forceinline__ float logsig_f(float v) { return fminf(v, 0.f) - log1pf(__expf(-fabsf(v))); }

__device__ __forceinline__ __amdgpu_buffer_rsrc_t mk_rsrc(const void* ptr) { return __builtin_amdgcn_make_buffer_rsrc((void*)ptr, 0, 0x7fffffff, 0x00020000); }
__device__ __forceinline__ bf16x8 bload8(__amdgpu_buffer_rsrc_t r, int voff, int soff) { return __builtin_bit_cast(bf16x8, __builtin_amdgcn_raw_buffer_load_b128(r, voff, soff, 0)); }
#define AUX_SC1 16
__device__ __forceinline__ bf16x8 bload8c(__amdgpu_buffer_rsrc_t r, int voff, int soff) { return __builtin_bit_cast(bf16x8, __builtin_amdgcn_raw_buffer_load_b128(r, voff, soff, AUX_SC1)); }
__device__ __forceinline__ u32x2 uload2c(__amdgpu_buffer_rsrc_t r, int voff, int soff) { return __builtin_bit_cast(u32x2, __builtin_amdgcn_raw_buffer_load_b64(r, voff, soff, AUX_SC1)); }
__device__ __forceinline__ float fload1c(__amdgpu_buffer_rsrc_t r, int voff, int soff) { return __builtin_bit_cast(float, __builtin_amdgcn_raw_buffer_load_b32(r, voff, soff, AUX_SC1)); }
__device__ __forceinline__ f32x4 fload4c(__amdgpu_buffer_rsrc_t r, int voff, int soff) { return __builtin_bit_cast(f32x4, __builtin_amdgcn_raw_buffer_load_b128(r, voff, soff, AUX_SC1)); }
__device__ __forceinline__ void ustore4c(__amdgpu_buffer_rsrc_t r, int voff, u32x4 v) { __builtin_amdgcn_raw_buffer_store_b128(v, r, voff, 0, AUX_SC1); }
__device__ __forceinline__ void ustore2c(__amdgpu_buffer_rsrc_t r, int voff, u32x2 v) { __builtin_amdgcn_raw_buffer_store_b64(v, r, voff, 0, AUX_SC1); }
__device__ __forceinline__ u32x4 uload4c(__amdgpu_buffer_rsrc_t r, int voff, int soff) { return __builtin_bit_cast(u32x4, __builtin_amdgcn_raw_buffer_load_b128(r, voff, soff, AUX_SC1)); }

__device__ __forceinline__ void ph0_prep(const P& p, int bid, int nb, char* smem) {
  float* sm = (float*)smem;
  const int tid = threadIdx.x & 255;
  const int N_MOD = 384, N_TIN = 16 * 44, N_TOUT = 256, N_TQ = 16 * 32, N_POOL = 16;
  const int total = N_MOD + N_TIN + N_TOUT + N_TQ + N_POOL;
  const int trips = (total + nb - 1) / nb;
  for (int k = 0; k < trips; ++k) {
    int r = (bid + k * nb) % total;
    if (r < N_MOD) {
      float* part = sm + 9 * 1024;
      for (int i = tid; i < 9 * 1024; i += NTHR) {
        int rr = i >> 10, kq = i & 1023;
        float v = rr < 8 ? p.c[rr * 1024 + kq] : p.c_ctx[kq];
        sm[i] = silu_f(v);
      }
      __syncthreads();
      {
        const int c = tid & 15, kg = tid >> 4, n = r * 16 + c;
        float acc[9];
#pragma unroll
        for (int q = 0; q < 9; ++q) acc[q] = 0.f;
#pragma unroll 8
        for (int i = 0; i < 64; ++i) {
          const int kq = kg + i * 16;
          const float w = p.w_mod[(size_t)kq * 6144 + n];
#pragma unroll
          for (int q = 0; q < 9; ++q) acc[q] += sm[q * 1024 + kq] * w;
        }
#pragma unroll
        for (int q = 0; q < 9; ++q) part[(kg * 9 + q) * 16 + c] = acc[q];
      }
      __syncthreads();
      if (tid < 144) {
        const int q = tid >> 4, c = tid & 15, n = r * 16 + c;
        float t = p.b_mod[n];
#pragma unroll
        for (int kg = 0; kg < 16; ++kg) t += part[(kg * 9 + q) * 16 + c];
        p.mod[q * 6144 + n] = t;
      }
      continue;
    }
    r -= N_MOD;
    const float* src = nullptr; bf16_t* dst = nullptr; int K = 1024, N = 0, ntn = 0;
    if (r < N_TIN) { src = p.w_in; dst = p.wt_in; N = 2576; ntn = 44; }
    else { r -= N_TIN;
      if (r < N_TOUT) { src = p.w_out; dst = p.wt_out; N = 1024; ntn = 16; }
      else { r -= N_TOUT;
        if (r < N_TQ) { src = p.wq; dst = p.wt_q; N = 2048; ntn = 32; }
        else { r -= N_TQ; int g = r >> 2; r &= 3; src = p.pool_w + g * 16384; dst = (bf16_t*)((char*)p.keys_bf + 524288) + g * 16384; K = 128; N = 128; ntn = 2; }
      }
    }
    {
      int kt = r / ntn, nt = r % ntn, k0 = kt * 64, n0 = nt * 64;
      int cc = tid & 63;
      for (int rr = tid >> 6; rr < 64; rr += 4) {
        int n = n0 + cc;
        sm[rr * 65 + cc] = n < N ? src[(size_t)(k0 + rr) * N + n] : 0.f;
      }
      __syncthreads();
      for (int rr = tid >> 6; rr < 64; rr += 4) dst[(size_t)(n0 + rr) * K + k0 + cc] = f2bf(sm[cc * 65 + rr]);
      __syncthreads();
    }
  }
  for (int i = bid * NTHR + tid; i < 262144; i += nb * NTHR) p.keys_bf[i] = f2bf(p.keys[i]);
}

template <int WHICH>
__device__ __forceinline__ void ph_norm_rows(const P& p, int bid, int nb) {
  const int wave = (threadIdx.x >> 6) & 3, lane = threadIdx.x & 63;
  const int nrows = WHICH == 0 ? TR : TL;
  for (int row = bid * 4 + wave; row < nrows; row += nb * 4) {
    const float* src = WHICH == 0 ? (row < TL ? p.x + (size_t)row * 1024 : p.ctx + (size_t)(row - TL) * 1024) : p.out + (size_t)row * 1024;
    const int mr = row < TL ? row / SEQ : 8;
    float4 v[4];
    float ss = 0.f;
#pragma unroll
    for (int j = 0; j < 4; ++j) {
      if (WHICH == 1) { const f32x4 t = fload4c(mk_rsrc(p.out), (row * 1024 + (j * 64 + lane) * 4) * 4, 0); v[j] = make_float4(t[0], t[1], t[2], t[3]); }
      else v[j] = ((const float4*)src)[j * 64 + lane];
      ss += v[j].x * v[j].x + v[j].y * v[j].y + v[j].z * v[j].z + v[j].w * v[j].w;
    }
    ss = wave_sum(ss);
    const float rstd = rsqrtf(ss * (1.f / 1024.f) + 1e-6f);
    const float* nw = WHICH == 0 ? p.norm1_w : p.norm2_w;
    const float* sh = p.mod + mr * 6144 + (WHICH == 0 ? 0 : 3) * 1024;
    const float* sc = sh + 1024;
#pragma unroll
    for (int j = 0; j < 4; ++j) {
      const int col = j * 256 + lane * 4;
      float4 w4 = *(const float4*)(nw + col), s4 = *(const float4*)(sh + col), c4 = *(const float4*)(sc + col);
      float y0 = v[j].x * rstd * w4.x * (1.f + c4.x) + s4.x;
      float y1 = v[j].y * rstd * w4.y * (1.f + c4.y) + s4.y;
      float y2 = v[j].z * rstd * w4.z * (1.f + c4.z) + s4.z;
      float y3 = v[j].w * rstd * w4.w * (1.f + c4.w) + s4.w;
      uint2 o;
      o.x = (unsigned)f2bf(y0) | ((unsigned)f2bf(y1) << 16);
      o.y = (unsigned)f2bf(y2) | ((unsigned)f2bf(y3) << 16);
      ustore2c(mk_rsrc(p.hn), (row * 1024 + col) * 2, (u32x2){o.x, o.y});
    }
  }
}

#define GBK 64
#define GLD 72
template <int EPI>
__device__ __forceinline__ void gemm_tile(const P& p, const bf16_t* A, int lda, const bf16_t* Bt, int m0, int n0, bf16_t* sA, bf16_t* sB) {
  const int tid = threadIdx.x & 255, lane = tid & 63, wave = tid >> 6;
  const int wm = wave >> 1, wn = wave & 1;
  const int lr = lane & 15, lq = lane >> 4;
  f32x4 acc[4][4];
#pragma unroll
  for (int i = 0; i < 4; ++i)
#pragma unroll
    for (int j = 0; j < 4; ++j) acc[i][j] = (f32x4){0.f, 0.f, 0.f, 0.f};
  const int sr = tid >> 3, scol = (tid & 7) * 8;
  u32x4 ra[4], rb[4];
  const bf16_t* Ap = A + (size_t)(m0 + sr) * lda + scol;
  const bf16_t* Bp = Bt + (size_t)(n0 + sr) * 1024 + scol;
#pragma unroll
  for (int i = 0; i < 4; ++i) {
    ra[i] = *(const u32x4*)(Ap + (size_t)(i * 32) * lda);
    rb[i] = *(const u32x4*)(Bp + (size_t)(i * 32) * 1024);
  }
  for (int kt = 0; kt < 1024 / GBK; ++kt) {
    __syncthreads();
#pragma unroll
    for (int i = 0; i < 4; ++i) {
      *(u32x4*)(sA + (sr + i * 32) * GLD + scol) = ra[i];
      *(u32x4*)(sB + (sr + i * 32) * GLD + scol) = rb[i];
    }
    __syncthreads();
    {
      const int k0 = (kt + 1 < 1024 / GBK ? kt + 1 : kt) * GBK;
#pragma unroll
      for (int i = 0; i < 4; ++i) {
        ra[i] = *(const u32x4*)(Ap + (size_t)(i * 32) * lda + k0);
        rb[i] = *(const u32x4*)(Bp + (size_t)(i * 32) * 1024 + k0);
      }
    }
#pragma unroll
    for (int ks = 0; ks < 2; ++ks) {
      bf16x8 af[4], bfr[4];
#pragma unroll
      for (int i = 0; i < 4; ++i) {
        af[i] = *(const bf16x8*)(sA + (wm * 64 + i * 16 + lr) * GLD + ks * 32 + lq * 8);
        bfr[i] = *(const bf16x8*)(sB + (wn * 64 + i * 16 + lr) * GLD + ks * 32 + lq * 8);
      }
#pragma unroll
      for (int i = 0; i < 4; ++i)
#pragma unroll
        for (int j = 0; j < 4; ++j) acc[i][j] = __builtin_amdgcn_mfma_f32_16x16x32_bf16(af[i], bfr[j], acc[i][j], 0, 0, 0);
    }
  }
#pragma unroll
  for (int i = 0; i < 4; ++i)
#pragma unroll
    for (int j = 0; j < 4; ++j)
#pragma unroll
      for (int e = 0; e < 4; ++e) {
        const int row = m0 + wm * 64 + i * 16 + lq * 4 + e;
        const int col = n0 + wn * 64 + j * 16 + lr;
        const float v = acc[i][j][e];
        if (EPI == 0) {
          if (col < 2560) p.pl[(size_t)row * LDP + col] = f2bf(v);
          else if (col < 2576) p.gates[(size_t)row * 16 + (col - 2560)] = v;
        } else if (EPI == 1) {
          const int b = row / SEQ;
          p.out[(size_t)row * 1024 + col] = p.x[(size_t)row * 1024 + col] + p.mod[b * 6144 + 2 * 1024 + col] * v;
        } else {
          p.qb[(size_t)row * 2048 + col] = f2bf(v);
        }
      }
}

template <int EPI>
__device__ __forceinline__ void ph_gemm(const P& p, int bid, int nb, char* smem) {
  bf16_t* sA = (bf16_t*)smem;
  bf16_t* sB = sA + 128 * GLD;
  const int ntn = EPI == 0 ? 21 : (EPI == 1 ? 8 : 16);
  const int ntm = EPI == 0 ? 144 : 128;
  const bf16_t* A = EPI == 0 ? p.hn : (EPI == 1 ? p.mix : p.hn);
  const int lda = 1024;
  const bf16_t* Bt = EPI == 0 ? p.wt_in : (EPI == 1 ? p.wt_out : p.wt_q);
  const int nlat = 128 * ntn;
  const int ntiles = EPI == 0 ? nlat + 16 * 13 : ntm * ntn;
  const int trips = (ntiles + nb - 1) / nb;
  for (int k = 0; k < trips; ++k) {
    const int t = (bid + k * nb) % ntiles;
    int tm, tn;
    if (EPI == 0 && t >= nlat) { const int r = t - nlat; tm = 128 + r / 13; tn = r % 13; if (tn == 12) tn = 20; }
    else { tm = t / ntn; tn = t % ntn; }
    gemm_tile<EPI>(p, A, lda, Bt, tm * 128, tn * 128, sA, sB);
  }
}

struct UnitInfo { int isctx, b, c, h, T, seqrow0, row0; };
__device__ __forceinline__ UnitInfo decode_unit(int u) {
  UnitInfo r;
  if (u < 512) { r.isctx = 0; r.b = u >> 6; r.c = (u >> 2) & 15; r.h = u & 3; r.T = SEQ; r.seqrow0 = r.b * SEQ; }
  else { int uu = u - 512; r.isctx = 1; r.b = uu >> 3; r.c = (uu >> 2) & 1; r.h = uu & 3; r.T = CTXL; r.seqrow0 = TL + r.b * CTXL; }
  r.row0 = r.seqrow0 + r.c * 128;
  return r;
}
__device__ __forceinline__ float qk_act(const P& p, int seqrow0, int T, int t, int col) {
  const bf16_t* base = p.pl + (size_t)(seqrow0 + t) * LDP + col;
  float r0 = t > 0 ? bf2f(base[-LDP]) : 0.f;
  float r1 = bf2f(base[0]);
  float r2 = t + 1 < T ? bf2f(base[LDP]) : 0.f;
  float y = p.conv_b[col] + r0 * p.conv_w[col] + r1 * p.conv_w[1024 + col] + r2 * p.conv_w[2048 + col];
  return silu_f(y);
}


typedef short s16x4 __attribute__((ext_vector_type(4)));
#define LDS_AS __attribute__((address_space(3)))
__device__ __forceinline__ s16x4 ds_tr16(const bf16_t* ptr) { return __builtin_amdgcn_ds_read_tr16_b64_v4i16((LDS_AS s16x4*)ptr); }
__device__ __forceinline__ bf16x8 frag_tr(const bf16_t* M, int ld, int s0, int c0, int lr, int lq) {
  const bf16_t* a = M + (s0 + lq * 8 + (lr >> 2)) * ld + c0 + (lr & 3) * 4;
  const s16x4 t0 = ds_tr16(a), t1 = ds_tr16(a + 4 * ld);
  return __builtin_shufflevector(t0, t1, 0, 1, 2, 3, 4, 5, 6, 7);
}
__device__ __forceinline__ unsigned cvt_pk_bf16(float lo, float hi) { const f32x2 v = {lo, hi}; const bf16x2 b = __builtin_convertvector(v, bf16x2); return __builtin_bit_cast(unsigned, b); }
__device__ __forceinline__ float blo(unsigned u) { return __uint_as_float(u << 16); }
__device__ __forceinline__ float bhi(unsigned u) { return __uint_as_float(u & 0xffff0000u); }
#define VLD 136


namespace pg8 {
#define PG8_LAS __attribute__((address_space(3)))
constexpr int BM = 256, BK = 64, HALF = 128, HTB = HALF * BK * 2, STAGE_BYTES = 8 * HTB, NXCD = 8, WGM = 8;
__host__ __device__ __forceinline__ int lds_byte(int r, int c) { const int st = (r >> 4) * 2 + (c >> 5), rr = r & 15, cc = c & 31, ob = rr * 64 + cc * 2; return st * 1024 + (ob ^ (((ob >> 9) & 1) << 5)); }
__host__ __device__ __forceinline__ void stage_rc(int b, int& R, int& C) { const int st = b / 1024, sb = b % 1024, swz = sb ^ (((sb >> 9) & 1) << 5); R = (st >> 1) * 16 + swz / 64; C = (st & 1) * 32 + (swz % 64) / 2; }
__host__ __device__ __forceinline__ int perm32(int rho) { const int n = rho >> 4, i = rho & 15; return 8 * (i >> 2) + 4 * n + (i & 3); }
struct Unit { int pm, pn; };
struct Gemm { const bf16_t* A; const bf16_t* Bt; int M, N, K; };
struct Order {
  int nM, nN, nwg, G, c, extra;
  __device__ void init(int nM_, int nN_, int G_, int c_, int extra_) { nM = nM_; nN = nN_; nwg = nM * nN; G = G_; c = c_; extra = extra_; }
  __device__ bool next(int i, Unit& u) const {
    const long L = (long)i * G + c;
    if (L >= nwg + extra) return false;
    if (L >= nwg) { const int r = (int)L - nwg; u.pm = nM + r / 7; const int q = r % 7; u.pn = q < 6 ? q : 10; return true; }
    int wgid = (int)L; { const int q = nwg / NXCD, r = nwg % NXCD, xcd = wgid % NXCD, off = wgid / NXCD; wgid = (xcd < r ? xcd * (q + 1) : r * (q + 1) + (xcd - r) * q) + off; }
    const int nig = WGM * nN, gid = wgid / nig, fm = gid * WGM, gsz = (nM - fm) < WGM ? (nM - fm) : WGM;
    u.pm = fm + ((wgid % nig) % gsz); u.pn = (wgid % nig) / gsz; return true;
  }
  __device__ __forceinline__ void a_ready(const Unit&) const {}
  __device__ __forceinline__ void done(const Unit&) const {}
};
template <class Epi, class Sched>
__device__ __forceinline__ void gemm_phase(PG8_LAS unsigned char* lds, const Gemm g, const Sched& S, const Epi& E) {
    const int tid = threadIdx.x, wid = __builtin_amdgcn_readfirstlane(tid >> 6), lane = tid & 63, wr = wid >> 2, wc = wid & 3, fr = lane & 15, fq = lane >> 4;
    const int K = g.K, nt = K / BK;
    unsigned voffA[2], voffB[2];
#pragma unroll
    for (int i = 0; i < 2; ++i) { int R, C; stage_rc(tid * 16 + i * 8192, R, C); const int Rb = Epi::PERM ? ((R & ~31) + perm32(R & 31)) : R;
        voffA[i] = (unsigned)(R * K + C) * 2u; voffB[i] = (unsigned)(Rb * K + C) * 2u; }
    const size_t kstep = (size_t)(BK * 2);
    const size_t hstep = (size_t)HALF * K * 2;
    const size_t tstep = 2 * hstep;
    const unsigned ldsw = (unsigned)wid * 1024u;
    const int aoff = lds_byte(wr * 64 + fr, fq * 8), boff = lds_byte(wc * 32 + fr, fq * 8);
#define PG8_SA(b, h) (((b) * 2 + (h)) * HTB)
#define PG8_SB(b, h) ((4 + (b) * 2 + (h)) * HTB)
#define PG8_STAGE_X(bufoff, gbase, voff, aux) do { _Pragma("unroll") for (int _i = 0; _i < 2; ++_i) \
        __builtin_amdgcn_global_load_lds((const unsigned*)((const char*)(gbase) + (voff)[_i]), (PG8_LAS unsigned*)(lds + (bufoff) + ldsw + _i * 8192), 16, 0, aux); } while (0)
#define PG8_STAGE(bufoff, gbase, voff) PG8_STAGE_X(bufoff, gbase, voff, 0)
#define PG8_STAGE_A(bufoff, gbase, voff) do { if (Epi::A_COHERENT) PG8_STAGE_X(bufoff, gbase, voff, AUX_SC1); else PG8_STAGE_X(bufoff, gbase, voff, 0); } while (0)
#define PG8_LDA(dst, b, h) do { _Pragma("unroll") for (int m = 0; m < 4; ++m) _Pragma("unroll") for (int k = 0; k < 2; ++k) dst[m][k] = *(const PG8_LAS bf16x8*)(lds + PG8_SA(b, h) + aoff + m * 2048 + k * 1024); } while (0)
#define PG8_LDB(dst, b, h) do { _Pragma("unroll") for (int n = 0; n < 2; ++n) _Pragma("unroll") for (int k = 0; k < 2; ++k) dst[n][k] = *(const PG8_LAS bf16x8*)(lds + PG8_SB(b, h) + boff + n * 2048 + k * 1024); } while (0)
#define PG8_MMA(ai, bj, At, Bt) do { __builtin_amdgcn_s_setprio(1); _Pragma("unroll") for (int m = 0; m < 4; ++m) _Pragma("unroll") for (int n = 0; n < 2; ++n) _Pragma("unroll") for (int k = 0; k < 2; ++k) \
        acc[ai][bj][m][n] = __builtin_amdgcn_mfma_f32_16x16x32_bf16(Bt[n][k], At[m][k], acc[ai][bj][m][n], 0, 0, 0); __builtin_amdgcn_s_setprio(0); } while (0)
#define PG8_WAIT_V(n) asm volatile("s_waitcnt vmcnt(" #n ")" ::: "memory")
#define PG8_WAIT_L(n) asm volatile("s_waitcnt lgkmcnt(" #n ")" ::: "memory")
#define PG8_BAR __builtin_amdgcn_s_barrier()
#define PG8_SCHED __builtin_amdgcn_sched_barrier(0)
    Unit cur, nxt; int ui = 0;
    if (!S.next(0, cur)) return;
    f32x4 acc[2][2][4][2];
#pragma unroll
    for (int a = 0; a < 2; ++a)
#pragma unroll
        for (int b = 0; b < 2; ++b)
#pragma unroll
            for (int m = 0; m < 4; ++m)
#pragma unroll
                for (int n = 0; n < 2; ++n) acc[a][b][m][n] = (f32x4){0.f, 0.f, 0.f, 0.f};
    bf16x8 At[4][2], B0[2][2], B1[2][2];
    const char* cA = (const char*)g.A + (size_t)cur.pm * tstep; const char* cB = (const char*)g.Bt + (size_t)cur.pn * tstep;
    S.a_ready(cur);
    PG8_STAGE(PG8_SB(0, 0), cB, voffB); PG8_STAGE_A(PG8_SA(0, 0), cA, voffA); PG8_STAGE(PG8_SB(0, 1), cB + hstep, voffB); PG8_STAGE_A(PG8_SA(0, 1), cA + hstep, voffA);
    if (wr == 1) PG8_BAR;
    PG8_WAIT_V(4); PG8_BAR;
    PG8_STAGE(PG8_SB(1, 0), cB + kstep, voffB); PG8_STAGE_A(PG8_SA(1, 0), cA + kstep, voffA); PG8_STAGE(PG8_SB(1, 1), cB + hstep + kstep, voffB);
    PG8_WAIT_V(6); PG8_BAR;
    for (;;) {
        const bool has_next = S.next(ui + 1, nxt);
        const char* nA = has_next ? (const char*)g.A + (size_t)nxt.pm * tstep : cA; const char* nB = has_next ? (const char*)g.Bt + (size_t)nxt.pn * tstep : cB;
        for (int t = 0; t < nt; t += 2) {
            const bool last = (t == nt - 2);
            const char* a1 = cA + (size_t)(t + 1) * kstep;
            const char* a2 = last ? nA : cA + (size_t)(t + 2) * kstep; const char* b2 = last ? nB : cB + (size_t)(t + 2) * kstep;
            const char* a3 = a2 + kstep; const char* b3 = b2 + kstep;
            if (last && has_next) S.a_ready(nxt);
            PG8_LDB(B0, 0, 0); PG8_SCHED; PG8_LDA(At, 0, 0); PG8_STAGE_A(PG8_SA(1, 1), a1 + hstep, voffA);
            PG8_WAIT_L(8); PG8_BAR; PG8_WAIT_L(0); PG8_MMA(0, 0, At, B0); PG8_BAR; PG8_SCHED;
            PG8_LDB(B1, 0, 1); PG8_STAGE(PG8_SB(0, 0), b2, voffB);
            PG8_BAR; PG8_WAIT_L(0); PG8_MMA(0, 1, At, B1); PG8_BAR;
            PG8_LDA(At, 0, 1); PG8_STAGE_A(PG8_SA(0, 0), a2, voffA);
            PG8_BAR; PG8_WAIT_L(0); PG8_MMA(1, 0, At, B0); PG8_BAR; PG8_SCHED;
            PG8_STAGE(PG8_SB(0, 1), b2 + hstep, voffB);
            PG8_WAIT_V(6); PG8_BAR; PG8_MMA(1, 1, At, B1); PG8_BAR;
            PG8_LDB(B0, 1, 0); PG8_SCHED; PG8_LDA(At, 1, 0); PG8_STAGE_A(PG8_SA(0, 1), a2 + hstep, voffA);
            PG8_WAIT_L(8); PG8_BAR; PG8_WAIT_L(0); PG8_MMA(0, 0, At, B0); PG8_BAR; PG8_SCHED;
            PG8_LDB(B1, 1, 1); PG8_STAGE(PG8_SB(1, 0), b3, voffB);
            PG8_BAR; PG8_WAIT_L(0); PG8_MMA(0, 1, At, B1); PG8_BAR;
            PG8_LDA(At, 1, 1); PG8_STAGE_A(PG8_SA(1, 0), a3, voffA);
            PG8_BAR; PG8_WAIT_L(0); PG8_MMA(1, 0, At, B0); PG8_BAR; PG8_SCHED;
            PG8_STAGE(PG8_SB(1, 1), b3 + hstep, voffB);
            PG8_WAIT_V(6); PG8_BAR; PG8_MMA(1, 1, At, B1); PG8_BAR;
        }
        if constexpr (!Epi::AFTER_DRAIN) { E(acc, cur, wr, wc, fr, fq); S.done(cur); }
        if (!has_next) break;
#pragma unroll
        for (int a = 0; a < 2; ++a)
#pragma unroll
            for (int b = 0; b < 2; ++b)
#pragma unroll
                for (int m = 0; m < 4; ++m)
#pragma unroll
                    for (int n = 0; n < 2; ++n) acc[a][b][m][n] = (f32x4){0.f, 0.f, 0.f, 0.f};
        cur = nxt; cA = nA; cB = nB; ++ui;
    }
    PG8_WAIT_V(0);
    if (wr == 0) PG8_BAR;
    PG8_BAR;
    if constexpr (Epi::AFTER_DRAIN) { E.fused(acc, cur, wr, wc, fr, fq, lds, wid, lane); S.done(cur); }
#undef PG8_SA
#undef PG8_SB
#undef PG8_STAGE
#undef PG8_LDA
#undef PG8_LDB
#undef PG8_MMA
#undef PG8_WAIT_V
#undef PG8_WAIT_L
#undef PG8_BAR
#undef PG8_SCHED
}
}

struct EpiIn {
  static constexpr bool PERM = true, AFTER_DRAIN = false, A_COHERENT = true;
  bf16_t* pl; float* gates;
  __device__ __forceinline__ void operator()(const f32x4 (&acc)[2][2][4][2], const pg8::Unit& u, int wr, int wc, int fr, int fq) const {
    const int row0 = u.pm * 256 + wr * 64 + fr;
#pragma unroll
    for (int ai = 0; ai < 2; ++ai)
#pragma unroll
      for (int m = 0; m < 4; ++m) {
        const int row = row0 + ai * 128 + m * 16;
#pragma unroll
        for (int bj = 0; bj < 2; ++bj) {
          const int c0 = u.pn * 256 + bj * 128 + wc * 32 + 8 * fq;
          const f32x4 v0 = acc[ai][bj][m][0], v1 = acc[ai][bj][m][1];
          if (c0 < 2560) {
            u32x4 w;
            w[0] = cvt_pk_bf16(v0[0], v0[1]); w[1] = cvt_pk_bf16(v0[2], v0[3]); w[2] = cvt_pk_bf16(v1[0], v1[1]); w[3] = cvt_pk_bf16(v1[2], v1[3]);
            *(u32x4*)(pl + (size_t)row * LDP + c0) = w;
          } else if (c0 < 2576) {
            *(f32x4*)(gates + (size_t)row * 16 + (c0 - 2560)) = v0;
            *(f32x4*)(gates + (size_t)row * 16 + (c0 - 2560) + 4) = v1;
          }
        }
      }
  }
};
struct EpiOut {
  static constexpr bool PERM = false, AFTER_DRAIN = false, A_COHERENT = true;
  const float* x; const float* mod; float* out;
  __device__ __forceinline__ void operator()(const f32x4 (&acc)[2][2][4][2], const pg8::Unit& u, int wr, int wc, int fr, int fq) const {
    const int row0 = u.pm * 256 + wr * 64 + fr, col0 = u.pn * 256 + wc * 32 + 4 * fq;
    const float* g1 = mod + (u.pm * 256 / SEQ) * 6144 + 2 * 1024;
#pragma unroll
    for (int ai = 0; ai < 2; ++ai)
#pragma unroll
      for (int m = 0; m < 4; ++m) {
        const size_t ro = (size_t)(row0 + ai * 128 + m * 16) * 1024;
#pragma unroll
        for (int bj = 0; bj < 2; ++bj)
#pragma unroll
          for (int n = 0; n < 2; ++n) {
            const int c = col0 + bj * 128 + n * 16;
            const f32x4 xv = *(const f32x4*)(x + ro + c), gv = *(const f32x4*)(g1 + c);
            *(f32x4*)(out + ro + c) = xv + gv * acc[ai][bj][m][n];
          }
      }
  }
};
struct EpiQ {
  static constexpr bool PERM = true, AFTER_DRAIN = false, A_COHERENT = true;
  bf16_t* q;
  __device__ __forceinline__ void operator()(const f32x4 (&acc)[2][2][4][2], const pg8::Unit& u, int wr, int wc, int fr, int fq) const {
    const int row0 = u.pm * 256 + wr * 64 + fr;
#pragma unroll
    for (int ai = 0; ai < 2; ++ai)
#pragma unroll
      for (int m = 0; m < 4; ++m)
#pragma unroll
        for (int bj = 0; bj < 2; ++bj) {
          const int c0 = u.pn * 256 + bj * 128 + wc * 32 + 8 * fq;
          const f32x4 v0 = acc[ai][bj][m][0], v1 = acc[ai][bj][m][1];
          u32x4 w;
          w[0] = cvt_pk_bf16(v0[0], v0[1]); w[1] = cvt_pk_bf16(v0[2], v0[3]); w[2] = cvt_pk_bf16(v1[0], v1[1]); w[3] = cvt_pk_bf16(v1[2], v1[3]);
          *(u32x4*)(q + (size_t)(row0 + ai * 128 + m * 16) * 2048 + c0) = w;
        }
  }
};
template <int EPI>
__device__ __forceinline__ void ph_gemm8(const P& p, char* lds_all) {
  PG8_LAS unsigned char* lds = (PG8_LAS unsigned char*)lds_all;
  pg8::Order S;
  if (EPI == 0) {
    S.init(64, 11, gridDim.x, blockIdx.x, 56);
    const pg8::Gemm g{p.hn, p.wt_in, TR, 2816, 1024};
    const EpiIn E{p.pl, p.gates};
    pg8::gemm_phase<EpiIn, pg8::Order>(lds, g, S, E);
  } else if (EPI == 1) {
    S.init(64, 4, gridDim.x, blockIdx.x, 0);
    const pg8::Gemm g{p.mix, p.wt_out, TL, 1024, 1024};
    const EpiOut E{p.x, p.mod, p.out};
    pg8::gemm_phase<EpiOut, pg8::Order>(lds, g, S, E);
  } else {
    S.init(64, 8, gridDim.x, blockIdx.x, 0);
    const pg8::Gemm g{p.hn, p.wt_q, TL, 2048, 1024};
    const EpiQ E{p.qb};
    pg8::gemm_phase<EpiQ, pg8::Order>(lds, g, S, E);
  }
}

template <bool REV>
__device__ __forceinline__ void scan128(const float* lf, const float* ig, float* bout, float* gout, float* pmout, float& Gtot, float& btot, int lane, float& g0o, float& g1o) {
  const int t0 = REV ? 127 - 2 * lane : 2 * lane, t1 = REV ? 126 - 2 * lane : 2 * lane + 1;
  const float v0 = lf[t0], v1 = lf[t1];
  float sacc = v0 + v1;
#pragma unroll
  for (int off = 1; off < 64; off <<= 1) { const float t = __shfl_up(sacc, off); if (lane >= off) sacc += t; }
  const float b1 = sacc, b0 = sacc - v1;
  const float g0 = ig[t0] - b0, g1 = ig[t1] - b1;
  float m = fmaxf(g0, g1);
#pragma unroll
  for (int off = 1; off < 64; off <<= 1) { const float t = __shfl_up(m, off); if (lane >= off) m = fmaxf(m, t); }
  float prev = __shfl_up(m, 1);
  if (lane == 0) prev = -3.0e38f;
  if (bout) { bout[t0] = b0; bout[t1] = b1; }
  if (gout) { gout[t0] = g0; gout[t1] = g1; }
  g0o = g0; g1o = g1;
  if (pmout) { pmout[t0] = fmaxf(prev, g0); pmout[t1] = m; }
  Gtot = __shfl(m, 63); btot = __shfl(sacc, 63);
}

__device__ __forceinline__ void ph3_chunk_local(const P& p, int bid, int nb, char* smem) {
  bf16_t* Vs = (bf16_t*)smem;
  bf16_t* Ks = Vs + 128 * VLD;
  float* fa = (float*)(Ks + 128 * VLD);
  float *igf = fa, *lff = fa + 128, *igb = fa + 256, *lfb = fa + 384, *ef = fa + 512, *eb = fa + 640, *scal = fa + 768;
  const int tid = threadIdx.x & 255, lane = tid & 63, wave = tid >> 6, lr = lane & 15, lq = lane >> 4;
  const int trips3 = (576 + nb - 1) / nb;
  for (int k3 = 0; k3 < trips3; ++k3) {
    const int u = (bid + k3 * nb) % 576;
    const UnitInfo ui = decode_unit(u);
    const int h = ui.h;
    if (tid < 128) {
      const float* g = p.gates + (size_t)(ui.row0 + tid) * 16;
      igf[tid] = g[h] + p.b_gates[h];
      lff[tid] = logsig_f(g[4 + h] + p.b_gates[4 + h]);
      igb[tid] = g[8 + h] + p.b_gates[8 + h];
      lfb[tid] = logsig_f(g[12 + h] + p.b_gates[12 + h]);
    }
    {
      const int dch = tid & 15, colq = h * 128 + dch * 8, colk = 512 + colq;
#pragma unroll 1
      for (int which = 0; which < 2; ++which) {
        if (which == 1 && ui.isctx) break;
        const int col = which == 0 ? colk : colq;
        float w0[8], w1[8], w2[8], bb[8];
#pragma unroll
        for (int i = 0; i < 8; ++i) { w0[i] = p.conv_w[col + i]; w1[i] = p.conv_w[1024 + col + i]; w2[i] = p.conv_w[2048 + col + i]; bb[i] = p.conv_b[col + i]; }
        const float scl = which == 0 ? 0.08838834764831845f : 1.f;
#pragma unroll 1
        for (int ib = 0; ib < 8; ib += 4) {
        u32x4 r0a[4], r1a[4], r2a[4];
#pragma unroll
        for (int i2 = 0; i2 < 4; ++i2) {
          const int t = (tid >> 4) + (ib + i2) * 16, tt = ui.c * 128 + t;
          const bf16_t* base = p.pl + (size_t)(ui.row0 + t) * LDP + col;
          const u32x4 z4 = (u32x4){0u, 0u, 0u, 0u};
          r1a[i2] = *(const u32x4*)base;
          r0a[i2] = tt > 0 ? *(const u32x4*)(base - LDP) : z4;
          r2a[i2] = tt + 1 < ui.T ? *(const u32x4*)(base + LDP) : z4;
        }
#pragma unroll
        for (int i2 = 0; i2 < 4; ++i2) {
          const int t = (tid >> 4) + (ib + i2) * 16;
          const u32x4 r0 = r0a[i2], r1 = r1a[i2], r2 = r2a[i2];
          float y[8];
#pragma unroll
          for (int q = 0; q < 4; ++q) {
            y[2 * q] = silu_f(bb[2 * q] + blo(r0[q]) * w0[2 * q] + blo(r1[q]) * w1[2 * q] + blo(r2[q]) * w2[2 * q]) * scl;
            y[2 * q + 1] = silu_f(bb[2 * q + 1] + bhi(r0[q]) * w0[2 * q + 1] + bhi(r1[q]) * w1[2 * q + 1] + bhi(r2[q]) * w2[2 * q + 1]) * scl;
          }
          u32x4 o;
#pragma unroll
          for (int q = 0; q < 4; ++q) o[q] = cvt_pk_bf16(y[2 * q], y[2 * q + 1]);
          if (which == 0) *(u32x4*)(Ks + t * VLD + dch * 8) = o;
          if (!ui.isctx) ustore4c(mk_rsrc(p.hn), ((ui.row0 + t) * 1024 + col) * 2, o);
        }
        }
      }
#pragma unroll
      for (int i = 0; i < 8; ++i) {
        const int t = (tid >> 4) + i * 16;
        *(u32x4*)(Vs + t * VLD + dch * 8) = *(const u32x4*)(p.pl + (size_t)(ui.row0 + t) * LDP + 1024 + h * 128 + dch * 8);
      }
    }
    __syncthreads();
    if (wave == 0) {
      float G, bt, ga, gb2;
      scan128<false>(lff, igf, nullptr, nullptr, nullptr, G, bt, lane, ga, gb2);
      ef[2 * lane] = __expf(ga - G); ef[2 * lane + 1] = __expf(gb2 - G);
      if (lane == 0) { scal[0] = G; scal[1] = bt; }
    } else if (wave == 1) {
      float G, bt, ga, gb2;
      scan128<true>(lfb, igb, nullptr, nullptr, nullptr, G, bt, lane, ga, gb2);
      eb[127 - 2 * lane] = __expf(ga - G); eb[126 - 2 * lane] = __expf(gb2 - G);
      if (lane == 0) { scal[2] = G; scal[3] = bt; }
    }
    __syncthreads();
#pragma unroll 1
    for (int dir = 0; dir < 2; ++dir) {
      const float* ee = dir ? eb : ef;
      f32x4 acc[2][8];
#pragma unroll
      for (int m = 0; m < 2; ++m)
#pragma unroll
        for (int j = 0; j < 8; ++j) acc[m][j] = (f32x4){0.f, 0.f, 0.f, 0.f};
#pragma unroll
      for (int kk = 0; kk < 4; ++kk) {
        const f32x4 e0 = *(const f32x4*)(ee + kk * 32 + lq * 8), e1 = *(const f32x4*)(ee + kk * 32 + lq * 8 + 4);
        bf16x8 af[2];
#pragma unroll
        for (int m = 0; m < 2; ++m) {
          const bf16x8 raw = frag_tr(Vs, VLD, kk * 32, wave * 32 + m * 16, lr, lq);
          const u32x4 ru = __builtin_bit_cast(u32x4, raw);
          u32x4 sc;
          sc[0] = cvt_pk_bf16(blo(ru[0]) * e0[0], bhi(ru[0]) * e0[1]);
          sc[1] = cvt_pk_bf16(blo(ru[1]) * e0[2], bhi(ru[1]) * e0[3]);
          sc[2] = cvt_pk_bf16(blo(ru[2]) * e1[0], bhi(ru[2]) * e1[1]);
          sc[3] = cvt_pk_bf16(blo(ru[3]) * e1[2], bhi(ru[3]) * e1[3]);
          af[m] = __builtin_bit_cast(bf16x8, sc);
        }
#pragma unroll
        for (int j = 0; j < 8; ++j) {
          const bf16x8 bfr = frag_tr(Ks, VLD, kk * 32, j * 16, lr, lq);
#pragma unroll
          for (int m = 0; m < 2; ++m) acc[m][j] = __builtin_amdgcn_mfma_f32_16x16x32_bf16(af[m], bfr, acc[m][j], 0, 0, 0);
        }
      }
      bf16_t* Dd = p.Dst + (size_t)(u * 2 + dir) * 16384;
#pragma unroll
      for (int m = 0; m < 2; ++m)
#pragma unroll
        for (int j = 0; j < 8; ++j)
#pragma unroll
          for (int e = 0; e < 4; ++e) Dd[(wave * 32 + m * 16 + lq * 4 + e) * 128 + j * 16 + lr] = f2bf(acc[m][j][e]);
    }
    {
      const int dir = tid >> 7, k = tid & 127;
      const float* e = dir ? eb : ef;
      float sacc = 0.f;
      for (int t = 0; t < 128; ++t) sacc += e[t] * bf2f(Ks[t * VLD + k]);
      p.ND[(size_t)(u * 2 + dir) * 128 + k] = sacc;
    }
    if (tid < 4) p.SC[(size_t)(u * 2 + (tid >> 1)) * 32 + (tid & 1)] = scal[tid];
    __syncthreads();
  }
}

__device__ __forceinline__ void ph4_scan(const P& p, int bid, int nb) {
  const int tid = threadIdx.x & 255;
  const __amdgpu_buffer_rsrc_t r_d = mk_rsrc(p.Dst), r_sc = mk_rsrc(p.SC), r_nd = mk_rsrc(p.ND);
  for (int it = bid; it < 1024; it += nb) {
    const int combo = it >> 4, vblk = it & 15;
    const int b = combo >> 3, h = (combo >> 1) & 3, dir = combo & 1;
    const int v = vblk * 8 + (tid >> 5), k0 = (tid & 31) * 4;
    const bool nrow = vblk == 0 && tid < 128;
    u32x2 dd[18]; float Gs[18], bs[18], nds[18];
#pragma unroll
    for (int i = 0; i < 18; ++i) {
      int u;
      if (i < 2) { const int cc = dir == 0 ? i : 1 - i; u = 512 + b * 8 + cc * 4 + h; }
      else { const int lc = i - 2, c = dir == 0 ? lc : 15 - lc; u = b * 64 + c * 4 + h; }
      const int di = u * 2 + dir;
      Gs[i] = fload1c(r_sc, di * 128, 0); bs[i] = fload1c(r_sc, di * 128 + 4, 0);
      dd[i] = uload2c(r_d, (di * 16384 + v * 128 + k0) * 2, 0);
      nds[i] = nrow ? fload1c(r_nd, (di * 128 + tid) * 4, 0) : 0.f;
    }
    float C0 = 0.f, C1 = 0.f, C2 = 0.f, C3 = 0.f, nacc = 0.f, m = 0.f;
#pragma unroll
    for (int i = 0; i < 18; ++i) {
      if (i >= 2) {
        const int lc = i - 2, c = dir == 0 ? lc : 15 - lc;
        const int u = b * 64 + c * 4 + h;
        const size_t ci = (size_t)u * 2 + dir;
        uint2 o;
        o.x = (unsigned)f2bf(C0) | ((unsigned)f2bf(C1) << 16);
        o.y = (unsigned)f2bf(C2) | ((unsigned)f2bf(C3) << 16);
        *(uint2*)(p.CIN + ci * 16384 + v * 128 + k0) = o;
        if (nrow) p.NIN[ci * 128 + tid] = nacc;
        if (vblk == 0 && tid == 0) p.MIN_[ci * 32] = m;
      }
      const float G = Gs[i], bend = bs[i];
      const float Mx = fmaxf(m, G);
      const float dec = __expf(m - Mx), inj = __expf(G - Mx);
      const u32x2 d2 = dd[i];
      C0 = dec * C0 + inj * __uint_as_float(d2.x << 16);
      C1 = dec * C1 + inj * __uint_as_float(d2.x & 0xffff0000u);
      C2 = dec * C2 + inj * __uint_as_float(d2.y << 16);
      C3 = dec * C3 + inj * __uint_as_float(d2.y & 0xffff0000u);
      nacc = dec * nacc + inj * nds[i];
      m = bend + Mx;
    }
  }
}

__device__ __forceinline__ void ph5_mlstm_out(const P& p, int bid, int nb, char* smem) {
  bf16_t* Vs = (bf16_t*)smem;
  bf16_t* Pw = Vs + 128 * VLD;
  float* fa = (float*)(Pw + 4 * 16 * VLD);
  float *igf = fa, *lff = fa + 128, *igb = fa + 256, *lfb = fa + 384, *gf = fa + 512, *gb = fa + 640, *bfw = fa + 768, *bbw = fa + 896,
        *pmf = fa + 1024, *pmb = fa + 1152, *nq = fa + 1280  ;
  const int tid = threadIdx.x & 255, lane = tid & 63, wave = tid >> 6, lr = lane & 15, lq = lane >> 4;
  const int trips5 = (1536 + nb - 1) / nb;
  for (int k5 = 0; k5 < trips5; ++k5) {
    const int it = (bid + k5 * nb) % 1536;
    if (it < 512) {
      const int u = it;
      const UnitInfo ui = decode_unit(u);
      const int h = ui.h;
      const size_t cif = (size_t)u * 2, cib = (size_t)u * 2 + 1;
      if (tid < 128) {
        const float* g = p.gates + (size_t)(ui.row0 + tid) * 16;
        igf[tid] = g[h] + p.b_gates[h];
        lff[tid] = logsig_f(g[4 + h] + p.b_gates[4 + h]);
        igb[tid] = g[8 + h] + p.b_gates[8 + h];
        lfb[tid] = logsig_f(g[12 + h] + p.b_gates[12 + h]);
      }
      {
        const int dch = tid & 15;
#pragma unroll
        for (int i = 0; i < 8; ++i) {
          const int t = (tid >> 4) + i * 16;
          *(u32x4*)(Vs + t * VLD + dch * 8) = *(const u32x4*)(p.pl + (size_t)(ui.row0 + t) * LDP + 1024 + h * 128 + dch * 8);
        }
      }
      {
        const int dir = tid >> 7, t = tid & 127;
        const __amdgpu_buffer_rsrc_t r_hq = mk_rsrc(p.hn);
        const int qoff = ((ui.row0 + t) * 1024 + h * 128) * 2;
        const float* nin = p.NIN + (dir ? cib : cif) * 128;
        float sacc = 0.f;
#pragma unroll 4
        for (int c8 = 0; c8 < 16; ++c8) {
          const u32x4 qv = uload4c(r_hq, qoff + c8 * 16, 0);
#pragma unroll
          for (int q = 0; q < 4; ++q) sacc += blo(qv[q]) * nin[c8 * 8 + 2 * q] + bhi(qv[q]) * nin[c8 * 8 + 2 * q + 1];
        }
        nq[dir * 128 + t] = sacc;
      }
      __syncthreads();
      if (wave == 0) { float G, bt, ga, gb2; scan128<false>(lff, igf, bfw, gf, pmf, G, bt, lane, ga, gb2); }
      else if (wave == 1) { float G, bt, ga, gb2; scan128<true>(lfb, igb, bbw, gb, pmb, G, bt, lane, ga, gb2); }
      __syncthreads();
      const float minf_ = p.MIN_[cif * 32], minb_ = p.MIN_[cib * 32];
      bf16_t* Pme = Pw + wave * 16 * VLD;
      const __amdgpu_buffer_rsrc_t r_hn = mk_rsrc(p.hn), r_cin = mk_rsrc(p.CIN);
      const int fvoff = (lr * 1024 + lq * 8) * 2, cvoff = (lr * 128 + lq * 8) * 2;
#pragma unroll 1
      for (int m = 0; m < 2; ++m) {
        const int t0 = wave * 32 + m * 16;
        bf16x8 Qf[4];
#pragma unroll
        for (int kk = 0; kk < 4; ++kk) Qf[kk] = bload8c(r_hn, fvoff + kk * 64, ((ui.row0 + t0) * 1024 + h * 128) * 2);
        f32x4 S[8];
#pragma unroll
        for (int j = 0; j < 8; ++j) {
          S[j] = (f32x4){0.f, 0.f, 0.f, 0.f};
#pragma unroll
          for (int kk = 0; kk < 4; ++kk) {
            const bf16x8 kf = bload8c(r_hn, fvoff + kk * 64, ((ui.row0 + j * 16) * 1024 + 512 + h * 128) * 2);
            S[j] = __builtin_amdgcn_mfma_f32_16x16x32_bf16(Qf[kk], kf, S[j], 0, 0, 0);
          }
          if (j & 1) __builtin_amdgcn_sched_barrier(0);
        }
        f32x4 hsum[8];
#pragma unroll 1
        for (int dir = 0; dir < 2; ++dir) {
          const float mi = dir ? minb_ : minf_;
          const float* gg = dir ? gb : gf;
          const float* pmx = dir ? pmb : pmf;
          const float* bw = dir ? bbw : bfw;
          float Mrow[4], wi[4];
#pragma unroll
          for (int e = 0; e < 4; ++e) { Mrow[e] = fmaxf(mi, pmx[t0 + lq * 4 + e]); wi[e] = __expf(mi - Mrow[e]); }
          f32x4 acc[8];
#pragma unroll
          for (int jv = 0; jv < 8; ++jv) {
            acc[jv] = (f32x4){0.f, 0.f, 0.f, 0.f};
#pragma unroll
            for (int kk = 0; kk < 4; ++kk) {
              const bf16x8 cf = bload8c(r_cin, cvoff + kk * 64, (int)((dir ? cib : cif) * 32768) + jv * 4096);
              acc[jv] = __builtin_amdgcn_mfma_f32_16x16x32_bf16(Qf[kk], cf, acc[jv], 0, 0, 0);
            }
#pragma unroll
            for (int e = 0; e < 4; ++e) acc[jv][e] *= wi[e];
            if (jv & 1) __builtin_amdgcn_sched_barrier(0);
          }
          float rs[4] = {0.f, 0.f, 0.f, 0.f};
#pragma unroll
          for (int j = 0; j < 8; ++j) {
            const int sidx = j * 16 + lr;
            const float gs = gg[sidx];
#pragma unroll
            for (int e = 0; e < 4; ++e) {
              const int t = t0 + lq * 4 + e;
              const bool keep = dir ? (sidx >= t) : (sidx <= t);
              const float pv = keep ? S[j][e] * __expf(gs - Mrow[e]) : 0.f;
              rs[e] += pv;
              Pme[(lq * 4 + e) * VLD + sidx] = f2bf(pv);
            }
          }
          float den[4];
#pragma unroll
          for (int e = 0; e < 4; ++e) {
            float r = rs[e];
            r += __shfl_xor(r, 1); r += __shfl_xor(r, 2); r += __shfl_xor(r, 4); r += __shfl_xor(r, 8);
            const int t = t0 + lq * 4 + e;
            const float dd = r + wi[e] * nq[dir * 128 + t];
            den[e] = fmaxf(fabsf(dd), __expf(-(bw[t] + Mrow[e])));
          }
          asm volatile("s_waitcnt lgkmcnt(0)" ::: "memory");
          __builtin_amdgcn_wave_barrier();
#pragma unroll
          for (int kk = 0; kk < 4; ++kk) {
            const bf16x8 pf = *(const bf16x8*)(Pme + lr * VLD + kk * 32 + lq * 8);
#pragma unroll
            for (int jv = 0; jv < 8; ++jv) {
              const bf16x8 vf = frag_tr(Vs, VLD, kk * 32, jv * 16, lr, lq);
              acc[jv] = __builtin_amdgcn_mfma_f32_16x16x32_bf16(pf, vf, acc[jv], 0, 0, 0);
            }
          }
          __builtin_amdgcn_wave_barrier();
#pragma unroll
          for (int jv = 0; jv < 8; ++jv)
#pragma unroll
            for (int e = 0; e < 4; ++e) {
              const float hv = acc[jv][e] / den[e];
              if (dir == 0) hsum[jv][e] = hv; else hsum[jv][e] += hv;
            }
        }
#pragma unroll
        for (int e = 0; e < 4; ++e) {
          float sm = 0.f;
#pragma unroll
          for (int jv = 0; jv < 8; ++jv) sm += hsum[jv][e];
          sm += __shfl_xor(sm, 1); sm += __shfl_xor(sm, 2); sm += __shfl_xor(sm, 4); sm += __shfl_xor(sm, 8);
          const float mu = sm * (1.f / 128.f);
          float vs = 0.f;
#pragma unroll
          for (int jv = 0; jv < 8; ++jv) { const float d = hsum[jv][e] - mu; vs += d * d; }
          vs += __shfl_xor(vs, 1); vs += __shfl_xor(vs, 2); vs += __shfl_xor(vs, 4); vs += __shfl_xor(vs, 8);
          const float rstd = rsqrtf(vs * (1.f / 128.f) + 1e-6f);
          const bf16_t* op = p.pl + (size_t)(ui.row0 + t0 + lq * 4 + e) * LDP + 1536 + h * 128;
          bf16_t* mp = p.mix + (size_t)(ui.row0 + t0 + lq * 4 + e) * 1024 + h * 128;
#pragma unroll
          for (int jv = 0; jv < 8; ++jv) {
            const int v = jv * 16 + lr;
            const float o = bf2f(op[v]);
            mp[v] = f2bf((hsum[jv][e] - mu) * rstd * p.head_norm_w[h * 128 + v] / (1.f + __expf(-o)));
          }
        }
      }
      __syncthreads();
    } else {
      const int pu = it - 512, grp = pu >> 2, g = pu & 3;
      float* us = (float*)smem;
      bf16_t* db = (bf16_t*)(us + 8192);
      const int w = 2 << g;
      const size_t rbase = (size_t)grp * 64;
      for (int idx = tid; idx < 1024; idx += NTHR) {
        const int t = idx >> 4, ch = idx & 15;
        const u32x4 r = *(const u32x4*)(p.pl + (rbase + t) * LDP + 2048 + g * 128 + ch * 8);
        float* d = us + t * 128 + ch * 8;
#pragma unroll
        for (int q = 0; q < 4; ++q) { d[2 * q] = blo(r[q]); d[2 * q + 1] = bhi(r[q]); }
      }
      __syncthreads();
      for (int idx = tid; idx < 8192; idx += NTHR) {
        const int t = idx >> 7, i = idx & 127;
        int lo = t - w / 2, hi = t - w / 2 + w;
        lo = lo < 0 ? 0 : lo; hi = hi > 64 ? 64 : hi;
        float sacc = 0.f;
        for (int j = lo; j < hi; ++j) sacc += us[j * 128 + i];
        db[t * VLD + i] = f2bf(sacc / (float)(hi - lo) - us[idx]);
      }
      __syncthreads();
      {
        const bf16_t* wt = (const bf16_t*)((const char*)p.keys_bf + 524288) + g * 16384;
        bf16x8 af[4];
#pragma unroll
        for (int kk = 0; kk < 4; ++kk) af[kk] = *(const bf16x8*)(db + (wave * 16 + lr) * VLD + kk * 32 + lq * 8);
#pragma unroll
        for (int j = 0; j < 8; ++j) {
          f32x4 acc = (f32x4){0.f, 0.f, 0.f, 0.f};
#pragma unroll
          for (int kk = 0; kk < 4; ++kk) {
            const bf16x8 bfr = *(const bf16x8*)(wt + (j * 16 + lr) * 128 + kk * 32 + lq * 8);
            acc = __builtin_amdgcn_mfma_f32_16x16x32_bf16(af[kk], bfr, acc, 0, 0, 0);
          }
          const float ps = p.pool_scale[g * 128 + j * 16 + lr];
#pragma unroll
          for (int e = 0; e < 4; ++e) p.mix[(rbase + wave * 16 + lq * 4 + e) * 1024 + 512 + g * 128 + j * 16 + lr] = f2bf(acc[e] * ps);
        }
      }
      __syncthreads();
    }
  }
}

#define SORT16(X) do { unsigned h_, l_; h_ = X[0] > X[1] ? X[0] : X[1]; l_ = X[0] > X[1] ? X[1] : X[0]; X[0] = h_; X[1] = l_; h_ = X[3] > X[2] ? X[3] : X[2]; l_ = X[3] > X[2] ? X[2] : X[3]; X[3] = h_; X[2] = l_; h_ = X[4] > X[5] ? X[4] : X[5]; l_ = X[4] > X[5] ? X[5] : X[4]; X[4] = h_; X[5] = l_; h_ = X[7] > X[6] ? X[7] : X[6]; l_ = X[7] > X[6] ? X[6] : X[7]; X[7] = h_; X[6] = l_; h_ = X[8] > X[9] ? X[8] : X[9]; l_ = X[8] > X[9] ? X[9] : X[8]; X[8] = h_; X[9] = l_; h_ = X[11] > X[10] ? X[11] : X[10]; l_ = X[11] > X[10] ? X[10] : X[11]; X[11] = h_; X[10] = l_; h_ = X[12] > X[13] ? X[12] : X[13]; l_ = X[12] > X[13] ? X[13] : X[12]; X[12] = h_; X[13] = l_; h_ = X[15] > X[14] ? X[15] : X[14]; l_ = X[15] > X[14] ? X[14] : X[15]; X[15] = h_; X[14] = l_; h_ = X[0] > X[2] ? X[0] : X[2]; l_ = X[0] > X[2] ? X[2] : X[0]; X[0] = h_; X[2] = l_; h_ = X[1] > X[3] ? X[1] : X[3]; l_ = X[1] > X[3] ? X[3] : X[1]; X[1] = h_; X[3] = l_; h_ = X[6] > X[4] ? X[6] : X[4]; l_ = X[6] > X[4] ? X[4] : X[6]; X[6] = h_; X[4] = l_; h_ = X[7] > X[5] ? X[7] : X[5]; l_ = X[7] > X[5] ? X[5] : X[7]; X[7] = h_; X[5] = l_; h_ = X[8] > X[10] ? X[8] : X[10]; l_ = X[8] > X[10] ? X[10] : X[8]; X[8] = h_; X[10] = l_; h_ = X[9] > X[11] ? X[9] : X[11]; l_ = X[9] > X[11] ? X[11] : X[9]; X[9] = h_; X[11] = l_; h_ = X[14] > X[12] ? X[14] : X[12]; l_ = X[14] > X[12] ? X[12] : X[14]; X[14] = h_; X[12] = l_; h_ = X[15] > X[13] ? X[15] : X[13]; l_ = X[15] > X[13] ? X[13] : X[15]; X[15] = h_; X[13] = l_; h_ = X[0] > X[1] ? X[0] : X[1]; l_ = X[0] > X[1] ? X[1] : X[0]; X[0] = h_; X[1] = l_; h_ = X[2] > X[3] ? X[2] : X[3]; l_ = X[2] > X[3] ? X[3] : X[2]; X[2] = h_; X[3] = l_; h_ = X[5] > X[4] ? X[5] : X[4]; l_ = X[5] > X[4] ? X[4] : X[5]; X[5] = h_; X[4] = l_; h_ = X[7] > X[6] ? X[7] : X[6]; l_ = X[7] > X[6] ? X[6] : X[7]; X[7] = h_; X[6] = l_; h_ = X[8] > X[9] ? X[8] : X[9]; l_ = X[8] > X[9] ? X[9] : X[8]; X[8] = h_; X[9] = l_; h_ = X[10] > X[11] ? X[10] : X[11]; l_ = X[10] > X[11] ? X[11] : X[10]; X[10] = h_; X[11] = l_; h_ = X[13] > X[12] ? X[13] : X[12]; l_ = X[13] > X[12] ? X[12] : X[13]; X[13] = h_; X[12] = l_; h_ = X[15] > X[14] ? X[15] : X[14]; l_ = X[15] > X[14] ? X[14] : X[15]; X[15] = h_; X[14] = l_; h_ = X[0] > X[4] ? X[0] : X[4]; l_ = X[0] > X[4] ? X[4] : X[0]; X[0] = h_; X[4] = l_; h_ = X[1] > X[5] ? X[1] : X[5]; l_ = X[1] > X[5] ? X[5] : X[1]; X[1] = h_; X[5] = l_; h_ = X[2] > X[6] ? X[2] : X[6]; l_ = X[2] > X[6] ? X[6] : X[2]; X[2] = h_; X[6] = l_; h_ = X[3] > X[7] ? X[3] : X[7]; l_ = X[3] > X[7] ? X[7] : X[3]; X[3] = h_; X[7] = l_; h_ = X[12] > X[8] ? X[12] : X[8]; l_ = X[12] > X[8] ? X[8] : X[12]; X[12] = h_; X[8] = l_; h_ = X[13] > X[9] ? X[13] : X[9]; l_ = X[13] > X[9] ? X[9] : X[13]; X[13] = h_; X[9] = l_; h_ = X[14] > X[10] ? X[14] : X[10]; l_ = X[14] > X[10] ? X[10] : X[14]; X[14] = h_; X[10] = l_; h_ = X[15] > X[11] ? X[15] : X[11]; l_ = X[15] > X[11] ? X[11] : X[15]; X[15] = h_; X[11] = l_; h_ = X[0] > X[2] ? X[0] : X[2]; l_ = X[0] > X[2] ? X[2] : X[0]; X[0] = h_; X[2] = l_; h_ = X[1] > X[3] ? X[1] : X[3]; l_ = X[1] > X[3] ? X[3] : X[1]; X[1] = h_; X[3] = l_; h_ = X[4] > X[6] ? X[4] : X[6]; l_ = X[4] > X[6] ? X[6] : X[4]; X[4] = h_; X[6] = l_; h_ = X[5] > X[7] ? X[5] : X[7]; l_ = X[5] > X[7] ? X[7] : X[5]; X[5] = h_; X[7] = l_; h_ = X[10] > X[8] ? X[10] : X[8]; l_ = X[10] > X[8] ? X[8] : X[10]; X[10] = h_; X[8] = l_; h_ = X[11] > X[9] ? X[11] : X[9]; l_ = X[11] > X[9] ? X[9] : X[11]; X[11] = h_; X[9] = l_; h_ = X[14] > X[12] ? X[14] : X[12]; l_ = X[14] > X[12] ? X[12] : X[14]; X[14] = h_; X[12] = l_; h_ = X[15] > X[13] ? X[15] : X[13]; l_ = X[15] > X[13] ? X[13] : X[15]; X[15] = h_; X[13] = l_; h_ = X[0] > X[1] ? X[0] : X[1]; l_ = X[0] > X[1] ? X[1] : X[0]; X[0] = h_; X[1] = l_; h_ = X[2] > X[3] ? X[2] : X[3]; l_ = X[2] > X[3] ? X[3] : X[2]; X[2] = h_; X[3] = l_; h_ = X[4] > X[5] ? X[4] : X[5]; l_ = X[4] > X[5] ? X[5] : X[4]; X[4] = h_; X[5] = l_; h_ = X[6] > X[7] ? X[6] : X[7]; l_ = X[6] > X[7] ? X[7] : X[6]; X[6] = h_; X[7] = l_; h_ = X[9] > X[8] ? X[9] : X[8]; l_ = X[9] > X[8] ? X[8] : X[9]; X[9] = h_; X[8] = l_; h_ = X[11] > X[10] ? X[11] : X[10]; l_ = X[11] > X[10] ? X[10] : X[11]; X[11] = h_; X[10] = l_; h_ = X[13] > X[12] ? X[13] : X[12]; l_ = X[13] > X[12] ? X[12] : X[13]; X[13] = h_; X[12] = l_; h_ = X[15] > X[14] ? X[15] : X[14]; l_ = X[15] > X[14] ? X[14] : X[15]; X[15] = h_; X[14] = l_; h_ = X[0] > X[8] ? X[0] : X[8]; l_ = X[0] > X[8] ? X[8] : X[0]; X[0] = h_; X[8] = l_; h_ = X[1] > X[9] ? X[1] : X[9]; l_ = X[1] > X[9] ? X[9] : X[1]; X[1] = h_; X[9] = l_; h_ = X[2] > X[10] ? X[2] : X[10]; l_ = X[2] > X[10] ? X[10] : X[2]; X[2] = h_; X[10] = l_; h_ = X[3] > X[11] ? X[3] : X[11]; l_ = X[3] > X[11] ? X[11] : X[3]; X[3] = h_; X[11] = l_; h_ = X[4] > X[12] ? X[4] : X[12]; l_ = X[4] > X[12] ? X[12] : X[4]; X[4] = h_; X[12] = l_; h_ = X[5] > X[13] ? X[5] : X[13]; l_ = X[5] > X[13] ? X[13] : X[5]; X[5] = h_; X[13] = l_; h_ = X[6] > X[14] ? X[6] : X[14]; l_ = X[6] > X[14] ? X[14] : X[6]; X[6] = h_; X[14] = l_; h_ = X[7] > X[15] ? X[7] : X[15]; l_ = X[7] > X[15] ? X[15] : X[7]; X[7] = h_; X[15] = l_; h_ = X[0] > X[4] ? X[0] : X[4]; l_ = X[0] > X[4] ? X[4] : X[0]; X[0] = h_; X[4] = l_; h_ = X[1] > X[5] ? X[1] : X[5]; l_ = X[1] > X[5] ? X[5] : X[1]; X[1] = h_; X[5] = l_; h_ = X[2] > X[6] ? X[2] : X[6]; l_ = X[2] > X[6] ? X[6] : X[2]; X[2] = h_; X[6] = l_; h_ = X[3] > X[7] ? X[3] : X[7]; l_ = X[3] > X[7] ? X[7] : X[3]; X[3] = h_; X[7] = l_; h_ = X[8] > X[12] ? X[8] : X[12]; l_ = X[8] > X[12] ? X[12] : X[8]; X[8] = h_; X[12] = l_; h_ = X[9] > X[13] ? X[9] : X[13]; l_ = X[9] > X[13] ? X[13] : X[9]; X[9] = h_; X[13] = l_; h_ = X[10] > X[14] ? X[10] : X[14]; l_ = X[10] > X[14] ? X[14] : X[10]; X[10] = h_; X[14] = l_; h_ = X[11] > X[15] ? X[11] : X[15]; l_ = X[11] > X[15] ? X[15] : X[11]; X[11] = h_; X[15] = l_; h_ = X[0] > X[2] ? X[0] : X[2]; l_ = X[0] > X[2] ? X[2] : X[0]; X[0] = h_; X[2] = l_; h_ = X[1] > X[3] ? X[1] : X[3]; l_ = X[1] > X[3] ? X[3] : X[1]; X[1] = h_; X[3] = l_; h_ = X[4] > X[6] ? X[4] : X[6]; l_ = X[4] > X[6] ? X[6] : X[4]; X[4] = h_; X[6] = l_; h_ = X[5] > X[7] ? X[5] : X[7]; l_ = X[5] > X[7] ? X[7] : X[5]; X[5] = h_; X[7] = l_; h_ = X[8] > X[10] ? X[8] : X[10]; l_ = X[8] > X[10] ? X[10] : X[8]; X[8] = h_; X[10] = l_; h_ = X[9] > X[11] ? X[9] : X[11]; l_ = X[9] > X[11] ? X[11] : X[9]; X[9] = h_; X[11] = l_; h_ = X[12] > X[14] ? X[12] : X[14]; l_ = X[12] > X[14] ? X[14] : X[12]; X[12] = h_; X[14] = l_; h_ = X[13] > X[15] ? X[13] : X[15]; l_ = X[13] > X[15] ? X[15] : X[13]; X[13] = h_; X[15] = l_; h_ = X[0] > X[1] ? X[0] : X[1]; l_ = X[0] > X[1] ? X[1] : X[0]; X[0] = h_; X[1] = l_; h_ = X[2] > X[3] ? X[2] : X[3]; l_ = X[2] > X[3] ? X[3] : X[2]; X[2] = h_; X[3] = l_; h_ = X[4] > X[5] ? X[4] : X[5]; l_ = X[4] > X[5] ? X[5] : X[4]; X[4] = h_; X[5] = l_; h_ = X[6] > X[7] ? X[6] : X[7]; l_ = X[6] > X[7] ? X[7] : X[6]; X[6] = h_; X[7] = l_; h_ = X[8] > X[9] ? X[8] : X[9]; l_ = X[8] > X[9] ? X[9] : X[8]; X[8] = h_; X[9] = l_; h_ = X[10] > X[11] ? X[10] : X[11]; l_ = X[10] > X[11] ? X[11] : X[10]; X[10] = h_; X[11] = l_; h_ = X[12] > X[13] ? X[12] : X[13]; l_ = X[12] > X[13] ? X[13] : X[12]; X[12] = h_; X[13] = l_; h_ = X[14] > X[15] ? X[14] : X[15]; l_ = X[14] > X[15] ? X[15] : X[14]; X[14] = h_; X[15] = l_; } while (0)
#define MERGE16(X) do { unsigned h_, l_; h_ = X[0] > X[8] ? X[0] : X[8]; l_ = X[0] > X[8] ? X[8] : X[0]; X[0] = h_; X[8] = l_; h_ = X[1] > X[9] ? X[1] : X[9]; l_ = X[1] > X[9] ? X[9] : X[1]; X[1] = h_; X[9] = l_; h_ = X[2] > X[10] ? X[2] : X[10]; l_ = X[2] > X[10] ? X[10] : X[2]; X[2] = h_; X[10] = l_; h_ = X[3] > X[11] ? X[3] : X[11]; l_ = X[3] > X[11] ? X[11] : X[3]; X[3] = h_; X[11] = l_; h_ = X[4] > X[12] ? X[4] : X[12]; l_ = X[4] > X[12] ? X[12] : X[4]; X[4] = h_; X[12] = l_; h_ = X[5] > X[13] ? X[5] : X[13]; l_ = X[5] > X[13] ? X[13] : X[5]; X[5] = h_; X[13] = l_; h_ = X[6] > X[14] ? X[6] : X[14]; l_ = X[6] > X[14] ? X[14] : X[6]; X[6] = h_; X[14] = l_; h_ = X[7] > X[15] ? X[7] : X[15]; l_ = X[7] > X[15] ? X[15] : X[7]; X[7] = h_; X[15] = l_; h_ = X[0] > X[4] ? X[0] : X[4]; l_ = X[0] > X[4] ? X[4] : X[0]; X[0] = h_; X[4] = l_; h_ = X[1] > X[5] ? X[1] : X[5]; l_ = X[1] > X[5] ? X[5] : X[1]; X[1] = h_; X[5] = l_; h_ = X[2] > X[6] ? X[2] : X[6]; l_ = X[2] > X[6] ? X[6] : X[2]; X[2] = h_; X[6] = l_; h_ = X[3] > X[7] ? X[3] : X[7]; l_ = X[3] > X[7] ? X[7] : X[3]; X[3] = h_; X[7] = l_; h_ = X[8] > X[12] ? X[8] : X[12]; l_ = X[8] > X[12] ? X[12] : X[8]; X[8] = h_; X[12] = l_; h_ = X[9] > X[13] ? X[9] : X[13]; l_ = X[9] > X[13] ? X[13] : X[9]; X[9] = h_; X[13] = l_; h_ = X[10] > X[14] ? X[10] : X[14]; l_ = X[10] > X[14] ? X[14] : X[10]; X[10] = h_; X[14] = l_; h_ = X[11] > X[15] ? X[11] : X[15]; l_ = X[11] > X[15] ? X[15] : X[11]; X[11] = h_; X[15] = l_; h_ = X[0] > X[2] ? X[0] : X[2]; l_ = X[0] > X[2] ? X[2] : X[0]; X[0] = h_; X[2] = l_; h_ = X[1] > X[3] ? X[1] : X[3]; l_ = X[1] > X[3] ? X[3] : X[1]; X[1] = h_; X[3] = l_; h_ = X[4] > X[6] ? X[4] : X[6]; l_ = X[4] > X[6] ? X[6] : X[4]; X[4] = h_; X[6] = l_; h_ = X[5] > X[7] ? X[5] : X[7]; l_ = X[5] > X[7] ? X[7] : X[5]; X[5] = h_; X[7] = l_; h_ = X[8] > X[10] ? X[8] : X[10]; l_ = X[8] > X[10] ? X[10] : X[8]; X[8] = h_; X[10] = l_; h_ = X[9] > X[11] ? X[9] : X[11]; l_ = X[9] > X[11] ? X[11] : X[9]; X[9] = h_; X[11] = l_; h_ = X[12] > X[14] ? X[12] : X[14]; l_ = X[12] > X[14] ? X[14] : X[12]; X[12] = h_; X[14] = l_; h_ = X[13] > X[15] ? X[13] : X[15]; l_ = X[13] > X[15] ? X[15] : X[13]; X[13] = h_; X[15] = l_; h_ = X[0] > X[1] ? X[0] : X[1]; l_ = X[0] > X[1] ? X[1] : X[0]; X[0] = h_; X[1] = l_; h_ = X[2] > X[3] ? X[2] : X[3]; l_ = X[2] > X[3] ? X[3] : X[2]; X[2] = h_; X[3] = l_; h_ = X[4] > X[5] ? X[4] : X[5]; l_ = X[4] > X[5] ? X[5] : X[4]; X[4] = h_; X[5] = l_; h_ = X[6] > X[7] ? X[6] : X[7]; l_ = X[6] > X[7] ? X[7] : X[6]; X[6] = h_; X[7] = l_; h_ = X[8] > X[9] ? X[8] : X[9]; l_ = X[8] > X[9] ? X[9] : X[8]; X[8] = h_; X[9] = l_; h_ = X[10] > X[11] ? X[10] : X[11]; l_ = X[10] > X[11] ? X[11] : X[10]; X[10] = h_; X[11] = l_; h_ = X[12] > X[13] ? X[12] : X[13]; l_ = X[12] > X[13] ? X[13] : X[12]; X[12] = h_; X[13] = l_; h_ = X[14] > X[15] ? X[14] : X[15]; l_ = X[14] > X[15] ? X[15] : X[14]; X[14] = h_; X[15] = l_; } while (0)

__device__ __forceinline__ unsigned f2ord(float f) { const unsigned u = __float_as_uint(f); return (u & 0x80000000u) ? ~u : (u | 0x80000000u); }
__device__ __forceinline__ float ord2f(unsigned o) { return __uint_as_float((o & 0x80000000u) ? (o & 0x7fffffffu) : ~o); }
#define CANDKEY(sum, c) ((f2ord(sum) & ~255u) | (255u - (unsigned)(c)))
__device__ __forceinline__ void xmerge16(unsigned (&X)[16], int mask) {
  unsigned T[16];
#pragma unroll
  for (int i = 0; i < 16; ++i) T[i] = (unsigned)__shfl_xor((int)X[15 - i], mask);
#pragma unroll
  for (int i = 0; i < 16; ++i) X[i] = X[i] > T[i] ? X[i] : T[i];
  MERGE16(X);
}

__device__ __forceinline__ void ph9_topk(const P& p, int bid, int nb, char* smem) {
  const int tid = threadIdx.x & 255, lane = tid & 63, wave = tid >> 6, lr = lane & 15, lq = lane >> 4;
  bf16_t* kl = (bf16_t*)smem;
  int* idxs = (int*)(smem + 65536) + wave * 512;
  const int h = ((bid >> 1) & 3) * 2 + (bid & 1), nper = nb >> 3, wgi = bid >> 3;
  for (int idx = tid; idx < 4096; idx += NTHR) {
    const int row = idx >> 4, c = idx & 15;
    *(u32x4*)(kl + row * 128 + ((c ^ (row & 15)) << 3)) = *(const u32x4*)(p.keys_bf + (size_t)h * 32768 + row * 128 + c * 8);
  }
  __syncthreads();
  const __amdgpu_buffer_rsrc_t r_q = mk_rsrc(p.qb);
  bf16x8 bq[4];
#pragma unroll
  for (int kk = 0; kk < 4; ++kk) bq[kk] = bload8c(r_q, (lr * 2048 + lq * 8) * 2 + kk * 64, ((wgi * 4 + wave) * 16 * 2048 + h * 256) * 2);
  for (int tile = wgi * 4 + wave; tile < 1024; tile += nper * 4) {
    const int tok = tile * 16 + lr;
    unsigned R0[16], R1[16];
#pragma unroll
    for (int pp = 0; pp < 2; ++pp) {
      bf16x8 bn[4];
      {
        const int ntile = pp == 0 ? tile : (tile + nper * 4 < 1024 ? tile + nper * 4 : tile);
#pragma unroll
        for (int kk = 0; kk < 4; ++kk) bn[kk] = bload8c(r_q, (lr * 2048 + lq * 8) * 2 + kk * 64, (ntile * 16 * 2048 + h * 256 + (pp ^ 1) * 128) * 2);
      }
      f32x4 acc[8];
#pragma unroll
      for (int j = 0; j < 8; ++j) acc[j] = (f32x4){0.f, 0.f, 0.f, 0.f};
#pragma unroll
      for (int j = 0; j < 8; ++j)
#pragma unroll
        for (int kk = 0; kk < 4; ++kk) {
          const bf16x8 a = *(const bf16x8*)(kl + (pp * 128 + j * 16 + lr) * 128 + (((kk * 4 + lq) ^ lr) << 3));
          acc[j] = __builtin_amdgcn_mfma_f32_16x16x32_bf16(a, bq[kk], acc[j], 0, 0, 0);
        }
      unsigned X[16], Y[16];
#pragma unroll
      for (int j = 0; j < 4; ++j)
#pragma unroll
        for (int e = 0; e < 4; ++e) {
          X[j * 4 + e] = (f2ord(acc[j][e]) & ~127u) | (127u - (unsigned)(j * 16 + lq * 4 + e));
          Y[j * 4 + e] = (f2ord(acc[4 + j][e]) & ~127u) | (127u - (unsigned)((4 + j) * 16 + lq * 4 + e));
        }
      SORT16(X);
      SORT16(Y);
#pragma unroll
      for (int i = 0; i < 16; ++i) X[i] = X[i] > Y[15 - i] ? X[i] : Y[15 - i];
      MERGE16(X);
      xmerge16(X, 16);
      xmerge16(X, 32);
#pragma unroll
      for (int i = 0; i < 16; ++i) { if (pp == 0) R0[i] = X[i]; else R1[i] = X[i]; }
#pragma unroll
      for (int kk = 0; kk < 4; ++kk) bq[kk] = bn[kk];
    }
    if (lq == 0) {
#pragma unroll
      for (int i = 0; i < 16; ++i) { idxs[lr * 32 + i] = 127 - (int)(R0[i] & 127u); idxs[lr * 32 + 16 + i] = 127 - (int)(R1[i] & 127u); }
    }
    asm volatile("s_waitcnt lgkmcnt(0)" ::: "memory");
    float va[16], vb[16];
#pragma unroll
    for (int i = 0; i < 16; ++i) { va[i] = ord2f(R0[i] & ~127u); vb[i] = ord2f(R1[i] & ~127u); }
    unsigned F[16];
  F[0] = lq == 0 ? CANDKEY(va[0] + vb[0], 0) : (lq == 1 ? CANDKEY(va[1] + vb[0], 16) : (lq == 2 ? CANDKEY(va[3] + vb[0], 48) : CANDKEY(va[13] + vb[0], 208)));
  F[1] = lq == 0 ? CANDKEY(va[0] + vb[1], 1) : (lq == 1 ? CANDKEY(va[1] + vb[1], 17) : (lq == 2 ? CANDKEY(va[3] + vb[1], 49) : CANDKEY(va[14] + vb[0], 224)));
  F[2] = lq == 0 ? CANDKEY(va[0] + vb[2], 2) : (lq == 1 ? CANDKEY(va[1] + vb[2], 18) : (lq == 2 ? CANDKEY(va[3] + vb[2], 50) : CANDKEY(va[15] + vb[0], 240)));
  F[3] = lq == 0 ? CANDKEY(va[0] + vb[3], 3) : (lq == 1 ? CANDKEY(va[1] + vb[3], 19) : (lq == 2 ? CANDKEY(va[3] + vb[3], 51) : 0u));
  F[4] = lq == 0 ? CANDKEY(va[0] + vb[4], 4) : (lq == 1 ? CANDKEY(va[1] + vb[4], 20) : (lq == 2 ? CANDKEY(va[4] + vb[0], 64) : 0u));
  F[5] = lq == 0 ? CANDKEY(va[0] + vb[5], 5) : (lq == 1 ? CANDKEY(va[1] + vb[5], 21) : (lq == 2 ? CANDKEY(va[4] + vb[1], 65) : 0u));
  F[6] = lq == 0 ? CANDKEY(va[0] + vb[6], 6) : (lq == 1 ? CANDKEY(va[1] + vb[6], 22) : (lq == 2 ? CANDKEY(va[4] + vb[2], 66) : 0u));
  F[7] = lq == 0 ? CANDKEY(va[0] + vb[7], 7) : (lq == 1 ? CANDKEY(va[1] + vb[7], 23) : (lq == 2 ? CANDKEY(va[6] + vb[0], 96) : 0u));
  F[8] = lq == 0 ? CANDKEY(va[0] + vb[8], 8) : (lq == 1 ? CANDKEY(va[2] + vb[0], 32) : (lq == 2 ? CANDKEY(va[6] + vb[1], 97) : 0u));
  F[9] = lq == 0 ? CANDKEY(va[0] + vb[9], 9) : (lq == 1 ? CANDKEY(va[2] + vb[1], 33) : (lq == 2 ? CANDKEY(va[7] + vb[0], 112) : 0u));
  F[10] = lq == 0 ? CANDKEY(va[0] + vb[10], 10) : (lq == 1 ? CANDKEY(va[2] + vb[2], 34) : (lq == 2 ? CANDKEY(va[7] + vb[1], 113) : 0u));
  F[11] = lq == 0 ? CANDKEY(va[0] + vb[11], 11) : (lq == 1 ? CANDKEY(va[2] + vb[3], 35) : (lq == 2 ? CANDKEY(va[8] + vb[0], 128) : 0u));
  F[12] = lq == 0 ? CANDKEY(va[0] + vb[12], 12) : (lq == 1 ? CANDKEY(va[2] + vb[4], 36) : (lq == 2 ? CANDKEY(va[9] + vb[0], 144) : 0u));
  F[13] = lq == 0 ? CANDKEY(va[0] + vb[13], 13) : (lq == 1 ? CANDKEY(va[5] + vb[0], 80) : (lq == 2 ? CANDKEY(va[10] + vb[0], 160) : 0u));
  F[14] = lq == 0 ? CANDKEY(va[0] + vb[14], 14) : (lq == 1 ? CANDKEY(va[5] + vb[1], 81) : (lq == 2 ? CANDKEY(va[11] + vb[0], 176) : 0u));
  F[15] = lq == 0 ? CANDKEY(va[0] + vb[15], 15) : (lq == 1 ? 0u : (lq == 2 ? CANDKEY(va[12] + vb[0], 192) : 0u));

    SORT16(F);
    xmerge16(F, 16);
    xmerge16(F, 32);
    if (lq == 0) {
      float ev[16];
      const float mx = ord2f(F[0] & ~255u);
      float tot = 0.f;
#pragma unroll
      for (int r = 0; r < 16; ++r) { ev[r] = __expf(ord2f(F[r] & ~255u) - mx); tot += ev[r]; }
      const float inv = 1.f / tot;
      int ei[16];
#pragma unroll
      for (int r = 0; r < 16; ++r) {
        const int c = 255 - (int)(F[r] & 255u);
        ei[r] = idxs[lr * 32 + (c >> 4)] * 128 + idxs[lr * 32 + 16 + (c & 15)];
      }
      unsigned short* ep = p.eidx + (size_t)tok * 128 + h * 16;
      float* gp = p.gate + (size_t)tok * 128 + h * 16;
#pragma unroll
      for (int r = 0; r < 4; ++r) {
        *(f32x4*)(gp + r * 4) = (f32x4){ev[r * 4] * inv, ev[r * 4 + 1] * inv, ev[r * 4 + 2] * inv, ev[r * 4 + 3] * inv};
      }
#pragma unroll
      for (int r = 0; r < 2; ++r)
        *(u32x4*)(ep + r * 8) = (u32x4){(unsigned)ei[r * 8] | ((unsigned)ei[r * 8 + 1] << 16), (unsigned)ei[r * 8 + 2] | ((unsigned)ei[r * 8 + 3] << 16),
                                         (unsigned)ei[r * 8 + 4] | ((unsigned)ei[r * 8 + 5] << 16), (unsigned)ei[r * 8 + 6] | ((unsigned)ei[r * 8 + 7] << 16)};
    }
  }
}

__device__ __forceinline__ void ph_convert_tables(const P& p, int bid, int nb) {
  const int wave = (threadIdx.x >> 6) & 3, lane = threadIdx.x & 63;
  for (int row = bid * 4 + wave; row < 32768; row += nb * 4) {
    const bool isu = row < 16384;
    const float* src = isu ? p.U + (size_t)row * 1024 : p.V + (size_t)(row - 16384) * 1024;
    unsigned char* dst = isu ? p.U8 + (size_t)row * 1024 : p.V8 + (size_t)(row - 16384) * 1024;
    const float sc = isu ? 512.f : 32.f;
#pragma unroll
    for (int j = 0; j < 4; ++j) {
      const f32x4 v = __builtin_nontemporal_load((const f32x4*)src + j * 64 + lane);
      int w = 0;
      w = __builtin_amdgcn_cvt_pk_fp8_f32(v.x * sc, v.y * sc, w, false);
      w = __builtin_amdgcn_cvt_pk_fp8_f32(v.z * sc, v.w * sc, w, true);
      *(int*)(dst + j * 256 + lane * 4) = w;
    }
  }
}

__device__ __forceinline__ float gelu_exact(float a) { return 0.5f * a * (1.f + erff(a * 0.70710678118654752f)); }

#define G_LOAD(buf, j, g_) do { const int g__ = (g_); const int er__ = (g__ & 8) ? e1s[j] : e0s[j]; \
    _Pragma("unroll") for (int k = 0; k < 8; ++k) { const int e__ = __builtin_amdgcn_readlane(er__, (g__ & 7) * 8 + k); \
      buf[k] = *((const u32x4*)(tab + (size_t)e__ * 1024) + lane); } } while (0)
#define G_COMPUTE_U(buf, j, g_) do { const int g__ = (g_); \
      float pp[8]; \
      _Pragma("unroll") for (int k = 0; k < 8; ++k) { \
        f32x2 ac = {0.f, 0.f}; \
        _Pragma("unroll") for (int d = 0; d < 4; ++d) { \
          ac = __builtin_amdgcn_cvt_pk_f32_fp8((int)buf[k][d], false) * x2[j][2 * d] + ac; \
          ac = __builtin_amdgcn_cvt_pk_f32_fp8((int)buf[k][d], true) * x2[j][2 * d + 1] + ac; } \
        pp[k] = ac.x + ac.y; } \
        \
      float q4[4], r2[2], tt; \
      _Pragma("unroll") for (int i = 0; i < 4; ++i) { const float sd = b5 ? pp[i] : pp[i + 4]; q4[i] = (b5 ? pp[i + 4] : pp[i]) + __shfl_xor(sd, 32); } \
      _Pragma("unroll") for (int i = 0; i < 2; ++i) { const float sd = b4 ? q4[i] : q4[i + 2]; r2[i] = (b4 ? q4[i + 2] : q4[i]) + __shfl_xor(sd, 16); } \
      { const float sd = b3 ? r2[0] : r2[1]; tt = (b3 ? r2[1] : r2[0]) + __shfl_xor(sd, 8); } \
      tt += __shfl_xor(tt, 4); tt += __shfl_xor(tt, 2); tt += __shfl_xor(tt, 1); \
      const float dv = __shfl(tt, (lane & 7) * 8); \
      if ((lane >> 3) == (g__ & 7)) { if (g__ & 8) a1[j] = dv; else a0[j] = dv; } } while (0)
#define G_COMPUTE_V(buf, j, g_) do { const int g__ = (g_); \
      const int wr__ = __float_as_int((g__ & 8) ? w1s[j] : w0s[j]); \
      _Pragma("unroll") for (int k = 0; k < 8; ++k) { \
        const float w__ = __int_as_float(__builtin_amdgcn_readlane(wr__, (g__ & 7) * 8 + k)); \
        const f32x2 ww = {w__, w__}; \
        _Pragma("unroll") for (int d = 0; d < 4; ++d) { \
          y2[j][2 * d] = __builtin_amdgcn_cvt_pk_f32_fp8((int)buf[k][d], false) * ww + y2[j][2 * d]; \
          y2[j][2 * d + 1] = __builtin_amdgcn_cvt_pk_f32_fp8((int)buf[k][d], true) * ww + y2[j][2 * d + 1]; } } } while (0)
#define G_SWEEP(COMP) do { \
    G_LOAD(A, 0, 0); G_LOAD(B, 1, 0); G_LOAD(C, 0, 1); \
    _Pragma("unroll 1") for (int g = 0; g < 16; g += 2) { \
      const int gn = g + 2 < 16 ? g + 2 : g;              \
      G_LOAD(D, 1, g + 1); COMP(A, 0, g); \
      G_LOAD(A, 0, gn); COMP(B, 1, g); \
      G_LOAD(B, 1, gn); COMP(C, 0, g + 1); \
      G_LOAD(C, 0, gn + 1); COMP(D, 1, g + 1); } } while (0)

__device__ __forceinline__ void ph10_gather(const P& p, int bid, int nb, char* smem) {
  const int wave = __builtin_amdgcn_readfirstlane((threadIdx.x >> 6) & 3), lane = threadIdx.x & 63;
  const bool b5 = lane & 32, b4 = lane & 16, b3 = lane & 8;
  int* se = (int*)(smem + wave * 1024);
  float* sg = (float*)(se + 128);
  for (int oct = bid * 4 + wave; oct < TL / 8; oct += nb * 4) {
#pragma unroll 1
    for (int grp = 0; grp < 4; ++grp) {
      int diag_bad = 0;
      const int tok0 = oct * 8 + grp * 2;
      int e0s[2], e1s[2];
      float g0s[2], g1s[2], a0[2], a1[2], w0s[2], w1s[2];
      f32x2 x2[2][8], y2[2][8];
#pragma unroll
      for (int j = 0; j < 2; ++j) {
        const int tok = tok0 + j;
        const int e0 = (int)p.eidx[(size_t)tok * 128 + lane], e1 = (int)p.eidx[(size_t)tok * 128 + 64 + lane];
        const float g0 = p.gate[(size_t)tok * 128 + lane], g1 = p.gate[(size_t)tok * 128 + 64 + lane];
        {
          const float gs = wave_sum(g0 + g1);
          const bool bad = (e0 < 0) || (e0 > 16383) || (e1 < 0) || (e1 > 16383) || !(fabsf(gs - 8.f) < 1e-2f);
          if (__ballot(bad) != 0ull) diag_bad = 1;
        }
        const int sl0 = e0 >> 10, sl1 = e1 >> 10;
        int base = 0, pos0 = 0, pos1 = 0;
#pragma unroll
        for (int sidx = 0; sidx < 16; ++sidx) {
          const unsigned long long m0 = __ballot(sl0 == sidx), m1 = __ballot(sl1 == sidx);
          const int c0 = __popcll(m0), c1 = __popcll(m1);
          const int r0 = __builtin_amdgcn_mbcnt_hi((unsigned)(m0 >> 32), __builtin_amdgcn_mbcnt_lo((unsigned)m0, 0u));
          const int r1 = __builtin_amdgcn_mbcnt_hi((unsigned)(m1 >> 32), __builtin_amdgcn_mbcnt_lo((unsigned)m1, 0u));
          if (sl0 == sidx) pos0 = base + r0;
          if (sl1 == sidx) pos1 = base + c0 + r1;
          base += c0 + c1;
        }
        asm volatile("s_waitcnt lgkmcnt(0)" ::: "memory");
        se[pos0] = e0; se[pos1] = e1; sg[pos0] = g0; sg[pos1] = g1;
        asm volatile("s_waitcnt lgkmcnt(0)" ::: "memory");
        e0s[j] = se[lane]; e1s[j] = se[64 + lane]; g0s[j] = sg[lane]; g1s[j] = sg[64 + lane];
        asm volatile("s_waitcnt lgkmcnt(0)" ::: "memory");
        const __amdgpu_buffer_rsrc_t r_h2 = mk_rsrc(p.hn);
        const u32x4 h0 = uload4c(r_h2, (tok * 1024 + lane * 16) * 2, 0);
        const u32x4 h1 = uload4c(r_h2, (tok * 1024 + lane * 16 + 8) * 2, 0);
#pragma unroll
        for (int i = 0; i < 4; ++i) { x2[j][i] = (f32x2){blo(h0[i]), bhi(h0[i])}; x2[j][4 + i] = (f32x2){blo(h1[i]), bhi(h1[i])}; }
        a0[j] = 0.f; a1[j] = 0.f;
      }
      u32x4 A[8], B[8], C[8], D[8];
      { const unsigned char* tab = p.U8; G_SWEEP(G_COMPUTE_U); }
#pragma unroll
      for (int j = 0; j < 2; ++j) { w0s[j] = gelu_exact(a0[j] * (1.f / 512.f)) * g0s[j]; w1s[j] = gelu_exact(a1[j] * (1.f / 512.f)) * g1s[j];
#pragma unroll
        for (int i = 0; i < 8; ++i) y2[j][i] = (f32x2){0.f, 0.f}; }
      { const unsigned char* tab = p.V8; G_SWEEP(G_COMPUTE_V); }
#pragma unroll
      for (int j = 0; j < 2; ++j) {
        const int tok = tok0 + j, b = tok / SEQ;
        float* orow = p.out + (size_t)tok * 1024 + lane * 16;
        const float* g2 = p.mod + b * 6144 + 5 * 1024 + lane * 16;
        float z[16];
        float ss = 0.f;
#pragma unroll
        for (int q = 0; q < 4; ++q) {
          const f32x4 xl = fload4c(mk_rsrc(p.out), (tok * 1024 + lane * 16 + q * 4) * 4, 0);
          const f32x4 gg = *(const f32x4*)(g2 + q * 4);
          const float yv[4] = {y2[j][2 * q].x, y2[j][2 * q].y, y2[j][2 * q + 1].x, y2[j][2 * q + 1].y};
#pragma unroll
          for (int i = 0; i < 4; ++i) { const float zz = xl[i] + gg[i] * (yv[i] * (1.f / 32.f)); z[q * 4 + i] = zz; ss += zz * zz; }
        }
        ss = wave_sum(ss);
        const float rstd = rsqrtf(ss * (1.f / 1024.f) + 1e-6f);
#pragma unroll
        for (int q = 0; q < 4; ++q) {
          const f32x4 fw = *(const f32x4*)(p.final_norm_w + lane * 16 + q * 4);
          f32x4 o;
#pragma unroll
          for (int i = 0; i < 4; ++i) o[i] = diag_bad ? __builtin_inff() : z[q * 4 + i] * rstd * fw[i];
          *(f32x4*)(orow + q * 4) = o;
        }
      }
    }
  }
}

__global__ void __launch_bounds__(2 * NTHR, 2) mega(P p) {
  __shared__ __attribute__((aligned(16))) char smem_all[2 * LDS_HALF];
  cg::grid_group grid = cg::this_grid();
  const int half = __builtin_amdgcn_readfirstlane(threadIdx.x >> 8);
  char* smem = smem_all + half * LDS_HALF;
  const int bid = blockIdx.x * 2 + half, nb = gridDim.x * 2;
  int nsync = 0;
  const int bng = (gridDim.x % 16 == 0) ? 16 : 1, bper = gridDim.x / bng, bgrp = blockIdx.x % bng;
  if (blockIdx.x == 0) { p.bar[threadIdx.x] = 0u; p.bar[512 + threadIdx.x] = 0u; for (int i = threadIdx.x; i < (int)gridDim.x * 32; i += 2 * NTHR) p.flg[i] = 0u; }
#ifndef REPEAT_MASK
#define REPEAT_MASK 0
#endif
#ifndef EXTRA_SYNCS
#define EXTRA_SYNCS 0
#endif
#define GSYNC() do { asm volatile("s_waitcnt vmcnt(0)" ::: "memory"); \
    if (nsync == 0) { grid.sync(); } else { __syncthreads(); \
      if (threadIdx.x < 64) { \
        int rel = 0; \
        if (threadIdx.x == 0) { __builtin_amdgcn_fence(__ATOMIC_RELEASE, "agent"); asm volatile("s_waitcnt vmcnt(0)" ::: "memory"); \
          const unsigned old = __hip_atomic_fetch_add(p.bar + bgrp * 32, 1u, __ATOMIC_RELAXED, __HIP_MEMORY_SCOPE_AGENT); \
          if (old + 1u == (unsigned)(nsync * bper)) { \
            const unsigned o2 = __hip_atomic_fetch_add(p.bar + 768, 1u, __ATOMIC_RELAXED, __HIP_MEMORY_SCOPE_AGENT); \
            if (o2 + 1u == (unsigned)(nsync * bng)) rel = 1; } } \
        rel = __builtin_amdgcn_readfirstlane(rel); \
        if (rel) for (int i = threadIdx.x; i < (int)gridDim.x; i += 64) __hip_atomic_store(p.flg + i * 32, (unsigned)nsync, __ATOMIC_RELAXED, __HIP_MEMORY_SCOPE_AGENT); \
        if (threadIdx.x == 0) { \
          while (__hip_atomic_load(p.flg + blockIdx.x * 32, __ATOMIC_RELAXED, __HIP_MEMORY_SCOPE_AGENT) < (unsigned)nsync) __builtin_amdgcn_s_sleep(2); \
          __builtin_amdgcn_fence(__ATOMIC_ACQUIRE, "agent"); asm volatile("s_waitcnt vmcnt(0)" ::: "memory"); } } \
      __syncthreads(); } \
    ++nsync; } while (0)
#define RUN(k, call) if ((PHMASK & (1 << k)) && p.ph_lo <= k && k < p.ph_hi) { call; if (REPEAT_MASK & (1 << k)) { GSYNC(); call; } \
    if (k + 1 < p.ph_hi) { GSYNC(); for (int xs = 0; xs < EXTRA_SYNCS; ++xs) GSYNC(); } }
  RUN(0, ph0_prep(p, bid, nb, smem))
  RUN(1, ph_norm_rows<0>(p, bid, nb))
  RUN(2, ph_gemm8<0>(p, smem_all))
  RUN(3, ph3_chunk_local(p, bid, nb, smem))
  RUN(4, ph4_scan(p, bid, nb))
  RUN(5, ph5_mlstm_out(p, bid, nb, smem))
  RUN(6, (ph_gemm8<1>(p, smem_all), ph_convert_tables(p, bid, nb)))
  RUN(7, ph_norm_rows<1>(p, bid, nb))
  RUN(8, ph_gemm8<2>(p, smem_all))
  RUN(9, ph9_topk(p, bid, nb, smem))
  RUN(10, ph10_gather(p, bid, nb, smem))
#undef RUN
}

extern "C" void kernel_launch(void* const* d_in, const int* in_sizes, int n_in, void* d_out, int out_size, void* d_ws, size_t ws_size,
                              hipStream_t stream) {
  static int grid_blocks = 0;
  if (!grid_blocks) {
    int dev = 0, cus = 0, per_cu = 0;
    hipGetDevice(&dev);
    hipDeviceGetAttribute(&cus, hipDeviceAttributeMultiprocessorCount, dev);
    hipOccupancyMaxActiveBlocksPerMultiprocessor(&per_cu, (const void*)mega, 2 * NTHR, 0);
    per_cu = 1;
    grid_blocks = cus * per_cu;
    if (ws_size < WS_END + 128ull * 1024 || grid_blocks > 1024) fprintf(stderr, "kernel_launch: workspace too small: %zu < %llu\n", ws_size, (unsigned long long)WS_END);
  }
  P p{};
  const float* const* in = (const float* const*)d_in;
  p.x = in[0]; p.c = in[1]; p.ctx = in[2]; p.c_ctx = in[3]; p.w_mod = in[4]; p.b_mod = in[5]; p.norm1_w = in[6]; p.w_in = in[7];
  p.conv_w = in[8]; p.conv_b = in[9]; p.b_gates = in[10]; p.head_norm_w = in[11]; p.pool_w = in[12]; p.pool_scale = in[13];
  p.w_out = in[14]; p.norm2_w = in[15]; p.wq = in[16]; p.keys = in[17]; p.U = in[18]; p.V = in[19]; p.final_norm_w = in[20];
  p.out = (float*)d_out;
  p.bar = (unsigned*)d_ws; p.flg = (unsigned*)((char*)d_ws + WS_END);
  char* ws = (char*)d_ws;
  p.mod = (float*)(ws + OFF_MOD); p.gates = (float*)(ws + OFF_GATES);
  p.wt_in = (bf16_t*)(ws + OFF_WTIN); p.wt_out = (bf16_t*)(ws + OFF_WTOUT); p.wt_q = (bf16_t*)(ws + OFF_WTQ);
  p.keys_bf = (bf16_t*)(ws + OFF_KEYS); p.hn = (bf16_t*)(ws + OFF_HN); p.pl = (bf16_t*)(ws + OFF_PL);
  p.Dst = (bf16_t*)(ws + OFF_D); p.ND = (float*)(ws + OFF_ND); p.SC = (float*)(ws + OFF_SC);
  p.CIN = (bf16_t*)(ws + OFF_CIN); p.NIN = (float*)(ws + OFF_NIN); p.MIN_ = (float*)(ws + OFF_MIN);
  p.mix = (bf16_t*)(ws + OFF_D); p.qb = (bf16_t*)(ws + OFF_D);
  p.U8 = (unsigned char*)(ws + OFF_U8); p.V8 = (unsigned char*)(ws + OFF_U8 + 16777216ull);
  p.eidx = (unsigned short*)(ws + OFF_EIDX); p.gate = (float*)(ws + OFF_GATE);
#if N_LAUNCHES == 1
  p.ph_lo = 0; p.ph_hi = NPH;
  void* args[] = {&p};
  hipError_t e = hipLaunchCooperativeKernel((const void*)mega, dim3(grid_blocks), dim3(2 * NTHR), args, 0, stream);
  if (e != hipSuccess) fprintf(stderr, "cooperative launch failed: %s (grid %d)\n", hipGetErrorString(e), grid_blocks);
#else
  for (int ph = 0; ph < NPH; ++ph) {
    p.ph_lo = ph; p.ph_hi = ph + 1;
    void* args[] = {&p};
    hipError_t e = hipLaunchCooperativeKernel((const void*)mega, dim3(grid_blocks), dim3(2 * NTHR), args, 0, stream);
    if (e != hipSuccess) fprintf(stderr, "launch %d failed: %s (grid %d)\n", ph, hipGetErrorString(e), grid_blocks);
  }
#endif
}
```

```cpp
#include <hip/hip_runtime.h>
#include <hip/hip_cooperative_groups.h>
#include <stdint.h>
#include <stdio.h>
namespace cg = cooperative_groups;

#ifndef PHMASK
#define PHMASK 0x7ff
#endif
#ifndef N_LAUNCHES
#define N_LAUNCHES 1
#endif

typedef unsigned short bf16_t;
typedef short bf16x8 __attribute__((ext_vector_type(8)));
typedef float f32x4 __attribute__((ext_vector_type(4)));
typedef unsigned u32x4 __attribute__((ext_vector_type(4)));
typedef float f32x2 __attribute__((ext_vector_type(2)));
typedef unsigned u32x2 __attribute__((ext_vector_type(2)));
typedef __bf16 bf16x2 __attribute__((ext_vector_type(2)));

#define NB 8
#define SEQ 2048
#define DM 1024
#define CTXL 256
#define TL 16384
#define TC 2048
#define TR 18432
#define LDP 2624
#define NPADIN 2688
#define NTHR 256
#define LDS_HALF 73728
#define NPH 11

#define OFF_MOD    (4096ull)
#define OFF_GATES  (OFF_MOD + 262144ull)
#define OFF_WTIN   (OFF_GATES + 1179648ull)
#define OFF_WTOUT  (OFF_WTIN + 5767168ull)
#define OFF_WTQ    (OFF_WTOUT + 2097152ull)
#define OFF_KEYS   (OFF_WTQ + 4194304ull)
#define OFF_POOLWT (OFF_KEYS + 524288ull)
#define OFF_HN     (OFF_POOLWT + 131072ull)
#define OFF_PL     (OFF_HN + 37748736ull)
#define OFF_D      (OFF_PL + 96731136ull)
#define OFF_ND     (OFF_D + 37748736ull)
#define OFF_SC     (OFF_ND + 589824ull)
#define OFF_CIN    (OFF_SC + 147456ull)
#define OFF_NIN    (OFF_CIN + 33554432ull)
#define OFF_MIN    (OFF_NIN + 524288ull)
#define OFF_EIDX   (OFF_MIN + 131072ull)
#define OFF_GATE   (OFF_EIDX + 4194304ull)
#define OFF_U8     (OFF_GATE + 8388608ull)
#define WS_END     (OFF_U8 + 33554432ull)

struct P {
  const float *x, *c, *ctx, *c_ctx, *w_mod, *b_mod, *norm1_w, *w_in, *conv_w, *conv_b, *b_gates, *head_norm_w,
      *pool_w, *pool_scale, *w_out, *norm2_w, *wq, *keys, *U, *V, *final_norm_w;
  float* out;
  float* mod;
  float* gates;
  bf16_t* wt_in;
  bf16_t* wt_out;
  bf16_t* wt_q;
  bf16_t* keys_bf;
  bf16_t* hn;
  bf16_t* pl;
  bf16_t* Dst;
  float* ND;
  float* SC;
  bf16_t* CIN;
  float* NIN;
  float* MIN_;
  bf16_t* mix;
  bf16_t* qb;
  unsigned char* U8;
  unsigned char* V8;
  unsigned short* eidx;
  float* gate;
  int ph_lo, ph_hi;
  unsigned* flg;
  unsigned* bar;
};

__device__ __forceinline__ bf16_t f2bf(float f) { return __builtin_bit_cast(bf16_t, (__bf16)f); }
__device__ __forceinline__ float bf2f(bf16_t h) { return __uint_as_float(((unsigned)h) << 16); }
__device__ __forceinline__ float wave_sum(float v) {
#pragma unroll
  for (int o = 32; o > 0; o >>= 1) v += __shfl_xor(v, o);
  return v;
}
__device__ __forceinline__ float silu_f(float v) { return v / (1.f + __expf(-v)); }
__device__ __forceinline__ float logsig_f(float v) { return fminf(v, 0.f) - log1pf(__expf(-fabsf(v))); }

__device__ __forceinline__ __amdgpu_buffer_rsrc_t mk_rsrc(const void* ptr) { return __builtin_amdgcn_make_buffer_rsrc((void*)ptr, 0, 0x7fffffff, 0x00020000); }
__device__ __forceinline__ bf16x8 bload8(__amdgpu_buffer_rsrc_t r, int voff, int soff) { return __builtin_bit_cast(bf16x8, __builtin_amdgcn_raw_buffer_load_b128(r, voff, soff, 0)); }
#define AUX_SC1 16
__device__ __forceinline__ bf16x8 bload8c(__amdgpu_buffer_rsrc_t r, int voff, int soff) { return __builtin_bit_cast(bf16x8, __builtin_amdgcn_raw_buffer_load_b128(r, voff, soff, AUX_SC1)); }
__device__ __forceinline__ u32x2 uload2c(__amdgpu_buffer_rsrc_t r, int voff, int soff) { return __builtin_bit_cast(u32x2, __builtin_amdgcn_raw_buffer_load_b64(r, voff, soff, AUX_SC1)); }
__device__ __forceinline__ float fload1c(__amdgpu_buffer_rsrc_t r, int voff, int soff) { return __builtin_bit_cast(float, __builtin_amdgcn_raw_buffer_load_b32(r, voff, soff, AUX_SC1)); }
__device__ __forceinline__ f32x4 fload4c(__amdgpu_buffer_rsrc_t r, int voff, int soff) { return __builtin_bit_cast(f32x4, __builtin_amdgcn_raw_buffer_load_b128(r, voff, soff, AUX_SC1)); }
__device__ __forceinline__ void ustore4c(__amdgpu_buffer_rsrc_t r, int voff, u32x4 v) { __builtin_amdgcn_raw_buffer_store_b128(v, r, voff, 0, AUX_SC1); }
__device__ __forceinline__ void ustore2c(__amdgpu_buffer_rsrc_t r, int voff, u32x2 v) { __builtin_amdgcn_raw_buffer_store_b64(v, r, voff, 0, AUX_SC1); }
__device__ __forceinline__ u32x4 uload4c(__amdgpu_buffer_rsrc_t r, int voff, int soff) { return __builtin_bit_cast(u32x4, __builtin_amdgcn_raw_buffer_load_b128(r, voff, soff, AUX_SC1)); }

__device__ __forceinline__ void ph0_prep(const P& p, int bid, int nb, char* smem) {
  float* sm = (float*)smem;
  const int tid = threadIdx.x & 255;
  const int N_MOD = 384, N_TIN = 16 * 44, N_TOUT = 256, N_TQ = 16 * 32, N_POOL = 16;
  const int total = N_MOD + N_TIN + N_TOUT + N_TQ + N_POOL;
  const int trips = (total + nb - 1) / nb;
  for (int k = 0; k < trips; ++k) {
    int r = (bid + k * nb) % total;
    if (r < N_MOD) {
      float* part = sm + 9 * 1024;
      for (int i = tid; i < 9 * 1024; i += NTHR) {
        int rr = i >> 10, kq = i & 1023;
        float v = rr < 8 ? p.c[rr * 1024 + kq] : p.c_ctx[kq];
        sm[i] = silu_f(v);
      }
      __syncthreads();
      {
        const int c = tid & 15, kg = tid >> 4, n = r * 16 + c;
        float acc[9];
#pragma unroll
        for (int q = 0; q < 9; ++q) acc[q] = 0.f;
#pragma unroll 8
        for (int i = 0; i < 64; ++i) {
          const int kq = kg + i * 16;
          const float w = p.w_mod[(size_t)kq * 6144 + n];
#pragma unroll
          for (int q = 0; q < 9; ++q) acc[q] += sm[q * 1024 + kq] * w;
        }
#pragma unroll
        for (int q = 0; q < 9; ++q) part[(kg * 9 + q) * 16 + c] = acc[q];
      }
      __syncthreads();
      if (tid < 144) {
        const int q = tid >> 4, c = tid & 15, n = r * 16 + c;
        float t = p.b_mod[n];
#pragma unroll
        for (int kg = 0; kg < 16; ++kg) t += part[(kg * 9 + q) * 16 + c];
        p.mod[q * 6144 + n] = t;
      }
      continue;
    }
    r -= N_MOD;
    const float* src = nullptr; bf16_t* dst = nullptr; int K = 1024, N = 0, ntn = 0;
    if (r < N_TIN) { src = p.w_in; dst = p.wt_in; N = 2576; ntn = 44; }
    else { r -= N_TIN;
      if (r < N_TOUT) { src = p.w_out; dst = p.wt_out; N = 1024; ntn = 16; }
      else { r -= N_TOUT;
        if (r < N_TQ) { src = p.wq; dst = p.wt_q; N = 2048; ntn = 32; }
        else { r -= N_TQ; int g = r >> 2; r &= 3; src = p.pool_w + g * 16384; dst = (bf16_t*)((char*)p.keys_bf + 524288) + g * 16384; K = 128; N = 128; ntn = 2; }
      }
    }
    {
      int kt = r / ntn, nt = r % ntn, k0 = kt * 64, n0 = nt * 64;
      int cc = tid & 63;
      for (int rr = tid >> 6; rr < 64; rr += 4) {
        int n = n0 + cc;
        sm[rr * 65 + cc] = n < N ? src[(size_t)(k0 + rr) * N + n] : 0.f;
      }
      __syncthreads();
      for (int rr = tid >> 6; rr < 64; rr += 4) dst[(size_t)(n0 + rr) * K + k0 + cc] = f2bf(sm[cc * 65 + rr]);
      __syncthreads();
    }
  }
  for (int i = bid * NTHR + tid; i < 262144; i += nb * NTHR) p.keys_bf[i] = f2bf(p.keys[i]);
}

template <int WHICH>
__device__ __forceinline__ void ph_norm_rows(const P& p, int bid, int nb) {
  const int wave = (threadIdx.x >> 6) & 3, lane = threadIdx.x & 63;
  const int nrows = WHICH == 0 ? TR : TL;
  for (int row = bid * 4 + wave; row < nrows; row += nb * 4) {
    const float* src = WHICH == 0 ? (row < TL ? p.x + (size_t)row * 1024 : p.ctx + (size_t)(row - TL) * 1024) : p.out + (size_t)row * 1024;
    const int mr = row < TL ? row / SEQ : 8;
    float4 v[4];
    float ss = 0.f;
#pragma unroll
    for (int j = 0; j < 4; ++j) {
      if (WHICH == 1) { const f32x4 t = fload4c(mk_rsrc(p.out), (row * 1024 + (j * 64 + lane) * 4) * 4, 0); v[j] = make_float4(t[0], t[1], t[2], t[3]); }
      else v[j] = ((const float4*)src)[j * 64 + lane];
      ss += v[j].x * v[j].x + v[j].y * v[j].y + v[j].z * v[j].z + v[j].w * v[j].w;
    }
    ss = wave_sum(ss);
    const float rstd = rsqrtf(ss * (1.f / 1024.f) + 1e-6f);
    const float* nw = WHICH == 0 ? p.norm1_w : p.norm2_w;
    const float* sh = p.mod + mr * 6144 + (WHICH == 0 ? 0 : 3) * 1024;
    const float* sc = sh + 1024;
#pragma unroll
    for (int j = 0; j < 4; ++j) {
      const int col = j * 256 + lane * 4;
      float4 w4 = *(const float4*)(nw + col), s4 = *(const float4*)(sh + col), c4 = *(const float4*)(sc + col);
      float y0 = v[j].x * rstd * w4.x * (1.f + c4.x) + s4.x;
      float y1 = v[j].y * rstd * w4.y * (1.f + c4.y) + s4.y;
      float y2 = v[j].z * rstd * w4.z * (1.f + c4.z) + s4.z;
      float y3 = v[j].w * rstd * w4.w * (1.f + c4.w) + s4.w;
      uint2 o;
      o.x = (unsigned)f2bf(y0) | ((unsigned)f2bf(y1) << 16);
      o.y = (unsigned)f2bf(y2) | ((unsigned)f2bf(y3) << 16);
      ustore2c(mk_rsrc(p.hn), (row * 1024 + col) * 2, (u32x2){o.x, o.y});
    }
  }
}

#define GBK 64
#define GLD 72
template <int EPI>
__device__ __forceinline__ void gemm_tile(const P& p, const bf16_t* A, int lda, const bf16_t* Bt, int m0, int n0, bf16_t* sA, bf16_t* sB) {
  const int tid = threadIdx.x & 255, lane = tid & 63, wave = tid >> 6;
  const int wm = wave >> 1, wn = wave & 1;
  const int lr = lane & 15, lq = lane >> 4;
  f32x4 acc[4][4];
#pragma unroll
  for (int i = 0; i < 4; ++i)
#pragma unroll
    for (int j = 0; j < 4; ++j) acc[i][j] = (f32x4){0.f, 0.f, 0.f, 0.f};
  const int sr = tid >> 3, scol = (tid & 7) * 8;
  u32x4 ra[4], rb[4];
  const bf16_t* Ap = A + (size_t)(m0 + sr) * lda + scol;
  const bf16_t* Bp = Bt + (size_t)(n0 + sr) * 1024 + scol;
#pragma unroll
  for (int i = 0; i < 4; ++i) {
    ra[i] = *(const u32x4*)(Ap + (size_t)(i * 32) * lda);
    rb[i] = *(const u32x4*)(Bp + (size_t)(i * 32) * 1024);
  }
  for (int kt = 0; kt < 1024 / GBK; ++kt) {
    __syncthreads();
#pragma unroll
    for (int i = 0; i < 4; ++i) {
      *(u32x4*)(sA + (sr + i * 32) * GLD + scol) = ra[i];
      *(u32x4*)(sB + (sr + i * 32) * GLD + scol) = rb[i];
    }
    __syncthreads();
    {
      const int k0 = (kt + 1 < 1024 / GBK ? kt + 1 : kt) * GBK;
#pragma unroll
      for (int i = 0; i < 4; ++i) {
        ra[i] = *(const u32x4*)(Ap + (size_t)(i * 32) * lda + k0);
        rb[i] = *(const u32x4*)(Bp + (size_t)(i * 32) * 1024 + k0);
      }
    }
#pragma unroll
    for (int ks = 0; ks < 2; ++ks) {
      bf16x8 af[4], bfr[4];
#pragma unroll
      for (int i = 0; i < 4; ++i) {
        af[i] = *(const bf16x8*)(sA + (wm * 64 + i * 16 + lr) * GLD + ks * 32 + lq * 8);
        bfr[i] = *(const bf16x8*)(sB + (wn * 64 + i * 16 + lr) * GLD + ks * 32 + lq * 8);
      }
#pragma unroll
      for (int i = 0; i < 4; ++i)
#pragma unroll
        for (int j = 0; j < 4; ++j) acc[i][j] = __builtin_amdgcn_mfma_f32_16x16x32_bf16(af[i], bfr[j], acc[i][j], 0, 0, 0);
    }
  }
#pragma unroll
  for (int i = 0; i < 4; ++i)
#pragma unroll
    for (int j = 0; j < 4; ++j)
#pragma unroll
      for (int e = 0; e < 4; ++e) {
        const int row = m0 + wm * 64 + i * 16 + lq * 4 + e;
        const int col = n0 + wn * 64 + j * 16 + lr;
        const float v = acc[i][j][e];
        if (EPI == 0) {
          if (col < 2560) p.pl[(size_t)row * LDP + col] = f2bf(v);
          else if (col < 2576) p.gates[(size_t)row * 16 + (col - 2560)] = v;
        } else if (EPI == 1) {
          const int b = row / SEQ;
          p.out[(size_t)row * 1024 + col] = p.x[(size_t)row * 1024 + col] + p.mod[b * 6144 + 2 * 1024 + col] * v;
        } else {
          p.qb[(size_t)row * 2048 + col] = f2bf(v);
        }
      }
}

template <int EPI>
__device__ __forceinline__ void ph_gemm(const P& p, int bid, int nb, char* smem) {
  bf16_t* sA = (bf16_t*)smem;
  bf16_t* sB = sA + 128 * GLD;
  const int ntn = EPI == 0 ? 21 : (EPI == 1 ? 8 : 16);
  const int ntm = EPI == 0 ? 144 : 128;
  const bf16_t* A = EPI == 0 ? p.hn : (EPI == 1 ? p.mix : p.hn);
  const int lda = 1024;
  const bf16_t* Bt = EPI == 0 ? p.wt_in : (EPI == 1 ? p.wt_out : p.wt_q);
  const int nlat = 128 * ntn;
  const int ntiles = EPI == 0 ? nlat + 16 * 13 : ntm * ntn;
  const int trips = (ntiles + nb - 1) / nb;
  for (int k = 0; k < trips; ++k) {
    const int t = (bid + k * nb) % ntiles;
    int tm, tn;
    if (EPI == 0 && t >= nlat) { const int r = t - nlat; tm = 128 + r / 13; tn = r % 13; if (tn == 12) tn = 20; }
    else { tm = t / ntn; tn = t % ntn; }
    gemm_tile<EPI>(p, A, lda, Bt, tm * 128, tn * 128, sA, sB);
  }
}

struct UnitInfo { int isctx, b, c, h, T, seqrow0, row0; };
__device__ __forceinline__ UnitInfo decode_unit(int u) {
  UnitInfo r;
  if (u < 512) { r.isctx = 0; r.b = u >> 6; r.c = (u >> 2) & 15; r.h = u & 3; r.T = SEQ; r.seqrow0 = r.b * SEQ; }
  else { int uu = u - 512; r.isctx = 1; r.b = uu >> 3; r.c = (uu >> 2) & 1; r.h = uu & 3; r.T = CTXL; r.seqrow0 = TL + r.b * CTXL; }
  r.row0 = r.seqrow0 + r.c * 128;
  return r;
}
__device__ __forceinline__ float qk_act(const P& p, int seqrow0, int T, int t, int col) {
  const bf16_t* base = p.pl + (size_t)(seqrow0 + t) * LDP + col;
  float r0 = t > 0 ? bf2f(base[-LDP]) : 0.f;
  float r1 = bf2f(base[0]);
  float r2 = t + 1 < T ? bf2f(base[LDP]) : 0.f;
  float y = p.conv_b[col] + r0 * p.conv_w[col] + r1 * p.conv_w[1024 + col] + r2 * p.conv_w[2048 + col];
  return silu_f(y);
}


typedef short s16x4 __attribute__((ext_vector_type(4)));
#define LDS_AS __attribute__((address_space(3)))
__device__ __forceinline__ s16x4 ds_tr16(const bf16_t* ptr) { return __builtin_amdgcn_ds_read_tr16_b64_v4i16((LDS_AS s16x4*)ptr); }
__device__ __forceinline__ bf16x8 frag_tr(const bf16_t* M, int ld, int s0, int c0, int lr, int lq) {
  const bf16_t* a = M + (s0 + lq * 8 + (lr >> 2)) * ld + c0 + (lr & 3) * 4;
  const s16x4 t0 = ds_tr16(a), t1 = ds_tr16(a + 4 * ld);
  return __builtin_shufflevector(t0, t1, 0, 1, 2, 3, 4, 5, 6, 7);
}
__device__ __forceinline__ unsigned cvt_pk_bf16(float lo, float hi) { const f32x2 v = {lo, hi}; const bf16x2 b = __builtin_convertvector(v, bf16x2); return __builtin_bit_cast(unsigned, b); }
__device__ __forceinline__ float blo(unsigned u) { return __uint_as_float(u << 16); }
__device__ __forceinline__ float bhi(unsigned u) { return __uint_as_float(u & 0xffff0000u); }
#define VLD 136


namespace pg8 {
#define PG8_LAS __attribute__((address_space(3)))
constexpr int BM = 256, BK = 64, HALF = 128, HTB = HALF * BK * 2, STAGE_BYTES = 8 * HTB, NXCD = 8, WGM = 8;
__host__ __device__ __forceinline__ int lds_byte(int r, int c) { const int st = (r >> 4) * 2 + (c >> 5), rr = r & 15, cc = c & 31, ob = rr * 64 + cc * 2; return st * 1024 + (ob ^ (((ob >> 9) & 1) << 5)); }
__host__ __device__ __forceinline__ void stage_rc(int b, int& R, int& C) { const int st = b / 1024, sb = b % 1024, swz = sb ^ (((sb >> 9) & 1) << 5); R = (st >> 1) * 16 + swz / 64; C = (st & 1) * 32 + (swz % 64) / 2; }
__host__ __device__ __forceinline__ int perm32(int rho) { const int n = rho >> 4, i = rho & 15; return 8 * (i >> 2) + 4 * n + (i & 3); }
struct Unit { int pm, pn; };
struct Gemm { const bf16_t* A; const bf16_t* Bt; int M, N, K; };
struct Order {
  int nM, nN, nwg, G, c, extra;
  __device__ void init(int nM_, int nN_, int G_, int c_, int extra_) { nM = nM_; nN = nN_; nwg = nM * nN; G = G_; c = c_; extra = extra_; }
  __device__ bool next(int i, Unit& u) const {
    const long L = (long)i * G + c;
    if (L >= nwg + extra) return false;
    if (L >= nwg) { const int r = (int)L - nwg; u.pm = nM + r / 7; const int q = r % 7; u.pn = q < 6 ? q : 10; return true; }
    int wgid = (int)L; { const int q = nwg / NXCD, r = nwg % NXCD, xcd = wgid % NXCD, off = wgid / NXCD; wgid = (xcd < r ? xcd * (q + 1) : r * (q + 1) + (xcd - r) * q) + off; }
    const int nig = WGM * nN, gid = wgid / nig, fm = gid * WGM, gsz = (nM - fm) < WGM ? (nM - fm) : WGM;
    u.pm = fm + ((wgid % nig) % gsz); u.pn = (wgid % nig) / gsz; return true;
  }
  __device__ __forceinline__ void a_ready(const Unit&) const {}
  __device__ __forceinline__ void done(const Unit&) const {}
};
template <class Epi, class Sched>
__device__ __forceinline__ void gemm_phase(PG8_LAS unsigned char* lds, const Gemm g, const Sched& S, const Epi& E) {
    const int tid = threadIdx.x, wid = __builtin_amdgcn_readfirstlane(tid >> 6), lane = tid & 63, wr = wid >> 2, wc = wid & 3, fr = lane & 15, fq = lane >> 4;
    const int K = g.K, nt = K / BK;
    unsigned voffA[2], voffB[2];
#pragma unroll
    for (int i = 0; i < 2; ++i) { int R, C; stage_rc(tid * 16 + i * 8192, R, C); const int Rb = Epi::PERM ? ((R & ~31) + perm32(R & 31)) : R;
        voffA[i] = (unsigned)(R * K + C) * 2u; voffB[i] = (unsigned)(Rb * K + C) * 2u; }
    const size_t kstep = (size_t)(BK * 2);
    const size_t hstep = (size_t)HALF * K * 2;
    const size_t tstep = 2 * hstep;
    const unsigned ldsw = (unsigned)wid * 1024u;
    const int aoff = lds_byte(wr * 64 + fr, fq * 8), boff = lds_byte(wc * 32 + fr, fq * 8);
#define PG8_SA(b, h) (((b) * 2 + (h)) * HTB)
#define PG8_SB(b, h) ((4 + (b) * 2 + (h)) * HTB)
#define PG8_STAGE_X(bufoff, gbase, voff, aux) do { _Pragma("unroll") for (int _i = 0; _i < 2; ++_i) \
        __builtin_amdgcn_global_load_lds((const unsigned*)((const char*)(gbase) + (voff)[_i]), (PG8_LAS unsigned*)(lds + (bufoff) + ldsw + _i * 8192), 16, 0, aux); } while (0)
#define PG8_STAGE(bufoff, gbase, voff) PG8_STAGE_X(bufoff, gbase, voff, 0)
#define PG8_STAGE_A(bufoff, gbase, voff) do { if (Epi::A_COHERENT) PG8_STAGE_X(bufoff, gbase, voff, AUX_SC1); else PG8_STAGE_X(bufoff, gbase, voff, 0); } while (0)
#define PG8_LDA(dst, b, h) do { _Pragma("unroll") for (int m = 0; m < 4; ++m) _Pragma("unroll") for (int k = 0; k < 2; ++k) dst[m][k] = *(const PG8_LAS bf16x8*)(lds + PG8_SA(b, h) + aoff + m * 2048 + k * 1024); } while (0)
#define PG8_LDB(dst, b, h) do { _Pragma("unroll") for (int n = 0; n < 2; ++n) _Pragma("unroll") for (int k = 0; k < 2; ++k) dst[n][k] = *(const PG8_LAS bf16x8*)(lds + PG8_SB(b, h) + boff + n * 2048 + k * 1024); } while (0)
#define PG8_MMA(ai, bj, At, Bt) do { __builtin_amdgcn_s_setprio(1); _Pragma("unroll") for (int m = 0; m < 4; ++m) _Pragma("unroll") for (int n = 0; n < 2; ++n) _Pragma("unroll") for (int k = 0; k < 2; ++k) \
        acc[ai][bj][m][n] = __builtin_amdgcn_mfma_f32_16x16x32_bf16(Bt[n][k], At[m][k], acc[ai][bj][m][n], 0, 0, 0); __builtin_amdgcn_s_setprio(0); } while (0)
#define PG8_WAIT_V(n) asm volatile("s_waitcnt vmcnt(" #n ")" ::: "memory")
#define PG8_WAIT_L(n) asm volatile("s_waitcnt lgkmcnt(" #n ")" ::: "memory")
#define PG8_BAR __builtin_amdgcn_s_barrier()
#define PG8_SCHED __builtin_amdgcn_sched_barrier(0)
    Unit cur, nxt; int ui = 0;
    if (!S.next(0, cur)) return;
    f32x4 acc[2][2][4][2];
#pragma unroll
    for (int a = 0; a < 2; ++a)
#pragma unroll
        for (int b = 0; b < 2; ++b)
#pragma unroll
            for (int m = 0; m < 4; ++m)
#pragma unroll
                for (int n = 0; n < 2; ++n) acc[a][b][m][n] = (f32x4){0.f, 0.f, 0.f, 0.f};
    bf16x8 At[4][2], B0[2][2], B1[2][2];
    const char* cA = (const char*)g.A + (size_t)cur.pm * tstep; const char* cB = (const char*)g.Bt + (size_t)cur.pn * tstep;
    S.a_ready(cur);
    PG8_STAGE(PG8_SB(0, 0), cB, voffB); PG8_STAGE_A(PG8_SA(0, 0), cA, voffA); PG8_STAGE(PG8_SB(0, 1), cB + hstep, voffB); PG8_STAGE_A(PG8_SA(0, 1), cA + hstep, voffA);
    if (wr == 1) PG8_BAR;
    PG8_WAIT_V(4); PG8_BAR;
    PG8_STAGE(PG8_SB(1, 0), cB + kstep, voffB); PG8_STAGE_A(PG8_SA(1, 0), cA + kstep, voffA); PG8_STAGE(PG8_SB(1, 1), cB + hstep + kstep, voffB);
    PG8_WAIT_V(6); PG8_BAR;
    for (;;) {
        const bool has_next = S.next(ui + 1, nxt);
        const char* nA = has_next ? (const char*)g.A + (size_t)nxt.pm * tstep : cA; const char* nB = has_next ? (const char*)g.Bt + (size_t)nxt.pn * tstep : cB;
        for (int t = 0; t < nt; t += 2) {
            const bool last = (t == nt - 2);
            const char* a1 = cA + (size_t)(t + 1) * kstep;
            const char* a2 = last ? nA : cA + (size_t)(t + 2) * kstep; const char* b2 = last ? nB : cB + (size_t)(t + 2) * kstep;
            const char* a3 = a2 + kstep; const char* b3 = b2 + kstep;
            if (last && has_next) S.a_ready(nxt);
            PG8_LDB(B0, 0, 0); PG8_SCHED; PG8_LDA(At, 0, 0); PG8_STAGE_A(PG8_SA(1, 1), a1 + hstep, voffA);
            PG8_WAIT_L(8); PG8_BAR; PG8_WAIT_L(0); PG8_MMA(0, 0, At, B0); PG8_BAR; PG8_SCHED;
            PG8_LDB(B1, 0, 1); PG8_STAGE(PG8_SB(0, 0), b2, voffB);
            PG8_BAR; PG8_WAIT_L(0); PG8_MMA(0, 1, At, B1); PG8_BAR;
            PG8_LDA(At, 0, 1); PG8_STAGE_A(PG8_SA(0, 0), a2, voffA);
            PG8_BAR; PG8_WAIT_L(0); PG8_MMA(1, 0, At, B0); PG8_BAR; PG8_SCHED;
            PG8_STAGE(PG8_SB(0, 1), b2 + hstep, voffB);
            PG8_WAIT_V(6); PG8_BAR; PG8_MMA(1, 1, At, B1); PG8_BAR;
            PG8_LDB(B0, 1, 0); PG8_SCHED; PG8_LDA(At, 1, 0); PG8_STAGE_A(PG8_SA(0, 1), a2 + hstep, voffA);
            PG8_WAIT_L(8); PG8_BAR; PG8_WAIT_L(0); PG8_MMA(0, 0, At, B0); PG8_BAR; PG8_SCHED;
            PG8_LDB(B1, 1, 1); PG8_STAGE(PG8_SB(1, 0), b3, voffB);
            PG8_BAR; PG8_WAIT_L(0); PG8_MMA(0, 1, At, B1); PG8_BAR;
            PG8_LDA(At, 1, 1); PG8_STAGE_A(PG8_SA(1, 0), a3, voffA);
            PG8_BAR; PG8_WAIT_L(0); PG8_MMA(1, 0, At, B0); PG8_BAR; PG8_SCHED;
            PG8_STAGE(PG8_SB(1, 1), b3 + hstep, voffB);
            PG8_WAIT_V(6); PG8_BAR; PG8_MMA(1, 1, At, B1); PG8_BAR;
        }
        if constexpr (!Epi::AFTER_DRAIN) { E(acc, cur, wr, wc, fr, fq); S.done(cur); }
        if (!has_next) break;
#pragma unroll
        for (int a = 0; a < 2; ++a)
#pragma unroll
            for (int b = 0; b < 2; ++b)
#pragma unroll
                for (int m = 0; m < 4; ++m)
#pragma unroll
                    for (int n = 0; n < 2; ++n) acc[a][b][m][n] = (f32x4){0.f, 0.f, 0.f, 0.f};
        cur = nxt; cA = nA; cB = nB; ++ui;
    }
    PG8_WAIT_V(0);
    if (wr == 0) PG8_BAR;
    PG8_BAR;
    if constexpr (Epi::AFTER_DRAIN) { E.fused(acc, cur, wr, wc, fr, fq, lds, wid, lane); S.done(cur); }
#undef PG8_SA
#undef PG8_SB
#undef PG8_STAGE
#undef PG8_LDA
#undef PG8_LDB
#undef PG8_MMA
#undef PG8_WAIT_V
#undef PG8_WAIT_L
#undef PG8_BAR
#undef PG8_SCHED
}
}

struct EpiIn {
  static constexpr bool PERM = true, AFTER_DRAIN = false, A_COHERENT = true;
  bf16_t* pl; float* gates;
  __device__ __forceinline__ void operator()(const f32x4 (&acc)[2][2][4][2], const pg8::Unit& u, int wr, int wc, int fr, int fq) const {
    const int row0 = u.pm * 256 + wr * 64 + fr;
#pragma unroll
    for (int ai = 0; ai < 2; ++ai)
#pragma unroll
      for (int m = 0; m < 4; ++m) {
        const int row = row0 + ai * 128 + m * 16;
#pragma unroll
        for (int bj = 0; bj < 2; ++bj) {
          const int c0 = u.pn * 256 + bj * 128 + wc * 32 + 8 * fq;
          const f32x4 v0 = acc[ai][bj][m][0], v1 = acc[ai][bj][m][1];
          if (c0 < 2560) {
            u32x4 w;
            w[0] = cvt_pk_bf16(v0[0], v0[1]); w[1] = cvt_pk_bf16(v0[2], v0[3]); w[2] = cvt_pk_bf16(v1[0], v1[1]); w[3] = cvt_pk_bf16(v1[2], v1[3]);
            *(u32x4*)(pl + (size_t)row * LDP + c0) = w;
          } else if (c0 < 2576) {
            *(f32x4*)(gates + (size_t)row * 16 + (c0 - 2560)) = v0;
            *(f32x4*)(gates + (size_t)row * 16 + (c0 - 2560) + 4) = v1;
          }
        }
      }
  }
};
struct EpiOut {
  static constexpr bool PERM = false, AFTER_DRAIN = false, A_COHERENT = true;
  const float* x; const float* mod; float* out;
  __device__ __forceinline__ void operator()(const f32x4 (&acc)[2][2][4][2], const pg8::Unit& u, int wr, int wc, int fr, int fq) const {
    const int row0 = u.pm * 256 + wr * 64 + fr, col0 = u.pn * 256 + wc * 32 + 4 * fq;
    const float* g1 = mod + (u.pm * 256 / SEQ) * 6144 + 2 * 1024;
#pragma unroll
    for (int ai = 0; ai < 2; ++ai)
#pragma unroll
      for (int m = 0; m < 4; ++m) {
        const size_t ro = (size_t)(row0 + ai * 128 + m * 16) * 1024;
#pragma unroll
        for (int bj = 0; bj < 2; ++bj)
#pragma unroll
          for (int n = 0; n < 2; ++n) {
            const int c = col0 + bj * 128 + n * 16;
            const f32x4 xv = *(const f32x4*)(x + ro + c), gv = *(const f32x4*)(g1 + c);
            *(f32x4*)(out + ro + c) = xv + gv * acc[ai][bj][m][n];
          }
      }
  }
};
struct EpiQ {
  static constexpr bool PERM = true, AFTER_DRAIN = false, A_COHERENT = true;
  bf16_t* q;
  __device__ __forceinline__ void operator()(const f32x4 (&acc)[2][2][4][2], const pg8::Unit& u, int wr, int wc, int fr, int fq) const {
    const int row0 = u.pm * 256 + wr * 64 + fr;
#pragma unroll
    for (int ai = 0; ai < 2; ++ai)
#pragma unroll
      for (int m = 0; m < 4; ++m)
#pragma unroll
        for (int bj = 0; bj < 2; ++bj) {
          const int c0 = u.pn * 256 + bj * 128 + wc * 32 + 8 * fq;
          const f32x4 v0 = acc[ai][bj][m][0], v1 = acc[ai][bj][m][1];
          u32x4 w;
          w[0] = cvt_pk_bf16(v0[0], v0[1]); w[1] = cvt_pk_bf16(v0[2], v0[3]); w[2] = cvt_pk_bf16(v1[0], v1[1]); w[3] = cvt_pk_bf16(v1[2], v1[3]);
          *(u32x4*)(q + (size_t)(row0 + ai * 128 + m * 16) * 2048 + c0) = w;
        }
  }
};
template <int EPI>
__device__ __forceinline__ void ph_gemm8(const P& p, char* lds_all) {
  PG8_LAS unsigned char* lds = (PG8_LAS unsigned char*)lds_all;
  pg8::Order S;
  if (EPI == 0) {
    S.init(64, 11, gridDim.x, blockIdx.x, 56);
    const pg8::Gemm g{p.hn, p.wt_in, TR, 2816, 1024};
    const EpiIn E{p.pl, p.gates};
    pg8::gemm_phase<EpiIn, pg8::Order>(lds, g, S, E);
  } else if (EPI == 1) {
    S.init(64, 4, gridDim.x, blockIdx.x, 0);
    const pg8::Gemm g{p.mix, p.wt_out, TL, 1024, 1024};
    const EpiOut E{p.x, p.mod, p.out};
    pg8::gemm_phase<EpiOut, pg8::Order>(lds, g, S, E);
  } else {
    S.init(64, 8, gridDim.x, blockIdx.x, 0);
    const pg8::Gemm g{p.hn, p.wt_q, TL, 2048, 1024};
    const EpiQ E{p.qb};
    pg8::gemm_phase<EpiQ, pg8::Order>(lds, g, S, E);
  }
}

template <bool REV>
__device__ __forceinline__ void scan128(const float* lf, const float* ig, float* bout, float* gout, float* pmout, float& Gtot, float& btot, int lane, float& g0o, float& g1o) {
  const int t0 = REV ? 127 - 2 * lane : 2 * lane, t1 = REV ? 126 - 2 * lane : 2 * lane + 1;
  const float v0 = lf[t0], v1 = lf[t1];
  float sacc = v0 + v1;
#pragma unroll
  for (int off = 1; off < 64; off <<= 1) { const float t = __shfl_up(sacc, off); if (lane >= off) sacc += t; }
  const float b1 = sacc, b0 = sacc - v1;
  const float g0 = ig[t0] - b0, g1 = ig[t1] - b1;
  float m = fmaxf(g0, g1);
#pragma unroll
  for (int off = 1; off < 64; off <<= 1) { const float t = __shfl_up(m, off); if (lane >= off) m = fmaxf(m, t); }
  float prev = __shfl_up(m, 1);
  if (lane == 0) prev = -3.0e38f;
  if (bout) { bout[t0] = b0; bout[t1] = b1; }
  if (gout) { gout[t0] = g0; gout[t1] = g1; }
  g0o = g0; g1o = g1;
  if (pmout) { pmout[t0] = fmaxf(prev, g0); pmout[t1] = m; }
  Gtot = __shfl(m, 63); btot = __shfl(sacc, 63);
}

__device__ __forceinline__ void ph_convert_tables(const P& p, int bid, int nb) {
  const int wave = (threadIdx.x >> 6) & 3, lane = threadIdx.x & 63;
  for (int row = bid * 4 + wave; row < 32768; row += nb * 4) {
    const bool isu = row < 16384;
    const float* src = isu ? p.U + (size_t)row * 1024 : p.V + (size_t)(row - 16384) * 1024;
    unsigned char* dst = isu ? p.U8 + (size_t)row * 1024 : p.V8 + (size_t)(row - 16384) * 1024;
    const float sc = isu ? 512.f : 32.f;
#pragma unroll
    for (int j = 0; j < 4; ++j) {
      const f32x4 v = __builtin_nontemporal_load((const f32x4*)src + j * 64 + lane);
      int w = 0;
      w = __builtin_amdgcn_cvt_pk_fp8_f32(v.x * sc, v.y * sc, w, false);
      w = __builtin_amdgcn_cvt_pk_fp8_f32(v.z * sc, v.w * sc, w, true);
      *(int*)(dst + j * 256 + lane * 4) = w;
    }
  }
}

__device__ __forceinline__ void ph3_chunk_local(const P& p, int bid, int nb, char* smem) {
  bf16_t* Vs = (bf16_t*)smem;
  bf16_t* Ks = Vs + 128 * VLD;
  float* fa = (float*)(Ks + 128 * VLD);
  float *igf = fa, *lff = fa + 128, *igb = fa + 256, *lfb = fa + 384, *ef = fa + 512, *eb = fa + 640, *scal = fa + 768;
  const int tid = threadIdx.x & 255, lane = tid & 63, wave = tid >> 6, lr = lane & 15, lq = lane >> 4;
  const int trips3 = (576 + nb - 1) / nb;
  for (int k3 = 0; k3 < trips3; ++k3) {
    const int u = bid + k3 * nb;
    if (u >= 576) {
      __syncthreads(); __syncthreads(); __syncthreads();
      ph_convert_tables(p, u - 576, trips3 * nb - 576);
      continue;
    }
    const UnitInfo ui = decode_unit(u);
    const int h = ui.h;
    if (tid < 128) {
      const float* g = p.gates + (size_t)(ui.row0 + tid) * 16;
      igf[tid] = g[h] + p.b_gates[h];
      lff[tid] = logsig_f(g[4 + h] + p.b_gates[4 + h]);
      igb[tid] = g[8 + h] + p.b_gates[8 + h];
      lfb[tid] = logsig_f(g[12 + h] + p.b_gates[12 + h]);
    }
    {
      const int dch = tid & 15, colq = h * 128 + dch * 8, colk = 512 + colq;
#pragma unroll 1
      for (int which = 0; which < 2; ++which) {
        if (which == 1 && ui.isctx) break;
        const int col = which == 0 ? colk : colq;
        float w0[8], w1[8], w2[8], bb[8];
#pragma unroll
        for (int i = 0; i < 8; ++i) { w0[i] = p.conv_w[col + i]; w1[i] = p.conv_w[1024 + col + i]; w2[i] = p.conv_w[2048 + col + i]; bb[i] = p.conv_b[col + i]; }
        const float scl = which == 0 ? 0.08838834764831845f : 1.f;
#pragma unroll 1
        for (int ib = 0; ib < 8; ib += 4) {
        u32x4 r0a[4], r1a[4], r2a[4];
#pragma unroll
        for (int i2 = 0; i2 < 4; ++i2) {
          const int t = (tid >> 4) + (ib + i2) * 16, tt = ui.c * 128 + t;
          const bf16_t* base = p.pl + (size_t)(ui.row0 + t) * LDP + col;
          const u32x4 z4 = (u32x4){0u, 0u, 0u, 0u};
          r1a[i2] = *(const u32x4*)base;
          r0a[i2] = tt > 0 ? *(const u32x4*)(base - LDP) : z4;
          r2a[i2] = tt + 1 < ui.T ? *(const u32x4*)(base + LDP) : z4;
        }
#pragma unroll
        for (int i2 = 0; i2 < 4; ++i2) {
          const int t = (tid >> 4) + (ib + i2) * 16;
          const u32x4 r0 = r0a[i2], r1 = r1a[i2], r2 = r2a[i2];
          float y[8];
#pragma unroll
          for (int q = 0; q < 4; ++q) {
            y[2 * q] = silu_f(bb[2 * q] + blo(r0[q]) * w0[2 * q] + blo(r1[q]) * w1[2 * q] + blo(r2[q]) * w2[2 * q]) * scl;
            y[2 * q + 1] = silu_f(bb[2 * q + 1] + bhi(r0[q]) * w0[2 * q + 1] + bhi(r1[q]) * w1[2 * q + 1] + bhi(r2[q]) * w2[2 * q + 1]) * scl;
          }
          u32x4 o;
#pragma unroll
          for (int q = 0; q < 4; ++q) o[q] = cvt_pk_bf16(y[2 * q], y[2 * q + 1]);
          if (which == 0) *(u32x4*)(Ks + t * VLD + dch * 8) = o;
          if (!ui.isctx) ustore4c(mk_rsrc(p.hn), ((ui.row0 + t) * 1024 + col) * 2, o);
        }
        }
      }
#pragma unroll
      for (int i = 0; i < 8; ++i) {
        const int t = (tid >> 4) + i * 16;
        *(u32x4*)(Vs + t * VLD + dch * 8) = *(const u32x4*)(p.pl + (size_t)(ui.row0 + t) * LDP + 1024 + h * 128 + dch * 8);
      }
    }
    __syncthreads();
    if (wave == 0) {
      float G, bt, ga, gb2;
      scan128<false>(lff, igf, nullptr, nullptr, nullptr, G, bt, lane, ga, gb2);
      ef[2 * lane] = __expf(ga - G); ef[2 * lane + 1] = __expf(gb2 - G);
      if (lane == 0) { scal[0] = G; scal[1] = bt; }
    } else if (wave == 1) {
      float G, bt, ga, gb2;
      scan128<true>(lfb, igb, nullptr, nullptr, nullptr, G, bt, lane, ga, gb2);
      eb[127 - 2 * lane] = __expf(ga - G); eb[126 - 2 * lane] = __expf(gb2 - G);
      if (lane == 0) { scal[2] = G; scal[3] = bt; }
    }
    __syncthreads();
#pragma unroll 1
    for (int dir = 0; dir < 2; ++dir) {
      const float* ee = dir ? eb : ef;
      f32x4 acc[2][8];
#pragma unroll
      for (int m = 0; m < 2; ++m)
#pragma unroll
        for (int j = 0; j < 8; ++j) acc[m][j] = (f32x4){0.f, 0.f, 0.f, 0.f};
#pragma unroll
      for (int kk = 0; kk < 4; ++kk) {
        const f32x4 e0 = *(const f32x4*)(ee + kk * 32 + lq * 8), e1 = *(const f32x4*)(ee + kk * 32 + lq * 8 + 4);
        bf16x8 af[2];
#pragma unroll
        for (int m = 0; m < 2; ++m) {
          const bf16x8 raw = frag_tr(Vs, VLD, kk * 32, wave * 32 + m * 16, lr, lq);
          const u32x4 ru = __builtin_bit_cast(u32x4, raw);
          u32x4 sc;
          sc[0] = cvt_pk_bf16(blo(ru[0]) * e0[0], bhi(ru[0]) * e0[1]);
          sc[1] = cvt_pk_bf16(blo(ru[1]) * e0[2], bhi(ru[1]) * e0[3]);
          sc[2] = cvt_pk_bf16(blo(ru[2]) * e1[0], bhi(ru[2]) * e1[1]);
          sc[3] = cvt_pk_bf16(blo(ru[3]) * e1[2], bhi(ru[3]) * e1[3]);
          af[m] = __builtin_bit_cast(bf16x8, sc);
        }
#pragma unroll
        for (int j = 0; j < 8; ++j) {
          const bf16x8 bfr = frag_tr(Ks, VLD, kk * 32, j * 16, lr, lq);
#pragma unroll
          for (int m = 0; m < 2; ++m) acc[m][j] = __builtin_amdgcn_mfma_f32_16x16x32_bf16(af[m], bfr, acc[m][j], 0, 0, 0);
        }
      }
      bf16_t* Dd = p.Dst + (size_t)(u * 2 + dir) * 16384;
#pragma unroll
      for (int m = 0; m < 2; ++m)
#pragma unroll
        for (int j = 0; j < 8; ++j)
#pragma unroll
          for (int e = 0; e < 4; ++e) Dd[(wave * 32 + m * 16 + lq * 4 + e) * 128 + j * 16 + lr] = f2bf(acc[m][j][e]);
    }
    {
      const int dir = tid >> 7, k = tid & 127;
      const float* e = dir ? eb : ef;
      float sacc = 0.f;
      for (int t = 0; t < 128; ++t) sacc += e[t] * bf2f(Ks[t * VLD + k]);
      p.ND[(size_t)(u * 2 + dir) * 128 + k] = sacc;
    }
    if (tid < 4) p.SC[(size_t)(u * 2 + (tid >> 1)) * 32 + (tid & 1)] = scal[tid];
    __syncthreads();
  }
}

__device__ __forceinline__ void ph4_scan(const P& p, int bid, int nb) {
  const int tid = threadIdx.x & 255;
  const __amdgpu_buffer_rsrc_t r_d = mk_rsrc(p.Dst), r_sc = mk_rsrc(p.SC), r_nd = mk_rsrc(p.ND);
  for (int it = bid; it < 1024; it += nb) {
    const int combo = it >> 4, vblk = it & 15;
    const int b = combo >> 3, h = (combo >> 1) & 3, dir = combo & 1;
    const int v = vblk * 8 + (tid >> 5), k0 = (tid & 31) * 4;
    const bool nrow = vblk == 0 && tid < 128;
    u32x2 dd[18]; float Gs[18], bs[18], nds[18];
#pragma unroll
    for (int i = 0; i < 18; ++i) {
      int u;
      if (i < 2) { const int cc = dir == 0 ? i : 1 - i; u = 512 + b * 8 + cc * 4 + h; }
      else { const int lc = i - 2, c = dir == 0 ? lc : 15 - lc; u = b * 64 + c * 4 + h; }
      const int di = u * 2 + dir;
      Gs[i] = fload1c(r_sc, di * 128, 0); bs[i] = fload1c(r_sc, di * 128 + 4, 0);
      dd[i] = uload2c(r_d, (di * 16384 + v * 128 + k0) * 2, 0);
      nds[i] = nrow ? fload1c(r_nd, (di * 128 + tid) * 4, 0) : 0.f;
    }
    float C0 = 0.f, C1 = 0.f, C2 = 0.f, C3 = 0.f, nacc = 0.f, m = 0.f;
#pragma unroll
    for (int i = 0; i < 18; ++i) {
      if (i >= 2) {
        const int lc = i - 2, c = dir == 0 ? lc : 15 - lc;
        const int u = b * 64 + c * 4 + h;
        const size_t ci = (size_t)u * 2 + dir;
        uint2 o;
        o.x = (unsigned)f2bf(C0) | ((unsigned)f2bf(C1) << 16);
        o.y = (unsigned)f2bf(C2) | ((unsigned)f2bf(C3) << 16);
        *(uint2*)(p.CIN + ci * 16384 + v * 128 + k0) = o;
        if (nrow) p.NIN[ci * 128 + tid] = nacc;
        if (vblk == 0 && tid == 0) p.MIN_[ci * 32] = m;
      }
      const float G = Gs[i], bend = bs[i];
      const float Mx = fmaxf(m, G);
      const float dec = __expf(m - Mx), inj = __expf(G - Mx);
      const u32x2 d2 = dd[i];
      C0 = dec * C0 + inj * __uint_as_float(d2.x << 16);
      C1 = dec * C1 + inj * __uint_as_float(d2.x & 0xffff0000u);
      C2 = dec * C2 + inj * __uint_as_float(d2.y << 16);
      C3 = dec * C3 + inj * __uint_as_float(d2.y & 0xffff0000u);
      nacc = dec * nacc + inj * nds[i];
      m = bend + Mx;
    }
  }
}

__device__ __forceinline__ void ph5_mlstm_out(const P& p, int bid, int nb, char* smem) {
  bf16_t* Vs = (bf16_t*)smem;
  bf16_t* Pw = Vs + 128 * VLD;
  float* fa = (float*)(Pw + 4 * 16 * VLD);
  float *igf = fa, *lff = fa + 128, *igb = fa + 256, *lfb = fa + 384, *gf = fa + 512, *gb = fa + 640, *bfw = fa + 768, *bbw = fa + 896,
        *pmf = fa + 1024, *pmb = fa + 1152, *nq = fa + 1280  ;
  const int tid = threadIdx.x & 255, lane = tid & 63, wave = tid >> 6, lr = lane & 15, lq = lane >> 4;
  const int trips5 = (1536 + nb - 1) / nb;
  for (int k5 = 0; k5 < trips5; ++k5) {
    const int it = (bid + k5 * nb) % 1536;
    if (it < 512) {
      const int u = it;
      const UnitInfo ui = decode_unit(u);
      const int h = ui.h;
      const size_t cif = (size_t)u * 2, cib = (size_t)u * 2 + 1;
      if (tid < 128) {
        const float* g = p.gates + (size_t)(ui.row0 + tid) * 16;
        igf[tid] = g[h] + p.b_gates[h];
        lff[tid] = logsig_f(g[4 + h] + p.b_gates[4 + h]);
        igb[tid] = g[8 + h] + p.b_gates[8 + h];
        lfb[tid] = logsig_f(g[12 + h] + p.b_gates[12 + h]);
      }
      {
        const int dch = tid & 15;
#pragma unroll
        for (int i = 0; i < 8; ++i) {
          const int t = (tid >> 4) + i * 16;
          *(u32x4*)(Vs + t * VLD + dch * 8) = *(const u32x4*)(p.pl + (size_t)(ui.row0 + t) * LDP + 1024 + h * 128 + dch * 8);
        }
      }
      {
        const int dir = tid >> 7, t = tid & 127;
        const __amdgpu_buffer_rsrc_t r_hq = mk_rsrc(p.hn);
        const int qoff = ((ui.row0 + t) * 1024 + h * 128) * 2;
        const float* nin = p.NIN + (dir ? cib : cif) * 128;
        float sacc = 0.f;
#pragma unroll 4
        for (int c8 = 0; c8 < 16; ++c8) {
          const u32x4 qv = uload4c(r_hq, qoff + c8 * 16, 0);
#pragma unroll
          for (int q = 0; q < 4; ++q) sacc += blo(qv[q]) * nin[c8 * 8 + 2 * q] + bhi(qv[q]) * nin[c8 * 8 + 2 * q + 1];
        }
        nq[dir * 128 + t] = sacc;
      }
      __syncthreads();
      if (wave == 0) { float G, bt, ga, gb2; scan128<false>(lff, igf, bfw, gf, pmf, G, bt, lane, ga, gb2); }
      else if (wave == 1) { float G, bt, ga, gb2; scan128<true>(lfb, igb, bbw, gb, pmb, G, bt, lane, ga, gb2); }
      __syncthreads();
      const float minf_ = p.MIN_[cif * 32], minb_ = p.MIN_[cib * 32];
      bf16_t* Pme = Pw + wave * 16 * VLD;
      const __amdgpu_buffer_rsrc_t r_hn = mk_rsrc(p.hn), r_cin = mk_rsrc(p.CIN);
      const int fvoff = (lr * 1024 + lq * 8) * 2, cvoff = (lr * 128 + lq * 8) * 2;
#pragma unroll 1
      for (int m = 0; m < 2; ++m) {
        const int t0 = wave * 32 + m * 16;
        bf16x8 Qf[4];
#pragma unroll
        for (int kk = 0; kk < 4; ++kk) Qf[kk] = bload8c(r_hn, fvoff + kk * 64, ((ui.row0 + t0) * 1024 + h * 128) * 2);
        f32x4 S[8];
#pragma unroll
        for (int j = 0; j < 8; ++j) {
          S[j] = (f32x4){0.f, 0.f, 0.f, 0.f};
#pragma unroll
          for (int kk = 0; kk < 4; ++kk) {
            const bf16x8 kf = bload8c(r_hn, fvoff + kk * 64, ((ui.row0 + j * 16) * 1024 + 512 + h * 128) * 2);
            S[j] = __builtin_amdgcn_mfma_f32_16x16x32_bf16(Qf[kk], kf, S[j], 0, 0, 0);
          }
          if (j & 1) __builtin_amdgcn_sched_barrier(0);
        }
        f32x4 hsum[8];
#pragma unroll 1
        for (int dir = 0; dir < 2; ++dir) {
          const float mi = dir ? minb_ : minf_;
          const float* gg = dir ? gb : gf;
          const float* pmx = dir ? pmb : pmf;
          const float* bw = dir ? bbw : bfw;
          float Mrow[4], wi[4];
#pragma unroll
          for (int e = 0; e < 4; ++e) { Mrow[e] = fmaxf(mi, pmx[t0 + lq * 4 + e]); wi[e] = __expf(mi - Mrow[e]); }
          f32x4 acc[8];
#pragma unroll
          for (int jv = 0; jv < 8; ++jv) {
            acc[jv] = (f32x4){0.f, 0.f, 0.f, 0.f};
#pragma unroll
            for (int kk = 0; kk < 4; ++kk) {
              const bf16x8 cf = bload8c(r_cin, cvoff + kk * 64, (int)((dir ? cib : cif) * 32768) + jv * 4096);
              acc[jv] = __builtin_amdgcn_mfma_f32_16x16x32_bf16(Qf[kk], cf, acc[jv], 0, 0, 0);
            }
#pragma unroll
            for (int e = 0; e < 4; ++e) acc[jv][e] *= wi[e];
            if (jv & 1) __builtin_amdgcn_sched_barrier(0);
          }
          float rs[4] = {0.f, 0.f, 0.f, 0.f};
#pragma unroll
          for (int j = 0; j < 8; ++j) {
            const int sidx = j * 16 + lr;
            const float gs = gg[sidx];
#pragma unroll
            for (int e = 0; e < 4; ++e) {
              const int t = t0 + lq * 4 + e;
              const bool keep = dir ? (sidx >= t) : (sidx <= t);
              const float pv = keep ? S[j][e] * __expf(gs - Mrow[e]) : 0.f;
              rs[e] += pv;
              Pme[(lq * 4 + e) * VLD + sidx] = f2bf(pv);
            }
          }
          float den[4];
#pragma unroll
          for (int e = 0; e < 4; ++e) {
            float r = rs[e];
            r += __shfl_xor(r, 1); r += __shfl_xor(r, 2); r += __shfl_xor(r, 4); r += __shfl_xor(r, 8);
            const int t = t0 + lq * 4 + e;
            const float dd = r + wi[e] * nq[dir * 128 + t];
            den[e] = fmaxf(fabsf(dd), __expf(-(bw[t] + Mrow[e])));
          }
          asm volatile("s_waitcnt lgkmcnt(0)" ::: "memory");
          __builtin_amdgcn_wave_barrier();
#pragma unroll
          for (int kk = 0; kk < 4; ++kk) {
            const bf16x8 pf = *(const bf16x8*)(Pme + lr * VLD + kk * 32 + lq * 8);
#pragma unroll
            for (int jv = 0; jv < 8; ++jv) {
              const bf16x8 vf = frag_tr(Vs, VLD, kk * 32, jv * 16, lr, lq);
              acc[jv] = __builtin_amdgcn_mfma_f32_16x16x32_bf16(pf, vf, acc[jv], 0, 0, 0);
            }
          }
          __builtin_amdgcn_wave_barrier();
#pragma unroll
          for (int jv = 0; jv < 8; ++jv)
#pragma unroll
            for (int e = 0; e < 4; ++e) {
              const float hv = acc[jv][e] / den[e];
              if (dir == 0) hsum[jv][e] = hv; else hsum[jv][e] += hv;
            }
        }
#pragma unroll
        for (int e = 0; e < 4; ++e) {
          float sm = 0.f;
#pragma unroll
          for (int jv = 0; jv < 8; ++jv) sm += hsum[jv][e];
          sm += __shfl_xor(sm, 1); sm += __shfl_xor(sm, 2); sm += __shfl_xor(sm, 4); sm += __shfl_xor(sm, 8);
          const float mu = sm * (1.f / 128.f);
          float vs = 0.f;
#pragma unroll
          for (int jv = 0; jv < 8; ++jv) { const float d = hsum[jv][e] - mu; vs += d * d; }
          vs += __shfl_xor(vs, 1); vs += __shfl_xor(vs, 2); vs += __shfl_xor(vs, 4); vs += __shfl_xor(vs, 8);
          const float rstd = rsqrtf(vs * (1.f / 128.f) + 1e-6f);
          const bf16_t* op = p.pl + (size_t)(ui.row0 + t0 + lq * 4 + e) * LDP + 1536 + h * 128;
          bf16_t* mp = p.mix + (size_t)(ui.row0 + t0 + lq * 4 + e) * 1024 + h * 128;
#pragma unroll
          for (int jv = 0; jv < 8; ++jv) {
            const int v = jv * 16 + lr;
            const float o = bf2f(op[v]);
            mp[v] = f2bf((hsum[jv][e] - mu) * rstd * p.head_norm_w[h * 128 + v] / (1.f + __expf(-o)));
          }
        }
      }
      __syncthreads();
    } else {
      const int pu = it - 512, grp = pu >> 2, g = pu & 3;
      float* us = (float*)smem;
      bf16_t* db = (bf16_t*)(us + 8192);
      const int w = 2 << g;
      const size_t rbase = (size_t)grp * 64;
      for (int idx = tid; idx < 1024; idx += NTHR) {
        const int t = idx >> 4, ch = idx & 15;
        const u32x4 r = *(const u32x4*)(p.pl + (rbase + t) * LDP + 2048 + g * 128 + ch * 8);
        float* d = us + t * 128 + ch * 8;
#pragma unroll
        for (int q = 0; q < 4; ++q) { d[2 * q] = blo(r[q]); d[2 * q + 1] = bhi(r[q]); }
      }
      __syncthreads();
      for (int idx = tid; idx < 8192; idx += NTHR) {
        const int t = idx >> 7, i = idx & 127;
        int lo = t - w / 2, hi = t - w / 2 + w;
        lo = lo < 0 ? 0 : lo; hi = hi > 64 ? 64 : hi;
        float sacc = 0.f;
        for (int j = lo; j < hi; ++j) sacc += us[j * 128 + i];
        db[t * VLD + i] = f2bf(sacc / (float)(hi - lo) - us[idx]);
      }
      __syncthreads();
      {
        const bf16_t* wt = (const bf16_t*)((const char*)p.keys_bf + 524288) + g * 16384;
        bf16x8 af[4];
#pragma unroll
        for (int kk = 0; kk < 4; ++kk) af[kk] = *(const bf16x8*)(db + (wave * 16 + lr) * VLD + kk * 32 + lq * 8);
#pragma unroll
        for (int j = 0; j < 8; ++j) {
          f32x4 acc = (f32x4){0.f, 0.f, 0.f, 0.f};
#pragma unroll
          for (int kk = 0; kk < 4; ++kk) {
            const bf16x8 bfr = *(const bf16x8*)(wt + (j * 16 + lr) * 128 + kk * 32 + lq * 8);
            acc = __builtin_amdgcn_mfma_f32_16x16x32_bf16(af[kk], bfr, acc, 0, 0, 0);
          }
          const float ps = p.pool_scale[g * 128 + j * 16 + lr];
#pragma unroll
          for (int e = 0; e < 4; ++e) p.mix[(rbase + wave * 16 + lq * 4 + e) * 1024 + 512 + g * 128 + j * 16 + lr] = f2bf(acc[e] * ps);
        }
      }
      __syncthreads();
    }
  }
}

#define SORT16(X) do { unsigned h_, l_; h_ = X[0] > X[1] ? X[0] : X[1]; l_ = X[0] > X[1] ? X[1] : X[0]; X[0] = h_; X[1] = l_; h_ = X[3] > X[2] ? X[3] : X[2]; l_ = X[3] > X[2] ? X[2] : X[3]; X[3] = h_; X[2] = l_; h_ = X[4] > X[5] ? X[4] : X[5]; l_ = X[4] > X[5] ? X[5] : X[4]; X[4] = h_; X[5] = l_; h_ = X[7] > X[6] ? X[7] : X[6]; l_ = X[7] > X[6] ? X[6] : X[7]; X[7] = h_; X[6] = l_; h_ = X[8] > X[9] ? X[8] : X[9]; l_ = X[8] > X[9] ? X[9] : X[8]; X[8] = h_; X[9] = l_; h_ = X[11] > X[10] ? X[11] : X[10]; l_ = X[11] > X[10] ? X[10] : X[11]; X[11] = h_; X[10] = l_; h_ = X[12] > X[13] ? X[12] : X[13]; l_ = X[12] > X[13] ? X[13] : X[12]; X[12] = h_; X[13] = l_; h_ = X[15] > X[14] ? X[15] : X[14]; l_ = X[15] > X[14] ? X[14] : X[15]; X[15] = h_; X[14] = l_; h_ = X[0] > X[2] ? X[0] : X[2]; l_ = X[0] > X[2] ? X[2] : X[0]; X[0] = h_; X[2] = l_; h_ = X[1] > X[3] ? X[1] : X[3]; l_ = X[1] > X[3] ? X[3] : X[1]; X[1] = h_; X[3] = l_; h_ = X[6] > X[4] ? X[6] : X[4]; l_ = X[6] > X[4] ? X[4] : X[6]; X[6] = h_; X[4] = l_; h_ = X[7] > X[5] ? X[7] : X[5]; l_ = X[7] > X[5] ? X[5] : X[7]; X[7] = h_; X[5] = l_; h_ = X[8] > X[10] ? X[8] : X[10]; l_ = X[8] > X[10] ? X[10] : X[8]; X[8] = h_; X[10] = l_; h_ = X[9] > X[11] ? X[9] : X[11]; l_ = X[9] > X[11] ? X[11] : X[9]; X[9] = h_; X[11] = l_; h_ = X[14] > X[12] ? X[14] : X[12]; l_ = X[14] > X[12] ? X[12] : X[14]; X[14] = h_; X[12] = l_; h_ = X[15] > X[13] ? X[15] : X[13]; l_ = X[15] > X[13] ? X[13] : X[15]; X[15] = h_; X[13] = l_; h_ = X[0] > X[1] ? X[0] : X[1]; l_ = X[0] > X[1] ? X[1] : X[0]; X[0] = h_; X[1] = l_; h_ = X[2] > X[3] ? X[2] : X[3]; l_ = X[2] > X[3] ? X[3] : X[2]; X[2] = h_; X[3] = l_; h_ = X[5] > X[4] ? X[5] : X[4]; l_ = X[5] > X[4] ? X[4] : X[5]; X[5] = h_; X[4] = l_; h_ = X[7] > X[6] ? X[7] : X[6]; l_ = X[7] > X[6] ? X[6] : X[7]; X[7] = h_; X[6] = l_; h_ = X[8] > X[9] ? X[8] : X[9]; l_ = X[8] > X[9] ? X[9] : X[8]; X[8] = h_; X[9] = l_; h_ = X[10] > X[11] ? X[10] : X[11]; l_ = X[10] > X[11] ? X[11] : X[10]; X[10] = h_; X[11] = l_; h_ = X[13] > X[12] ? X[13] : X[12]; l_ = X[13] > X[12] ? X[12] : X[13]; X[13] = h_; X[12] = l_; h_ = X[15] > X[14] ? X[15] : X[14]; l_ = X[15] > X[14] ? X[14] : X[15]; X[15] = h_; X[14] = l_; h_ = X[0] > X[4] ? X[0] : X[4]; l_ = X[0] > X[4] ? X[4] : X[0]; X[0] = h_; X[4] = l_; h_ = X[1] > X[5] ? X[1] : X[5]; l_ = X[1] > X[5] ? X[5] : X[1]; X[1] = h_; X[5] = l_; h_ = X[2] > X[6] ? X[2] : X[6]; l_ = X[2] > X[6] ? X[6] : X[2]; X[2] = h_; X[6] = l_; h_ = X[3] > X[7] ? X[3] : X[7]; l_ = X[3] > X[7] ? X[7] : X[3]; X[3] = h_; X[7] = l_; h_ = X[12] > X[8] ? X[12] : X[8]; l_ = X[12] > X[8] ? X[8] : X[12]; X[12] = h_; X[8] = l_; h_ = X[13] > X[9] ? X[13] : X[9]; l_ = X[13] > X[9] ? X[9] : X[13]; X[13] = h_; X[9] = l_; h_ = X[14] > X[10] ? X[14] : X[10]; l_ = X[14] > X[10] ? X[10] : X[14]; X[14] = h_; X[10] = l_; h_ = X[15] > X[11] ? X[15] : X[11]; l_ = X[15] > X[11] ? X[11] : X[15]; X[15] = h_; X[11] = l_; h_ = X[0] > X[2] ? X[0] : X[2]; l_ = X[0] > X[2] ? X[2] : X[0]; X[0] = h_; X[2] = l_; h_ = X[1] > X[3] ? X[1] : X[3]; l_ = X[1] > X[3] ? X[3] : X[1]; X[1] = h_; X[3] = l_; h_ = X[4] > X[6] ? X[4] : X[6]; l_ = X[4] > X[6] ? X[6] : X[4]; X[4] = h_; X[6] = l_; h_ = X[5] > X[7] ? X[5] : X[7]; l_ = X[5] > X[7] ? X[7] : X[5]; X[5] = h_; X[7] = l_; h_ = X[10] > X[8] ? X[10] : X[8]; l_ = X[10] > X[8] ? X[8] : X[10]; X[10] = h_; X[8] = l_; h_ = X[11] > X[9] ? X[11] : X[9]; l_ = X[11] > X[9] ? X[9] : X[11]; X[11] = h_; X[9] = l_; h_ = X[14] > X[12] ? X[14] : X[12]; l_ = X[14] > X[12] ? X[12] : X[14]; X[14] = h_; X[12] = l_; h_ = X[15] > X[13] ? X[15] : X[13]; l_ = X[15] > X[13] ? X[13] : X[15]; X[15] = h_; X[13] = l_; h_ = X[0] > X[1] ? X[0] : X[1]; l_ = X[0] > X[1] ? X[1] : X[0]; X[0] = h_; X[1] = l_; h_ = X[2] > X[3] ? X[2] : X[3]; l_ = X[2] > X[3] ? X[3] : X[2]; X[2] = h_; X[3] = l_; h_ = X[4] > X[5] ? X[4] : X[5]; l_ = X[4] > X[5] ? X[5] : X[4]; X[4] = h_; X[5] = l_; h_ = X[6] > X[7] ? X[6] : X[7]; l_ = X[6] > X[7] ? X[7] : X[6]; X[6] = h_; X[7] = l_; h_ = X[9] > X[8] ? X[9] : X[8]; l_ = X[9] > X[8] ? X[8] : X[9]; X[9] = h_; X[8] = l_; h_ = X[11] > X[10] ? X[11] : X[10]; l_ = X[11] > X[10] ? X[10] : X[11]; X[11] = h_; X[10] = l_; h_ = X[13] > X[12] ? X[13] : X[12]; l_ = X[13] > X[12] ? X[12] : X[13]; X[13] = h_; X[12] = l_; h_ = X[15] > X[14] ? X[15] : X[14]; l_ = X[15] > X[14] ? X[14] : X[15]; X[15] = h_; X[14] = l_; h_ = X[0] > X[8] ? X[0] : X[8]; l_ = X[0] > X[8] ? X[8] : X[0]; X[0] = h_; X[8] = l_; h_ = X[1] > X[9] ? X[1] : X[9]; l_ = X[1] > X[9] ? X[9] : X[1]; X[1] = h_; X[9] = l_; h_ = X[2] > X[10] ? X[2] : X[10]; l_ = X[2] > X[10] ? X[10] : X[2]; X[2] = h_; X[10] = l_; h_ = X[3] > X[11] ? X[3] : X[11]; l_ = X[3] > X[11] ? X[11] : X[3]; X[3] = h_; X[11] = l_; h_ = X[4] > X[12] ? X[4] : X[12]; l_ = X[4] > X[12] ? X[12] : X[4]; X[4] = h_; X[12] = l_; h_ = X[5] > X[13] ? X[5] : X[13]; l_ = X[5] > X[13] ? X[13] : X[5]; X[5] = h_; X[13] = l_; h_ = X[6] > X[14] ? X[6] : X[14]; l_ = X[6] > X[14] ? X[14] : X[6]; X[6] = h_; X[14] = l_; h_ = X[7] > X[15] ? X[7] : X[15]; l_ = X[7] > X[15] ? X[15] : X[7]; X[7] = h_; X[15] = l_; h_ = X[0] > X[4] ? X[0] : X[4]; l_ = X[0] > X[4] ? X[4] : X[0]; X[0] = h_; X[4] = l_; h_ = X[1] > X[5] ? X[1] : X[5]; l_ = X[1] > X[5] ? X[5] : X[1]; X[1] = h_; X[5] = l_; h_ = X[2] > X[6] ? X[2] : X[6]; l_ = X[2] > X[6] ? X[6] : X[2]; X[2] = h_; X[6] = l_; h_ = X[3] > X[7] ? X[3] : X[7]; l_ = X[3] > X[7] ? X[7] : X[3]; X[3] = h_; X[7] = l_; h_ = X[8] > X[12] ? X[8] : X[12]; l_ = X[8] > X[12] ? X[12] : X[8]; X[8] = h_; X[12] = l_; h_ = X[9] > X[13] ? X[9] : X[13]; l_ = X[9] > X[13] ? X[13] : X[9]; X[9] = h_; X[13] = l_; h_ = X[10] > X[14] ? X[10] : X[14]; l_ = X[10] > X[14] ? X[14] : X[10]; X[10] = h_; X[14] = l_; h_ = X[11] > X[15] ? X[11] : X[15]; l_ = X[11] > X[15] ? X[15] : X[11]; X[11] = h_; X[15] = l_; h_ = X[0] > X[2] ? X[0] : X[2]; l_ = X[0] > X[2] ? X[2] : X[0]; X[0] = h_; X[2] = l_; h_ = X[1] > X[3] ? X[1] : X[3]; l_ = X[1] > X[3] ? X[3] : X[1]; X[1] = h_; X[3] = l_; h_ = X[4] > X[6] ? X[4] : X[6]; l_ = X[4] > X[6] ? X[6] : X[4]; X[4] = h_; X[6] = l_; h_ = X[5] > X[7] ? X[5] : X[7]; l_ = X[5] > X[7] ? X[7] : X[5]; X[5] = h_; X[7] = l_; h_ = X[8] > X[10] ? X[8] : X[10]; l_ = X[8] > X[10] ? X[10] : X[8]; X[8] = h_; X[10] = l_; h_ = X[9] > X[11] ? X[9] : X[11]; l_ = X[9] > X[11] ? X[11] : X[9]; X[9] = h_; X[11] = l_; h_ = X[12] > X[14] ? X[12] : X[14]; l_ = X[12] > X[14] ? X[14] : X[12]; X[12] = h_; X[14] = l_; h_ = X[13] > X[15] ? X[13] : X[15]; l_ = X[13] > X[15] ? X[15] : X[13]; X[13] = h_; X[15] = l_; h_ = X[0] > X[1] ? X[0] : X[1]; l_ = X[0] > X[1] ? X[1] : X[0]; X[0] = h_; X[1] = l_; h_ = X[2] > X[3] ? X[2] : X[3]; l_ = X[2] > X[3] ? X[3] : X[2]; X[2] = h_; X[3] = l_; h_ = X[4] > X[5] ? X[4] : X[5]; l_ = X[4] > X[5] ? X[5] : X[4]; X[4] = h_; X[5] = l_; h_ = X[6] > X[7] ? X[6] : X[7]; l_ = X[6] > X[7] ? X[7] : X[6]; X[6] = h_; X[7] = l_; h_ = X[8] > X[9] ? X[8] : X[9]; l_ = X[8] > X[9] ? X[9] : X[8]; X[8] = h_; X[9] = l_; h_ = X[10] > X[11] ? X[10] : X[11]; l_ = X[10] > X[11] ? X[11] : X[10]; X[10] = h_; X[11] = l_; h_ = X[12] > X[13] ? X[12] : X[13]; l_ = X[12] > X[13] ? X[13] : X[12]; X[12] = h_; X[13] = l_; h_ = X[14] > X[15] ? X[14] : X[15]; l_ = X[14] > X[15] ? X[15] : X[14]; X[14] = h_; X[15] = l_; } while (0)
#define MERGE16(X) do { unsigned h_, l_; h_ = X[0] > X[8] ? X[0] : X[8]; l_ = X[0] > X[8] ? X[8] : X[0]; X[0] = h_; X[8] = l_; h_ = X[1] > X[9] ? X[1] : X[9]; l_ = X[1] > X[9] ? X[9] : X[1]; X[1] = h_; X[9] = l_; h_ = X[2] > X[10] ? X[2] : X[10]; l_ = X[2] > X[10] ? X[10] : X[2]; X[2] = h_; X[10] = l_; h_ = X[3] > X[11] ? X[3] : X[11]; l_ = X[3] > X[11] ? X[11] : X[3]; X[3] = h_; X[11] = l_; h_ = X[4] > X[12] ? X[4] : X[12]; l_ = X[4] > X[12] ? X[12] : X[4]; X[4] = h_; X[12] = l_; h_ = X[5] > X[13] ? X[5] : X[13]; l_ = X[5] > X[13] ? X[13] : X[5]; X[5] = h_; X[13] = l_; h_ = X[6] > X[14] ? X[6] : X[14]; l_ = X[6] > X[14] ? X[14] : X[6]; X[6] = h_; X[14] = l_; h_ = X[7] > X[15] ? X[7] : X[15]; l_ = X[7] > X[15] ? X[15] : X[7]; X[7] = h_; X[15] = l_; h_ = X[0] > X[4] ? X[0] : X[4]; l_ = X[0] > X[4] ? X[4] : X[0]; X[0] = h_; X[4] = l_; h_ = X[1] > X[5] ? X[1] : X[5]; l_ = X[1] > X[5] ? X[5] : X[1]; X[1] = h_; X[5] = l_; h_ = X[2] > X[6] ? X[2] : X[6]; l_ = X[2] > X[6] ? X[6] : X[2]; X[2] = h_; X[6] = l_; h_ = X[3] > X[7] ? X[3] : X[7]; l_ = X[3] > X[7] ? X[7] : X[3]; X[3] = h_; X[7] = l_; h_ = X[8] > X[12] ? X[8] : X[12]; l_ = X[8] > X[12] ? X[12] : X[8]; X[8] = h_; X[12] = l_; h_ = X[9] > X[13] ? X[9] : X[13]; l_ = X[9] > X[13] ? X[13] : X[9]; X[9] = h_; X[13] = l_; h_ = X[10] > X[14] ? X[10] : X[14]; l_ = X[10] > X[14] ? X[14] : X[10]; X[10] = h_; X[14] = l_; h_ = X[11] > X[15] ? X[11] : X[15]; l_ = X[11] > X[15] ? X[15] : X[11]; X[11] = h_; X[15] = l_; h_ = X[0] > X[2] ? X[0] : X[2]; l_ = X[0] > X[2] ? X[2] : X[0]; X[0] = h_; X[2] = l_; h_ = X[1] > X[3] ? X[1] : X[3]; l_ = X[1] > X[3] ? X[3] : X[1]; X[1] = h_; X[3] = l_; h_ = X[4] > X[6] ? X[4] : X[6]; l_ = X[4] > X[6] ? X[6] : X[4]; X[4] = h_; X[6] = l_; h_ = X[5] > X[7] ? X[5] : X[7]; l_ = X[5] > X[7] ? X[7] : X[5]; X[5] = h_; X[7] = l_; h_ = X[8] > X[10] ? X[8] : X[10]; l_ = X[8] > X[10] ? X[10] : X[8]; X[8] = h_; X[10] = l_; h_ = X[9] > X[11] ? X[9] : X[11]; l_ = X[9] > X[11] ? X[11] : X[9]; X[9] = h_; X[11] = l_; h_ = X[12] > X[14] ? X[12] : X[14]; l_ = X[12] > X[14] ? X[14] : X[12]; X[12] = h_; X[14] = l_; h_ = X[13] > X[15] ? X[13] : X[15]; l_ = X[13] > X[15] ? X[15] : X[13]; X[13] = h_; X[15] = l_; h_ = X[0] > X[1] ? X[0] : X[1]; l_ = X[0] > X[1] ? X[1] : X[0]; X[0] = h_; X[1] = l_; h_ = X[2] > X[3] ? X[2] : X[3]; l_ = X[2] > X[3] ? X[3] : X[2]; X[2] = h_; X[3] = l_; h_ = X[4] > X[5] ? X[4] : X[5]; l_ = X[4] > X[5] ? X[5] : X[4]; X[4] = h_; X[5] = l_; h_ = X[6] > X[7] ? X[6] : X[7]; l_ = X[6] > X[7] ? X[7] : X[6]; X[6] = h_; X[7] = l_; h_ = X[8] > X[9] ? X[8] : X[9]; l_ = X[8] > X[9] ? X[9] : X[8]; X[8] = h_; X[9] = l_; h_ = X[10] > X[11] ? X[10] : X[11]; l_ = X[10] > X[11] ? X[11] : X[10]; X[10] = h_; X[11] = l_; h_ = X[12] > X[13] ? X[12] : X[13]; l_ = X[12] > X[13] ? X[13] : X[12]; X[12] = h_; X[13] = l_; h_ = X[14] > X[15] ? X[14] : X[15]; l_ = X[14] > X[15] ? X[15] : X[14]; X[14] = h_; X[15] = l_; } while (0)

__device__ __forceinline__ unsigned f2ord(float f) { const unsigned u = __float_as_uint(f); return (u & 0x80000000u) ? ~u : (u | 0x80000000u); }
__device__ __forceinline__ float ord2f(unsigned o) { return __uint_as_float((o & 0x80000000u) ? (o & 0x7fffffffu) : ~o); }
#define CANDKEY(sum, c) ((f2ord(sum) & ~255u) | (255u - (unsigned)(c)))
__device__ __forceinline__ void xmerge16(unsigned (&X)[16], int mask) {
  unsigned T[16];
#pragma unroll
  for (int i = 0; i < 16; ++i) T[i] = (unsigned)__shfl_xor((int)X[15 - i], mask);
#pragma unroll
  for (int i = 0; i < 16; ++i) X[i] = X[i] > T[i] ? X[i] : T[i];
  MERGE16(X);
}

__device__ __forceinline__ void ph9_topk(const P& p, int bid, int nb, char* smem) {
  const int tid = threadIdx.x & 255, lane = tid & 63, wave = tid >> 6, lr = lane & 15, lq = lane >> 4;
  bf16_t* kl = (bf16_t*)smem;
  int* idxs = (int*)(smem + 65536) + wave * 512;
  const int h = ((bid >> 1) & 3) * 2 + (bid & 1), nper = nb >> 3, wgi = bid >> 3;
  for (int idx = tid; idx < 4096; idx += NTHR) {
    const int row = idx >> 4, c = idx & 15;
    *(u32x4*)(kl + row * 128 + ((c ^ (row & 15)) << 3)) = *(const u32x4*)(p.keys_bf + (size_t)h * 32768 + row * 128 + c * 8);
  }
  __syncthreads();
  const __amdgpu_buffer_rsrc_t r_q = mk_rsrc(p.qb);
  bf16x8 bq[4];
#pragma unroll
  for (int kk = 0; kk < 4; ++kk) bq[kk] = bload8c(r_q, (lr * 2048 + lq * 8) * 2 + kk * 64, ((wgi * 4 + wave) * 16 * 2048 + h * 256) * 2);
  for (int tile = wgi * 4 + wave; tile < 1024; tile += nper * 4) {
    const int tok = tile * 16 + lr;
    unsigned R0[16], R1[16];
#pragma unroll
    for (int pp = 0; pp < 2; ++pp) {
      bf16x8 bn[4];
      {
        const int ntile = pp == 0 ? tile : (tile + nper * 4 < 1024 ? tile + nper * 4 : tile);
#pragma unroll
        for (int kk = 0; kk < 4; ++kk) bn[kk] = bload8c(r_q, (lr * 2048 + lq * 8) * 2 + kk * 64, (ntile * 16 * 2048 + h * 256 + (pp ^ 1) * 128) * 2);
      }
      f32x4 acc[8];
#pragma unroll
      for (int j = 0; j < 8; ++j) acc[j] = (f32x4){0.f, 0.f, 0.f, 0.f};
#pragma unroll
      for (int j = 0; j < 8; ++j)
#pragma unroll
        for (int kk = 0; kk < 4; ++kk) {
          const bf16x8 a = *(const bf16x8*)(kl + (pp * 128 + j * 16 + lr) * 128 + (((kk * 4 + lq) ^ lr) << 3));
          acc[j] = __builtin_amdgcn_mfma_f32_16x16x32_bf16(a, bq[kk], acc[j], 0, 0, 0);
        }
      unsigned X[16], Y[16];
#pragma unroll
      for (int j = 0; j < 4; ++j)
#pragma unroll
        for (int e = 0; e < 4; ++e) {
          X[j * 4 + e] = (f2ord(acc[j][e]) & ~127u) | (127u - (unsigned)(j * 16 + lq * 4 + e));
          Y[j * 4 + e] = (f2ord(acc[4 + j][e]) & ~127u) | (127u - (unsigned)((4 + j) * 16 + lq * 4 + e));
        }
      SORT16(X);
      SORT16(Y);
#pragma unroll
      for (int i = 0; i < 16; ++i) X[i] = X[i] > Y[15 - i] ? X[i] : Y[15 - i];
      MERGE16(X);
      xmerge16(X, 16);
      xmerge16(X, 32);
#pragma unroll
      for (int i = 0; i < 16; ++i) { if (pp == 0) R0[i] = X[i]; else R1[i] = X[i]; }
#pragma unroll
      for (int kk = 0; kk < 4; ++kk) bq[kk] = bn[kk];
    }
    if (lq == 0) {
#pragma unroll
      for (int i = 0; i < 16; ++i) { idxs[lr * 32 + i] = 127 - (int)(R0[i] & 127u); idxs[lr * 32 + 16 + i] = 127 - (int)(R1[i] & 127u); }
    }
    asm volatile("s_waitcnt lgkmcnt(0)" ::: "memory");
    float va[16], vb[16];
#pragma unroll
    for (int i = 0; i < 16; ++i) { va[i] = ord2f(R0[i] & ~127u); vb[i] = ord2f(R1[i] & ~127u); }
    unsigned F[16];
  F[0] = lq == 0 ? CANDKEY(va[0] + vb[0], 0) : (lq == 1 ? CANDKEY(va[1] + vb[0], 16) : (lq == 2 ? CANDKEY(va[3] + vb[0], 48) : CANDKEY(va[13] + vb[0], 208)));
  F[1] = lq == 0 ? CANDKEY(va[0] + vb[1], 1) : (lq == 1 ? CANDKEY(va[1] + vb[1], 17) : (lq == 2 ? CANDKEY(va[3] + vb[1], 49) : CANDKEY(va[14] + vb[0], 224)));
  F[2] = lq == 0 ? CANDKEY(va[0] + vb[2], 2) : (lq == 1 ? CANDKEY(va[1] + vb[2], 18) : (lq == 2 ? CANDKEY(va[3] + vb[2], 50) : CANDKEY(va[15] + vb[0], 240)));
  F[3] = lq == 0 ? CANDKEY(va[0] + vb[3], 3) : (lq == 1 ? CANDKEY(va[1] + vb[3], 19) : (lq == 2 ? CANDKEY(va[3] + vb[3], 51) : 0u));
  F[4] = lq == 0 ? CANDKEY(va[0] + vb[4], 4) : (lq == 1 ? CANDKEY(va[1] + vb[4], 20) : (lq == 2 ? CANDKEY(va[4] + vb[0], 64) : 0u));
  F[5] = lq == 0 ? CANDKEY(va[0] + vb[5], 5) : (lq == 1 ? CANDKEY(va[1] + vb[5], 21) : (lq == 2 ? CANDKEY(va[4] + vb[1], 65) : 0u));
  F[6] = lq == 0 ? CANDKEY(va[0] + vb[6], 6) : (lq == 1 ? CANDKEY(va[1] + vb[6], 22) : (lq == 2 ? CANDKEY(va[4] + vb[2], 66) : 0u));
  F[7] = lq == 0 ? CANDKEY(va[0] + vb[7], 7) : (lq == 1 ? CANDKEY(va[1] + vb[7], 23) : (lq == 2 ? CANDKEY(va[6] + vb[0], 96) : 0u));
  F[8] = lq == 0 ? CANDKEY(va[0] + vb[8], 8) : (lq == 1 ? CANDKEY(va[2] + vb[0], 32) : (lq == 2 ? CANDKEY(va[6] + vb[1], 97) : 0u));
  F[9] = lq == 0 ? CANDKEY(va[0] + vb[9], 9) : (lq == 1 ? CANDKEY(va[2] + vb[1], 33) : (lq == 2 ? CANDKEY(va[7] + vb[0], 112) : 0u));
  F[10] = lq == 0 ? CANDKEY(va[0] + vb[10], 10) : (lq == 1 ? CANDKEY(va[2] + vb[2], 34) : (lq == 2 ? CANDKEY(va[7] + vb[1], 113) : 0u));
  F[11] = lq == 0 ? CANDKEY(va[0] + vb[11], 11) : (lq == 1 ? CANDKEY(va[2] + vb[3], 35) : (lq == 2 ? CANDKEY(va[8] + vb[0], 128) : 0u));
  F[12] = lq == 0 ? CANDKEY(va[0] + vb[12], 12) : (lq == 1 ? CANDKEY(va[2] + vb[4], 36) : (lq == 2 ? CANDKEY(va[9] + vb[0], 144) : 0u));
  F[13] = lq == 0 ? CANDKEY(va[0] + vb[13], 13) : (lq == 1 ? CANDKEY(va[5] + vb[0], 80) : (lq == 2 ? CANDKEY(va[10] + vb[0], 160) : 0u));
  F[14] = lq == 0 ? CANDKEY(va[0] + vb[14], 14) : (lq == 1 ? CANDKEY(va[5] + vb[1], 81) : (lq == 2 ? CANDKEY(va[11] + vb[0], 176) : 0u));
  F[15] = lq == 0 ? CANDKEY(va[0] + vb[15], 15) : (lq == 1 ? 0u : (lq == 2 ? CANDKEY(va[12] + vb[0], 192) : 0u));

    SORT16(F);
    xmerge16(F, 16);
    xmerge16(F, 32);
    if (lq == 0) {
      float ev[16];
      const float mx = ord2f(F[0] & ~255u);
      float tot = 0.f;
#pragma unroll
      for (int r = 0; r < 16; ++r) { ev[r] = __expf(ord2f(F[r] & ~255u) - mx); tot += ev[r]; }
      const float inv = 1.f / tot;
      int ei[16];
#pragma unroll
      for (int r = 0; r < 16; ++r) {
        const int c = 255 - (int)(F[r] & 255u);
        ei[r] = idxs[lr * 32 + (c >> 4)] * 128 + idxs[lr * 32 + 16 + (c & 15)];
      }
      unsigned short* ep = p.eidx + (size_t)tok * 128 + h * 16;
      float* gp = p.gate + (size_t)tok * 128 + h * 16;
#pragma unroll
      for (int r = 0; r < 4; ++r) {
        *(f32x4*)(gp + r * 4) = (f32x4){ev[r * 4] * inv, ev[r * 4 + 1] * inv, ev[r * 4 + 2] * inv, ev[r * 4 + 3] * inv};
      }
#pragma unroll
      for (int r = 0; r < 2; ++r)
        *(u32x4*)(ep + r * 8) = (u32x4){(unsigned)ei[r * 8] | ((unsigned)ei[r * 8 + 1] << 16), (unsigned)ei[r * 8 + 2] | ((unsigned)ei[r * 8 + 3] << 16),
                                         (unsigned)ei[r * 8 + 4] | ((unsigned)ei[r * 8 + 5] << 16), (unsigned)ei[r * 8 + 6] | ((unsigned)ei[r * 8 + 7] << 16)};
    }
  }
}

__device__ __forceinline__ float gelu_exact(float a) { return 0.5f * a * (1.f + erff(a * 0.70710678118654752f)); }

#define G_LOAD(buf, j, g_) do { const int g__ = (g_); const int er__ = (g__ & 8) ? e1s[j] : e0s[j]; \
    _Pragma("unroll") for (int k = 0; k < 8; ++k) { const int e__ = __builtin_amdgcn_readlane(er__, (g__ & 7) * 8 + k); \
      buf[k] = *((const u32x4*)(tab + (size_t)e__ * 1024) + lane); } } while (0)
#define G_COMPUTE_U(buf, j, g_) do { const int g__ = (g_); \
      float pp[8]; \
      _Pragma("unroll") for (int k = 0; k < 8; ++k) { \
        f32x2 ac = {0.f, 0.f}; \
        _Pragma("unroll") for (int d = 0; d < 4; ++d) { \
          ac = __builtin_amdgcn_cvt_pk_f32_fp8((int)buf[k][d], false) * x2[j][2 * d] + ac; \
          ac = __builtin_amdgcn_cvt_pk_f32_fp8((int)buf[k][d], true) * x2[j][2 * d + 1] + ac; } \
        pp[k] = ac.x + ac.y; } \
        \
      float q4[4], r2[2], tt; \
      _Pragma("unroll") for (int i = 0; i < 4; ++i) { const float sd = b5 ? pp[i] : pp[i + 4]; q4[i] = (b5 ? pp[i + 4] : pp[i]) + __shfl_xor(sd, 32); } \
      _Pragma("unroll") for (int i = 0; i < 2; ++i) { const float sd = b4 ? q4[i] : q4[i + 2]; r2[i] = (b4 ? q4[i + 2] : q4[i]) + __shfl_xor(sd, 16); } \
      { const float sd = b3 ? r2[0] : r2[1]; tt = (b3 ? r2[1] : r2[0]) + __shfl_xor(sd, 8); } \
      tt += __shfl_xor(tt, 4); tt += __shfl_xor(tt, 2); tt += __shfl_xor(tt, 1); \
      const float dv = __shfl(tt, (lane & 7) * 8); \
      if ((lane >> 3) == (g__ & 7)) { if (g__ & 8) a1[j] = dv; else a0[j] = dv; } } while (0)
#define G_COMPUTE_V(buf, j, g_) do { const int g__ = (g_); \
      const int wr__ = __float_as_int((g__ & 8) ? w1s[j] : w0s[j]); \
      _Pragma("unroll") for (int k = 0; k < 8; ++k) { \
        const float w__ = __int_as_float(__builtin_amdgcn_readlane(wr__, (g__ & 7) * 8 + k)); \
        const f32x2 ww = {w__, w__}; \
        _Pragma("unroll") for (int d = 0; d < 4; ++d) { \
          y2[j][2 * d] = __builtin_amdgcn_cvt_pk_f32_fp8((int)buf[k][d], false) * ww + y2[j][2 * d]; \
          y2[j][2 * d + 1] = __builtin_amdgcn_cvt_pk_f32_fp8((int)buf[k][d], true) * ww + y2[j][2 * d + 1]; } } } while (0)
#define G_SWEEP(COMP) do { \
    G_LOAD(A, 0, 0); G_LOAD(B, 1, 0); G_LOAD(C, 0, 1); \
    _Pragma("unroll 1") for (int g = 0; g < 16; g += 2) { \
      const int gn = g + 2 < 16 ? g + 2 : g;              \
      G_LOAD(D, 1, g + 1); COMP(A, 0, g); \
      G_LOAD(A, 0, gn); COMP(B, 1, g); \
      G_LOAD(B, 1, gn); COMP(C, 0, g + 1); \
      G_LOAD(C, 0, gn + 1); COMP(D, 1, g + 1); } } while (0)

__device__ __forceinline__ void ph10_gather(const P& p, int bid, int nb, char* smem) {
  const int wave = __builtin_amdgcn_readfirstlane((threadIdx.x >> 6) & 3), lane = threadIdx.x & 63;
  const bool b5 = lane & 32, b4 = lane & 16, b3 = lane & 8;
  int* se = (int*)(smem + wave * 1024);
  float* sg = (float*)(se + 128);
  for (int oct = bid * 4 + wave; oct < TL / 8; oct += nb * 4) {
#pragma unroll 1
    for (int grp = 0; grp < 4; ++grp) {
      int diag_bad = 0;
      const int tok0 = oct * 8 + grp * 2;
      int e0s[2], e1s[2];
      float g0s[2], g1s[2], a0[2], a1[2], w0s[2], w1s[2];
      f32x2 x2[2][8], y2[2][8];
#pragma unroll
      for (int j = 0; j < 2; ++j) {
        const int tok = tok0 + j;
        const int e0 = (int)p.eidx[(size_t)tok * 128 + lane], e1 = (int)p.eidx[(size_t)tok * 128 + 64 + lane];
        const float g0 = p.gate[(size_t)tok * 128 + lane], g1 = p.gate[(size_t)tok * 128 + 64 + lane];
        {
          const float gs = wave_sum(g0 + g1);
          const bool bad = (e0 < 0) || (e0 > 16383) || (e1 < 0) || (e1 > 16383) || !(fabsf(gs - 8.f) < 1e-2f);
          if (__ballot(bad) != 0ull) diag_bad = 1;
        }
        const int sl0 = e0 >> 10, sl1 = e1 >> 10;
        int base = 0, pos0 = 0, pos1 = 0;
#pragma unroll
        for (int sidx = 0; sidx < 16; ++sidx) {
          const unsigned long long m0 = __ballot(sl0 == sidx), m1 = __ballot(sl1 == sidx);
          const int c0 = __popcll(m0), c1 = __popcll(m1);
          const int r0 = __builtin_amdgcn_mbcnt_hi((unsigned)(m0 >> 32), __builtin_amdgcn_mbcnt_lo((unsigned)m0, 0u));
          const int r1 = __builtin_amdgcn_mbcnt_hi((unsigned)(m1 >> 32), __builtin_amdgcn_mbcnt_lo((unsigned)m1, 0u));
          if (sl0 == sidx) pos0 = base + r0;
          if (sl1 == sidx) pos1 = base + c0 + r1;
          base += c0 + c1;
        }
        asm volatile("s_waitcnt lgkmcnt(0)" ::: "memory");
        se[pos0] = e0; se[pos1] = e1; sg[pos0] = g0; sg[pos1] = g1;
        asm volatile("s_waitcnt lgkmcnt(0)" ::: "memory");
        e0s[j] = se[lane]; e1s[j] = se[64 + lane]; g0s[j] = sg[lane]; g1s[j] = sg[64 + lane];
        asm volatile("s_waitcnt lgkmcnt(0)" ::: "memory");
        const __amdgpu_buffer_rsrc_t r_h2 = mk_rsrc(p.hn);
        const u32x4 h0 = uload4c(r_h2, (tok * 1024 + lane * 16) * 2, 0);
        const u32x4 h1 = uload4c(r_h2, (tok * 1024 + lane * 16 + 8) * 2, 0);
#pragma unroll
        for (int i = 0; i < 4; ++i) { x2[j][i] = (f32x2){blo(h0[i]), bhi(h0[i])}; x2[j][4 + i] = (f32x2){blo(h1[i]), bhi(h1[i])}; }
        a0[j] = 0.f; a1[j] = 0.f;
      }
      u32x4 A[8], B[8], C[8], D[8];
      { const unsigned char* tab = p.U8; G_SWEEP(G_COMPUTE_U); }
#pragma unroll
      for (int j = 0; j < 2; ++j) { w0s[j] = gelu_exact(a0[j] * (1.f / 512.f)) * g0s[j]; w1s[j] = gelu_exact(a1[j] * (1.f / 512.f)) * g1s[j];
#pragma unroll
        for (int i = 0; i < 8; ++i) y2[j][i] = (f32x2){0.f, 0.f}; }
      { const unsigned char* tab = p.V8; G_SWEEP(G_COMPUTE_V); }
#pragma unroll
      for (int j = 0; j < 2; ++j) {
        const int tok = tok0 + j, b = tok / SEQ;
        float* orow = p.out + (size_t)tok * 1024 + lane * 16;
        const float* g2 = p.mod + b * 6144 + 5 * 1024 + lane * 16;
        float z[16];
        float ss = 0.f;
#pragma unroll
        for (int q = 0; q < 4; ++q) {
          const f32x4 xl = fload4c(mk_rsrc(p.out), (tok * 1024 + lane * 16 + q * 4) * 4, 0);
          const f32x4 gg = *(const f32x4*)(g2 + q * 4);
          const float yv[4] = {y2[j][2 * q].x, y2[j][2 * q].y, y2[j][2 * q + 1].x, y2[j][2 * q + 1].y};
#pragma unroll
          for (int i = 0; i < 4; ++i) { const float zz = xl[i] + gg[i] * (yv[i] * (1.f / 32.f)); z[q * 4 + i] = zz; ss += zz * zz; }
        }
        ss = wave_sum(ss);
        const float rstd = rsqrtf(ss * (1.f / 1024.f) + 1e-6f);
#pragma unroll
        for (int q = 0; q < 4; ++q) {
          const f32x4 fw = *(const f32x4*)(p.final_norm_w + lane * 16 + q * 4);
          f32x4 o;
#pragma unroll
          for (int i = 0; i < 4; ++i) o[i] = diag_bad ? __builtin_inff() : z[q * 4 + i] * rstd * fw[i];
          *(f32x4*)(orow + q * 4) = o;
        }
      }
    }
  }
}

__global__ void __launch_bounds__(2 * NTHR, 2) mega(P p) {
  __shared__ __attribute__((aligned(16))) char smem_all[2 * LDS_HALF];
  cg::grid_group grid = cg::this_grid();
  const int half = __builtin_amdgcn_readfirstlane(threadIdx.x >> 8);
  char* smem = smem_all + half * LDS_HALF;
  const int bid = blockIdx.x * 2 + half, nb = gridDim.x * 2;
  int nsync = 0;
  const int bng = (gridDim.x % 8 == 0) ? 8 : 1, bper = gridDim.x / bng, bgrp = blockIdx.x % bng;
  if (blockIdx.x == 0) { p.bar[threadIdx.x] = 0u; for (int i = threadIdx.x; i < (int)gridDim.x * 32; i += 2 * NTHR) p.flg[i] = 0u; }
#ifndef REPEAT_MASK
#define REPEAT_MASK 0
#endif
#ifndef EXTRA_SYNCS
#define EXTRA_SYNCS 0
#endif
#define GSYNC() do { asm volatile("s_waitcnt vmcnt(0)" ::: "memory"); \
    if (nsync == 0) { grid.sync(); } else { __syncthreads(); \
      if (threadIdx.x < 64) { \
        int rel = 0; \
        if (threadIdx.x == 0) { __builtin_amdgcn_fence(__ATOMIC_RELEASE, "agent"); asm volatile("s_waitcnt vmcnt(0)" ::: "memory"); \
          const unsigned old = __hip_atomic_fetch_add(p.bar + bgrp * 32, 1u, __ATOMIC_RELAXED, __HIP_MEMORY_SCOPE_AGENT); \
          if (old + 1u == (unsigned)(nsync * bper)) { \
            const unsigned o2 = __hip_atomic_fetch_add(p.bar + 256, 1u, __ATOMIC_RELAXED, __HIP_MEMORY_SCOPE_AGENT); \
            if (o2 + 1u == (unsigned)(nsync * bng)) rel = 1; } } \
        rel = __builtin_amdgcn_readfirstlane(rel); \
        if (rel) for (int i = threadIdx.x; i < (int)gridDim.x; i += 64) __hip_atomic_store(p.flg + i * 32, (unsigned)nsync, __ATOMIC_RELAXED, __HIP_MEMORY_SCOPE_AGENT); \
        if (threadIdx.x == 0) { \
          while (__hip_atomic_load(p.flg + blockIdx.x * 32, __ATOMIC_RELAXED, __HIP_MEMORY_SCOPE_AGENT) < (unsigned)nsync) __builtin_amdgcn_s_sleep(2); \
          __builtin_amdgcn_fence(__ATOMIC_ACQUIRE, "agent"); asm volatile("s_waitcnt vmcnt(0)" ::: "memory"); } } \
      __syncthreads(); } \
    ++nsync; } while (0)
#define RUN(k, call) if ((PHMASK & (1 << k)) && p.ph_lo <= k && k < p.ph_hi) { call; if (REPEAT_MASK & (1 << k)) { GSYNC(); call; } \
    if (k + 1 < p.ph_hi) { GSYNC(); for (int xs = 0; xs < EXTRA_SYNCS; ++xs) GSYNC(); } }
  RUN(0, ph0_prep(p, bid, nb, smem))
  RUN(1, ph_norm_rows<0>(p, bid, nb))
  RUN(2, ph_gemm8<0>(p, smem_all))
  RUN(3, ph3_chunk_local(p, bid, nb, smem))
  RUN(4, ph4_scan(p, bid, nb))
  RUN(5, ph5_mlstm_out(p, bid, nb, smem))
  RUN(6, (ph_gemm8<1>(p, smem_all), (((576 + nb - 1) / nb) * nb == 576 ? ph_convert_tables(p, bid, nb) : (void)0)))
  RUN(7, ph_norm_rows<1>(p, bid, nb))
  RUN(8, ph_gemm8<2>(p, smem_all))
  RUN(9, ph9_topk(p, bid, nb, smem))
  RUN(10, ph10_gather(p, bid, nb, smem))
#undef RUN
}

extern "C" void kernel_launch(void* const* d_in, const int* in_sizes, int n_in, void* d_out, int out_size, void* d_ws, size_t ws_size,
                              hipStream_t stream) {
  static int grid_blocks = 0;
  if (!grid_blocks) {
    int dev = 0, cus = 0, per_cu = 0;
    hipGetDevice(&dev);
    hipDeviceGetAttribute(&cus, hipDeviceAttributeMultiprocessorCount, dev);
    hipOccupancyMaxActiveBlocksPerMultiprocessor(&per_cu, (const void*)mega, 2 * NTHR, 0);
    per_cu = 1;
    grid_blocks = cus * per_cu;
    if (ws_size < WS_END + 128ull * 1024 || grid_blocks > 1024) fprintf(stderr, "kernel_launch: workspace too small: %zu < %llu\n", ws_size, (unsigned long long)WS_END);
  }
  P p{};
  const float* const* in = (const float* const*)d_in;
  p.x = in[0]; p.c = in[1]; p.ctx = in[2]; p.c_ctx = in[3]; p.w_mod = in[4]; p.b_mod = in[5]; p.norm1_w = in[6]; p.w_in = in[7];
  p.conv_w = in[8]; p.conv_b = in[9]; p.b_gates = in[10]; p.head_norm_w = in[11]; p.pool_w = in[12]; p.pool_scale = in[13];
  p.w_out = in[14]; p.norm2_w = in[15]; p.wq = in[16]; p.keys = in[17]; p.U = in[18]; p.V = in[19]; p.final_norm_w = in[20];
  p.out = (float*)d_out;
  p.bar = (unsigned*)d_ws; p.flg = (unsigned*)((char*)d_ws + WS_END);
  char* ws = (char*)d_ws;
  p.mod = (float*)(ws + OFF_MOD); p.gates = (float*)(ws + OFF_GATES);
  p.wt_in = (bf16_t*)(ws + OFF_WTIN); p.wt_out = (bf16_t*)(ws + OFF_WTOUT); p.wt_q = (bf16_t*)(ws + OFF_WTQ);
  p.keys_bf = (bf16_t*)(ws + OFF_KEYS); p.hn = (bf16_t*)(ws + OFF_HN); p.pl = (bf16_t*)(ws + OFF_PL);
  p.Dst = (bf16_t*)(ws + OFF_D); p.ND = (float*)(ws + OFF_ND); p.SC = (float*)(ws + OFF_SC);
  p.CIN = (bf16_t*)(ws + OFF_CIN); p.NIN = (float*)(ws + OFF_NIN); p.MIN_ = (float*)(ws + OFF_MIN);
  p.mix = (bf16_t*)(ws + OFF_D); p.qb = (bf16_t*)(ws + OFF_D);
  p.U8 = (unsigned char*)(ws + OFF_U8); p.V8 = (unsigned char*)(ws + OFF_U8 + 16777216ull);
  p.eidx = (unsigned short*)(ws + OFF_EIDX); p.gate = (float*)(ws + OFF_GATE);
#if N_LAUNCHES == 1
  p.ph_lo = 0; p.ph_hi = NPH;
  void* args[] = {&p};
  hipError_t e = hipLaunchCooperativeKernel((const void*)mega, dim3(grid_blocks), dim3(2 * NTHR), args, 0, stream);
  if (e != hipSuccess) fprintf(stderr, "cooperative launch failed: %s (grid %d)\n", hipGetErrorString(e), grid_blocks);
#else
  for (int ph = 0; ph < NPH; ++ph) {
    p.ph_lo = ph; p.ph_hi = ph + 1;
    void* args[] = {&p};
    hipError_t e = hipLaunchCooperativeKernel((const void*)mega, dim3(grid_blocks), dim3(2 * NTHR), args, 0, stream);
    if (e != hipSuccess) fprintf(stderr, "launch %d failed: %s (grid %d)\n", ph, hipGetErrorString(e), grid_blocks);
  }
#endif
}
```
